# Optimizing an MI355X kernel written in HIP

```python
import jax, jax.numpy as jnp
from jax import lax
import numpy as np

D_MODEL = 1024
BATCH = 4
SEQ = 4096
DEPTH = 1

POOL_WINDOWS = (2, 4, 8, 16)
N_POOL_GROUPS = len(POOL_WINDOWS)
D_POOL = D_MODEL // 2
POOL_GROUP = D_POOL // N_POOL_GROUPS
D_RNN = D_MODEL
N_RNN_HEADS = 8
RNN_HEAD = D_RNN // N_RNN_HEADS
CONV_WIDTH = 4
LRU_C = 8.0
N_BRANCHES = 2
D_IN = D_POOL + 2 * D_RNN + N_BRANCHES * D_MODEL
D_FF = -(-8 * D_MODEL // (3 * 256)) * 256
NORM_EPS = 1e-6

kernel_name = "hybrid_pool_rglru_gated_block"


def rmsnorm(x, g):
    xf = x.astype(jnp.float32)
    y = xf * lax.rsqrt(jnp.mean(xf * xf, axis=-1, keepdims=True) + NORM_EPS)
    return (y * g.astype(jnp.float32)).astype(x.dtype)


def pool_mixer(u, w_grp, scale):
    B, S, _ = u.shape
    uf = u.astype(jnp.float32).reshape(B, S, N_POOL_GROUPS, POOL_GROUP)
    c = jnp.cumsum(uf, axis=1)
    pos = jnp.arange(S)
    outs = []
    for g, w in enumerate(POOL_WINDOWS):
        cg = c[:, :, g]
        c_lo = jnp.pad(cg[:, : S - w], ((0, 0), (w, 0), (0, 0)))
        count = jnp.minimum(pos + 1, w).astype(jnp.float32)[None, :, None]
        outs.append((cg - c_lo) / count - uf[:, :, g])
    pooled = jnp.stack(outs, axis=2).astype(u.dtype)
    mixed = jnp.einsum("bsgc,gcd->bsgd", pooled, w_grp)
    return mixed.reshape(B, S, D_POOL) * scale


def causal_depthwise_conv(u, w, b):
    S = u.shape[1]
    up = jnp.pad(u, ((0, 0), (CONV_WIDTH - 1, 0), (0, 0)))
    y = b
    for k in range(CONV_WIDTH):
        y = y + up[:, k : k + S] * w[k]
    return y


def rg_lru(v, w_a, b_a, w_x, b_x, lam):
    B, S, _ = v.shape
    vh = v.reshape(B, S, N_RNN_HEADS, RNN_HEAD)
    r = jax.nn.sigmoid((jnp.einsum("bshi,hij->bshj", vh, w_a) + b_a).astype(jnp.float32)).reshape(B, S, D_RNN)
    i = jax.nn.sigmoid((jnp.einsum("bshi,hij->bshj", vh, w_x) + b_x).astype(jnp.float32)).reshape(B, S, D_RNN)
    log_a = -LRU_C * r * jax.nn.softplus(-lam.astype(jnp.float32))
    a = jnp.exp(log_a)
    b = jnp.sqrt(-jnp.expm1(2.0 * log_a)) * i * v.astype(jnp.float32)

    def combine(left, right):
        a1, b1 = left
        a2, b2 = right
        return a1 * a2, a2 * b1 + b2

    _, h = lax.associative_scan(combine, (a, b), axis=1)
    return h.astype(v.dtype)


def setup_inputs(seed: int = 0) -> dict:
    key = jax.random.key(seed)
    ks = jax.random.split(key, 22)
    f32 = jnp.float32
    L = DEPTH

    def nrm(k, shape, fan_in):
        return jax.random.normal(k, shape, f32) * fan_in ** -0.5

    def small(k, shape, s=0.02):
        return jax.random.normal(k, shape, f32) * s

    x = jax.random.normal(ks[0], (BATCH, SEQ, D_MODEL), f32)
    norm_mix = 1.0 + small(ks[1], (L, D_MODEL))
    w_in = nrm(ks[2], (L, D_MODEL, D_IN), D_MODEL)
    w_pool_grp = nrm(ks[3], (L, N_POOL_GROUPS, POOL_GROUP, POOL_GROUP), POOL_GROUP)
    pool_scale = 1.0 + small(ks[4], (L, D_POOL))
    w_pool_out = nrm(ks[5], (L, D_POOL, D_MODEL), D_POOL)
    conv_w = nrm(ks[6], (L, CONV_WIDTH, D_RNN), CONV_WIDTH)
    conv_b = small(ks[7], (L, D_RNN))
    w_rg_a = nrm(ks[8], (L, N_RNN_HEADS, RNN_HEAD, RNN_HEAD), RNN_HEAD)
    b_rg_a = small(ks[9], (L, N_RNN_HEADS, RNN_HEAD))
    w_rg_x = nrm(ks[10], (L, N_RNN_HEADS, RNN_HEAD, RNN_HEAD), RNN_HEAD)
    b_rg_x = small(ks[11], (L, N_RNN_HEADS, RNN_HEAD))
    a_c = jax.random.uniform(ks[12], (L, D_RNN), f32, minval=0.9, maxval=0.999)
    a0 = a_c ** (1.0 / LRU_C)
    lru_lambda = jnp.log(a0) - jnp.log1p(-a0)
    w_rnn_out = nrm(ks[13], (L, D_RNN, D_MODEL), D_RNN)
    w_o = nrm(ks[14], (L, D_MODEL, D_MODEL), D_MODEL)
    norm_ffn = 1.0 + small(ks[15], (L, D_MODEL))
    w_ffn_in = nrm(ks[16], (L, D_MODEL, 2 * D_FF), D_MODEL)
    w_ffn_out = nrm(ks[17], (L, D_FF, D_MODEL), D_FF)
    norm_final = 1.0 + small(ks[18], (D_MODEL,))
    return {"x": x, "norm_mix": norm_mix, "w_in": w_in, "w_pool_grp": w_pool_grp,
            "pool_scale": pool_scale, "w_pool_out": w_pool_out, "conv_w": conv_w, "conv_b": conv_b,
            "w_rg_a": w_rg_a, "b_rg_a": b_rg_a, "w_rg_x": w_rg_x, "b_rg_x": b_rg_x,
            "lru_lambda": lru_lambda, "w_rnn_out": w_rnn_out, "w_o": w_o, "norm_ffn": norm_ffn,
            "w_ffn_in": w_ffn_in, "w_ffn_out": w_ffn_out, "norm_final": norm_final}


def reference(x, norm_mix, w_in, w_pool_grp, pool_scale, w_pool_out, conv_w, conv_b,
              w_rg_a, b_rg_a, w_rg_x, b_rg_x, lru_lambda, w_rnn_out, w_o, norm_ffn,
              w_ffn_in, w_ffn_out, norm_final):
    B, S, _ = x.shape
    for l in range(DEPTH):
        h = rmsnorm(x, norm_mix[l])
        proj = h @ w_in[l]
        o1 = D_POOL
        o2 = o1 + D_RNN
        o3 = o2 + D_RNN
        u_pool = proj[..., :o1]
        u_rnn = proj[..., o1:o2]
        u_gate = proj[..., o2:o3]
        g_merge = jax.nn.sigmoid(proj[..., o3:].reshape(B, S, N_BRANCHES, D_MODEL))

        y_pool = pool_mixer(u_pool, w_pool_grp[l], pool_scale[l]) @ w_pool_out[l]

        v = causal_depthwise_conv(u_rnn, conv_w[l], conv_b[l])
        hr = rg_lru(v, w_rg_a[l], b_rg_a[l], w_rg_x[l], b_rg_x[l], lru_lambda[l])
        y_rnn = (hr * jax.nn.gelu(u_gate)) @ w_rnn_out[l]

        mix = g_merge[:, :, 0] * y_pool + g_merge[:, :, 1] * y_rnn
        x = x + mix @ w_o[l]

        h = rmsnorm(x, norm_ffn[l])
        gu = h @ w_ffn_in[l]
        gate, up = gu[..., :D_FF], gu[..., D_FF:]
        x = x + (jax.nn.silu(gate) * up) @ w_ffn_out[l]
    return rmsnorm(x, norm_final)
```

```cpp
#include <hip/hip_runtime.h>
#include <hip/hip_cooperative_groups.h>
#include <cstdio>
#include <cstdint>
namespace cg = cooperative_groups;

#ifndef MK_PER_PHASE
#define MK_PER_PHASE 0
#endif

namespace pg8 {
#define PG8_LAS __attribute__((address_space(3)))
typedef unsigned short bf16_t;
typedef short bf16x8 __attribute__((ext_vector_type(8)));
typedef float f32x4 __attribute__((ext_vector_type(4)));
typedef float f32x2 __attribute__((ext_vector_type(2)));
typedef unsigned u32x4 __attribute__((ext_vector_type(4)));
typedef unsigned u32x2 __attribute__((ext_vector_type(2)));
constexpr int BM = 256, BK = 64, HALF = 128, HTB = HALF * BK * 2, STAGE_BYTES = 8 * HTB, NXCD = 8, WGM = 8;

__host__ __device__ __forceinline__ int lds_byte(int r, int c) { const int st = (r >> 4) * 2 + (c >> 5), rr = r & 15, cc = c & 31, ob = rr * 64 + cc * 2; return st * 1024 + (ob ^ (((ob >> 9) & 1) << 5)); }
__host__ __device__ __forceinline__ void stage_rc(int b, int& R, int& C) { const int st = b / 1024, sb = b % 1024, swz = sb ^ (((sb >> 9) & 1) << 5); R = (st >> 1) * 16 + swz / 64; C = (st & 1) * 32 + (swz % 64) / 2; }
__host__ __device__ __forceinline__ int perm32(int rho) { const int n = rho >> 4, i = rho & 15; return 8 * (i >> 2) + 4 * n + (i & 3); }

struct Unit { int pm, pn; };
struct Gemm { const bf16_t* A; const bf16_t* Bt; int M, N, K, lda, ldb, ash, amul; };

struct StaticOrder {
    int nM, nN, nwg, G, c;
    __host__ __device__ void init(int M, int N, int G_, int c_) { nM = M / BM; nN = N / BM; nwg = nM * nN; G = G_; c = c_; }
    __host__ __device__ bool next(int i, Unit& u) const {
        const long L = (long)i * G + c; if (L >= nwg) return false;
        int wgid = (int)L; { const int q = nwg / NXCD, r = nwg % NXCD, xcd = wgid % NXCD, off = wgid / NXCD; wgid = (xcd < r ? xcd * (q + 1) : r * (q + 1) + (xcd - r) * q) + off; }
        const int nig = WGM * nN, gid = wgid / nig, fm = gid * WGM, gsz = (nM - fm) < WGM ? (nM - fm) : WGM;
        u.pm = fm + ((wgid % nig) % gsz); u.pn = (wgid % nig) / gsz; return true;
    }
};

__device__ __forceinline__ unsigned cvt_pk_bf16(float lo, float hi) { unsigned r; asm volatile("v_cvt_pk_bf16_f32 %0, %1, %2" : "=v"(r) : "v"(lo), "v"(hi)); return r; }
__device__ __forceinline__ float bf_lo(unsigned w) { return __uint_as_float(w << 16); }
__device__ __forceinline__ float bf_hi(unsigned w) { return __uint_as_float(w & 0xffff0000u); }
__device__ __forceinline__ float sigmoidf_(float x) { return __builtin_amdgcn_rcpf(1.0f + __expf(-x)); }
__device__ __forceinline__ float gelu_tanh_(float x) { const float z = 1.5957691216057308f * (x + 0.044715f * x * x * x); return x * sigmoidf_(z); }
__device__ __forceinline__ u32x4 pack8(const f32x4 a, const f32x4 b) { u32x4 w; w.x = cvt_pk_bf16(a[0], a[1]); w.y = cvt_pk_bf16(a[2], a[3]); w.z = cvt_pk_bf16(b[0], b[1]); w.w = cvt_pk_bf16(b[2], b[3]); return w; }
__device__ __forceinline__ void unpack8(const u32x4 w, f32x4& a, f32x4& b) { a = (f32x4){bf_lo(w.x), bf_hi(w.x), bf_lo(w.y), bf_hi(w.y)}; b = (f32x4){bf_lo(w.z), bf_hi(w.z), bf_lo(w.w), bf_hi(w.w)}; }

#define EPI_ROWS_BEGIN _Pragma("unroll") for (int ai = 0; ai < 2; ++ai) _Pragma("unroll") for (int m = 0; m < 4; ++m) { const int row = u.pm * BM + ai * HALF + wr * 64 + m * 16 + fr;
#define EPI_ROWS_END __builtin_amdgcn_sched_barrier(0); }

struct EpiProj {
    bf16_t *UP, *UR, *UG, *G0, *G1;
    __device__ __forceinline__ void operator()(const f32x4 (&acc)[2][2][4][2], const Unit& u, int wr, int wc, int fr, int fq) const {
        const int pn = u.pn; bf16_t* base; int ldc, colt, act;
        if (pn < 2) { base = UP; ldc = 512; colt = pn * 256; act = 0; }
        else if (pn < 6) { base = UR; ldc = 1024; colt = (pn - 2) * 256; act = 0; }
        else if (pn < 10) { base = UG; ldc = 1024; colt = (pn - 6) * 256; act = 1; }
        else if (pn < 14) { base = G0; ldc = 1024; colt = (pn - 10) * 256; act = 2; }
        else { base = G1; ldc = 1024; colt = (pn - 14) * 256; act = 2; }
        const int col0 = colt + wc * 32 + 8 * fq;
        EPI_ROWS_BEGIN
            bf16_t* rowp = base + (size_t)row * ldc + col0;
#pragma unroll
            for (int bj = 0; bj < 2; ++bj) { f32x4 v0 = acc[ai][bj][m][0], v1 = acc[ai][bj][m][1];
                if (act == 1) {
#pragma unroll
                    for (int j = 0; j < 4; ++j) { v0[j] = gelu_tanh_(v0[j]); v1[j] = gelu_tanh_(v1[j]); } }
                else if (act == 2) {
#pragma unroll
                    for (int j = 0; j < 4; ++j) { v0[j] = sigmoidf_(v0[j]); v1[j] = sigmoidf_(v1[j]); } }
                *(u32x4*)(rowp + bj * HALF) = pack8(v0, v1); }
        EPI_ROWS_END
    }
};
struct EpiGrp {
    bf16_t* O; const float* scale;
    __device__ __forceinline__ void operator()(const f32x4 (&acc)[2][2][4][2], const Unit& u, int wr, int wc, int fr, int fq) const {
        const int col0 = u.pn * BM + wc * 32 + 8 * fq;
        f32x4 sc[2][2];
#pragma unroll
        for (int bj = 0; bj < 2; ++bj)
#pragma unroll
            for (int n = 0; n < 2; ++n) sc[bj][n] = *(const f32x4*)(scale + col0 + bj * HALF + 4 * n);
        EPI_ROWS_BEGIN
            bf16_t* rowp = O + (size_t)row * 512 + col0;
#pragma unroll
            for (int bj = 0; bj < 2; ++bj) *(u32x4*)(rowp + bj * HALF) = pack8(acc[ai][bj][m][0] * sc[bj][0], acc[ai][bj][m][1] * sc[bj][1]);
        EPI_ROWS_END
    }
};
struct EpiGate {
    const bf16_t* V; bf16_t *LA, *BB; const float *b_a, *b_x, *sp8;
    __device__ __forceinline__ void operator()(const f32x4 (&acc)[2][2][4][2], const Unit& u, int wr, int wc, int fr, int fq) const {
        const int ch0 = u.pn * 128 + wc * 32 + 8 * fq;
        f32x4 ba[2], bx[2], sp[2];
#pragma unroll
        for (int n = 0; n < 2; ++n) { ba[n] = *(const f32x4*)(b_a + ch0 + 4 * n); bx[n] = *(const f32x4*)(b_x + ch0 + 4 * n); sp[n] = *(const f32x4*)(sp8 + ch0 + 4 * n); }
        EPI_ROWS_BEGIN
            const size_t off = (size_t)row * 1024 + ch0;
            const u32x4 vw = *(const u32x4*)(V + off); f32x4 vv[2]; unpack8(vw, vv[0], vv[1]);
            f32x4 la[2], bb[2];
#pragma unroll
            for (int n = 0; n < 2; ++n)
#pragma unroll
                for (int j = 0; j < 4; ++j) {
                    const float r = sigmoidf_(acc[ai][0][m][n][j] + ba[n][j]), ig = sigmoidf_(acc[ai][1][m][n][j] + bx[n][j]);
                    const float l = sp[n][j] * r, x2 = 2.0f * l;
                    const float em1 = (x2 > -0.125f) ? x2 * (1.0f + 0.5f * x2 * (1.0f + 0.33333334f * x2 * (1.0f + 0.25f * x2 * (1.0f + 0.2f * x2)))) : (__expf(x2) - 1.0f);
                    la[n][j] = l; bb[n][j] = sqrtf(fmaxf(-em1, 0.f)) * ig * vv[n][j]; }
            *(u32x4*)(LA + off) = pack8(la[0], la[1]); *(u32x4*)(BB + off) = pack8(bb[0], bb[1]);
            asm volatile("" ::: "memory");
        EPI_ROWS_END
    }
};
struct EpiMix0 {
    const bf16_t* G0; float* MIX0;
    __device__ __forceinline__ void operator()(const f32x4 (&acc)[2][2][4][2], const Unit& u, int wr, int wc, int fr, int fq) const {
        const int col0 = u.pn * BM + wc * 32 + 8 * fq;
        EPI_ROWS_BEGIN
            const size_t off = (size_t)row * 1024 + col0;
#pragma unroll
            for (int bj = 0; bj < 2; ++bj) { f32x4 g[2]; unpack8(*(const u32x4*)(G0 + off + bj * HALF), g[0], g[1]);
                *(f32x4*)(MIX0 + off + bj * HALF) = g[0] * acc[ai][bj][m][0]; *(f32x4*)(MIX0 + off + bj * HALF + 4) = g[1] * acc[ai][bj][m][1]; }
        EPI_ROWS_END
    }
};
struct EpiMix1 {
    const bf16_t* G1; const float* MIX0; bf16_t* MIXB;
    __device__ __forceinline__ void operator()(const f32x4 (&acc)[2][2][4][2], const Unit& u, int wr, int wc, int fr, int fq) const {
        const int col0 = u.pn * BM + wc * 32 + 8 * fq;
        EPI_ROWS_BEGIN
            const size_t off = (size_t)row * 1024 + col0;
#pragma unroll
            for (int bj = 0; bj < 2; ++bj) { f32x4 g[2]; unpack8(*(const u32x4*)(G1 + off + bj * HALF), g[0], g[1]);
                const f32x4 m0 = *(const f32x4*)(MIX0 + off + bj * HALF), m1 = *(const f32x4*)(MIX0 + off + bj * HALF + 4);
                *(u32x4*)(MIXB + off + bj * HALF) = pack8(m0 + g[0] * acc[ai][bj][m][0], m1 + g[1] * acc[ai][bj][m][1]); }
        EPI_ROWS_END
    }
};
struct EpiRes1 {
    const float* X; float* X1; bf16_t* X1B; float* SSQ;
    __device__ __forceinline__ void operator()(const f32x4 (&acc)[2][2][4][2], const Unit& u, int wr, int wc, int fr, int fq) const {
        const int col0 = u.pn * BM + wc * 32 + 8 * fq;
        EPI_ROWS_BEGIN
            const size_t off = (size_t)row * 1024 + col0; float ss = 0.f;
#pragma unroll
            for (int bj = 0; bj < 2; ++bj) {
                const f32x4 a = *(const f32x4*)(X + off + bj * HALF) + acc[ai][bj][m][0], b = *(const f32x4*)(X + off + bj * HALF + 4) + acc[ai][bj][m][1];
                *(f32x4*)(X1 + off + bj * HALF) = a; *(f32x4*)(X1 + off + bj * HALF + 4) = b; *(u32x4*)(X1B + off + bj * HALF) = pack8(a, b);
                ss += (a[0] * a[0] + a[1] * a[1]) + (a[2] * a[2] + a[3] * a[3]) + (b[0] * b[0] + b[1] * b[1]) + (b[2] * b[2] + b[3] * b[3]); }
            ss += __shfl_xor(ss, 16); ss += __shfl_xor(ss, 32);
            if (fq == 0) SSQ[(size_t)row * 16 + u.pn * 4 + wc] = ss;
        EPI_ROWS_END
    }
};
struct EpiSwiglu {
    const float* SSQ; bf16_t* ACT;
    __device__ __forceinline__ void operator()(const f32x4 (&acc)[2][2][4][2], const Unit& u, int wr, int wc, int fr, int fq) const {
        const int col0 = u.pn * 128 + wc * 32 + 8 * fq;
        EPI_ROWS_BEGIN
            const f32x4* sp = (const f32x4*)(SSQ + (size_t)row * 16); const f32x4 s0 = sp[0], s1 = sp[1], s2 = sp[2], s3 = sp[3];
            const f32x4 st = (s0 + s1) + (s2 + s3); const float rs = __builtin_amdgcn_rsqf((st[0] + st[1] + st[2] + st[3]) * (1.0f / 1024.0f) + 1e-6f);
            f32x4 o[2];
#pragma unroll
            for (int n = 0; n < 2; ++n)
#pragma unroll
                for (int j = 0; j < 4; ++j) { const float g = acc[ai][0][m][n][j] * rs, up = acc[ai][1][m][n][j] * rs; o[n][j] = g * sigmoidf_(g) * up; }
            *(u32x4*)(ACT + (size_t)row * 2816 + col0) = pack8(o[0], o[1]);
        EPI_ROWS_END
    }
};
struct EpiRes2 {
    float* X1;
    __device__ __forceinline__ void operator()(const f32x4 (&acc)[2][2][4][2], const Unit& u, int wr, int wc, int fr, int fq) const {
        const int col0 = u.pn * BM + wc * 32 + 8 * fq;
        EPI_ROWS_BEGIN
            const size_t off = (size_t)row * 1024 + col0;
#pragma unroll
            for (int bj = 0; bj < 2; ++bj) {
                const f32x4 a = *(const f32x4*)(X1 + off + bj * HALF) + acc[ai][bj][m][0], b = *(const f32x4*)(X1 + off + bj * HALF + 4) + acc[ai][bj][m][1];
                *(f32x4*)(X1 + off + bj * HALF) = a; *(f32x4*)(X1 + off + bj * HALF + 4) = b; }
        EPI_ROWS_END
    }
};

template <class Epi, bool ALIGN_EPI>
__device__ __forceinline__ void gemm_phase(PG8_LAS unsigned char* lds, const Gemm g, const StaticOrder& S, const Epi& E) {
    const int tid = threadIdx.x, wid = __builtin_amdgcn_readfirstlane(tid >> 6), lane = tid & 63, wr = wid >> 2, wc = wid & 3, fr = lane & 15, fq = lane >> 4;
    int nt = g.K / BK; asm volatile("" : "+s"(nt));
    unsigned voffA[2], voffB[2];
#pragma unroll
    for (int i = 0; i < 2; ++i) { int R, C; stage_rc(tid * 16 + i * 8192, R, C); const int Rb = (R & ~31) + perm32(R & 31);
        voffA[i] = (unsigned)(R * g.lda + C) * 2u; voffB[i] = (unsigned)(Rb * g.ldb + C) * 2u; }
    const size_t kstep = (size_t)(BK * 2);
    const size_t hstepA = (size_t)HALF * g.lda * 2, hstepB = (size_t)HALF * g.ldb * 2;
    const size_t tstepA = 2 * hstepA, tstepB = 2 * hstepB;
    const unsigned ldsw = (unsigned)wid * 1024u;
    const int aoff = lds_byte(wr * 64 + fr, fq * 8), boff = lds_byte(wc * 32 + fr, fq * 8);
#define PG8_SA(b, h) (((b) * 2 + (h)) * HTB)
#define PG8_SB(b, h) ((4 + (b) * 2 + (h)) * HTB)
#define PG8_STAGE(bufoff, gbase, voff) do { _Pragma("unroll") for (int _i = 0; _i < 2; ++_i) \
        __builtin_amdgcn_global_load_lds((const unsigned*)((const char*)(gbase) + (voff)[_i]), (PG8_LAS unsigned*)(lds + (bufoff) + ldsw + _i * 8192), 16, 0, 0); } while (0)
#define PG8_LDA(dst, b, h) do { _Pragma("unroll") for (int m = 0; m < 4; ++m) _Pragma("unroll") for (int k = 0; k < 2; ++k) dst[m][k] = *(const PG8_LAS bf16x8*)(lds + PG8_SA(b, h) + aoff + m * 2048 + k * 1024); } while (0)
#define PG8_LDB(dst, b, h) do { _Pragma("unroll") for (int n = 0; n < 2; ++n) _Pragma("unroll") for (int k = 0; k < 2; ++k) dst[n][k] = *(const PG8_LAS bf16x8*)(lds + PG8_SB(b, h) + boff + n * 2048 + k * 1024); } while (0)
#define PG8_MMA(ai, bj, At, Bt) do { __builtin_amdgcn_s_setprio(1); _Pragma("unroll") for (int m = 0; m < 4; ++m) _Pragma("unroll") for (int n = 0; n < 2; ++n) _Pragma("unroll") for (int k = 0; k < 2; ++k) \
        acc[ai][bj][m][n] = __builtin_amdgcn_mfma_f32_16x16x32_bf16(Bt[n][k], At[m][k], acc[ai][bj][m][n], 0, 0, 0); __builtin_amdgcn_s_setprio(0); } while (0)
#define PG8_WAIT_V(n) asm volatile("s_waitcnt vmcnt(" #n ")" ::: "memory")
#define PG8_WAIT_L(n) asm volatile("s_waitcnt lgkmcnt(" #n ")" ::: "memory")
#define PG8_BAR __builtin_amdgcn_s_barrier()
#define PG8_SCHED __builtin_amdgcn_sched_barrier(0)
    Unit cur, nxt; int ui = 0;
    if (!S.next(0, cur)) return;
    f32x4 acc[2][2][4][2];
#pragma unroll
    for (int a = 0; a < 2; ++a)
#pragma unroll
        for (int b = 0; b < 2; ++b)
#pragma unroll
            for (int m = 0; m < 4; ++m)
#pragma unroll
                for (int n = 0; n < 2; ++n) acc[a][b][m][n] = (f32x4){0.f, 0.f, 0.f, 0.f};
    bf16x8 At[4][2], B0[2][2], B1[2][2];
    const char* cA = (const char*)g.A + (size_t)cur.pm * tstepA + (size_t)((cur.pn >> g.ash) * g.amul) * 2; const char* cB = (const char*)g.Bt + (size_t)cur.pn * tstepB;
    PG8_STAGE(PG8_SB(0, 0), cB, voffB); PG8_STAGE(PG8_SB(0, 1), cB + hstepB, voffB); PG8_STAGE(PG8_SA(0, 0), cA, voffA); PG8_STAGE(PG8_SA(0, 1), cA + hstepA, voffA);
    if (wr == 1) PG8_BAR;
    PG8_WAIT_V(2); PG8_BAR;
    PG8_STAGE(PG8_SB(1, 0), cB + kstep, voffB); PG8_STAGE(PG8_SA(1, 0), cA + kstep, voffA); PG8_STAGE(PG8_SB(1, 1), cB + hstepB + kstep, voffB);
    PG8_WAIT_V(6); PG8_BAR;
    for (;;) {
        const bool has_next = S.next(ui + 1, nxt);
        const char* nA = has_next ? (const char*)g.A + (size_t)nxt.pm * tstepA + (size_t)((nxt.pn >> g.ash) * g.amul) * 2 : cA; const char* nB = has_next ? (const char*)g.Bt + (size_t)nxt.pn * tstepB : cB;
        for (int t = 0; t < nt; t += 2) {
            const bool last = (t == nt - 2);
            const char* a1 = cA + (size_t)(t + 1) * kstep;
            const char* a2 = last ? nA : cA + (size_t)(t + 2) * kstep; const char* b2 = last ? nB : cB + (size_t)(t + 2) * kstep;
            const char* a3 = a2 + kstep; const char* b3 = b2 + kstep;
            PG8_LDB(B0, 0, 0); PG8_LDB(B1, 0, 1); PG8_SCHED; PG8_LDA(At, 0, 0); PG8_STAGE(PG8_SA(1, 1), a1 + hstepA, voffA);
            PG8_WAIT_V(8); PG8_WAIT_L(0); PG8_BAR; PG8_MMA(0, 0, At, B0); PG8_MMA(0, 1, At, B1); PG8_BAR; PG8_SCHED;
            PG8_LDA(At, 0, 1); PG8_STAGE(PG8_SB(0, 0), b2, voffB); PG8_STAGE(PG8_SB(0, 1), b2 + hstepB, voffB); PG8_STAGE(PG8_SA(0, 0), a2, voffA);
            PG8_WAIT_V(8); PG8_WAIT_L(0); PG8_BAR; PG8_MMA(1, 0, At, B0); PG8_MMA(1, 1, At, B1); PG8_BAR; PG8_SCHED;
            PG8_LDB(B0, 1, 0); PG8_LDB(B1, 1, 1); PG8_SCHED; PG8_LDA(At, 1, 0); PG8_STAGE(PG8_SA(0, 1), a2 + hstepA, voffA);
            PG8_WAIT_V(8); PG8_WAIT_L(0); PG8_BAR; PG8_MMA(0, 0, At, B0); PG8_MMA(0, 1, At, B1); PG8_BAR; PG8_SCHED;
            PG8_LDA(At, 1, 1); PG8_STAGE(PG8_SB(1, 0), b3, voffB); PG8_STAGE(PG8_SB(1, 1), b3 + hstepB, voffB); PG8_STAGE(PG8_SA(1, 0), a3, voffA);
            PG8_WAIT_V(8); PG8_WAIT_L(0); PG8_BAR; PG8_MMA(1, 0, At, B0); PG8_MMA(1, 1, At, B1); PG8_BAR; PG8_SCHED;
        }
        if constexpr (ALIGN_EPI) { if (wr == 0) PG8_BAR; }
        E(acc, cur, wr, wc, fr, fq);
        if (!has_next) break;
#pragma unroll
        for (int a = 0; a < 2; ++a)
#pragma unroll
            for (int b = 0; b < 2; ++b)
#pragma unroll
                for (int m = 0; m < 4; ++m)
#pragma unroll
                    for (int n = 0; n < 2; ++n) acc[a][b][m][n] = (f32x4){0.f, 0.f, 0.f, 0.f};
        cur = nxt; cA = nA; cB = nB; ++ui;
        if constexpr (ALIGN_EPI) { if (wr == 1) PG8_BAR; }
    }
    PG8_WAIT_V(0);
    if constexpr (!ALIGN_EPI) { if (wr == 0) PG8_BAR; }
    PG8_BAR;
#undef PG8_SA
#undef PG8_SB
#undef PG8_STAGE
#undef PG8_LDA
#undef PG8_LDB
#undef PG8_MMA
#undef PG8_WAIT_V
#undef PG8_WAIT_L
#undef PG8_BAR
#undef PG8_SCHED
}
}

constexpr int NWAVES = 8, NTHR = 512;
constexpr int M = 16384, SEQ = 4096, NB = 4, D = 1024, DPOOL = 512, DRNN = 1024, DIN = 4608, DFF = 2816;
constexpr float EPS = 1e-6f;
constexpr int NPH = 11;
constexpr int SCAN_T = 64, SCAN_NC = SEQ / SCAN_T;

constexpr size_t MiB = 1u << 20;
constexpr size_t WS_SP8 = 512 * 1024;
constexpr size_t WS_SSQ = 1 * MiB;
constexpr size_t WS_CS = 2 * MiB, WS_CH = 3 * MiB;
constexpr size_t WS_WIN = 4 * MiB;
constexpr size_t WS_WFI = 13 * MiB;
constexpr size_t WS_WFO = 24 * MiB;
constexpr size_t WS_WRO = WS_WFO + 5632 * 1024;
constexpr size_t WS_WO = WS_WRO + 2 * MiB;
constexpr size_t WS_WPO = WS_WO + 2 * MiB;
constexpr size_t WS_WGRP = WS_WPO + 1 * MiB;
constexpr size_t WS_WGATE = WS_WGRP + MiB / 4;
constexpr size_t WS_R1 = 36 * MiB;
constexpr size_t WS_R2 = 68 * MiB;
constexpr size_t WS_R3 = 84 * MiB;
constexpr size_t WS_R4 = 116 * MiB;
constexpr size_t WS_R7 = 148 * MiB;
constexpr size_t WS_R8 = 164 * MiB;
constexpr size_t WS_MIX0 = 84 * MiB;
constexpr size_t WS_MIXB = 148 * MiB;
constexpr size_t WS_ACT = 68 * MiB;
constexpr size_t WS_END = 196 * MiB;

constexpr int LDS_BYTES = 147456;

#define LAS __attribute__((address_space(3)))
typedef unsigned short bf16;
typedef unsigned v4u __attribute__((ext_vector_type(4)));
typedef unsigned v2u __attribute__((ext_vector_type(2)));
typedef float f32x4 __attribute__((ext_vector_type(4)));
typedef float f32x2 __attribute__((ext_vector_type(2)));
#define LDS_WAIT() asm volatile("s_waitcnt lgkmcnt(0)" ::: "memory")
using pg8::cvt_pk_bf16; using pg8::bf_lo; using pg8::bf_hi;

struct Args { const float* in[19]; float* out; unsigned char* ws; int ph_lo, ph_hi; };
enum { I_X = 0, I_NORM_MIX, I_W_IN, I_W_GRP, I_POOL_SCALE, I_W_POOL_OUT, I_CONV_W, I_CONV_B, I_W_RG_A, I_B_RG_A, I_W_RG_X, I_B_RG_X, I_LAMBDA, I_W_RNN_OUT, I_W_O, I_NORM_FFN, I_W_FFN_IN, I_W_FFN_OUT, I_NORM_FINAL };

__device__ __forceinline__ float wave_sum(float v) {
#pragma unroll
    for (int o = 1; o < 64; o <<= 1) v += __shfl_xor(v, o);
    return v;
}

__device__ __forceinline__ void transpose_item(const float* W, int Nsrc, int Kdst, bf16* WT, int k0, int n_src0, int n_dst0, const float* kscale, LAS float* scr, int lane) {
#pragma unroll 8
    for (int i = 0; i < 32; ++i) { const int kk = 2 * i + (lane >> 5); float w = W[(size_t)(k0 + kk) * Nsrc + n_src0 + (lane & 31)]; if (kscale) w *= kscale[k0 + kk]; scr[kk * 33 + (lane & 31)] = w; }
    LDS_WAIT(); asm volatile("" ::: "memory");
    const int c = lane & 7;
#pragma unroll
    for (int j = 0; j < 4; ++j) { const int n = (lane >> 3) + 8 * j; const LAS float* s = scr + (8 * c) * 33 + n;
        v4u o; o.x = cvt_pk_bf16(s[0 * 33], s[1 * 33]); o.y = cvt_pk_bf16(s[2 * 33], s[3 * 33]); o.z = cvt_pk_bf16(s[4 * 33], s[5 * 33]); o.w = cvt_pk_bf16(s[6 * 33], s[7 * 33]);
        *(v4u*)(WT + (size_t)(n_dst0 + n) * Kdst + k0 + 8 * c) = o; }
    LDS_WAIT(); asm volatile("" ::: "memory");
}

__global__ void __launch_bounds__(NTHR, 2) fwd_kernel(Args args) {
    extern __shared__ __attribute__((aligned(16))) unsigned char lds_raw[];
    LAS unsigned char* lds = (LAS unsigned char*)lds_raw;
    const int tid = threadIdx.x, lane = tid & 63, wave = __builtin_amdgcn_readfirstlane(tid >> 6);
    const int G = gridDim.x, bx = blockIdx.x;
    unsigned char* ws = args.ws;
    const int lo = args.ph_lo, hi = args.ph_hi;
#ifndef PHASE_MASK
#define PHASE_MASK 0x7ff
#endif
#define IN(k) (((PHASE_MASK >> (k)) & 1) && lo <= (k) && (k) < hi)
#define SEAM(k) do { if (IN(k) && IN((k) + 1)) { cg::this_grid().sync(); } } while (0)

    const float* x = args.in[I_X];
    bf16* WIN = (bf16*)(ws + WS_WIN); bf16* WFI = (bf16*)(ws + WS_WFI); bf16* WFO = (bf16*)(ws + WS_WFO); bf16* WRO = (bf16*)(ws + WS_WRO);
    bf16* WO = (bf16*)(ws + WS_WO); bf16* WPO = (bf16*)(ws + WS_WPO); bf16* WGRP = (bf16*)(ws + WS_WGRP); bf16* WGATE = (bf16*)(ws + WS_WGATE);
    bf16* XN = (bf16*)(ws + WS_R1); bf16* V = XN; bf16* HG = XN; bf16* X1B = XN;
    bf16* UP = (bf16*)(ws + WS_R2); bf16* MIXED = UP;
    bf16* UR = (bf16*)(ws + WS_R3); bf16* LA = UR;
    bf16* UG = (bf16*)(ws + WS_R4);
    bf16* POOLED = (bf16*)(ws + WS_R7); bf16* BB = (bf16*)(ws + WS_R8);
    float* MIX0 = (float*)(ws + WS_MIX0); bf16* MIXB = (bf16*)(ws + WS_MIXB); bf16* ACT = (bf16*)(ws + WS_ACT);
    float* SSQ = (float*)(ws + WS_SSQ); float* CS = (float*)(ws + WS_CS); float* CH = (float*)(ws + WS_CH);
    bf16* G0 = (bf16*)args.out; bf16* G1 = G0 + (size_t)M * 1024;
    float* X1 = args.out;

    if (IN(0)) {
        LAS float* scr = (LAS float*)(lds + wave * 16384);
        const int gw = bx * NWAVES + wave, NGW = G * NWAVES;
        constexpr int I_IN = 16 * (DIN / 32), I_FI = 16 * (2 * DFF / 32), I_FO = (DFF / 64) * (D / 32), I_RO = 16 * 32, I_WO = 16 * 32, I_PO = 8 * 32;
        constexpr int NITEMS = I_IN + I_FI + I_FO + I_RO + I_WO + I_PO;
        for (int it = gw; it < NITEMS; it += NGW) {
            int r = it;
            if (r < I_IN) { const int nblk = DIN / 32, kb = r / nblk, nb = r % nblk; transpose_item(args.in[I_W_IN], DIN, D, WIN, 64 * kb, 32 * nb, 32 * nb, nullptr, scr, lane); continue; } r -= I_IN;
            if (r < I_FI) { const int nblk = 2 * DFF / 32, kb = r / nblk, nb = r % nblk, nd = 32 * nb, pn = nd >> 8, j0 = nd & 255;
                const int ns = j0 < 128 ? 128 * pn + j0 : DFF + 128 * pn + (j0 - 128);
                transpose_item(args.in[I_W_FFN_IN], 2 * DFF, D, WFI, 64 * kb, ns, nd, args.in[I_NORM_FFN], scr, lane); continue; } r -= I_FI;
            if (r < I_FO) { const int nblk = D / 32, kb = r / nblk, nb = r % nblk; transpose_item(args.in[I_W_FFN_OUT], D, DFF, WFO, 64 * kb, 32 * nb, 32 * nb, nullptr, scr, lane); continue; } r -= I_FO;
            if (r < I_RO) { const int nblk = D / 32, kb = r / nblk, nb = r % nblk; transpose_item(args.in[I_W_RNN_OUT], D, D, WRO, 64 * kb, 32 * nb, 32 * nb, nullptr, scr, lane); continue; } r -= I_RO;
            if (r < I_WO) { const int nblk = D / 32, kb = r / nblk, nb = r % nblk; transpose_item(args.in[I_W_O], D, D, WO, 64 * kb, 32 * nb, 32 * nb, nullptr, scr, lane); continue; } r -= I_WO;
            { const int nblk = D / 32, kb = r / nblk, nb = r % nblk; transpose_item(args.in[I_W_POOL_OUT], D, DPOOL, WPO, 64 * kb, 32 * nb, 32 * nb, nullptr, scr, lane); }
        }
        {
            const int gt = bx * NTHR + tid, NT = G * NTHR;
            const float* wg = args.in[I_W_GRP];
            for (int e = gt; e < 512 * 32; e += NT) { const int n = e >> 5, kc = (e & 31) * 8, g = n >> 7, nn = n & 127; float v[8];
#pragma unroll
                for (int j = 0; j < 8; ++j) { const int kk = kc + j - (g & 1) * 128; v[j] = (kk >= 0 && kk < 128) ? wg[((size_t)g * 128 + kk) * 128 + nn] : 0.f; }
                v4u o; o.x = cvt_pk_bf16(v[0], v[1]); o.y = cvt_pk_bf16(v[2], v[3]); o.z = cvt_pk_bf16(v[4], v[5]); o.w = cvt_pk_bf16(v[6], v[7]);
                *(v4u*)(WGRP + (size_t)n * 256 + kc) = o; }
            const float* wa = args.in[I_W_RG_A]; const float* wx = args.in[I_W_RG_X];
            for (int e = gt; e < 2048 * 32; e += NT) { const int n = e >> 5, kc = (e & 31) * 8, h = n >> 8, j = n & 255; const float* src = j < 128 ? wa : wx; const int jj = j & 127; float v[8];
#pragma unroll
                for (int q = 0; q < 8; ++q) { const int kk = kc + q - (h & 1) * 128; v[q] = (kk >= 0 && kk < 128) ? src[((size_t)h * 128 + kk) * 128 + jj] : 0.f; }
                v4u o; o.x = cvt_pk_bf16(v[0], v[1]); o.y = cvt_pk_bf16(v[2], v[3]); o.z = cvt_pk_bf16(v[4], v[5]); o.w = cvt_pk_bf16(v[6], v[7]);
                *(v4u*)(WGATE + (size_t)n * 256 + kc) = o; }
        }
        { const int gt = bx * NTHR + tid; if (gt < DRNN) { const float z = -args.in[I_LAMBDA][gt]; ((float*)(ws + WS_SP8))[gt] = -8.0f * (fmaxf(z, 0.f) + log1pf(expf(-fabsf(z)))); } }
        const float* gmix = args.in[I_NORM_MIX];
        f32x4 gv[4];
#pragma unroll
        for (int j = 0; j < 4; ++j) gv[j] = ((const f32x4*)gmix)[lane + 64 * j];
        for (int m = gw; m < M; m += NGW) {
            const f32x4* xr = (const f32x4*)(x + (size_t)m * D) + lane; f32x4 v[4]; float s = 0.f;
#pragma unroll
            for (int j = 0; j < 4; ++j) { v[j] = xr[64 * j]; s += (v[j].x * v[j].x + v[j].y * v[j].y) + (v[j].z * v[j].z + v[j].w * v[j].w); }
            const float rs = 1.0f / sqrtf(wave_sum(s) * (1.f / D) + EPS);
            v2u* o8 = (v2u*)(XN + (size_t)m * D) + lane;
#pragma unroll
            for (int j = 0; j < 4; ++j) { const f32x4 y = v[j] * rs * gv[j]; v2u w; w.x = cvt_pk_bf16(y.x, y.y); w.y = cvt_pk_bf16(y.z, y.w); o8[64 * j] = w; }
        }
        __syncthreads();
    }
    SEAM(0);

    if (IN(1)) {
        pg8::Gemm g{XN, WIN, M, DIN, D, D, D, 0, 0}; pg8::StaticOrder S; S.init(M, DIN, G, bx);
        pg8::EpiProj E{UP, UR, UG, G0, G1};
        pg8::gemm_phase<pg8::EpiProj, true>(lds, g, S, E);
    }
    SEAM(1);

    if (IN(2)) {
        const int gt = bx * NTHR + tid, NT = G * NTHR;
        constexpr int CT = 32, NCH = SEQ / CT;
        constexpr int POOL_ITEMS = NB * NCH * 64, CONV_ITEMS = NB * NCH * 128;
        for (int it = gt; it < POOL_ITEMS + CONV_ITEMS; it += NT) {
            if (it < POOL_ITEMS) {
                const int cgp = it & 63, chunk = (it >> 6) % NCH, b = it / (64 * NCH);
                const int w = 2 << (cgp >> 4), t0 = chunk * CT;
                const bf16* src = UP + (size_t)b * SEQ * DPOOL + cgp * 8; bf16* dst = POOLED + (size_t)b * SEQ * DPOOL + cgp * 8;
                f32x4 s0 = {0.f, 0.f, 0.f, 0.f}, s1 = s0;
                for (int k = 1; k < w; ++k) { const int t = t0 - k; if (t >= 0) { f32x4 a, c; pg8::unpack8(*(const v4u*)(src + (size_t)t * DPOOL), a, c); s0 += a; s1 += c; } }
#pragma unroll 4
                for (int i = 0; i < CT; ++i) { const int t = t0 + i; f32x4 a, c; pg8::unpack8(*(const v4u*)(src + (size_t)t * DPOOL), a, c); s0 += a; s1 += c;
                    const int cnt = (t + 1 < w) ? t + 1 : w; const float inv = 1.0f / (float)cnt;
                    *(v4u*)(dst + (size_t)t * DPOOL) = pg8::pack8(s0 * inv - a, s1 * inv - c);
                    const int tl = t - w + 1; if (tl >= 0) { f32x4 a2, c2; pg8::unpack8(*(const v4u*)(src + (size_t)tl * DPOOL), a2, c2); s0 -= a2; s1 -= c2; } }
            } else {
                const int r = it - POOL_ITEMS, cgp = r & 127, chunk = (r >> 7) % NCH, b = r / (128 * NCH), t0 = chunk * CT;
                const bf16* src = UR + (size_t)b * SEQ * DRNN + cgp * 8; bf16* dst = V + (size_t)b * SEQ * DRNN + cgp * 8;
                const float* cw = args.in[I_CONV_W] + cgp * 8; const float* cb = args.in[I_CONV_B] + cgp * 8;
                f32x4 w0[2], w1[2], w2[2], w3[2], bb[2], um1[2], um2[2], um3[2];
#pragma unroll
                for (int n = 0; n < 2; ++n) { w0[n] = *(const f32x4*)(cw + 4 * n); w1[n] = *(const f32x4*)(cw + 1024 + 4 * n); w2[n] = *(const f32x4*)(cw + 2048 + 4 * n); w3[n] = *(const f32x4*)(cw + 3072 + 4 * n); bb[n] = *(const f32x4*)(cb + 4 * n);
                    um1[n] = um2[n] = um3[n] = (f32x4){0.f, 0.f, 0.f, 0.f}; }
                if (t0 >= 3) { pg8::unpack8(*(const v4u*)(src + (size_t)(t0 - 1) * DRNN), um1[0], um1[1]); pg8::unpack8(*(const v4u*)(src + (size_t)(t0 - 2) * DRNN), um2[0], um2[1]); pg8::unpack8(*(const v4u*)(src + (size_t)(t0 - 3) * DRNN), um3[0], um3[1]); }
#pragma unroll 4
                for (int i = 0; i < CT; ++i) { const int t = t0 + i; f32x4 cur[2]; pg8::unpack8(*(const v4u*)(src + (size_t)t * DRNN), cur[0], cur[1]);
                    f32x4 o[2];
#pragma unroll
                    for (int n = 0; n < 2; ++n) { o[n] = bb[n] + w0[n] * um3[n] + w1[n] * um2[n] + w2[n] * um1[n] + w3[n] * cur[n]; um3[n] = um2[n]; um2[n] = um1[n]; um1[n] = cur[n]; }
                    *(v4u*)(dst + (size_t)t * DRNN) = pg8::pack8(o[0], o[1]); }
            }
        }
    }
    SEAM(2);

    if (IN(3)) {
        { pg8::Gemm g{POOLED, WGRP, M, 512, 256, 512, 256, 0, 256}; pg8::StaticOrder S; S.init(M, 512, G, (bx + G / 2) % G);
          pg8::EpiGrp E{MIXED, args.in[I_POOL_SCALE]};
          pg8::gemm_phase<pg8::EpiGrp, true>(lds, g, S, E); }
        { pg8::Gemm g{V, WGATE, M, 2048, 256, 1024, 256, 1, 256}; pg8::StaticOrder S; S.init(M, 2048, G, bx);
          pg8::EpiGate E{V, LA, BB, args.in[I_B_RG_A], args.in[I_B_RG_X], (const float*)(ws + WS_SP8)};
          pg8::gemm_phase<pg8::EpiGate, true>(lds, g, S, E); }
    }
    SEAM(3);

    if (IN(4)) {
        const int gt = bx * NTHR + tid, NT = G * NTHR;
        for (int it = gt; it < NB * SCAN_NC * 512; it += NT) {
            const int cp = it & 511, c = (it >> 9) % SCAN_NC, b = it / (512 * SCAN_NC);
            const size_t off = ((size_t)b * SEQ + (size_t)c * SCAN_T) * DRNN + cp * 2;
            const unsigned* la = (const unsigned*)(LA + off); const unsigned* bb = (const unsigned*)(BB + off);
            float S0 = 0.f, S1 = 0.f, h0 = 0.f, h1 = 0.f;
#pragma unroll 8
            for (int i = 0; i < SCAN_T; ++i) { const unsigned lw = la[(size_t)i * (DRNN / 2)], bw = bb[(size_t)i * (DRNN / 2)];
                const float l0 = bf_lo(lw), l1 = bf_hi(lw); S0 += l0; S1 += l1;
                h0 = __expf(l0) * h0 + bf_lo(bw); h1 = __expf(l1) * h1 + bf_hi(bw); }
            const size_t co = ((size_t)b * SCAN_NC + c) * DRNN + cp * 2;
            *(f32x2*)(CS + co) = (f32x2){S0, S1}; *(f32x2*)(CH + co) = (f32x2){h0, h1};
        }
    }
    SEAM(4);

    if (IN(5)) {
        const int gt = bx * NTHR + tid, NT = G * NTHR;
        for (int it = gt; it < NB * SCAN_NC * 512; it += NT) {
            const int cp = it & 511, c = (it >> 9) % SCAN_NC, b = it / (512 * SCAN_NC);
            float h0 = 0.f, h1 = 0.f;
            for (int cc = 0; cc < c; ++cc) { const size_t co = ((size_t)b * SCAN_NC + cc) * DRNN + cp * 2; const f32x2 s = *(const f32x2*)(CS + co), e = *(const f32x2*)(CH + co);
                h0 = __expf(s.x) * h0 + e.x; h1 = __expf(s.y) * h1 + e.y; }
            const size_t off = ((size_t)b * SEQ + (size_t)c * SCAN_T) * DRNN + cp * 2;
            const unsigned* la = (const unsigned*)(LA + off); const unsigned* bb = (const unsigned*)(BB + off); const unsigned* ug = (const unsigned*)(UG + off); unsigned* hg = (unsigned*)(HG + off);
#pragma unroll 8
            for (int i = 0; i < SCAN_T; ++i) { const unsigned lw = la[(size_t)i * (DRNN / 2)], bw = bb[(size_t)i * (DRNN / 2)], gw = ug[(size_t)i * (DRNN / 2)];
                h0 = __expf(bf_lo(lw)) * h0 + bf_lo(bw); h1 = __expf(bf_hi(lw)) * h1 + bf_hi(bw);
                hg[(size_t)i * (DRNN / 2)] = cvt_pk_bf16(h0 * bf_lo(gw), h1 * bf_hi(gw)); }
        }
    }
    SEAM(5);

    if (IN(6)) {
        { pg8::Gemm g{MIXED, WPO, M, D, DPOOL, DPOOL, DPOOL, 0, 0}; pg8::StaticOrder S; S.init(M, D, G, bx);
          pg8::EpiMix0 E{G0, MIX0};
          pg8::gemm_phase<pg8::EpiMix0, true>(lds, g, S, E); }
        { pg8::Gemm g{HG, WRO, M, D, D, D, D, 0, 0}; pg8::StaticOrder S; S.init(M, D, G, bx);
          pg8::EpiMix1 E{G1, MIX0, MIXB};
          pg8::gemm_phase<pg8::EpiMix1, true>(lds, g, S, E); }
    }
    SEAM(6);

    if (IN(7)) {
        pg8::Gemm g{MIXB, WO, M, D, D, D, D, 0, 0}; pg8::StaticOrder S; S.init(M, D, G, bx);
        pg8::EpiRes1 E{x, X1, X1B, SSQ};
        pg8::gemm_phase<pg8::EpiRes1, true>(lds, g, S, E);
    }
    SEAM(7);

    if (IN(8)) {
        pg8::Gemm g{X1B, WFI, M, 2 * DFF, D, D, D, 0, 0}; pg8::StaticOrder S; S.init(M, 2 * DFF, G, bx);
        pg8::EpiSwiglu E{SSQ, ACT};
        pg8::gemm_phase<pg8::EpiSwiglu, true>(lds, g, S, E);
    }
    SEAM(8);

    if (IN(9)) {
        pg8::Gemm g{ACT, WFO, M, D, DFF, DFF, DFF, 0, 0}; pg8::StaticOrder S; S.init(M, D, G, bx);
        pg8::EpiRes2 E{X1};
        pg8::gemm_phase<pg8::EpiRes2, true>(lds, g, S, E);
    }
    SEAM(9);

    if (IN(10)) {
        const int gw = bx * NWAVES + wave, NGW = G * NWAVES;
        const float* gf = args.in[I_NORM_FINAL]; f32x4 gv[4];
#pragma unroll
        for (int j = 0; j < 4; ++j) gv[j] = ((const f32x4*)gf)[lane + 64 * j];
        for (int m = gw; m < M; m += NGW) {
            f32x4* xr = (f32x4*)(X1 + (size_t)m * D) + lane; f32x4 v[4]; float s = 0.f;
#pragma unroll
            for (int j = 0; j < 4; ++j) { v[j] = xr[64 * j]; s += (v[j].x * v[j].x + v[j].y * v[j].y) + (v[j].z * v[j].z + v[j].w * v[j].w); }
            const float rs = 1.0f / sqrtf(wave_sum(s) * (1.f / D) + EPS);
#pragma unroll
            for (int j = 0; j < 4; ++j) xr[64 * j] = v[j] * rs * gv[j];
        }
    }
#undef IN
#undef SEAM
}

extern "C" void kernel_launch(void* const* d_in, const int* in_sizes, int n_in, void* d_out, int out_size, void* d_ws, size_t ws_size, hipStream_t stream) {
    static int grid = 0;
    if (grid == 0) {
        if (n_in != 19 || out_size != M * D || ws_size < WS_END) { fprintf(stderr, "kernel_launch: unexpected shapes (n_in %d out %d ws %zu)\n", n_in, out_size, ws_size); grid = -1; return; }
        int dev = 0, cus = 0, per_cu = 0;
        hipGetDevice(&dev);
        hipDeviceGetAttribute(&cus, hipDeviceAttributeMultiprocessorCount, dev);
        if (hipFuncSetAttribute((const void*)fwd_kernel, hipFuncAttributeMaxDynamicSharedMemorySize, LDS_BYTES) != hipSuccess) { fprintf(stderr, "kernel_launch: hipFuncSetAttribute failed\n"); grid = -1; return; }
        if (hipOccupancyMaxActiveBlocksPerMultiprocessor(&per_cu, (const void*)fwd_kernel, NTHR, LDS_BYTES) != hipSuccess || per_cu < 1) { fprintf(stderr, "kernel_launch: occupancy query says %d\n", per_cu); per_cu = 1; }
        (void)hipGetLastError();
        grid = cus * 1;
        fprintf(stderr, "kernel_launch: grid %d (cus %d, per_cu %d)\n", grid, cus, per_cu);
    }
    if (grid < 0) return;
    Args a{};
    for (int i = 0; i < 19; ++i) a.in[i] = (const float*)d_in[i];
    a.out = (float*)d_out; a.ws = (unsigned char*)d_ws;
#if MK_PER_PHASE
    for (int p = 0; p < NPH; ++p) { a.ph_lo = p; a.ph_hi = p + 1; hipLaunchKernelGGL(fwd_kernel, dim3(grid), dim3(NTHR), LDS_BYTES, stream, a); }
#else
    a.ph_lo = 0; a.ph_hi = NPH;
    void* kargs[] = {&a};
    hipError_t e = hipLaunchCooperativeKernel((const void*)fwd_kernel, dim3(grid), dim3(NTHR), kargs, LDS_BYTES, stream);
    if (e != hipSuccess) fprintf(stderr, "cooperative launch failed: %s (grid %d)\n", hipGetErrorString(e), grid);
#endif
}
```

```cpp
#include <hip/hip_runtime.h>
#include <hip/hip_cooperative_groups.h>
#include <cstdio>
#include <cstdint>
namespace cg = cooperative_groups;

#ifndef MK_PER_PHASE
#define MK_PER_PHASE 0
#endif

namespace pg8 {
#define PG8_LAS __attribute__((address_space(3)))
typedef unsigned short bf16_t;
typedef short bf16x8 __attribute__((ext_vector_type(8)));
typedef float f32x4 __attribute__((ext_vector_type(4)));
typedef float f32x2 __attribute__((ext_vector_type(2)));
typedef unsigned u32x4 __attribute__((ext_vector_type(4)));
typedef unsigned u32x2 __attribute__((ext_vector_type(2)));
constexpr int BM = 256, BK = 64, HALF = 128, HTB = HALF * BK * 2, STAGE_BYTES = 8 * HTB, NXCD = 8, WGM = 8;

__host__ __device__ __forceinline__ int lds_byte(int r, int c) { const int st = (r >> 4) * 2 + (c >> 5), rr = r & 15, cc = c & 31, ob = rr * 64 + cc * 2; return st * 1024 + (ob ^ (((ob >> 9) & 1) << 5)); }
__host__ __device__ __forceinline__ void stage_rc(int b, int& R, int& C) { const int st = b / 1024, sb = b % 1024, swz = sb ^ (((sb >> 9) & 1) << 5); R = (st >> 1) * 16 + swz / 64; C = (st & 1) * 32 + (swz % 64) / 2; }
__host__ __device__ __forceinline__ int perm32(int rho) { const int n = rho >> 4, i = rho & 15; return 8 * (i >> 2) + 4 * n + (i & 3); }

struct Unit { int pm, pn; };
struct Gemm { const bf16_t* A; const bf16_t* Bt; int M, N, K, lda, ldb, ash, amul; };

struct StaticOrder {
    int nM, nN, nwg, G, c;
    __host__ __device__ void init(int M, int N, int G_, int c_) { nM = M / BM; nN = N / BM; nwg = nM * nN; G = G_; c = c_; }
    __host__ __device__ bool next(int i, Unit& u) const {
        const long L = (long)i * G + c; if (L >= nwg) return false;
        int wgid = (int)L; { const int q = nwg / NXCD, r = nwg % NXCD, xcd = wgid % NXCD, off = wgid / NXCD; wgid = (xcd < r ? xcd * (q + 1) : r * (q + 1) + (xcd - r) * q) + off; }
        const int nig = WGM * nN, gid = wgid / nig, fm = gid * WGM, gsz = (nM - fm) < WGM ? (nM - fm) : WGM;
        u.pm = fm + ((wgid % nig) % gsz); u.pn = (wgid % nig) / gsz; return true;
    }
};

__device__ __forceinline__ unsigned cvt_pk_bf16(float lo, float hi) { unsigned r; asm volatile("v_cvt_pk_bf16_f32 %0, %1, %2" : "=v"(r) : "v"(lo), "v"(hi)); return r; }
__device__ __forceinline__ float bf_lo(unsigned w) { return __uint_as_float(w << 16); }
__device__ __forceinline__ float bf_hi(unsigned w) { return __uint_as_float(w & 0xffff0000u); }
__device__ __forceinline__ float sigmoidf_(float x) { return __builtin_amdgcn_rcpf(1.0f + __expf(-x)); }
__device__ __forceinline__ float gelu_tanh_(float x) { const float z = 1.5957691216057308f * (x + 0.044715f * x * x * x); return x * sigmoidf_(z); }
__device__ __forceinline__ u32x4 pack8(const f32x4 a, const f32x4 b) { u32x4 w; w.x = cvt_pk_bf16(a[0], a[1]); w.y = cvt_pk_bf16(a[2], a[3]); w.z = cvt_pk_bf16(b[0], b[1]); w.w = cvt_pk_bf16(b[2], b[3]); return w; }
__device__ __forceinline__ void unpack8(const u32x4 w, f32x4& a, f32x4& b) { a = (f32x4){bf_lo(w.x), bf_hi(w.x), bf_lo(w.y), bf_hi(w.y)}; b = (f32x4){bf_lo(w.z), bf_hi(w.z), bf_lo(w.w), bf_hi(w.w)}; }

#define EPI_ROWS_BEGIN _Pragma("unroll") for (int ai = 0; ai < 2; ++ai) _Pragma("unroll") for (int m = 0; m < 4; ++m) { const int row = u.pm * BM + ai * HALF + wr * 64 + m * 16 + fr;
#define EPI_ROWS_END __builtin_amdgcn_sched_barrier(0); }

struct EpiProj {
    bf16_t *UP, *UR, *UG, *G0, *G1;
    __device__ __forceinline__ void operator()(const f32x4 (&acc)[2][2][4][2], const Unit& u, int wr, int wc, int fr, int fq) const {
        const int pn = u.pn; bf16_t* base; int ldc, colt, act;
        if (pn < 2) { base = UP; ldc = 512; colt = pn * 256; act = 0; }
        else if (pn < 6) { base = UR; ldc = 1024; colt = (pn - 2) * 256; act = 0; }
        else if (pn < 10) { base = UG; ldc = 1024; colt = (pn - 6) * 256; act = 1; }
        else if (pn < 14) { base = G0; ldc = 1024; colt = (pn - 10) * 256; act = 2; }
        else { base = G1; ldc = 1024; colt = (pn - 14) * 256; act = 2; }
        const int col0 = colt + wc * 32 + 8 * fq;
        EPI_ROWS_BEGIN
            bf16_t* rowp = base + (size_t)row * ldc + col0;
#pragma unroll
            for (int bj = 0; bj < 2; ++bj) { f32x4 v0 = acc[ai][bj][m][0], v1 = acc[ai][bj][m][1];
                if (act == 1) {
#pragma unroll
                    for (int j = 0; j < 4; ++j) { v0[j] = gelu_tanh_(v0[j]); v1[j] = gelu_tanh_(v1[j]); } }
                else if (act == 2) {
#pragma unroll
                    for (int j = 0; j < 4; ++j) { v0[j] = sigmoidf_(v0[j]); v1[j] = sigmoidf_(v1[j]); } }
                *(u32x4*)(rowp + bj * HALF) = pack8(v0, v1); }
        EPI_ROWS_END
    }
};
struct EpiGrp {
    bf16_t* O; const float* scale;
    __device__ __forceinline__ void operator()(const f32x4 (&acc)[2][2][4][2], const Unit& u, int wr, int wc, int fr, int fq) const {
        const int col0 = u.pn * BM + wc * 32 + 8 * fq;
        f32x4 sc[2][2];
#pragma unroll
        for (int bj = 0; bj < 2; ++bj)
#pragma unroll
            for (int n = 0; n < 2; ++n) sc[bj][n] = *(const f32x4*)(scale + col0 + bj * HALF + 4 * n);
        EPI_ROWS_BEGIN
            bf16_t* rowp = O + (size_t)row * 512 + col0;
#pragma unroll
            for (int bj = 0; bj < 2; ++bj) *(u32x4*)(rowp + bj * HALF) = pack8(acc[ai][bj][m][0] * sc[bj][0], acc[ai][bj][m][1] * sc[bj][1]);
        EPI_ROWS_END
    }
};
struct EpiGate {
    const bf16_t* V; bf16_t *LA, *BB; const float *b_a, *b_x, *sp8;
    __device__ __forceinline__ void operator()(const f32x4 (&acc)[2][2][4][2], const Unit& u, int wr, int wc, int fr, int fq) const {
        const int ch0 = u.pn * 128 + wc * 32 + 8 * fq;
        f32x4 ba[2], bx[2], sp[2];
#pragma unroll
        for (int n = 0; n < 2; ++n) { ba[n] = *(const f32x4*)(b_a + ch0 + 4 * n); bx[n] = *(const f32x4*)(b_x + ch0 + 4 * n); sp[n] = *(const f32x4*)(sp8 + ch0 + 4 * n); }
        EPI_ROWS_BEGIN
            const size_t off = (size_t)row * 1024 + ch0;
            const u32x4 vw = *(const u32x4*)(V + off); f32x4 vv[2]; unpack8(vw, vv[0], vv[1]);
            f32x4 la[2], bb[2];
#pragma unroll
            for (int n = 0; n < 2; ++n)
#pragma unroll
                for (int j = 0; j < 4; ++j) {
                    const float r = sigmoidf_(acc[ai][0][m][n][j] + ba[n][j]), ig = sigmoidf_(acc[ai][1][m][n][j] + bx[n][j]);
                    const float l = sp[n][j] * r, x2 = 2.0f * l;
                    const float em1 = (x2 > -0.125f) ? x2 * (1.0f + 0.5f * x2 * (1.0f + 0.33333334f * x2 * (1.0f + 0.25f * x2 * (1.0f + 0.2f * x2)))) : (__expf(x2) - 1.0f);
                    la[n][j] = l; bb[n][j] = sqrtf(fmaxf(-em1, 0.f)) * ig * vv[n][j]; }
            *(u32x4*)(LA + off) = pack8(la[0], la[1]); *(u32x4*)(BB + off) = pack8(bb[0], bb[1]);
            asm volatile("" ::: "memory");
        EPI_ROWS_END
    }
};
struct EpiMix0 {
    const bf16_t* G0; float* MIX0;
    __device__ __forceinline__ void operator()(const f32x4 (&acc)[2][2][4][2], const Unit& u, int wr, int wc, int fr, int fq) const {
        const int col0 = u.pn * BM + wc * 32 + 8 * fq;
        EPI_ROWS_BEGIN
            const size_t off = (size_t)row * 1024 + col0;
#pragma unroll
            for (int bj = 0; bj < 2; ++bj) { f32x4 g[2]; unpack8(*(const u32x4*)(G0 + off + bj * HALF), g[0], g[1]);
                *(f32x4*)(MIX0 + off + bj * HALF) = g[0] * acc[ai][bj][m][0]; *(f32x4*)(MIX0 + off + bj * HALF + 4) = g[1] * acc[ai][bj][m][1]; }
        EPI_ROWS_END
    }
};
struct EpiMix1 {
    const bf16_t* G1; const float* MIX0; bf16_t* MIXB;
    __device__ __forceinline__ void operator()(const f32x4 (&acc)[2][2][4][2], const Unit& u, int wr, int wc, int fr, int fq) const {
        const int col0 = u.pn * BM + wc * 32 + 8 * fq;
        EPI_ROWS_BEGIN
            const size_t off = (size_t)row * 1024 + col0;
#pragma unroll
            for (int bj = 0; bj < 2; ++bj) { f32x4 g[2]; unpack8(*(const u32x4*)(G1 + off + bj * HALF), g[0], g[1]);
                const f32x4 m0 = *(const f32x4*)(MIX0 + off + bj * HALF), m1 = *(const f32x4*)(MIX0 + off + bj * HALF + 4);
                *(u32x4*)(MIXB + off + bj * HALF) = pack8(m0 + g[0] * acc[ai][bj][m][0], m1 + g[1] * acc[ai][bj][m][1]); }
        EPI_ROWS_END
    }
};
struct EpiRes1 {
    const float* X; float* X1; bf16_t* X1B; float* SSQ;
    __device__ __forceinline__ void operator()(const f32x4 (&acc)[2][2][4][2], const Unit& u, int wr, int wc, int fr, int fq) const {
        const int col0 = u.pn * BM + wc * 32 + 8 * fq;
        EPI_ROWS_BEGIN
            const size_t off = (size_t)row * 1024 + col0; float ss = 0.f;
#pragma unroll
            for (int bj = 0; bj < 2; ++bj) {
                const f32x4 a = *(const f32x4*)(X + off + bj * HALF) + acc[ai][bj][m][0], b = *(const f32x4*)(X + off + bj * HALF + 4) + acc[ai][bj][m][1];
                *(f32x4*)(X1 + off + bj * HALF) = a; *(f32x4*)(X1 + off + bj * HALF + 4) = b; *(u32x4*)(X1B + off + bj * HALF) = pack8(a, b);
                ss += (a[0] * a[0] + a[1] * a[1]) + (a[2] * a[2] + a[3] * a[3]) + (b[0] * b[0] + b[1] * b[1]) + (b[2] * b[2] + b[3] * b[3]); }
            ss += __shfl_xor(ss, 16); ss += __shfl_xor(ss, 32);
            if (fq == 0) SSQ[(size_t)row * 16 + u.pn * 4 + wc] = ss;
        EPI_ROWS_END
    }
};
struct EpiSwiglu {
    const float* SSQ; bf16_t* ACT;
    __device__ __forceinline__ void operator()(const f32x4 (&acc)[2][2][4][2], const Unit& u, int wr, int wc, int fr, int fq) const {
        const int col0 = u.pn * 128 + wc * 32 + 8 * fq;
        EPI_ROWS_BEGIN
            const f32x4* sp = (const f32x4*)(SSQ + (size_t)row * 16); const f32x4 s0 = sp[0], s1 = sp[1], s2 = sp[2], s3 = sp[3];
            const f32x4 st = (s0 + s1) + (s2 + s3); const float rs = __builtin_amdgcn_rsqf((st[0] + st[1] + st[2] + st[3]) * (1.0f / 1024.0f) + 1e-6f);
            f32x4 o[2];
#pragma unroll
            for (int n = 0; n < 2; ++n)
#pragma unroll
                for (int j = 0; j < 4; ++j) { const float g = acc[ai][0][m][n][j] * rs, up = acc[ai][1][m][n][j] * rs; o[n][j] = g * sigmoidf_(g) * up; }
            *(u32x4*)(ACT + (size_t)row * 2816 + col0) = pack8(o[0], o[1]);
        EPI_ROWS_END
    }
};
struct EpiRes2 {
    float* X1;
    __device__ __forceinline__ void operator()(const f32x4 (&acc)[2][2][4][2], const Unit& u, int wr, int wc, int fr, int fq) const {
        const int col0 = u.pn * BM + wc * 32 + 8 * fq;
        EPI_ROWS_BEGIN
            const size_t off = (size_t)row * 1024 + col0;
#pragma unroll
            for (int bj = 0; bj < 2; ++bj) {
                const f32x4 a = *(const f32x4*)(X1 + off + bj * HALF) + acc[ai][bj][m][0], b = *(const f32x4*)(X1 + off + bj * HALF + 4) + acc[ai][bj][m][1];
                *(f32x4*)(X1 + off + bj * HALF) = a; *(f32x4*)(X1 + off + bj * HALF + 4) = b; }
        EPI_ROWS_END
    }
};

template <class Epi, bool ALIGN_EPI>
__device__ __forceinline__ void gemm_phase(PG8_LAS unsigned char* lds, const Gemm g, const StaticOrder& S, const Epi& E) {
    const int tid = threadIdx.x, wid = __builtin_amdgcn_readfirstlane(tid >> 6), lane = tid & 63, wr = wid >> 2, wc = wid & 3, fr = lane & 15, fq = lane >> 4;
    int nt = g.K / BK; asm volatile("" : "+s"(nt));
    unsigned voffA[2], voffB[2];
#pragma unroll
    for (int i = 0; i < 2; ++i) { int R, C; stage_rc(tid * 16 + i * 8192, R, C); const int Rb = (R & ~31) + perm32(R & 31);
        voffA[i] = (unsigned)(R * g.lda + C) * 2u; voffB[i] = (unsigned)(Rb * g.ldb + C) * 2u; }
    const size_t kstep = (size_t)(BK * 2);
    const size_t hstepA = (size_t)HALF * g.lda * 2, hstepB = (size_t)HALF * g.ldb * 2;
    const size_t tstepA = 2 * hstepA, tstepB = 2 * hstepB;
    const unsigned ldsw = (unsigned)wid * 1024u;
    const int aoff = lds_byte(wr * 64 + fr, fq * 8), boff = lds_byte(wc * 32 + fr, fq * 8);
#define PG8_SA(b, h) (((b) * 2 + (h)) * HTB)
#define PG8_SB(b, h) ((4 + (b) * 2 + (h)) * HTB)
#define PG8_STAGE(bufoff, gbase, voff) do { _Pragma("unroll") for (int _i = 0; _i < 2; ++_i) \
        __builtin_amdgcn_global_load_lds((const unsigned*)((const char*)(gbase) + (voff)[_i]), (PG8_LAS unsigned*)(lds + (bufoff) + ldsw + _i * 8192), 16, 0, 0); } while (0)
#define PG8_LDA(dst, b, h) do { _Pragma("unroll") for (int m = 0; m < 4; ++m) _Pragma("unroll") for (int k = 0; k < 2; ++k) dst[m][k] = *(const PG8_LAS bf16x8*)(lds + PG8_SA(b, h) + aoff + m * 2048 + k * 1024); } while (0)
#define PG8_LDB(dst, b, h) do { _Pragma("unroll") for (int n = 0; n < 2; ++n) _Pragma("unroll") for (int k = 0; k < 2; ++k) dst[n][k] = *(const PG8_LAS bf16x8*)(lds + PG8_SB(b, h) + boff + n * 2048 + k * 1024); } while (0)
#define PG8_MMA(ai, bj, At, Bt) do { __builtin_amdgcn_s_setprio(1); _Pragma("unroll") for (int m = 0; m < 4; ++m) _Pragma("unroll") for (int n = 0; n < 2; ++n) _Pragma("unroll") for (int k = 0; k < 2; ++k) \
        acc[ai][bj][m][n] = __builtin_amdgcn_mfma_f32_16x16x32_bf16(Bt[n][k], At[m][k], acc[ai][bj][m][n], 0, 0, 0); __builtin_amdgcn_s_setprio(0); } while (0)
#define PG8_WAIT_V(n) asm volatile("s_waitcnt vmcnt(" #n ")" ::: "memory")
#define PG8_WAIT_L(n) asm volatile("s_waitcnt lgkmcnt(" #n ")" ::: "memory")
#define PG8_BAR __builtin_amdgcn_s_barrier()
#define PG8_SCHED __builtin_amdgcn_sched_barrier(0)
    Unit cur, nxt; int ui = 0;
    if (!S.next(0, cur)) return;
    f32x4 acc[2][2][4][2];
#pragma unroll
    for (int a = 0; a < 2; ++a)
#pragma unroll
        for (int b = 0; b < 2; ++b)
#pragma unroll
            for (int m = 0; m < 4; ++m)
#pragma unroll
                for (int n = 0; n < 2; ++n) acc[a][b][m][n] = (f32x4){0.f, 0.f, 0.f, 0.f};
    bf16x8 At[4][2], B0[2][2], B1[2][2];
    const char* cA = (const char*)g.A + (size_t)cur.pm * tstepA + (size_t)((cur.pn >> g.ash) * g.amul) * 2; const char* cB = (const char*)g.Bt + (size_t)cur.pn * tstepB;
    PG8_STAGE(PG8_SB(0, 0), cB, voffB); PG8_STAGE(PG8_SB(0, 1), cB + hstepB, voffB); PG8_STAGE(PG8_SA(0, 0), cA, voffA); PG8_STAGE(PG8_SA(0, 1), cA + hstepA, voffA);
    if (wr == 1) PG8_BAR;
    PG8_WAIT_V(2); PG8_BAR;
    PG8_STAGE(PG8_SB(1, 0), cB + kstep, voffB); PG8_STAGE(PG8_SA(1, 0), cA + kstep, voffA); PG8_STAGE(PG8_SB(1, 1), cB + hstepB + kstep, voffB);
    PG8_WAIT_V(6); PG8_BAR;
    for (;;) {
        const bool has_next = S.next(ui + 1, nxt);
        const char* nA = has_next ? (const char*)g.A + (size_t)nxt.pm * tstepA + (size_t)((nxt.pn >> g.ash) * g.amul) * 2 : cA; const char* nB = has_next ? (const char*)g.Bt + (size_t)nxt.pn * tstepB : cB;
        for (int t = 0; t < nt; t += 2) {
            const bool last = (t == nt - 2);
            const char* a1 = cA + (size_t)(t + 1) * kstep;
            const char* a2 = last ? nA : cA + (size_t)(t + 2) * kstep; const char* b2 = last ? nB : cB + (size_t)(t + 2) * kstep;
            const char* a3 = a2 + kstep; const char* b3 = b2 + kstep;
            PG8_LDB(B0, 0, 0); PG8_LDB(B1, 0, 1); PG8_SCHED; PG8_LDA(At, 0, 0); PG8_STAGE(PG8_SA(1, 1), a1 + hstepA, voffA);
            PG8_WAIT_V(8); PG8_WAIT_L(0); PG8_BAR; PG8_MMA(0, 0, At, B0); PG8_MMA(0, 1, At, B1); PG8_BAR; PG8_SCHED;
            PG8_LDA(At, 0, 1); PG8_STAGE(PG8_SB(0, 0), b2, voffB); PG8_STAGE(PG8_SB(0, 1), b2 + hstepB, voffB); PG8_STAGE(PG8_SA(0, 0), a2, voffA);
            PG8_WAIT_V(8); PG8_WAIT_L(0); PG8_BAR; PG8_MMA(1, 0, At, B0); PG8_MMA(1, 1, At, B1); PG8_BAR; PG8_SCHED;
            PG8_LDB(B0, 1, 0); PG8_LDB(B1, 1, 1); PG8_SCHED; PG8_LDA(At, 1, 0); PG8_STAGE(PG8_SA(0, 1), a2 + hstepA, voffA);
            PG8_WAIT_V(8); PG8_WAIT_L(0); PG8_BAR; PG8_MMA(0, 0, At, B0); PG8_MMA(0, 1, At, B1); PG8_BAR; PG8_SCHED;
            PG8_LDA(At, 1, 1); PG8_STAGE(PG8_SB(1, 0), b3, voffB); PG8_STAGE(PG8_SB(1, 1), b3 + hstepB, voffB); PG8_STAGE(PG8_SA(1, 0), a3, voffA);
            PG8_WAIT_V(8); PG8_WAIT_L(0); PG8_BAR; PG8_MMA(1, 0, At, B0); PG8_MMA(1, 1, At, B1); PG8_BAR; PG8_SCHED;
        }
        if constexpr (ALIGN_EPI) { if (wr == 0) PG8_BAR; }
        E(acc, cur, wr, wc, fr, fq);
        if (!has_next) break;
#pragma unroll
        for (int a = 0; a < 2; ++a)
#pragma unroll
            for (int b = 0; b < 2; ++b)
#pragma unroll
                for (int m = 0; m < 4; ++m)
#pragma unroll
                    for (int n = 0; n < 2; ++n) acc[a][b][m][n] = (f32x4){0.f, 0.f, 0.f, 0.f};
        cur = nxt; cA = nA; cB = nB; ++ui;
        if constexpr (ALIGN_EPI) { if (wr == 1) PG8_BAR; }
    }
    PG8_WAIT_V(0);
    if constexpr (!ALIGN_EPI) { if (wr == 0) PG8_BAR; }
    PG8_BAR;
#undef PG8_SA
#undef PG8_SB
#undef PG8_STAGE
#undef PG8_LDA
#undef PG8_LDB
#undef PG8_MMA
#undef PG8_WAIT_V
#undef PG8_WAIT_L
#undef PG8_BAR
#undef PG8_SCHED
}
}

constexpr int NWAVES = 8, NTHR = 512;
constexpr int M = 16384, SEQ = 4096, NB = 4, D = 1024, DPOOL = 512, DRNN = 1024, DIN = 4608, DFF = 2816;
constexpr float EPS = 1e-6f;
constexpr int NPH = 11;
constexpr int SCAN_T = 128, SCAN_NC = SEQ / SCAN_T;

constexpr size_t MiB = 1u << 20;
constexpr size_t WS_SP8 = 512 * 1024;
constexpr size_t WS_SSQ = 1 * MiB;
constexpr size_t WS_CS = 2 * MiB, WS_CH = 3 * MiB;
constexpr size_t WS_WIN = 4 * MiB;
constexpr size_t WS_WFI = 13 * MiB;
constexpr size_t WS_WFO = 24 * MiB;
constexpr size_t WS_WRO = WS_WFO + 5632 * 1024;
constexpr size_t WS_WO = WS_WRO + 2 * MiB;
constexpr size_t WS_WPO = WS_WO + 2 * MiB;
constexpr size_t WS_WGRP = WS_WPO + 1 * MiB;
constexpr size_t WS_WGATE = WS_WGRP + MiB / 4;
constexpr size_t WS_R1 = 36 * MiB;
constexpr size_t WS_R2 = 68 * MiB;
constexpr size_t WS_R3 = 84 * MiB;
constexpr size_t WS_R4 = 116 * MiB;
constexpr size_t WS_R7 = 148 * MiB;
constexpr size_t WS_R8 = 164 * MiB;
constexpr size_t WS_MIX0 = 84 * MiB;
constexpr size_t WS_MIXB = 148 * MiB;
constexpr size_t WS_ACT = 68 * MiB;
constexpr size_t WS_END = 196 * MiB;

constexpr int LDS_BYTES = 147456;

#define LAS __attribute__((address_space(3)))
typedef unsigned short bf16;
typedef unsigned v4u __attribute__((ext_vector_type(4)));
typedef unsigned v2u __attribute__((ext_vector_type(2)));
typedef float f32x4 __attribute__((ext_vector_type(4)));
typedef float f32x2 __attribute__((ext_vector_type(2)));
#define LDS_WAIT() asm volatile("s_waitcnt lgkmcnt(0)" ::: "memory")
using pg8::cvt_pk_bf16; using pg8::bf_lo; using pg8::bf_hi;

struct Args { const float* in[19]; float* out; unsigned char* ws; int ph_lo, ph_hi; };
enum { I_X = 0, I_NORM_MIX, I_W_IN, I_W_GRP, I_POOL_SCALE, I_W_POOL_OUT, I_CONV_W, I_CONV_B, I_W_RG_A, I_B_RG_A, I_W_RG_X, I_B_RG_X, I_LAMBDA, I_W_RNN_OUT, I_W_O, I_NORM_FFN, I_W_FFN_IN, I_W_FFN_OUT, I_NORM_FINAL };

__device__ __forceinline__ float wave_sum(float v) {
#pragma unroll
    for (int o = 1; o < 64; o <<= 1) v += __shfl_xor(v, o);
    return v;
}

__device__ __forceinline__ void transpose_item(const float* W, int Nsrc, int Kdst, bf16* WT, int k0, int n_src0, int n_dst0, const float* kscale, LAS float* scr, int lane) {
#pragma unroll 8
    for (int i = 0; i < 32; ++i) { const int kk = 2 * i + (lane >> 5); float w = W[(size_t)(k0 + kk) * Nsrc + n_src0 + (lane & 31)]; if (kscale) w *= kscale[k0 + kk]; scr[kk * 33 + (lane & 31)] = w; }
    LDS_WAIT(); asm volatile("" ::: "memory");
    const int c = lane & 7;
#pragma unroll
    for (int j = 0; j < 4; ++j) { const int n = (lane >> 3) + 8 * j; const LAS float* s = scr + (8 * c) * 33 + n;
        v4u o; o.x = cvt_pk_bf16(s[0 * 33], s[1 * 33]); o.y = cvt_pk_bf16(s[2 * 33], s[3 * 33]); o.z = cvt_pk_bf16(s[4 * 33], s[5 * 33]); o.w = cvt_pk_bf16(s[6 * 33], s[7 * 33]);
        *(v4u*)(WT + (size_t)(n_dst0 + n) * Kdst + k0 + 8 * c) = o; }
    LDS_WAIT(); asm volatile("" ::: "memory");
}

#define XB_TMO      128
#define XB_XCNT(j)  (256  + 64 * (j))
#define XB_XSUB(j)  (1280 + 64 * (j))
#define XB_XGEN(j)  (2304 + 64 * (j))
#define XB_TOP      3328
#define XB_TOPGEN   3392
#define XCD_BAR_WORDS 3456
#define XB_SPIN_CAP (1u << 18)
__device__ __forceinline__ unsigned xb_ld(unsigned* p)              { return __hip_atomic_load(p, __ATOMIC_RELAXED, __HIP_MEMORY_SCOPE_AGENT); }
__device__ __forceinline__ unsigned xb_add(unsigned* p, unsigned v) { return __hip_atomic_fetch_add(p, v, __ATOMIC_RELAXED, __HIP_MEMORY_SCOPE_AGENT); }
__device__ __forceinline__ unsigned xb_xcc_id() { return (unsigned)__builtin_amdgcn_s_getreg((3 << 11) | 20) & 0xFu; }
#define XB_SPIN(cond, bar) do { unsigned _sp = 0; while (cond) { __builtin_amdgcn_s_sleep(1); \
    if ((++_sp & 255u) == 0u) { if (xb_ld(&(bar)[XB_TMO])) break; if (_sp > XB_SPIN_CAP) { atomicAdd(&(bar)[XB_TMO], 1u); break; } } } } while (0)
struct XcdBarrier { unsigned* bar; unsigned x; volatile LAS unsigned* st; };
__device__ __forceinline__ XcdBarrier xcd_barrier_post(unsigned* bar, volatile LAS unsigned* st) {
    XcdBarrier b; b.bar = bar; b.x = xb_xcc_id(); b.st = st;
    if (threadIdx.x == 0) (void)xb_add(&bar[XB_XCNT(b.x)], 1u);
    return b;
}
__device__ __forceinline__ void xcd_barrier_complete(unsigned* bar, unsigned x, unsigned& nloc, unsigned& nx) {
    const unsigned G = gridDim.x * gridDim.y * gridDim.z;
    unsigned sum, cnt, mine, sp = 0u;
    for (;;) {
        sum = 0u; cnt = 0u; mine = 0u;
#pragma unroll
        for (unsigned j = 0; j < 16; ++j) { const unsigned c = xb_ld(&bar[XB_XCNT(j)]); sum += c; cnt += (c > 0u) ? 1u : 0u; mine = (j == x) ? c : mine; }
        if (sum == G) break;
        __builtin_amdgcn_s_sleep(1);
        if ((++sp & 255u) == 0u) { if (xb_ld(&bar[XB_TMO])) break; if (sp > XB_SPIN_CAP) { atomicAdd(&bar[XB_TMO], 1u); break; } }
    }
    nloc = mine > 0u ? mine : 1u; nx = cnt > 0u ? cnt : 1u;
}
__device__ __forceinline__ void xcd_barrier(const XcdBarrier& b) {
    asm volatile("s_waitcnt vmcnt(0)" ::: "memory");
    __syncthreads();
    if (threadIdx.x == 0) {
        unsigned* bar = b.bar;
        __builtin_amdgcn_s_waitcnt(0);
        unsigned nloc = b.st[0], nx = b.st[1];
        if (nloc == 0u) { xcd_barrier_complete(bar, b.x, nloc, nx); b.st[0] = nloc; b.st[1] = nx; }
        const unsigned old = xb_add(&bar[XB_XSUB(b.x)], 1u);
        const unsigned gen = old / nloc;
        if (old + 1u == (gen + 1u) * nloc) {
            __builtin_amdgcn_fence(__ATOMIC_RELEASE, "agent");
            asm volatile("s_waitcnt vmcnt(0)" ::: "memory");
            const unsigned og = xb_add(&bar[XB_TOP], 1u);
            const unsigned tg = og / nx;
            if (og + 1u == (tg + 1u) * nx) xb_add(&bar[XB_TOPGEN], 1u);
            else XB_SPIN(xb_ld(&bar[XB_TOPGEN]) == tg, bar);
            __builtin_amdgcn_fence(__ATOMIC_ACQUIRE, "agent");
            xb_add(&bar[XB_XGEN(b.x)], 1u);
            asm volatile("s_waitcnt vmcnt(0)" ::: "memory");
        } else {
            XB_SPIN(xb_ld(&bar[XB_XGEN(b.x)]) == gen, bar);
            __builtin_amdgcn_fence(__ATOMIC_ACQUIRE, "agent");
            asm volatile("s_waitcnt vmcnt(0)" ::: "memory");
        }
    }
    __syncthreads();
}

template <int W>
__device__ __forceinline__ void pool_item(const bf16* src, bf16* dst, int tl) {
    v4u rw[W + 7];
#pragma unroll
    for (int k = 0; k < W + 7; ++k) rw[k] = (tl + k - (W - 1) >= 0) ? *(const v4u*)(src + (ptrdiff_t)(k - (W - 1)) * DPOOL) : (v4u){0u, 0u, 0u, 0u};
    f32x4 s0 = {0.f, 0.f, 0.f, 0.f}, s1 = s0;
#pragma unroll
    for (int k = 0; k < W - 1; ++k) { f32x4 a, c; pg8::unpack8(rw[k], a, c); s0 += a; s1 += c; }
#pragma unroll
    for (int i = 0; i < 8; ++i) { f32x4 a, c; pg8::unpack8(rw[W - 1 + i], a, c); s0 += a; s1 += c;
        const int t = tl + i; const int cnt = (t + 1 < W) ? t + 1 : W; const float inv = 1.0f / (float)cnt;
        *(v4u*)(dst + (size_t)i * DPOOL) = pg8::pack8(s0 * inv - a, s1 * inv - c);
        f32x4 a2, c2; pg8::unpack8(rw[i], a2, c2); s0 -= a2; s1 -= c2; }
}
__device__ __forceinline__ void scan_local16(const bf16* lap, const bf16* bbp, f32x4 (&S)[2], f32x4 (&H)[2]) {
    S[0] = S[1] = H[0] = H[1] = (f32x4){0.f, 0.f, 0.f, 0.f};
#pragma unroll
    for (int i0 = 0; i0 < 16; i0 += 8) { v4u lw[8], bw[8];
#pragma unroll
        for (int i = 0; i < 8; ++i) { lw[i] = *(const v4u*)(lap + (size_t)(i0 + i) * DRNN); bw[i] = *(const v4u*)(bbp + (size_t)(i0 + i) * DRNN); }
#pragma unroll
        for (int i = 0; i < 8; ++i) { f32x4 l[2], bq[2]; pg8::unpack8(lw[i], l[0], l[1]); pg8::unpack8(bw[i], bq[0], bq[1]);
#pragma unroll
            for (int n = 0; n < 2; ++n)
#pragma unroll
                for (int j = 0; j < 4; ++j) { H[n][j] = __expf(l[n][j]) * H[n][j] + bq[n][j]; S[n][j] += l[n][j]; } } }
}

__global__ void __launch_bounds__(NTHR, 2) fwd_kernel(Args args) {
    extern __shared__ __attribute__((aligned(16))) unsigned char lds_raw[];
    LAS unsigned char* lds = (LAS unsigned char*)lds_raw;
    const int tid = threadIdx.x, lane = tid & 63, wave = __builtin_amdgcn_readfirstlane(tid >> 6);
    const int G = gridDim.x, bx = blockIdx.x;
    unsigned char* ws = args.ws;
    const int lo = args.ph_lo, hi = args.ph_hi;
#ifndef PHASE_MASK
#define PHASE_MASK 0x7ff
#endif
#define IN(k) (((PHASE_MASK >> (k)) & 1) && lo <= (k) && (k) < hi)
#ifndef REPEAT_MASK
#define REPEAT_MASK 0
#endif
#define REPS(k) (((REPEAT_MASK >> (k)) & 1) ? 2 : 1)
#define GSYNC() xcd_barrier(bar)
#define SEAM(k) do { if (IN(k) && IN((k) + 1)) { GSYNC(); } } while (0)

    const float* x = args.in[I_X];
    bf16* WIN = (bf16*)(ws + WS_WIN); bf16* WFI = (bf16*)(ws + WS_WFI); bf16* WFO = (bf16*)(ws + WS_WFO); bf16* WRO = (bf16*)(ws + WS_WRO);
    bf16* WO = (bf16*)(ws + WS_WO); bf16* WPO = (bf16*)(ws + WS_WPO); bf16* WGRP = (bf16*)(ws + WS_WGRP); bf16* WGATE = (bf16*)(ws + WS_WGATE);
    bf16* XN = (bf16*)(ws + WS_R1); bf16* V = XN; bf16* HG = XN; bf16* X1B = XN;
    bf16* UP = (bf16*)(ws + WS_R2); bf16* MIXED = UP;
    bf16* UR = (bf16*)(ws + WS_R3); bf16* LA = UR;
    bf16* UG = (bf16*)(ws + WS_R4);
    bf16* POOLED = (bf16*)(ws + WS_R7); bf16* BB = (bf16*)(ws + WS_R8);
    float* MIX0 = (float*)(ws + WS_MIX0); bf16* MIXB = (bf16*)(ws + WS_MIXB); bf16* ACT = (bf16*)(ws + WS_ACT);
    float* SSQ = (float*)(ws + WS_SSQ); float* CS = (float*)(ws + WS_CS); float* CH = (float*)(ws + WS_CH);
    bf16* G0 = (bf16*)args.out; bf16* G1 = G0 + (size_t)M * 1024;
    float* X1 = args.out;

#ifndef EXTRA_SYNCS
#define EXTRA_SYNCS 0
#endif
    volatile LAS unsigned* MISC = (volatile LAS unsigned*)(lds + 131072 + 1024);
    if (tid < 32) MISC[tid] = 0u;
    __syncthreads();
    XcdBarrier bar = xcd_barrier_post((unsigned*)ws, MISC + 8);
    if (lo < 0) cg::this_grid().sync();
    for (int i = 0; i < EXTRA_SYNCS; ++i) GSYNC();
    if (IN(0)) for (int rep = 0; rep < REPS(0); ++rep) { if (rep) GSYNC();
        LAS float* scr = (LAS float*)(lds + wave * 16384);
        const int gw = bx * NWAVES + wave, NGW = G * NWAVES;
        constexpr int I_IN = 16 * (DIN / 32), I_FI = 16 * (2 * DFF / 32), I_FO = (DFF / 64) * (D / 32), I_RO = 16 * 32, I_WO = 16 * 32, I_PO = 8 * 32;
        constexpr int NITEMS = I_IN + I_FI + I_FO + I_RO + I_WO + I_PO;
        for (int it = gw; it < NITEMS; it += NGW) {
            int r = it;
            if (r < I_IN) { const int nblk = DIN / 32, kb = r / nblk, nb = r % nblk; transpose_item(args.in[I_W_IN], DIN, D, WIN, 64 * kb, 32 * nb, 32 * nb, nullptr, scr, lane); continue; } r -= I_IN;
            if (r < I_FI) { const int nblk = 2 * DFF / 32, kb = r / nblk, nb = r % nblk, nd = 32 * nb, pn = nd >> 8, j0 = nd & 255;
                const int ns = j0 < 128 ? 128 * pn + j0 : DFF + 128 * pn + (j0 - 128);
                transpose_item(args.in[I_W_FFN_IN], 2 * DFF, D, WFI, 64 * kb, ns, nd, args.in[I_NORM_FFN], scr, lane); continue; } r -= I_FI;
            if (r < I_FO) { const int nblk = D / 32, kb = r / nblk, nb = r % nblk; transpose_item(args.in[I_W_FFN_OUT], D, DFF, WFO, 64 * kb, 32 * nb, 32 * nb, nullptr, scr, lane); continue; } r -= I_FO;
            if (r < I_RO) { const int nblk = D / 32, kb = r / nblk, nb = r % nblk; transpose_item(args.in[I_W_RNN_OUT], D, D, WRO, 64 * kb, 32 * nb, 32 * nb, nullptr, scr, lane); continue; } r -= I_RO;
            if (r < I_WO) { const int nblk = D / 32, kb = r / nblk, nb = r % nblk; transpose_item(args.in[I_W_O], D, D, WO, 64 * kb, 32 * nb, 32 * nb, nullptr, scr, lane); continue; } r -= I_WO;
            { const int nblk = D / 32, kb = r / nblk, nb = r % nblk; transpose_item(args.in[I_W_POOL_OUT], D, DPOOL, WPO, 64 * kb, 32 * nb, 32 * nb, nullptr, scr, lane); }
        }
        {
            const int gt = bx * NTHR + tid, NT = G * NTHR;
            const float* wg = args.in[I_W_GRP];
            for (int e = gt; e < 512 * 32; e += NT) { const int n = e >> 5, kc = (e & 31) * 8, g = n >> 7, nn = n & 127; float v[8];
#pragma unroll
                for (int j = 0; j < 8; ++j) { const int kk = kc + j - (g & 1) * 128; v[j] = (kk >= 0 && kk < 128) ? wg[((size_t)g * 128 + kk) * 128 + nn] : 0.f; }
                v4u o; o.x = cvt_pk_bf16(v[0], v[1]); o.y = cvt_pk_bf16(v[2], v[3]); o.z = cvt_pk_bf16(v[4], v[5]); o.w = cvt_pk_bf16(v[6], v[7]);
                *(v4u*)(WGRP + (size_t)n * 256 + kc) = o; }
            const float* wa = args.in[I_W_RG_A]; const float* wx = args.in[I_W_RG_X];
            for (int e = gt; e < 2048 * 32; e += NT) { const int n = e >> 5, kc = (e & 31) * 8, h = n >> 8, j = n & 255; const float* src = j < 128 ? wa : wx; const int jj = j & 127; float v[8];
#pragma unroll
                for (int q = 0; q < 8; ++q) { const int kk = kc + q - (h & 1) * 128; v[q] = (kk >= 0 && kk < 128) ? src[((size_t)h * 128 + kk) * 128 + jj] : 0.f; }
                v4u o; o.x = cvt_pk_bf16(v[0], v[1]); o.y = cvt_pk_bf16(v[2], v[3]); o.z = cvt_pk_bf16(v[4], v[5]); o.w = cvt_pk_bf16(v[6], v[7]);
                *(v4u*)(WGATE + (size_t)n * 256 + kc) = o; }
        }
        { const int gt = bx * NTHR + tid; if (gt < DRNN) { const float z = -args.in[I_LAMBDA][gt]; ((float*)(ws + WS_SP8))[gt] = -8.0f * (fmaxf(z, 0.f) + log1pf(expf(-fabsf(z)))); } }
        const float* gmix = args.in[I_NORM_MIX];
        f32x4 gv[4];
#pragma unroll
        for (int j = 0; j < 4; ++j) gv[j] = ((const f32x4*)gmix)[lane + 64 * j];
        for (int m = gw; m < M; m += NGW) {
            const f32x4* xr = (const f32x4*)(x + (size_t)m * D) + lane; f32x4 v[4]; float s = 0.f;
#pragma unroll
            for (int j = 0; j < 4; ++j) { v[j] = xr[64 * j]; s += (v[j].x * v[j].x + v[j].y * v[j].y) + (v[j].z * v[j].z + v[j].w * v[j].w); }
            const float rs = 1.0f / sqrtf(wave_sum(s) * (1.f / D) + EPS);
            v2u* o8 = (v2u*)(XN + (size_t)m * D) + lane;
#pragma unroll
            for (int j = 0; j < 4; ++j) { const f32x4 y = v[j] * rs * gv[j]; v2u w; w.x = cvt_pk_bf16(y.x, y.y); w.y = cvt_pk_bf16(y.z, y.w); o8[64 * j] = w; }
        }
        __syncthreads();
    }
    SEAM(0);

    if (IN(1)) for (int rep = 0; rep < REPS(1); ++rep) { if (rep) GSYNC();
        pg8::Gemm g{XN, WIN, M, DIN, D, D, D, 0, 0}; pg8::StaticOrder S; S.init(M, DIN, G, bx);
        pg8::EpiProj E{UP, UR, UG, G0, G1};
        pg8::gemm_phase<pg8::EpiProj, true>(lds, g, S, E);
    }
    SEAM(1);

    if (IN(2)) for (int rep = 0; rep < REPS(2); ++rep) { if (rep) GSYNC();
        { const int gw = bx * NWAVES + wave, NGW = G * NWAVES;
          for (int wi = gw; wi < (M / 32) * 4; wi += NGW) { const int g = wi & 3, t0 = (wi >> 2) * 32 + (lane >> 4) * 8, co = g * 16 + (lane & 15);
              const bf16* src = UP + (size_t)t0 * DPOOL + co * 8; bf16* dst = POOLED + (size_t)t0 * DPOOL + co * 8; const int tl = t0 & (SEQ - 1);
              if (g == 0) pool_item<2>(src, dst, tl); else if (g == 1) pool_item<4>(src, dst, tl); else if (g == 2) pool_item<8>(src, dst, tl); else pool_item<16>(src, dst, tl); } }
        { const int gt = bx * NTHR + tid, NT = G * NTHR;
          for (int it = gt; it < (M / 8) * 128; it += NT) { const int co = it & 127, t0 = (it >> 7) * 8, tl = t0 & (SEQ - 1);
              const bf16* src = UR + (size_t)t0 * DRNN + co * 8; bf16* dst = V + (size_t)t0 * DRNN + co * 8;
              const float* cw = args.in[I_CONV_W] + co * 8; const float* cb = args.in[I_CONV_B] + co * 8;
              v4u rw[11];
#pragma unroll
              for (int k = 0; k < 11; ++k) rw[k] = (k >= 3 || tl != 0) ? *(const v4u*)(src + (ptrdiff_t)(k - 3) * DRNN) : (v4u){0u, 0u, 0u, 0u};
              f32x4 w0[2], w1[2], w2[2], w3[2], bb[2];
#pragma unroll
              for (int n = 0; n < 2; ++n) { w0[n] = *(const f32x4*)(cw + 4 * n); w1[n] = *(const f32x4*)(cw + 1024 + 4 * n); w2[n] = *(const f32x4*)(cw + 2048 + 4 * n); w3[n] = *(const f32x4*)(cw + 3072 + 4 * n); bb[n] = *(const f32x4*)(cb + 4 * n); }
#pragma unroll
              for (int i = 0; i < 8; ++i) { f32x4 a[2], b[2], c[2], d[2]; pg8::unpack8(rw[i], a[0], a[1]); pg8::unpack8(rw[i + 1], b[0], b[1]); pg8::unpack8(rw[i + 2], c[0], c[1]); pg8::unpack8(rw[i + 3], d[0], d[1]);
                  *(v4u*)(dst + (size_t)i * DRNN) = pg8::pack8(bb[0] + w0[0] * a[0] + w1[0] * b[0] + w2[0] * c[0] + w3[0] * d[0], bb[1] + w0[1] * a[1] + w1[1] * b[1] + w2[1] * c[1] + w3[1] * d[1]); }
          } }
    }
    SEAM(2);

    if (IN(3)) for (int rep = 0; rep < REPS(3); ++rep) { if (rep) GSYNC();
        { pg8::Gemm g{POOLED, WGRP, M, 512, 256, 512, 256, 0, 256}; pg8::StaticOrder S; S.init(M, 512, G, (bx + G / 2) % G);
          pg8::EpiGrp E{MIXED, args.in[I_POOL_SCALE]};
          pg8::gemm_phase<pg8::EpiGrp, true>(lds, g, S, E); }
        { pg8::Gemm g{V, WGATE, M, 2048, 256, 1024, 256, 1, 256}; pg8::StaticOrder S; S.init(M, 2048, G, bx);
          pg8::EpiGate E{V, LA, BB, args.in[I_B_RG_A], args.in[I_B_RG_X], (const float*)(ws + WS_SP8)};
          pg8::gemm_phase<pg8::EpiGate, true>(lds, g, S, E); }
    }
    SEAM(3);

    if (IN(4)) for (int rep = 0; rep < REPS(4); ++rep) { if (rep) GSYNC();
        LAS float* LS = (LAS float*)lds; LAS float* LH = LS + 8 * 512;
        for (int bi = bx; bi < NB * SCAN_NC * 2; bi += G) { const int hh = bi & 1, c = (bi >> 1) % SCAN_NC, b = bi / (2 * SCAN_NC);
            const size_t off = ((size_t)b * SEQ + (size_t)c * SCAN_T + wave * 16) * DRNN + hh * 512 + lane * 8;
            f32x4 S[2], H[2]; scan_local16(LA + off, BB + off, S, H);
            *(LAS f32x4*)(LS + wave * 512 + lane * 8) = S[0]; *(LAS f32x4*)(LS + wave * 512 + lane * 8 + 4) = S[1];
            *(LAS f32x4*)(LH + wave * 512 + lane * 8) = H[0]; *(LAS f32x4*)(LH + wave * 512 + lane * 8 + 4) = H[1];
            __syncthreads();
            { float h = 0.f, st = 0.f;
#pragma unroll
              for (int sb = 0; sb < 8; ++sb) { const float sv = LS[sb * 512 + tid]; h = __expf(sv) * h + LH[sb * 512 + tid]; st += sv; }
              const size_t co = ((size_t)b * SCAN_NC + c) * DRNN + hh * 512 + tid; CS[co] = st; CH[co] = h; }
            __syncthreads();
        }
    }
    SEAM(4);

    if (IN(5)) for (int rep = 0; rep < REPS(5); ++rep) { if (rep) GSYNC();
        LAS float* PAS = (LAS float*)lds; LAS float* PAH = PAS + 8 * 512; LAS float* PBS = PAH + 8 * 512; LAS float* PBH = PBS + 8 * 512;
        for (int bi = bx; bi < NB * SCAN_NC * 2; bi += G) { const int hh = bi & 1, c = (bi >> 1) % SCAN_NC, b = bi / (2 * SCAN_NC);
            { f32x4 S[2] = {{0.f, 0.f, 0.f, 0.f}, {0.f, 0.f, 0.f, 0.f}}, H[2] = {{0.f, 0.f, 0.f, 0.f}, {0.f, 0.f, 0.f, 0.f}};
              f32x4 cs[4][2], ch[4][2];
#pragma unroll
              for (int q = 0; q < 4; ++q) { const int cc = wave * 4 + q; const size_t co = ((size_t)b * SCAN_NC + (cc < c ? cc : 0)) * DRNN + hh * 512 + lane * 8;
                  cs[q][0] = *(const f32x4*)(CS + co); cs[q][1] = *(const f32x4*)(CS + co + 4); ch[q][0] = *(const f32x4*)(CH + co); ch[q][1] = *(const f32x4*)(CH + co + 4); }
#pragma unroll
              for (int q = 0; q < 4; ++q) { if (wave * 4 + q < c) {
#pragma unroll
                  for (int n = 0; n < 2; ++n)
#pragma unroll
                      for (int j = 0; j < 4; ++j) { H[n][j] = __expf(cs[q][n][j]) * H[n][j] + ch[q][n][j]; S[n][j] += cs[q][n][j]; } } }
              *(LAS f32x4*)(PAS + wave * 512 + lane * 8) = S[0]; *(LAS f32x4*)(PAS + wave * 512 + lane * 8 + 4) = S[1];
              *(LAS f32x4*)(PAH + wave * 512 + lane * 8) = H[0]; *(LAS f32x4*)(PAH + wave * 512 + lane * 8 + 4) = H[1]; }
            const size_t off = ((size_t)b * SEQ + (size_t)c * SCAN_T + wave * 16) * DRNN + hh * 512 + lane * 8;
            { f32x4 S[2], H[2]; scan_local16(LA + off, BB + off, S, H);
              *(LAS f32x4*)(PBS + wave * 512 + lane * 8) = S[0]; *(LAS f32x4*)(PBS + wave * 512 + lane * 8 + 4) = S[1];
              *(LAS f32x4*)(PBH + wave * 512 + lane * 8) = H[0]; *(LAS f32x4*)(PBH + wave * 512 + lane * 8 + 4) = H[1]; }
            __syncthreads();
            f32x4 h[2] = {{0.f, 0.f, 0.f, 0.f}, {0.f, 0.f, 0.f, 0.f}};
#pragma unroll
            for (int sb = 0; sb < 8; ++sb) {
#pragma unroll
                for (int n = 0; n < 2; ++n) { const f32x4 sv = *(const LAS f32x4*)(PAS + sb * 512 + lane * 8 + 4 * n), hv = *(const LAS f32x4*)(PAH + sb * 512 + lane * 8 + 4 * n);
#pragma unroll
                    for (int j = 0; j < 4; ++j) h[n][j] = __expf(sv[j]) * h[n][j] + hv[j]; } }
            for (int sb = 0; sb < wave; ++sb) {
#pragma unroll
                for (int n = 0; n < 2; ++n) { const f32x4 sv = *(const LAS f32x4*)(PBS + sb * 512 + lane * 8 + 4 * n), hv = *(const LAS f32x4*)(PBH + sb * 512 + lane * 8 + 4 * n);
#pragma unroll
                    for (int j = 0; j < 4; ++j) h[n][j] = __expf(sv[j]) * h[n][j] + hv[j]; } }
            const bf16* lap = LA + off; const bf16* bbp = BB + off; const bf16* ugp = UG + off; bf16* hgp = HG + off;
#pragma unroll
            for (int i0 = 0; i0 < 16; i0 += 4) { v4u lw[4], bw[4], gw4[4];
#pragma unroll
                for (int i = 0; i < 4; ++i) { lw[i] = *(const v4u*)(lap + (size_t)(i0 + i) * DRNN); bw[i] = *(const v4u*)(bbp + (size_t)(i0 + i) * DRNN); gw4[i] = *(const v4u*)(ugp + (size_t)(i0 + i) * DRNN); }
#pragma unroll
                for (int i = 0; i < 4; ++i) { f32x4 l[2], bq[2], gq[2], o[2]; pg8::unpack8(lw[i], l[0], l[1]); pg8::unpack8(bw[i], bq[0], bq[1]); pg8::unpack8(gw4[i], gq[0], gq[1]);
#pragma unroll
                    for (int n = 0; n < 2; ++n)
#pragma unroll
                        for (int j = 0; j < 4; ++j) { h[n][j] = __expf(l[n][j]) * h[n][j] + bq[n][j]; o[n][j] = h[n][j] * gq[n][j]; }
                    *(v4u*)(hgp + (size_t)(i0 + i) * DRNN) = pg8::pack8(o[0], o[1]); } }
            __syncthreads();
        }
    }
    SEAM(5);

    if (IN(6)) for (int rep = 0; rep < REPS(6); ++rep) { if (rep) GSYNC();
        { pg8::Gemm g{MIXED, WPO, M, D, DPOOL, DPOOL, DPOOL, 0, 0}; pg8::StaticOrder S; S.init(M, D, G, bx);
          pg8::EpiMix0 E{G0, MIX0};
          pg8::gemm_phase<pg8::EpiMix0, true>(lds, g, S, E); }
        { pg8::Gemm g{HG, WRO, M, D, D, D, D, 0, 0}; pg8::StaticOrder S; S.init(M, D, G, bx);
          pg8::EpiMix1 E{G1, MIX0, MIXB};
          pg8::gemm_phase<pg8::EpiMix1, true>(lds, g, S, E); }
    }
    SEAM(6);

    if (IN(7)) for (int rep = 0; rep < REPS(7); ++rep) { if (rep) GSYNC();
        pg8::Gemm g{MIXB, WO, M, D, D, D, D, 0, 0}; pg8::StaticOrder S; S.init(M, D, G, bx);
        pg8::EpiRes1 E{x, X1, X1B, SSQ};
        pg8::gemm_phase<pg8::EpiRes1, true>(lds, g, S, E);
    }
    SEAM(7);

    if (IN(8)) for (int rep = 0; rep < REPS(8); ++rep) { if (rep) GSYNC();
        pg8::Gemm g{X1B, WFI, M, 2 * DFF, D, D, D, 0, 0}; pg8::StaticOrder S; S.init(M, 2 * DFF, G, bx);
        pg8::EpiSwiglu E{SSQ, ACT};
        pg8::gemm_phase<pg8::EpiSwiglu, true>(lds, g, S, E);
    }
    SEAM(8);

    if (IN(9)) for (int rep = 0; rep < REPS(9); ++rep) { if (rep) GSYNC();
        pg8::Gemm g{ACT, WFO, M, D, DFF, DFF, DFF, 0, 0}; pg8::StaticOrder S; S.init(M, D, G, bx);
        pg8::EpiRes2 E{X1};
        pg8::gemm_phase<pg8::EpiRes2, true>(lds, g, S, E);
    }
    SEAM(9);

    if (IN(10)) for (int rep = 0; rep < REPS(10); ++rep) { if (rep) GSYNC();
        const int gw = bx * NWAVES + wave, NGW = G * NWAVES;
        const float* gf = args.in[I_NORM_FINAL]; f32x4 gv[4];
#pragma unroll
        for (int j = 0; j < 4; ++j) gv[j] = ((const f32x4*)gf)[lane + 64 * j];
        for (int m = gw; m < M; m += NGW) {
            f32x4* xr = (f32x4*)(X1 + (size_t)m * D) + lane; f32x4 v[4]; float s = 0.f;
#pragma unroll
            for (int j = 0; j < 4; ++j) { v[j] = xr[64 * j]; s += (v[j].x * v[j].x + v[j].y * v[j].y) + (v[j].z * v[j].z + v[j].w * v[j].w); }
            const float rs = 1.0f / sqrtf(wave_sum(s) * (1.f / D) + EPS);
#pragma unroll
            for (int j = 0; j < 4; ++j) xr[64 * j] = v[j] * rs * gv[j];
        }
    }
#undef IN
#undef SEAM
}

extern "C" void kernel_launch(void* const* d_in, const int* in_sizes, int n_in, void* d_out, int out_size, void* d_ws, size_t ws_size, hipStream_t stream) {
    static int grid = 0;
    if (grid == 0) {
        if (n_in != 19 || out_size != M * D || ws_size < WS_END) { fprintf(stderr, "kernel_launch: unexpected shapes (n_in %d out %d ws %zu)\n", n_in, out_size, ws_size); grid = -1; return; }
        int dev = 0, cus = 0, per_cu = 0;
        hipGetDevice(&dev);
        hipDeviceGetAttribute(&cus, hipDeviceAttributeMultiprocessorCount, dev);
        if (hipFuncSetAttribute((const void*)fwd_kernel, hipFuncAttributeMaxDynamicSharedMemorySize, LDS_BYTES) != hipSuccess) { fprintf(stderr, "kernel_launch: hipFuncSetAttribute failed\n"); grid = -1; return; }
        if (hipOccupancyMaxActiveBlocksPerMultiprocessor(&per_cu, (const void*)fwd_kernel, NTHR, LDS_BYTES) != hipSuccess || per_cu < 1) { fprintf(stderr, "kernel_launch: occupancy query says %d\n", per_cu); per_cu = 1; }
        (void)hipGetLastError();
        grid = cus * 1;
        fprintf(stderr, "kernel_launch: grid %d (cus %d, per_cu %d)\n", grid, cus, per_cu);
    }
    if (grid < 0) return;
    if (hipMemsetAsync(d_ws, 0, 16384, stream) != hipSuccess) { fprintf(stderr, "kernel_launch: memset failed\n"); return; }
    Args a{};
    for (int i = 0; i < 19; ++i) a.in[i] = (const float*)d_in[i];
    a.out = (float*)d_out; a.ws = (unsigned char*)d_ws;
#if MK_PER_PHASE
    for (int p = 0; p < NPH; ++p) { a.ph_lo = p; a.ph_hi = p + 1; hipLaunchKernelGGL(fwd_kernel, dim3(grid), dim3(NTHR), LDS_BYTES, stream, a); }
#else
    a.ph_lo = 0; a.ph_hi = NPH;
    void* kargs[] = {&a};
    hipError_t e = hipLaunchCooperativeKernel((const void*)fwd_kernel, dim3(grid), dim3(NTHR), kargs, LDS_BYTES, stream);
    if (e != hipSuccess) fprintf(stderr, "cooperative launch failed: %s (grid %d)\n", hipGetErrorString(e), grid);
#endif
}
```

```cpp
#include <hip/hip_runtime.h>
#include <hip/hip_cooperative_groups.h>
#include <cstdio>
#include <cstdint>
namespace cg = cooperative_groups;

#ifndef MK_PER_PHASE
#define MK_PER_PHASE 0
#endif

namespace pg8 {
#define PG8_LAS __attribute__((address_space(3)))
typedef unsigned short bf16_t;
typedef short bf16x8 __attribute__((ext_vector_type(8)));
typedef float f32x4 __attribute__((ext_vector_type(4)));
typedef float f32x2 __attribute__((ext_vector_type(2)));
typedef unsigned u32x4 __attribute__((ext_vector_type(4)));
typedef unsigned u32x2 __attribute__((ext_vector_type(2)));
constexpr int BM = 256, BK = 64, HALF = 128, HTB = HALF * BK * 2, STAGE_BYTES = 8 * HTB, NXCD = 8, WGM = 8;

__host__ __device__ __forceinline__ int lds_byte(int r, int c) { const int st = (r >> 4) * 2 + (c >> 5), rr = r & 15, cc = c & 31, ob = rr * 64 + cc * 2; return st * 1024 + (ob ^ (((ob >> 9) & 1) << 5)); }
__host__ __device__ __forceinline__ void stage_rc(int b, int& R, int& C) { const int st = b / 1024, sb = b % 1024, swz = sb ^ (((sb >> 9) & 1) << 5); R = (st >> 1) * 16 + swz / 64; C = (st & 1) * 32 + (swz % 64) / 2; }
__host__ __device__ __forceinline__ int perm32(int rho) { const int n = rho >> 4, i = rho & 15; return 8 * (i >> 2) + 4 * n + (i & 3); }

struct Unit { int pm, pn; };
struct Gemm { const bf16_t* A; const bf16_t* Bt; int M, N, K, lda, ldb, ash, amul; };

struct StaticOrder {
    int nM, nN, nwg, G, c;
    __host__ __device__ void init(int M, int N, int G_, int c_) { nM = M / BM; nN = N / BM; nwg = nM * nN; G = G_; c = c_; }
    __host__ __device__ bool next(int i, Unit& u) const {
        const long L = (long)i * G + c; if (L >= nwg) return false;
        int wgid = (int)L; { const int q = nwg / NXCD, r = nwg % NXCD, xcd = wgid % NXCD, off = wgid / NXCD; wgid = (xcd < r ? xcd * (q + 1) : r * (q + 1) + (xcd - r) * q) + off; }
        const int nig = WGM * nN, gid = wgid / nig, fm = gid * WGM, gsz = (nM - fm) < WGM ? (nM - fm) : WGM;
        u.pm = fm + ((wgid % nig) % gsz); u.pn = (wgid % nig) / gsz; return true;
    }
};

__device__ __forceinline__ unsigned cvt_pk_bf16(float lo, float hi) { unsigned r; asm volatile("v_cvt_pk_bf16_f32 %0, %1, %2" : "=v"(r) : "v"(lo), "v"(hi)); return r; }
__device__ __forceinline__ float bf_lo(unsigned w) { return __uint_as_float(w << 16); }
__device__ __forceinline__ float bf_hi(unsigned w) { return __uint_as_float(w & 0xffff0000u); }
__device__ __forceinline__ float sigmoidf_(float x) { return __builtin_amdgcn_rcpf(1.0f + __expf(-x)); }
__device__ __forceinline__ float gelu_tanh_(float x) { const float z = 1.5957691216057308f * (x + 0.044715f * x * x * x); return x * sigmoidf_(z); }
__device__ __forceinline__ u32x4 pack8(const f32x4 a, const f32x4 b) { u32x4 w; w.x = cvt_pk_bf16(a[0], a[1]); w.y = cvt_pk_bf16(a[2], a[3]); w.z = cvt_pk_bf16(b[0], b[1]); w.w = cvt_pk_bf16(b[2], b[3]); return w; }
__device__ __forceinline__ void unpack8(const u32x4 w, f32x4& a, f32x4& b) { a = (f32x4){bf_lo(w.x), bf_hi(w.x), bf_lo(w.y), bf_hi(w.y)}; b = (f32x4){bf_lo(w.z), bf_hi(w.z), bf_lo(w.w), bf_hi(w.w)}; }

#define EPI_ROWS_BEGIN _Pragma("unroll") for (int ai = 0; ai < 2; ++ai) _Pragma("unroll") for (int m = 0; m < 4; ++m) { const int row = u.pm * BM + ai * HALF + wr * 64 + m * 16 + fr;
#define EPI_ROWS_END __builtin_amdgcn_sched_barrier(0); }

struct EpiProj {
    bf16_t *UP, *UR, *UG, *G0, *G1;
    __device__ __forceinline__ void operator()(const f32x4 (&acc)[2][2][4][2], const Unit& u, int wr, int wc, int fr, int fq) const {
        const int pn = u.pn; bf16_t* base; int ldc, colt, act;
        if (pn < 2) { base = UP; ldc = 512; colt = pn * 256; act = 0; }
        else if (pn < 6) { base = UR; ldc = 1024; colt = (pn - 2) * 256; act = 0; }
        else if (pn < 10) { base = UG; ldc = 1024; colt = (pn - 6) * 256; act = 1; }
        else if (pn < 14) { base = G0; ldc = 1024; colt = (pn - 10) * 256; act = 2; }
        else { base = G1; ldc = 1024; colt = (pn - 14) * 256; act = 2; }
        const int col0 = colt + wc * 32 + 8 * fq;
        EPI_ROWS_BEGIN
            bf16_t* rowp = base + (unsigned)((unsigned)row * (unsigned)ldc + (unsigned)col0);
#pragma unroll
            for (int bj = 0; bj < 2; ++bj) { f32x4 v0 = acc[ai][bj][m][0], v1 = acc[ai][bj][m][1];
                if (act == 1) {
#pragma unroll
                    for (int j = 0; j < 4; ++j) { v0[j] = gelu_tanh_(v0[j]); v1[j] = gelu_tanh_(v1[j]); } }
                else if (act == 2) {
#pragma unroll
                    for (int j = 0; j < 4; ++j) { v0[j] = sigmoidf_(v0[j]); v1[j] = sigmoidf_(v1[j]); } }
                *(u32x4*)(rowp + bj * HALF) = pack8(v0, v1); }
        EPI_ROWS_END
    }
};
struct EpiGrp {
    bf16_t* O; int ldc; const float* scale;
    __device__ __forceinline__ void operator()(const f32x4 (&acc)[2][2][4][2], const Unit& u, int wr, int wc, int fr, int fq) const {
        const int col0 = u.pn * BM + wc * 32 + 8 * fq;
        f32x4 sc[2][2];
#pragma unroll
        for (int bj = 0; bj < 2; ++bj)
#pragma unroll
            for (int n = 0; n < 2; ++n) sc[bj][n] = *(const f32x4*)(scale + col0 + bj * HALF + 4 * n);
        EPI_ROWS_BEGIN
            bf16_t* rowp = O + (unsigned)((unsigned)row * (unsigned)ldc + (unsigned)col0);
#pragma unroll
            for (int bj = 0; bj < 2; ++bj) *(u32x4*)(rowp + bj * HALF) = pack8(acc[ai][bj][m][0] * sc[bj][0], acc[ai][bj][m][1] * sc[bj][1]);
        EPI_ROWS_END
    }
};
struct EpiGate {
    const bf16_t* V; bf16_t *LA, *BB; const float *b_a, *b_x, *sp8;
    __device__ __forceinline__ void operator()(const f32x4 (&acc)[2][2][4][2], const Unit& u, int wr, int wc, int fr, int fq) const {
        const int ch0 = u.pn * 128 + wc * 32 + 8 * fq;
        f32x4 ba[2], bx[2], sp[2];
#pragma unroll
        for (int n = 0; n < 2; ++n) { ba[n] = *(const f32x4*)(b_a + ch0 + 4 * n); bx[n] = *(const f32x4*)(b_x + ch0 + 4 * n); sp[n] = *(const f32x4*)(sp8 + ch0 + 4 * n); }
        EPI_ROWS_BEGIN
            const unsigned off = (unsigned)row * 1024u + (unsigned)ch0;
            const u32x4 vw = *(const u32x4*)(V + off); f32x4 vv[2]; unpack8(vw, vv[0], vv[1]);
            f32x4 la[2], bb[2];
#pragma unroll
            for (int n = 0; n < 2; ++n)
#pragma unroll
                for (int j = 0; j < 4; ++j) {
                    const float r = sigmoidf_(acc[ai][0][m][n][j] + ba[n][j]), ig = sigmoidf_(acc[ai][1][m][n][j] + bx[n][j]);
                    const float l = sp[n][j] * r, x2 = 2.0f * l;
                    const float em1 = (x2 > -0.125f) ? x2 * (1.0f + 0.5f * x2 * (1.0f + 0.33333334f * x2 * (1.0f + 0.25f * x2 * (1.0f + 0.2f * x2)))) : (__expf(x2) - 1.0f);
                    la[n][j] = l; bb[n][j] = sqrtf(fmaxf(-em1, 0.f)) * ig * vv[n][j]; }
            *(u32x4*)(LA + off) = pack8(la[0], la[1]); *(u32x4*)(BB + off) = pack8(bb[0], bb[1]);
            asm volatile("" ::: "memory");
        EPI_ROWS_END
    }
};
struct EpiMix {
    const bf16_t *G0, *G1; bf16_t* MIXB;
    __device__ __forceinline__ void mid(f32x4 (&acc)[2][2][4][2], const Unit& u0, int wr, int wc, int fr, int fq) const {
        Unit u = u0; asm volatile("" : "+s"(u.pm), "+s"(u.pn));
        const int col0 = u.pn * BM + wc * 32 + 8 * fq;
        EPI_ROWS_BEGIN
            const unsigned off = (unsigned)row * 1024u + (unsigned)col0;
#pragma unroll
            for (int bj = 0; bj < 2; ++bj) { f32x4 g0[2], g1[2]; unpack8(*(const u32x4*)(G0 + off + bj * HALF), g0[0], g0[1]); unpack8(*(const u32x4*)(G1 + off + bj * HALF), g1[0], g1[1]);
#pragma unroll
                for (int n = 0; n < 2; ++n)
#pragma unroll
                    for (int j = 0; j < 4; ++j) acc[ai][bj][m][n][j] *= g0[n][j] * __builtin_amdgcn_rcpf(fmaxf(g1[n][j], 1e-30f)); }
        EPI_ROWS_END
    }
    __device__ __forceinline__ void operator()(const f32x4 (&acc)[2][2][4][2], const Unit& u, int wr, int wc, int fr, int fq) const {
        const int col0 = u.pn * BM + wc * 32 + 8 * fq;
        EPI_ROWS_BEGIN
            const unsigned off = (unsigned)row * 1024u + (unsigned)col0;
#pragma unroll
            for (int bj = 0; bj < 2; ++bj) { f32x4 g[2]; unpack8(*(const u32x4*)(G1 + off + bj * HALF), g[0], g[1]);
                *(u32x4*)(MIXB + off + bj * HALF) = pack8(g[0] * acc[ai][bj][m][0], g[1] * acc[ai][bj][m][1]); }
        EPI_ROWS_END
    }
};
struct EpiRes1 {
    const float* X; bf16_t* X1B; float* SSQ;
    __device__ __forceinline__ void operator()(const f32x4 (&acc)[2][2][4][2], const Unit& u, int wr, int wc, int fr, int fq) const {
        const int col0 = u.pn * BM + wc * 32 + 8 * fq;
        EPI_ROWS_BEGIN
            const unsigned off = (unsigned)row * 1024u + (unsigned)col0; float ss = 0.f;
#pragma unroll
            for (int bj = 0; bj < 2; ++bj) {
                const f32x4 a = *(const f32x4*)(X + off + bj * HALF) + acc[ai][bj][m][0], b = *(const f32x4*)(X + off + bj * HALF + 4) + acc[ai][bj][m][1];
                *(u32x4*)(X1B + off + bj * HALF) = pack8(a, b);
                ss += (a[0] * a[0] + a[1] * a[1]) + (a[2] * a[2] + a[3] * a[3]) + (b[0] * b[0] + b[1] * b[1]) + (b[2] * b[2] + b[3] * b[3]); }
            ss += __shfl_xor(ss, 16); ss += __shfl_xor(ss, 32);
            if (fq == 0) SSQ[(unsigned)row * 16u + (unsigned)(u.pn * 4 + wc)] = ss;
        EPI_ROWS_END
    }
};
struct EpiSwiglu {
    const float* SSQ; bf16_t* ACT;
    __device__ __forceinline__ void operator()(const f32x4 (&acc)[2][2][4][2], const Unit& u, int wr, int wc, int fr, int fq) const {
        const int col0 = u.pn * 128 + wc * 32 + 8 * fq;
        EPI_ROWS_BEGIN
            const f32x4* sp = (const f32x4*)(SSQ + (unsigned)row * 16u); const f32x4 s0 = sp[0], s1 = sp[1], s2 = sp[2], s3 = sp[3];
            const f32x4 st = (s0 + s1) + (s2 + s3); const float rs = __builtin_amdgcn_rsqf((st[0] + st[1] + st[2] + st[3]) * (1.0f / 1024.0f) + 1e-6f);
            f32x4 o[2];
#pragma unroll
            for (int n = 0; n < 2; ++n)
#pragma unroll
                for (int j = 0; j < 4; ++j) { const float g = acc[ai][0][m][n][j] * rs, up = acc[ai][1][m][n][j] * rs; o[n][j] = g * sigmoidf_(g) * up; }
            *(u32x4*)(ACT + (unsigned)((unsigned)row * 2816u + (unsigned)col0)) = pack8(o[0], o[1]);
        EPI_ROWS_END
    }
};
struct EpiRes2 {
    const bf16_t* X1B; float* OUT;
    __device__ __forceinline__ void operator()(const f32x4 (&acc)[2][2][4][2], const Unit& u, int wr, int wc, int fr, int fq) const {
        const int col0 = u.pn * BM + wc * 32 + 8 * fq;
        EPI_ROWS_BEGIN
            const unsigned off = (unsigned)row * 1024u + (unsigned)col0;
#pragma unroll
            for (int bj = 0; bj < 2; ++bj) { f32x4 xa, xb; unpack8(*(const u32x4*)(X1B + off + bj * HALF), xa, xb);
                *(f32x4*)(OUT + off + bj * HALF) = xa + acc[ai][bj][m][0]; *(f32x4*)(OUT + off + bj * HALF + 4) = xb + acc[ai][bj][m][1]; }
        EPI_ROWS_END
    }
};

template <class Epi, bool ALIGN_EPI, int MID_T = -1>
__device__ __forceinline__ void gemm_phase(PG8_LAS unsigned char* lds, const Gemm g, const StaticOrder& S, const Epi& E) {
    const int tid = threadIdx.x, wid = __builtin_amdgcn_readfirstlane(tid >> 6), lane = tid & 63, wr = wid >> 2, wc = wid & 3, fr = lane & 15, fq = lane >> 4;
    int nt = g.K / BK; asm volatile("" : "+s"(nt));
    unsigned voffA[2], voffB[2];
#pragma unroll
    for (int i = 0; i < 2; ++i) { int R, C; stage_rc(tid * 16 + i * 8192, R, C); const int Rb = (R & ~31) + perm32(R & 31);
        voffA[i] = (unsigned)(R * g.lda + C) * 2u; voffB[i] = (unsigned)(Rb * g.ldb + C) * 2u; }
    const size_t kstep = (size_t)(BK * 2);
    const size_t hstepA = (size_t)HALF * g.lda * 2, hstepB = (size_t)HALF * g.ldb * 2;
    const size_t tstepA = 2 * hstepA, tstepB = 2 * hstepB;
    const unsigned ldsw = (unsigned)wid * 1024u;
    const int aoff = lds_byte(wr * 64 + fr, fq * 8), boff = lds_byte(wc * 32 + fr, fq * 8);
#define PG8_SA(b, h) (((b) * 2 + (h)) * HTB)
#define PG8_SB(b, h) ((4 + (b) * 2 + (h)) * HTB)
#define PG8_STAGE(bufoff, gbase, voff) do { _Pragma("unroll") for (int _i = 0; _i < 2; ++_i) \
        __builtin_amdgcn_global_load_lds((const unsigned*)((const char*)(gbase) + (voff)[_i]), (PG8_LAS unsigned*)(lds + (bufoff) + ldsw + _i * 8192), 16, 0, 0); } while (0)
#define PG8_LDA(dst, b, h) do { _Pragma("unroll") for (int m = 0; m < 4; ++m) _Pragma("unroll") for (int k = 0; k < 2; ++k) dst[m][k] = *(const PG8_LAS bf16x8*)(lds + PG8_SA(b, h) + aoff + m * 2048 + k * 1024); } while (0)
#define PG8_LDB(dst, b, h) do { _Pragma("unroll") for (int n = 0; n < 2; ++n) _Pragma("unroll") for (int k = 0; k < 2; ++k) dst[n][k] = *(const PG8_LAS bf16x8*)(lds + PG8_SB(b, h) + boff + n * 2048 + k * 1024); } while (0)
#define PG8_MMA(ai, bj, At, Bt) do { __builtin_amdgcn_s_setprio(1); _Pragma("unroll") for (int m = 0; m < 4; ++m) _Pragma("unroll") for (int n = 0; n < 2; ++n) _Pragma("unroll") for (int k = 0; k < 2; ++k) \
        acc[ai][bj][m][n] = __builtin_amdgcn_mfma_f32_16x16x32_bf16(Bt[n][k], At[m][k], acc[ai][bj][m][n], 0, 0, 0); __builtin_amdgcn_s_setprio(0); } while (0)
#define PG8_WAIT_V(n) asm volatile("s_waitcnt vmcnt(" #n ")" ::: "memory")
#define PG8_WAIT_L(n) asm volatile("s_waitcnt lgkmcnt(" #n ")" ::: "memory")
#define PG8_BAR __builtin_amdgcn_s_barrier()
#define PG8_SCHED __builtin_amdgcn_sched_barrier(0)
    Unit cur, nxt; int ui = 0;
    if (!S.next(0, cur)) return;
    f32x4 acc[2][2][4][2];
#pragma unroll
    for (int a = 0; a < 2; ++a)
#pragma unroll
        for (int b = 0; b < 2; ++b)
#pragma unroll
            for (int m = 0; m < 4; ++m)
#pragma unroll
                for (int n = 0; n < 2; ++n) acc[a][b][m][n] = (f32x4){0.f, 0.f, 0.f, 0.f};
    bf16x8 At[4][2], B0[2][2], B1[2][2];
    const char* cA = (const char*)g.A + (size_t)cur.pm * tstepA + (size_t)((cur.pn >> g.ash) * g.amul) * 2; const char* cB = (const char*)g.Bt + (size_t)cur.pn * tstepB;
    PG8_STAGE(PG8_SB(0, 0), cB, voffB); PG8_STAGE(PG8_SB(0, 1), cB + hstepB, voffB); PG8_STAGE(PG8_SA(0, 0), cA, voffA); PG8_STAGE(PG8_SA(0, 1), cA + hstepA, voffA);
    if (wr == 1) PG8_BAR;
    PG8_WAIT_V(2); PG8_BAR;
    PG8_STAGE(PG8_SB(1, 0), cB + kstep, voffB); PG8_STAGE(PG8_SA(1, 0), cA + kstep, voffA); PG8_STAGE(PG8_SB(1, 1), cB + hstepB + kstep, voffB);
    PG8_WAIT_V(6); PG8_BAR;
    for (;;) {
        const bool has_next = S.next(ui + 1, nxt);
        const char* nA = has_next ? (const char*)g.A + (size_t)nxt.pm * tstepA + (size_t)((nxt.pn >> g.ash) * g.amul) * 2 : cA; const char* nB = has_next ? (const char*)g.Bt + (size_t)nxt.pn * tstepB : cB;
        for (int t = 0; t < nt; t += 2) {
            const bool last = (t == nt - 2);
            if constexpr (MID_T >= 0) { if (t == MID_T) E.mid(acc, cur, wr, wc, fr, fq); }
            const char* a1 = cA + (size_t)(t + 1) * kstep;
            const char* a2 = last ? nA : cA + (size_t)(t + 2) * kstep; const char* b2 = last ? nB : cB + (size_t)(t + 2) * kstep;
            const char* a3 = a2 + kstep; const char* b3 = b2 + kstep;
            PG8_LDB(B0, 0, 0); PG8_LDB(B1, 0, 1); PG8_SCHED; PG8_LDA(At, 0, 0); PG8_STAGE(PG8_SA(1, 1), a1 + hstepA, voffA);
            PG8_WAIT_V(8); PG8_WAIT_L(0); PG8_BAR; PG8_MMA(0, 0, At, B0); PG8_MMA(0, 1, At, B1); PG8_BAR; PG8_SCHED;
            PG8_LDA(At, 0, 1); PG8_STAGE(PG8_SB(0, 0), b2, voffB); PG8_STAGE(PG8_SB(0, 1), b2 + hstepB, voffB); PG8_STAGE(PG8_SA(0, 0), a2, voffA);
            PG8_WAIT_V(8); PG8_WAIT_L(0); PG8_BAR; PG8_MMA(1, 0, At, B0); PG8_MMA(1, 1, At, B1); PG8_BAR; PG8_SCHED;
            PG8_LDB(B0, 1, 0); PG8_LDB(B1, 1, 1); PG8_SCHED; PG8_LDA(At, 1, 0); PG8_STAGE(PG8_SA(0, 1), a2 + hstepA, voffA);
            PG8_WAIT_V(8); PG8_WAIT_L(0); PG8_BAR; PG8_MMA(0, 0, At, B0); PG8_MMA(0, 1, At, B1); PG8_BAR; PG8_SCHED;
            PG8_LDA(At, 1, 1); PG8_STAGE(PG8_SB(1, 0), b3, voffB); PG8_STAGE(PG8_SB(1, 1), b3 + hstepB, voffB); PG8_STAGE(PG8_SA(1, 0), a3, voffA);
            PG8_WAIT_V(8); PG8_WAIT_L(0); PG8_BAR; PG8_MMA(1, 0, At, B0); PG8_MMA(1, 1, At, B1); PG8_BAR; PG8_SCHED;
        }
        if constexpr (ALIGN_EPI) { if (wr == 0) PG8_BAR; }
        E(acc, cur, wr, wc, fr, fq);
        if (!has_next) break;
#pragma unroll
        for (int a = 0; a < 2; ++a)
#pragma unroll
            for (int b = 0; b < 2; ++b)
#pragma unroll
                for (int m = 0; m < 4; ++m)
#pragma unroll
                    for (int n = 0; n < 2; ++n) acc[a][b][m][n] = (f32x4){0.f, 0.f, 0.f, 0.f};
        cur = nxt; cA = nA; cB = nB; ++ui;
        if constexpr (ALIGN_EPI) { if (wr == 1) PG8_BAR; }
    }
    PG8_WAIT_V(0);
    if constexpr (!ALIGN_EPI) { if (wr == 0) PG8_BAR; }
    PG8_BAR;
#undef PG8_SA
#undef PG8_SB
#undef PG8_STAGE
#undef PG8_LDA
#undef PG8_LDB
#undef PG8_MMA
#undef PG8_WAIT_V
#undef PG8_WAIT_L
#undef PG8_BAR
#undef PG8_SCHED
}
}

constexpr int NWAVES = 8, NTHR = 512;
constexpr int M = 16384, SEQ = 4096, NB = 4, D = 1024, DPOOL = 512, DRNN = 1024, DIN = 4608, DFF = 2816;
constexpr float EPS = 1e-6f;
constexpr int NPH = 11;
constexpr int SCAN_T = 128, SCAN_NC = SEQ / SCAN_T;

constexpr size_t MiB = 1u << 20;
constexpr size_t WS_SP8 = 512 * 1024;
constexpr size_t WS_SSQ = 1 * MiB;
constexpr size_t WS_CS = 2 * MiB, WS_CH = 3 * MiB;
constexpr size_t WS_WIN = 4 * MiB;
constexpr size_t WS_WFI = 13 * MiB;
constexpr size_t WS_WFO = 24 * MiB;
constexpr size_t WS_WCAT = WS_WFO + 5632 * 1024;
constexpr size_t WS_WO = WS_WCAT + 3 * MiB;
constexpr size_t WS_WGRP = WS_WO + 2 * MiB;
constexpr size_t WS_WGATE = WS_WGRP + MiB / 4;
constexpr size_t WS_R1 = 36 * MiB;
constexpr size_t WS_R2 = 68 * MiB;
constexpr size_t WS_R3 = 84 * MiB;
constexpr size_t WS_R4 = 116 * MiB;
constexpr size_t WS_R7 = 148 * MiB;
constexpr size_t WS_R8 = 164 * MiB;
constexpr size_t WS_CAT = 196 * MiB;
constexpr size_t WS_MIXB = 148 * MiB;
constexpr size_t WS_ACT = 68 * MiB;
constexpr size_t WS_END = 244 * MiB;

constexpr int LDS_BYTES = 147456;

#define LAS __attribute__((address_space(3)))
typedef unsigned short bf16;
typedef unsigned v4u __attribute__((ext_vector_type(4)));
typedef unsigned v2u __attribute__((ext_vector_type(2)));
typedef float f32x4 __attribute__((ext_vector_type(4)));
typedef float f32x2 __attribute__((ext_vector_type(2)));
#define LDS_WAIT() asm volatile("s_waitcnt lgkmcnt(0)" ::: "memory")
using pg8::cvt_pk_bf16; using pg8::bf_lo; using pg8::bf_hi;

struct Args { const float* in[19]; float* out; unsigned char* ws; int ph_lo, ph_hi; };
enum { I_X = 0, I_NORM_MIX, I_W_IN, I_W_GRP, I_POOL_SCALE, I_W_POOL_OUT, I_CONV_W, I_CONV_B, I_W_RG_A, I_B_RG_A, I_W_RG_X, I_B_RG_X, I_LAMBDA, I_W_RNN_OUT, I_W_O, I_NORM_FFN, I_W_FFN_IN, I_W_FFN_OUT, I_NORM_FINAL };

__device__ __forceinline__ float wave_sum(float v) {
#pragma unroll
    for (int o = 1; o < 64; o <<= 1) v += __shfl_xor(v, o);
    return v;
}

__device__ __forceinline__ void transpose_item(const float* W, int Nsrc, int Kdst, bf16* WT, int k0, int n_src0, int n_dst0, const float* kscale, LAS float* scr, int lane) {
    f32x4 v[8]; const int n4 = (lane & 7) * 4;
#pragma unroll
    for (int i = 0; i < 8; ++i) { const int kk = 8 * i + (lane >> 3); v[i] = *(const f32x4*)(W + (size_t)(k0 + kk) * Nsrc + n_src0 + n4); }
    if (kscale) {
#pragma unroll
        for (int i = 0; i < 8; ++i) v[i] = v[i] * kscale[k0 + 8 * i + (lane >> 3)]; }
#pragma unroll
    for (int i = 0; i < 8; ++i) { const int kk = 8 * i + (lane >> 3);
#pragma unroll
        for (int j = 0; j < 4; ++j) scr[kk * 33 + n4 + j] = v[i][j]; }
    LDS_WAIT(); asm volatile("" ::: "memory");
    const int c = lane & 7;
#pragma unroll
    for (int j = 0; j < 4; ++j) { const int n = (lane >> 3) + 8 * j; const LAS float* s = scr + (8 * c) * 33 + n;
        v4u o; o.x = cvt_pk_bf16(s[0 * 33], s[1 * 33]); o.y = cvt_pk_bf16(s[2 * 33], s[3 * 33]); o.z = cvt_pk_bf16(s[4 * 33], s[5 * 33]); o.w = cvt_pk_bf16(s[6 * 33], s[7 * 33]);
        *(v4u*)(WT + (size_t)(n_dst0 + n) * Kdst + k0 + 8 * c) = o; }
    LDS_WAIT(); asm volatile("" ::: "memory");
}

#define XB_TMO      128
#define XB_XCNT(j)  (256  + 64 * (j))
#define XB_XSUB(j)  (1280 + 64 * (j))
#define XB_XGEN(j)  (2304 + 64 * (j))
#define XB_TOP      3328
#define XB_TOPGEN   3392
#define XCD_BAR_WORDS 3456
#define XB_SPIN_CAP (1u << 18)
__device__ __forceinline__ unsigned xb_ld(unsigned* p)              { return __hip_atomic_load(p, __ATOMIC_RELAXED, __HIP_MEMORY_SCOPE_AGENT); }
__device__ __forceinline__ unsigned xb_add(unsigned* p, unsigned v) { return __hip_atomic_fetch_add(p, v, __ATOMIC_RELAXED, __HIP_MEMORY_SCOPE_AGENT); }
__device__ __forceinline__ unsigned xb_xcc_id() { return (unsigned)__builtin_amdgcn_s_getreg((3 << 11) | 20) & 0xFu; }
#define XB_SPIN(cond, bar) do { unsigned _sp = 0; while (cond) { __builtin_amdgcn_s_sleep(1); \
    if ((++_sp & 255u) == 0u) { if (xb_ld(&(bar)[XB_TMO])) break; if (_sp > XB_SPIN_CAP) { atomicAdd(&(bar)[XB_TMO], 1u); break; } } } } while (0)
struct XcdBarrier { unsigned* bar; unsigned x; volatile LAS unsigned* st; };
__device__ __forceinline__ XcdBarrier xcd_barrier_post(unsigned* bar, volatile LAS unsigned* st) {
    XcdBarrier b; b.bar = bar; b.x = xb_xcc_id(); b.st = st;
    if (threadIdx.x == 0) (void)xb_add(&bar[XB_XCNT(b.x)], 1u);
    return b;
}
__device__ __forceinline__ void xcd_barrier_complete(unsigned* bar, unsigned x, unsigned& nloc, unsigned& nx) {
    const unsigned G = gridDim.x * gridDim.y * gridDim.z;
    unsigned sum, cnt, mine, sp = 0u;
    for (;;) {
        sum = 0u; cnt = 0u; mine = 0u;
#pragma unroll
        for (unsigned j = 0; j < 16; ++j) { const unsigned c = xb_ld(&bar[XB_XCNT(j)]); sum += c; cnt += (c > 0u) ? 1u : 0u; mine = (j == x) ? c : mine; }
        if (sum == G) break;
        __builtin_amdgcn_s_sleep(1);
        if ((++sp & 255u) == 0u) { if (xb_ld(&bar[XB_TMO])) break; if (sp > XB_SPIN_CAP) { atomicAdd(&bar[XB_TMO], 1u); break; } }
    }
    nloc = mine > 0u ? mine : 1u; nx = cnt > 0u ? cnt : 1u;
}
__device__ __forceinline__ void xcd_barrier(const XcdBarrier& b) {
    asm volatile("s_waitcnt vmcnt(0)" ::: "memory");
    __syncthreads();
    if (threadIdx.x == 0) {
        unsigned* bar = b.bar;
        __builtin_amdgcn_s_waitcnt(0);
        unsigned nloc = b.st[0], nx = b.st[1];
        if (nloc == 0u) { xcd_barrier_complete(bar, b.x, nloc, nx); b.st[0] = nloc; b.st[1] = nx; }
        const unsigned old = xb_add(&bar[XB_XSUB(b.x)], 1u);
        const unsigned gen = old / nloc;
        if (old + 1u == (gen + 1u) * nloc) {
            __builtin_amdgcn_fence(__ATOMIC_RELEASE, "agent");
            asm volatile("s_waitcnt vmcnt(0)" ::: "memory");
            const unsigned og = xb_add(&bar[XB_TOP], 1u);
            const unsigned tg = og / nx;
            if (og + 1u == (tg + 1u) * nx) xb_add(&bar[XB_TOPGEN], 1u);
            else XB_SPIN(xb_ld(&bar[XB_TOPGEN]) == tg, bar);
            __builtin_amdgcn_fence(__ATOMIC_ACQUIRE, "agent");
            xb_add(&bar[XB_XGEN(b.x)], 1u);
            asm volatile("s_waitcnt vmcnt(0)" ::: "memory");
        } else {
            XB_SPIN(xb_ld(&bar[XB_XGEN(b.x)]) == gen, bar);
            __builtin_amdgcn_fence(__ATOMIC_ACQUIRE, "agent");
            asm volatile("s_waitcnt vmcnt(0)" ::: "memory");
        }
    }
    __syncthreads();
}

template <int W>
__device__ __forceinline__ void pool_item(const bf16* src, bf16* dst, int tl) {
    v4u rw[W + 7];
#pragma unroll
    for (int k = 0; k < W + 7; ++k) rw[k] = (tl + k - (W - 1) >= 0) ? *(const v4u*)(src + (ptrdiff_t)(k - (W - 1)) * DPOOL) : (v4u){0u, 0u, 0u, 0u};
    f32x4 s0 = {0.f, 0.f, 0.f, 0.f}, s1 = s0;
#pragma unroll
    for (int k = 0; k < W - 1; ++k) { f32x4 a, c; pg8::unpack8(rw[k], a, c); s0 += a; s1 += c; }
#pragma unroll
    for (int i = 0; i < 8; ++i) { f32x4 a, c; pg8::unpack8(rw[W - 1 + i], a, c); s0 += a; s1 += c;
        const int t = tl + i; const int cnt = (t + 1 < W) ? t + 1 : W; const float inv = 1.0f / (float)cnt;
        *(v4u*)(dst + (size_t)i * DPOOL) = pg8::pack8(s0 * inv - a, s1 * inv - c);
        f32x4 a2, c2; pg8::unpack8(rw[i], a2, c2); s0 -= a2; s1 -= c2; }
}
__device__ __forceinline__ void scan_local16(const bf16* lap, const bf16* bbp, f32x4 (&S)[2], f32x4 (&H)[2]) {
    S[0] = S[1] = H[0] = H[1] = (f32x4){0.f, 0.f, 0.f, 0.f};
#pragma unroll
    for (int i0 = 0; i0 < 16; i0 += 8) { v4u lw[8], bw[8];
#pragma unroll
        for (int i = 0; i < 8; ++i) { lw[i] = *(const v4u*)(lap + (size_t)(i0 + i) * DRNN); bw[i] = *(const v4u*)(bbp + (size_t)(i0 + i) * DRNN); }
#pragma unroll
        for (int i = 0; i < 8; ++i) { f32x4 l[2], bq[2]; pg8::unpack8(lw[i], l[0], l[1]); pg8::unpack8(bw[i], bq[0], bq[1]);
#pragma unroll
            for (int n = 0; n < 2; ++n)
#pragma unroll
                for (int j = 0; j < 4; ++j) { H[n][j] = __expf(l[n][j]) * H[n][j] + bq[n][j]; S[n][j] += l[n][j]; } } }
}

__global__ void __launch_bounds__(NTHR, 2) fwd_kernel(Args args) {
    extern __shared__ __attribute__((aligned(16))) unsigned char lds_raw[];
    LAS unsigned char* lds = (LAS unsigned char*)lds_raw;
    const int tid = threadIdx.x, lane = tid & 63, wave = __builtin_amdgcn_readfirstlane(tid >> 6);
    const int G = gridDim.x, bx = blockIdx.x;
    unsigned char* ws = args.ws;
    const int lo = args.ph_lo, hi = args.ph_hi;
#ifndef PHASE_MASK
#define PHASE_MASK 0x7ff
#endif
#define IN(k) (((PHASE_MASK >> (k)) & 1) && lo <= (k) && (k) < hi)
#ifndef REPEAT_MASK
#define REPEAT_MASK 0
#endif
#define REPS(k) (((REPEAT_MASK >> (k)) & 1) ? 2 : 1)
#ifndef PROBE_PHASE
#define PROBE_PHASE -1
#endif
#define PROBE_MULT 4
    unsigned long long tp0 = 0, tp1 = 0;
#define TSTART(k) do { if ((k) == PROBE_PHASE) tp0 = __builtin_amdgcn_s_memrealtime(); } while (0)
#define TEND(k) do { if ((k) == PROBE_PHASE) tp1 = __builtin_amdgcn_s_memrealtime(); } while (0)
#define GSYNC() xcd_barrier(bar)
#define SEAM(k) do { if (IN(k) && IN((k) + 1)) { GSYNC(); } } while (0)

    const float* x = args.in[I_X];
    bf16* WIN = (bf16*)(ws + WS_WIN); bf16* WFI = (bf16*)(ws + WS_WFI); bf16* WFO = (bf16*)(ws + WS_WFO); bf16* WCAT = (bf16*)(ws + WS_WCAT);
    bf16* WO = (bf16*)(ws + WS_WO); bf16* WGRP = (bf16*)(ws + WS_WGRP); bf16* WGATE = (bf16*)(ws + WS_WGATE);
    bf16* XN = (bf16*)(ws + WS_R1); bf16* V = XN; bf16* X1B = XN;
    bf16* CAT = (bf16*)(ws + WS_CAT);
    bf16* UP = (bf16*)(ws + WS_R2);
    bf16* UR = (bf16*)(ws + WS_R3); bf16* LA = UR;
    bf16* UG = (bf16*)(ws + WS_R4);
    bf16* POOLED = (bf16*)(ws + WS_R7); bf16* BB = (bf16*)(ws + WS_R8);
    bf16* MIXB = (bf16*)(ws + WS_MIXB); bf16* ACT = (bf16*)(ws + WS_ACT);
    float* SSQ = (float*)(ws + WS_SSQ); float* CS = (float*)(ws + WS_CS); float* CH = (float*)(ws + WS_CH);
    bf16* G0 = (bf16*)args.out; bf16* G1 = G0 + (size_t)M * 1024;
    float* X1 = args.out;

#ifndef EXTRA_SYNCS
#define EXTRA_SYNCS 0
#endif
    volatile LAS unsigned* MISC = (volatile LAS unsigned*)(lds + 131072 + 1024);
    if (tid < 32) MISC[tid] = 0u;
    __syncthreads();
    XcdBarrier bar = xcd_barrier_post((unsigned*)ws, MISC + 8);
    if (lo < 0) cg::this_grid().sync();
    for (int i = 0; i < EXTRA_SYNCS; ++i) GSYNC();
    TSTART(0);
    if (IN(0)) for (int rep = 0; rep < REPS(0); ++rep) { if (rep) GSYNC();
        LAS float* scr = (LAS float*)(lds + wave * 16384);
        const int gw = bx * NWAVES + wave, NGW = G * NWAVES;
        constexpr int I_IN = 16 * (DIN / 32), I_FI = 16 * (2 * DFF / 32), I_FO = (DFF / 64) * (D / 32), I_RO = 16 * 32, I_WO = 16 * 32, I_PO = 8 * 32;
        constexpr int NITEMS = I_IN + I_FI + I_FO + I_RO + I_WO + I_PO;
        for (int it = gw; it < NITEMS; it += NGW) {
            int r = it;
            if (r < I_IN) { const int nblk = DIN / 32, kb = r / nblk, nb = r % nblk; transpose_item(args.in[I_W_IN], DIN, D, WIN, 64 * kb, 32 * nb, 32 * nb, nullptr, scr, lane); continue; } r -= I_IN;
            if (r < I_FI) { const int nblk = 2 * DFF / 32, kb = r / nblk, nb = r % nblk, nd = 32 * nb, pn = nd >> 8, j0 = nd & 255;
                const int ns = j0 < 128 ? 128 * pn + j0 : DFF + 128 * pn + (j0 - 128);
                transpose_item(args.in[I_W_FFN_IN], 2 * DFF, D, WFI, 64 * kb, ns, nd, args.in[I_NORM_FFN], scr, lane); continue; } r -= I_FI;
            if (r < I_FO) { const int nblk = D / 32, kb = r / nblk, nb = r % nblk; transpose_item(args.in[I_W_FFN_OUT], D, DFF, WFO, 64 * kb, 32 * nb, 32 * nb, nullptr, scr, lane); continue; } r -= I_FO;
            if (r < I_RO) { const int nblk = D / 32, kb = r / nblk, nb = r % nblk; transpose_item(args.in[I_W_RNN_OUT], D, 1536, WCAT + 512, 64 * kb, 32 * nb, 32 * nb, nullptr, scr, lane); continue; } r -= I_RO;
            if (r < I_WO) { const int nblk = D / 32, kb = r / nblk, nb = r % nblk; transpose_item(args.in[I_W_O], D, D, WO, 64 * kb, 32 * nb, 32 * nb, nullptr, scr, lane); continue; } r -= I_WO;
            { const int nblk = D / 32, kb = r / nblk, nb = r % nblk; transpose_item(args.in[I_W_POOL_OUT], D, 1536, WCAT, 64 * kb, 32 * nb, 32 * nb, nullptr, scr, lane); }
        }
        {
            const int gt = bx * NTHR + tid, NT = G * NTHR;
            const float* wg = args.in[I_W_GRP];
            for (int e = gt; e < 512 * 32; e += NT) { const int n = e >> 5, kc = (e & 31) * 8, g = n >> 7, nn = n & 127; float v[8];
#pragma unroll
                for (int j = 0; j < 8; ++j) { const int kk = kc + j - (g & 1) * 128; v[j] = (kk >= 0 && kk < 128) ? wg[((size_t)g * 128 + kk) * 128 + nn] : 0.f; }
                v4u o; o.x = cvt_pk_bf16(v[0], v[1]); o.y = cvt_pk_bf16(v[2], v[3]); o.z = cvt_pk_bf16(v[4], v[5]); o.w = cvt_pk_bf16(v[6], v[7]);
                *(v4u*)(WGRP + (size_t)n * 256 + kc) = o; }
            const float* wa = args.in[I_W_RG_A]; const float* wx = args.in[I_W_RG_X];
            for (int e = gt; e < 2048 * 32; e += NT) { const int n = e >> 5, kc = (e & 31) * 8, h = n >> 8, j = n & 255; const float* src = j < 128 ? wa : wx; const int jj = j & 127; float v[8];
#pragma unroll
                for (int q = 0; q < 8; ++q) { const int kk = kc + q - (h & 1) * 128; v[q] = (kk >= 0 && kk < 128) ? src[((size_t)h * 128 + kk) * 128 + jj] : 0.f; }
                v4u o; o.x = cvt_pk_bf16(v[0], v[1]); o.y = cvt_pk_bf16(v[2], v[3]); o.z = cvt_pk_bf16(v[4], v[5]); o.w = cvt_pk_bf16(v[6], v[7]);
                *(v4u*)(WGATE + (size_t)n * 256 + kc) = o; }
        }
        { const int gt = bx * NTHR + tid; if (gt < DRNN) { const float z = -args.in[I_LAMBDA][gt]; ((float*)(ws + WS_SP8))[gt] = -8.0f * (fmaxf(z, 0.f) + log1pf(expf(-fabsf(z)))); } }
        const float* gmix = args.in[I_NORM_MIX];
        f32x4 gv[4];
#pragma unroll
        for (int j = 0; j < 4; ++j) gv[j] = ((const f32x4*)gmix)[lane + 64 * j];
        for (int m = gw; m < M; m += 2 * NGW) {
            const int m1 = (m + NGW < M) ? m + NGW : m;
            const f32x4* xr0 = (const f32x4*)(x + (size_t)m * D) + lane; const f32x4* xr1 = (const f32x4*)(x + (size_t)m1 * D) + lane; f32x4 v0[4], v1[4]; float s0 = 0.f, s1 = 0.f;
#pragma unroll
            for (int j = 0; j < 4; ++j) { v0[j] = xr0[64 * j]; v1[j] = xr1[64 * j]; }
#pragma unroll
            for (int j = 0; j < 4; ++j) { s0 += (v0[j].x * v0[j].x + v0[j].y * v0[j].y) + (v0[j].z * v0[j].z + v0[j].w * v0[j].w); s1 += (v1[j].x * v1[j].x + v1[j].y * v1[j].y) + (v1[j].z * v1[j].z + v1[j].w * v1[j].w); }
            const float rs0 = 1.0f / sqrtf(wave_sum(s0) * (1.f / D) + EPS), rs1 = 1.0f / sqrtf(wave_sum(s1) * (1.f / D) + EPS);
            v2u* o0 = (v2u*)(XN + (size_t)m * D) + lane; v2u* o1 = (v2u*)(XN + (size_t)m1 * D) + lane;
#pragma unroll
            for (int j = 0; j < 4; ++j) { const f32x4 y0 = v0[j] * rs0 * gv[j], y1 = v1[j] * rs1 * gv[j]; v2u w0, w1; w0.x = cvt_pk_bf16(y0.x, y0.y); w0.y = cvt_pk_bf16(y0.z, y0.w); w1.x = cvt_pk_bf16(y1.x, y1.y); w1.y = cvt_pk_bf16(y1.z, y1.w); o0[64 * j] = w0; o1[64 * j] = w1; }
        }
        __syncthreads();
    }
    SEAM(0);
    TEND(0);

    TSTART(1);
    if (IN(1)) for (int rep = 0; rep < REPS(1); ++rep) { if (rep) GSYNC();
        pg8::Gemm g{XN, WIN, M, DIN, D, D, D, 0, 0}; pg8::StaticOrder S; S.init(M, DIN, G, bx);
        pg8::EpiProj E{UP, UR, UG, G0, G1};
        pg8::gemm_phase<pg8::EpiProj, true>(lds, g, S, E);
    }
    SEAM(1);
    TEND(1);

    TSTART(2);
    if (IN(2)) for (int rep = 0; rep < REPS(2); ++rep) { if (rep) GSYNC();
        { const int gw = bx * NWAVES + wave, NGW = G * NWAVES;
          for (int wi = gw; wi < (M / 32) * 4; wi += NGW) { const int g = wi & 3, t0 = (wi >> 2) * 32 + (lane >> 4) * 8, co = g * 16 + (lane & 15);
              const bf16* src = UP + (size_t)t0 * DPOOL + co * 8; bf16* dst = POOLED + (size_t)t0 * DPOOL + co * 8; const int tl = t0 & (SEQ - 1);
              if (g == 0) pool_item<2>(src, dst, tl); else if (g == 1) pool_item<4>(src, dst, tl); else if (g == 2) pool_item<8>(src, dst, tl); else pool_item<16>(src, dst, tl); } }
        { const int gt = bx * NTHR + tid, NT = G * NTHR;
          for (int it = gt; it < (M / 8) * 128; it += NT) { const int co = it & 127, t0 = (it >> 7) * 8, tl = t0 & (SEQ - 1);
              const bf16* src = UR + (size_t)t0 * DRNN + co * 8; bf16* dst = V + (size_t)t0 * DRNN + co * 8;
              const float* cw = args.in[I_CONV_W] + co * 8; const float* cb = args.in[I_CONV_B] + co * 8;
              v4u rw[11];
#pragma unroll
              for (int k = 0; k < 11; ++k) rw[k] = (k >= 3 || tl != 0) ? *(const v4u*)(src + (ptrdiff_t)(k - 3) * DRNN) : (v4u){0u, 0u, 0u, 0u};
              f32x4 w0[2], w1[2], w2[2], w3[2], bb[2];
#pragma unroll
              for (int n = 0; n < 2; ++n) { w0[n] = *(const f32x4*)(cw + 4 * n); w1[n] = *(const f32x4*)(cw + 1024 + 4 * n); w2[n] = *(const f32x4*)(cw + 2048 + 4 * n); w3[n] = *(const f32x4*)(cw + 3072 + 4 * n); bb[n] = *(const f32x4*)(cb + 4 * n); }
#pragma unroll
              for (int i = 0; i < 8; ++i) { f32x4 a[2], b[2], c[2], d[2]; pg8::unpack8(rw[i], a[0], a[1]); pg8::unpack8(rw[i + 1], b[0], b[1]); pg8::unpack8(rw[i + 2], c[0], c[1]); pg8::unpack8(rw[i + 3], d[0], d[1]);
                  *(v4u*)(dst + (size_t)i * DRNN) = pg8::pack8(bb[0] + w0[0] * a[0] + w1[0] * b[0] + w2[0] * c[0] + w3[0] * d[0], bb[1] + w0[1] * a[1] + w1[1] * b[1] + w2[1] * c[1] + w3[1] * d[1]); }
          } }
    }
    SEAM(2);
    TEND(2);

    TSTART(3);
    if (IN(3)) for (int rep = 0; rep < REPS(3); ++rep) { if (rep) GSYNC();
        { pg8::Gemm g{POOLED, WGRP, M, 512, 256, 512, 256, 0, 256}; pg8::StaticOrder S; S.init(M, 512, G, (bx + G / 2) % G);
          pg8::EpiGrp E{CAT, 1536, args.in[I_POOL_SCALE]};
          pg8::gemm_phase<pg8::EpiGrp, true>(lds, g, S, E); }
        { pg8::Gemm g{V, WGATE, M, 2048, 256, 1024, 256, 1, 256}; pg8::StaticOrder S; S.init(M, 2048, G, bx);
          pg8::EpiGate E{V, LA, BB, args.in[I_B_RG_A], args.in[I_B_RG_X], (const float*)(ws + WS_SP8)};
          pg8::gemm_phase<pg8::EpiGate, true>(lds, g, S, E); }
    }
    SEAM(3);
    TEND(3);

    TSTART(4);
    if (IN(4)) for (int rep = 0; rep < REPS(4); ++rep) { if (rep) GSYNC();
        LAS float* LS = (LAS float*)lds; LAS float* LH = LS + 8 * 512;
        for (int bi = bx; bi < NB * SCAN_NC * 2; bi += G) { const int hh = bi & 1, c = (bi >> 1) % SCAN_NC, b = bi / (2 * SCAN_NC);
            const size_t off = ((size_t)b * SEQ + (size_t)c * SCAN_T + wave * 16) * DRNN + hh * 512 + lane * 8;
            f32x4 S[2], H[2]; scan_local16(LA + off, BB + off, S, H);
            *(LAS f32x4*)(LS + wave * 512 + lane * 8) = S[0]; *(LAS f32x4*)(LS + wave * 512 + lane * 8 + 4) = S[1];
            *(LAS f32x4*)(LH + wave * 512 + lane * 8) = H[0]; *(LAS f32x4*)(LH + wave * 512 + lane * 8 + 4) = H[1];
            __syncthreads();
            { float h = 0.f, st = 0.f;
#pragma unroll
              for (int sb = 0; sb < 8; ++sb) { const float sv = LS[sb * 512 + tid]; h = __expf(sv) * h + LH[sb * 512 + tid]; st += sv; }
              const size_t co = ((size_t)b * SCAN_NC + c) * DRNN + hh * 512 + tid; CS[co] = st; CH[co] = h; }
            __syncthreads();
        }
    }
    SEAM(4);
    TEND(4);

    TSTART(5);
    if (IN(5)) for (int rep = 0; rep < REPS(5); ++rep) { if (rep) GSYNC();
        LAS float* PAS = (LAS float*)lds; LAS float* PAH = PAS + 8 * 512; LAS float* PBS = PAH + 8 * 512; LAS float* PBH = PBS + 8 * 512;
        for (int bi = bx; bi < NB * SCAN_NC * 2; bi += G) { const int hh = bi & 1, c = (bi >> 1) % SCAN_NC, b = bi / (2 * SCAN_NC);
            { f32x4 S[2] = {{0.f, 0.f, 0.f, 0.f}, {0.f, 0.f, 0.f, 0.f}}, H[2] = {{0.f, 0.f, 0.f, 0.f}, {0.f, 0.f, 0.f, 0.f}};
              f32x4 cs[4][2], ch[4][2];
#pragma unroll
              for (int q = 0; q < 4; ++q) { const int cc = wave * 4 + q; const size_t co = ((size_t)b * SCAN_NC + (cc < c ? cc : 0)) * DRNN + hh * 512 + lane * 8;
                  cs[q][0] = *(const f32x4*)(CS + co); cs[q][1] = *(const f32x4*)(CS + co + 4); ch[q][0] = *(const f32x4*)(CH + co); ch[q][1] = *(const f32x4*)(CH + co + 4); }
#pragma unroll
              for (int q = 0; q < 4; ++q) { if (wave * 4 + q < c) {
#pragma unroll
                  for (int n = 0; n < 2; ++n)
#pragma unroll
                      for (int j = 0; j < 4; ++j) { H[n][j] = __expf(cs[q][n][j]) * H[n][j] + ch[q][n][j]; S[n][j] += cs[q][n][j]; } } }
              *(LAS f32x4*)(PAS + wave * 512 + lane * 8) = S[0]; *(LAS f32x4*)(PAS + wave * 512 + lane * 8 + 4) = S[1];
              *(LAS f32x4*)(PAH + wave * 512 + lane * 8) = H[0]; *(LAS f32x4*)(PAH + wave * 512 + lane * 8 + 4) = H[1]; }
            const size_t off = ((size_t)b * SEQ + (size_t)c * SCAN_T + wave * 16) * DRNN + hh * 512 + lane * 8;
            { f32x4 S[2], H[2]; scan_local16(LA + off, BB + off, S, H);
              *(LAS f32x4*)(PBS + wave * 512 + lane * 8) = S[0]; *(LAS f32x4*)(PBS + wave * 512 + lane * 8 + 4) = S[1];
              *(LAS f32x4*)(PBH + wave * 512 + lane * 8) = H[0]; *(LAS f32x4*)(PBH + wave * 512 + lane * 8 + 4) = H[1]; }
            __syncthreads();
            f32x4 h[2] = {{0.f, 0.f, 0.f, 0.f}, {0.f, 0.f, 0.f, 0.f}};
#pragma unroll
            for (int sb = 0; sb < 8; ++sb) {
#pragma unroll
                for (int n = 0; n < 2; ++n) { const f32x4 sv = *(const LAS f32x4*)(PAS + sb * 512 + lane * 8 + 4 * n), hv = *(const LAS f32x4*)(PAH + sb * 512 + lane * 8 + 4 * n);
#pragma unroll
                    for (int j = 0; j < 4; ++j) h[n][j] = __expf(sv[j]) * h[n][j] + hv[j]; } }
            for (int sb = 0; sb < wave; ++sb) {
#pragma unroll
                for (int n = 0; n < 2; ++n) { const f32x4 sv = *(const LAS f32x4*)(PBS + sb * 512 + lane * 8 + 4 * n), hv = *(const LAS f32x4*)(PBH + sb * 512 + lane * 8 + 4 * n);
#pragma unroll
                    for (int j = 0; j < 4; ++j) h[n][j] = __expf(sv[j]) * h[n][j] + hv[j]; } }
            const bf16* lap = LA + off; const bf16* bbp = BB + off; const bf16* ugp = UG + off;
            bf16* hgp = CAT + ((size_t)b * SEQ + (size_t)c * SCAN_T + wave * 16) * 1536 + 512 + hh * 512 + lane * 8;
#pragma unroll
            for (int i0 = 0; i0 < 16; i0 += 4) { v4u lw[4], bw[4], gw4[4];
#pragma unroll
                for (int i = 0; i < 4; ++i) { lw[i] = *(const v4u*)(lap + (size_t)(i0 + i) * DRNN); bw[i] = *(const v4u*)(bbp + (size_t)(i0 + i) * DRNN); gw4[i] = *(const v4u*)(ugp + (size_t)(i0 + i) * DRNN); }
#pragma unroll
                for (int i = 0; i < 4; ++i) { f32x4 l[2], bq[2], gq[2], o[2]; pg8::unpack8(lw[i], l[0], l[1]); pg8::unpack8(bw[i], bq[0], bq[1]); pg8::unpack8(gw4[i], gq[0], gq[1]);
#pragma unroll
                    for (int n = 0; n < 2; ++n)
#pragma unroll
                        for (int j = 0; j < 4; ++j) { h[n][j] = __expf(l[n][j]) * h[n][j] + bq[n][j]; o[n][j] = h[n][j] * gq[n][j]; }
                    *(v4u*)(hgp + (size_t)(i0 + i) * 1536) = pg8::pack8(o[0], o[1]); } }
            __syncthreads();
        }
    }
    SEAM(5);
    TEND(5);

    TSTART(6);
    if (IN(6)) for (int rep = 0; rep < REPS(6); ++rep) { if (rep) GSYNC();
        pg8::Gemm g{CAT, WCAT, M, D, 1536, 1536, 1536, 0, 0}; pg8::StaticOrder S; S.init(M, D, G, bx);
        pg8::EpiMix E{G0, G1, MIXB};
        pg8::gemm_phase<pg8::EpiMix, true, 8>(lds, g, S, E);
    }
    SEAM(6);
    TEND(6);

    TSTART(7);
    if (IN(7)) for (int rep = 0; rep < REPS(7); ++rep) { if (rep) GSYNC();
        pg8::Gemm g{MIXB, WO, M, D, D, D, D, 0, 0}; pg8::StaticOrder S; S.init(M, D, G, bx);
        pg8::EpiRes1 E{x, X1B, SSQ};
        pg8::gemm_phase<pg8::EpiRes1, true>(lds, g, S, E);
    }
    SEAM(7);
    TEND(7);

    TSTART(8);
    if (IN(8)) for (int rep = 0; rep < REPS(8); ++rep) { if (rep) GSYNC();
        pg8::Gemm g{X1B, WFI, M, 2 * DFF, D, D, D, 0, 0}; pg8::StaticOrder S; S.init(M, 2 * DFF, G, bx);
        pg8::EpiSwiglu E{SSQ, ACT};
        pg8::gemm_phase<pg8::EpiSwiglu, true>(lds, g, S, E);
    }
    SEAM(8);
    TEND(8);

    TSTART(9);
    if (IN(9)) for (int rep = 0; rep < REPS(9); ++rep) { if (rep) GSYNC();
        pg8::Gemm g{ACT, WFO, M, D, DFF, DFF, DFF, 0, 0}; pg8::StaticOrder S; S.init(M, D, G, bx);
        pg8::EpiRes2 E{X1B, X1};
        pg8::gemm_phase<pg8::EpiRes2, true>(lds, g, S, E);
    }
    SEAM(9);
    TEND(9);

    TSTART(10);
    if (IN(10)) for (int rep = 0; rep < REPS(10); ++rep) { if (rep) GSYNC();
        const int gw = bx * NWAVES + wave, NGW = G * NWAVES;
        const float* gf = args.in[I_NORM_FINAL]; f32x4 gv[4];
#pragma unroll
        for (int j = 0; j < 4; ++j) gv[j] = ((const f32x4*)gf)[lane + 64 * j];
        for (int m = gw; m < M; m += NGW) {
            f32x4* xr = (f32x4*)(X1 + (size_t)m * D) + lane; f32x4 v[4]; float s = 0.f;
#pragma unroll
            for (int j = 0; j < 4; ++j) { v[j] = xr[64 * j]; s += (v[j].x * v[j].x + v[j].y * v[j].y) + (v[j].z * v[j].z + v[j].w * v[j].w); }
            const float rs = 1.0f / sqrtf(wave_sum(s) * (1.f / D) + EPS);
#pragma unroll
            for (int j = 0; j < 4; ++j) xr[64 * j] = v[j] * rs * gv[j];
        }
    }
    if (PROBE_PHASE == 10) tp1 = __builtin_amdgcn_s_memrealtime();
    if (PROBE_PHASE >= 0 && bx == 0 && tid == 0) { const unsigned long long dt = (tp1 - tp0) * PROBE_MULT, te = __builtin_amdgcn_s_memrealtime(); while (__builtin_amdgcn_s_memrealtime() - te < dt) __builtin_amdgcn_s_sleep(8); }
#undef IN
#undef SEAM
}

extern "C" void kernel_launch(void* const* d_in, const int* in_sizes, int n_in, void* d_out, int out_size, void* d_ws, size_t ws_size, hipStream_t stream) {
    static int grid = 0;
    if (grid == 0) {
        if (n_in != 19 || out_size != M * D || ws_size < WS_END) { fprintf(stderr, "kernel_launch: unexpected shapes (n_in %d out %d ws %zu)\n", n_in, out_size, ws_size); grid = -1; return; }
        int dev = 0, cus = 0, per_cu = 0;
        hipGetDevice(&dev);
        hipDeviceGetAttribute(&cus, hipDeviceAttributeMultiprocessorCount, dev);
        if (hipFuncSetAttribute((const void*)fwd_kernel, hipFuncAttributeMaxDynamicSharedMemorySize, LDS_BYTES) != hipSuccess) { fprintf(stderr, "kernel_launch: hipFuncSetAttribute failed\n"); grid = -1; return; }
        if (hipOccupancyMaxActiveBlocksPerMultiprocessor(&per_cu, (const void*)fwd_kernel, NTHR, LDS_BYTES) != hipSuccess || per_cu < 1) { fprintf(stderr, "kernel_launch: occupancy query says %d\n", per_cu); per_cu = 1; }
        (void)hipGetLastError();
        grid = cus * 1;
        fprintf(stderr, "kernel_launch: grid %d (cus %d, per_cu %d)\n", grid, cus, per_cu);
    }
    if (grid < 0) return;
    if (hipMemsetAsync(d_ws, 0, 16384, stream) != hipSuccess) { fprintf(stderr, "kernel_launch: memset failed\n"); return; }
    Args a{};
    for (int i = 0; i < 19; ++i) a.in[i] = (const float*)d_in[i];
    a.out = (float*)d_out; a.ws = (unsigned char*)d_ws;
#if MK_PER_PHASE
    for (int p = 0; p < NPH; ++p) { a.ph_lo = p; a.ph_hi = p + 1; hipLaunchKernelGGL(fwd_kernel, dim3(grid), dim3(NTHR), LDS_BYTES, stream, a); }
#else
    a.ph_lo = 0; a.ph_hi = NPH;
    void* kargs[] = {&a};
    hipError_t e = hipLaunchCooperativeKernel((const void*)fwd_kernel, dim3(grid), dim3(NTHR), kargs, LDS_BYTES, stream);
    if (e != hipSuccess) fprintf(stderr, "cooperative launch failed: %s (grid %d)\n", hipGetErrorString(e), grid);
#endif
}
```

```cpp
#include <hip/hip_runtime.h>
#include <hip/hip_cooperative_groups.h>
#include <cstdio>
#include <cstdint>
namespace cg = cooperative_groups;

#ifndef MK_PER_PHASE
#define MK_PER_PHASE 0
#endif

namespace pg8 {
#define PG8_LAS __attribute__((address_space(3)))
typedef unsigned short bf16_t;
typedef short bf16x8 __attribute__((ext_vector_type(8)));
typedef float f32x4 __attribute__((ext_vector_type(4)));
typedef float f32x2 __attribute__((ext_vector_type(2)));
typedef unsigned u32x4 __attribute__((ext_vector_type(4)));
typedef unsigned u32x2 __attribute__((ext_vector_type(2)));
constexpr int BM = 256, BK = 64, HALF = 128, HTB = HALF * BK * 2, STAGE_BYTES = 8 * HTB, NXCD = 8, WGM = 8;

__host__ __device__ __forceinline__ int lds_byte(int r, int c) { const int st = (r >> 4) * 2 + (c >> 5), rr = r & 15, cc = c & 31, ob = rr * 64 + cc * 2; return st * 1024 + (ob ^ (((ob >> 9) & 1) << 5)); }
__host__ __device__ __forceinline__ void stage_rc(int b, int& R, int& C) { const int st = b / 1024, sb = b % 1024, swz = sb ^ (((sb >> 9) & 1) << 5); R = (st >> 1) * 16 + swz / 64; C = (st & 1) * 32 + (swz % 64) / 2; }
__host__ __device__ __forceinline__ int perm32(int rho) { const int n = rho >> 4, i = rho & 15; return 8 * (i >> 2) + 4 * n + (i & 3); }

struct Unit { int pm, pn, rh; };
struct Gemm { const bf16_t* A; const bf16_t* Bt; int M, N, K, lda, ldb, ash, amul; };

struct StaticOrder {
    int nM, nN, nwg, G, c, limit;
    __host__ __device__ void init(int M, int N, int G_, int c_) { nM = M / BM; nN = N / BM; nwg = nM * nN; G = G_; c = c_; limit = nwg; }
    __host__ __device__ void map(int L, Unit& u) const {
        int wgid = L; { const int q = nwg / NXCD, r = nwg % NXCD, xcd = wgid % NXCD, off = wgid / NXCD; wgid = (xcd < r ? xcd * (q + 1) : r * (q + 1) + (xcd - r) * q) + off; }
        const int nig = WGM * nN, gid = wgid / nig, fm = gid * WGM, gsz = (nM - fm) < WGM ? (nM - fm) : WGM;
        u.pm = fm + ((wgid % nig) % gsz); u.pn = (wgid % nig) / gsz; u.rh = 0;
    }
    __host__ __device__ bool next(int i, Unit& u) const {
        const long L = (long)i * G + c; if (L >= limit) return false;
        map((int)L, u); return true;
    }
};

__device__ __forceinline__ unsigned cvt_pk_bf16(float lo, float hi) { unsigned r; asm volatile("v_cvt_pk_bf16_f32 %0, %1, %2" : "=v"(r) : "v"(lo), "v"(hi)); return r; }
__device__ __forceinline__ float bf_lo(unsigned w) { return __uint_as_float(w << 16); }
__device__ __forceinline__ float bf_hi(unsigned w) { return __uint_as_float(w & 0xffff0000u); }
__device__ __forceinline__ float sigmoidf_(float x) { return __builtin_amdgcn_rcpf(1.0f + __expf(-x)); }
__device__ __forceinline__ float gelu_tanh_(float x) { const float z = 1.5957691216057308f * (x + 0.044715f * x * x * x); return x * sigmoidf_(z); }
__device__ __forceinline__ u32x4 pack8(const f32x4 a, const f32x4 b) { u32x4 w; w.x = cvt_pk_bf16(a[0], a[1]); w.y = cvt_pk_bf16(a[2], a[3]); w.z = cvt_pk_bf16(b[0], b[1]); w.w = cvt_pk_bf16(b[2], b[3]); return w; }
__device__ __forceinline__ void unpack8(const u32x4 w, f32x4& a, f32x4& b) { a = (f32x4){bf_lo(w.x), bf_hi(w.x), bf_lo(w.y), bf_hi(w.y)}; b = (f32x4){bf_lo(w.z), bf_hi(w.z), bf_lo(w.w), bf_hi(w.w)}; }

#define EPI_ROWS_BEGIN _Pragma("unroll") for (int ai = 0; ai < NAI; ++ai) _Pragma("unroll") for (int m = 0; m < 4; ++m) { const int row = u.pm * BM + u.rh + ai * HALF + wr * 64 + m * 16 + fr;
#define EPI_ROWS_END }

struct EpiProj {
    bf16_t *UP, *UR, *UG, *G0, *G1;
    template <int NAI> __device__ __forceinline__ void run(const f32x4 (&acc)[2][2][4][2], const Unit& u, int wr, int wc, int fr, int fq) const {
        const int pn = u.pn; bf16_t* base; int ldc, colt, act;
        if (pn < 2) { base = UP; ldc = 512; colt = pn * 256; act = 0; }
        else if (pn < 6) { base = UR; ldc = 1024; colt = (pn - 2) * 256; act = 0; }
        else if (pn < 10) { base = UG; ldc = 1024; colt = (pn - 6) * 256; act = 0; }
        else if (pn < 14) { base = G0; ldc = 1024; colt = (pn - 10) * 256; act = 2; }
        else { base = G1; ldc = 1024; colt = (pn - 14) * 256; act = 2; }
        const int col0 = colt + wc * 32 + 8 * fq;
        EPI_ROWS_BEGIN
            bf16_t* rowp = base + (unsigned)((unsigned)row * (unsigned)ldc + (unsigned)col0);
#pragma unroll
            for (int bj = 0; bj < 2; ++bj) { f32x4 v0 = acc[ai][bj][m][0], v1 = acc[ai][bj][m][1];
                if (act == 1) {
#pragma unroll
                    for (int j = 0; j < 4; ++j) { v0[j] = gelu_tanh_(v0[j]); v1[j] = gelu_tanh_(v1[j]); } }
                else if (act == 2) {
#pragma unroll
                    for (int j = 0; j < 4; ++j) { v0[j] = sigmoidf_(v0[j]); v1[j] = sigmoidf_(v1[j]); } }
                *(u32x4*)(rowp + bj * HALF) = pack8(v0, v1); }
        EPI_ROWS_END
    }
};
struct EpiGrp {
    bf16_t* O; int ldc; const float* scale;
    template <int NAI> __device__ __forceinline__ void run(const f32x4 (&acc)[2][2][4][2], const Unit& u, int wr, int wc, int fr, int fq) const {
        const int col0 = u.pn * BM + wc * 32 + 8 * fq;
        f32x4 sc[2][2];
#pragma unroll
        for (int bj = 0; bj < 2; ++bj)
#pragma unroll
            for (int n = 0; n < 2; ++n) sc[bj][n] = *(const f32x4*)(scale + col0 + bj * HALF + 4 * n);
        EPI_ROWS_BEGIN
            bf16_t* rowp = O + (unsigned)((unsigned)row * (unsigned)ldc + (unsigned)col0);
#pragma unroll
            for (int bj = 0; bj < 2; ++bj) *(u32x4*)(rowp + bj * HALF) = pack8(acc[ai][bj][m][0] * sc[bj][0], acc[ai][bj][m][1] * sc[bj][1]);
        EPI_ROWS_END
    }
};
struct EpiGate {
    const bf16_t* V; bf16_t *LA, *BB; const float *b_a, *b_x, *sp8;
    template <int NAI> __device__ __forceinline__ void run(const f32x4 (&acc)[2][2][4][2], const Unit& u, int wr, int wc, int fr, int fq) const {
        const int ch0 = u.pn * 128 + wc * 32 + 8 * fq;
        f32x4 ba[2], bx[2], sp[2];
#pragma unroll
        for (int n = 0; n < 2; ++n) { ba[n] = *(const f32x4*)(b_a + ch0 + 4 * n); bx[n] = *(const f32x4*)(b_x + ch0 + 4 * n); sp[n] = *(const f32x4*)(sp8 + ch0 + 4 * n); }
        EPI_ROWS_BEGIN
            const unsigned off = (unsigned)row * 1024u + (unsigned)ch0;
            const u32x4 vw = *(const u32x4*)(V + off); f32x4 vv[2]; unpack8(vw, vv[0], vv[1]);
            f32x4 la[2], bb[2];
#pragma unroll
            for (int n = 0; n < 2; ++n)
#pragma unroll
                for (int j = 0; j < 4; ++j) {
                    const float r = sigmoidf_(acc[ai][0][m][n][j] + ba[n][j]), ig = sigmoidf_(acc[ai][1][m][n][j] + bx[n][j]);
                    const float l = sp[n][j] * r, x2 = 2.0f * l;
                    const float em1 = (x2 > -0.125f) ? x2 * (1.0f + 0.5f * x2 * (1.0f + 0.33333334f * x2 * (1.0f + 0.25f * x2 * (1.0f + 0.2f * x2)))) : (__expf(x2) - 1.0f);
                    la[n][j] = l; bb[n][j] = __builtin_amdgcn_sqrtf(fmaxf(-em1, 0.f)) * ig * vv[n][j]; }
            *(u32x4*)(LA + off) = pack8(la[0], la[1]); *(u32x4*)(BB + off) = pack8(bb[0], bb[1]);
            asm volatile("" ::: "memory");
        EPI_ROWS_END
    }
};
struct EpiMix {
    const bf16_t *G0, *G1; bf16_t* MIXB;
    __device__ __forceinline__ void mid(f32x4 (&acc)[2][2][4][2], const Unit& u0, int wr, int wc, int fr, int fq) const {
        constexpr int NAI = 2; Unit u = u0; asm volatile("" : "+s"(u.pm), "+s"(u.pn));
        const int col0 = u.pn * BM + wc * 32 + 8 * fq;
        EPI_ROWS_BEGIN
            const unsigned off = (unsigned)row * 1024u + (unsigned)col0;
#pragma unroll
            for (int bj = 0; bj < 2; ++bj) { f32x4 g0[2], g1[2]; unpack8(*(const u32x4*)(G0 + off + bj * HALF), g0[0], g0[1]); unpack8(*(const u32x4*)(G1 + off + bj * HALF), g1[0], g1[1]);
#pragma unroll
                for (int n = 0; n < 2; ++n)
#pragma unroll
                    for (int j = 0; j < 4; ++j) acc[ai][bj][m][n][j] *= g0[n][j] * __builtin_amdgcn_rcpf(fmaxf(g1[n][j], 1e-30f)); }
        EPI_ROWS_END
    }
    template <int NAI> __device__ __forceinline__ void run(const f32x4 (&acc)[2][2][4][2], const Unit& u, int wr, int wc, int fr, int fq) const {
        const int col0 = u.pn * BM + wc * 32 + 8 * fq;
        EPI_ROWS_BEGIN
            const unsigned off = (unsigned)row * 1024u + (unsigned)col0;
#pragma unroll
            for (int bj = 0; bj < 2; ++bj) { f32x4 g[2]; unpack8(*(const u32x4*)(G1 + off + bj * HALF), g[0], g[1]);
                *(u32x4*)(MIXB + off + bj * HALF) = pack8(g[0] * acc[ai][bj][m][0], g[1] * acc[ai][bj][m][1]); }
        EPI_ROWS_END
    }
};
struct EpiRes1 {
    const float* X; bf16_t* X1B; float* SSQ;
    template <int NAI> __device__ __forceinline__ void run(const f32x4 (&acc)[2][2][4][2], const Unit& u, int wr, int wc, int fr, int fq) const {
        const int col0 = u.pn * BM + wc * 32 + 8 * fq;
        EPI_ROWS_BEGIN
            const unsigned off = (unsigned)row * 1024u + (unsigned)col0; float ss = 0.f;
#pragma unroll
            for (int bj = 0; bj < 2; ++bj) {
                const f32x4 a = *(const f32x4*)(X + off + bj * HALF) + acc[ai][bj][m][0], b = *(const f32x4*)(X + off + bj * HALF + 4) + acc[ai][bj][m][1];
                *(u32x4*)(X1B + off + bj * HALF) = pack8(a, b);
                ss += (a[0] * a[0] + a[1] * a[1]) + (a[2] * a[2] + a[3] * a[3]) + (b[0] * b[0] + b[1] * b[1]) + (b[2] * b[2] + b[3] * b[3]); }
            ss += __shfl_xor(ss, 16); ss += __shfl_xor(ss, 32);
            if (fq == 0) SSQ[(unsigned)row * 16u + (unsigned)(u.pn * 4 + wc)] = ss;
        EPI_ROWS_END
    }
};
struct EpiSwiglu {
    const float* SSQ; bf16_t* ACT;
    template <int NAI> __device__ __forceinline__ void run(const f32x4 (&acc)[2][2][4][2], const Unit& u, int wr, int wc, int fr, int fq) const {
        const int col0 = u.pn * 128 + wc * 32 + 8 * fq;
        EPI_ROWS_BEGIN
            const f32x4 st = *(const f32x4*)(SSQ + (unsigned)row * 16u + (unsigned)(4 * fq));
            float sq = (st[0] + st[1]) + (st[2] + st[3]); sq += __shfl_xor(sq, 16); sq += __shfl_xor(sq, 32);
            const float rs = __builtin_amdgcn_rsqf(sq * (1.0f / 1024.0f) + 1e-6f);
            f32x4 o[2];
#pragma unroll
            for (int n = 0; n < 2; ++n)
#pragma unroll
                for (int j = 0; j < 4; ++j) { const float g = acc[ai][0][m][n][j] * rs, up = acc[ai][1][m][n][j] * rs; o[n][j] = g * sigmoidf_(g) * up; }
            *(u32x4*)(ACT + (unsigned)((unsigned)row * 2816u + (unsigned)col0)) = pack8(o[0], o[1]);
        EPI_ROWS_END
    }
};
struct EpiRes2 {
    const bf16_t* X1B; float* OUT;
    template <int NAI> __device__ __forceinline__ void run(const f32x4 (&acc)[2][2][4][2], const Unit& u, int wr, int wc, int fr, int fq) const {
        const int col0 = u.pn * BM + wc * 32 + 8 * fq;
        EPI_ROWS_BEGIN
            const unsigned off = (unsigned)row * 1024u + (unsigned)col0;
#pragma unroll
            for (int bj = 0; bj < 2; ++bj) { f32x4 xa, xb; unpack8(*(const u32x4*)(X1B + off + bj * HALF), xa, xb);
                *(f32x4*)(OUT + off + bj * HALF) = xa + acc[ai][bj][m][0]; *(f32x4*)(OUT + off + bj * HALF + 4) = xb + acc[ai][bj][m][1]; }
        EPI_ROWS_END
    }
};

struct EpiFinal {
    const bf16_t* X1B; float* OUT; float* SSQ2; unsigned* cnt; const float* gfin;
    template <int NAI> __device__ __forceinline__ void run(f32x4 (&acc)[2][2][4][2], const Unit& u, int wr, int wc, int fr, int fq) const {
        const int col0 = u.pn * BM + wc * 32 + 8 * fq;
        EPI_ROWS_BEGIN
            const unsigned off = (unsigned)row * 1024u + (unsigned)col0; float ss = 0.f;
#pragma unroll
            for (int bj = 0; bj < 2; ++bj) { f32x4 xa, xb; unpack8(*(const u32x4*)(X1B + off + bj * HALF), xa, xb);
                const f32x4 a = xa + acc[ai][bj][m][0], b = xb + acc[ai][bj][m][1]; acc[ai][bj][m][0] = a; acc[ai][bj][m][1] = b;
                ss += (a[0] * a[0] + a[1] * a[1]) + (a[2] * a[2] + a[3] * a[3]) + (b[0] * b[0] + b[1] * b[1]) + (b[2] * b[2] + b[3] * b[3]); }
            ss += __shfl_xor(ss, 16); ss += __shfl_xor(ss, 32);
            if (fq == 0) __hip_atomic_store(SSQ2 + (unsigned)row * 16u + (unsigned)(u.pn * 4 + wc), ss, __ATOMIC_RELAXED, __HIP_MEMORY_SCOPE_AGENT);
        EPI_ROWS_END
        asm volatile("s_waitcnt vmcnt(0)" ::: "memory");
        unsigned* c = cnt + 64 * u.pm;
        if ((threadIdx.x & 63) == 0) __hip_atomic_fetch_add(c, 1u, __ATOMIC_RELAXED, __HIP_MEMORY_SCOPE_AGENT);
        { unsigned sp = 0;
          while ((unsigned)__builtin_amdgcn_readfirstlane(__hip_atomic_load(c, __ATOMIC_RELAXED, __HIP_MEMORY_SCOPE_AGENT)) < 32u) { __builtin_amdgcn_s_sleep(2); if (++sp > (1u << 20)) break; } }
        __builtin_amdgcn_fence(__ATOMIC_ACQUIRE, "agent");
        f32x4 gv[2][2];
#pragma unroll
        for (int bj = 0; bj < 2; ++bj)
#pragma unroll
            for (int n = 0; n < 2; ++n) gv[bj][n] = *(const f32x4*)(gfin + col0 + bj * HALF + 4 * n);
        EPI_ROWS_BEGIN
            const unsigned off = (unsigned)row * 1024u + (unsigned)col0;
            const unsigned long long* sl = (const unsigned long long*)(SSQ2 + (unsigned)row * 16u + (unsigned)(4 * fq));
            const unsigned long long w0 = __hip_atomic_load(sl, __ATOMIC_RELAXED, __HIP_MEMORY_SCOPE_AGENT), w1 = __hip_atomic_load(sl + 1, __ATOMIC_RELAXED, __HIP_MEMORY_SCOPE_AGENT);
            float sq = (__uint_as_float((unsigned)w0) + __uint_as_float((unsigned)(w0 >> 32))) + (__uint_as_float((unsigned)w1) + __uint_as_float((unsigned)(w1 >> 32)));
            sq += __shfl_xor(sq, 16); sq += __shfl_xor(sq, 32);
            const float rs = 1.0f / sqrtf(sq * (1.0f / 1024.0f) + 1e-6f);
#pragma unroll
            for (int bj = 0; bj < 2; ++bj) { *(f32x4*)(OUT + off + bj * HALF) = acc[ai][bj][m][0] * rs * gv[bj][0]; *(f32x4*)(OUT + off + bj * HALF + 4) = acc[ai][bj][m][1] * rs * gv[bj][1]; }
        EPI_ROWS_END
    }
};

template <class Epi, bool ALIGN_EPI, int MID_T = -1>
__device__ __forceinline__ void gemm_phase(PG8_LAS unsigned char* lds, const Gemm g, const StaticOrder& S, const Epi& E) {
    const int tid = threadIdx.x, wid = __builtin_amdgcn_readfirstlane(tid >> 6), lane = tid & 63, wr = wid >> 2, wc = wid & 3, fr = lane & 15, fq = lane >> 4;
    int nt = g.K / BK; asm volatile("" : "+s"(nt));
    unsigned voffA[2], voffB[2];
#pragma unroll
    for (int i = 0; i < 2; ++i) { int R, C; stage_rc(tid * 16 + i * 8192, R, C); const int Rb = (R & ~31) + perm32(R & 31);
        voffA[i] = (unsigned)(R * g.lda + C) * 2u; voffB[i] = (unsigned)(Rb * g.ldb + C) * 2u; }
    const size_t kstep = (size_t)(BK * 2);
    const size_t hstepA = (size_t)HALF * g.lda * 2, hstepB = (size_t)HALF * g.ldb * 2;
    const size_t tstepA = 2 * hstepA, tstepB = 2 * hstepB;
    const unsigned ldsw = (unsigned)wid * 1024u;
    const int aoff = lds_byte(wr * 64 + fr, fq * 8), boff = lds_byte(wc * 32 + fr, fq * 8);
#define PG8_SA(b, h) (((b) * 2 + (h)) * HTB)
#define PG8_SB(b, h) ((4 + (b) * 2 + (h)) * HTB)
#define PG8_STAGE(bufoff, gbase, voff) do { _Pragma("unroll") for (int _i = 0; _i < 2; ++_i) \
        __builtin_amdgcn_global_load_lds((const unsigned*)((const char*)(gbase) + (voff)[_i]), (PG8_LAS unsigned*)(lds + (bufoff) + ldsw + _i * 8192), 16, 0, 0); } while (0)
#define PG8_LDA(dst, b, h) do { _Pragma("unroll") for (int m = 0; m < 4; ++m) _Pragma("unroll") for (int k = 0; k < 2; ++k) dst[m][k] = *(const PG8_LAS bf16x8*)(lds + PG8_SA(b, h) + aoff + m * 2048 + k * 1024); } while (0)
#define PG8_LDB(dst, b, h) do { _Pragma("unroll") for (int n = 0; n < 2; ++n) _Pragma("unroll") for (int k = 0; k < 2; ++k) dst[n][k] = *(const PG8_LAS bf16x8*)(lds + PG8_SB(b, h) + boff + n * 2048 + k * 1024); } while (0)
#define PG8_MMA(ai, bj, At, Bt) do { __builtin_amdgcn_s_setprio(1); _Pragma("unroll") for (int m = 0; m < 4; ++m) _Pragma("unroll") for (int n = 0; n < 2; ++n) _Pragma("unroll") for (int k = 0; k < 2; ++k) \
        acc[ai][bj][m][n] = __builtin_amdgcn_mfma_f32_16x16x32_bf16(Bt[n][k], At[m][k], acc[ai][bj][m][n], 0, 0, 0); __builtin_amdgcn_s_setprio(0); } while (0)
#define PG8_WAIT_V(n) asm volatile("s_waitcnt vmcnt(" #n ")" ::: "memory")
#define PG8_WAIT_L(n) asm volatile("s_waitcnt lgkmcnt(" #n ")" ::: "memory")
#define PG8_BAR __builtin_amdgcn_s_barrier()
#define PG8_SCHED __builtin_amdgcn_sched_barrier(0)
    Unit cur, nxt; int ui = 0;
    if (!S.next(0, cur)) return;
    f32x4 acc[2][2][4][2];
#pragma unroll
    for (int a = 0; a < 2; ++a)
#pragma unroll
        for (int b = 0; b < 2; ++b)
#pragma unroll
            for (int m = 0; m < 4; ++m)
#pragma unroll
                for (int n = 0; n < 2; ++n) acc[a][b][m][n] = (f32x4){0.f, 0.f, 0.f, 0.f};
    bf16x8 At[4][2], B0[2][2], B1[2][2];
    const char* cA = (const char*)g.A + (size_t)cur.pm * tstepA + (size_t)((cur.pn >> g.ash) * g.amul) * 2; const char* cB = (const char*)g.Bt + (size_t)cur.pn * tstepB;
    PG8_STAGE(PG8_SB(0, 0), cB, voffB); PG8_STAGE(PG8_SB(0, 1), cB + hstepB, voffB); PG8_STAGE(PG8_SA(0, 0), cA, voffA); PG8_STAGE(PG8_SA(0, 1), cA + hstepA, voffA);
    if (wr == 1) PG8_BAR;
    PG8_WAIT_V(2); PG8_BAR;
    PG8_STAGE(PG8_SB(1, 0), cB + kstep, voffB); PG8_STAGE(PG8_SA(1, 0), cA + kstep, voffA); PG8_STAGE(PG8_SB(1, 1), cB + hstepB + kstep, voffB);
    PG8_WAIT_V(6); PG8_BAR;
    for (;;) {
        const bool has_next = S.next(ui + 1, nxt);
        const char* nA = has_next ? (const char*)g.A + (size_t)nxt.pm * tstepA + (size_t)((nxt.pn >> g.ash) * g.amul) * 2 : cA; const char* nB = has_next ? (const char*)g.Bt + (size_t)nxt.pn * tstepB : cB;
        for (int t = 0; t < nt; t += 2) {
            const bool last = (t == nt - 2);
            if constexpr (MID_T >= 0) { if (t == MID_T) E.mid(acc, cur, wr, wc, fr, fq); }
            const char* a1 = cA + (size_t)(t + 1) * kstep;
            const char* a2 = last ? nA : cA + (size_t)(t + 2) * kstep; const char* b2 = last ? nB : cB + (size_t)(t + 2) * kstep;
            const char* a3 = a2 + kstep; const char* b3 = b2 + kstep;
            PG8_LDB(B0, 0, 0); PG8_LDB(B1, 0, 1); PG8_SCHED; PG8_LDA(At, 0, 0); PG8_STAGE(PG8_SA(1, 1), a1 + hstepA, voffA);
            PG8_WAIT_V(8); PG8_WAIT_L(0); PG8_BAR; PG8_MMA(0, 0, At, B0); PG8_MMA(0, 1, At, B1); PG8_BAR; PG8_SCHED;
            PG8_LDA(At, 0, 1); PG8_STAGE(PG8_SB(0, 0), b2, voffB); PG8_STAGE(PG8_SB(0, 1), b2 + hstepB, voffB); PG8_STAGE(PG8_SA(0, 0), a2, voffA);
            PG8_WAIT_V(8); PG8_WAIT_L(0); PG8_BAR; PG8_MMA(1, 0, At, B0); PG8_MMA(1, 1, At, B1); PG8_BAR; PG8_SCHED;
            PG8_LDB(B0, 1, 0); PG8_LDB(B1, 1, 1); PG8_SCHED; PG8_LDA(At, 1, 0); PG8_STAGE(PG8_SA(0, 1), a2 + hstepA, voffA);
            PG8_WAIT_V(8); PG8_WAIT_L(0); PG8_BAR; PG8_MMA(0, 0, At, B0); PG8_MMA(0, 1, At, B1); PG8_BAR; PG8_SCHED;
            PG8_LDA(At, 1, 1); PG8_STAGE(PG8_SB(1, 0), b3, voffB); PG8_STAGE(PG8_SB(1, 1), b3 + hstepB, voffB); PG8_STAGE(PG8_SA(1, 0), a3, voffA);
            PG8_WAIT_V(8); PG8_WAIT_L(0); PG8_BAR; PG8_MMA(1, 0, At, B0); PG8_MMA(1, 1, At, B1); PG8_BAR; PG8_SCHED;
        }
        if constexpr (ALIGN_EPI) { if (wr == 0) PG8_BAR; }
        E.template run<2>(acc, cur, wr, wc, fr, fq);
        if (!has_next) break;
#pragma unroll
        for (int a = 0; a < 2; ++a)
#pragma unroll
            for (int b = 0; b < 2; ++b)
#pragma unroll
                for (int m = 0; m < 4; ++m)
#pragma unroll
                    for (int n = 0; n < 2; ++n) acc[a][b][m][n] = (f32x4){0.f, 0.f, 0.f, 0.f};
        cur = nxt; cA = nA; cB = nB; ++ui;
        if constexpr (ALIGN_EPI) { if (wr == 1) PG8_BAR; }
    }
    PG8_WAIT_V(0);
    if constexpr (!ALIGN_EPI) { if (wr == 0) PG8_BAR; }
    PG8_BAR;
#undef PG8_SA
#undef PG8_SB
#undef PG8_STAGE
#undef PG8_LDA
#undef PG8_LDB
#undef PG8_MMA
#undef PG8_WAIT_V
#undef PG8_WAIT_L
#undef PG8_BAR
#undef PG8_SCHED
}

template <class Epi>
__device__ __forceinline__ void gemm_half(PG8_LAS unsigned char* lds, const Gemm g, const Unit u, const Epi& E) {
    const int tid = threadIdx.x, wid = __builtin_amdgcn_readfirstlane(tid >> 6), lane = tid & 63, wr = wid >> 2, wc = wid & 3, fr = lane & 15, fq = lane >> 4;
    int nt = g.K / BK; asm volatile("" : "+s"(nt));
    unsigned voffA[2], voffB[2];
#pragma unroll
    for (int i = 0; i < 2; ++i) { int R, C; stage_rc(tid * 16 + i * 8192, R, C); const int Rb = (R & ~31) + perm32(R & 31);
        voffA[i] = (unsigned)(R * g.lda + C) * 2u; voffB[i] = (unsigned)(Rb * g.ldb + C) * 2u; }
    const size_t kstep = (size_t)(BK * 2);
    const size_t hstepA = (size_t)HALF * g.lda * 2, hstepB = (size_t)HALF * g.ldb * 2;
    const unsigned ldsw = (unsigned)wid * 1024u;
    const int aoff = lds_byte(wr * 64 + fr, fq * 8), boff = lds_byte(wc * 32 + fr, fq * 8);
#define PG8_SA(b, h) (((b) * 2 + (h)) * HTB)
#define PG8_SB(b, h) ((4 + (b) * 2 + (h)) * HTB)
#define PG8_STAGE(bufoff, gbase, voff) do { _Pragma("unroll") for (int _i = 0; _i < 2; ++_i) \
        __builtin_amdgcn_global_load_lds((const unsigned*)((const char*)(gbase) + (voff)[_i]), (PG8_LAS unsigned*)(lds + (bufoff) + ldsw + _i * 8192), 16, 0, 0); } while (0)
#define PG8_LDA(dst, b, h) do { _Pragma("unroll") for (int m = 0; m < 4; ++m) _Pragma("unroll") for (int k = 0; k < 2; ++k) dst[m][k] = *(const PG8_LAS bf16x8*)(lds + PG8_SA(b, h) + aoff + m * 2048 + k * 1024); } while (0)
#define PG8_LDB(dst, b, h) do { _Pragma("unroll") for (int n = 0; n < 2; ++n) _Pragma("unroll") for (int k = 0; k < 2; ++k) dst[n][k] = *(const PG8_LAS bf16x8*)(lds + PG8_SB(b, h) + boff + n * 2048 + k * 1024); } while (0)
#define PG8_MMA(ai, bj, At, Bt) do { __builtin_amdgcn_s_setprio(1); _Pragma("unroll") for (int m = 0; m < 4; ++m) _Pragma("unroll") for (int n = 0; n < 2; ++n) _Pragma("unroll") for (int k = 0; k < 2; ++k) \
        acc[ai][bj][m][n] = __builtin_amdgcn_mfma_f32_16x16x32_bf16(Bt[n][k], At[m][k], acc[ai][bj][m][n], 0, 0, 0); __builtin_amdgcn_s_setprio(0); } while (0)
#define PG8_WAIT_V(n) asm volatile("s_waitcnt vmcnt(" #n ")" ::: "memory")
#define PG8_WAIT_L(n) asm volatile("s_waitcnt lgkmcnt(" #n ")" ::: "memory")
#define PG8_BAR __builtin_amdgcn_s_barrier()
#define PG8_SCHED __builtin_amdgcn_sched_barrier(0)
    f32x4 acc[2][2][4][2];
#pragma unroll
    for (int a = 0; a < 2; ++a)
#pragma unroll
        for (int b = 0; b < 2; ++b)
#pragma unroll
            for (int m = 0; m < 4; ++m)
#pragma unroll
                for (int n = 0; n < 2; ++n) acc[a][b][m][n] = (f32x4){0.f, 0.f, 0.f, 0.f};
    bf16x8 At[4][2], B0[2][2], B1[2][2];
    const char* cA = (const char*)g.A + ((size_t)u.pm * BM + u.rh) * g.lda * 2 + (size_t)((u.pn >> g.ash) * g.amul) * 2; const char* cB = (const char*)g.Bt + (size_t)u.pn * 2 * hstepB;
    PG8_STAGE(PG8_SB(0, 0), cB, voffB); PG8_STAGE(PG8_SB(0, 1), cB + hstepB, voffB); PG8_STAGE(PG8_SA(0, 0), cA, voffA);
    PG8_STAGE(PG8_SB(1, 0), cB + kstep, voffB); PG8_STAGE(PG8_SB(1, 1), cB + hstepB + kstep, voffB); PG8_STAGE(PG8_SA(1, 0), cA + kstep, voffA);
    PG8_WAIT_V(6); PG8_BAR;
#define PG8_HALF_STEP(b, tt) do { \
        PG8_LDB(B0, b, 0); PG8_LDB(B1, b, 1); PG8_LDA(At, b, 0); PG8_WAIT_L(0); PG8_BAR; PG8_SCHED; \
        const bool more_ = (tt) + 2 < nt; \
        if (more_) { const char* b2 = cB + (size_t)((tt) + 2) * kstep; const char* a2 = cA + (size_t)((tt) + 2) * kstep; \
            PG8_STAGE(PG8_SB(b, 0), b2, voffB); PG8_STAGE(PG8_SB(b, 1), b2 + hstepB, voffB); PG8_STAGE(PG8_SA(b, 0), a2, voffA); } \
        PG8_MMA(0, 0, At, B0); PG8_MMA(0, 1, At, B1); \
        if (more_) PG8_WAIT_V(6); else PG8_WAIT_V(0); \
        PG8_BAR; PG8_SCHED; } while (0)
    for (int t = 0; t < nt; t += 2) { PG8_HALF_STEP(0, t); PG8_HALF_STEP(1, t + 1); }
    E.template run<1>(acc, u, wr, wc, fr, fq);
    PG8_BAR;
#undef PG8_HALF_STEP
#undef PG8_SA
#undef PG8_SB
#undef PG8_STAGE
#undef PG8_LDA
#undef PG8_LDB
#undef PG8_MMA
#undef PG8_WAIT_V
#undef PG8_WAIT_L
#undef PG8_BAR
#undef PG8_SCHED
}
}

constexpr int NWAVES = 8, NTHR = 512;
constexpr int M = 16384, SEQ = 4096, NB = 4, D = 1024, DPOOL = 512, DRNN = 1024, DIN = 4608, DFF = 2816;
constexpr float EPS = 1e-6f;
constexpr int NPH = 11;
constexpr int SCAN_T = 128, SCAN_NC = SEQ / SCAN_T;

constexpr size_t MiB = 1u << 20;
constexpr size_t WS_SP8 = 512 * 1024;
constexpr size_t WS_SSQ = 1 * MiB;
constexpr size_t WS_SSQ2 = 2 * MiB;
constexpr size_t WS_CS = 2 * MiB, WS_CH = 3 * MiB;
constexpr size_t WS_WIN = 4 * MiB;
constexpr size_t WS_WFI = 13 * MiB;
constexpr size_t WS_WFO = 24 * MiB;
constexpr size_t WS_WCAT = WS_WFO + 5632 * 1024;
constexpr size_t WS_WO = WS_WCAT + 3 * MiB;
constexpr size_t WS_WGRP = WS_WO + 2 * MiB;
constexpr size_t WS_WGATE = WS_WGRP + MiB / 4;
constexpr size_t WS_R1 = 36 * MiB;
constexpr size_t WS_R2 = 68 * MiB;
constexpr size_t WS_R3 = 84 * MiB;
constexpr size_t WS_R4 = 116 * MiB;
constexpr size_t WS_R7 = 148 * MiB;
constexpr size_t WS_R8 = 164 * MiB;
constexpr size_t WS_CAT = 196 * MiB;
constexpr size_t WS_MIXB = 148 * MiB;
constexpr size_t WS_ACT = 68 * MiB;
constexpr size_t WS_END = 244 * MiB;

constexpr int LDS_BYTES = 147456;

#define LAS __attribute__((address_space(3)))
typedef unsigned short bf16;
typedef unsigned v4u __attribute__((ext_vector_type(4)));
typedef unsigned v2u __attribute__((ext_vector_type(2)));
typedef float f32x4 __attribute__((ext_vector_type(4)));
typedef float f32x2 __attribute__((ext_vector_type(2)));
#define LDS_WAIT() asm volatile("s_waitcnt lgkmcnt(0)" ::: "memory")
using pg8::cvt_pk_bf16; using pg8::bf_lo; using pg8::bf_hi;

struct Args { const float* in[19]; float* out; unsigned char* ws; int ph_lo, ph_hi; };
enum { I_X = 0, I_NORM_MIX, I_W_IN, I_W_GRP, I_POOL_SCALE, I_W_POOL_OUT, I_CONV_W, I_CONV_B, I_W_RG_A, I_B_RG_A, I_W_RG_X, I_B_RG_X, I_LAMBDA, I_W_RNN_OUT, I_W_O, I_NORM_FFN, I_W_FFN_IN, I_W_FFN_OUT, I_NORM_FINAL };

__device__ __forceinline__ float wave_sum(float v) {
#pragma unroll
    for (int o = 1; o < 64; o <<= 1) v += __shfl_xor(v, o);
    return v;
}

__device__ __forceinline__ void transpose_item(const float* W, int Nsrc, int Kdst, bf16* WT, int k0, int n_src0, int n_dst0, const float* kscale, LAS float* scr, int lane) {
    f32x4 v[8]; const int n4 = (lane & 7) * 4;
#pragma unroll
    for (int i = 0; i < 8; ++i) { const int kk = 8 * i + (lane >> 3); v[i] = *(const f32x4*)(W + (size_t)(k0 + kk) * Nsrc + n_src0 + n4); }
    if (kscale) {
#pragma unroll
        for (int i = 0; i < 8; ++i) v[i] = v[i] * kscale[k0 + 8 * i + (lane >> 3)]; }
#pragma unroll
    for (int i = 0; i < 8; ++i) { const int kk = 8 * i + (lane >> 3);
#pragma unroll
        for (int j = 0; j < 4; ++j) scr[kk * 33 + n4 + j] = v[i][j]; }
    LDS_WAIT(); asm volatile("" ::: "memory");
    const int c = lane & 7;
#pragma unroll
    for (int j = 0; j < 4; ++j) { const int n = (lane >> 3) + 8 * j; const LAS float* s = scr + (8 * c) * 33 + n;
        v4u o; o.x = cvt_pk_bf16(s[0 * 33], s[1 * 33]); o.y = cvt_pk_bf16(s[2 * 33], s[3 * 33]); o.z = cvt_pk_bf16(s[4 * 33], s[5 * 33]); o.w = cvt_pk_bf16(s[6 * 33], s[7 * 33]);
        *(v4u*)(WT + (size_t)(n_dst0 + n) * Kdst + k0 + 8 * c) = o; }
    LDS_WAIT(); asm volatile("" ::: "memory");
}

#define XB_TMO      128
#define XB_XCNT(j)  (256  + 64 * (j))
#define XB_XSUB(j)  (1280 + 64 * (j))
#define XB_XGEN(j)  (2304 + 64 * (j))
#define XB_TOP      3328
#define XB_TOPGEN   3392
#define XCD_BAR_WORDS 3456
#define XB_SPIN_CAP (1u << 18)
__device__ __forceinline__ unsigned xb_ld(unsigned* p)              { return __hip_atomic_load(p, __ATOMIC_RELAXED, __HIP_MEMORY_SCOPE_AGENT); }
__device__ __forceinline__ unsigned xb_add(unsigned* p, unsigned v) { return __hip_atomic_fetch_add(p, v, __ATOMIC_RELAXED, __HIP_MEMORY_SCOPE_AGENT); }
__device__ __forceinline__ unsigned xb_xcc_id() { return (unsigned)__builtin_amdgcn_s_getreg((3 << 11) | 20) & 0xFu; }
#define XB_SPIN(cond, bar) do { unsigned _sp = 0; while (cond) { __builtin_amdgcn_s_sleep(1); \
    if ((++_sp & 255u) == 0u) { if (xb_ld(&(bar)[XB_TMO])) break; if (_sp > XB_SPIN_CAP) { atomicAdd(&(bar)[XB_TMO], 1u); break; } } } } while (0)
struct XcdBarrier { unsigned* bar; unsigned x; volatile LAS unsigned* st; };
__device__ __forceinline__ XcdBarrier xcd_barrier_post(unsigned* bar, volatile LAS unsigned* st) {
    XcdBarrier b; b.bar = bar; b.x = xb_xcc_id(); b.st = st;
    if (threadIdx.x == 0) (void)xb_add(&bar[XB_XCNT(b.x)], 1u);
    return b;
}
__device__ __forceinline__ void xcd_barrier_complete(unsigned* bar, unsigned x, unsigned& nloc, unsigned& nx) {
    const unsigned G = gridDim.x * gridDim.y * gridDim.z;
    unsigned sum, cnt, mine, sp = 0u;
    for (;;) {
        sum = 0u; cnt = 0u; mine = 0u;
#pragma unroll
        for (unsigned j = 0; j < 16; ++j) { const unsigned c = xb_ld(&bar[XB_XCNT(j)]); sum += c; cnt += (c > 0u) ? 1u : 0u; mine = (j == x) ? c : mine; }
        if (sum == G) break;
        __builtin_amdgcn_s_sleep(1);
        if ((++sp & 255u) == 0u) { if (xb_ld(&bar[XB_TMO])) break; if (sp > XB_SPIN_CAP) { atomicAdd(&bar[XB_TMO], 1u); break; } }
    }
    nloc = mine > 0u ? mine : 1u; nx = cnt > 0u ? cnt : 1u;
}
__device__ __forceinline__ void xcd_barrier(const XcdBarrier& b) {
    asm volatile("s_waitcnt vmcnt(0)" ::: "memory");
    __syncthreads();
    if (threadIdx.x == 0) {
        unsigned* bar = b.bar;
        __builtin_amdgcn_s_waitcnt(0);
        unsigned nloc = b.st[0], nx = b.st[1];
        if (nloc == 0u) { xcd_barrier_complete(bar, b.x, nloc, nx); b.st[0] = nloc; b.st[1] = nx; }
        const unsigned old = xb_add(&bar[XB_XSUB(b.x)], 1u);
        const unsigned gen = old / nloc;
        if (old + 1u == (gen + 1u) * nloc) {
            __builtin_amdgcn_fence(__ATOMIC_RELEASE, "agent");
            asm volatile("s_waitcnt vmcnt(0)" ::: "memory");
            const unsigned og = xb_add(&bar[XB_TOP], 1u);
            const unsigned tg = og / nx;
            if (og + 1u == (tg + 1u) * nx) xb_add(&bar[XB_TOPGEN], 1u);
            else XB_SPIN(xb_ld(&bar[XB_TOPGEN]) == tg, bar);
            __builtin_amdgcn_fence(__ATOMIC_ACQUIRE, "agent");
            xb_add(&bar[XB_XGEN(b.x)], 1u);
            asm volatile("s_waitcnt vmcnt(0)" ::: "memory");
        } else {
            XB_SPIN(xb_ld(&bar[XB_XGEN(b.x)]) == gen, bar);
            __builtin_amdgcn_fence(__ATOMIC_ACQUIRE, "agent");
            asm volatile("s_waitcnt vmcnt(0)" ::: "memory");
        }
    }
    __syncthreads();
}

template <int W>
__device__ __forceinline__ void pool_item(const bf16* src, bf16* dst, int tl) {
    v4u rw[W + 7];
#pragma unroll
    for (int k = 0; k < W + 7; ++k) rw[k] = (tl + k - (W - 1) >= 0) ? *(const v4u*)(src + (ptrdiff_t)(k - (W - 1)) * DPOOL) : (v4u){0u, 0u, 0u, 0u};
    f32x4 s0 = {0.f, 0.f, 0.f, 0.f}, s1 = s0;
#pragma unroll
    for (int k = 0; k < W - 1; ++k) { f32x4 a, c; pg8::unpack8(rw[k], a, c); s0 += a; s1 += c; }
#pragma unroll
    for (int i = 0; i < 8; ++i) { f32x4 a, c; pg8::unpack8(rw[W - 1 + i], a, c); s0 += a; s1 += c;
        const int t = tl + i; const int cnt = (t + 1 < W) ? t + 1 : W; const float inv = 1.0f / (float)cnt;
        *(v4u*)(dst + (size_t)i * DPOOL) = pg8::pack8(s0 * inv - a, s1 * inv - c);
        f32x4 a2, c2; pg8::unpack8(rw[i], a2, c2); s0 -= a2; s1 -= c2; }
}
__device__ __forceinline__ void scan_local16(const bf16* lap, const bf16* bbp, f32x4 (&S)[2], f32x4 (&H)[2]) {
    S[0] = S[1] = H[0] = H[1] = (f32x4){0.f, 0.f, 0.f, 0.f};
#pragma unroll
    for (int i0 = 0; i0 < 16; i0 += 8) { v4u lw[8], bw[8];
#pragma unroll
        for (int i = 0; i < 8; ++i) { lw[i] = *(const v4u*)(lap + (size_t)(i0 + i) * DRNN); bw[i] = *(const v4u*)(bbp + (size_t)(i0 + i) * DRNN); }
#pragma unroll
        for (int i = 0; i < 8; ++i) { f32x4 l[2], bq[2]; pg8::unpack8(lw[i], l[0], l[1]); pg8::unpack8(bw[i], bq[0], bq[1]);
#pragma unroll
            for (int n = 0; n < 2; ++n)
#pragma unroll
                for (int j = 0; j < 4; ++j) { H[n][j] = __expf(l[n][j]) * H[n][j] + bq[n][j]; S[n][j] += l[n][j]; } } }
}

__global__ void __launch_bounds__(NTHR, 2) fwd_kernel(Args args) {
    extern __shared__ __attribute__((aligned(16))) unsigned char lds_raw[];
    LAS unsigned char* lds = (LAS unsigned char*)lds_raw;
    const int tid = threadIdx.x, lane = tid & 63, wave = __builtin_amdgcn_readfirstlane(tid >> 6);
    const int G = gridDim.x, bx = blockIdx.x;
    unsigned char* ws = args.ws;
    const int lo = args.ph_lo, hi = args.ph_hi;
#ifndef PHASE_MASK
#define PHASE_MASK 0x7ff
#endif
#define IN(k) (((PHASE_MASK >> (k)) & 1) && lo <= (k) && (k) < hi)
#ifndef REPEAT_MASK
#define REPEAT_MASK 0
#endif
#define REPS(k) (((REPEAT_MASK >> (k)) & 1) ? 2 : 1)
#ifndef PROBE_PHASE
#define PROBE_PHASE -1
#endif
#define PROBE_MULT 4
    unsigned long long tp0 = 0, tp1 = 0;
#define TSTART(k) do { if ((k) == PROBE_PHASE) tp0 = __builtin_amdgcn_s_memrealtime(); } while (0)
#define TEND(k) do { if ((k) == PROBE_PHASE) tp1 = __builtin_amdgcn_s_memrealtime(); } while (0)
#define GSYNC() xcd_barrier(bar)
#define SEAM(k) do { if (IN(k) && IN((k) + 1)) { GSYNC(); } } while (0)

    const float* x = args.in[I_X];
    bf16* WIN = (bf16*)(ws + WS_WIN); bf16* WFI = (bf16*)(ws + WS_WFI); bf16* WFO = (bf16*)(ws + WS_WFO); bf16* WCAT = (bf16*)(ws + WS_WCAT);
    bf16* WO = (bf16*)(ws + WS_WO); bf16* WGRP = (bf16*)(ws + WS_WGRP); bf16* WGATE = (bf16*)(ws + WS_WGATE);
    bf16* XN = (bf16*)(ws + WS_R1); bf16* V = XN; bf16* X1B = XN;
    bf16* CAT = (bf16*)(ws + WS_CAT);
    bf16* UP = (bf16*)(ws + WS_R2);
    bf16* UR = (bf16*)(ws + WS_R3); bf16* LA = UR;
    bf16* UG = (bf16*)(ws + WS_R4);
    bf16* POOLED = (bf16*)(ws + WS_R7); bf16* BB = (bf16*)(ws + WS_R8);
    bf16* MIXB = (bf16*)(ws + WS_MIXB); bf16* ACT = (bf16*)(ws + WS_ACT);
    float* SSQ = (float*)(ws + WS_SSQ); float* CS = (float*)(ws + WS_CS); float* CH = (float*)(ws + WS_CH);
    bf16* G0 = (bf16*)args.out; bf16* G1 = G0 + (size_t)M * 1024;
    float* X1 = args.out;

#ifndef EXTRA_SYNCS
#define EXTRA_SYNCS 0
#endif
    volatile LAS unsigned* MISC = (volatile LAS unsigned*)(lds + 131072 + 1024);
    if (tid < 32) MISC[tid] = 0u;
    __syncthreads();
    XcdBarrier bar = xcd_barrier_post((unsigned*)ws, MISC + 8);
    if (lo < 0) cg::this_grid().sync();
    for (int i = 0; i < EXTRA_SYNCS; ++i) GSYNC();
    TSTART(0);
    if (IN(0)) for (int rep = 0; rep < REPS(0); ++rep) { if (rep) GSYNC();
        LAS float* scr = (LAS float*)(lds + wave * 16384);
        const int gw = bx * NWAVES + wave, NGW = G * NWAVES;
        constexpr int I_IN = 16 * (DIN / 32), I_FI = 16 * (2 * DFF / 32), I_FO = (DFF / 64) * (D / 32), I_RO = 16 * 32, I_WO = 16 * 32, I_PO = 8 * 32;
        constexpr int NITEMS = I_IN + I_FI + I_FO + I_RO + I_WO + I_PO;
        for (int it = gw; it < NITEMS; it += NGW) {
            int r = it;
            if (r < I_IN) { const int nblk = DIN / 32, kb = r / nblk, nb = r % nblk; transpose_item(args.in[I_W_IN], DIN, D, WIN, 64 * kb, 32 * nb, 32 * nb, nullptr, scr, lane); continue; } r -= I_IN;
            if (r < I_FI) { const int nblk = 2 * DFF / 32, kb = r / nblk, nb = r % nblk, nd = 32 * nb, pn = nd >> 8, j0 = nd & 255;
                const int ns = j0 < 128 ? 128 * pn + j0 : DFF + 128 * pn + (j0 - 128);
                transpose_item(args.in[I_W_FFN_IN], 2 * DFF, D, WFI, 64 * kb, ns, nd, args.in[I_NORM_FFN], scr, lane); continue; } r -= I_FI;
            if (r < I_FO) { const int nblk = D / 32, kb = r / nblk, nb = r % nblk; transpose_item(args.in[I_W_FFN_OUT], D, DFF, WFO, 64 * kb, 32 * nb, 32 * nb, nullptr, scr, lane); continue; } r -= I_FO;
            if (r < I_RO) { const int nblk = D / 32, kb = r / nblk, nb = r % nblk; transpose_item(args.in[I_W_RNN_OUT], D, 1536, WCAT + 512, 64 * kb, 32 * nb, 32 * nb, nullptr, scr, lane); continue; } r -= I_RO;
            if (r < I_WO) { const int nblk = D / 32, kb = r / nblk, nb = r % nblk; transpose_item(args.in[I_W_O], D, D, WO, 64 * kb, 32 * nb, 32 * nb, nullptr, scr, lane); continue; } r -= I_WO;
            { const int nblk = D / 32, kb = r / nblk, nb = r % nblk; transpose_item(args.in[I_W_POOL_OUT], D, 1536, WCAT, 64 * kb, 32 * nb, 32 * nb, nullptr, scr, lane); }
        }
        {
            const int gt = bx * NTHR + tid, NT = G * NTHR;
            const float* wg = args.in[I_W_GRP];
            for (int e = gt; e < 512 * 32; e += NT) { const int n = e >> 5, kc = (e & 31) * 8, g = n >> 7, nn = n & 127; float v[8];
#pragma unroll
                for (int j = 0; j < 8; ++j) { const int kk = kc + j - (g & 1) * 128; v[j] = (kk >= 0 && kk < 128) ? wg[((size_t)g * 128 + kk) * 128 + nn] : 0.f; }
                v4u o; o.x = cvt_pk_bf16(v[0], v[1]); o.y = cvt_pk_bf16(v[2], v[3]); o.z = cvt_pk_bf16(v[4], v[5]); o.w = cvt_pk_bf16(v[6], v[7]);
                *(v4u*)(WGRP + (size_t)n * 256 + kc) = o; }
            const float* wa = args.in[I_W_RG_A]; const float* wx = args.in[I_W_RG_X];
            for (int e = gt; e < 2048 * 16; e += NT) { const int n = e >> 4, kc = (e & 15) * 8, h = n >> 8, j = n & 255; const float* src = j < 128 ? wa : wx; const int jj = j & 127; float v[8];
#pragma unroll
                for (int q = 0; q < 8; ++q) v[q] = src[((size_t)h * 128 + kc + q) * 128 + jj];
                v4u o; o.x = cvt_pk_bf16(v[0], v[1]); o.y = cvt_pk_bf16(v[2], v[3]); o.z = cvt_pk_bf16(v[4], v[5]); o.w = cvt_pk_bf16(v[6], v[7]);
                *(v4u*)(WGATE + (size_t)n * 128 + kc) = o; }
        }
        { const int gt = bx * NTHR + tid; if (gt < DRNN) { const float z = -args.in[I_LAMBDA][gt]; ((float*)(ws + WS_SP8))[gt] = -8.0f * (fmaxf(z, 0.f) + log1pf(expf(-fabsf(z)))); } }
        const float* gmix = args.in[I_NORM_MIX];
        f32x4 gv[4];
#pragma unroll
        for (int j = 0; j < 4; ++j) gv[j] = ((const f32x4*)gmix)[lane + 64 * j];
        for (int m = gw; m < M; m += 2 * NGW) {
            const int m1 = (m + NGW < M) ? m + NGW : m;
            const f32x4* xr0 = (const f32x4*)(x + (size_t)m * D) + lane; const f32x4* xr1 = (const f32x4*)(x + (size_t)m1 * D) + lane; f32x4 v0[4], v1[4]; float s0 = 0.f, s1 = 0.f;
#pragma unroll
            for (int j = 0; j < 4; ++j) { v0[j] = xr0[64 * j]; v1[j] = xr1[64 * j]; }
#pragma unroll
            for (int j = 0; j < 4; ++j) { s0 += (v0[j].x * v0[j].x + v0[j].y * v0[j].y) + (v0[j].z * v0[j].z + v0[j].w * v0[j].w); s1 += (v1[j].x * v1[j].x + v1[j].y * v1[j].y) + (v1[j].z * v1[j].z + v1[j].w * v1[j].w); }
            const float rs0 = 1.0f / sqrtf(wave_sum(s0) * (1.f / D) + EPS), rs1 = 1.0f / sqrtf(wave_sum(s1) * (1.f / D) + EPS);
            v2u* o0 = (v2u*)(XN + (size_t)m * D) + lane; v2u* o1 = (v2u*)(XN + (size_t)m1 * D) + lane;
#pragma unroll
            for (int j = 0; j < 4; ++j) { const f32x4 y0 = v0[j] * rs0 * gv[j], y1 = v1[j] * rs1 * gv[j]; v2u w0, w1; w0.x = cvt_pk_bf16(y0.x, y0.y); w0.y = cvt_pk_bf16(y0.z, y0.w); w1.x = cvt_pk_bf16(y1.x, y1.y); w1.y = cvt_pk_bf16(y1.z, y1.w); o0[64 * j] = w0; o1[64 * j] = w1; }
        }
        __syncthreads();
    }
    SEAM(0);
    TEND(0);

    TSTART(1);
    if (IN(1)) for (int rep = 0; rep < REPS(1); ++rep) { if (rep) GSYNC();
        pg8::Gemm g{XN, WIN, M, DIN, D, D, D, 0, 0}; pg8::StaticOrder S; S.init(M, DIN, G, bx);
        pg8::EpiProj E{UP, UR, UG, G0, G1};
        pg8::gemm_phase<pg8::EpiProj, true>(lds, g, S, E);
    }
    SEAM(1);
    TEND(1);

    TSTART(2);
    if (IN(2)) for (int rep = 0; rep < REPS(2); ++rep) { if (rep) GSYNC();
        { const int gw = bx * NWAVES + wave, NGW = G * NWAVES;
          for (int wi = gw; wi < (M / 32) * 4; wi += NGW) { const int g = wi & 3, t0 = (wi >> 2) * 32 + (lane >> 4) * 8, co = g * 16 + (lane & 15);
              const bf16* src = UP + (size_t)t0 * DPOOL + co * 8; bf16* dst = POOLED + (size_t)t0 * DPOOL + co * 8; const int tl = t0 & (SEQ - 1);
              if (g == 0) pool_item<2>(src, dst, tl); else if (g == 1) pool_item<4>(src, dst, tl); else if (g == 2) pool_item<8>(src, dst, tl); else pool_item<16>(src, dst, tl); } }
        { const int gt = bx * NTHR + tid, NT = G * NTHR;
          for (int it = gt; it < (M / 8) * 128; it += NT) { const int co = it & 127, t0 = (it >> 7) * 8, tl = t0 & (SEQ - 1);
              const bf16* src = UR + (size_t)t0 * DRNN + co * 8; bf16* dst = V + (size_t)t0 * DRNN + co * 8;
              const float* cw = args.in[I_CONV_W] + co * 8; const float* cb = args.in[I_CONV_B] + co * 8;
              v4u rw[11];
#pragma unroll
              for (int k = 0; k < 11; ++k) rw[k] = (k >= 3 || tl != 0) ? *(const v4u*)(src + (ptrdiff_t)(k - 3) * DRNN) : (v4u){0u, 0u, 0u, 0u};
              f32x4 w0[2], w1[2], w2[2], w3[2], bb[2];
#pragma unroll
              for (int n = 0; n < 2; ++n) { w0[n] = *(const f32x4*)(cw + 4 * n); w1[n] = *(const f32x4*)(cw + 1024 + 4 * n); w2[n] = *(const f32x4*)(cw + 2048 + 4 * n); w3[n] = *(const f32x4*)(cw + 3072 + 4 * n); bb[n] = *(const f32x4*)(cb + 4 * n); }
#pragma unroll
              for (int i = 0; i < 8; ++i) { f32x4 a[2], b[2], c[2], d[2]; pg8::unpack8(rw[i], a[0], a[1]); pg8::unpack8(rw[i + 1], b[0], b[1]); pg8::unpack8(rw[i + 2], c[0], c[1]); pg8::unpack8(rw[i + 3], d[0], d[1]);
                  *(v4u*)(dst + (size_t)i * DRNN) = pg8::pack8(bb[0] + w0[0] * a[0] + w1[0] * b[0] + w2[0] * c[0] + w3[0] * d[0], bb[1] + w0[1] * a[1] + w1[1] * b[1] + w2[1] * c[1] + w3[1] * d[1]); }
          } }
    }
    SEAM(2);
    TEND(2);

    TSTART(3);
    if (IN(3)) for (int rep = 0; rep < REPS(3); ++rep) { if (rep) GSYNC();
        { pg8::Gemm g{POOLED, WGRP, M, 512, 256, 512, 256, 0, 256}; pg8::StaticOrder S; S.init(M, 512, G, (bx + G / 2) % G);
          pg8::EpiGrp E{CAT, 1536, args.in[I_POOL_SCALE]};
          pg8::gemm_phase<pg8::EpiGrp, true>(lds, g, S, E); }
        { pg8::Gemm g{V, WGATE, M, 2048, 128, 1024, 128, 0, 128}; pg8::StaticOrder S; S.init(M, 2048, G, bx);
          pg8::EpiGate E{V, LA, BB, args.in[I_B_RG_A], args.in[I_B_RG_X], (const float*)(ws + WS_SP8)};
          pg8::gemm_phase<pg8::EpiGate, true>(lds, g, S, E); }
    }
    SEAM(3);
    TEND(3);

    TSTART(4);
    TEND(4);

    TSTART(5);
    if (IN(5)) for (int rep = 0; rep < REPS(5); ++rep) { if (rep) GSYNC();
        LAS float* PAS = (LAS float*)lds; LAS float* PAH = PAS + 8 * 512; LAS float* PBS = PAH + 8 * 512; LAS float* PBH = PBS + 8 * 512;
        unsigned* flags = (unsigned*)ws + 8192;
        for (int bi = bx; bi < NB * SCAN_NC * 2; bi += G) { const int hh = bi & 1, c = (bi >> 1) % SCAN_NC, b = bi / (2 * SCAN_NC);
            const size_t off = ((size_t)b * SEQ + (size_t)c * SCAN_T + wave * 16) * DRNN + hh * 512 + lane * 8;
            { f32x4 S[2], H[2]; scan_local16(LA + off, BB + off, S, H);
              *(LAS f32x4*)(PBS + wave * 512 + lane * 8) = S[0]; *(LAS f32x4*)(PBS + wave * 512 + lane * 8 + 4) = S[1];
              *(LAS f32x4*)(PBH + wave * 512 + lane * 8) = H[0]; *(LAS f32x4*)(PBH + wave * 512 + lane * 8 + 4) = H[1]; }
            __syncthreads();
            { float h = 0.f, st = 0.f;
#pragma unroll
              for (int sb = 0; sb < 8; ++sb) { const float sv = PBS[sb * 512 + tid]; h = __expf(sv) * h + PBH[sb * 512 + tid]; st += sv; }
              const size_t co = ((size_t)b * SCAN_NC + c) * DRNN + hh * 512 + tid;
              __hip_atomic_store(CS + co, st, __ATOMIC_RELAXED, __HIP_MEMORY_SCOPE_AGENT); __hip_atomic_store(CH + co, h, __ATOMIC_RELAXED, __HIP_MEMORY_SCOPE_AGENT); }
            asm volatile("s_waitcnt vmcnt(0)" ::: "memory");
            __syncthreads();
            if (tid == 0) __hip_atomic_store(flags + ((b * 2 + hh) * SCAN_NC + c) * 16, 1u, __ATOMIC_RELAXED, __HIP_MEMORY_SCOPE_AGENT);
            { f32x4 S[2] = {{0.f, 0.f, 0.f, 0.f}, {0.f, 0.f, 0.f, 0.f}}, H[2] = {{0.f, 0.f, 0.f, 0.f}, {0.f, 0.f, 0.f, 0.f}};
              if (wave * 4 < c) {
                  for (int q = 0; q < 4; ++q) { const int cc = wave * 4 + q; if (cc < c) { unsigned* f = flags + ((b * 2 + hh) * SCAN_NC + cc) * 16; unsigned sp = 0;
                      while ((unsigned)__builtin_amdgcn_readfirstlane(__hip_atomic_load(f, __ATOMIC_RELAXED, __HIP_MEMORY_SCOPE_AGENT)) == 0u) { __builtin_amdgcn_s_sleep(1); if (++sp > (1u << 20)) break; } } }
                  __builtin_amdgcn_fence(__ATOMIC_ACQUIRE, "agent");
                  f32x4 cs[4][2], ch[4][2];
#pragma unroll
                  for (int q = 0; q < 4; ++q) { const int cc = wave * 4 + q; const size_t co = ((size_t)b * SCAN_NC + (cc < c ? cc : 0)) * DRNN + hh * 512 + lane * 8;
                      cs[q][0] = *(const f32x4*)(CS + co); cs[q][1] = *(const f32x4*)(CS + co + 4); ch[q][0] = *(const f32x4*)(CH + co); ch[q][1] = *(const f32x4*)(CH + co + 4); }
#pragma unroll
                  for (int q = 0; q < 4; ++q) { if (wave * 4 + q < c) {
#pragma unroll
                      for (int n = 0; n < 2; ++n)
#pragma unroll
                          for (int j = 0; j < 4; ++j) { H[n][j] = __expf(cs[q][n][j]) * H[n][j] + ch[q][n][j]; S[n][j] += cs[q][n][j]; } } }
              }
              *(LAS f32x4*)(PAS + wave * 512 + lane * 8) = S[0]; *(LAS f32x4*)(PAS + wave * 512 + lane * 8 + 4) = S[1];
              *(LAS f32x4*)(PAH + wave * 512 + lane * 8) = H[0]; *(LAS f32x4*)(PAH + wave * 512 + lane * 8 + 4) = H[1]; }
            __syncthreads();
            f32x4 h[2] = {{0.f, 0.f, 0.f, 0.f}, {0.f, 0.f, 0.f, 0.f}};
#pragma unroll
            for (int sb = 0; sb < 8; ++sb) {
#pragma unroll
                for (int n = 0; n < 2; ++n) { const f32x4 sv = *(const LAS f32x4*)(PAS + sb * 512 + lane * 8 + 4 * n), hv = *(const LAS f32x4*)(PAH + sb * 512 + lane * 8 + 4 * n);
#pragma unroll
                    for (int j = 0; j < 4; ++j) h[n][j] = __expf(sv[j]) * h[n][j] + hv[j]; } }
            for (int sb = 0; sb < wave; ++sb) {
#pragma unroll
                for (int n = 0; n < 2; ++n) { const f32x4 sv = *(const LAS f32x4*)(PBS + sb * 512 + lane * 8 + 4 * n), hv = *(const LAS f32x4*)(PBH + sb * 512 + lane * 8 + 4 * n);
#pragma unroll
                    for (int j = 0; j < 4; ++j) h[n][j] = __expf(sv[j]) * h[n][j] + hv[j]; } }
            const bf16* lap = LA + off; const bf16* bbp = BB + off; const bf16* ugp = UG + off;
            bf16* hgp = CAT + ((size_t)b * SEQ + (size_t)c * SCAN_T + wave * 16) * 1536 + 512 + hh * 512 + lane * 8;
#pragma unroll
            for (int i0 = 0; i0 < 16; i0 += 4) { v4u lw[4], bw[4], gw4[4];
#pragma unroll
                for (int i = 0; i < 4; ++i) { lw[i] = *(const v4u*)(lap + (size_t)(i0 + i) * DRNN); bw[i] = *(const v4u*)(bbp + (size_t)(i0 + i) * DRNN); gw4[i] = *(const v4u*)(ugp + (size_t)(i0 + i) * DRNN); }
#pragma unroll
                for (int i = 0; i < 4; ++i) { f32x4 l[2], bq[2], gq[2], o[2]; pg8::unpack8(lw[i], l[0], l[1]); pg8::unpack8(bw[i], bq[0], bq[1]); pg8::unpack8(gw4[i], gq[0], gq[1]);
#pragma unroll
                    for (int n = 0; n < 2; ++n)
#pragma unroll
                        for (int j = 0; j < 4; ++j) { h[n][j] = __expf(l[n][j]) * h[n][j] + bq[n][j]; o[n][j] = h[n][j] * pg8::gelu_tanh_(gq[n][j]); }
                    *(v4u*)(hgp + (size_t)(i0 + i) * 1536) = pg8::pack8(o[0], o[1]); } }
            __syncthreads();
        }
    }
    SEAM(5);
    TEND(5);

    TSTART(6);
    if (IN(6)) for (int rep = 0; rep < REPS(6); ++rep) { if (rep) GSYNC();
        pg8::Gemm g{CAT, WCAT, M, D, 1536, 1536, 1536, 0, 0}; pg8::StaticOrder S; S.init(M, D, G, bx);
        pg8::EpiMix E{G0, G1, MIXB};
        pg8::gemm_phase<pg8::EpiMix, true, 8>(lds, g, S, E);
    }
    SEAM(6);
    TEND(6);

    TSTART(7);
    if (IN(7)) for (int rep = 0; rep < REPS(7); ++rep) { if (rep) GSYNC();
        pg8::Gemm g{MIXB, WO, M, D, D, D, D, 0, 0}; pg8::StaticOrder S; S.init(M, D, G, bx);
        pg8::EpiRes1 E{x, X1B, SSQ};
        pg8::gemm_phase<pg8::EpiRes1, true>(lds, g, S, E);
    }
    SEAM(7);
    TEND(7);

    TSTART(8);
    if (IN(8)) for (int rep = 0; rep < REPS(8); ++rep) { if (rep) GSYNC();
        pg8::Gemm g{X1B, WFI, M, 2 * DFF, D, D, D, 0, 0}; pg8::StaticOrder S; S.init(M, 2 * DFF, G, bx);
        pg8::EpiSwiglu E{SSQ, ACT};
        pg8::gemm_phase<pg8::EpiSwiglu, true>(lds, g, S, E);
    }
    SEAM(8);
    TEND(8);

    TSTART(9);
    if (IN(9)) for (int rep = 0; rep < REPS(9); ++rep) { if (rep) GSYNC();
        pg8::Gemm g{ACT, WFO, M, D, DFF, DFF, DFF, 0, 0}; pg8::StaticOrder S; S.init(M, D, G, bx);
        if (G == 256) { pg8::EpiFinal E{X1B, X1, (float*)(ws + WS_SSQ2), (unsigned*)ws + 4096, args.in[I_NORM_FINAL]};
            pg8::gemm_phase<pg8::EpiFinal, true>(lds, g, S, E); }
        else { pg8::EpiRes2 E{X1B, X1};
            pg8::gemm_phase<pg8::EpiRes2, true>(lds, g, S, E); }
    }
    if (G != 256) SEAM(9);
    TEND(9);

    TSTART(10);
    if (IN(10) && G != 256) for (int rep = 0; rep < REPS(10); ++rep) { if (rep) GSYNC();
        const int gw = bx * NWAVES + wave, NGW = G * NWAVES;
        const float* gf = args.in[I_NORM_FINAL]; f32x4 gv[4];
#pragma unroll
        for (int j = 0; j < 4; ++j) gv[j] = ((const f32x4*)gf)[lane + 64 * j];
        for (int m = gw; m < M; m += NGW) {
            f32x4* xr = (f32x4*)(X1 + (size_t)m * D) + lane; f32x4 v[4]; float s = 0.f;
#pragma unroll
            for (int j = 0; j < 4; ++j) { v[j] = xr[64 * j]; s += (v[j].x * v[j].x + v[j].y * v[j].y) + (v[j].z * v[j].z + v[j].w * v[j].w); }
            const float rs = 1.0f / sqrtf(wave_sum(s) * (1.f / D) + EPS);
#pragma unroll
            for (int j = 0; j < 4; ++j) xr[64 * j] = v[j] * rs * gv[j];
        }
    }
    if (PROBE_PHASE == 10) tp1 = __builtin_amdgcn_s_memrealtime();
    if (PROBE_PHASE >= 0 && bx == 0 && tid == 0) { const unsigned long long dt = (tp1 - tp0) * PROBE_MULT, te = __builtin_amdgcn_s_memrealtime(); while (__builtin_amdgcn_s_memrealtime() - te < dt) __builtin_amdgcn_s_sleep(8); }
#undef IN
#undef SEAM
}

extern "C" void kernel_launch(void* const* d_in, const int* in_sizes, int n_in, void* d_out, int out_size, void* d_ws, size_t ws_size, hipStream_t stream) {
    static int grid = 0;
    if (grid == 0) {
        if (n_in != 19 || out_size != M * D || ws_size < WS_END) { fprintf(stderr, "kernel_launch: unexpected shapes (n_in %d out %d ws %zu)\n", n_in, out_size, ws_size); grid = -1; return; }
        int dev = 0, cus = 0, per_cu = 0;
        hipGetDevice(&dev);
        hipDeviceGetAttribute(&cus, hipDeviceAttributeMultiprocessorCount, dev);
        if (hipFuncSetAttribute((const void*)fwd_kernel, hipFuncAttributeMaxDynamicSharedMemorySize, LDS_BYTES) != hipSuccess) { fprintf(stderr, "kernel_launch: hipFuncSetAttribute failed\n"); grid = -1; return; }
        if (hipOccupancyMaxActiveBlocksPerMultiprocessor(&per_cu, (const void*)fwd_kernel, NTHR, LDS_BYTES) != hipSuccess || per_cu < 1) { fprintf(stderr, "kernel_launch: occupancy query says %d\n", per_cu); per_cu = 1; }
        (void)hipGetLastError();
        grid = cus * 1;
        fprintf(stderr, "kernel_launch: grid %d (cus %d, per_cu %d)\n", grid, cus, per_cu);
    }
    if (grid < 0) return;
    if (hipMemsetAsync(d_ws, 0, 49152, stream) != hipSuccess) { fprintf(stderr, "kernel_launch: memset failed\n"); return; }
    Args a{};
    for (int i = 0; i < 19; ++i) a.in[i] = (const float*)d_in[i];
    a.out = (float*)d_out; a.ws = (unsigned char*)d_ws;
#if MK_PER_PHASE
    for (int p = 0; p < NPH; ++p) { a.ph_lo = p; a.ph_hi = p + 1; hipLaunchKernelGGL(fwd_kernel, dim3(grid), dim3(NTHR), LDS_BYTES, stream, a); }
#else
    a.ph_lo = 0; a.ph_hi = NPH;
    void* kargs[] = {&a};
    hipError_t e = hipLaunchCooperativeKernel((const void*)fwd_kernel, dim3(grid), dim3(NTHR), kargs, LDS_BYTES, stream);
    if (e != hipSuccess) fprintf(stderr, "cooperative launch failed: %s (grid %d)\n", hipGetErrorString(e), grid);
#endif
}
```

```cpp
#include <hip/hip_runtime.h>
#include <hip/hip_cooperative_groups.h>
#include <cstdio>
#include <cstdint>
namespace cg = cooperative_groups;

#ifndef MK_PER_PHASE
#define MK_PER_PHASE 0
#endif

namespace pg8 {
#define PG8_LAS __attribute__((address_space(3)))
typedef unsigned short bf16_t;
typedef short bf16x8 __attribute__((ext_vector_type(8)));
typedef float f32x4 __attribute__((ext_vector_type(4)));
typedef float f32x2 __attribute__((ext_vector_type(2)));
typedef unsigned u32x4 __attribute__((ext_vector_type(4)));
typedef unsigned u32x2 __attribute__((ext_vector_type(2)));
constexpr int BM = 256, BK = 64, HALF = 128, HTB = HALF * BK * 2, STAGE_BYTES = 8 * HTB, NXCD = 8, WGM = 8;

__host__ __device__ __forceinline__ int lds_byte(int r, int c) { const int st = (r >> 4) * 2 + (c >> 5), rr = r & 15, cc = c & 31, ob = rr * 64 + cc * 2; return st * 1024 + (ob ^ (((ob >> 9) & 1) << 5)); }
__host__ __device__ __forceinline__ void stage_rc(int b, int& R, int& C) { const int st = b / 1024, sb = b % 1024, swz = sb ^ (((sb >> 9) & 1) << 5); R = (st >> 1) * 16 + swz / 64; C = (st & 1) * 32 + (swz % 64) / 2; }
__host__ __device__ __forceinline__ int perm32(int rho) { const int n = rho >> 4, i = rho & 15; return 8 * (i >> 2) + 4 * n + (i & 3); }

struct Unit { int pm, pn, rh; };
struct Gemm { const bf16_t* A; const bf16_t* Bt; int M, N, K, lda, ldb, ash, amul; };

struct StaticOrder {
    int nM, nN, nwg, G, c, limit;
    __host__ __device__ void init(int M, int N, int G_, int c_) { nM = M / BM; nN = N / BM; nwg = nM * nN; G = G_; c = c_; limit = nwg; }
    __host__ __device__ void map(int L, Unit& u) const {
        int wgid = L; { const int q = nwg / NXCD, r = nwg % NXCD, xcd = wgid % NXCD, off = wgid / NXCD; wgid = (xcd < r ? xcd * (q + 1) : r * (q + 1) + (xcd - r) * q) + off; }
        const int nig = WGM * nN, gid = wgid / nig, fm = gid * WGM, gsz = (nM - fm) < WGM ? (nM - fm) : WGM;
        u.pm = fm + ((wgid % nig) % gsz); u.pn = (wgid % nig) / gsz; u.rh = 0;
    }
    __host__ __device__ bool next(int i, Unit& u) const {
        const long L = (long)i * G + c; if (L >= limit) return false;
        map((int)L, u); return true;
    }
};

__device__ __forceinline__ unsigned cvt_pk_bf16(float lo, float hi) { unsigned r; asm volatile("v_cvt_pk_bf16_f32 %0, %1, %2" : "=v"(r) : "v"(lo), "v"(hi)); return r; }
__device__ __forceinline__ float bf_lo(unsigned w) { return __uint_as_float(w << 16); }
__device__ __forceinline__ float bf_hi(unsigned w) { return __uint_as_float(w & 0xffff0000u); }
__device__ __forceinline__ float sigmoidf_(float x) { return __builtin_amdgcn_rcpf(1.0f + __expf(-x)); }
__device__ __forceinline__ float gelu_tanh_(float x) { const float z = 1.5957691216057308f * (x + 0.044715f * x * x * x); return x * sigmoidf_(z); }
__device__ __forceinline__ u32x4 pack8(const f32x4 a, const f32x4 b) { u32x4 w; w.x = cvt_pk_bf16(a[0], a[1]); w.y = cvt_pk_bf16(a[2], a[3]); w.z = cvt_pk_bf16(b[0], b[1]); w.w = cvt_pk_bf16(b[2], b[3]); return w; }
__device__ __forceinline__ void unpack8(const u32x4 w, f32x4& a, f32x4& b) { a = (f32x4){bf_lo(w.x), bf_hi(w.x), bf_lo(w.y), bf_hi(w.y)}; b = (f32x4){bf_lo(w.z), bf_hi(w.z), bf_lo(w.w), bf_hi(w.w)}; }

#define EPI_ROWS_BEGIN _Pragma("unroll") for (int ai = 0; ai < NAI; ++ai) _Pragma("unroll") for (int m = 0; m < 4; ++m) { const int row = u.pm * BM + u.rh + ai * HALF + wr * 64 + m * 16 + fr;
#define EPI_ROWS_END }

struct EpiProj {
    bf16_t *UP, *UR, *UG, *G0, *G1;
    template <int NAI> __device__ __forceinline__ void run(const f32x4 (&acc)[2][2][4][2], const Unit& u, int wr, int wc, int fr, int fq) const {
        const int pn = u.pn; bf16_t* base; int ldc, colt, act;
        if (pn < 2) { base = UP; ldc = 512; colt = pn * 256; act = 0; }
        else if (pn < 6) { base = UR; ldc = 1024; colt = (pn - 2) * 256; act = 0; }
        else if (pn < 10) { base = UG; ldc = 1024; colt = (pn - 6) * 256; act = 0; }
        else if (pn < 14) { base = G0; ldc = 1024; colt = (pn - 10) * 256; act = 2; }
        else { base = G1; ldc = 1024; colt = (pn - 14) * 256; act = 2; }
        const int col0 = colt + wc * 32 + 8 * fq;
        EPI_ROWS_BEGIN
            bf16_t* rowp = base + (unsigned)((unsigned)row * (unsigned)ldc + (unsigned)col0);
#pragma unroll
            for (int bj = 0; bj < 2; ++bj) { f32x4 v0 = acc[ai][bj][m][0], v1 = acc[ai][bj][m][1];
                if (act == 1) {
#pragma unroll
                    for (int j = 0; j < 4; ++j) { v0[j] = gelu_tanh_(v0[j]); v1[j] = gelu_tanh_(v1[j]); } }
                else if (act == 2) {
#pragma unroll
                    for (int j = 0; j < 4; ++j) { v0[j] = sigmoidf_(v0[j]); v1[j] = sigmoidf_(v1[j]); } }
                *(u32x4*)(rowp + bj * HALF) = pack8(v0, v1); }
        EPI_ROWS_END
    }
};
struct EpiGrp {
    bf16_t* O; int ldc; const float* scale;
    template <int NAI> __device__ __forceinline__ void run(const f32x4 (&acc)[2][2][4][2], const Unit& u, int wr, int wc, int fr, int fq) const {
        const int col0 = u.pn * BM + wc * 32 + 8 * fq;
        f32x4 sc[2][2];
#pragma unroll
        for (int bj = 0; bj < 2; ++bj)
#pragma unroll
            for (int n = 0; n < 2; ++n) sc[bj][n] = *(const f32x4*)(scale + col0 + bj * HALF + 4 * n);
        EPI_ROWS_BEGIN
            bf16_t* rowp = O + (unsigned)((unsigned)row * (unsigned)ldc + (unsigned)col0);
#pragma unroll
            for (int bj = 0; bj < 2; ++bj) *(u32x4*)(rowp + bj * HALF) = pack8(acc[ai][bj][m][0] * sc[bj][0], acc[ai][bj][m][1] * sc[bj][1]);
        EPI_ROWS_END
    }
};
struct EpiGate {
    const bf16_t* V; bf16_t *LA, *BB; const float *b_a, *b_x, *sp8;
    template <int NAI> __device__ __forceinline__ void run(const f32x4 (&acc)[2][2][4][2], const Unit& u, int wr, int wc, int fr, int fq) const {
        const int ch0 = u.pn * 128 + wc * 32 + 8 * fq;
        f32x4 ba[2], bx[2], sp[2];
#pragma unroll
        for (int n = 0; n < 2; ++n) { ba[n] = *(const f32x4*)(b_a + ch0 + 4 * n); bx[n] = *(const f32x4*)(b_x + ch0 + 4 * n); sp[n] = *(const f32x4*)(sp8 + ch0 + 4 * n); }
        EPI_ROWS_BEGIN
            const unsigned off = (unsigned)row * 1024u + (unsigned)ch0;
            const u32x4 vw = *(const u32x4*)(V + off); f32x4 vv[2]; unpack8(vw, vv[0], vv[1]);
            f32x4 la[2], bb[2];
#pragma unroll
            for (int n = 0; n < 2; ++n)
#pragma unroll
                for (int j = 0; j < 4; ++j) {
                    const float r = sigmoidf_(acc[ai][0][m][n][j] + ba[n][j]), ig = sigmoidf_(acc[ai][1][m][n][j] + bx[n][j]);
                    const float l = sp[n][j] * r, x2 = 2.0f * l;
                    const float em1 = (x2 > -0.125f) ? x2 * (1.0f + 0.5f * x2 * (1.0f + 0.33333334f * x2 * (1.0f + 0.25f * x2 * (1.0f + 0.2f * x2)))) : (__expf(x2) - 1.0f);
                    la[n][j] = l; bb[n][j] = __builtin_amdgcn_sqrtf(fmaxf(-em1, 0.f)) * ig * vv[n][j]; }
            *(u32x4*)(LA + off) = pack8(la[0], la[1]); *(u32x4*)(BB + off) = pack8(bb[0], bb[1]);
            asm volatile("" ::: "memory");
        EPI_ROWS_END
    }
};
struct EpiMix {
    const bf16_t *G0, *G1; bf16_t* MIXB;
    __device__ __forceinline__ void mid(f32x4 (&acc)[2][2][4][2], const Unit& u0, int wr, int wc, int fr, int fq) const {
        constexpr int NAI = 2; Unit u = u0; asm volatile("" : "+s"(u.pm), "+s"(u.pn));
        const int col0 = u.pn * BM + wc * 32 + 8 * fq;
        EPI_ROWS_BEGIN
            const unsigned off = (unsigned)row * 1024u + (unsigned)col0;
#pragma unroll
            for (int bj = 0; bj < 2; ++bj) { f32x4 g0[2], g1[2]; unpack8(*(const u32x4*)(G0 + off + bj * HALF), g0[0], g0[1]); unpack8(*(const u32x4*)(G1 + off + bj * HALF), g1[0], g1[1]);
#pragma unroll
                for (int n = 0; n < 2; ++n)
#pragma unroll
                    for (int j = 0; j < 4; ++j) acc[ai][bj][m][n][j] *= g0[n][j] * __builtin_amdgcn_rcpf(fmaxf(g1[n][j], 1e-30f)); }
        EPI_ROWS_END
    }
    template <int NAI> __device__ __forceinline__ void run(const f32x4 (&acc)[2][2][4][2], const Unit& u, int wr, int wc, int fr, int fq) const {
        const int col0 = u.pn * BM + wc * 32 + 8 * fq;
        EPI_ROWS_BEGIN
            const unsigned off = (unsigned)row * 1024u + (unsigned)col0;
#pragma unroll
            for (int bj = 0; bj < 2; ++bj) { f32x4 g[2]; unpack8(*(const u32x4*)(G1 + off + bj * HALF), g[0], g[1]);
                *(u32x4*)(MIXB + off + bj * HALF) = pack8(g[0] * acc[ai][bj][m][0], g[1] * acc[ai][bj][m][1]); }
        EPI_ROWS_END
    }
};
struct EpiRes1 {
    const float* X; bf16_t* X1B; float* SSQ;
    template <int NAI> __device__ __forceinline__ void run(const f32x4 (&acc)[2][2][4][2], const Unit& u, int wr, int wc, int fr, int fq) const {
        const int col0 = u.pn * BM + wc * 32 + 8 * fq;
        EPI_ROWS_BEGIN
            const unsigned off = (unsigned)row * 1024u + (unsigned)col0; float ss = 0.f;
#pragma unroll
            for (int bj = 0; bj < 2; ++bj) {
                const f32x4 a = *(const f32x4*)(X + off + bj * HALF) + acc[ai][bj][m][0], b = *(const f32x4*)(X + off + bj * HALF + 4) + acc[ai][bj][m][1];
                *(u32x4*)(X1B + off + bj * HALF) = pack8(a, b);
                ss += (a[0] * a[0] + a[1] * a[1]) + (a[2] * a[2] + a[3] * a[3]) + (b[0] * b[0] + b[1] * b[1]) + (b[2] * b[2] + b[3] * b[3]); }
            ss += __shfl_xor(ss, 16); ss += __shfl_xor(ss, 32);
            if (fq == 0) SSQ[(unsigned)row * 16u + (unsigned)(u.pn * 4 + wc)] = ss;
        EPI_ROWS_END
    }
};
struct EpiSwiglu {
    const float* SSQ; bf16_t* ACT;
    template <int NAI> __device__ __forceinline__ void run(const f32x4 (&acc)[2][2][4][2], const Unit& u, int wr, int wc, int fr, int fq) const {
        const int col0 = u.pn * 128 + wc * 32 + 8 * fq;
        EPI_ROWS_BEGIN
            const f32x4 st = *(const f32x4*)(SSQ + (unsigned)row * 16u + (unsigned)(4 * fq));
            float sq = (st[0] + st[1]) + (st[2] + st[3]); sq += __shfl_xor(sq, 16); sq += __shfl_xor(sq, 32);
            const float rs = __builtin_amdgcn_rsqf(sq * (1.0f / 1024.0f) + 1e-6f);
            f32x4 o[2];
#pragma unroll
            for (int n = 0; n < 2; ++n)
#pragma unroll
                for (int j = 0; j < 4; ++j) { const float g = acc[ai][0][m][n][j] * rs, up = acc[ai][1][m][n][j] * rs; o[n][j] = g * sigmoidf_(g) * up; }
            *(u32x4*)(ACT + (unsigned)((unsigned)row * 2816u + (unsigned)col0)) = pack8(o[0], o[1]);
        EPI_ROWS_END
    }
};
struct EpiRes2 {
    const bf16_t* X1B; float* OUT;
    template <int NAI> __device__ __forceinline__ void run(const f32x4 (&acc)[2][2][4][2], const Unit& u, int wr, int wc, int fr, int fq) const {
        const int col0 = u.pn * BM + wc * 32 + 8 * fq;
        EPI_ROWS_BEGIN
            const unsigned off = (unsigned)row * 1024u + (unsigned)col0;
#pragma unroll
            for (int bj = 0; bj < 2; ++bj) { f32x4 xa, xb; unpack8(*(const u32x4*)(X1B + off + bj * HALF), xa, xb);
                *(f32x4*)(OUT + off + bj * HALF) = xa + acc[ai][bj][m][0]; *(f32x4*)(OUT + off + bj * HALF + 4) = xb + acc[ai][bj][m][1]; }
        EPI_ROWS_END
    }
};

struct EpiFinal {
    const bf16_t* X1B; float* OUT; float* SSQ2; unsigned* cnt; const float* gfin;
    template <int NAI> __device__ __forceinline__ void run(f32x4 (&acc)[2][2][4][2], const Unit& u, int wr, int wc, int fr, int fq) const {
        const int col0 = u.pn * BM + wc * 32 + 8 * fq;
        EPI_ROWS_BEGIN
            const unsigned off = (unsigned)row * 1024u + (unsigned)col0; float ss = 0.f;
#pragma unroll
            for (int bj = 0; bj < 2; ++bj) { f32x4 xa, xb; unpack8(*(const u32x4*)(X1B + off + bj * HALF), xa, xb);
                const f32x4 a = xa + acc[ai][bj][m][0], b = xb + acc[ai][bj][m][1]; acc[ai][bj][m][0] = a; acc[ai][bj][m][1] = b;
                ss += (a[0] * a[0] + a[1] * a[1]) + (a[2] * a[2] + a[3] * a[3]) + (b[0] * b[0] + b[1] * b[1]) + (b[2] * b[2] + b[3] * b[3]); }
            ss += __shfl_xor(ss, 16); ss += __shfl_xor(ss, 32);
            if (fq == 0) __hip_atomic_store(SSQ2 + (unsigned)row * 16u + (unsigned)(u.pn * 4 + wc), ss, __ATOMIC_RELAXED, __HIP_MEMORY_SCOPE_AGENT);
        EPI_ROWS_END
        asm volatile("s_waitcnt vmcnt(0)" ::: "memory");
        unsigned* c = cnt + 64 * u.pm;
        if ((threadIdx.x & 63) == 0) __hip_atomic_fetch_add(c, 1u, __ATOMIC_RELAXED, __HIP_MEMORY_SCOPE_AGENT);
        { unsigned sp = 0;
          while ((unsigned)__builtin_amdgcn_readfirstlane(__hip_atomic_load(c, __ATOMIC_RELAXED, __HIP_MEMORY_SCOPE_AGENT)) < 32u) { __builtin_amdgcn_s_sleep(2); if (++sp > (1u << 20)) break; } }
        __builtin_amdgcn_fence(__ATOMIC_ACQUIRE, "agent");
        f32x4 gv[2][2];
#pragma unroll
        for (int bj = 0; bj < 2; ++bj)
#pragma unroll
            for (int n = 0; n < 2; ++n) gv[bj][n] = *(const f32x4*)(gfin + col0 + bj * HALF + 4 * n);
        EPI_ROWS_BEGIN
            const unsigned off = (unsigned)row * 1024u + (unsigned)col0;
            const unsigned long long* sl = (const unsigned long long*)(SSQ2 + (unsigned)row * 16u + (unsigned)(4 * fq));
            const unsigned long long w0 = __hip_atomic_load(sl, __ATOMIC_RELAXED, __HIP_MEMORY_SCOPE_AGENT), w1 = __hip_atomic_load(sl + 1, __ATOMIC_RELAXED, __HIP_MEMORY_SCOPE_AGENT);
            float sq = (__uint_as_float((unsigned)w0) + __uint_as_float((unsigned)(w0 >> 32))) + (__uint_as_float((unsigned)w1) + __uint_as_float((unsigned)(w1 >> 32)));
            sq += __shfl_xor(sq, 16); sq += __shfl_xor(sq, 32);
            const float rs = 1.0f / sqrtf(sq * (1.0f / 1024.0f) + 1e-6f);
#pragma unroll
            for (int bj = 0; bj < 2; ++bj) { *(f32x4*)(OUT + off + bj * HALF) = acc[ai][bj][m][0] * rs * gv[bj][0]; *(f32x4*)(OUT + off + bj * HALF + 4) = acc[ai][bj][m][1] * rs * gv[bj][1]; }
        EPI_ROWS_END
    }
};

template <class Epi, bool ALIGN_EPI, int MID_T = -1>
__device__ __forceinline__ void gemm_phase(PG8_LAS unsigned char* lds, const Gemm g, const StaticOrder& S, const Epi& E) {
    const int tid = threadIdx.x, wid = __builtin_amdgcn_readfirstlane(tid >> 6), lane = tid & 63, wr = wid >> 2, wc = wid & 3, fr = lane & 15, fq = lane >> 4;
    int nt = g.K / BK; asm volatile("" : "+s"(nt));
    unsigned voffA[2], voffB[2];
#pragma unroll
    for (int i = 0; i < 2; ++i) { int R, C; stage_rc(tid * 16 + i * 8192, R, C); const int Rb = (R & ~31) + perm32(R & 31);
        voffA[i] = (unsigned)(R * g.lda + C) * 2u; voffB[i] = (unsigned)(Rb * g.ldb + C) * 2u; }
    const size_t kstep = (size_t)(BK * 2);
    const size_t hstepA = (size_t)HALF * g.lda * 2, hstepB = (size_t)HALF * g.ldb * 2;
    const size_t tstepA = 2 * hstepA, tstepB = 2 * hstepB;
    const unsigned ldsw = (unsigned)wid * 1024u;
    const int aoff = lds_byte(wr * 64 + fr, fq * 8), boff = lds_byte(wc * 32 + fr, fq * 8);
#define PG8_SA(b, h) (((b) * 2 + (h)) * HTB)
#define PG8_SB(b, h) ((4 + (b) * 2 + (h)) * HTB)
#define PG8_STAGE(bufoff, gbase, voff) do { _Pragma("unroll") for (int _i = 0; _i < 2; ++_i) \
        __builtin_amdgcn_global_load_lds((const unsigned*)((const char*)(gbase) + (voff)[_i]), (PG8_LAS unsigned*)(lds + (bufoff) + ldsw + _i * 8192), 16, 0, 0); } while (0)
#define PG8_LDA(dst, b, h) do { _Pragma("unroll") for (int m = 0; m < 4; ++m) _Pragma("unroll") for (int k = 0; k < 2; ++k) dst[m][k] = *(const PG8_LAS bf16x8*)(lds + PG8_SA(b, h) + aoff + m * 2048 + k * 1024); } while (0)
#define PG8_LDB(dst, b, h) do { _Pragma("unroll") for (int n = 0; n < 2; ++n) _Pragma("unroll") for (int k = 0; k < 2; ++k) dst[n][k] = *(const PG8_LAS bf16x8*)(lds + PG8_SB(b, h) + boff + n * 2048 + k * 1024); } while (0)
#define PG8_MMA(ai, bj, At, Bt) do { __builtin_amdgcn_s_setprio(1); _Pragma("unroll") for (int m = 0; m < 4; ++m) _Pragma("unroll") for (int n = 0; n < 2; ++n) _Pragma("unroll") for (int k = 0; k < 2; ++k) \
        acc[ai][bj][m][n] = __builtin_amdgcn_mfma_f32_16x16x32_bf16(Bt[n][k], At[m][k], acc[ai][bj][m][n], 0, 0, 0); __builtin_amdgcn_s_setprio(0); } while (0)
#define PG8_WAIT_V(n) asm volatile("s_waitcnt vmcnt(" #n ")" ::: "memory")
#define PG8_WAIT_L(n) asm volatile("s_waitcnt lgkmcnt(" #n ")" ::: "memory")
#define PG8_BAR __builtin_amdgcn_s_barrier()
#define PG8_SCHED __builtin_amdgcn_sched_barrier(0)
    Unit cur, nxt; int ui = 0;
    if (!S.next(0, cur)) return;
    f32x4 acc[2][2][4][2];
#pragma unroll
    for (int a = 0; a < 2; ++a)
#pragma unroll
        for (int b = 0; b < 2; ++b)
#pragma unroll
            for (int m = 0; m < 4; ++m)
#pragma unroll
                for (int n = 0; n < 2; ++n) acc[a][b][m][n] = (f32x4){0.f, 0.f, 0.f, 0.f};
    bf16x8 At[4][2], B0[2][2], B1[2][2];
    const char* cA = (const char*)g.A + (size_t)cur.pm * tstepA + (size_t)((cur.pn >> g.ash) * g.amul) * 2; const char* cB = (const char*)g.Bt + (size_t)cur.pn * tstepB;
    PG8_STAGE(PG8_SB(0, 0), cB, voffB); PG8_STAGE(PG8_SB(0, 1), cB + hstepB, voffB); PG8_STAGE(PG8_SA(0, 0), cA, voffA); PG8_STAGE(PG8_SA(0, 1), cA + hstepA, voffA);
    if (wr == 1) PG8_BAR;
    PG8_WAIT_V(2); PG8_BAR;
    PG8_STAGE(PG8_SB(1, 0), cB + kstep, voffB); PG8_STAGE(PG8_SA(1, 0), cA + kstep, voffA); PG8_STAGE(PG8_SB(1, 1), cB + hstepB + kstep, voffB);
    PG8_WAIT_V(6); PG8_BAR;
    for (;;) {
        const bool has_next = S.next(ui + 1, nxt);
        const char* nA = has_next ? (const char*)g.A + (size_t)nxt.pm * tstepA + (size_t)((nxt.pn >> g.ash) * g.amul) * 2 : cA; const char* nB = has_next ? (const char*)g.Bt + (size_t)nxt.pn * tstepB : cB;
        for (int t = 0; t < nt; t += 2) {
            const bool last = (t == nt - 2);
            if constexpr (MID_T >= 0) { if (t == MID_T) E.mid(acc, cur, wr, wc, fr, fq); }
            const char* a1 = cA + (size_t)(t + 1) * kstep;
            const char* a2 = last ? nA : cA + (size_t)(t + 2) * kstep; const char* b2 = last ? nB : cB + (size_t)(t + 2) * kstep;
            const char* a3 = a2 + kstep; const char* b3 = b2 + kstep;
            PG8_LDB(B0, 0, 0); PG8_LDB(B1, 0, 1); PG8_SCHED; PG8_LDA(At, 0, 0); PG8_STAGE(PG8_SA(1, 1), a1 + hstepA, voffA);
            PG8_WAIT_V(8); PG8_WAIT_L(0); PG8_BAR; PG8_MMA(0, 0, At, B0); PG8_MMA(0, 1, At, B1); PG8_BAR; PG8_SCHED;
            PG8_LDA(At, 0, 1); PG8_STAGE(PG8_SB(0, 0), b2, voffB); PG8_STAGE(PG8_SB(0, 1), b2 + hstepB, voffB); PG8_STAGE(PG8_SA(0, 0), a2, voffA);
            PG8_WAIT_V(8); PG8_WAIT_L(0); PG8_BAR; PG8_MMA(1, 0, At, B0); PG8_MMA(1, 1, At, B1); PG8_BAR; PG8_SCHED;
            PG8_LDB(B0, 1, 0); PG8_LDB(B1, 1, 1); PG8_SCHED; PG8_LDA(At, 1, 0); PG8_STAGE(PG8_SA(0, 1), a2 + hstepA, voffA);
            PG8_WAIT_V(8); PG8_WAIT_L(0); PG8_BAR; PG8_MMA(0, 0, At, B0); PG8_MMA(0, 1, At, B1); PG8_BAR; PG8_SCHED;
            PG8_LDA(At, 1, 1); PG8_STAGE(PG8_SB(1, 0), b3, voffB); PG8_STAGE(PG8_SB(1, 1), b3 + hstepB, voffB); PG8_STAGE(PG8_SA(1, 0), a3, voffA);
            PG8_WAIT_V(8); PG8_WAIT_L(0); PG8_BAR; PG8_MMA(1, 0, At, B0); PG8_MMA(1, 1, At, B1); PG8_BAR; PG8_SCHED;
        }
        if constexpr (ALIGN_EPI) { if (wr == 0) PG8_BAR; }
        E.template run<2>(acc, cur, wr, wc, fr, fq);
        if (!has_next) break;
#pragma unroll
        for (int a = 0; a < 2; ++a)
#pragma unroll
            for (int b = 0; b < 2; ++b)
#pragma unroll
                for (int m = 0; m < 4; ++m)
#pragma unroll
                    for (int n = 0; n < 2; ++n) acc[a][b][m][n] = (f32x4){0.f, 0.f, 0.f, 0.f};
        cur = nxt; cA = nA; cB = nB; ++ui;
        if constexpr (ALIGN_EPI) { if (wr == 1) PG8_BAR; }
    }
    PG8_WAIT_V(0);
    if constexpr (!ALIGN_EPI) { if (wr == 0) PG8_BAR; }
    PG8_BAR;
#undef PG8_SA
#undef PG8_SB
#undef PG8_STAGE
#undef PG8_LDA
#undef PG8_LDB
#undef PG8_MMA
#undef PG8_WAIT_V
#undef PG8_WAIT_L
#undef PG8_BAR
#undef PG8_SCHED
}

template <class Epi>
__device__ __forceinline__ void gemm_half(PG8_LAS unsigned char* lds, const Gemm g, const Unit u, const Epi& E) {
    const int tid = threadIdx.x, wid = __builtin_amdgcn_readfirstlane(tid >> 6), lane = tid & 63, wr = wid >> 2, wc = wid & 3, fr = lane & 15, fq = lane >> 4;
    int nt = g.K / BK; asm volatile("" : "+s"(nt));
    unsigned voffA[2], voffB[2];
#pragma unroll
    for (int i = 0; i < 2; ++i) { int R, C; stage_rc(tid * 16 + i * 8192, R, C); const int Rb = (R & ~31) + perm32(R & 31);
        voffA[i] = (unsigned)(R * g.lda + C) * 2u; voffB[i] = (unsigned)(Rb * g.ldb + C) * 2u; }
    const size_t kstep = (size_t)(BK * 2);
    const size_t hstepA = (size_t)HALF * g.lda * 2, hstepB = (size_t)HALF * g.ldb * 2;
    const unsigned ldsw = (unsigned)wid * 1024u;
    const int aoff = lds_byte(wr * 64 + fr, fq * 8), boff = lds_byte(wc * 32 + fr, fq * 8);
#define PG8_SA(b, h) (((b) * 2 + (h)) * HTB)
#define PG8_SB(b, h) ((4 + (b) * 2 + (h)) * HTB)
#define PG8_STAGE(bufoff, gbase, voff) do { _Pragma("unroll") for (int _i = 0; _i < 2; ++_i) \
        __builtin_amdgcn_global_load_lds((const unsigned*)((const char*)(gbase) + (voff)[_i]), (PG8_LAS unsigned*)(lds + (bufoff) + ldsw + _i * 8192), 16, 0, 0); } while (0)
#define PG8_LDA(dst, b, h) do { _Pragma("unroll") for (int m = 0; m < 4; ++m) _Pragma("unroll") for (int k = 0; k < 2; ++k) dst[m][k] = *(const PG8_LAS bf16x8*)(lds + PG8_SA(b, h) + aoff + m * 2048 + k * 1024); } while (0)
#define PG8_LDB(dst, b, h) do { _Pragma("unroll") for (int n = 0; n < 2; ++n) _Pragma("unroll") for (int k = 0; k < 2; ++k) dst[n][k] = *(const PG8_LAS bf16x8*)(lds + PG8_SB(b, h) + boff + n * 2048 + k * 1024); } while (0)
#define PG8_MMA(ai, bj, At, Bt) do { __builtin_amdgcn_s_setprio(1); _Pragma("unroll") for (int m = 0; m < 4; ++m) _Pragma("unroll") for (int n = 0; n < 2; ++n) _Pragma("unroll") for (int k = 0; k < 2; ++k) \
        acc[ai][bj][m][n] = __builtin_amdgcn_mfma_f32_16x16x32_bf16(Bt[n][k], At[m][k], acc[ai][bj][m][n], 0, 0, 0); __builtin_amdgcn_s_setprio(0); } while (0)
#define PG8_WAIT_V(n) asm volatile("s_waitcnt vmcnt(" #n ")" ::: "memory")
#define PG8_WAIT_L(n) asm volatile("s_waitcnt lgkmcnt(" #n ")" ::: "memory")
#define PG8_BAR __builtin_amdgcn_s_barrier()
#define PG8_SCHED __builtin_amdgcn_sched_barrier(0)
    f32x4 acc[2][2][4][2];
#pragma unroll
    for (int a = 0; a < 2; ++a)
#pragma unroll
        for (int b = 0; b < 2; ++b)
#pragma unroll
            for (int m = 0; m < 4; ++m)
#pragma unroll
                for (int n = 0; n < 2; ++n) acc[a][b][m][n] = (f32x4){0.f, 0.f, 0.f, 0.f};
    bf16x8 At[4][2], B0[2][2], B1[2][2];
    const char* cA = (const char*)g.A + ((size_t)u.pm * BM + u.rh) * g.lda * 2 + (size_t)((u.pn >> g.ash) * g.amul) * 2; const char* cB = (const char*)g.Bt + (size_t)u.pn * 2 * hstepB;
    PG8_STAGE(PG8_SB(0, 0), cB, voffB); PG8_STAGE(PG8_SB(0, 1), cB + hstepB, voffB); PG8_STAGE(PG8_SA(0, 0), cA, voffA);
    PG8_STAGE(PG8_SB(1, 0), cB + kstep, voffB); PG8_STAGE(PG8_SB(1, 1), cB + hstepB + kstep, voffB); PG8_STAGE(PG8_SA(1, 0), cA + kstep, voffA);
    PG8_WAIT_V(6); PG8_BAR;
#define PG8_HALF_STEP(b, tt) do { \
        PG8_LDB(B0, b, 0); PG8_LDB(B1, b, 1); PG8_LDA(At, b, 0); PG8_WAIT_L(0); PG8_BAR; PG8_SCHED; \
        const bool more_ = (tt) + 2 < nt; \
        if (more_) { const char* b2 = cB + (size_t)((tt) + 2) * kstep; const char* a2 = cA + (size_t)((tt) + 2) * kstep; \
            PG8_STAGE(PG8_SB(b, 0), b2, voffB); PG8_STAGE(PG8_SB(b, 1), b2 + hstepB, voffB); PG8_STAGE(PG8_SA(b, 0), a2, voffA); } \
        PG8_MMA(0, 0, At, B0); PG8_MMA(0, 1, At, B1); \
        if (more_) PG8_WAIT_V(6); else PG8_WAIT_V(0); \
        PG8_BAR; PG8_SCHED; } while (0)
    for (int t = 0; t < nt; t += 2) { PG8_HALF_STEP(0, t); PG8_HALF_STEP(1, t + 1); }
    E.template run<1>(acc, u, wr, wc, fr, fq);
    PG8_BAR;
#undef PG8_HALF_STEP
#undef PG8_SA
#undef PG8_SB
#undef PG8_STAGE
#undef PG8_LDA
#undef PG8_LDB
#undef PG8_MMA
#undef PG8_WAIT_V
#undef PG8_WAIT_L
#undef PG8_BAR
#undef PG8_SCHED
}
}

constexpr int NWAVES = 8, NTHR = 512;
constexpr int M = 16384, SEQ = 4096, NB = 4, D = 1024, DPOOL = 512, DRNN = 1024, DIN = 4608, DFF = 2816;
constexpr float EPS = 1e-6f;
constexpr int NPH = 11;
constexpr int SCAN_T = 128, SCAN_NC = SEQ / SCAN_T;

constexpr size_t MiB = 1u << 20;
constexpr size_t WS_SP8 = 512 * 1024;
constexpr size_t WS_SSQ = 1 * MiB;
constexpr size_t WS_SSQ2 = 2 * MiB;
constexpr size_t WS_CS = 2 * MiB, WS_CH = 3 * MiB;
constexpr size_t WS_WIN = 4 * MiB;
constexpr size_t WS_WFI = 13 * MiB;
constexpr size_t WS_WFO = 24 * MiB;
constexpr size_t WS_WCAT = WS_WFO + 5632 * 1024;
constexpr size_t WS_WO = WS_WCAT + 3 * MiB;
constexpr size_t WS_WGRP = WS_WO + 2 * MiB;
constexpr size_t WS_WGATE = WS_WGRP + MiB / 4;
constexpr size_t WS_R1 = 36 * MiB;
constexpr size_t WS_R2 = 68 * MiB;
constexpr size_t WS_R3 = 84 * MiB;
constexpr size_t WS_R4 = 116 * MiB;
constexpr size_t WS_R7 = 148 * MiB;
constexpr size_t WS_R8 = 164 * MiB;
constexpr size_t WS_CAT = 196 * MiB;
constexpr size_t WS_MIXB = 148 * MiB;
constexpr size_t WS_ACT = 68 * MiB;
constexpr size_t WS_END = 244 * MiB;

constexpr int LDS_BYTES = 147456;

#define LAS __attribute__((address_space(3)))
typedef unsigned short bf16;
typedef unsigned v4u __attribute__((ext_vector_type(4)));
typedef unsigned v2u __attribute__((ext_vector_type(2)));
typedef float f32x4 __attribute__((ext_vector_type(4)));
typedef float f32x2 __attribute__((ext_vector_type(2)));
#define LDS_WAIT() asm volatile("s_waitcnt lgkmcnt(0)" ::: "memory")
using pg8::cvt_pk_bf16; using pg8::bf_lo; using pg8::bf_hi;

struct Args { const float* in[19]; float* out; unsigned char* ws; int ph_lo, ph_hi; };
enum { I_X = 0, I_NORM_MIX, I_W_IN, I_W_GRP, I_POOL_SCALE, I_W_POOL_OUT, I_CONV_W, I_CONV_B, I_W_RG_A, I_B_RG_A, I_W_RG_X, I_B_RG_X, I_LAMBDA, I_W_RNN_OUT, I_W_O, I_NORM_FFN, I_W_FFN_IN, I_W_FFN_OUT, I_NORM_FINAL };

__device__ __forceinline__ float wave_sum(float v) {
#pragma unroll
    for (int o = 1; o < 64; o <<= 1) v += __shfl_xor(v, o);
    return v;
}

__device__ __forceinline__ void transpose_item(const float* W, int Nsrc, int Kdst, bf16* WT, int k0, int n_src0, int n_dst0, const float* kscale, LAS float* scr, int lane) {
    f32x4 v[8]; const int n4 = (lane & 7) * 4;
#pragma unroll
    for (int i = 0; i < 8; ++i) { const int kk = 8 * i + (lane >> 3); v[i] = *(const f32x4*)(W + (size_t)(k0 + kk) * Nsrc + n_src0 + n4); }
    if (kscale) {
#pragma unroll
        for (int i = 0; i < 8; ++i) v[i] = v[i] * kscale[k0 + 8 * i + (lane >> 3)]; }
#pragma unroll
    for (int i = 0; i < 8; ++i) { const int kk = 8 * i + (lane >> 3);
#pragma unroll
        for (int j = 0; j < 4; ++j) scr[kk * 33 + n4 + j] = v[i][j]; }
    LDS_WAIT(); asm volatile("" ::: "memory");
    const int c = lane & 7;
#pragma unroll
    for (int j = 0; j < 4; ++j) { const int n = (lane >> 3) + 8 * j; const LAS float* s = scr + (8 * c) * 33 + n;
        v4u o; o.x = cvt_pk_bf16(s[0 * 33], s[1 * 33]); o.y = cvt_pk_bf16(s[2 * 33], s[3 * 33]); o.z = cvt_pk_bf16(s[4 * 33], s[5 * 33]); o.w = cvt_pk_bf16(s[6 * 33], s[7 * 33]);
        *(v4u*)(WT + (size_t)(n_dst0 + n) * Kdst + k0 + 8 * c) = o; }
    LDS_WAIT(); asm volatile("" ::: "memory");
}

#define XB_TMO      128
#define XB_XCNT(j)  (256  + 64 * (j))
#define XB_XSUB(j)  (1280 + 64 * (j))
#define XB_XGEN(j)  (2304 + 64 * (j))
#define XB_TOP      3328
#define XB_TOPGEN   3392
#define XCD_BAR_WORDS 3456
#define XB_SPIN_CAP (1u << 18)
__device__ __forceinline__ unsigned xb_ld(unsigned* p)              { return __hip_atomic_load(p, __ATOMIC_RELAXED, __HIP_MEMORY_SCOPE_AGENT); }
__device__ __forceinline__ unsigned xb_add(unsigned* p, unsigned v) { return __hip_atomic_fetch_add(p, v, __ATOMIC_RELAXED, __HIP_MEMORY_SCOPE_AGENT); }
__device__ __forceinline__ unsigned xb_xcc_id() { return (unsigned)__builtin_amdgcn_s_getreg((3 << 11) | 20) & 0xFu; }
#define XB_SPIN(cond, bar) do { unsigned _sp = 0; while (cond) { __builtin_amdgcn_s_sleep(1); \
    if ((++_sp & 255u) == 0u) { if (xb_ld(&(bar)[XB_TMO])) break; if (_sp > XB_SPIN_CAP) { atomicAdd(&(bar)[XB_TMO], 1u); break; } } } } while (0)
struct XcdBarrier { unsigned* bar; unsigned x; volatile LAS unsigned* st; };
__device__ __forceinline__ XcdBarrier xcd_barrier_post(unsigned* bar, volatile LAS unsigned* st) {
    XcdBarrier b; b.bar = bar; b.x = xb_xcc_id(); b.st = st;
    if (threadIdx.x == 0) (void)xb_add(&bar[XB_XCNT(b.x)], 1u);
    return b;
}
__device__ __forceinline__ void xcd_barrier_complete(unsigned* bar, unsigned x, unsigned& nloc, unsigned& nx) {
    const unsigned G = gridDim.x * gridDim.y * gridDim.z;
    unsigned sum, cnt, mine, sp = 0u;
    for (;;) {
        sum = 0u; cnt = 0u; mine = 0u;
#pragma unroll
        for (unsigned j = 0; j < 16; ++j) { const unsigned c = xb_ld(&bar[XB_XCNT(j)]); sum += c; cnt += (c > 0u) ? 1u : 0u; mine = (j == x) ? c : mine; }
        if (sum == G) break;
        __builtin_amdgcn_s_sleep(1);
        if ((++sp & 255u) == 0u) { if (xb_ld(&bar[XB_TMO])) break; if (sp > XB_SPIN_CAP) { atomicAdd(&bar[XB_TMO], 1u); break; } }
    }
    nloc = mine > 0u ? mine : 1u; nx = cnt > 0u ? cnt : 1u;
}
__device__ __forceinline__ void xcd_barrier(const XcdBarrier& b) {
    asm volatile("s_waitcnt vmcnt(0)" ::: "memory");
    __syncthreads();
    if (threadIdx.x == 0) {
        unsigned* bar = b.bar;
        __builtin_amdgcn_s_waitcnt(0);
        unsigned nloc = b.st[0], nx = b.st[1];
        if (nloc == 0u) { xcd_barrier_complete(bar, b.x, nloc, nx); b.st[0] = nloc; b.st[1] = nx; }
        const unsigned old = xb_add(&bar[XB_XSUB(b.x)], 1u);
        const unsigned gen = old / nloc;
        if (old + 1u == (gen + 1u) * nloc) {
            __builtin_amdgcn_fence(__ATOMIC_RELEASE, "agent");
            asm volatile("s_waitcnt vmcnt(0)" ::: "memory");
            const unsigned og = xb_add(&bar[XB_TOP], 1u);
            const unsigned tg = og / nx;
            if (og + 1u == (tg + 1u) * nx) xb_add(&bar[XB_TOPGEN], 1u);
            else XB_SPIN(xb_ld(&bar[XB_TOPGEN]) == tg, bar);
            __builtin_amdgcn_fence(__ATOMIC_ACQUIRE, "agent");
            xb_add(&bar[XB_XGEN(b.x)], 1u);
            asm volatile("s_waitcnt vmcnt(0)" ::: "memory");
        } else {
            XB_SPIN(xb_ld(&bar[XB_XGEN(b.x)]) == gen, bar);
            __builtin_amdgcn_fence(__ATOMIC_ACQUIRE, "agent");
            asm volatile("s_waitcnt vmcnt(0)" ::: "memory");
        }
    }
    __syncthreads();
}

template <int W>
__device__ __forceinline__ void pool_item(const bf16* src, bf16* dst, int tl) {
    v4u rw[W + 7];
#pragma unroll
    for (int k = 0; k < W + 7; ++k) rw[k] = (tl + k - (W - 1) >= 0) ? *(const v4u*)(src + (ptrdiff_t)(k - (W - 1)) * DPOOL) : (v4u){0u, 0u, 0u, 0u};
    f32x4 s0 = {0.f, 0.f, 0.f, 0.f}, s1 = s0;
#pragma unroll
    for (int k = 0; k < W - 1; ++k) { f32x4 a, c; pg8::unpack8(rw[k], a, c); s0 += a; s1 += c; }
#pragma unroll
    for (int i = 0; i < 8; ++i) { f32x4 a, c; pg8::unpack8(rw[W - 1 + i], a, c); s0 += a; s1 += c;
        const int t = tl + i; const int cnt = (t + 1 < W) ? t + 1 : W; const float inv = 1.0f / (float)cnt;
        *(v4u*)(dst + (size_t)i * DPOOL) = pg8::pack8(s0 * inv - a, s1 * inv - c);
        f32x4 a2, c2; pg8::unpack8(rw[i], a2, c2); s0 -= a2; s1 -= c2; }
}
__device__ __forceinline__ void scan_local16(const bf16* lap, const bf16* bbp, f32x4 (&S)[2], f32x4 (&H)[2]) {
    S[0] = S[1] = H[0] = H[1] = (f32x4){0.f, 0.f, 0.f, 0.f};
#pragma unroll
    for (int i0 = 0; i0 < 16; i0 += 8) { v4u lw[8], bw[8];
#pragma unroll
        for (int i = 0; i < 8; ++i) { lw[i] = *(const v4u*)(lap + (size_t)(i0 + i) * DRNN); bw[i] = *(const v4u*)(bbp + (size_t)(i0 + i) * DRNN); }
#pragma unroll
        for (int i = 0; i < 8; ++i) { f32x4 l[2], bq[2]; pg8::unpack8(lw[i], l[0], l[1]); pg8::unpack8(bw[i], bq[0], bq[1]);
#pragma unroll
            for (int n = 0; n < 2; ++n)
#pragma unroll
                for (int j = 0; j < 4; ++j) { H[n][j] = __expf(l[n][j]) * H[n][j] + bq[n][j]; S[n][j] += l[n][j]; } } }
}

__global__ void __launch_bounds__(NTHR, 2) fwd_kernel(Args args) {
    extern __shared__ __attribute__((aligned(16))) unsigned char lds_raw[];
    LAS unsigned char* lds = (LAS unsigned char*)lds_raw;
    const int tid = threadIdx.x, lane = tid & 63, wave = __builtin_amdgcn_readfirstlane(tid >> 6);
    const int G = gridDim.x, bx = blockIdx.x;
    unsigned char* ws = args.ws;
    const int lo = args.ph_lo, hi = args.ph_hi;
#ifndef PHASE_MASK
#define PHASE_MASK 0x7ff
#endif
#define IN(k) (((PHASE_MASK >> (k)) & 1) && lo <= (k) && (k) < hi)
#ifndef REPEAT_MASK
#define REPEAT_MASK 0
#endif
#define REPS(k) (((REPEAT_MASK >> (k)) & 1) ? 2 : 1)
#ifndef PROBE_PHASE
#define PROBE_PHASE -1
#endif
#define PROBE_MULT 4
    unsigned long long tp0 = 0, tp1 = 0;
#define TSTART(k) do { if ((k) == PROBE_PHASE) tp0 = __builtin_amdgcn_s_memrealtime(); } while (0)
#define TEND(k) do { if ((k) == PROBE_PHASE) tp1 = __builtin_amdgcn_s_memrealtime(); } while (0)
#define GSYNC() xcd_barrier(bar)
#define SEAM(k) do { if (IN(k) && IN((k) + 1)) { GSYNC(); } } while (0)

    const float* x = args.in[I_X];
    bf16* WIN = (bf16*)(ws + WS_WIN); bf16* WFI = (bf16*)(ws + WS_WFI); bf16* WFO = (bf16*)(ws + WS_WFO); bf16* WCAT = (bf16*)(ws + WS_WCAT);
    bf16* WO = (bf16*)(ws + WS_WO); bf16* WGRP = (bf16*)(ws + WS_WGRP); bf16* WGATE = (bf16*)(ws + WS_WGATE);
    bf16* XN = (bf16*)(ws + WS_R1); bf16* V = XN; bf16* X1B = XN;
    bf16* CAT = (bf16*)(ws + WS_CAT);
    bf16* UP = (bf16*)(ws + WS_R2);
    bf16* UR = (bf16*)(ws + WS_R3); bf16* LA = UR;
    bf16* UG = (bf16*)(ws + WS_R4);
    bf16* POOLED = (bf16*)(ws + WS_R7); bf16* BB = (bf16*)(ws + WS_R8);
    bf16* MIXB = (bf16*)(ws + WS_MIXB); bf16* ACT = (bf16*)(ws + WS_ACT);
    float* SSQ = (float*)(ws + WS_SSQ); float* CS = (float*)(ws + WS_CS); float* CH = (float*)(ws + WS_CH);
    bf16* G0 = (bf16*)args.out; bf16* G1 = G0 + (size_t)M * 1024;
    float* X1 = args.out;

#ifndef EXTRA_SYNCS
#define EXTRA_SYNCS 0
#endif
    if (PROBE_PHASE == 99) tp0 = __builtin_amdgcn_s_memrealtime();
    volatile LAS unsigned* MISC = (volatile LAS unsigned*)(lds + 131072 + 1024);
    if (tid < 32) MISC[tid] = 0u;
    __syncthreads();
    XcdBarrier bar = xcd_barrier_post((unsigned*)ws, MISC + 8);
    if (lo < 0) cg::this_grid().sync();
    for (int i = 0; i < EXTRA_SYNCS; ++i) GSYNC();
    TSTART(0);
    if (IN(0)) for (int rep = 0; rep < REPS(0); ++rep) { if (rep) GSYNC();
        LAS float* scr = (LAS float*)(lds + wave * 16384);
        const int gw = bx * NWAVES + wave, NGW = G * NWAVES;
        constexpr int I_IN = 16 * (DIN / 32), I_FI = 16 * (2 * DFF / 32), I_FO = (DFF / 64) * (D / 32), I_RO = 16 * 32, I_WO = 16 * 32, I_PO = 8 * 32;
        constexpr int NITEMS = I_IN + I_FI + I_FO + I_RO + I_WO + I_PO;
        for (int it = gw; it < NITEMS; it += NGW) {
            int r = it;
            if (r < I_IN) { const int nblk = DIN / 32, kb = r / nblk, nb = r % nblk; transpose_item(args.in[I_W_IN], DIN, D, WIN, 64 * kb, 32 * nb, 32 * nb, nullptr, scr, lane); continue; } r -= I_IN;
            if (r < I_FI) { const int nblk = 2 * DFF / 32, kb = r / nblk, nb = r % nblk, nd = 32 * nb, pn = nd >> 8, j0 = nd & 255;
                const int ns = j0 < 128 ? 128 * pn + j0 : DFF + 128 * pn + (j0 - 128);
                transpose_item(args.in[I_W_FFN_IN], 2 * DFF, D, WFI, 64 * kb, ns, nd, args.in[I_NORM_FFN], scr, lane); continue; } r -= I_FI;
            if (r < I_FO) { const int nblk = D / 32, kb = r / nblk, nb = r % nblk; transpose_item(args.in[I_W_FFN_OUT], D, DFF, WFO, 64 * kb, 32 * nb, 32 * nb, nullptr, scr, lane); continue; } r -= I_FO;
            if (r < I_RO) { const int nblk = D / 32, kb = r / nblk, nb = r % nblk; transpose_item(args.in[I_W_RNN_OUT], D, 1536, WCAT + 512, 64 * kb, 32 * nb, 32 * nb, nullptr, scr, lane); continue; } r -= I_RO;
            if (r < I_WO) { const int nblk = D / 32, kb = r / nblk, nb = r % nblk; transpose_item(args.in[I_W_O], D, D, WO, 64 * kb, 32 * nb, 32 * nb, nullptr, scr, lane); continue; } r -= I_WO;
            { const int nblk = D / 32, kb = r / nblk, nb = r % nblk; transpose_item(args.in[I_W_POOL_OUT], D, 1536, WCAT, 64 * kb, 32 * nb, 32 * nb, nullptr, scr, lane); }
        }
        {
            const int gt = bx * NTHR + tid, NT = G * NTHR;
            const float* wg = args.in[I_W_GRP];
            for (int e = gt; e < 512 * 32; e += NT) { const int n = e >> 5, kc = (e & 31) * 8, g = n >> 7, nn = n & 127; float v[8];
#pragma unroll
                for (int j = 0; j < 8; ++j) { const int kk = kc + j - (g & 1) * 128; v[j] = (kk >= 0 && kk < 128) ? wg[((size_t)g * 128 + kk) * 128 + nn] : 0.f; }
                v4u o; o.x = cvt_pk_bf16(v[0], v[1]); o.y = cvt_pk_bf16(v[2], v[3]); o.z = cvt_pk_bf16(v[4], v[5]); o.w = cvt_pk_bf16(v[6], v[7]);
                *(v4u*)(WGRP + (size_t)n * 256 + kc) = o; }
            const float* wa = args.in[I_W_RG_A]; const float* wx = args.in[I_W_RG_X];
            for (int e = gt; e < 2048 * 16; e += NT) { const int n = e >> 4, kc = (e & 15) * 8, h = n >> 8, j = n & 255; const float* src = j < 128 ? wa : wx; const int jj = j & 127; float v[8];
#pragma unroll
                for (int q = 0; q < 8; ++q) v[q] = src[((size_t)h * 128 + kc + q) * 128 + jj];
                v4u o; o.x = cvt_pk_bf16(v[0], v[1]); o.y = cvt_pk_bf16(v[2], v[3]); o.z = cvt_pk_bf16(v[4], v[5]); o.w = cvt_pk_bf16(v[6], v[7]);
                *(v4u*)(WGATE + (size_t)n * 128 + kc) = o; }
        }
        { const int gt = bx * NTHR + tid; if (gt < DRNN) { const float z = -args.in[I_LAMBDA][gt]; ((float*)(ws + WS_SP8))[gt] = -8.0f * (fmaxf(z, 0.f) + log1pf(expf(-fabsf(z)))); } }
        const float* gmix = args.in[I_NORM_MIX];
        f32x4 gv[4];
#pragma unroll
        for (int j = 0; j < 4; ++j) gv[j] = ((const f32x4*)gmix)[lane + 64 * j];
        for (int m = gw; m < M; m += 2 * NGW) {
            const int m1 = (m + NGW < M) ? m + NGW : m;
            const f32x4* xr0 = (const f32x4*)(x + (size_t)m * D) + lane; const f32x4* xr1 = (const f32x4*)(x + (size_t)m1 * D) + lane; f32x4 v0[4], v1[4]; float s0 = 0.f, s1 = 0.f;
#pragma unroll
            for (int j = 0; j < 4; ++j) { v0[j] = xr0[64 * j]; v1[j] = xr1[64 * j]; }
#pragma unroll
            for (int j = 0; j < 4; ++j) { s0 += (v0[j].x * v0[j].x + v0[j].y * v0[j].y) + (v0[j].z * v0[j].z + v0[j].w * v0[j].w); s1 += (v1[j].x * v1[j].x + v1[j].y * v1[j].y) + (v1[j].z * v1[j].z + v1[j].w * v1[j].w); }
            const float rs0 = 1.0f / sqrtf(wave_sum(s0) * (1.f / D) + EPS), rs1 = 1.0f / sqrtf(wave_sum(s1) * (1.f / D) + EPS);
            v2u* o0 = (v2u*)(XN + (size_t)m * D) + lane; v2u* o1 = (v2u*)(XN + (size_t)m1 * D) + lane;
#pragma unroll
            for (int j = 0; j < 4; ++j) { const f32x4 y0 = v0[j] * rs0 * gv[j], y1 = v1[j] * rs1 * gv[j]; v2u w0, w1; w0.x = cvt_pk_bf16(y0.x, y0.y); w0.y = cvt_pk_bf16(y0.z, y0.w); w1.x = cvt_pk_bf16(y1.x, y1.y); w1.y = cvt_pk_bf16(y1.z, y1.w); o0[64 * j] = w0; o1[64 * j] = w1; }
        }
        __syncthreads();
    }
    SEAM(0);
    TEND(0);

    TSTART(1);
    if (IN(1)) for (int rep = 0; rep < REPS(1); ++rep) { if (rep) GSYNC();
        pg8::Gemm g{XN, WIN, M, DIN, D, D, D, 0, 0}; pg8::StaticOrder S; S.init(M, DIN, G, bx);
        pg8::EpiProj E{UP, UR, UG, G0, G1};
        pg8::gemm_phase<pg8::EpiProj, true>(lds, g, S, E);
    }
    SEAM(1);
    TEND(1);

    TSTART(2);
    if (IN(2)) for (int rep = 0; rep < REPS(2); ++rep) { if (rep) GSYNC();
        { const int gw = bx * NWAVES + wave, NGW = G * NWAVES;
          for (int wi = gw; wi < (M / 32) * 4; wi += NGW) { const int g = wi & 3, t0 = (wi >> 2) * 32 + (lane >> 4) * 8, co = g * 16 + (lane & 15);
              const bf16* src = UP + (size_t)t0 * DPOOL + co * 8; bf16* dst = POOLED + (size_t)t0 * DPOOL + co * 8; const int tl = t0 & (SEQ - 1);
              if (g == 0) pool_item<2>(src, dst, tl); else if (g == 1) pool_item<4>(src, dst, tl); else if (g == 2) pool_item<8>(src, dst, tl); else pool_item<16>(src, dst, tl); } }
        { const int gt = bx * NTHR + tid, NT = G * NTHR;
          for (int it = gt; it < (M / 8) * 128; it += NT) { const int co = it & 127, t0 = (it >> 7) * 8, tl = t0 & (SEQ - 1);
              const bf16* src = UR + (size_t)t0 * DRNN + co * 8; bf16* dst = V + (size_t)t0 * DRNN + co * 8;
              const float* cw = args.in[I_CONV_W] + co * 8; const float* cb = args.in[I_CONV_B] + co * 8;
              v4u rw[11];
#pragma unroll
              for (int k = 0; k < 11; ++k) rw[k] = (k >= 3 || tl != 0) ? *(const v4u*)(src + (ptrdiff_t)(k - 3) * DRNN) : (v4u){0u, 0u, 0u, 0u};
              f32x4 w0[2], w1[2], w2[2], w3[2], bb[2];
#pragma unroll
              for (int n = 0; n < 2; ++n) { w0[n] = *(const f32x4*)(cw + 4 * n); w1[n] = *(const f32x4*)(cw + 1024 + 4 * n); w2[n] = *(const f32x4*)(cw + 2048 + 4 * n); w3[n] = *(const f32x4*)(cw + 3072 + 4 * n); bb[n] = *(const f32x4*)(cb + 4 * n); }
#pragma unroll
              for (int i = 0; i < 8; ++i) { f32x4 a[2], b[2], c[2], d[2]; pg8::unpack8(rw[i], a[0], a[1]); pg8::unpack8(rw[i + 1], b[0], b[1]); pg8::unpack8(rw[i + 2], c[0], c[1]); pg8::unpack8(rw[i + 3], d[0], d[1]);
                  *(v4u*)(dst + (size_t)i * DRNN) = pg8::pack8(bb[0] + w0[0] * a[0] + w1[0] * b[0] + w2[0] * c[0] + w3[0] * d[0], bb[1] + w0[1] * a[1] + w1[1] * b[1] + w2[1] * c[1] + w3[1] * d[1]); }
          } }
    }
    SEAM(2);
    TEND(2);

    TSTART(3);
    if (IN(3)) for (int rep = 0; rep < REPS(3); ++rep) { if (rep) GSYNC();
        { pg8::Gemm g{POOLED, WGRP, M, 512, 256, 512, 256, 0, 256}; pg8::StaticOrder S; S.init(M, 512, G, (bx + G / 2) % G);
          pg8::EpiGrp E{CAT, 1536, args.in[I_POOL_SCALE]};
          pg8::gemm_phase<pg8::EpiGrp, true>(lds, g, S, E); }
        { pg8::Gemm g{V, WGATE, M, 2048, 128, 1024, 128, 0, 128}; pg8::StaticOrder S; S.init(M, 2048, G, bx);
          pg8::EpiGate E{V, LA, BB, args.in[I_B_RG_A], args.in[I_B_RG_X], (const float*)(ws + WS_SP8)};
          pg8::gemm_phase<pg8::EpiGate, true>(lds, g, S, E); }
    }
    SEAM(3);
    TEND(3);

    TSTART(4);
    TEND(4);

    TSTART(5);
    if (IN(5)) for (int rep = 0; rep < REPS(5); ++rep) { if (rep) GSYNC();
        LAS float* PAS = (LAS float*)lds; LAS float* PAH = PAS + 8 * 512; LAS float* PBS = PAH + 8 * 512; LAS float* PBH = PBS + 8 * 512;
        unsigned* flags = (unsigned*)ws + 8192;
        for (int bi = bx; bi < NB * SCAN_NC * 2; bi += G) { const int hh = bi & 1, c = (bi >> 1) % SCAN_NC, b = bi / (2 * SCAN_NC);
            const size_t off = ((size_t)b * SEQ + (size_t)c * SCAN_T + wave * 16) * DRNN + hh * 512 + lane * 8;
            v4u lwk[16], bwk[16];
#pragma unroll
            for (int i = 0; i < 16; ++i) { lwk[i] = *(const v4u*)(LA + off + (size_t)i * DRNN); bwk[i] = *(const v4u*)(BB + off + (size_t)i * DRNN); }
            { f32x4 S[2] = {{0.f, 0.f, 0.f, 0.f}, {0.f, 0.f, 0.f, 0.f}}, H[2] = {{0.f, 0.f, 0.f, 0.f}, {0.f, 0.f, 0.f, 0.f}};
#pragma unroll
              for (int i = 0; i < 16; ++i) { f32x4 l[2], bq[2]; pg8::unpack8(lwk[i], l[0], l[1]); pg8::unpack8(bwk[i], bq[0], bq[1]);
#pragma unroll
                  for (int n = 0; n < 2; ++n)
#pragma unroll
                      for (int j = 0; j < 4; ++j) { H[n][j] = __expf(l[n][j]) * H[n][j] + bq[n][j]; S[n][j] += l[n][j]; } }
              *(LAS f32x4*)(PBS + wave * 512 + lane * 8) = S[0]; *(LAS f32x4*)(PBS + wave * 512 + lane * 8 + 4) = S[1];
              *(LAS f32x4*)(PBH + wave * 512 + lane * 8) = H[0]; *(LAS f32x4*)(PBH + wave * 512 + lane * 8 + 4) = H[1]; }
#pragma unroll
            for (int i = 0; i < 16; ++i) asm volatile("" : "+v"(lwk[i]), "+v"(bwk[i]));
            __syncthreads();
            { float h = 0.f, st = 0.f;
#pragma unroll
              for (int sb = 0; sb < 8; ++sb) { const float sv = PBS[sb * 512 + tid]; h = __expf(sv) * h + PBH[sb * 512 + tid]; st += sv; }
              const size_t co = ((size_t)b * SCAN_NC + c) * DRNN + hh * 512 + tid;
              __hip_atomic_store(CS + co, st, __ATOMIC_RELAXED, __HIP_MEMORY_SCOPE_AGENT); __hip_atomic_store(CH + co, h, __ATOMIC_RELAXED, __HIP_MEMORY_SCOPE_AGENT); }
            asm volatile("s_waitcnt vmcnt(0)" ::: "memory");
            __syncthreads();
            if (tid == 0) __hip_atomic_store(flags + ((b * 2 + hh) * SCAN_NC + c) * 16, 1u, __ATOMIC_RELAXED, __HIP_MEMORY_SCOPE_AGENT);
            { f32x4 S[2] = {{0.f, 0.f, 0.f, 0.f}, {0.f, 0.f, 0.f, 0.f}}, H[2] = {{0.f, 0.f, 0.f, 0.f}, {0.f, 0.f, 0.f, 0.f}};
              if (wave * 4 < c) {
                  for (int q = 0; q < 4; ++q) { const int cc = wave * 4 + q; if (cc < c) { unsigned* f = flags + ((b * 2 + hh) * SCAN_NC + cc) * 16; unsigned sp = 0;
                      while ((unsigned)__builtin_amdgcn_readfirstlane(__hip_atomic_load(f, __ATOMIC_RELAXED, __HIP_MEMORY_SCOPE_AGENT)) == 0u) { __builtin_amdgcn_s_sleep(1); if (++sp > (1u << 20)) break; } } }
                  __builtin_amdgcn_fence(__ATOMIC_ACQUIRE, "agent");
#pragma unroll
                  for (int q0 = 0; q0 < 4; q0 += 2) { f32x4 cs[2][2], ch[2][2];
#pragma unroll
                      for (int q = 0; q < 2; ++q) { const int cc = wave * 4 + q0 + q; const size_t co = ((size_t)b * SCAN_NC + (cc < c ? cc : 0)) * DRNN + hh * 512 + lane * 8;
                          cs[q][0] = *(const f32x4*)(CS + co); cs[q][1] = *(const f32x4*)(CS + co + 4); ch[q][0] = *(const f32x4*)(CH + co); ch[q][1] = *(const f32x4*)(CH + co + 4); }
#pragma unroll
                      for (int q = 0; q < 2; ++q) { if (wave * 4 + q0 + q < c) {
#pragma unroll
                          for (int n = 0; n < 2; ++n)
#pragma unroll
                              for (int j = 0; j < 4; ++j) { H[n][j] = __expf(cs[q][n][j]) * H[n][j] + ch[q][n][j]; S[n][j] += cs[q][n][j]; } } }
                      asm volatile("" ::: "memory"); }
              }
              *(LAS f32x4*)(PAS + wave * 512 + lane * 8) = S[0]; *(LAS f32x4*)(PAS + wave * 512 + lane * 8 + 4) = S[1];
              *(LAS f32x4*)(PAH + wave * 512 + lane * 8) = H[0]; *(LAS f32x4*)(PAH + wave * 512 + lane * 8 + 4) = H[1]; }
            __syncthreads();
            f32x4 h[2] = {{0.f, 0.f, 0.f, 0.f}, {0.f, 0.f, 0.f, 0.f}};
#pragma unroll
            for (int sb = 0; sb < 8; ++sb) {
#pragma unroll
                for (int n = 0; n < 2; ++n) { const f32x4 sv = *(const LAS f32x4*)(PAS + sb * 512 + lane * 8 + 4 * n), hv = *(const LAS f32x4*)(PAH + sb * 512 + lane * 8 + 4 * n);
#pragma unroll
                    for (int j = 0; j < 4; ++j) h[n][j] = __expf(sv[j]) * h[n][j] + hv[j]; } }
            for (int sb = 0; sb < wave; ++sb) {
#pragma unroll
                for (int n = 0; n < 2; ++n) { const f32x4 sv = *(const LAS f32x4*)(PBS + sb * 512 + lane * 8 + 4 * n), hv = *(const LAS f32x4*)(PBH + sb * 512 + lane * 8 + 4 * n);
#pragma unroll
                    for (int j = 0; j < 4; ++j) h[n][j] = __expf(sv[j]) * h[n][j] + hv[j]; } }
            const bf16* ugp = UG + off;
            bf16* hgp = CAT + ((size_t)b * SEQ + (size_t)c * SCAN_T + wave * 16) * 1536 + 512 + hh * 512 + lane * 8;
#pragma unroll
            for (int i0 = 0; i0 < 16; i0 += 8) { v4u gw8[8];
#pragma unroll
                for (int i = 0; i < 8; ++i) gw8[i] = *(const v4u*)(ugp + (size_t)(i0 + i) * DRNN);
#pragma unroll
                for (int i = 0; i < 8; ++i) { f32x4 l[2], bq[2], gq[2], o[2]; pg8::unpack8(lwk[i0 + i], l[0], l[1]); pg8::unpack8(bwk[i0 + i], bq[0], bq[1]); pg8::unpack8(gw8[i], gq[0], gq[1]);
#pragma unroll
                    for (int n = 0; n < 2; ++n)
#pragma unroll
                        for (int j = 0; j < 4; ++j) { h[n][j] = __expf(l[n][j]) * h[n][j] + bq[n][j]; o[n][j] = h[n][j] * pg8::gelu_tanh_(gq[n][j]); }
                    *(v4u*)(hgp + (size_t)(i0 + i) * 1536) = pg8::pack8(o[0], o[1]); } }
            __syncthreads();
        }
    }
    SEAM(5);
    TEND(5);

    TSTART(6);
    if (IN(6)) for (int rep = 0; rep < REPS(6); ++rep) { if (rep) GSYNC();
        pg8::Gemm g{CAT, WCAT, M, D, 1536, 1536, 1536, 0, 0}; pg8::StaticOrder S; S.init(M, D, G, bx);
        pg8::EpiMix E{G0, G1, MIXB};
        pg8::gemm_phase<pg8::EpiMix, true, 8>(lds, g, S, E);
    }
    SEAM(6);
    TEND(6);

    TSTART(7);
    if (IN(7)) for (int rep = 0; rep < REPS(7); ++rep) { if (rep) GSYNC();
        pg8::Gemm g{MIXB, WO, M, D, D, D, D, 0, 0}; pg8::StaticOrder S; S.init(M, D, G, bx);
        pg8::EpiRes1 E{x, X1B, SSQ};
        pg8::gemm_phase<pg8::EpiRes1, true>(lds, g, S, E);
    }
    SEAM(7);
    TEND(7);

    TSTART(8);
    if (IN(8)) for (int rep = 0; rep < REPS(8); ++rep) { if (rep) GSYNC();
        pg8::Gemm g{X1B, WFI, M, 2 * DFF, D, D, D, 0, 0}; pg8::StaticOrder S; S.init(M, 2 * DFF, G, bx);
        pg8::EpiSwiglu E{SSQ, ACT};
        pg8::gemm_phase<pg8::EpiSwiglu, true>(lds, g, S, E);
    }
    SEAM(8);
    TEND(8);

    TSTART(9);
    if (IN(9)) for (int rep = 0; rep < REPS(9); ++rep) { if (rep) GSYNC();
        pg8::Gemm g{ACT, WFO, M, D, DFF, DFF, DFF, 0, 0}; pg8::StaticOrder S; S.init(M, D, G, bx);
        if (G == 256) { pg8::EpiFinal E{X1B, X1, (float*)(ws + WS_SSQ2), (unsigned*)ws + 4096, args.in[I_NORM_FINAL]};
            pg8::gemm_phase<pg8::EpiFinal, true>(lds, g, S, E); }
        else { pg8::EpiRes2 E{X1B, X1};
            pg8::gemm_phase<pg8::EpiRes2, true>(lds, g, S, E); }
    }
    if (G != 256) SEAM(9);
    TEND(9);

    TSTART(10);
    if (IN(10) && G != 256) for (int rep = 0; rep < REPS(10); ++rep) { if (rep) GSYNC();
        const int gw = bx * NWAVES + wave, NGW = G * NWAVES;
        const float* gf = args.in[I_NORM_FINAL]; f32x4 gv[4];
#pragma unroll
        for (int j = 0; j < 4; ++j) gv[j] = ((const f32x4*)gf)[lane + 64 * j];
        for (int m = gw; m < M; m += NGW) {
            f32x4* xr = (f32x4*)(X1 + (size_t)m * D) + lane; f32x4 v[4]; float s = 0.f;
#pragma unroll
            for (int j = 0; j < 4; ++j) { v[j] = xr[64 * j]; s += (v[j].x * v[j].x + v[j].y * v[j].y) + (v[j].z * v[j].z + v[j].w * v[j].w); }
            const float rs = 1.0f / sqrtf(wave_sum(s) * (1.f / D) + EPS);
#pragma unroll
            for (int j = 0; j < 4; ++j) xr[64 * j] = v[j] * rs * gv[j];
        }
    }
    if (PROBE_PHASE == 10 || PROBE_PHASE == 99) tp1 = __builtin_amdgcn_s_memrealtime();
    if (PROBE_PHASE >= 0 && bx == 0 && tid == 0) { const unsigned long long dt = (tp1 - tp0) * PROBE_MULT, te = __builtin_amdgcn_s_memrealtime(); while (__builtin_amdgcn_s_memrealtime() - te < dt) __builtin_amdgcn_s_sleep(8); }
#undef IN
#undef SEAM
}

extern "C" void kernel_launch(void* const* d_in, const int* in_sizes, int n_in, void* d_out, int out_size, void* d_ws, size_t ws_size, hipStream_t stream) {
    static int grid = 0;
    if (grid == 0) {
        if (n_in != 19 || out_size != M * D || ws_size < WS_END) { fprintf(stderr, "kernel_launch: unexpected shapes (n_in %d out %d ws %zu)\n", n_in, out_size, ws_size); grid = -1; return; }
        int dev = 0, cus = 0, per_cu = 0;
        hipGetDevice(&dev);
        hipDeviceGetAttribute(&cus, hipDeviceAttributeMultiprocessorCount, dev);
        if (hipFuncSetAttribute((const void*)fwd_kernel, hipFuncAttributeMaxDynamicSharedMemorySize, LDS_BYTES) != hipSuccess) { fprintf(stderr, "kernel_launch: hipFuncSetAttribute failed\n"); grid = -1; return; }
        if (hipOccupancyMaxActiveBlocksPerMultiprocessor(&per_cu, (const void*)fwd_kernel, NTHR, LDS_BYTES) != hipSuccess || per_cu < 1) { fprintf(stderr, "kernel_launch: occupancy query says %d\n", per_cu); per_cu = 1; }
        (void)hipGetLastError();
        grid = cus * 1;
        fprintf(stderr, "kernel_launch: grid %d (cus %d, per_cu %d)\n", grid, cus, per_cu);
    }
    if (grid < 0) return;
    if (hipMemsetAsync(d_ws, 0, 49152, stream) != hipSuccess) { fprintf(stderr, "kernel_launch: memset failed\n"); return; }
    Args a{};
    for (int i = 0; i < 19; ++i) a.in[i] = (const float*)d_in[i];
    a.out = (float*)d_out; a.ws = (unsigned char*)d_ws;
#if MK_PER_PHASE
    for (int p = 0; p < NPH; ++p) { a.ph_lo = p; a.ph_hi = p + 1; hipLaunchKernelGGL(fwd_kernel, dim3(grid), dim3(NTHR), LDS_BYTES, stream, a); }
#else
    a.ph_lo = 0; a.ph_hi = NPH;
    void* kargs[] = {&a};
    hipError_t e = hipLaunchCooperativeKernel((const void*)fwd_kernel, dim3(grid), dim3(NTHR), kargs, LDS_BYTES, stream);
    if (e != hipSuccess) fprintf(stderr, "cooperative launch failed: %s (grid %d)\n", hipGetErrorString(e), grid);
#endif
}
```

```cpp
#include <hip/hip_runtime.h>
#include <hip/hip_cooperative_groups.h>
#include <cstdio>
#include <cstdint>
namespace cg = cooperative_groups;

#ifndef MK_PER_PHASE
#define MK_PER_PHASE 0
#endif

namespace pg8 {
#define PG8_LAS __attribute__((address_space(3)))
typedef unsigned short bf16_t;
typedef short bf16x8 __attribute__((ext_vector_type(8)));
typedef float f32x4 __attribute__((ext_vector_type(4)));
typedef float f32x2 __attribute__((ext_vector_type(2)));
typedef unsigned u32x4 __attribute__((ext_vector_type(4)));
typedef unsigned u32x2 __attribute__((ext_vector_type(2)));
constexpr int BM = 256, BK = 64, HALF = 128, HTB = HALF * BK * 2, STAGE_BYTES = 8 * HTB, NXCD = 8, WGM = 8;

__host__ __device__ __forceinline__ int lds_byte(int r, int c) { const int st = (r >> 4) * 2 + (c >> 5), rr = r & 15, cc = c & 31, ob = rr * 64 + cc * 2; return st * 1024 + (ob ^ (((ob >> 9) & 1) << 5)); }
__host__ __device__ __forceinline__ void stage_rc(int b, int& R, int& C) { const int st = b / 1024, sb = b % 1024, swz = sb ^ (((sb >> 9) & 1) << 5); R = (st >> 1) * 16 + swz / 64; C = (st & 1) * 32 + (swz % 64) / 2; }
__host__ __device__ __forceinline__ int perm32(int rho) { const int n = rho >> 4, i = rho & 15; return 8 * (i >> 2) + 4 * n + (i & 3); }

struct Unit { int pm, pn, rh; };
struct Gemm { const bf16_t* A; const bf16_t* Bt; int M, N, K, lda, ldb, ash, amul; };

struct StaticOrder {
    int nM, nN, nwg, G, c, limit;
    __host__ __device__ void init(int M, int N, int G_, int c_) { nM = M / BM; nN = N / BM; nwg = nM * nN; G = G_; c = c_; limit = nwg; }
    __host__ __device__ void map(int L, Unit& u) const {
        int wgid = L; { const int q = nwg / NXCD, r = nwg % NXCD, xcd = wgid % NXCD, off = wgid / NXCD; wgid = (xcd < r ? xcd * (q + 1) : r * (q + 1) + (xcd - r) * q) + off; }
        const int nig = WGM * nN, gid = wgid / nig, fm = gid * WGM, gsz = (nM - fm) < WGM ? (nM - fm) : WGM;
        u.pm = fm + ((wgid % nig) % gsz); u.pn = (wgid % nig) / gsz; u.rh = 0;
    }
    __host__ __device__ bool next(int i, Unit& u) const {
        const long L = (long)i * G + c; if (L >= limit) return false;
        map((int)L, u); return true;
    }
};

__device__ __forceinline__ unsigned cvt_pk_bf16(float lo, float hi) { unsigned r; asm volatile("v_cvt_pk_bf16_f32 %0, %1, %2" : "=v"(r) : "v"(lo), "v"(hi)); return r; }
__device__ __forceinline__ float bf_lo(unsigned w) { return __uint_as_float(w << 16); }
__device__ __forceinline__ float bf_hi(unsigned w) { return __uint_as_float(w & 0xffff0000u); }
__device__ __forceinline__ float sigmoidf_(float x) { return __builtin_amdgcn_rcpf(1.0f + __expf(-x)); }
__device__ __forceinline__ float gelu_tanh_(float x) { const float z = 1.5957691216057308f * (x + 0.044715f * x * x * x); return x * sigmoidf_(z); }
__device__ __forceinline__ u32x4 pack8(const f32x4 a, const f32x4 b) { u32x4 w; w.x = cvt_pk_bf16(a[0], a[1]); w.y = cvt_pk_bf16(a[2], a[3]); w.z = cvt_pk_bf16(b[0], b[1]); w.w = cvt_pk_bf16(b[2], b[3]); return w; }
__device__ __forceinline__ void unpack8(const u32x4 w, f32x4& a, f32x4& b) { a = (f32x4){bf_lo(w.x), bf_hi(w.x), bf_lo(w.y), bf_hi(w.y)}; b = (f32x4){bf_lo(w.z), bf_hi(w.z), bf_lo(w.w), bf_hi(w.w)}; }

#define EPI_ROWS_BEGIN _Pragma("unroll") for (int ai = 0; ai < NAI; ++ai) _Pragma("unroll") for (int m = 0; m < 4; ++m) { const int row = u.pm * BM + u.rh + ai * HALF + wr * 64 + m * 16 + fr;
#define EPI_ROWS_END }

struct EpiProj {
    bf16_t *UP, *UR, *UG, *RB, *G1;
    template <int NAI> __device__ __forceinline__ void run(const f32x4 (&acc)[2][2][4][2], const Unit& u, int wr, int wc, int fr, int fq) const {
        const int pn = u.pn;
        if (pn < 10) {
            bf16_t* base; int ldc, colt;
            if (pn < 2) { base = UP; ldc = 512; colt = pn * 256; }
            else if (pn < 6) { base = UR; ldc = 1024; colt = (pn - 2) * 256; }
            else { base = UG; ldc = 1024; colt = (pn - 6) * 256; }
            const int col0 = colt + wc * 32 + 8 * fq;
            EPI_ROWS_BEGIN
                bf16_t* rowp = base + (unsigned)((unsigned)row * (unsigned)ldc + (unsigned)col0);
#pragma unroll
                for (int bj = 0; bj < 2; ++bj) *(u32x4*)(rowp + bj * HALF) = pack8(acc[ai][bj][m][0], acc[ai][bj][m][1]);
            EPI_ROWS_END
        } else {
            const int ch0 = (pn - 10) * 128 + wc * 32 + 8 * fq;
            EPI_ROWS_BEGIN
                const unsigned off = (unsigned)row * 1024u + (unsigned)ch0; f32x4 rr[2], gg[2];
#pragma unroll
                for (int n = 0; n < 2; ++n)
#pragma unroll
                    for (int j = 0; j < 4; ++j) { const float d0 = 1.0f + fminf(__expf(-acc[ai][0][m][n][j]), 1e18f), d1 = 1.0f + fminf(__expf(-acc[ai][1][m][n][j]), 1e18f);
                        gg[n][j] = __builtin_amdgcn_rcpf(d1); rr[n][j] = d1 * __builtin_amdgcn_rcpf(d0); }
                *(u32x4*)(RB + off) = pack8(rr[0], rr[1]); *(u32x4*)(G1 + off) = pack8(gg[0], gg[1]);
            EPI_ROWS_END
        }
    }
};
struct EpiGrp {
    bf16_t* O; int ldc; const float* scale;
    template <int NAI> __device__ __forceinline__ void run(const f32x4 (&acc)[2][2][4][2], const Unit& u, int wr, int wc, int fr, int fq) const {
        const int col0 = u.pn * BM + wc * 32 + 8 * fq;
        f32x4 sc[2][2];
#pragma unroll
        for (int bj = 0; bj < 2; ++bj)
#pragma unroll
            for (int n = 0; n < 2; ++n) sc[bj][n] = *(const f32x4*)(scale + col0 + bj * HALF + 4 * n);
        EPI_ROWS_BEGIN
            bf16_t* rowp = O + (unsigned)((unsigned)row * (unsigned)ldc + (unsigned)col0);
#pragma unroll
            for (int bj = 0; bj < 2; ++bj) *(u32x4*)(rowp + bj * HALF) = pack8(acc[ai][bj][m][0] * sc[bj][0], acc[ai][bj][m][1] * sc[bj][1]);
        EPI_ROWS_END
    }
};
struct EpiGate {
    const bf16_t* V; bf16_t *LA, *BB; const float *b_a, *b_x, *sp8;
    template <int NAI> __device__ __forceinline__ void run(const f32x4 (&acc)[2][2][4][2], const Unit& u, int wr, int wc, int fr, int fq) const {
        const int ch0 = u.pn * 128 + wc * 32 + 8 * fq;
        f32x4 ba[2], bx[2], sp[2];
#pragma unroll
        for (int n = 0; n < 2; ++n) { ba[n] = *(const f32x4*)(b_a + ch0 + 4 * n); bx[n] = *(const f32x4*)(b_x + ch0 + 4 * n); sp[n] = *(const f32x4*)(sp8 + ch0 + 4 * n); }
        EPI_ROWS_BEGIN
            const unsigned off = (unsigned)row * 1024u + (unsigned)ch0;
            const u32x4 vw = *(const u32x4*)(V + off); f32x4 vv[2]; unpack8(vw, vv[0], vv[1]);
            f32x4 la[2], bb[2];
#pragma unroll
            for (int n = 0; n < 2; ++n)
#pragma unroll
                for (int j = 0; j < 4; ++j) {
                    const float r = sigmoidf_(acc[ai][0][m][n][j] + ba[n][j]), ig = sigmoidf_(acc[ai][1][m][n][j] + bx[n][j]);
                    const float l = sp[n][j] * r, x2 = 2.0f * l;
                    const float em1 = (x2 > -0.125f) ? x2 * (1.0f + 0.5f * x2 * (1.0f + 0.33333334f * x2 * (1.0f + 0.25f * x2 * (1.0f + 0.2f * x2)))) : (__expf(x2) - 1.0f);
                    la[n][j] = l; bb[n][j] = __builtin_amdgcn_sqrtf(fmaxf(-em1, 0.f)) * ig * vv[n][j]; }
            *(u32x4*)(LA + off) = pack8(la[0], la[1]); *(u32x4*)(BB + off) = pack8(bb[0], bb[1]);
            asm volatile("" ::: "memory");
        EPI_ROWS_END
    }
};
struct EpiMix {
    const bf16_t *RB, *G1; bf16_t* MIXB;
    __device__ __forceinline__ void mid(f32x4 (&acc)[2][2][4][2], const Unit& u0, int wr, int wc, int fr, int fq) const {
        constexpr int NAI = 2; Unit u = u0; asm volatile("" : "+s"(u.pm), "+s"(u.pn));
        const int col0 = u.pn * BM + wc * 32 + 8 * fq;
        EPI_ROWS_BEGIN
            const unsigned off = (unsigned)row * 1024u + (unsigned)col0;
#pragma unroll
            for (int bj = 0; bj < 2; ++bj) { f32x4 r[2]; unpack8(*(const u32x4*)(RB + off + bj * HALF), r[0], r[1]); acc[ai][bj][m][0] *= r[0]; acc[ai][bj][m][1] *= r[1]; }
        EPI_ROWS_END
    }
    template <int NAI> __device__ __forceinline__ void run(const f32x4 (&acc)[2][2][4][2], const Unit& u, int wr, int wc, int fr, int fq) const {
        const int col0 = u.pn * BM + wc * 32 + 8 * fq;
        EPI_ROWS_BEGIN
            const unsigned off = (unsigned)row * 1024u + (unsigned)col0;
#pragma unroll
            for (int bj = 0; bj < 2; ++bj) { f32x4 g[2]; unpack8(*(const u32x4*)(G1 + off + bj * HALF), g[0], g[1]);
                *(u32x4*)(MIXB + off + bj * HALF) = pack8(g[0] * acc[ai][bj][m][0], g[1] * acc[ai][bj][m][1]); }
        EPI_ROWS_END
    }
};
struct EpiRes1 {
    const float* X; bf16_t* X1B; float* SSQ;
    template <int NAI> __device__ __forceinline__ void run(const f32x4 (&acc)[2][2][4][2], const Unit& u, int wr, int wc, int fr, int fq) const {
        const int col0 = u.pn * BM + wc * 32 + 8 * fq;
        EPI_ROWS_BEGIN
            const unsigned off = (unsigned)row * 1024u + (unsigned)col0; float ss = 0.f;
#pragma unroll
            for (int bj = 0; bj < 2; ++bj) {
                const f32x4 a = *(const f32x4*)(X + off + bj * HALF) + acc[ai][bj][m][0], b = *(const f32x4*)(X + off + bj * HALF + 4) + acc[ai][bj][m][1];
                *(u32x4*)(X1B + off + bj * HALF) = pack8(a, b);
                ss += (a[0] * a[0] + a[1] * a[1]) + (a[2] * a[2] + a[3] * a[3]) + (b[0] * b[0] + b[1] * b[1]) + (b[2] * b[2] + b[3] * b[3]); }
            ss += __shfl_xor(ss, 16); ss += __shfl_xor(ss, 32);
            if (fq == 0) SSQ[(unsigned)row * 16u + (unsigned)(u.pn * 4 + wc)] = ss;
        EPI_ROWS_END
    }
};
struct EpiSwiglu {
    const float* SSQ; bf16_t* ACT;
    template <int NAI> __device__ __forceinline__ void run(const f32x4 (&acc)[2][2][4][2], const Unit& u, int wr, int wc, int fr, int fq) const {
        const int col0 = u.pn * 128 + wc * 32 + 8 * fq;
        EPI_ROWS_BEGIN
            const f32x4 st = *(const f32x4*)(SSQ + (unsigned)row * 16u + (unsigned)(4 * fq));
            float sq = (st[0] + st[1]) + (st[2] + st[3]); sq += __shfl_xor(sq, 16); sq += __shfl_xor(sq, 32);
            const float rs = __builtin_amdgcn_rsqf(sq * (1.0f / 1024.0f) + 1e-6f);
            f32x4 o[2];
#pragma unroll
            for (int n = 0; n < 2; ++n)
#pragma unroll
                for (int j = 0; j < 4; ++j) { const float g = acc[ai][0][m][n][j] * rs, up = acc[ai][1][m][n][j] * rs; o[n][j] = g * sigmoidf_(g) * up; }
            *(u32x4*)(ACT + (unsigned)((unsigned)row * 2816u + (unsigned)col0)) = pack8(o[0], o[1]);
        EPI_ROWS_END
    }
};
struct EpiRes2 {
    const bf16_t* X1B; float* OUT;
    template <int NAI> __device__ __forceinline__ void run(const f32x4 (&acc)[2][2][4][2], const Unit& u, int wr, int wc, int fr, int fq) const {
        const int col0 = u.pn * BM + wc * 32 + 8 * fq;
        EPI_ROWS_BEGIN
            const unsigned off = (unsigned)row * 1024u + (unsigned)col0;
#pragma unroll
            for (int bj = 0; bj < 2; ++bj) { f32x4 xa, xb; unpack8(*(const u32x4*)(X1B + off + bj * HALF), xa, xb);
                *(f32x4*)(OUT + off + bj * HALF) = xa + acc[ai][bj][m][0]; *(f32x4*)(OUT + off + bj * HALF + 4) = xb + acc[ai][bj][m][1]; }
        EPI_ROWS_END
    }
};

struct EpiFinal {
    const bf16_t* X1B; float* OUT; float* SSQ2; unsigned* cnt; const float* gfin;
    template <int NAI> __device__ __forceinline__ void run(f32x4 (&acc)[2][2][4][2], const Unit& u, int wr, int wc, int fr, int fq) const {
        const int col0 = u.pn * BM + wc * 32 + 8 * fq;
        EPI_ROWS_BEGIN
            const unsigned off = (unsigned)row * 1024u + (unsigned)col0; float ss = 0.f;
#pragma unroll
            for (int bj = 0; bj < 2; ++bj) { f32x4 xa, xb; unpack8(*(const u32x4*)(X1B + off + bj * HALF), xa, xb);
                const f32x4 a = xa + acc[ai][bj][m][0], b = xb + acc[ai][bj][m][1]; acc[ai][bj][m][0] = a; acc[ai][bj][m][1] = b;
                ss += (a[0] * a[0] + a[1] * a[1]) + (a[2] * a[2] + a[3] * a[3]) + (b[0] * b[0] + b[1] * b[1]) + (b[2] * b[2] + b[3] * b[3]); }
            ss += __shfl_xor(ss, 16); ss += __shfl_xor(ss, 32);
            if (fq == 0) __hip_atomic_store(SSQ2 + (unsigned)row * 16u + (unsigned)(u.pn * 4 + wc), ss, __ATOMIC_RELAXED, __HIP_MEMORY_SCOPE_AGENT);
        EPI_ROWS_END
        asm volatile("s_waitcnt vmcnt(0)" ::: "memory");
        unsigned* c = cnt + 64 * u.pm;
        if ((threadIdx.x & 63) == 0) __hip_atomic_fetch_add(c, 1u, __ATOMIC_RELAXED, __HIP_MEMORY_SCOPE_AGENT);
        { unsigned sp = 0;
          while ((unsigned)__builtin_amdgcn_readfirstlane(__hip_atomic_load(c, __ATOMIC_RELAXED, __HIP_MEMORY_SCOPE_AGENT)) < 32u) { __builtin_amdgcn_s_sleep(2); if (++sp > (1u << 20)) break; } }
        __builtin_amdgcn_fence(__ATOMIC_ACQUIRE, "agent");
        f32x4 gv[2][2];
#pragma unroll
        for (int bj = 0; bj < 2; ++bj)
#pragma unroll
            for (int n = 0; n < 2; ++n) gv[bj][n] = *(const f32x4*)(gfin + col0 + bj * HALF + 4 * n);
        EPI_ROWS_BEGIN
            const unsigned off = (unsigned)row * 1024u + (unsigned)col0;
            const unsigned long long* sl = (const unsigned long long*)(SSQ2 + (unsigned)row * 16u + (unsigned)(4 * fq));
            const unsigned long long w0 = __hip_atomic_load(sl, __ATOMIC_RELAXED, __HIP_MEMORY_SCOPE_AGENT), w1 = __hip_atomic_load(sl + 1, __ATOMIC_RELAXED, __HIP_MEMORY_SCOPE_AGENT);
            float sq = (__uint_as_float((unsigned)w0) + __uint_as_float((unsigned)(w0 >> 32))) + (__uint_as_float((unsigned)w1) + __uint_as_float((unsigned)(w1 >> 32)));
            sq += __shfl_xor(sq, 16); sq += __shfl_xor(sq, 32);
            const float rs = 1.0f / sqrtf(sq * (1.0f / 1024.0f) + 1e-6f);
#pragma unroll
            for (int bj = 0; bj < 2; ++bj) { *(f32x4*)(OUT + off + bj * HALF) = acc[ai][bj][m][0] * rs * gv[bj][0]; *(f32x4*)(OUT + off + bj * HALF + 4) = acc[ai][bj][m][1] * rs * gv[bj][1]; }
        EPI_ROWS_END
    }
};

template <class Epi, bool ALIGN_EPI, int MID_T = -1>
__device__ __forceinline__ void gemm_phase(PG8_LAS unsigned char* lds, const Gemm g, const StaticOrder& S, const Epi& E) {
    const int tid = threadIdx.x, wid = __builtin_amdgcn_readfirstlane(tid >> 6), lane = tid & 63, wr = wid >> 2, wc = wid & 3, fr = lane & 15, fq = lane >> 4;
    int nt = g.K / BK; asm volatile("" : "+s"(nt));
    unsigned voffA[2], voffB[2];
#pragma unroll
    for (int i = 0; i < 2; ++i) { int R, C; stage_rc(tid * 16 + i * 8192, R, C); const int Rb = (R & ~31) + perm32(R & 31);
        voffA[i] = (unsigned)(R * g.lda + C) * 2u; voffB[i] = (unsigned)(Rb * g.ldb + C) * 2u; }
    const size_t kstep = (size_t)(BK * 2);
    const size_t hstepA = (size_t)HALF * g.lda * 2, hstepB = (size_t)HALF * g.ldb * 2;
    const size_t tstepA = 2 * hstepA, tstepB = 2 * hstepB;
    const unsigned ldsw = (unsigned)wid * 1024u;
    const int aoff = lds_byte(wr * 64 + fr, fq * 8), boff = lds_byte(wc * 32 + fr, fq * 8);
#define PG8_SA(b, h) (((b) * 2 + (h)) * HTB)
#define PG8_SB(b, h) ((4 + (b) * 2 + (h)) * HTB)
#define PG8_STAGE(bufoff, gbase, voff) do { _Pragma("unroll") for (int _i = 0; _i < 2; ++_i) \
        __builtin_amdgcn_global_load_lds((const unsigned*)((const char*)(gbase) + (voff)[_i]), (PG8_LAS unsigned*)(lds + (bufoff) + ldsw + _i * 8192), 16, 0, 0); } while (0)
#define PG8_LDA(dst, b, h) do { _Pragma("unroll") for (int m = 0; m < 4; ++m) _Pragma("unroll") for (int k = 0; k < 2; ++k) dst[m][k] = *(const PG8_LAS bf16x8*)(lds + PG8_SA(b, h) + aoff + m * 2048 + k * 1024); } while (0)
#define PG8_LDB(dst, b, h) do { _Pragma("unroll") for (int n = 0; n < 2; ++n) _Pragma("unroll") for (int k = 0; k < 2; ++k) dst[n][k] = *(const PG8_LAS bf16x8*)(lds + PG8_SB(b, h) + boff + n * 2048 + k * 1024); } while (0)
#define PG8_MMA(ai, bj, At, Bt) do { __builtin_amdgcn_s_setprio(1); _Pragma("unroll") for (int m = 0; m < 4; ++m) _Pragma("unroll") for (int n = 0; n < 2; ++n) _Pragma("unroll") for (int k = 0; k < 2; ++k) \
        acc[ai][bj][m][n] = __builtin_amdgcn_mfma_f32_16x16x32_bf16(Bt[n][k], At[m][k], acc[ai][bj][m][n], 0, 0, 0); __builtin_amdgcn_s_setprio(0); } while (0)
#define PG8_WAIT_V(n) asm volatile("s_waitcnt vmcnt(" #n ")" ::: "memory")
#define PG8_WAIT_L(n) asm volatile("s_waitcnt lgkmcnt(" #n ")" ::: "memory")
#define PG8_BAR __builtin_amdgcn_s_barrier()
#define PG8_SCHED __builtin_amdgcn_sched_barrier(0)
    Unit cur, nxt; int ui = 0;
    if (!S.next(0, cur)) return;
    f32x4 acc[2][2][4][2];
#pragma unroll
    for (int a = 0; a < 2; ++a)
#pragma unroll
        for (int b = 0; b < 2; ++b)
#pragma unroll
            for (int m = 0; m < 4; ++m)
#pragma unroll
                for (int n = 0; n < 2; ++n) acc[a][b][m][n] = (f32x4){0.f, 0.f, 0.f, 0.f};
    bf16x8 At[4][2], B0[2][2], B1[2][2];
    const char* cA = (const char*)g.A + (size_t)cur.pm * tstepA + (size_t)((cur.pn >> g.ash) * g.amul) * 2; const char* cB = (const char*)g.Bt + (size_t)cur.pn * tstepB;
    PG8_STAGE(PG8_SB(0, 0), cB, voffB); PG8_STAGE(PG8_SB(0, 1), cB + hstepB, voffB); PG8_STAGE(PG8_SA(0, 0), cA, voffA); PG8_STAGE(PG8_SA(0, 1), cA + hstepA, voffA);
    if (wr == 1) PG8_BAR;
    PG8_WAIT_V(2); PG8_BAR;
    PG8_STAGE(PG8_SB(1, 0), cB + kstep, voffB); PG8_STAGE(PG8_SA(1, 0), cA + kstep, voffA); PG8_STAGE(PG8_SB(1, 1), cB + hstepB + kstep, voffB);
    PG8_WAIT_V(6); PG8_BAR;
    for (;;) {
        const bool has_next = S.next(ui + 1, nxt);
        const char* nA = has_next ? (const char*)g.A + (size_t)nxt.pm * tstepA + (size_t)((nxt.pn >> g.ash) * g.amul) * 2 : cA; const char* nB = has_next ? (const char*)g.Bt + (size_t)nxt.pn * tstepB : cB;
        for (int t = 0; t < nt; t += 2) {
            const bool last = (t == nt - 2);
            if constexpr (MID_T >= 0) { if (t == MID_T) E.mid(acc, cur, wr, wc, fr, fq); }
            const char* a1 = cA + (size_t)(t + 1) * kstep;
            const char* a2 = last ? nA : cA + (size_t)(t + 2) * kstep; const char* b2 = last ? nB : cB + (size_t)(t + 2) * kstep;
            const char* a3 = a2 + kstep; const char* b3 = b2 + kstep;
            PG8_LDB(B0, 0, 0); PG8_LDB(B1, 0, 1); PG8_SCHED; PG8_LDA(At, 0, 0); PG8_STAGE(PG8_SA(1, 1), a1 + hstepA, voffA);
            PG8_WAIT_V(8); PG8_WAIT_L(0); PG8_BAR; PG8_MMA(0, 0, At, B0); PG8_MMA(0, 1, At, B1); PG8_BAR; PG8_SCHED;
            PG8_LDA(At, 0, 1); PG8_STAGE(PG8_SB(0, 0), b2, voffB); PG8_STAGE(PG8_SB(0, 1), b2 + hstepB, voffB); PG8_STAGE(PG8_SA(0, 0), a2, voffA);
            PG8_WAIT_V(8); PG8_WAIT_L(0); PG8_BAR; PG8_MMA(1, 0, At, B0); PG8_MMA(1, 1, At, B1); PG8_BAR; PG8_SCHED;
            PG8_LDB(B0, 1, 0); PG8_LDB(B1, 1, 1); PG8_SCHED; PG8_LDA(At, 1, 0); PG8_STAGE(PG8_SA(0, 1), a2 + hstepA, voffA);
            PG8_WAIT_V(8); PG8_WAIT_L(0); PG8_BAR; PG8_MMA(0, 0, At, B0); PG8_MMA(0, 1, At, B1); PG8_BAR; PG8_SCHED;
            PG8_LDA(At, 1, 1); PG8_STAGE(PG8_SB(1, 0), b3, voffB); PG8_STAGE(PG8_SB(1, 1), b3 + hstepB, voffB); PG8_STAGE(PG8_SA(1, 0), a3, voffA);
            PG8_WAIT_V(8); PG8_WAIT_L(0); PG8_BAR; PG8_MMA(1, 0, At, B0); PG8_MMA(1, 1, At, B1); PG8_BAR; PG8_SCHED;
        }
        if constexpr (ALIGN_EPI) { if (wr == 0) PG8_BAR; }
        E.template run<2>(acc, cur, wr, wc, fr, fq);
        if (!has_next) break;
#pragma unroll
        for (int a = 0; a < 2; ++a)
#pragma unroll
            for (int b = 0; b < 2; ++b)
#pragma unroll
                for (int m = 0; m < 4; ++m)
#pragma unroll
                    for (int n = 0; n < 2; ++n) acc[a][b][m][n] = (f32x4){0.f, 0.f, 0.f, 0.f};
        cur = nxt; cA = nA; cB = nB; ++ui;
        if constexpr (ALIGN_EPI) { if (wr == 1) PG8_BAR; }
    }
    PG8_WAIT_V(0);
    if constexpr (!ALIGN_EPI) { if (wr == 0) PG8_BAR; }
    PG8_BAR;
#undef PG8_SA
#undef PG8_SB
#undef PG8_STAGE
#undef PG8_LDA
#undef PG8_LDB
#undef PG8_MMA
#undef PG8_WAIT_V
#undef PG8_WAIT_L
#undef PG8_BAR
#undef PG8_SCHED
}

template <class Epi>
__device__ __forceinline__ void gemm_half(PG8_LAS unsigned char* lds, const Gemm g, const Unit u, const Epi& E) {
    const int tid = threadIdx.x, wid = __builtin_amdgcn_readfirstlane(tid >> 6), lane = tid & 63, wr = wid >> 2, wc = wid & 3, fr = lane & 15, fq = lane >> 4;
    int nt = g.K / BK; asm volatile("" : "+s"(nt));
    unsigned voffA[2], voffB[2];
#pragma unroll
    for (int i = 0; i < 2; ++i) { int R, C; stage_rc(tid * 16 + i * 8192, R, C); const int Rb = (R & ~31) + perm32(R & 31);
        voffA[i] = (unsigned)(R * g.lda + C) * 2u; voffB[i] = (unsigned)(Rb * g.ldb + C) * 2u; }
    const size_t kstep = (size_t)(BK * 2);
    const size_t hstepA = (size_t)HALF * g.lda * 2, hstepB = (size_t)HALF * g.ldb * 2;
    const unsigned ldsw = (unsigned)wid * 1024u;
    const int aoff = lds_byte(wr * 64 + fr, fq * 8), boff = lds_byte(wc * 32 + fr, fq * 8);
#define PG8_SA(b, h) (((b) * 2 + (h)) * HTB)
#define PG8_SB(b, h) ((4 + (b) * 2 + (h)) * HTB)
#define PG8_STAGE(bufoff, gbase, voff) do { _Pragma("unroll") for (int _i = 0; _i < 2; ++_i) \
        __builtin_amdgcn_global_load_lds((const unsigned*)((const char*)(gbase) + (voff)[_i]), (PG8_LAS unsigned*)(lds + (bufoff) + ldsw + _i * 8192), 16, 0, 0); } while (0)
#define PG8_LDA(dst, b, h) do { _Pragma("unroll") for (int m = 0; m < 4; ++m) _Pragma("unroll") for (int k = 0; k < 2; ++k) dst[m][k] = *(const PG8_LAS bf16x8*)(lds + PG8_SA(b, h) + aoff + m * 2048 + k * 1024); } while (0)
#define PG8_LDB(dst, b, h) do { _Pragma("unroll") for (int n = 0; n < 2; ++n) _Pragma("unroll") for (int k = 0; k < 2; ++k) dst[n][k] = *(const PG8_LAS bf16x8*)(lds + PG8_SB(b, h) + boff + n * 2048 + k * 1024); } while (0)
#define PG8_MMA(ai, bj, At, Bt) do { __builtin_amdgcn_s_setprio(1); _Pragma("unroll") for (int m = 0; m < 4; ++m) _Pragma("unroll") for (int n = 0; n < 2; ++n) _Pragma("unroll") for (int k = 0; k < 2; ++k) \
        acc[ai][bj][m][n] = __builtin_amdgcn_mfma_f32_16x16x32_bf16(Bt[n][k], At[m][k], acc[ai][bj][m][n], 0, 0, 0); __builtin_amdgcn_s_setprio(0); } while (0)
#define PG8_WAIT_V(n) asm volatile("s_waitcnt vmcnt(" #n ")" ::: "memory")
#define PG8_WAIT_L(n) asm volatile("s_waitcnt lgkmcnt(" #n ")" ::: "memory")
#define PG8_BAR __builtin_amdgcn_s_barrier()
#define PG8_SCHED __builtin_amdgcn_sched_barrier(0)
    f32x4 acc[2][2][4][2];
#pragma unroll
    for (int a = 0; a < 2; ++a)
#pragma unroll
        for (int b = 0; b < 2; ++b)
#pragma unroll
            for (int m = 0; m < 4; ++m)
#pragma unroll
                for (int n = 0; n < 2; ++n) acc[a][b][m][n] = (f32x4){0.f, 0.f, 0.f, 0.f};
    bf16x8 At[4][2], B0[2][2], B1[2][2];
    const char* cA = (const char*)g.A + ((size_t)u.pm * BM + u.rh) * g.lda * 2 + (size_t)((u.pn >> g.ash) * g.amul) * 2; const char* cB = (const char*)g.Bt + (size_t)u.pn * 2 * hstepB;
    PG8_STAGE(PG8_SB(0, 0), cB, voffB); PG8_STAGE(PG8_SB(0, 1), cB + hstepB, voffB); PG8_STAGE(PG8_SA(0, 0), cA, voffA);
    PG8_STAGE(PG8_SB(1, 0), cB + kstep, voffB); PG8_STAGE(PG8_SB(1, 1), cB + hstepB + kstep, voffB); PG8_STAGE(PG8_SA(1, 0), cA + kstep, voffA);
    PG8_WAIT_V(6); PG8_BAR;
#define PG8_HALF_STEP(b, tt) do { \
        PG8_LDB(B0, b, 0); PG8_LDB(B1, b, 1); PG8_LDA(At, b, 0); PG8_WAIT_L(0); PG8_BAR; PG8_SCHED; \
        const bool more_ = (tt) + 2 < nt; \
        if (more_) { const char* b2 = cB + (size_t)((tt) + 2) * kstep; const char* a2 = cA + (size_t)((tt) + 2) * kstep; \
            PG8_STAGE(PG8_SB(b, 0), b2, voffB); PG8_STAGE(PG8_SB(b, 1), b2 + hstepB, voffB); PG8_STAGE(PG8_SA(b, 0), a2, voffA); } \
        PG8_MMA(0, 0, At, B0); PG8_MMA(0, 1, At, B1); \
        if (more_) PG8_WAIT_V(6); else PG8_WAIT_V(0); \
        PG8_BAR; PG8_SCHED; } while (0)
    for (int t = 0; t < nt; t += 2) { PG8_HALF_STEP(0, t); PG8_HALF_STEP(1, t + 1); }
    E.template run<1>(acc, u, wr, wc, fr, fq);
    PG8_BAR;
#undef PG8_HALF_STEP
#undef PG8_SA
#undef PG8_SB
#undef PG8_STAGE
#undef PG8_LDA
#undef PG8_LDB
#undef PG8_MMA
#undef PG8_WAIT_V
#undef PG8_WAIT_L
#undef PG8_BAR
#undef PG8_SCHED
}
}

constexpr int NWAVES = 8, NTHR = 512;
constexpr int M = 16384, SEQ = 4096, NB = 4, D = 1024, DPOOL = 512, DRNN = 1024, DIN = 4608, DFF = 2816;
constexpr float EPS = 1e-6f;
constexpr int NPH = 11;
constexpr int SCAN_T = 128, SCAN_NC = SEQ / SCAN_T;

constexpr size_t MiB = 1u << 20;
constexpr size_t WS_SP8 = 512 * 1024;
constexpr size_t WS_SSQ = 1 * MiB;
constexpr size_t WS_SSQ2 = 2 * MiB;
constexpr size_t WS_CS = 2 * MiB, WS_CH = 3 * MiB;
constexpr size_t WS_WIN = 4 * MiB;
constexpr size_t WS_WFI = 13 * MiB;
constexpr size_t WS_WFO = 24 * MiB;
constexpr size_t WS_WCAT = WS_WFO + 5632 * 1024;
constexpr size_t WS_WO = WS_WCAT + 3 * MiB;
constexpr size_t WS_WGRP = WS_WO + 2 * MiB;
constexpr size_t WS_WGATE = WS_WGRP + MiB / 4;
constexpr size_t WS_R1 = 36 * MiB;
constexpr size_t WS_R2 = 68 * MiB;
constexpr size_t WS_R3 = 84 * MiB;
constexpr size_t WS_R4 = 116 * MiB;
constexpr size_t WS_R7 = 148 * MiB;
constexpr size_t WS_R8 = 164 * MiB;
constexpr size_t WS_CAT = 196 * MiB;
constexpr size_t WS_MIXB = 148 * MiB;
constexpr size_t WS_ACT = 68 * MiB;
constexpr size_t WS_END = 244 * MiB;

constexpr int LDS_BYTES = 147456;

#define LAS __attribute__((address_space(3)))
typedef unsigned short bf16;
typedef unsigned v4u __attribute__((ext_vector_type(4)));
typedef unsigned v2u __attribute__((ext_vector_type(2)));
typedef float f32x4 __attribute__((ext_vector_type(4)));
typedef float f32x2 __attribute__((ext_vector_type(2)));
#define LDS_WAIT() asm volatile("s_waitcnt lgkmcnt(0)" ::: "memory")
using pg8::cvt_pk_bf16; using pg8::bf_lo; using pg8::bf_hi;

struct Args { const float* in[19]; float* out; unsigned char* ws; int ph_lo, ph_hi; };
enum { I_X = 0, I_NORM_MIX, I_W_IN, I_W_GRP, I_POOL_SCALE, I_W_POOL_OUT, I_CONV_W, I_CONV_B, I_W_RG_A, I_B_RG_A, I_W_RG_X, I_B_RG_X, I_LAMBDA, I_W_RNN_OUT, I_W_O, I_NORM_FFN, I_W_FFN_IN, I_W_FFN_OUT, I_NORM_FINAL };

__device__ __forceinline__ float wave_sum(float v) {
#pragma unroll
    for (int o = 1; o < 64; o <<= 1) v += __shfl_xor(v, o);
    return v;
}

__device__ __forceinline__ void transpose_item(const float* W, int Nsrc, int Kdst, bf16* WT, int k0, int n_src0, int n_dst0, const float* kscale, LAS float* scr, int lane) {
    f32x4 v[8]; const int n4 = (lane & 7) * 4;
#pragma unroll
    for (int i = 0; i < 8; ++i) { const int kk = 8 * i + (lane >> 3); v[i] = *(const f32x4*)(W + (size_t)(k0 + kk) * Nsrc + n_src0 + n4); }
    if (kscale) {
#pragma unroll
        for (int i = 0; i < 8; ++i) v[i] = v[i] * kscale[k0 + 8 * i + (lane >> 3)]; }
#pragma unroll
    for (int i = 0; i < 8; ++i) { const int kk = 8 * i + (lane >> 3);
#pragma unroll
        for (int j = 0; j < 4; ++j) scr[kk * 33 + n4 + j] = v[i][j]; }
    LDS_WAIT(); asm volatile("" ::: "memory");
    const int c = lane & 7;
#pragma unroll
    for (int j = 0; j < 4; ++j) { const int n = (lane >> 3) + 8 * j; const LAS float* s = scr + (8 * c) * 33 + n;
        v4u o; o.x = cvt_pk_bf16(s[0 * 33], s[1 * 33]); o.y = cvt_pk_bf16(s[2 * 33], s[3 * 33]); o.z = cvt_pk_bf16(s[4 * 33], s[5 * 33]); o.w = cvt_pk_bf16(s[6 * 33], s[7 * 33]);
        *(v4u*)(WT + (size_t)(n_dst0 + n) * Kdst + k0 + 8 * c) = o; }
    LDS_WAIT(); asm volatile("" ::: "memory");
}

#define XB_TMO      128
#define XB_XCNT(j)  (256  + 64 * (j))
#define XB_XSUB(j)  (1280 + 64 * (j))
#define XB_XGEN(j)  (2304 + 64 * (j))
#define XB_TOP      3328
#define XB_TOPGEN   3392
#define XCD_BAR_WORDS 3456
#define XB_SPIN_CAP (1u << 18)
__device__ __forceinline__ unsigned xb_ld(unsigned* p)              { return __hip_atomic_load(p, __ATOMIC_RELAXED, __HIP_MEMORY_SCOPE_AGENT); }
__device__ __forceinline__ unsigned xb_add(unsigned* p, unsigned v) { return __hip_atomic_fetch_add(p, v, __ATOMIC_RELAXED, __HIP_MEMORY_SCOPE_AGENT); }
__device__ __forceinline__ unsigned xb_xcc_id() { return (unsigned)__builtin_amdgcn_s_getreg((3 << 11) | 20) & 0xFu; }
#define XB_SPIN(cond, bar) do { unsigned _sp = 0; while (cond) { __builtin_amdgcn_s_sleep(1); \
    if ((++_sp & 255u) == 0u) { if (xb_ld(&(bar)[XB_TMO])) break; if (_sp > XB_SPIN_CAP) { atomicAdd(&(bar)[XB_TMO], 1u); break; } } } } while (0)
struct XcdBarrier { unsigned* bar; unsigned x; volatile LAS unsigned* st; };
__device__ __forceinline__ XcdBarrier xcd_barrier_post(unsigned* bar, volatile LAS unsigned* st) {
    XcdBarrier b; b.bar = bar; b.x = xb_xcc_id(); b.st = st;
    if (threadIdx.x == 0) (void)xb_add(&bar[XB_XCNT(b.x)], 1u);
    return b;
}
__device__ __forceinline__ void xcd_barrier_complete(unsigned* bar, unsigned x, unsigned& nloc, unsigned& nx) {
    const unsigned G = gridDim.x * gridDim.y * gridDim.z;
    unsigned sum, cnt, mine, sp = 0u;
    for (;;) {
        sum = 0u; cnt = 0u; mine = 0u;
#pragma unroll
        for (unsigned j = 0; j < 16; ++j) { const unsigned c = xb_ld(&bar[XB_XCNT(j)]); sum += c; cnt += (c > 0u) ? 1u : 0u; mine = (j == x) ? c : mine; }
        if (sum == G) break;
        __builtin_amdgcn_s_sleep(1);
        if ((++sp & 255u) == 0u) { if (xb_ld(&bar[XB_TMO])) break; if (sp > XB_SPIN_CAP) { atomicAdd(&bar[XB_TMO], 1u); break; } }
    }
    nloc = mine > 0u ? mine : 1u; nx = cnt > 0u ? cnt : 1u;
}
__device__ __forceinline__ void xcd_barrier(const XcdBarrier& b) {
    asm volatile("s_waitcnt vmcnt(0)" ::: "memory");
    __syncthreads();
    if (threadIdx.x == 0) {
        unsigned* bar = b.bar;
        __builtin_amdgcn_s_waitcnt(0);
        unsigned nloc = b.st[0], nx = b.st[1];
        if (nloc == 0u) { xcd_barrier_complete(bar, b.x, nloc, nx); b.st[0] = nloc; b.st[1] = nx; }
        const unsigned old = xb_add(&bar[XB_XSUB(b.x)], 1u);
        const unsigned gen = old / nloc;
        if (old + 1u == (gen + 1u) * nloc) {
            __builtin_amdgcn_fence(__ATOMIC_RELEASE, "agent");
            asm volatile("s_waitcnt vmcnt(0)" ::: "memory");
            const unsigned og = xb_add(&bar[XB_TOP], 1u);
            const unsigned tg = og / nx;
            if (og + 1u == (tg + 1u) * nx) xb_add(&bar[XB_TOPGEN], 1u);
            else XB_SPIN(xb_ld(&bar[XB_TOPGEN]) == tg, bar);
            __builtin_amdgcn_fence(__ATOMIC_ACQUIRE, "agent");
            xb_add(&bar[XB_XGEN(b.x)], 1u);
            asm volatile("s_waitcnt vmcnt(0)" ::: "memory");
        } else {
            XB_SPIN(xb_ld(&bar[XB_XGEN(b.x)]) == gen, bar);
            __builtin_amdgcn_fence(__ATOMIC_ACQUIRE, "agent");
            asm volatile("s_waitcnt vmcnt(0)" ::: "memory");
        }
    }
    __syncthreads();
}

template <int W>
__device__ __forceinline__ void pool_item(const bf16* src, bf16* dst, int tl) {
    v4u rw[W + 7];
#pragma unroll
    for (int k = 0; k < W + 7; ++k) rw[k] = (tl + k - (W - 1) >= 0) ? *(const v4u*)(src + (ptrdiff_t)(k - (W - 1)) * DPOOL) : (v4u){0u, 0u, 0u, 0u};
    f32x4 s0 = {0.f, 0.f, 0.f, 0.f}, s1 = s0;
#pragma unroll
    for (int k = 0; k < W - 1; ++k) { f32x4 a, c; pg8::unpack8(rw[k], a, c); s0 += a; s1 += c; }
#pragma unroll
    for (int i = 0; i < 8; ++i) { f32x4 a, c; pg8::unpack8(rw[W - 1 + i], a, c); s0 += a; s1 += c;
        const int t = tl + i; const int cnt = (t + 1 < W) ? t + 1 : W; const float inv = 1.0f / (float)cnt;
        *(v4u*)(dst + (size_t)i * DPOOL) = pg8::pack8(s0 * inv - a, s1 * inv - c);
        f32x4 a2, c2; pg8::unpack8(rw[i], a2, c2); s0 -= a2; s1 -= c2; }
}
__device__ __forceinline__ void scan_local16(const bf16* lap, const bf16* bbp, f32x4 (&S)[2], f32x4 (&H)[2]) {
    S[0] = S[1] = H[0] = H[1] = (f32x4){0.f, 0.f, 0.f, 0.f};
#pragma unroll
    for (int i0 = 0; i0 < 16; i0 += 8) { v4u lw[8], bw[8];
#pragma unroll
        for (int i = 0; i < 8; ++i) { lw[i] = *(const v4u*)(lap + (size_t)(i0 + i) * DRNN); bw[i] = *(const v4u*)(bbp + (size_t)(i0 + i) * DRNN); }
#pragma unroll
        for (int i = 0; i < 8; ++i) { f32x4 l[2], bq[2]; pg8::unpack8(lw[i], l[0], l[1]); pg8::unpack8(bw[i], bq[0], bq[1]);
#pragma unroll
            for (int n = 0; n < 2; ++n)
#pragma unroll
                for (int j = 0; j < 4; ++j) { H[n][j] = __expf(l[n][j]) * H[n][j] + bq[n][j]; S[n][j] += l[n][j]; } } }
}

__global__ void __launch_bounds__(NTHR, 2) fwd_kernel(Args args) {
    extern __shared__ __attribute__((aligned(16))) unsigned char lds_raw[];
    LAS unsigned char* lds = (LAS unsigned char*)lds_raw;
    const int tid = threadIdx.x, lane = tid & 63, wave = __builtin_amdgcn_readfirstlane(tid >> 6);
    const int G = gridDim.x, bx = blockIdx.x;
    unsigned char* ws = args.ws;
    const int lo = args.ph_lo, hi = args.ph_hi;
#ifndef PHASE_MASK
#define PHASE_MASK 0x7ff
#endif
#define IN(k) (((PHASE_MASK >> (k)) & 1) && lo <= (k) && (k) < hi)
#ifndef REPEAT_MASK
#define REPEAT_MASK 0
#endif
#define REPS(k) (((REPEAT_MASK >> (k)) & 1) ? 2 : 1)
#ifndef PROBE_PHASE
#define PROBE_PHASE -1
#endif
#define PROBE_MULT 4
    unsigned long long tp0 = 0, tp1 = 0;
#define TSTART(k) do { if ((k) == PROBE_PHASE) tp0 = __builtin_amdgcn_s_memrealtime(); } while (0)
#define TEND(k) do { if ((k) == PROBE_PHASE) tp1 = __builtin_amdgcn_s_memrealtime(); } while (0)
#define GSYNC() xcd_barrier(bar)
#define SEAM(k) do { if (IN(k) && IN((k) + 1)) { GSYNC(); } } while (0)

    const float* x = args.in[I_X];
    bf16* WIN = (bf16*)(ws + WS_WIN); bf16* WFI = (bf16*)(ws + WS_WFI); bf16* WFO = (bf16*)(ws + WS_WFO); bf16* WCAT = (bf16*)(ws + WS_WCAT);
    bf16* WO = (bf16*)(ws + WS_WO); bf16* WGRP = (bf16*)(ws + WS_WGRP); bf16* WGATE = (bf16*)(ws + WS_WGATE);
    bf16* XN = (bf16*)(ws + WS_R1); bf16* V = XN; bf16* X1B = XN;
    bf16* CAT = (bf16*)(ws + WS_CAT);
    bf16* UP = (bf16*)(ws + WS_R2);
    bf16* UR = (bf16*)(ws + WS_R3); bf16* LA = UR;
    bf16* UG = (bf16*)(ws + WS_R4);
    bf16* POOLED = (bf16*)(ws + WS_R7); bf16* BB = (bf16*)(ws + WS_R8);
    bf16* MIXB = (bf16*)(ws + WS_MIXB); bf16* ACT = (bf16*)(ws + WS_ACT);
    float* SSQ = (float*)(ws + WS_SSQ); float* CS = (float*)(ws + WS_CS); float* CH = (float*)(ws + WS_CH);
    bf16* G0 = (bf16*)args.out; bf16* G1 = G0 + (size_t)M * 1024;
    float* X1 = args.out;

#ifndef EXTRA_SYNCS
#define EXTRA_SYNCS 0
#endif
    if (PROBE_PHASE == 99) tp0 = __builtin_amdgcn_s_memrealtime();
    volatile LAS unsigned* MISC = (volatile LAS unsigned*)(lds + 131072 + 1024);
    if (tid < 32) MISC[tid] = 0u;
    __syncthreads();
    XcdBarrier bar = xcd_barrier_post((unsigned*)ws, MISC + 8);
    if (lo < 0) cg::this_grid().sync();
    for (int i = 0; i < EXTRA_SYNCS; ++i) GSYNC();
    TSTART(0);
    if (IN(0)) for (int rep = 0; rep < REPS(0); ++rep) { if (rep) GSYNC();
        LAS float* scr = (LAS float*)(lds + wave * 16384);
        const int gw = bx * NWAVES + wave, NGW = G * NWAVES;
        constexpr int I_IN = 16 * (DIN / 32), I_FI = 16 * (2 * DFF / 32), I_FO = (DFF / 64) * (D / 32), I_RO = 16 * 32, I_WO = 16 * 32, I_PO = 8 * 32;
        constexpr int NITEMS = I_IN + I_FI + I_FO + I_RO + I_WO + I_PO;
        for (int it = gw; it < NITEMS; it += NGW) {
            int r = it;
            if (r < I_IN) { const int nblk = DIN / 32, kb = r / nblk, nb = r % nblk, nd = 32 * nb; int ns = nd;
                if (nd >= 2560) { const int q = nd - 2560, pq = q >> 8, j0 = q & 255; ns = 2560 + (j0 < 128 ? 128 * pq + j0 : 1024 + 128 * pq + (j0 - 128)); }
                transpose_item(args.in[I_W_IN], DIN, D, WIN, 64 * kb, ns, nd, nullptr, scr, lane); continue; } r -= I_IN;
            if (r < I_FI) { const int nblk = 2 * DFF / 32, kb = r / nblk, nb = r % nblk, nd = 32 * nb, pn = nd >> 8, j0 = nd & 255;
                const int ns = j0 < 128 ? 128 * pn + j0 : DFF + 128 * pn + (j0 - 128);
                transpose_item(args.in[I_W_FFN_IN], 2 * DFF, D, WFI, 64 * kb, ns, nd, args.in[I_NORM_FFN], scr, lane); continue; } r -= I_FI;
            if (r < I_FO) { const int nblk = D / 32, kb = r / nblk, nb = r % nblk; transpose_item(args.in[I_W_FFN_OUT], D, DFF, WFO, 64 * kb, 32 * nb, 32 * nb, nullptr, scr, lane); continue; } r -= I_FO;
            if (r < I_RO) { const int nblk = D / 32, kb = r / nblk, nb = r % nblk; transpose_item(args.in[I_W_RNN_OUT], D, 1536, WCAT + 512, 64 * kb, 32 * nb, 32 * nb, nullptr, scr, lane); continue; } r -= I_RO;
            if (r < I_WO) { const int nblk = D / 32, kb = r / nblk, nb = r % nblk; transpose_item(args.in[I_W_O], D, D, WO, 64 * kb, 32 * nb, 32 * nb, nullptr, scr, lane); continue; } r -= I_WO;
            { const int nblk = D / 32, kb = r / nblk, nb = r % nblk; transpose_item(args.in[I_W_POOL_OUT], D, 1536, WCAT, 64 * kb, 32 * nb, 32 * nb, nullptr, scr, lane); }
        }
        {
            const int gt = bx * NTHR + tid, NT = G * NTHR;
            const float* wg = args.in[I_W_GRP];
            for (int e = gt; e < 512 * 32; e += NT) { const int n = e >> 5, kc = (e & 31) * 8, g = n >> 7, nn = n & 127; float v[8];
#pragma unroll
                for (int j = 0; j < 8; ++j) { const int kk = kc + j - (g & 1) * 128; v[j] = (kk >= 0 && kk < 128) ? wg[((size_t)g * 128 + kk) * 128 + nn] : 0.f; }
                v4u o; o.x = cvt_pk_bf16(v[0], v[1]); o.y = cvt_pk_bf16(v[2], v[3]); o.z = cvt_pk_bf16(v[4], v[5]); o.w = cvt_pk_bf16(v[6], v[7]);
                *(v4u*)(WGRP + (size_t)n * 256 + kc) = o; }
            const float* wa = args.in[I_W_RG_A]; const float* wx = args.in[I_W_RG_X];
            for (int e = gt; e < 2048 * 16; e += NT) { const int n = e >> 4, kc = (e & 15) * 8, h = n >> 8, j = n & 255; const float* src = j < 128 ? wa : wx; const int jj = j & 127; float v[8];
#pragma unroll
                for (int q = 0; q < 8; ++q) v[q] = src[((size_t)h * 128 + kc + q) * 128 + jj];
                v4u o; o.x = cvt_pk_bf16(v[0], v[1]); o.y = cvt_pk_bf16(v[2], v[3]); o.z = cvt_pk_bf16(v[4], v[5]); o.w = cvt_pk_bf16(v[6], v[7]);
                *(v4u*)(WGATE + (size_t)n * 128 + kc) = o; }
        }
        { const int gt = bx * NTHR + tid; if (gt < DRNN) { const float z = -args.in[I_LAMBDA][gt]; ((float*)(ws + WS_SP8))[gt] = -8.0f * (fmaxf(z, 0.f) + log1pf(expf(-fabsf(z)))); } }
        const float* gmix = args.in[I_NORM_MIX];
        f32x4 gv[4];
#pragma unroll
        for (int j = 0; j < 4; ++j) gv[j] = ((const f32x4*)gmix)[lane + 64 * j];
        for (int m = gw; m < M; m += 2 * NGW) {
            const int m1 = (m + NGW < M) ? m + NGW : m;
            const f32x4* xr0 = (const f32x4*)(x + (size_t)m * D) + lane; const f32x4* xr1 = (const f32x4*)(x + (size_t)m1 * D) + lane; f32x4 v0[4], v1[4]; float s0 = 0.f, s1 = 0.f;
#pragma unroll
            for (int j = 0; j < 4; ++j) { v0[j] = xr0[64 * j]; v1[j] = xr1[64 * j]; }
#pragma unroll
            for (int j = 0; j < 4; ++j) { s0 += (v0[j].x * v0[j].x + v0[j].y * v0[j].y) + (v0[j].z * v0[j].z + v0[j].w * v0[j].w); s1 += (v1[j].x * v1[j].x + v1[j].y * v1[j].y) + (v1[j].z * v1[j].z + v1[j].w * v1[j].w); }
            const float rs0 = 1.0f / sqrtf(wave_sum(s0) * (1.f / D) + EPS), rs1 = 1.0f / sqrtf(wave_sum(s1) * (1.f / D) + EPS);
            v2u* o0 = (v2u*)(XN + (size_t)m * D) + lane; v2u* o1 = (v2u*)(XN + (size_t)m1 * D) + lane;
#pragma unroll
            for (int j = 0; j < 4; ++j) { const f32x4 y0 = v0[j] * rs0 * gv[j], y1 = v1[j] * rs1 * gv[j]; v2u w0, w1; w0.x = cvt_pk_bf16(y0.x, y0.y); w0.y = cvt_pk_bf16(y0.z, y0.w); w1.x = cvt_pk_bf16(y1.x, y1.y); w1.y = cvt_pk_bf16(y1.z, y1.w); o0[64 * j] = w0; o1[64 * j] = w1; }
        }
        __syncthreads();
    }
    SEAM(0);
    TEND(0);

    TSTART(1);
    if (IN(1)) for (int rep = 0; rep < REPS(1); ++rep) { if (rep) GSYNC();
        pg8::Gemm g{XN, WIN, M, DIN, D, D, D, 0, 0}; pg8::StaticOrder S; S.init(M, DIN, G, bx);
        pg8::EpiProj E{UP, UR, UG, G0, G1};
        pg8::gemm_phase<pg8::EpiProj, true>(lds, g, S, E);
    }
    SEAM(1);
    TEND(1);

    TSTART(2);
    if (IN(2)) for (int rep = 0; rep < REPS(2); ++rep) { if (rep) GSYNC();
        { const int gw = bx * NWAVES + wave, NGW = G * NWAVES;
          for (int wi = gw; wi < (M / 32) * 4; wi += NGW) { const int g = wi & 3, t0 = (wi >> 2) * 32 + (lane >> 4) * 8, co = g * 16 + (lane & 15);
              const bf16* src = UP + (size_t)t0 * DPOOL + co * 8; bf16* dst = POOLED + (size_t)t0 * DPOOL + co * 8; const int tl = t0 & (SEQ - 1);
              if (g == 0) pool_item<2>(src, dst, tl); else if (g == 1) pool_item<4>(src, dst, tl); else if (g == 2) pool_item<8>(src, dst, tl); else pool_item<16>(src, dst, tl); } }
        { const int gt = bx * NTHR + tid, NT = G * NTHR;
          for (int it = gt; it < (M / 8) * 128; it += NT) { const int co = it & 127, t0 = (it >> 7) * 8, tl = t0 & (SEQ - 1);
              const bf16* src = UR + (size_t)t0 * DRNN + co * 8; bf16* dst = V + (size_t)t0 * DRNN + co * 8;
              const float* cw = args.in[I_CONV_W] + co * 8; const float* cb = args.in[I_CONV_B] + co * 8;
              v4u rw[11];
#pragma unroll
              for (int k = 0; k < 11; ++k) rw[k] = (k >= 3 || tl != 0) ? *(const v4u*)(src + (ptrdiff_t)(k - 3) * DRNN) : (v4u){0u, 0u, 0u, 0u};
              f32x4 w0[2], w1[2], w2[2], w3[2], bb[2];
#pragma unroll
              for (int n = 0; n < 2; ++n) { w0[n] = *(const f32x4*)(cw + 4 * n); w1[n] = *(const f32x4*)(cw + 1024 + 4 * n); w2[n] = *(const f32x4*)(cw + 2048 + 4 * n); w3[n] = *(const f32x4*)(cw + 3072 + 4 * n); bb[n] = *(const f32x4*)(cb + 4 * n); }
#pragma unroll
              for (int i = 0; i < 8; ++i) { f32x4 a[2], b[2], c[2], d[2]; pg8::unpack8(rw[i], a[0], a[1]); pg8::unpack8(rw[i + 1], b[0], b[1]); pg8::unpack8(rw[i + 2], c[0], c[1]); pg8::unpack8(rw[i + 3], d[0], d[1]);
                  *(v4u*)(dst + (size_t)i * DRNN) = pg8::pack8(bb[0] + w0[0] * a[0] + w1[0] * b[0] + w2[0] * c[0] + w3[0] * d[0], bb[1] + w0[1] * a[1] + w1[1] * b[1] + w2[1] * c[1] + w3[1] * d[1]); }
          } }
    }
    SEAM(2);
    TEND(2);

    TSTART(3);
    if (IN(3)) for (int rep = 0; rep < REPS(3); ++rep) { if (rep) GSYNC();
        { pg8::Gemm g{POOLED, WGRP, M, 512, 256, 512, 256, 0, 256}; pg8::StaticOrder S; S.init(M, 512, G, (bx + G / 2) % G);
          pg8::EpiGrp E{CAT, 1536, args.in[I_POOL_SCALE]};
          pg8::gemm_phase<pg8::EpiGrp, true>(lds, g, S, E); }
        { pg8::Gemm g{V, WGATE, M, 2048, 128, 1024, 128, 0, 128}; pg8::StaticOrder S; S.init(M, 2048, G, bx);
          pg8::EpiGate E{V, LA, BB, args.in[I_B_RG_A], args.in[I_B_RG_X], (const float*)(ws + WS_SP8)};
          pg8::gemm_phase<pg8::EpiGate, true>(lds, g, S, E); }
    }
    SEAM(3);
    TEND(3);

    TSTART(4);
    TEND(4);

    TSTART(5);
    if (IN(5)) for (int rep = 0; rep < REPS(5); ++rep) { if (rep) GSYNC();
        LAS float* PAS = (LAS float*)lds; LAS float* PAH = PAS + 8 * 512; LAS float* PBS = PAH + 8 * 512; LAS float* PBH = PBS + 8 * 512;
        unsigned* flags = (unsigned*)ws + 8192;
        for (int bi = bx; bi < NB * SCAN_NC * 2; bi += G) { const int hh = bi & 1, c = (bi >> 1) % SCAN_NC, b = bi / (2 * SCAN_NC);
            const size_t off = ((size_t)b * SEQ + (size_t)c * SCAN_T + wave * 16) * DRNN + hh * 512 + lane * 8;
            v4u lwk[16], bwk[16];
#pragma unroll
            for (int i = 0; i < 16; ++i) { lwk[i] = *(const v4u*)(LA + off + (size_t)i * DRNN); bwk[i] = *(const v4u*)(BB + off + (size_t)i * DRNN); }
            { f32x4 S[2] = {{0.f, 0.f, 0.f, 0.f}, {0.f, 0.f, 0.f, 0.f}}, H[2] = {{0.f, 0.f, 0.f, 0.f}, {0.f, 0.f, 0.f, 0.f}};
#pragma unroll
              for (int i = 0; i < 16; ++i) { f32x4 l[2], bq[2]; pg8::unpack8(lwk[i], l[0], l[1]); pg8::unpack8(bwk[i], bq[0], bq[1]);
#pragma unroll
                  for (int n = 0; n < 2; ++n)
#pragma unroll
                      for (int j = 0; j < 4; ++j) { H[n][j] = __expf(l[n][j]) * H[n][j] + bq[n][j]; S[n][j] += l[n][j]; } }
              *(LAS f32x4*)(PBS + wave * 512 + lane * 8) = S[0]; *(LAS f32x4*)(PBS + wave * 512 + lane * 8 + 4) = S[1];
              *(LAS f32x4*)(PBH + wave * 512 + lane * 8) = H[0]; *(LAS f32x4*)(PBH + wave * 512 + lane * 8 + 4) = H[1]; }
#pragma unroll
            for (int i = 0; i < 16; ++i) asm volatile("" : "+v"(lwk[i]), "+v"(bwk[i]));
            __syncthreads();
            { float h = 0.f, st = 0.f;
#pragma unroll
              for (int sb = 0; sb < 8; ++sb) { const float sv = PBS[sb * 512 + tid]; h = __expf(sv) * h + PBH[sb * 512 + tid]; st += sv; }
              const size_t co = ((size_t)b * SCAN_NC + c) * DRNN + hh * 512 + tid;
              __hip_atomic_store(CS + co, st, __ATOMIC_RELAXED, __HIP_MEMORY_SCOPE_AGENT); __hip_atomic_store(CH + co, h, __ATOMIC_RELAXED, __HIP_MEMORY_SCOPE_AGENT); }
            asm volatile("s_waitcnt vmcnt(0)" ::: "memory");
            __syncthreads();
            if (tid == 0) __hip_atomic_store(flags + ((b * 2 + hh) * SCAN_NC + c) * 16, 1u, __ATOMIC_RELAXED, __HIP_MEMORY_SCOPE_AGENT);
            { f32x4 S[2] = {{0.f, 0.f, 0.f, 0.f}, {0.f, 0.f, 0.f, 0.f}}, H[2] = {{0.f, 0.f, 0.f, 0.f}, {0.f, 0.f, 0.f, 0.f}};
              if (wave * 4 < c) {
                  for (int q = 0; q < 4; ++q) { const int cc = wave * 4 + q; if (cc < c) { unsigned* f = flags + ((b * 2 + hh) * SCAN_NC + cc) * 16; unsigned sp = 0;
                      while ((unsigned)__builtin_amdgcn_readfirstlane(__hip_atomic_load(f, __ATOMIC_RELAXED, __HIP_MEMORY_SCOPE_AGENT)) == 0u) { __builtin_amdgcn_s_sleep(1); if (++sp > (1u << 20)) break; } } }
                  __builtin_amdgcn_fence(__ATOMIC_ACQUIRE, "agent");
#pragma unroll
                  for (int q0 = 0; q0 < 4; q0 += 2) { f32x4 cs[2][2], ch[2][2];
#pragma unroll
                      for (int q = 0; q < 2; ++q) { const int cc = wave * 4 + q0 + q; const size_t co = ((size_t)b * SCAN_NC + (cc < c ? cc : 0)) * DRNN + hh * 512 + lane * 8;
                          cs[q][0] = *(const f32x4*)(CS + co); cs[q][1] = *(const f32x4*)(CS + co + 4); ch[q][0] = *(const f32x4*)(CH + co); ch[q][1] = *(const f32x4*)(CH + co + 4); }
#pragma unroll
                      for (int q = 0; q < 2; ++q) { if (wave * 4 + q0 + q < c) {
#pragma unroll
                          for (int n = 0; n < 2; ++n)
#pragma unroll
                              for (int j = 0; j < 4; ++j) { H[n][j] = __expf(cs[q][n][j]) * H[n][j] + ch[q][n][j]; S[n][j] += cs[q][n][j]; } } }
                      asm volatile("" ::: "memory"); }
              }
              *(LAS f32x4*)(PAS + wave * 512 + lane * 8) = S[0]; *(LAS f32x4*)(PAS + wave * 512 + lane * 8 + 4) = S[1];
              *(LAS f32x4*)(PAH + wave * 512 + lane * 8) = H[0]; *(LAS f32x4*)(PAH + wave * 512 + lane * 8 + 4) = H[1]; }
            __syncthreads();
            f32x4 h[2] = {{0.f, 0.f, 0.f, 0.f}, {0.f, 0.f, 0.f, 0.f}};
#pragma unroll
            for (int sb = 0; sb < 8; ++sb) {
#pragma unroll
                for (int n = 0; n < 2; ++n) { const f32x4 sv = *(const LAS f32x4*)(PAS + sb * 512 + lane * 8 + 4 * n), hv = *(const LAS f32x4*)(PAH + sb * 512 + lane * 8 + 4 * n);
#pragma unroll
                    for (int j = 0; j < 4; ++j) h[n][j] = __expf(sv[j]) * h[n][j] + hv[j]; } }
            for (int sb = 0; sb < wave; ++sb) {
#pragma unroll
                for (int n = 0; n < 2; ++n) { const f32x4 sv = *(const LAS f32x4*)(PBS + sb * 512 + lane * 8 + 4 * n), hv = *(const LAS f32x4*)(PBH + sb * 512 + lane * 8 + 4 * n);
#pragma unroll
                    for (int j = 0; j < 4; ++j) h[n][j] = __expf(sv[j]) * h[n][j] + hv[j]; } }
            const bf16* ugp = UG + off;
            bf16* hgp = CAT + ((size_t)b * SEQ + (size_t)c * SCAN_T + wave * 16) * 1536 + 512 + hh * 512 + lane * 8;
#pragma unroll
            for (int i0 = 0; i0 < 16; i0 += 8) { v4u gw8[8];
#pragma unroll
                for (int i = 0; i < 8; ++i) gw8[i] = *(const v4u*)(ugp + (size_t)(i0 + i) * DRNN);
#pragma unroll
                for (int i = 0; i < 8; ++i) { f32x4 l[2], bq[2], gq[2], o[2]; pg8::unpack8(lwk[i0 + i], l[0], l[1]); pg8::unpack8(bwk[i0 + i], bq[0], bq[1]); pg8::unpack8(gw8[i], gq[0], gq[1]);
#pragma unroll
                    for (int n = 0; n < 2; ++n)
#pragma unroll
                        for (int j = 0; j < 4; ++j) { h[n][j] = __expf(l[n][j]) * h[n][j] + bq[n][j]; o[n][j] = h[n][j] * pg8::gelu_tanh_(gq[n][j]); }
                    *(v4u*)(hgp + (size_t)(i0 + i) * 1536) = pg8::pack8(o[0], o[1]); } }
            __syncthreads();
        }
    }
    SEAM(5);
    TEND(5);

    TSTART(6);
    if (IN(6)) for (int rep = 0; rep < REPS(6); ++rep) { if (rep) GSYNC();
        pg8::Gemm g{CAT, WCAT, M, D, 1536, 1536, 1536, 0, 0}; pg8::StaticOrder S; S.init(M, D, G, bx);
        pg8::EpiMix E{G0, G1, MIXB};
        pg8::gemm_phase<pg8::EpiMix, true, 8>(lds, g, S, E);
    }
    SEAM(6);
    TEND(6);

    TSTART(7);
    if (IN(7)) for (int rep = 0; rep < REPS(7); ++rep) { if (rep) GSYNC();
        pg8::Gemm g{MIXB, WO, M, D, D, D, D, 0, 0}; pg8::StaticOrder S; S.init(M, D, G, bx);
        pg8::EpiRes1 E{x, X1B, SSQ};
        pg8::gemm_phase<pg8::EpiRes1, true>(lds, g, S, E);
    }
    SEAM(7);
    TEND(7);

    TSTART(8);
    if (IN(8)) for (int rep = 0; rep < REPS(8); ++rep) { if (rep) GSYNC();
        pg8::Gemm g{X1B, WFI, M, 2 * DFF, D, D, D, 0, 0}; pg8::StaticOrder S; S.init(M, 2 * DFF, G, bx);
        pg8::EpiSwiglu E{SSQ, ACT};
        pg8::gemm_phase<pg8::EpiSwiglu, true>(lds, g, S, E);
    }
    SEAM(8);
    TEND(8);

    TSTART(9);
    if (IN(9)) for (int rep = 0; rep < REPS(9); ++rep) { if (rep) GSYNC();
        pg8::Gemm g{ACT, WFO, M, D, DFF, DFF, DFF, 0, 0}; pg8::StaticOrder S; S.init(M, D, G, bx);
        if (G == 256) { pg8::EpiFinal E{X1B, X1, (float*)(ws + WS_SSQ2), (unsigned*)ws + 4096, args.in[I_NORM_FINAL]};
            pg8::gemm_phase<pg8::EpiFinal, true>(lds, g, S, E); }
        else { pg8::EpiRes2 E{X1B, X1};
            pg8::gemm_phase<pg8::EpiRes2, true>(lds, g, S, E); }
    }
    if (G != 256) SEAM(9);
    TEND(9);

    TSTART(10);
    if (IN(10) && G != 256) for (int rep = 0; rep < REPS(10); ++rep) { if (rep) GSYNC();
        const int gw = bx * NWAVES + wave, NGW = G * NWAVES;
        const float* gf = args.in[I_NORM_FINAL]; f32x4 gv[4];
#pragma unroll
        for (int j = 0; j < 4; ++j) gv[j] = ((const f32x4*)gf)[lane + 64 * j];
        for (int m = gw; m < M; m += NGW) {
            f32x4* xr = (f32x4*)(X1 + (size_t)m * D) + lane; f32x4 v[4]; float s = 0.f;
#pragma unroll
            for (int j = 0; j < 4; ++j) { v[j] = xr[64 * j]; s += (v[j].x * v[j].x + v[j].y * v[j].y) + (v[j].z * v[j].z + v[j].w * v[j].w); }
            const float rs = 1.0f / sqrtf(wave_sum(s) * (1.f / D) + EPS);
#pragma unroll
            for (int j = 0; j < 4; ++j) xr[64 * j] = v[j] * rs * gv[j];
        }
    }
    if (PROBE_PHASE == 10 || PROBE_PHASE == 99) tp1 = __builtin_amdgcn_s_memrealtime();
    if (PROBE_PHASE >= 0 && bx == 0 && tid == 0) { const unsigned long long dt = (tp1 - tp0) * PROBE_MULT, te = __builtin_amdgcn_s_memrealtime(); while (__builtin_amdgcn_s_memrealtime() - te < dt) __builtin_amdgcn_s_sleep(8); }
#undef IN
#undef SEAM
}

extern "C" void kernel_launch(void* const* d_in, const int* in_sizes, int n_in, void* d_out, int out_size, void* d_ws, size_t ws_size, hipStream_t stream) {
    static int grid = 0;
    if (grid == 0) {
        if (n_in != 19 || out_size != M * D || ws_size < WS_END) { fprintf(stderr, "kernel_launch: unexpected shapes (n_in %d out %d ws %zu)\n", n_in, out_size, ws_size); grid = -1; return; }
        int dev = 0, cus = 0, per_cu = 0;
        hipGetDevice(&dev);
        hipDeviceGetAttribute(&cus, hipDeviceAttributeMultiprocessorCount, dev);
        if (hipFuncSetAttribute((const void*)fwd_kernel, hipFuncAttributeMaxDynamicSharedMemorySize, LDS_BYTES) != hipSuccess) { fprintf(stderr, "kernel_launch: hipFuncSetAttribute failed\n"); grid = -1; return; }
        if (hipOccupancyMaxActiveBlocksPerMultiprocessor(&per_cu, (const void*)fwd_kernel, NTHR, LDS_BYTES) != hipSuccess || per_cu < 1) { fprintf(stderr, "kernel_launch: occupancy query says %d\n", per_cu); per_cu = 1; }
        (void)hipGetLastError();
        grid = cus * 1;
        fprintf(stderr, "kernel_launch: grid %d (cus %d, per_cu %d)\n", grid, cus, per_cu);
    }
    if (grid < 0) return;
    if (hipMemsetAsync(d_ws, 0, 49152, stream) != hipSuccess) { fprintf(stderr, "kernel_launch: memset failed\n"); return; }
    Args a{};
    for (int i = 0; i < 19; ++i) a.in[i] = (const float*)d_in[i];
    a.out = (float*)d_out; a.ws = (unsigned char*)d_ws;
#if MK_PER_PHASE
    for (int p = 0; p < NPH; ++p) { a.ph_lo = p; a.ph_hi = p + 1; hipLaunchKernelGGL(fwd_kernel, dim3(grid), dim3(NTHR), LDS_BYTES, stream, a); }
#else
    a.ph_lo = 0; a.ph_hi = NPH;
    void* kargs[] = {&a};
    hipError_t e = hipLaunchCooperativeKernel((const void*)fwd_kernel, dim3(grid), dim3(NTHR), kargs, LDS_BYTES, stream);
    if (e != hipSuccess) fprintf(stderr, "cooperative launch failed: %s (grid %d)\n", hipGetErrorString(e), grid);
#endif
}
```

```cpp
#include <hip/hip_runtime.h>
#include <hip/hip_cooperative_groups.h>
#include <cstdio>
#include <cstdint>
namespace cg = cooperative_groups;

#ifndef MK_PER_PHASE
#define MK_PER_PHASE 0
#endif

namespace pg8 {
#define PG8_LAS __attribute__((address_space(3)))
typedef unsigned short bf16_t;
typedef short bf16x8 __attribute__((ext_vector_type(8)));
typedef float f32x4 __attribute__((ext_vector_type(4)));
typedef float f32x2 __attribute__((ext_vector_type(2)));
typedef unsigned u32x4 __attribute__((ext_vector_type(4)));
typedef unsigned u32x2 __attribute__((ext_vector_type(2)));
constexpr int BM = 256, BK = 64, HALF = 128, HTB = HALF * BK * 2, STAGE_BYTES = 8 * HTB, NXCD = 8, WGM = 8;

__host__ __device__ __forceinline__ int lds_byte(int r, int c) { const int st = (r >> 4) * 2 + (c >> 5), rr = r & 15, cc = c & 31, ob = rr * 64 + cc * 2; return st * 1024 + (ob ^ (((ob >> 9) & 1) << 5)); }
__host__ __device__ __forceinline__ void stage_rc(int b, int& R, int& C) { const int st = b / 1024, sb = b % 1024, swz = sb ^ (((sb >> 9) & 1) << 5); R = (st >> 1) * 16 + swz / 64; C = (st & 1) * 32 + (swz % 64) / 2; }
__host__ __device__ __forceinline__ int perm32(int rho) { const int n = rho >> 4, i = rho & 15; return 8 * (i >> 2) + 4 * n + (i & 3); }

struct Unit { int pm, pn, rh; };
struct Gemm { const bf16_t* A; const bf16_t* Bt; int M, N, K, lda, ldb, ash, amul; };

struct StaticOrder {
    int nM, nN, nwg, G, c, limit, lin_base, lin_cnt;
    __host__ __device__ void init(int M, int N, int G_, int c_) { nM = M / BM; nN = N / BM; nwg = nM * nN; G = G_; c = c_; limit = nwg; lin_base = 0; lin_cnt = -1; }
    __host__ __device__ void map(int L, Unit& u) const {
        int wgid = L; { const int q = nwg / NXCD, r = nwg % NXCD, xcd = wgid % NXCD, off = wgid / NXCD; wgid = (xcd < r ? xcd * (q + 1) : r * (q + 1) + (xcd - r) * q) + off; }
        const int nig = WGM * nN, gid = wgid / nig, fm = gid * WGM, gsz = (nM - fm) < WGM ? (nM - fm) : WGM;
        u.pm = fm + ((wgid % nig) % gsz); u.pn = (wgid % nig) / gsz; u.rh = 0;
    }
    __host__ __device__ bool next(int i, Unit& u) const {
        if (lin_cnt >= 0) { if (i >= lin_cnt) return false; map(lin_base + i, u); return true; }
        const long L = (long)i * G + c; if (L >= limit) return false;
        map((int)L, u); return true;
    }
};

__device__ __forceinline__ unsigned cvt_pk_bf16(float lo, float hi) { unsigned r; asm volatile("v_cvt_pk_bf16_f32 %0, %1, %2" : "=v"(r) : "v"(lo), "v"(hi)); return r; }
__device__ __forceinline__ float bf_lo(unsigned w) { return __uint_as_float(w << 16); }
__device__ __forceinline__ float bf_hi(unsigned w) { return __uint_as_float(w & 0xffff0000u); }
__device__ __forceinline__ float sigmoidf_(float x) { return __builtin_amdgcn_rcpf(1.0f + __expf(-x)); }
__device__ __forceinline__ float gelu_tanh_(float x) { const float z = 1.5957691216057308f * (x + 0.044715f * x * x * x); return x * sigmoidf_(z); }
__device__ __forceinline__ u32x4 pack8(const f32x4 a, const f32x4 b) { u32x4 w; w.x = cvt_pk_bf16(a[0], a[1]); w.y = cvt_pk_bf16(a[2], a[3]); w.z = cvt_pk_bf16(b[0], b[1]); w.w = cvt_pk_bf16(b[2], b[3]); return w; }
__device__ __forceinline__ void unpack8(const u32x4 w, f32x4& a, f32x4& b) { a = (f32x4){bf_lo(w.x), bf_hi(w.x), bf_lo(w.y), bf_hi(w.y)}; b = (f32x4){bf_lo(w.z), bf_hi(w.z), bf_lo(w.w), bf_hi(w.w)}; }

#define EPI_ROWS_BEGIN _Pragma("unroll") for (int ai = 0; ai < NAI; ++ai) _Pragma("unroll") for (int m = 0; m < 4; ++m) { const int row = u.pm * BM + u.rh + ai * HALF + wr * 64 + m * 16 + fr;
#define EPI_ROWS_END }

struct EpiProj {
    bf16_t *UP, *UR, *UG, *RB, *G1; int pn_off;
    template <int NAI> __device__ __forceinline__ void run(const f32x4 (&acc)[2][2][4][2], const Unit& u, int wr, int wc, int fr, int fq) const {
        const int pn = u.pn + pn_off;
        if (pn < 10) {
            bf16_t* base; int ldc, colt;
            if (pn < 2) { base = UP; ldc = 512; colt = pn * 256; }
            else if (pn < 6) { base = UR; ldc = 1024; colt = (pn - 2) * 256; }
            else { base = UG; ldc = 1024; colt = (pn - 6) * 256; }
            const int col0 = colt + wc * 32 + 8 * fq;
            EPI_ROWS_BEGIN
                bf16_t* rowp = base + (unsigned)((unsigned)row * (unsigned)ldc + (unsigned)col0);
#pragma unroll
                for (int bj = 0; bj < 2; ++bj) *(u32x4*)(rowp + bj * HALF) = pack8(acc[ai][bj][m][0], acc[ai][bj][m][1]);
            EPI_ROWS_END
        } else {
            const int ch0 = (pn - 10) * 128 + wc * 32 + 8 * fq;
            EPI_ROWS_BEGIN
                const unsigned off = (unsigned)row * 1024u + (unsigned)ch0; f32x4 rr[2], gg[2];
#pragma unroll
                for (int n = 0; n < 2; ++n)
#pragma unroll
                    for (int j = 0; j < 4; ++j) { const float d0 = 1.0f + fminf(__expf(-acc[ai][0][m][n][j]), 1e18f), d1 = 1.0f + fminf(__expf(-acc[ai][1][m][n][j]), 1e18f);
                        gg[n][j] = __builtin_amdgcn_rcpf(d1); rr[n][j] = d1 * __builtin_amdgcn_rcpf(d0); }
                *(u32x4*)(RB + off) = pack8(rr[0], rr[1]); *(u32x4*)(G1 + off) = pack8(gg[0], gg[1]);
            EPI_ROWS_END
        }
    }
};
struct EpiGrp {
    bf16_t* O; int ldc; const float* scale;
    template <int NAI> __device__ __forceinline__ void run(const f32x4 (&acc)[2][2][4][2], const Unit& u, int wr, int wc, int fr, int fq) const {
        const int col0 = u.pn * BM + wc * 32 + 8 * fq;
        f32x4 sc[2][2];
#pragma unroll
        for (int bj = 0; bj < 2; ++bj)
#pragma unroll
            for (int n = 0; n < 2; ++n) sc[bj][n] = *(const f32x4*)(scale + col0 + bj * HALF + 4 * n);
        EPI_ROWS_BEGIN
            bf16_t* rowp = O + (unsigned)((unsigned)row * (unsigned)ldc + (unsigned)col0);
#pragma unroll
            for (int bj = 0; bj < 2; ++bj) *(u32x4*)(rowp + bj * HALF) = pack8(acc[ai][bj][m][0] * sc[bj][0], acc[ai][bj][m][1] * sc[bj][1]);
        EPI_ROWS_END
    }
};
struct EpiGate {
    const bf16_t* V; bf16_t *LA, *BB; const float *b_a, *b_x, *sp8;
    template <int NAI> __device__ __forceinline__ void run(const f32x4 (&acc)[2][2][4][2], const Unit& u, int wr, int wc, int fr, int fq) const {
        const int ch0 = u.pn * 128 + wc * 32 + 8 * fq;
        f32x4 ba[2], bx[2], sp[2];
#pragma unroll
        for (int n = 0; n < 2; ++n) { ba[n] = *(const f32x4*)(b_a + ch0 + 4 * n); bx[n] = *(const f32x4*)(b_x + ch0 + 4 * n); sp[n] = *(const f32x4*)(sp8 + ch0 + 4 * n); }
        EPI_ROWS_BEGIN
            const unsigned off = (unsigned)row * 1024u + (unsigned)ch0;
            const u32x4 vw = *(const u32x4*)(V + ((unsigned)row * 1536u + (unsigned)ch0)); f32x4 vv[2]; unpack8(vw, vv[0], vv[1]);
            f32x4 la[2], bb[2];
#pragma unroll
            for (int n = 0; n < 2; ++n)
#pragma unroll
                for (int j = 0; j < 4; ++j) {
                    const float r = sigmoidf_(acc[ai][0][m][n][j] + ba[n][j]), ig = sigmoidf_(acc[ai][1][m][n][j] + bx[n][j]);
                    const float l = sp[n][j] * r, x2 = 2.0f * l;
                    const float em1 = (x2 > -0.125f) ? x2 * (1.0f + 0.5f * x2 * (1.0f + 0.33333334f * x2 * (1.0f + 0.25f * x2 * (1.0f + 0.2f * x2)))) : (__expf(x2) - 1.0f);
                    la[n][j] = l; bb[n][j] = __builtin_amdgcn_sqrtf(fmaxf(-em1, 0.f)) * ig * vv[n][j]; }
            *(u32x4*)(LA + off) = pack8(la[0], la[1]); *(u32x4*)(BB + off) = pack8(bb[0], bb[1]);
            asm volatile("" ::: "memory");
        EPI_ROWS_END
    }
};
struct EpiMix {
    const bf16_t *RB, *G1; bf16_t* MIXB;
    __device__ __forceinline__ void mid(f32x4 (&acc)[2][2][4][2], const Unit& u0, int wr, int wc, int fr, int fq) const {
        constexpr int NAI = 2; Unit u = u0; asm volatile("" : "+s"(u.pm), "+s"(u.pn));
        const int col0 = u.pn * BM + wc * 32 + 8 * fq;
        EPI_ROWS_BEGIN
            const unsigned off = (unsigned)row * 1024u + (unsigned)col0;
#pragma unroll
            for (int bj = 0; bj < 2; ++bj) { f32x4 r[2]; unpack8(*(const u32x4*)(RB + off + bj * HALF), r[0], r[1]); acc[ai][bj][m][0] *= r[0]; acc[ai][bj][m][1] *= r[1]; }
        EPI_ROWS_END
    }
    template <int NAI> __device__ __forceinline__ void run(const f32x4 (&acc)[2][2][4][2], const Unit& u, int wr, int wc, int fr, int fq) const {
        const int col0 = u.pn * BM + wc * 32 + 8 * fq;
        EPI_ROWS_BEGIN
            const unsigned off = (unsigned)row * 1024u + (unsigned)col0;
#pragma unroll
            for (int bj = 0; bj < 2; ++bj) { f32x4 g[2]; unpack8(*(const u32x4*)(G1 + off + bj * HALF), g[0], g[1]);
                *(u32x4*)(MIXB + off + bj * HALF) = pack8(g[0] * acc[ai][bj][m][0], g[1] * acc[ai][bj][m][1]); }
        EPI_ROWS_END
    }
};
struct EpiRes1 {
    const float* X; bf16_t* X1B; float* SSQ;
    template <int NAI> __device__ __forceinline__ void run(const f32x4 (&acc)[2][2][4][2], const Unit& u, int wr, int wc, int fr, int fq) const {
        const int col0 = u.pn * BM + wc * 32 + 8 * fq;
        EPI_ROWS_BEGIN
            const unsigned off = (unsigned)row * 1024u + (unsigned)col0; float ss = 0.f;
#pragma unroll
            for (int bj = 0; bj < 2; ++bj) {
                const f32x4 a = *(const f32x4*)(X + off + bj * HALF) + acc[ai][bj][m][0], b = *(const f32x4*)(X + off + bj * HALF + 4) + acc[ai][bj][m][1];
                *(u32x4*)(X1B + off + bj * HALF) = pack8(a, b);
                ss += (a[0] * a[0] + a[1] * a[1]) + (a[2] * a[2] + a[3] * a[3]) + (b[0] * b[0] + b[1] * b[1]) + (b[2] * b[2] + b[3] * b[3]); }
            ss += __shfl_xor(ss, 16); ss += __shfl_xor(ss, 32);
            if (fq == 0) SSQ[(unsigned)row * 16u + (unsigned)(u.pn * 4 + wc)] = ss;
        EPI_ROWS_END
    }
};
struct EpiSwiglu {
    const float* SSQ; bf16_t* ACT;
    template <int NAI> __device__ __forceinline__ void run(const f32x4 (&acc)[2][2][4][2], const Unit& u, int wr, int wc, int fr, int fq) const {
        const int col0 = u.pn * 128 + wc * 32 + 8 * fq;
        EPI_ROWS_BEGIN
            const f32x4 st = *(const f32x4*)(SSQ + (unsigned)row * 16u + (unsigned)(4 * fq));
            float sq = (st[0] + st[1]) + (st[2] + st[3]); sq += __shfl_xor(sq, 16); sq += __shfl_xor(sq, 32);
            const float rs = __builtin_amdgcn_rsqf(sq * (1.0f / 1024.0f) + 1e-6f);
            f32x4 o[2];
#pragma unroll
            for (int n = 0; n < 2; ++n)
#pragma unroll
                for (int j = 0; j < 4; ++j) { const float g = acc[ai][0][m][n][j] * rs, up = acc[ai][1][m][n][j] * rs; o[n][j] = g * sigmoidf_(g) * up; }
            *(u32x4*)(ACT + (unsigned)((unsigned)row * 2816u + (unsigned)col0)) = pack8(o[0], o[1]);
        EPI_ROWS_END
    }
};
struct EpiRes2 {
    const bf16_t* X1B; float* OUT;
    template <int NAI> __device__ __forceinline__ void run(const f32x4 (&acc)[2][2][4][2], const Unit& u, int wr, int wc, int fr, int fq) const {
        const int col0 = u.pn * BM + wc * 32 + 8 * fq;
        EPI_ROWS_BEGIN
            const unsigned off = (unsigned)row * 1024u + (unsigned)col0;
#pragma unroll
            for (int bj = 0; bj < 2; ++bj) { f32x4 xa, xb; unpack8(*(const u32x4*)(X1B + off + bj * HALF), xa, xb);
                *(f32x4*)(OUT + off + bj * HALF) = xa + acc[ai][bj][m][0]; *(f32x4*)(OUT + off + bj * HALF + 4) = xb + acc[ai][bj][m][1]; }
        EPI_ROWS_END
    }
};

struct EpiFinal {
    const bf16_t* X1B; float* OUT; float* SSQ2; unsigned* cnt; const float* gfin;
    template <int NAI> __device__ __forceinline__ void run(f32x4 (&acc)[2][2][4][2], const Unit& u, int wr, int wc, int fr, int fq) const {
        const int col0 = u.pn * BM + wc * 32 + 8 * fq;
        EPI_ROWS_BEGIN
            const unsigned off = (unsigned)row * 1024u + (unsigned)col0; float ss = 0.f;
#pragma unroll
            for (int bj = 0; bj < 2; ++bj) { f32x4 xa, xb; unpack8(*(const u32x4*)(X1B + off + bj * HALF), xa, xb);
                const f32x4 a = xa + acc[ai][bj][m][0], b = xb + acc[ai][bj][m][1]; acc[ai][bj][m][0] = a; acc[ai][bj][m][1] = b;
                ss += (a[0] * a[0] + a[1] * a[1]) + (a[2] * a[2] + a[3] * a[3]) + (b[0] * b[0] + b[1] * b[1]) + (b[2] * b[2] + b[3] * b[3]); }
            ss += __shfl_xor(ss, 16); ss += __shfl_xor(ss, 32);
            if (fq == 0) __hip_atomic_store(SSQ2 + (unsigned)row * 16u + (unsigned)(u.pn * 4 + wc), ss, __ATOMIC_RELAXED, __HIP_MEMORY_SCOPE_AGENT);
        EPI_ROWS_END
        asm volatile("s_waitcnt vmcnt(0)" ::: "memory");
        unsigned* c = cnt + 64 * u.pm;
        if ((threadIdx.x & 63) == 0) __hip_atomic_fetch_add(c, 1u, __ATOMIC_RELAXED, __HIP_MEMORY_SCOPE_AGENT);
        { unsigned sp = 0;
          while ((unsigned)__builtin_amdgcn_readfirstlane(__hip_atomic_load(c, __ATOMIC_RELAXED, __HIP_MEMORY_SCOPE_AGENT)) < 32u) { __builtin_amdgcn_s_sleep(2); if (++sp > (1u << 20)) break; } }
        __builtin_amdgcn_fence(__ATOMIC_ACQUIRE, "agent");
        f32x4 gv[2][2];
#pragma unroll
        for (int bj = 0; bj < 2; ++bj)
#pragma unroll
            for (int n = 0; n < 2; ++n) gv[bj][n] = *(const f32x4*)(gfin + col0 + bj * HALF + 4 * n);
        EPI_ROWS_BEGIN
            const unsigned off = (unsigned)row * 1024u + (unsigned)col0;
            const unsigned long long* sl = (const unsigned long long*)(SSQ2 + (unsigned)row * 16u + (unsigned)(4 * fq));
            const unsigned long long w0 = __hip_atomic_load(sl, __ATOMIC_RELAXED, __HIP_MEMORY_SCOPE_AGENT), w1 = __hip_atomic_load(sl + 1, __ATOMIC_RELAXED, __HIP_MEMORY_SCOPE_AGENT);
            float sq = (__uint_as_float((unsigned)w0) + __uint_as_float((unsigned)(w0 >> 32))) + (__uint_as_float((unsigned)w1) + __uint_as_float((unsigned)(w1 >> 32)));
            sq += __shfl_xor(sq, 16); sq += __shfl_xor(sq, 32);
            const float rs = 1.0f / sqrtf(sq * (1.0f / 1024.0f) + 1e-6f);
#pragma unroll
            for (int bj = 0; bj < 2; ++bj) { *(f32x4*)(OUT + off + bj * HALF) = acc[ai][bj][m][0] * rs * gv[bj][0]; *(f32x4*)(OUT + off + bj * HALF + 4) = acc[ai][bj][m][1] * rs * gv[bj][1]; }
        EPI_ROWS_END
    }
};

template <class Epi, bool ALIGN_EPI, int MID_T = -1>
__device__ __forceinline__ void gemm_phase(PG8_LAS unsigned char* lds, const Gemm g, const StaticOrder& S, const Epi& E) {
    const int tid = threadIdx.x, wid = __builtin_amdgcn_readfirstlane(tid >> 6), lane = tid & 63, wr = wid >> 2, wc = wid & 3, fr = lane & 15, fq = lane >> 4;
    int nt = g.K / BK; asm volatile("" : "+s"(nt));
    unsigned voffA[2], voffB[2];
#pragma unroll
    for (int i = 0; i < 2; ++i) { int R, C; stage_rc(tid * 16 + i * 8192, R, C); const int Rb = (R & ~31) + perm32(R & 31);
        voffA[i] = (unsigned)(R * g.lda + C) * 2u; voffB[i] = (unsigned)(Rb * g.ldb + C) * 2u; }
    const size_t kstep = (size_t)(BK * 2);
    const size_t hstepA = (size_t)HALF * g.lda * 2, hstepB = (size_t)HALF * g.ldb * 2;
    const size_t tstepA = 2 * hstepA, tstepB = 2 * hstepB;
    const unsigned ldsw = (unsigned)wid * 1024u;
    const int aoff = lds_byte(wr * 64 + fr, fq * 8), boff = lds_byte(wc * 32 + fr, fq * 8);
#define PG8_SA(b, h) (((b) * 2 + (h)) * HTB)
#define PG8_SB(b, h) ((4 + (b) * 2 + (h)) * HTB)
#define PG8_STAGE(bufoff, gbase, voff) do { _Pragma("unroll") for (int _i = 0; _i < 2; ++_i) \
        __builtin_amdgcn_global_load_lds((const unsigned*)((const char*)(gbase) + (voff)[_i]), (PG8_LAS unsigned*)(lds + (bufoff) + ldsw + _i * 8192), 16, 0, 0); } while (0)
#define PG8_LDA(dst, b, h) do { _Pragma("unroll") for (int m = 0; m < 4; ++m) _Pragma("unroll") for (int k = 0; k < 2; ++k) dst[m][k] = *(const PG8_LAS bf16x8*)(lds + PG8_SA(b, h) + aoff + m * 2048 + k * 1024); } while (0)
#define PG8_LDB(dst, b, h) do { _Pragma("unroll") for (int n = 0; n < 2; ++n) _Pragma("unroll") for (int k = 0; k < 2; ++k) dst[n][k] = *(const PG8_LAS bf16x8*)(lds + PG8_SB(b, h) + boff + n * 2048 + k * 1024); } while (0)
#define PG8_MMA(ai, bj, At, Bt) do { __builtin_amdgcn_s_setprio(1); _Pragma("unroll") for (int m = 0; m < 4; ++m) _Pragma("unroll") for (int n = 0; n < 2; ++n) _Pragma("unroll") for (int k = 0; k < 2; ++k) \
        acc[ai][bj][m][n] = __builtin_amdgcn_mfma_f32_16x16x32_bf16(Bt[n][k], At[m][k], acc[ai][bj][m][n], 0, 0, 0); __builtin_amdgcn_s_setprio(0); } while (0)
#define PG8_WAIT_V(n) asm volatile("s_waitcnt vmcnt(" #n ")" ::: "memory")
#define PG8_WAIT_L(n) asm volatile("s_waitcnt lgkmcnt(" #n ")" ::: "memory")
#define PG8_BAR __builtin_amdgcn_s_barrier()
#define PG8_SCHED __builtin_amdgcn_sched_barrier(0)
    Unit cur, nxt; int ui = 0;
    if (!S.next(0, cur)) return;
    f32x4 acc[2][2][4][2];
#pragma unroll
    for (int a = 0; a < 2; ++a)
#pragma unroll
        for (int b = 0; b < 2; ++b)
#pragma unroll
            for (int m = 0; m < 4; ++m)
#pragma unroll
                for (int n = 0; n < 2; ++n) acc[a][b][m][n] = (f32x4){0.f, 0.f, 0.f, 0.f};
    bf16x8 At[4][2], B0[2][2], B1[2][2];
    const char* cA = (const char*)g.A + (size_t)cur.pm * tstepA + (size_t)((cur.pn >> g.ash) * g.amul) * 2; const char* cB = (const char*)g.Bt + (size_t)cur.pn * tstepB;
    PG8_STAGE(PG8_SB(0, 0), cB, voffB); PG8_STAGE(PG8_SB(0, 1), cB + hstepB, voffB); PG8_STAGE(PG8_SA(0, 0), cA, voffA); PG8_STAGE(PG8_SA(0, 1), cA + hstepA, voffA);
    if (wr == 1) PG8_BAR;
    PG8_WAIT_V(2); PG8_BAR;
    PG8_STAGE(PG8_SB(1, 0), cB + kstep, voffB); PG8_STAGE(PG8_SA(1, 0), cA + kstep, voffA); PG8_STAGE(PG8_SB(1, 1), cB + hstepB + kstep, voffB);
    PG8_WAIT_V(6); PG8_BAR;
    for (;;) {
        const bool has_next = S.next(ui + 1, nxt);
        const char* nA = has_next ? (const char*)g.A + (size_t)nxt.pm * tstepA + (size_t)((nxt.pn >> g.ash) * g.amul) * 2 : cA; const char* nB = has_next ? (const char*)g.Bt + (size_t)nxt.pn * tstepB : cB;
        for (int t = 0; t < nt; t += 2) {
            const bool last = (t == nt - 2);
            if constexpr (MID_T >= 0) { if (t == MID_T) E.mid(acc, cur, wr, wc, fr, fq); }
            const char* a1 = cA + (size_t)(t + 1) * kstep;
            const char* a2 = last ? nA : cA + (size_t)(t + 2) * kstep; const char* b2 = last ? nB : cB + (size_t)(t + 2) * kstep;
            const char* a3 = a2 + kstep; const char* b3 = b2 + kstep;
            PG8_LDB(B0, 0, 0); PG8_LDB(B1, 0, 1); PG8_SCHED; PG8_LDA(At, 0, 0); PG8_STAGE(PG8_SA(1, 1), a1 + hstepA, voffA);
            PG8_WAIT_V(8); PG8_WAIT_L(0); PG8_BAR; PG8_MMA(0, 0, At, B0); PG8_MMA(0, 1, At, B1); PG8_BAR; PG8_SCHED;
            PG8_LDA(At, 0, 1); PG8_STAGE(PG8_SB(0, 0), b2, voffB); PG8_STAGE(PG8_SB(0, 1), b2 + hstepB, voffB); PG8_STAGE(PG8_SA(0, 0), a2, voffA);
            PG8_WAIT_V(8); PG8_WAIT_L(0); PG8_BAR; PG8_MMA(1, 0, At, B0); PG8_MMA(1, 1, At, B1); PG8_BAR; PG8_SCHED;
            PG8_LDB(B0, 1, 0); PG8_LDB(B1, 1, 1); PG8_SCHED; PG8_LDA(At, 1, 0); PG8_STAGE(PG8_SA(0, 1), a2 + hstepA, voffA);
            PG8_WAIT_V(8); PG8_WAIT_L(0); PG8_BAR; PG8_MMA(0, 0, At, B0); PG8_MMA(0, 1, At, B1); PG8_BAR; PG8_SCHED;
            PG8_LDA(At, 1, 1); PG8_STAGE(PG8_SB(1, 0), b3, voffB); PG8_STAGE(PG8_SB(1, 1), b3 + hstepB, voffB); PG8_STAGE(PG8_SA(1, 0), a3, voffA);
            PG8_WAIT_V(8); PG8_WAIT_L(0); PG8_BAR; PG8_MMA(1, 0, At, B0); PG8_MMA(1, 1, At, B1); PG8_BAR; PG8_SCHED;
        }
        if constexpr (ALIGN_EPI) { if (wr == 0) PG8_BAR; }
        E.template run<2>(acc, cur, wr, wc, fr, fq);
        if (!has_next) break;
#pragma unroll
        for (int a = 0; a < 2; ++a)
#pragma unroll
            for (int b = 0; b < 2; ++b)
#pragma unroll
                for (int m = 0; m < 4; ++m)
#pragma unroll
                    for (int n = 0; n < 2; ++n) acc[a][b][m][n] = (f32x4){0.f, 0.f, 0.f, 0.f};
        cur = nxt; cA = nA; cB = nB; ++ui;
        if constexpr (ALIGN_EPI) { if (wr == 1) PG8_BAR; }
    }
    PG8_WAIT_V(0);
    if constexpr (!ALIGN_EPI) { if (wr == 0) PG8_BAR; }
    PG8_BAR;
#undef PG8_SA
#undef PG8_SB
#undef PG8_STAGE
#undef PG8_LDA
#undef PG8_LDB
#undef PG8_MMA
#undef PG8_WAIT_V
#undef PG8_WAIT_L
#undef PG8_BAR
#undef PG8_SCHED
}

template <class Epi>
__device__ __forceinline__ void gemm_half(PG8_LAS unsigned char* lds, const Gemm g, const Unit u, const Epi& E) {
    const int tid = threadIdx.x, wid = __builtin_amdgcn_readfirstlane(tid >> 6), lane = tid & 63, wr = wid >> 2, wc = wid & 3, fr = lane & 15, fq = lane >> 4;
    int nt = g.K / BK; asm volatile("" : "+s"(nt));
    unsigned voffA[2], voffB[2];
#pragma unroll
    for (int i = 0; i < 2; ++i) { int R, C; stage_rc(tid * 16 + i * 8192, R, C); const int Rb = (R & ~31) + perm32(R & 31);
        voffA[i] = (unsigned)(R * g.lda + C) * 2u; voffB[i] = (unsigned)(Rb * g.ldb + C) * 2u; }
    const size_t kstep = (size_t)(BK * 2);
    const size_t hstepA = (size_t)HALF * g.lda * 2, hstepB = (size_t)HALF * g.ldb * 2;
    const unsigned ldsw = (unsigned)wid * 1024u;
    const int aoff = lds_byte(wr * 64 + fr, fq * 8), boff = lds_byte(wc * 32 + fr, fq * 8);
#define PG8_SA(b, h) (((b) * 2 + (h)) * HTB)
#define PG8_SB(b, h) ((4 + (b) * 2 + (h)) * HTB)
#define PG8_STAGE(bufoff, gbase, voff) do { _Pragma("unroll") for (int _i = 0; _i < 2; ++_i) \
        __builtin_amdgcn_global_load_lds((const unsigned*)((const char*)(gbase) + (voff)[_i]), (PG8_LAS unsigned*)(lds + (bufoff) + ldsw + _i * 8192), 16, 0, 0); } while (0)
#define PG8_LDA(dst, b, h) do { _Pragma("unroll") for (int m = 0; m < 4; ++m) _Pragma("unroll") for (int k = 0; k < 2; ++k) dst[m][k] = *(const PG8_LAS bf16x8*)(lds + PG8_SA(b, h) + aoff + m * 2048 + k * 1024); } while (0)
#define PG8_LDB(dst, b, h) do { _Pragma("unroll") for (int n = 0; n < 2; ++n) _Pragma("unroll") for (int k = 0; k < 2; ++k) dst[n][k] = *(const PG8_LAS bf16x8*)(lds + PG8_SB(b, h) + boff + n * 2048 + k * 1024); } while (0)
#define PG8_MMA(ai, bj, At, Bt) do { __builtin_amdgcn_s_setprio(1); _Pragma("unroll") for (int m = 0; m < 4; ++m) _Pragma("unroll") for (int n = 0; n < 2; ++n) _Pragma("unroll") for (int k = 0; k < 2; ++k) \
        acc[ai][bj][m][n] = __builtin_amdgcn_mfma_f32_16x16x32_bf16(Bt[n][k], At[m][k], acc[ai][bj][m][n], 0, 0, 0); __builtin_amdgcn_s_setprio(0); } while (0)
#define PG8_WAIT_V(n) asm volatile("s_waitcnt vmcnt(" #n ")" ::: "memory")
#define PG8_WAIT_L(n) asm volatile("s_waitcnt lgkmcnt(" #n ")" ::: "memory")
#define PG8_BAR __builtin_amdgcn_s_barrier()
#define PG8_SCHED __builtin_amdgcn_sched_barrier(0)
    f32x4 acc[2][2][4][2];
#pragma unroll
    for (int a = 0; a < 2; ++a)
#pragma unroll
        for (int b = 0; b < 2; ++b)
#pragma unroll
            for (int m = 0; m < 4; ++m)
#pragma unroll
                for (int n = 0; n < 2; ++n) acc[a][b][m][n] = (f32x4){0.f, 0.f, 0.f, 0.f};
    bf16x8 At[4][2], B0[2][2], B1[2][2];
    const char* cA = (const char*)g.A + ((size_t)u.pm * BM + u.rh) * g.lda * 2 + (size_t)((u.pn >> g.ash) * g.amul) * 2; const char* cB = (const char*)g.Bt + (size_t)u.pn * 2 * hstepB;
    PG8_STAGE(PG8_SB(0, 0), cB, voffB); PG8_STAGE(PG8_SB(0, 1), cB + hstepB, voffB); PG8_STAGE(PG8_SA(0, 0), cA, voffA);
    PG8_STAGE(PG8_SB(1, 0), cB + kstep, voffB); PG8_STAGE(PG8_SB(1, 1), cB + hstepB + kstep, voffB); PG8_STAGE(PG8_SA(1, 0), cA + kstep, voffA);
    PG8_WAIT_V(6); PG8_BAR;
#define PG8_HALF_STEP(b, tt) do { \
        PG8_LDB(B0, b, 0); PG8_LDB(B1, b, 1); PG8_LDA(At, b, 0); PG8_WAIT_L(0); PG8_BAR; PG8_SCHED; \
        const bool more_ = (tt) + 2 < nt; \
        if (more_) { const char* b2 = cB + (size_t)((tt) + 2) * kstep; const char* a2 = cA + (size_t)((tt) + 2) * kstep; \
            PG8_STAGE(PG8_SB(b, 0), b2, voffB); PG8_STAGE(PG8_SB(b, 1), b2 + hstepB, voffB); PG8_STAGE(PG8_SA(b, 0), a2, voffA); } \
        PG8_MMA(0, 0, At, B0); PG8_MMA(0, 1, At, B1); \
        if (more_) PG8_WAIT_V(6); else PG8_WAIT_V(0); \
        PG8_BAR; PG8_SCHED; } while (0)
    for (int t = 0; t < nt; t += 2) { PG8_HALF_STEP(0, t); PG8_HALF_STEP(1, t + 1); }
    E.template run<1>(acc, u, wr, wc, fr, fq);
    PG8_BAR;
#undef PG8_HALF_STEP
#undef PG8_SA
#undef PG8_SB
#undef PG8_STAGE
#undef PG8_LDA
#undef PG8_LDB
#undef PG8_MMA
#undef PG8_WAIT_V
#undef PG8_WAIT_L
#undef PG8_BAR
#undef PG8_SCHED
}
}

constexpr int NWAVES = 8, NTHR = 512;
constexpr int M = 16384, SEQ = 4096, NB = 4, D = 1024, DPOOL = 512, DRNN = 1024, DIN = 4608, DFF = 2816;
constexpr float EPS = 1e-6f;
constexpr int NPH = 11;
constexpr int SCAN_T = 128, SCAN_NC = SEQ / SCAN_T;

constexpr size_t MiB = 1u << 20;
constexpr size_t WS_SP8 = 512 * 1024;
constexpr size_t WS_SSQ = 1 * MiB;
constexpr size_t WS_SSQ2 = 2 * MiB;
constexpr size_t WS_CS = 2 * MiB, WS_CH = 3 * MiB;
constexpr size_t WS_WIN = 4 * MiB;
constexpr size_t WS_WFI = 13 * MiB;
constexpr size_t WS_WFO = 24 * MiB;
constexpr size_t WS_WCAT = WS_WFO + 5632 * 1024;
constexpr size_t WS_WO = WS_WCAT + 3 * MiB;
constexpr size_t WS_WGRP = WS_WO + 2 * MiB;
constexpr size_t WS_WGATE = WS_WGRP + MiB / 4;
constexpr size_t WS_R1 = 36 * MiB;
constexpr size_t WS_R2 = 68 * MiB;
constexpr size_t WS_R3 = 84 * MiB;
constexpr size_t WS_R4 = 116 * MiB;
constexpr size_t WS_R7 = 148 * MiB;
constexpr size_t WS_R8 = 164 * MiB;
constexpr size_t WS_CAT = 196 * MiB;
constexpr size_t WS_MIXB = 148 * MiB;
constexpr size_t WS_ACT = 68 * MiB;
constexpr size_t WS_END = 244 * MiB;

constexpr int LDS_BYTES = 147456;

#define LAS __attribute__((address_space(3)))
typedef unsigned short bf16;
typedef unsigned v4u __attribute__((ext_vector_type(4)));
typedef unsigned v2u __attribute__((ext_vector_type(2)));
typedef float f32x4 __attribute__((ext_vector_type(4)));
typedef float f32x2 __attribute__((ext_vector_type(2)));
#define LDS_WAIT() asm volatile("s_waitcnt lgkmcnt(0)" ::: "memory")
using pg8::cvt_pk_bf16; using pg8::bf_lo; using pg8::bf_hi;

struct Args { const float* in[19]; float* out; unsigned char* ws; int ph_lo, ph_hi; };
enum { I_X = 0, I_NORM_MIX, I_W_IN, I_W_GRP, I_POOL_SCALE, I_W_POOL_OUT, I_CONV_W, I_CONV_B, I_W_RG_A, I_B_RG_A, I_W_RG_X, I_B_RG_X, I_LAMBDA, I_W_RNN_OUT, I_W_O, I_NORM_FFN, I_W_FFN_IN, I_W_FFN_OUT, I_NORM_FINAL };

__device__ __forceinline__ float wave_sum(float v) {
#pragma unroll
    for (int o = 1; o < 64; o <<= 1) v += __shfl_xor(v, o);
    return v;
}

__device__ __forceinline__ void transpose_item(const float* W, int Nsrc, int Kdst, bf16* WT, int k0, int n_src0, int n_dst0, const float* kscale, LAS float* scr, int lane) {
    f32x4 v[8]; const int n4 = (lane & 7) * 4;
#pragma unroll
    for (int i = 0; i < 8; ++i) { const int kk = 8 * i + (lane >> 3); v[i] = *(const f32x4*)(W + (size_t)(k0 + kk) * Nsrc + n_src0 + n4); }
    if (kscale) {
#pragma unroll
        for (int i = 0; i < 8; ++i) v[i] = v[i] * kscale[k0 + 8 * i + (lane >> 3)]; }
#pragma unroll
    for (int i = 0; i < 8; ++i) { const int kk = 8 * i + (lane >> 3);
#pragma unroll
        for (int j = 0; j < 4; ++j) scr[kk * 33 + n4 + j] = v[i][j]; }
    LDS_WAIT(); asm volatile("" ::: "memory");
    const int c = lane & 7;
#pragma unroll
    for (int j = 0; j < 4; ++j) { const int n = (lane >> 3) + 8 * j; const LAS float* s = scr + (8 * c) * 33 + n;
        v4u o; o.x = cvt_pk_bf16(s[0 * 33], s[1 * 33]); o.y = cvt_pk_bf16(s[2 * 33], s[3 * 33]); o.z = cvt_pk_bf16(s[4 * 33], s[5 * 33]); o.w = cvt_pk_bf16(s[6 * 33], s[7 * 33]);
        *(v4u*)(WT + (size_t)(n_dst0 + n) * Kdst + k0 + 8 * c) = o; }
    LDS_WAIT(); asm volatile("" ::: "memory");
}

#define XB_TMO      128
#define XB_XCNT(j)  (256  + 64 * (j))
#define XB_XSUB(j)  (1280 + 64 * (j))
#define XB_XGEN(j)  (2304 + 64 * (j))
#define XB_TOP      3328
#define XB_TOPGEN   3392
#define XCD_BAR_WORDS 3456
#define XB_SPIN_CAP (1u << 18)
__device__ __forceinline__ unsigned xb_ld(unsigned* p)              { return __hip_atomic_load(p, __ATOMIC_RELAXED, __HIP_MEMORY_SCOPE_AGENT); }
__device__ __forceinline__ unsigned xb_add(unsigned* p, unsigned v) { return __hip_atomic_fetch_add(p, v, __ATOMIC_RELAXED, __HIP_MEMORY_SCOPE_AGENT); }
__device__ __forceinline__ unsigned xb_xcc_id() { return (unsigned)__builtin_amdgcn_s_getreg((3 << 11) | 20) & 0xFu; }
#define XB_SPIN(cond, bar) do { unsigned _sp = 0; while (cond) { __builtin_amdgcn_s_sleep(1); \
    if ((++_sp & 255u) == 0u) { if (xb_ld(&(bar)[XB_TMO])) break; if (_sp > XB_SPIN_CAP) { atomicAdd(&(bar)[XB_TMO], 1u); break; } } } } while (0)
struct XcdBarrier { unsigned* bar; unsigned x; volatile LAS unsigned* st; };
__device__ __forceinline__ XcdBarrier xcd_barrier_post(unsigned* bar, volatile LAS unsigned* st) {
    XcdBarrier b; b.bar = bar; b.x = xb_xcc_id(); b.st = st;
    if (threadIdx.x == 0) (void)xb_add(&bar[XB_XCNT(b.x)], 1u);
    return b;
}
__device__ __forceinline__ void xcd_barrier_complete(unsigned* bar, unsigned x, unsigned& nloc, unsigned& nx) {
    const unsigned G = gridDim.x * gridDim.y * gridDim.z;
    unsigned sum, cnt, mine, sp = 0u;
    for (;;) {
        sum = 0u; cnt = 0u; mine = 0u;
#pragma unroll
        for (unsigned j = 0; j < 16; ++j) { const unsigned c = xb_ld(&bar[XB_XCNT(j)]); sum += c; cnt += (c > 0u) ? 1u : 0u; mine = (j == x) ? c : mine; }
        if (sum == G) break;
        __builtin_amdgcn_s_sleep(1);
        if ((++sp & 255u) == 0u) { if (xb_ld(&bar[XB_TMO])) break; if (sp > XB_SPIN_CAP) { atomicAdd(&bar[XB_TMO], 1u); break; } }
    }
    nloc = mine > 0u ? mine : 1u; nx = cnt > 0u ? cnt : 1u;
}
__device__ __forceinline__ void xcd_barrier(const XcdBarrier& b) {
    asm volatile("s_waitcnt vmcnt(0)" ::: "memory");
    __syncthreads();
    if (threadIdx.x == 0) {
        unsigned* bar = b.bar;
        __builtin_amdgcn_s_waitcnt(0);
        unsigned nloc = b.st[0], nx = b.st[1];
        if (nloc == 0u) { xcd_barrier_complete(bar, b.x, nloc, nx); b.st[0] = nloc; b.st[1] = nx; }
        const unsigned old = xb_add(&bar[XB_XSUB(b.x)], 1u);
        const unsigned gen = old / nloc;
        if (old + 1u == (gen + 1u) * nloc) {
            __builtin_amdgcn_fence(__ATOMIC_RELEASE, "agent");
            asm volatile("s_waitcnt vmcnt(0)" ::: "memory");
            const unsigned og = xb_add(&bar[XB_TOP], 1u);
            const unsigned tg = og / nx;
            if (og + 1u == (tg + 1u) * nx) xb_add(&bar[XB_TOPGEN], 1u);
            else XB_SPIN(xb_ld(&bar[XB_TOPGEN]) == tg, bar);
            __builtin_amdgcn_fence(__ATOMIC_ACQUIRE, "agent");
            xb_add(&bar[XB_XGEN(b.x)], 1u);
            asm volatile("s_waitcnt vmcnt(0)" ::: "memory");
        } else {
            XB_SPIN(xb_ld(&bar[XB_XGEN(b.x)]) == gen, bar);
            __builtin_amdgcn_fence(__ATOMIC_ACQUIRE, "agent");
            asm volatile("s_waitcnt vmcnt(0)" ::: "memory");
        }
    }
    __syncthreads();
}

template <int W>
__device__ __forceinline__ void pool_item(const bf16* src, bf16* dst, int tl) {
    v4u rw[W + 7];
#pragma unroll
    for (int k = 0; k < W + 7; ++k) rw[k] = (tl + k - (W - 1) >= 0) ? *(const v4u*)(src + (ptrdiff_t)(k - (W - 1)) * DPOOL) : (v4u){0u, 0u, 0u, 0u};
    f32x4 s0 = {0.f, 0.f, 0.f, 0.f}, s1 = s0;
#pragma unroll
    for (int k = 0; k < W - 1; ++k) { f32x4 a, c; pg8::unpack8(rw[k], a, c); s0 += a; s1 += c; }
#pragma unroll
    for (int i = 0; i < 8; ++i) { f32x4 a, c; pg8::unpack8(rw[W - 1 + i], a, c); s0 += a; s1 += c;
        const int t = tl + i; const int cnt = (t + 1 < W) ? t + 1 : W; const float inv = 1.0f / (float)cnt;
        *(v4u*)(dst + (size_t)i * DPOOL) = pg8::pack8(s0 * inv - a, s1 * inv - c);
        f32x4 a2, c2; pg8::unpack8(rw[i], a2, c2); s0 -= a2; s1 -= c2; }
}
__device__ __forceinline__ void scan_local16(const bf16* lap, const bf16* bbp, f32x4 (&S)[2], f32x4 (&H)[2]) {
    S[0] = S[1] = H[0] = H[1] = (f32x4){0.f, 0.f, 0.f, 0.f};
#pragma unroll
    for (int i0 = 0; i0 < 16; i0 += 8) { v4u lw[8], bw[8];
#pragma unroll
        for (int i = 0; i < 8; ++i) { lw[i] = *(const v4u*)(lap + (size_t)(i0 + i) * DRNN); bw[i] = *(const v4u*)(bbp + (size_t)(i0 + i) * DRNN); }
#pragma unroll
        for (int i = 0; i < 8; ++i) { f32x4 l[2], bq[2]; pg8::unpack8(lw[i], l[0], l[1]); pg8::unpack8(bw[i], bq[0], bq[1]);
#pragma unroll
            for (int n = 0; n < 2; ++n)
#pragma unroll
                for (int j = 0; j < 4; ++j) { H[n][j] = __expf(l[n][j]) * H[n][j] + bq[n][j]; S[n][j] += l[n][j]; } } }
}

__global__ void __launch_bounds__(NTHR, 2) fwd_kernel(Args args) {
    extern __shared__ __attribute__((aligned(16))) unsigned char lds_raw[];
    LAS unsigned char* lds = (LAS unsigned char*)lds_raw;
    const int tid = threadIdx.x, lane = tid & 63, wave = __builtin_amdgcn_readfirstlane(tid >> 6);
    const int G = gridDim.x, bx = blockIdx.x;
    unsigned char* ws = args.ws;
    const int lo = args.ph_lo, hi = args.ph_hi;
#ifndef PHASE_MASK
#define PHASE_MASK 0x7ff
#endif
#define IN(k) (((PHASE_MASK >> (k)) & 1) && lo <= (k) && (k) < hi)
#ifndef REPEAT_MASK
#define REPEAT_MASK 0
#endif
#define REPS(k) (((REPEAT_MASK >> (k)) & 1) ? 2 : 1)
#ifndef PROBE_PHASE
#define PROBE_PHASE -1
#endif
#define PROBE_MULT 4
    unsigned long long tp0 = 0, tp1 = 0;
#define TSTART(k) do { if ((k) == PROBE_PHASE) tp0 = __builtin_amdgcn_s_memrealtime(); } while (0)
#define TEND(k) do { if ((k) == PROBE_PHASE) tp1 = __builtin_amdgcn_s_memrealtime(); } while (0)
#define GSYNC() xcd_barrier(bar)
#define SEAM(k) do { if (IN(k) && IN((k) + 1)) { GSYNC(); } } while (0)

    const float* x = args.in[I_X];
    bf16* WIN = (bf16*)(ws + WS_WIN); bf16* WFI = (bf16*)(ws + WS_WFI); bf16* WFO = (bf16*)(ws + WS_WFO); bf16* WCAT = (bf16*)(ws + WS_WCAT);
    bf16* WO = (bf16*)(ws + WS_WO); bf16* WGRP = (bf16*)(ws + WS_WGRP); bf16* WGATE = (bf16*)(ws + WS_WGATE);
    bf16* XN = (bf16*)(ws + WS_R1); bf16* X1B = XN;
    bf16* CAT = (bf16*)(ws + WS_CAT); bf16* V = CAT + 512;
    bf16* UP = (bf16*)(ws + WS_R2);
    bf16* UR = (bf16*)(ws + WS_R3); bf16* LA = UR;
    bf16* UG = (bf16*)(ws + WS_R4);
    bf16* POOLED = (bf16*)(ws + WS_R7); bf16* BB = (bf16*)(ws + WS_R8);
    bf16* MIXB = (bf16*)(ws + WS_MIXB); bf16* ACT = (bf16*)(ws + WS_ACT);
    float* SSQ = (float*)(ws + WS_SSQ); float* CS = (float*)(ws + WS_CS); float* CH = (float*)(ws + WS_CH);
    bf16* G0 = (bf16*)args.out; bf16* G1 = G0 + (size_t)M * 1024;
    float* X1 = args.out;

#ifndef EXTRA_SYNCS
#define EXTRA_SYNCS 0
#endif
    if (PROBE_PHASE == 99) tp0 = __builtin_amdgcn_s_memrealtime();
    volatile LAS unsigned* MISC = (volatile LAS unsigned*)(lds + 131072 + 1024);
    if (tid < 32) MISC[tid] = 0u;
    __syncthreads();
    XcdBarrier bar = xcd_barrier_post((unsigned*)ws, MISC + 8);
    if (lo < 0) cg::this_grid().sync();
    for (int i = 0; i < EXTRA_SYNCS; ++i) GSYNC();
    TSTART(0);
    if (IN(0)) for (int rep = 0; rep < REPS(0); ++rep) { if (rep) GSYNC();
        LAS float* scr = (LAS float*)(lds + wave * 16384);
        const int gw = bx * NWAVES + wave, NGW = G * NWAVES;
        constexpr int I_IN = 16 * (DIN / 32), I_FI = 16 * (2 * DFF / 32), I_FO = (DFF / 64) * (D / 32), I_RO = 16 * 32, I_WO = 16 * 32, I_PO = 8 * 32;
        constexpr int NITEMS = I_IN + I_FI + I_FO + I_RO + I_WO + I_PO;
        for (int it = gw; it < NITEMS; it += NGW) {
            int r = it;
            if (r < I_IN) { const int nblk = DIN / 32, kb = r / nblk, nb = r % nblk, nd = 32 * nb; int ns = nd;
                if (nd >= 2560) { const int q = nd - 2560, pq = q >> 8, j0 = q & 255; ns = 2560 + (j0 < 128 ? 128 * pq + j0 : 1024 + 128 * pq + (j0 - 128)); }
                transpose_item(args.in[I_W_IN], DIN, D, WIN, 64 * kb, ns, nd, nullptr, scr, lane); continue; } r -= I_IN;
            if (r < I_FI) { const int nblk = 2 * DFF / 32, kb = r / nblk, nb = r % nblk, nd = 32 * nb, pn = nd >> 8, j0 = nd & 255;
                const int ns = j0 < 128 ? 128 * pn + j0 : DFF + 128 * pn + (j0 - 128);
                transpose_item(args.in[I_W_FFN_IN], 2 * DFF, D, WFI, 64 * kb, ns, nd, args.in[I_NORM_FFN], scr, lane); continue; } r -= I_FI;
            if (r < I_FO) { const int nblk = D / 32, kb = r / nblk, nb = r % nblk; transpose_item(args.in[I_W_FFN_OUT], D, DFF, WFO, 64 * kb, 32 * nb, 32 * nb, nullptr, scr, lane); continue; } r -= I_FO;
            if (r < I_RO) { const int nblk = D / 32, kb = r / nblk, nb = r % nblk; transpose_item(args.in[I_W_RNN_OUT], D, 1536, WCAT + 512, 64 * kb, 32 * nb, 32 * nb, nullptr, scr, lane); continue; } r -= I_RO;
            if (r < I_WO) { const int nblk = D / 32, kb = r / nblk, nb = r % nblk; transpose_item(args.in[I_W_O], D, D, WO, 64 * kb, 32 * nb, 32 * nb, nullptr, scr, lane); continue; } r -= I_WO;
            { const int nblk = D / 32, kb = r / nblk, nb = r % nblk; transpose_item(args.in[I_W_POOL_OUT], D, 1536, WCAT, 64 * kb, 32 * nb, 32 * nb, nullptr, scr, lane); }
        }
        {
            const int gt = bx * NTHR + tid, NT = G * NTHR;
            const float* wg = args.in[I_W_GRP];
            for (int e = gt; e < 512 * 32; e += NT) { const int n = e >> 5, kc = (e & 31) * 8, g = n >> 7, nn = n & 127; float v[8];
#pragma unroll
                for (int j = 0; j < 8; ++j) { const int kk = kc + j - (g & 1) * 128; v[j] = (kk >= 0 && kk < 128) ? wg[((size_t)g * 128 + kk) * 128 + nn] : 0.f; }
                v4u o; o.x = cvt_pk_bf16(v[0], v[1]); o.y = cvt_pk_bf16(v[2], v[3]); o.z = cvt_pk_bf16(v[4], v[5]); o.w = cvt_pk_bf16(v[6], v[7]);
                *(v4u*)(WGRP + (size_t)n * 256 + kc) = o; }
            const float* wa = args.in[I_W_RG_A]; const float* wx = args.in[I_W_RG_X];
            for (int e = gt; e < 2048 * 16; e += NT) { const int n = e >> 4, kc = (e & 15) * 8, h = n >> 8, j = n & 255; const float* src = j < 128 ? wa : wx; const int jj = j & 127; float v[8];
#pragma unroll
                for (int q = 0; q < 8; ++q) v[q] = src[((size_t)h * 128 + kc + q) * 128 + jj];
                v4u o; o.x = cvt_pk_bf16(v[0], v[1]); o.y = cvt_pk_bf16(v[2], v[3]); o.z = cvt_pk_bf16(v[4], v[5]); o.w = cvt_pk_bf16(v[6], v[7]);
                *(v4u*)(WGATE + (size_t)n * 128 + kc) = o; }
        }
        { const int gt = bx * NTHR + tid; if (gt < DRNN) { const float z = -args.in[I_LAMBDA][gt]; ((float*)(ws + WS_SP8))[gt] = -8.0f * (fmaxf(z, 0.f) + log1pf(expf(-fabsf(z)))); } }
        const float* gmix = args.in[I_NORM_MIX];
        f32x4 gv[4];
#pragma unroll
        for (int j = 0; j < 4; ++j) gv[j] = ((const f32x4*)gmix)[lane + 64 * j];
        for (int m = gw; m < M; m += 2 * NGW) {
            const int m1 = (m + NGW < M) ? m + NGW : m;
            const f32x4* xr0 = (const f32x4*)(x + (size_t)m * D) + lane; const f32x4* xr1 = (const f32x4*)(x + (size_t)m1 * D) + lane; f32x4 v0[4], v1[4]; float s0 = 0.f, s1 = 0.f;
#pragma unroll
            for (int j = 0; j < 4; ++j) { v0[j] = xr0[64 * j]; v1[j] = xr1[64 * j]; }
#pragma unroll
            for (int j = 0; j < 4; ++j) { s0 += (v0[j].x * v0[j].x + v0[j].y * v0[j].y) + (v0[j].z * v0[j].z + v0[j].w * v0[j].w); s1 += (v1[j].x * v1[j].x + v1[j].y * v1[j].y) + (v1[j].z * v1[j].z + v1[j].w * v1[j].w); }
            const float rs0 = 1.0f / sqrtf(wave_sum(s0) * (1.f / D) + EPS), rs1 = 1.0f / sqrtf(wave_sum(s1) * (1.f / D) + EPS);
            v2u* o0 = (v2u*)(XN + (size_t)m * D) + lane; v2u* o1 = (v2u*)(XN + (size_t)m1 * D) + lane;
#pragma unroll
            for (int j = 0; j < 4; ++j) { const f32x4 y0 = v0[j] * rs0 * gv[j], y1 = v1[j] * rs1 * gv[j]; v2u w0, w1; w0.x = cvt_pk_bf16(y0.x, y0.y); w0.y = cvt_pk_bf16(y0.z, y0.w); w1.x = cvt_pk_bf16(y1.x, y1.y); w1.y = cvt_pk_bf16(y1.z, y1.w); o0[64 * j] = w0; o1[64 * j] = w1; }
        }
        __syncthreads();
    }
    SEAM(0);
    TEND(0);

    TSTART(1);
    if (IN(1)) for (int rep = 0; rep < REPS(1); ++rep) { if (rep) GSYNC();
        pg8::Gemm g{XN, WIN, M, 4096, D, D, D, 0, 0}; pg8::StaticOrder S; S.init(M, 4096, G, bx);
        pg8::EpiProj E{UP, UR, UG, G0, G1, 0};
        pg8::gemm_phase<pg8::EpiProj, true>(lds, g, S, E);
    }
    SEAM(1);
    TEND(1);

    TSTART(2);
    if (IN(2)) for (int rep = 0; rep < REPS(2); ++rep) { if (rep) GSYNC();
        { const int gw = bx * NWAVES + wave, NGW = G * NWAVES;
          for (int wi = gw; wi < (M / 32) * 4; wi += NGW) { const int g = wi & 3, t0 = (wi >> 2) * 32 + (lane >> 4) * 8, co = g * 16 + (lane & 15);
              const bf16* src = UP + (size_t)t0 * DPOOL + co * 8; bf16* dst = POOLED + (size_t)t0 * DPOOL + co * 8; const int tl = t0 & (SEQ - 1);
              if (g == 0) pool_item<2>(src, dst, tl); else if (g == 1) pool_item<4>(src, dst, tl); else if (g == 2) pool_item<8>(src, dst, tl); else pool_item<16>(src, dst, tl); } }
        { const int gt = bx * NTHR + tid, NT = G * NTHR;
          for (int it = gt; it < (M / 8) * 128; it += NT) { const int co = it & 127, t0 = (it >> 7) * 8, tl = t0 & (SEQ - 1);
              const bf16* src = UR + (size_t)t0 * DRNN + co * 8; bf16* dst = V + (size_t)t0 * 1536 + co * 8;
              const float* cw = args.in[I_CONV_W] + co * 8; const float* cb = args.in[I_CONV_B] + co * 8;
              v4u rw[11];
#pragma unroll
              for (int k = 0; k < 11; ++k) rw[k] = (k >= 3 || tl != 0) ? *(const v4u*)(src + (ptrdiff_t)(k - 3) * DRNN) : (v4u){0u, 0u, 0u, 0u};
              f32x4 w0[2], w1[2], w2[2], w3[2], bb[2];
#pragma unroll
              for (int n = 0; n < 2; ++n) { w0[n] = *(const f32x4*)(cw + 4 * n); w1[n] = *(const f32x4*)(cw + 1024 + 4 * n); w2[n] = *(const f32x4*)(cw + 2048 + 4 * n); w3[n] = *(const f32x4*)(cw + 3072 + 4 * n); bb[n] = *(const f32x4*)(cb + 4 * n); }
#pragma unroll
              for (int i = 0; i < 8; ++i) { f32x4 a[2], b[2], c[2], d[2]; pg8::unpack8(rw[i], a[0], a[1]); pg8::unpack8(rw[i + 1], b[0], b[1]); pg8::unpack8(rw[i + 2], c[0], c[1]); pg8::unpack8(rw[i + 3], d[0], d[1]);
                  *(v4u*)(dst + (size_t)i * 1536) = pg8::pack8(bb[0] + w0[0] * a[0] + w1[0] * b[0] + w2[0] * c[0] + w3[0] * d[0], bb[1] + w0[1] * a[1] + w1[1] * b[1] + w2[1] * c[1] + w3[1] * d[1]); }
          } }
    }
    SEAM(2);
    TEND(2);

    TSTART(3);
    if (IN(3)) for (int rep = 0; rep < REPS(3); ++rep) { if (rep) GSYNC();
        const bool uneven = (G == 256);
        {
          pg8::Gemm g{XN, WIN + (size_t)4096 * D, M, 512, D, D, D, 0, 0}; pg8::StaticOrder S; S.init(M, 512, G, bx);
          pg8::EpiProj E{UP, UR, UG, G0, G1, 16};
          pg8::gemm_phase<pg8::EpiProj, true>(lds, g, S, E); }
        { pg8::Gemm g{POOLED, WGRP, M, 512, 256, 512, 256, 0, 256}; pg8::StaticOrder S; S.init(M, 512, G, (bx + G / 2) % G);
          pg8::EpiGrp E{CAT, 1536, args.in[I_POOL_SCALE]};
          pg8::gemm_phase<pg8::EpiGrp, true>(lds, g, S, E); }
        { pg8::Gemm g{V, WGATE, M, 2048, 128, 1536, 128, 0, 128}; pg8::StaticOrder S; S.init(M, 2048, G, bx);
          if (uneven) { if (bx < 128) { S.lin_base = bx; S.lin_cnt = 1; } else { S.lin_base = 128 + (bx - 128) * 3; S.lin_cnt = 3; } }
          pg8::EpiGate E{V, LA, BB, args.in[I_B_RG_A], args.in[I_B_RG_X], (const float*)(ws + WS_SP8)};
          pg8::gemm_phase<pg8::EpiGate, true>(lds, g, S, E); }
    }
    SEAM(3);
    TEND(3);

    TSTART(4);
    TEND(4);

    TSTART(5);
    if (IN(5)) for (int rep = 0; rep < REPS(5); ++rep) { if (rep) GSYNC();
        LAS float* PAS = (LAS float*)lds; LAS float* PAH = PAS + 8 * 512; LAS float* PBS = PAH + 8 * 512; LAS float* PBH = PBS + 8 * 512;
        unsigned* flags = (unsigned*)ws + 8192;
        for (int bi = bx; bi < NB * SCAN_NC * 2; bi += G) { const int hh = bi & 1, c = (bi >> 1) % SCAN_NC, b = bi / (2 * SCAN_NC);
            const size_t off = ((size_t)b * SEQ + (size_t)c * SCAN_T + wave * 16) * DRNN + hh * 512 + lane * 8;
            v4u lwk[16], bwk[16];
#pragma unroll
            for (int i = 0; i < 16; ++i) { lwk[i] = *(const v4u*)(LA + off + (size_t)i * DRNN); bwk[i] = *(const v4u*)(BB + off + (size_t)i * DRNN); }
            { f32x4 S[2] = {{0.f, 0.f, 0.f, 0.f}, {0.f, 0.f, 0.f, 0.f}}, H[2] = {{0.f, 0.f, 0.f, 0.f}, {0.f, 0.f, 0.f, 0.f}};
#pragma unroll
              for (int i = 0; i < 16; ++i) { f32x4 l[2], bq[2]; pg8::unpack8(lwk[i], l[0], l[1]); pg8::unpack8(bwk[i], bq[0], bq[1]);
#pragma unroll
                  for (int n = 0; n < 2; ++n)
#pragma unroll
                      for (int j = 0; j < 4; ++j) { H[n][j] = __expf(l[n][j]) * H[n][j] + bq[n][j]; S[n][j] += l[n][j]; } }
              *(LAS f32x4*)(PBS + wave * 512 + lane * 8) = S[0]; *(LAS f32x4*)(PBS + wave * 512 + lane * 8 + 4) = S[1];
              *(LAS f32x4*)(PBH + wave * 512 + lane * 8) = H[0]; *(LAS f32x4*)(PBH + wave * 512 + lane * 8 + 4) = H[1]; }
#pragma unroll
            for (int i = 0; i < 16; ++i) asm volatile("" : "+v"(lwk[i]), "+v"(bwk[i]));
            __syncthreads();
            { float h = 0.f, st = 0.f;
#pragma unroll
              for (int sb = 0; sb < 8; ++sb) { const float sv = PBS[sb * 512 + tid]; h = __expf(sv) * h + PBH[sb * 512 + tid]; st += sv; }
              const size_t co = ((size_t)b * SCAN_NC + c) * DRNN + hh * 512 + tid;
              __hip_atomic_store(CS + co, st, __ATOMIC_RELAXED, __HIP_MEMORY_SCOPE_AGENT); __hip_atomic_store(CH + co, h, __ATOMIC_RELAXED, __HIP_MEMORY_SCOPE_AGENT); }
            asm volatile("s_waitcnt vmcnt(0)" ::: "memory");
            __syncthreads();
            if (tid == 0) __hip_atomic_store(flags + ((b * 2 + hh) * SCAN_NC + c) * 16, 1u, __ATOMIC_RELAXED, __HIP_MEMORY_SCOPE_AGENT);
            { f32x4 S[2] = {{0.f, 0.f, 0.f, 0.f}, {0.f, 0.f, 0.f, 0.f}}, H[2] = {{0.f, 0.f, 0.f, 0.f}, {0.f, 0.f, 0.f, 0.f}};
              if (wave * 4 < c) {
                  for (int q = 0; q < 4; ++q) { const int cc = wave * 4 + q; if (cc < c) { unsigned* f = flags + ((b * 2 + hh) * SCAN_NC + cc) * 16; unsigned sp = 0;
                      while ((unsigned)__builtin_amdgcn_readfirstlane(__hip_atomic_load(f, __ATOMIC_RELAXED, __HIP_MEMORY_SCOPE_AGENT)) == 0u) { __builtin_amdgcn_s_sleep(1); if (++sp > (1u << 20)) break; } } }
                  __builtin_amdgcn_fence(__ATOMIC_ACQUIRE, "agent");
#pragma unroll
                  for (int q0 = 0; q0 < 4; q0 += 2) { f32x4 cs[2][2], ch[2][2];
#pragma unroll
                      for (int q = 0; q < 2; ++q) { const int cc = wave * 4 + q0 + q; const size_t co = ((size_t)b * SCAN_NC + (cc < c ? cc : 0)) * DRNN + hh * 512 + lane * 8;
                          cs[q][0] = *(const f32x4*)(CS + co); cs[q][1] = *(const f32x4*)(CS + co + 4); ch[q][0] = *(const f32x4*)(CH + co); ch[q][1] = *(const f32x4*)(CH + co + 4); }
#pragma unroll
                      for (int q = 0; q < 2; ++q) { if (wave * 4 + q0 + q < c) {
#pragma unroll
                          for (int n = 0; n < 2; ++n)
#pragma unroll
                              for (int j = 0; j < 4; ++j) { H[n][j] = __expf(cs[q][n][j]) * H[n][j] + ch[q][n][j]; S[n][j] += cs[q][n][j]; } } }
                      asm volatile("" ::: "memory"); }
              }
              *(LAS f32x4*)(PAS + wave * 512 + lane * 8) = S[0]; *(LAS f32x4*)(PAS + wave * 512 + lane * 8 + 4) = S[1];
              *(LAS f32x4*)(PAH + wave * 512 + lane * 8) = H[0]; *(LAS f32x4*)(PAH + wave * 512 + lane * 8 + 4) = H[1]; }
            __syncthreads();
            f32x4 h[2] = {{0.f, 0.f, 0.f, 0.f}, {0.f, 0.f, 0.f, 0.f}};
#pragma unroll
            for (int sb = 0; sb < 8; ++sb) {
#pragma unroll
                for (int n = 0; n < 2; ++n) { const f32x4 sv = *(const LAS f32x4*)(PAS + sb * 512 + lane * 8 + 4 * n), hv = *(const LAS f32x4*)(PAH + sb * 512 + lane * 8 + 4 * n);
#pragma unroll
                    for (int j = 0; j < 4; ++j) h[n][j] = __expf(sv[j]) * h[n][j] + hv[j]; } }
            for (int sb = 0; sb < wave; ++sb) {
#pragma unroll
                for (int n = 0; n < 2; ++n) { const f32x4 sv = *(const LAS f32x4*)(PBS + sb * 512 + lane * 8 + 4 * n), hv = *(const LAS f32x4*)(PBH + sb * 512 + lane * 8 + 4 * n);
#pragma unroll
                    for (int j = 0; j < 4; ++j) h[n][j] = __expf(sv[j]) * h[n][j] + hv[j]; } }
            const bf16* ugp = UG + off;
            bf16* hgp = CAT + ((size_t)b * SEQ + (size_t)c * SCAN_T + wave * 16) * 1536 + 512 + hh * 512 + lane * 8;
#pragma unroll
            for (int i0 = 0; i0 < 16; i0 += 8) { v4u gw8[8];
#pragma unroll
                for (int i = 0; i < 8; ++i) gw8[i] = *(const v4u*)(ugp + (size_t)(i0 + i) * DRNN);
#pragma unroll
                for (int i = 0; i < 8; ++i) { f32x4 l[2], bq[2], gq[2], o[2]; pg8::unpack8(lwk[i0 + i], l[0], l[1]); pg8::unpack8(bwk[i0 + i], bq[0], bq[1]); pg8::unpack8(gw8[i], gq[0], gq[1]);
#pragma unroll
                    for (int n = 0; n < 2; ++n)
#pragma unroll
                        for (int j = 0; j < 4; ++j) { h[n][j] = __expf(l[n][j]) * h[n][j] + bq[n][j]; o[n][j] = h[n][j] * pg8::gelu_tanh_(gq[n][j]); }
                    *(v4u*)(hgp + (size_t)(i0 + i) * 1536) = pg8::pack8(o[0], o[1]); } }
            __syncthreads();
        }
    }
    SEAM(5);
    TEND(5);

    TSTART(6);
    if (IN(6)) for (int rep = 0; rep < REPS(6); ++rep) { if (rep) GSYNC();
        pg8::Gemm g{CAT, WCAT, M, D, 1536, 1536, 1536, 0, 0}; pg8::StaticOrder S; S.init(M, D, G, bx);
        pg8::EpiMix E{G0, G1, MIXB};
        pg8::gemm_phase<pg8::EpiMix, true, 8>(lds, g, S, E);
    }
    SEAM(6);
    TEND(6);

    TSTART(7);
    if (IN(7)) for (int rep = 0; rep < REPS(7); ++rep) { if (rep) GSYNC();
        pg8::Gemm g{MIXB, WO, M, D, D, D, D, 0, 0}; pg8::StaticOrder S; S.init(M, D, G, bx);
        pg8::EpiRes1 E{x, X1B, SSQ};
        pg8::gemm_phase<pg8::EpiRes1, true>(lds, g, S, E);
    }
    SEAM(7);
    TEND(7);

    TSTART(8);
    if (IN(8)) for (int rep = 0; rep < REPS(8); ++rep) { if (rep) GSYNC();
        pg8::Gemm g{X1B, WFI, M, 2 * DFF, D, D, D, 0, 0}; pg8::StaticOrder S; S.init(M, 2 * DFF, G, bx);
        pg8::EpiSwiglu E{SSQ, ACT};
        pg8::gemm_phase<pg8::EpiSwiglu, true>(lds, g, S, E);
    }
    SEAM(8);
    TEND(8);

    TSTART(9);
    if (IN(9)) for (int rep = 0; rep < REPS(9); ++rep) { if (rep) GSYNC();
        pg8::Gemm g{ACT, WFO, M, D, DFF, DFF, DFF, 0, 0}; pg8::StaticOrder S; S.init(M, D, G, bx);
        if (G == 256) { pg8::EpiFinal E{X1B, X1, (float*)(ws + WS_SSQ2), (unsigned*)ws + 4096, args.in[I_NORM_FINAL]};
            pg8::gemm_phase<pg8::EpiFinal, true>(lds, g, S, E); }
        else { pg8::EpiRes2 E{X1B, X1};
            pg8::gemm_phase<pg8::EpiRes2, true>(lds, g, S, E); }
    }
    if (G != 256) SEAM(9);
    TEND(9);

    TSTART(10);
    if (IN(10) && G != 256) for (int rep = 0; rep < REPS(10); ++rep) { if (rep) GSYNC();
        const int gw = bx * NWAVES + wave, NGW = G * NWAVES;
        const float* gf = args.in[I_NORM_FINAL]; f32x4 gv[4];
#pragma unroll
        for (int j = 0; j < 4; ++j) gv[j] = ((const f32x4*)gf)[lane + 64 * j];
        for (int m = gw; m < M; m += NGW) {
            f32x4* xr = (f32x4*)(X1 + (size_t)m * D) + lane; f32x4 v[4]; float s = 0.f;
#pragma unroll
            for (int j = 0; j < 4; ++j) { v[j] = xr[64 * j]; s += (v[j].x * v[j].x + v[j].y * v[j].y) + (v[j].z * v[j].z + v[j].w * v[j].w); }
            const float rs = 1.0f / sqrtf(wave_sum(s) * (1.f / D) + EPS);
#pragma unroll
            for (int j = 0; j < 4; ++j) xr[64 * j] = v[j] * rs * gv[j];
        }
    }
    if (PROBE_PHASE == 10 || PROBE_PHASE == 99) tp1 = __builtin_amdgcn_s_memrealtime();
    if (PROBE_PHASE >= 0 && bx == 0 && tid == 0) { const unsigned long long dt = (tp1 - tp0) * PROBE_MULT, te = __builtin_amdgcn_s_memrealtime(); while (__builtin_amdgcn_s_memrealtime() - te < dt) __builtin_amdgcn_s_sleep(8); }
#undef IN
#undef SEAM
}

extern "C" void kernel_launch(void* const* d_in, const int* in_sizes, int n_in, void* d_out, int out_size, void* d_ws, size_t ws_size, hipStream_t stream) {
    static int grid = 0;
    if (grid == 0) {
        if (n_in != 19 || out_size != M * D || ws_size < WS_END) { fprintf(stderr, "kernel_launch: unexpected shapes (n_in %d out %d ws %zu)\n", n_in, out_size, ws_size); grid = -1; return; }
        int dev = 0, cus = 0, per_cu = 0;
        hipGetDevice(&dev);
        hipDeviceGetAttribute(&cus, hipDeviceAttributeMultiprocessorCount, dev);
        if (hipFuncSetAttribute((const void*)fwd_kernel, hipFuncAttributeMaxDynamicSharedMemorySize, LDS_BYTES) != hipSuccess) { fprintf(stderr, "kernel_launch: hipFuncSetAttribute failed\n"); grid = -1; return; }
        if (hipOccupancyMaxActiveBlocksPerMultiprocessor(&per_cu, (const void*)fwd_kernel, NTHR, LDS_BYTES) != hipSuccess || per_cu < 1) { fprintf(stderr, "kernel_launch: occupancy query says %d\n", per_cu); per_cu = 1; }
        (void)hipGetLastError();
        grid = cus * 1;
        fprintf(stderr, "kernel_launch: grid %d (cus %d, per_cu %d)\n", grid, cus, per_cu);
    }
    if (grid < 0) return;
    if (hipMemsetAsync(d_ws, 0, 49152, stream) != hipSuccess) { fprintf(stderr, "kernel_launch: memset failed\n"); return; }
    Args a{};
    for (int i = 0; i < 19; ++i) a.in[i] = (const float*)d_in[i];
    a.out = (float*)d_out; a.ws = (unsigned char*)d_ws;
#if MK_PER_PHASE
    for (int p = 0; p < NPH; ++p) { a.ph_lo = p; a.ph_hi = p + 1; hipLaunchKernelGGL(fwd_kernel, dim3(grid), dim3(NTHR), LDS_BYTES, stream, a); }
#else
    a.ph_lo = 0; a.ph_hi = NPH;
    void* kargs[] = {&a};
    hipError_t e = hipLaunchCooperativeKernel((const void*)fwd_kernel, dim3(grid), dim3(NTHR), kargs, LDS_BYTES, stream);
    if (e != hipSuccess) fprintf(stderr, "cooperative launch failed: %s (grid %d)\n", hipGetErrorString(e), grid);
#endif
}
```

```cpp
#include <hip/hip_runtime.h>
#include <hip/hip_cooperative_groups.h>
#include <cstdio>
#include <cstdint>
namespace cg = cooperative_groups;

#ifndef MK_PER_PHASE
#define MK_PER_PHASE 0
#endif

namespace pg8 {
#define PG8_LAS __attribute__((address_space(3)))
typedef unsigned short bf16_t;
typedef short bf16x8 __attribute__((ext_vector_type(8)));
typedef float f32x4 __attribute__((ext_vector_type(4)));
typedef float f32x2 __attribute__((ext_vector_type(2)));
typedef unsigned u32x4 __attribute__((ext_vector_type(4)));
typedef unsigned u32x2 __attribute__((ext_vector_type(2)));
constexpr int BM = 256, BK = 64, HALF = 128, HTB = HALF * BK * 2, STAGE_BYTES = 8 * HTB, NXCD = 8, WGM = 8;

__host__ __device__ __forceinline__ int lds_byte(int r, int c) { const int st = (r >> 4) * 2 + (c >> 5), rr = r & 15, cc = c & 31, ob = rr * 64 + cc * 2; return st * 1024 + (ob ^ (((ob >> 9) & 1) << 5)); }
__host__ __device__ __forceinline__ void stage_rc(int b, int& R, int& C) { const int st = b / 1024, sb = b % 1024, swz = sb ^ (((sb >> 9) & 1) << 5); R = (st >> 1) * 16 + swz / 64; C = (st & 1) * 32 + (swz % 64) / 2; }
__host__ __device__ __forceinline__ int perm32(int rho) { const int n = rho >> 4, i = rho & 15; return 8 * (i >> 2) + 4 * n + (i & 3); }

struct Unit { int pm, pn, rh, idx; };
struct Gemm { const bf16_t* A; const bf16_t* Bt; int M, N, K, lda, ldb, ash, amul; };

struct StaticOrder {
    int nM, nN, nwg, G, c, limit, lin_base, lin_cnt;
    __host__ __device__ void init(int M, int N, int G_, int c_) { nM = M / BM; nN = N / BM; nwg = nM * nN; G = G_; c = c_; limit = nwg; lin_base = 0; lin_cnt = -1; }
    __host__ __device__ void map(int L, Unit& u) const {
        int wgid = L; { const int q = nwg / NXCD, r = nwg % NXCD, xcd = wgid % NXCD, off = wgid / NXCD; wgid = (xcd < r ? xcd * (q + 1) : r * (q + 1) + (xcd - r) * q) + off; }
        const int nig = WGM * nN, gid = wgid / nig, fm = gid * WGM, gsz = (nM - fm) < WGM ? (nM - fm) : WGM;
        u.pm = fm + ((wgid % nig) % gsz); u.pn = (wgid % nig) / gsz; u.rh = 0;
    }
    __host__ __device__ bool next(int i, Unit& u) const {
        u.idx = i;
        if (lin_cnt >= 0) { if (i >= lin_cnt) return false; map(lin_base + i, u); return true; }
        const long L = (long)i * G + c; if (L >= limit) return false;
        map((int)L, u); return true;
    }
};

__device__ __forceinline__ unsigned cvt_pk_bf16(float lo, float hi) { unsigned r; asm volatile("v_cvt_pk_bf16_f32 %0, %1, %2" : "=v"(r) : "v"(lo), "v"(hi)); return r; }
__device__ __forceinline__ float bf_lo(unsigned w) { return __uint_as_float(w << 16); }
__device__ __forceinline__ float bf_hi(unsigned w) { return __uint_as_float(w & 0xffff0000u); }
__device__ __forceinline__ float sigmoidf_(float x) { return __builtin_amdgcn_rcpf(1.0f + __expf(-x)); }
__device__ __forceinline__ float gelu_tanh_(float x) { const float z = 1.5957691216057308f * (x + 0.044715f * x * x * x); return x * sigmoidf_(z); }
__device__ __forceinline__ u32x4 pack8(const f32x4 a, const f32x4 b) { u32x4 w; w.x = cvt_pk_bf16(a[0], a[1]); w.y = cvt_pk_bf16(a[2], a[3]); w.z = cvt_pk_bf16(b[0], b[1]); w.w = cvt_pk_bf16(b[2], b[3]); return w; }
__device__ __forceinline__ void unpack8(const u32x4 w, f32x4& a, f32x4& b) { a = (f32x4){bf_lo(w.x), bf_hi(w.x), bf_lo(w.y), bf_hi(w.y)}; b = (f32x4){bf_lo(w.z), bf_hi(w.z), bf_lo(w.w), bf_hi(w.w)}; }

#define EPI_ROWS_BEGIN _Pragma("unroll") for (int ai = 0; ai < NAI; ++ai) _Pragma("unroll") for (int m = 0; m < 4; ++m) { const int row = u.pm * BM + u.rh + ai * HALF + wr * 64 + m * 16 + fr;
#define EPI_ROWS_END }

struct EpiProj {
    bf16_t *UP, *UR, *UG, *RB, *G1; int pn_off;
    template <int NAI> __device__ __forceinline__ void run(const f32x4 (&acc)[2][2][4][2], const Unit& u, int wr, int wc, int fr, int fq) const {
        const int pn = u.pn + pn_off;
        if (pn < 10) {
            bf16_t* base; int ldc, colt;
            if (pn < 2) { base = UP; ldc = 512; colt = pn * 256; }
            else if (pn < 6) { base = UR; ldc = 1024; colt = (pn - 2) * 256; }
            else { base = UG; ldc = 1024; colt = (pn - 6) * 256; }
            const int col0 = colt + wc * 32 + 8 * fq;
            EPI_ROWS_BEGIN
                bf16_t* rowp = base + (unsigned)((unsigned)row * (unsigned)ldc + (unsigned)col0);
#pragma unroll
                for (int bj = 0; bj < 2; ++bj) *(u32x4*)(rowp + bj * HALF) = pack8(acc[ai][bj][m][0], acc[ai][bj][m][1]);
            EPI_ROWS_END
        } else {
            const int ch0 = (pn - 10) * 128 + wc * 32 + 8 * fq;
            EPI_ROWS_BEGIN
                const unsigned off = (unsigned)row * 1024u + (unsigned)ch0; f32x4 rr[2], gg[2];
#pragma unroll
                for (int n = 0; n < 2; ++n)
#pragma unroll
                    for (int j = 0; j < 4; ++j) { const float d0 = 1.0f + fminf(__expf(-acc[ai][0][m][n][j]), 1e18f), d1 = 1.0f + fminf(__expf(-acc[ai][1][m][n][j]), 1e18f);
                        gg[n][j] = __builtin_amdgcn_rcpf(d1); rr[n][j] = d1 * __builtin_amdgcn_rcpf(d0); }
                *(u32x4*)(RB + off) = pack8(rr[0], rr[1]); *(u32x4*)(G1 + off) = pack8(gg[0], gg[1]);
            EPI_ROWS_END
        }
    }
};
struct EpiGrp {
    bf16_t* O; int ldc; const float* scale;
    template <int NAI> __device__ __forceinline__ void run(const f32x4 (&acc)[2][2][4][2], const Unit& u, int wr, int wc, int fr, int fq) const {
        const int col0 = u.pn * BM + wc * 32 + 8 * fq;
        f32x4 sc[2][2];
#pragma unroll
        for (int bj = 0; bj < 2; ++bj)
#pragma unroll
            for (int n = 0; n < 2; ++n) sc[bj][n] = *(const f32x4*)(scale + col0 + bj * HALF + 4 * n);
        EPI_ROWS_BEGIN
            bf16_t* rowp = O + (unsigned)((unsigned)row * (unsigned)ldc + (unsigned)col0);
#pragma unroll
            for (int bj = 0; bj < 2; ++bj) *(u32x4*)(rowp + bj * HALF) = pack8(acc[ai][bj][m][0] * sc[bj][0], acc[ai][bj][m][1] * sc[bj][1]);
        EPI_ROWS_END
    }
};
struct EpiGate {
    const bf16_t* V; bf16_t *LA, *BB; const float *b_a, *b_x, *sp8;
    template <int NAI> __device__ __forceinline__ void run(const f32x4 (&acc)[2][2][4][2], const Unit& u, int wr, int wc, int fr, int fq) const {
        const int ch0 = u.pn * 128 + wc * 32 + 8 * fq;
        f32x4 ba[2], bx[2], sp[2];
#pragma unroll
        for (int n = 0; n < 2; ++n) { ba[n] = *(const f32x4*)(b_a + ch0 + 4 * n); bx[n] = *(const f32x4*)(b_x + ch0 + 4 * n); sp[n] = *(const f32x4*)(sp8 + ch0 + 4 * n); }
        EPI_ROWS_BEGIN
            const unsigned off = (unsigned)row * 1024u + (unsigned)ch0;
            const u32x4 vw = *(const u32x4*)(V + ((unsigned)row * 1536u + (unsigned)ch0)); f32x4 vv[2]; unpack8(vw, vv[0], vv[1]);
            f32x4 la[2], bb[2];
#pragma unroll
            for (int n = 0; n < 2; ++n)
#pragma unroll
                for (int j = 0; j < 4; ++j) {
                    const float r = sigmoidf_(acc[ai][0][m][n][j] + ba[n][j]), ig = sigmoidf_(acc[ai][1][m][n][j] + bx[n][j]);
                    const float l = sp[n][j] * r, x2 = 2.0f * l;
                    const float em1 = (x2 > -0.125f) ? x2 * (1.0f + 0.5f * x2 * (1.0f + 0.33333334f * x2 * (1.0f + 0.25f * x2 * (1.0f + 0.2f * x2)))) : (__expf(x2) - 1.0f);
                    la[n][j] = l; bb[n][j] = __builtin_amdgcn_sqrtf(fmaxf(-em1, 0.f)) * ig * vv[n][j]; }
            *(u32x4*)(LA + off) = pack8(la[0], la[1]); *(u32x4*)(BB + off) = pack8(bb[0], bb[1]);
            asm volatile("" ::: "memory");
        EPI_ROWS_END
    }
};
struct EpiMix {
    const bf16_t *RB, *G1; bf16_t* MIXB;
    __device__ __forceinline__ void mid(f32x4 (&acc)[2][2][4][2], const Unit& u0, int wr, int wc, int fr, int fq) const {
        constexpr int NAI = 2; Unit u = u0; asm volatile("" : "+s"(u.pm), "+s"(u.pn));
        const int col0 = u.pn * BM + wc * 32 + 8 * fq;
        EPI_ROWS_BEGIN
            const unsigned off = (unsigned)row * 1024u + (unsigned)col0;
#pragma unroll
            for (int bj = 0; bj < 2; ++bj) { f32x4 r[2]; unpack8(*(const u32x4*)(RB + off + bj * HALF), r[0], r[1]); acc[ai][bj][m][0] *= r[0]; acc[ai][bj][m][1] *= r[1]; }
        EPI_ROWS_END
    }
    template <int NAI> __device__ __forceinline__ void run(const f32x4 (&acc)[2][2][4][2], const Unit& u, int wr, int wc, int fr, int fq) const {
        const int col0 = u.pn * BM + wc * 32 + 8 * fq;
        EPI_ROWS_BEGIN
            const unsigned off = (unsigned)row * 1024u + (unsigned)col0;
#pragma unroll
            for (int bj = 0; bj < 2; ++bj) { f32x4 g[2]; unpack8(*(const u32x4*)(G1 + off + bj * HALF), g[0], g[1]);
                *(u32x4*)(MIXB + off + bj * HALF) = pack8(g[0] * acc[ai][bj][m][0], g[1] * acc[ai][bj][m][1]); }
        EPI_ROWS_END
    }
};
struct EpiRes1 {
    const float* X; bf16_t* X1B; float* SSQ;
    template <int NAI> __device__ __forceinline__ void run(const f32x4 (&acc)[2][2][4][2], const Unit& u, int wr, int wc, int fr, int fq) const {
        const int col0 = u.pn * BM + wc * 32 + 8 * fq;
        EPI_ROWS_BEGIN
            const unsigned off = (unsigned)row * 1024u + (unsigned)col0; float ss = 0.f;
#pragma unroll
            for (int bj = 0; bj < 2; ++bj) {
                const f32x4 a = *(const f32x4*)(X + off + bj * HALF) + acc[ai][bj][m][0], b = *(const f32x4*)(X + off + bj * HALF + 4) + acc[ai][bj][m][1];
                *(u32x4*)(X1B + off + bj * HALF) = pack8(a, b);
                ss += (a[0] * a[0] + a[1] * a[1]) + (a[2] * a[2] + a[3] * a[3]) + (b[0] * b[0] + b[1] * b[1]) + (b[2] * b[2] + b[3] * b[3]); }
            ss += __shfl_xor(ss, 16); ss += __shfl_xor(ss, 32);
            if (fq == 0) SSQ[(unsigned)row * 16u + (unsigned)(u.pn * 4 + wc)] = ss;
        EPI_ROWS_END
    }
};
struct EpiSwiglu {
    const PG8_LAS float* RSL; bf16_t* ACT;
    template <int NAI> __device__ __forceinline__ void run(const f32x4 (&acc)[2][2][4][2], const Unit& u, int wr, int wc, int fr, int fq) const {
        const int col0 = u.pn * 128 + wc * 32 + 8 * fq;
        const PG8_LAS float* rt = RSL + u.idx * 256 + wr * 64 + fr;
        EPI_ROWS_BEGIN
            const float rs = rt[ai * HALF + m * 16];
            f32x4 o[2];
#pragma unroll
            for (int n = 0; n < 2; ++n)
#pragma unroll
                for (int j = 0; j < 4; ++j) { const float g = acc[ai][0][m][n][j] * rs, up = acc[ai][1][m][n][j] * rs; o[n][j] = g * sigmoidf_(g) * up; }
            *(u32x4*)(ACT + (unsigned)((unsigned)row * 2816u + (unsigned)col0)) = pack8(o[0], o[1]);
        EPI_ROWS_END
    }
};
struct EpiRes2 {
    const bf16_t* X1B; float* OUT;
    template <int NAI> __device__ __forceinline__ void run(const f32x4 (&acc)[2][2][4][2], const Unit& u, int wr, int wc, int fr, int fq) const {
        const int col0 = u.pn * BM + wc * 32 + 8 * fq;
        EPI_ROWS_BEGIN
            const unsigned off = (unsigned)row * 1024u + (unsigned)col0;
#pragma unroll
            for (int bj = 0; bj < 2; ++bj) { f32x4 xa, xb; unpack8(*(const u32x4*)(X1B + off + bj * HALF), xa, xb);
                *(f32x4*)(OUT + off + bj * HALF) = xa + acc[ai][bj][m][0]; *(f32x4*)(OUT + off + bj * HALF + 4) = xb + acc[ai][bj][m][1]; }
        EPI_ROWS_END
    }
};

struct EpiFinal {
    const bf16_t* X1B; float* OUT; float* SSQ2; unsigned* cnt; const float* gfin;
    template <int NAI> __device__ __forceinline__ void run(f32x4 (&acc)[2][2][4][2], const Unit& u, int wr, int wc, int fr, int fq) const {
        const int col0 = u.pn * BM + wc * 32 + 8 * fq;
        EPI_ROWS_BEGIN
            const unsigned off = (unsigned)row * 1024u + (unsigned)col0; float ss = 0.f;
#pragma unroll
            for (int bj = 0; bj < 2; ++bj) { f32x4 xa, xb; unpack8(*(const u32x4*)(X1B + off + bj * HALF), xa, xb);
                const f32x4 a = xa + acc[ai][bj][m][0], b = xb + acc[ai][bj][m][1]; acc[ai][bj][m][0] = a; acc[ai][bj][m][1] = b;
                ss += (a[0] * a[0] + a[1] * a[1]) + (a[2] * a[2] + a[3] * a[3]) + (b[0] * b[0] + b[1] * b[1]) + (b[2] * b[2] + b[3] * b[3]); }
            ss += __shfl_xor(ss, 16); ss += __shfl_xor(ss, 32);
            if (fq == 0) __hip_atomic_store(SSQ2 + (unsigned)row * 16u + (unsigned)(u.pn * 4 + wc), ss, __ATOMIC_RELAXED, __HIP_MEMORY_SCOPE_AGENT);
        EPI_ROWS_END
        asm volatile("s_waitcnt vmcnt(0)" ::: "memory");
        unsigned* c = cnt + 64 * u.pm;
        if ((threadIdx.x & 63) == 0) __hip_atomic_fetch_add(c, 1u, __ATOMIC_RELAXED, __HIP_MEMORY_SCOPE_AGENT);
        { unsigned sp = 0;
          while ((unsigned)__builtin_amdgcn_readfirstlane(__hip_atomic_load(c, __ATOMIC_RELAXED, __HIP_MEMORY_SCOPE_AGENT)) < 32u) { __builtin_amdgcn_s_sleep(2); if (++sp > (1u << 20)) break; } }
        __builtin_amdgcn_fence(__ATOMIC_ACQUIRE, "agent");
        f32x4 gv[2][2];
#pragma unroll
        for (int bj = 0; bj < 2; ++bj)
#pragma unroll
            for (int n = 0; n < 2; ++n) gv[bj][n] = *(const f32x4*)(gfin + col0 + bj * HALF + 4 * n);
        EPI_ROWS_BEGIN
            const unsigned off = (unsigned)row * 1024u + (unsigned)col0;
            const unsigned long long* sl = (const unsigned long long*)(SSQ2 + (unsigned)row * 16u + (unsigned)(4 * fq));
            const unsigned long long w0 = __hip_atomic_load(sl, __ATOMIC_RELAXED, __HIP_MEMORY_SCOPE_AGENT), w1 = __hip_atomic_load(sl + 1, __ATOMIC_RELAXED, __HIP_MEMORY_SCOPE_AGENT);
            float sq = (__uint_as_float((unsigned)w0) + __uint_as_float((unsigned)(w0 >> 32))) + (__uint_as_float((unsigned)w1) + __uint_as_float((unsigned)(w1 >> 32)));
            sq += __shfl_xor(sq, 16); sq += __shfl_xor(sq, 32);
            const float rs = 1.0f / sqrtf(sq * (1.0f / 1024.0f) + 1e-6f);
#pragma unroll
            for (int bj = 0; bj < 2; ++bj) { *(f32x4*)(OUT + off + bj * HALF) = acc[ai][bj][m][0] * rs * gv[bj][0]; *(f32x4*)(OUT + off + bj * HALF + 4) = acc[ai][bj][m][1] * rs * gv[bj][1]; }
        EPI_ROWS_END
    }
};

template <class Epi, bool ALIGN_EPI, int MID_T = -1>
__device__ __forceinline__ void gemm_phase(PG8_LAS unsigned char* lds, const Gemm g, const StaticOrder& S, const Epi& E) {
    const int tid = threadIdx.x, wid = __builtin_amdgcn_readfirstlane(tid >> 6), lane = tid & 63, wr = wid >> 2, wc = wid & 3, fr = lane & 15, fq = lane >> 4;
    int nt = g.K / BK; asm volatile("" : "+s"(nt));
    unsigned voffA[2], voffB[2];
#pragma unroll
    for (int i = 0; i < 2; ++i) { int R, C; stage_rc(tid * 16 + i * 8192, R, C); const int Rb = (R & ~31) + perm32(R & 31);
        voffA[i] = (unsigned)(R * g.lda + C) * 2u; voffB[i] = (unsigned)(Rb * g.ldb + C) * 2u; }
    const size_t kstep = (size_t)(BK * 2);
    const size_t hstepA = (size_t)HALF * g.lda * 2, hstepB = (size_t)HALF * g.ldb * 2;
    const size_t tstepA = 2 * hstepA, tstepB = 2 * hstepB;
    const unsigned ldsw = (unsigned)wid * 1024u;
    const int aoff = lds_byte(wr * 64 + fr, fq * 8), boff = lds_byte(wc * 32 + fr, fq * 8);
#define PG8_SA(b, h) (((b) * 2 + (h)) * HTB)
#define PG8_SB(b, h) ((4 + (b) * 2 + (h)) * HTB)
#define PG8_STAGE(bufoff, gbase, voff) do { _Pragma("unroll") for (int _i = 0; _i < 2; ++_i) \
        __builtin_amdgcn_global_load_lds((const unsigned*)((const char*)(gbase) + (voff)[_i]), (PG8_LAS unsigned*)(lds + (bufoff) + ldsw + _i * 8192), 16, 0, 0); } while (0)
#define PG8_LDA(dst, b, h) do { _Pragma("unroll") for (int m = 0; m < 4; ++m) _Pragma("unroll") for (int k = 0; k < 2; ++k) dst[m][k] = *(const PG8_LAS bf16x8*)(lds + PG8_SA(b, h) + aoff + m * 2048 + k * 1024); } while (0)
#define PG8_LDB(dst, b, h) do { _Pragma("unroll") for (int n = 0; n < 2; ++n) _Pragma("unroll") for (int k = 0; k < 2; ++k) dst[n][k] = *(const PG8_LAS bf16x8*)(lds + PG8_SB(b, h) + boff + n * 2048 + k * 1024); } while (0)
#define PG8_MMA(ai, bj, At, Bt) do { __builtin_amdgcn_s_setprio(1); _Pragma("unroll") for (int m = 0; m < 4; ++m) _Pragma("unroll") for (int n = 0; n < 2; ++n) _Pragma("unroll") for (int k = 0; k < 2; ++k) \
        acc[ai][bj][m][n] = __builtin_amdgcn_mfma_f32_16x16x32_bf16(Bt[n][k], At[m][k], acc[ai][bj][m][n], 0, 0, 0); __builtin_amdgcn_s_setprio(0); } while (0)
#define PG8_WAIT_V(n) asm volatile("s_waitcnt vmcnt(" #n ")" ::: "memory")
#define PG8_WAIT_L(n) asm volatile("s_waitcnt lgkmcnt(" #n ")" ::: "memory")
#define PG8_BAR __builtin_amdgcn_s_barrier()
#define PG8_SCHED __builtin_amdgcn_sched_barrier(0)
    Unit cur, nxt; int ui = 0;
    if (!S.next(0, cur)) return;
    f32x4 acc[2][2][4][2];
#pragma unroll
    for (int a = 0; a < 2; ++a)
#pragma unroll
        for (int b = 0; b < 2; ++b)
#pragma unroll
            for (int m = 0; m < 4; ++m)
#pragma unroll
                for (int n = 0; n < 2; ++n) acc[a][b][m][n] = (f32x4){0.f, 0.f, 0.f, 0.f};
    bf16x8 At[4][2], B0[2][2], B1[2][2];
    const char* cA = (const char*)g.A + (size_t)cur.pm * tstepA + (size_t)((cur.pn >> g.ash) * g.amul) * 2; const char* cB = (const char*)g.Bt + (size_t)cur.pn * tstepB;
    PG8_STAGE(PG8_SB(0, 0), cB, voffB); PG8_STAGE(PG8_SB(0, 1), cB + hstepB, voffB); PG8_STAGE(PG8_SA(0, 0), cA, voffA); PG8_STAGE(PG8_SA(0, 1), cA + hstepA, voffA);
    if (wr == 1) PG8_BAR;
    PG8_WAIT_V(2); PG8_BAR;
    PG8_STAGE(PG8_SB(1, 0), cB + kstep, voffB); PG8_STAGE(PG8_SA(1, 0), cA + kstep, voffA); PG8_STAGE(PG8_SB(1, 1), cB + hstepB + kstep, voffB);
    PG8_WAIT_V(6); PG8_BAR;
    for (;;) {
        const bool has_next = S.next(ui + 1, nxt);
        const char* nA = has_next ? (const char*)g.A + (size_t)nxt.pm * tstepA + (size_t)((nxt.pn >> g.ash) * g.amul) * 2 : cA; const char* nB = has_next ? (const char*)g.Bt + (size_t)nxt.pn * tstepB : cB;
        for (int t = 0; t < nt; t += 2) {
            const bool last = (t == nt - 2);
            if constexpr (MID_T >= 0) { if (t == MID_T) E.mid(acc, cur, wr, wc, fr, fq); }
            const char* a1 = cA + (size_t)(t + 1) * kstep;
            const char* a2 = last ? nA : cA + (size_t)(t + 2) * kstep; const char* b2 = last ? nB : cB + (size_t)(t + 2) * kstep;
            const char* a3 = a2 + kstep; const char* b3 = b2 + kstep;
            PG8_LDB(B0, 0, 0); PG8_LDB(B1, 0, 1); PG8_SCHED; PG8_LDA(At, 0, 0); PG8_STAGE(PG8_SA(1, 1), a1 + hstepA, voffA);
            PG8_WAIT_V(8); PG8_WAIT_L(0); PG8_BAR; PG8_MMA(0, 0, At, B0); PG8_MMA(0, 1, At, B1); PG8_BAR; PG8_SCHED;
            PG8_LDA(At, 0, 1); PG8_STAGE(PG8_SB(0, 0), b2, voffB); PG8_STAGE(PG8_SB(0, 1), b2 + hstepB, voffB); PG8_STAGE(PG8_SA(0, 0), a2, voffA);
            PG8_WAIT_V(8); PG8_WAIT_L(0); PG8_BAR; PG8_MMA(1, 0, At, B0); PG8_MMA(1, 1, At, B1); PG8_BAR; PG8_SCHED;
            PG8_LDB(B0, 1, 0); PG8_LDB(B1, 1, 1); PG8_SCHED; PG8_LDA(At, 1, 0); PG8_STAGE(PG8_SA(0, 1), a2 + hstepA, voffA);
            PG8_WAIT_V(8); PG8_WAIT_L(0); PG8_BAR; PG8_MMA(0, 0, At, B0); PG8_MMA(0, 1, At, B1); PG8_BAR; PG8_SCHED;
            PG8_LDA(At, 1, 1); PG8_STAGE(PG8_SB(1, 0), b3, voffB); PG8_STAGE(PG8_SB(1, 1), b3 + hstepB, voffB); PG8_STAGE(PG8_SA(1, 0), a3, voffA);
            PG8_WAIT_V(8); PG8_WAIT_L(0); PG8_BAR; PG8_MMA(1, 0, At, B0); PG8_MMA(1, 1, At, B1); PG8_BAR; PG8_SCHED;
        }
        if constexpr (ALIGN_EPI) { if (wr == 0) PG8_BAR; }
        E.template run<2>(acc, cur, wr, wc, fr, fq);
        if (!has_next) break;
#pragma unroll
        for (int a = 0; a < 2; ++a)
#pragma unroll
            for (int b = 0; b < 2; ++b)
#pragma unroll
                for (int m = 0; m < 4; ++m)
#pragma unroll
                    for (int n = 0; n < 2; ++n) acc[a][b][m][n] = (f32x4){0.f, 0.f, 0.f, 0.f};
        cur = nxt; cA = nA; cB = nB; ++ui;
        if constexpr (ALIGN_EPI) { if (wr == 1) PG8_BAR; }
    }
    PG8_WAIT_V(0);
    if constexpr (!ALIGN_EPI) { if (wr == 0) PG8_BAR; }
    PG8_BAR;
#undef PG8_SA
#undef PG8_SB
#undef PG8_STAGE
#undef PG8_LDA
#undef PG8_LDB
#undef PG8_MMA
#undef PG8_WAIT_V
#undef PG8_WAIT_L
#undef PG8_BAR
#undef PG8_SCHED
}

template <class Epi>
__device__ __forceinline__ void gemm_half(PG8_LAS unsigned char* lds, const Gemm g, const Unit u, const Epi& E) {
    const int tid = threadIdx.x, wid = __builtin_amdgcn_readfirstlane(tid >> 6), lane = tid & 63, wr = wid >> 2, wc = wid & 3, fr = lane & 15, fq = lane >> 4;
    int nt = g.K / BK; asm volatile("" : "+s"(nt));
    unsigned voffA[2], voffB[2];
#pragma unroll
    for (int i = 0; i < 2; ++i) { int R, C; stage_rc(tid * 16 + i * 8192, R, C); const int Rb = (R & ~31) + perm32(R & 31);
        voffA[i] = (unsigned)(R * g.lda + C) * 2u; voffB[i] = (unsigned)(Rb * g.ldb + C) * 2u; }
    const size_t kstep = (size_t)(BK * 2);
    const size_t hstepA = (size_t)HALF * g.lda * 2, hstepB = (size_t)HALF * g.ldb * 2;
    const unsigned ldsw = (unsigned)wid * 1024u;
    const int aoff = lds_byte(wr * 64 + fr, fq * 8), boff = lds_byte(wc * 32 + fr, fq * 8);
#define PG8_SA(b, h) (((b) * 2 + (h)) * HTB)
#define PG8_SB(b, h) ((4 + (b) * 2 + (h)) * HTB)
#define PG8_STAGE(bufoff, gbase, voff) do { _Pragma("unroll") for (int _i = 0; _i < 2; ++_i) \
        __builtin_amdgcn_global_load_lds((const unsigned*)((const char*)(gbase) + (voff)[_i]), (PG8_LAS unsigned*)(lds + (bufoff) + ldsw + _i * 8192), 16, 0, 0); } while (0)
#define PG8_LDA(dst, b, h) do { _Pragma("unroll") for (int m = 0; m < 4; ++m) _Pragma("unroll") for (int k = 0; k < 2; ++k) dst[m][k] = *(const PG8_LAS bf16x8*)(lds + PG8_SA(b, h) + aoff + m * 2048 + k * 1024); } while (0)
#define PG8_LDB(dst, b, h) do { _Pragma("unroll") for (int n = 0; n < 2; ++n) _Pragma("unroll") for (int k = 0; k < 2; ++k) dst[n][k] = *(const PG8_LAS bf16x8*)(lds + PG8_SB(b, h) + boff + n * 2048 + k * 1024); } while (0)
#define PG8_MMA(ai, bj, At, Bt) do { __builtin_amdgcn_s_setprio(1); _Pragma("unroll") for (int m = 0; m < 4; ++m) _Pragma("unroll") for (int n = 0; n < 2; ++n) _Pragma("unroll") for (int k = 0; k < 2; ++k) \
        acc[ai][bj][m][n] = __builtin_amdgcn_mfma_f32_16x16x32_bf16(Bt[n][k], At[m][k], acc[ai][bj][m][n], 0, 0, 0); __builtin_amdgcn_s_setprio(0); } while (0)
#define PG8_WAIT_V(n) asm volatile("s_waitcnt vmcnt(" #n ")" ::: "memory")
#define PG8_WAIT_L(n) asm volatile("s_waitcnt lgkmcnt(" #n ")" ::: "memory")
#define PG8_BAR __builtin_amdgcn_s_barrier()
#define PG8_SCHED __builtin_amdgcn_sched_barrier(0)
    f32x4 acc[2][2][4][2];
#pragma unroll
    for (int a = 0; a < 2; ++a)
#pragma unroll
        for (int b = 0; b < 2; ++b)
#pragma unroll
            for (int m = 0; m < 4; ++m)
#pragma unroll
                for (int n = 0; n < 2; ++n) acc[a][b][m][n] = (f32x4){0.f, 0.f, 0.f, 0.f};
    bf16x8 At[4][2], B0[2][2], B1[2][2];
    const char* cA = (const char*)g.A + ((size_t)u.pm * BM + u.rh) * g.lda * 2 + (size_t)((u.pn >> g.ash) * g.amul) * 2; const char* cB = (const char*)g.Bt + (size_t)u.pn * 2 * hstepB;
    PG8_STAGE(PG8_SB(0, 0), cB, voffB); PG8_STAGE(PG8_SB(0, 1), cB + hstepB, voffB); PG8_STAGE(PG8_SA(0, 0), cA, voffA);
    PG8_STAGE(PG8_SB(1, 0), cB + kstep, voffB); PG8_STAGE(PG8_SB(1, 1), cB + hstepB + kstep, voffB); PG8_STAGE(PG8_SA(1, 0), cA + kstep, voffA);
    PG8_WAIT_V(6); PG8_BAR;
#define PG8_HALF_STEP(b, tt) do { \
        PG8_LDB(B0, b, 0); PG8_LDB(B1, b, 1); PG8_LDA(At, b, 0); PG8_WAIT_L(0); PG8_BAR; PG8_SCHED; \
        const bool more_ = (tt) + 2 < nt; \
        if (more_) { const char* b2 = cB + (size_t)((tt) + 2) * kstep; const char* a2 = cA + (size_t)((tt) + 2) * kstep; \
            PG8_STAGE(PG8_SB(b, 0), b2, voffB); PG8_STAGE(PG8_SB(b, 1), b2 + hstepB, voffB); PG8_STAGE(PG8_SA(b, 0), a2, voffA); } \
        PG8_MMA(0, 0, At, B0); PG8_MMA(0, 1, At, B1); \
        if (more_) PG8_WAIT_V(6); else PG8_WAIT_V(0); \
        PG8_BAR; PG8_SCHED; } while (0)
    for (int t = 0; t < nt; t += 2) { PG8_HALF_STEP(0, t); PG8_HALF_STEP(1, t + 1); }
    E.template run<1>(acc, u, wr, wc, fr, fq);
    PG8_BAR;
#undef PG8_HALF_STEP
#undef PG8_SA
#undef PG8_SB
#undef PG8_STAGE
#undef PG8_LDA
#undef PG8_LDB
#undef PG8_MMA
#undef PG8_WAIT_V
#undef PG8_WAIT_L
#undef PG8_BAR
#undef PG8_SCHED
}
}

constexpr int NWAVES = 8, NTHR = 512;
constexpr int M = 16384, SEQ = 4096, NB = 4, D = 1024, DPOOL = 512, DRNN = 1024, DIN = 4608, DFF = 2816;
constexpr float EPS = 1e-6f;
constexpr int NPH = 11;
constexpr int SCAN_T = 128, SCAN_NC = SEQ / SCAN_T;

constexpr size_t MiB = 1u << 20;
constexpr size_t WS_SP8 = 512 * 1024;
constexpr size_t WS_SSQ = 1 * MiB;
constexpr size_t WS_SSQ2 = 2 * MiB;
constexpr size_t WS_CS = 2 * MiB, WS_CH = 3 * MiB;
constexpr size_t WS_WIN = 4 * MiB;
constexpr size_t WS_WFI = 13 * MiB;
constexpr size_t WS_WFO = 24 * MiB;
constexpr size_t WS_WCAT = WS_WFO + 5632 * 1024;
constexpr size_t WS_WO = WS_WCAT + 3 * MiB;
constexpr size_t WS_WGRP = WS_WO + 2 * MiB;
constexpr size_t WS_WGATE = WS_WGRP + MiB / 4;
constexpr size_t WS_R1 = 36 * MiB;
constexpr size_t WS_R2 = 68 * MiB;
constexpr size_t WS_R3 = 84 * MiB;
constexpr size_t WS_R4 = 116 * MiB;
constexpr size_t WS_R7 = 148 * MiB;
constexpr size_t WS_R8 = 164 * MiB;
constexpr size_t WS_CAT = 196 * MiB;
constexpr size_t WS_MIXB = 148 * MiB;
constexpr size_t WS_ACT = 68 * MiB;
constexpr size_t WS_END = 244 * MiB;

constexpr int LDS_BYTES = 147456;

#define LAS __attribute__((address_space(3)))
typedef unsigned short bf16;
typedef unsigned v4u __attribute__((ext_vector_type(4)));
typedef unsigned v2u __attribute__((ext_vector_type(2)));
typedef float f32x4 __attribute__((ext_vector_type(4)));
typedef float f32x2 __attribute__((ext_vector_type(2)));
#define LDS_WAIT() asm volatile("s_waitcnt lgkmcnt(0)" ::: "memory")
using pg8::cvt_pk_bf16; using pg8::bf_lo; using pg8::bf_hi;

struct Args { const float* in[19]; float* out; unsigned char* ws; int ph_lo, ph_hi; };
enum { I_X = 0, I_NORM_MIX, I_W_IN, I_W_GRP, I_POOL_SCALE, I_W_POOL_OUT, I_CONV_W, I_CONV_B, I_W_RG_A, I_B_RG_A, I_W_RG_X, I_B_RG_X, I_LAMBDA, I_W_RNN_OUT, I_W_O, I_NORM_FFN, I_W_FFN_IN, I_W_FFN_OUT, I_NORM_FINAL };

__device__ __forceinline__ float wave_sum(float v) {
#pragma unroll
    for (int o = 1; o < 64; o <<= 1) v += __shfl_xor(v, o);
    return v;
}

__device__ __forceinline__ void transpose_item(const float* W, int Nsrc, int Kdst, bf16* WT, int k0, int n_src0, int n_dst0, const float* kscale, LAS float* scr, int lane) {
    f32x4 v[8]; const int n4 = (lane & 7) * 4;
#pragma unroll
    for (int i = 0; i < 8; ++i) { const int kk = 8 * i + (lane >> 3); v[i] = *(const f32x4*)(W + (size_t)(k0 + kk) * Nsrc + n_src0 + n4); }
    if (kscale) {
#pragma unroll
        for (int i = 0; i < 8; ++i) v[i] = v[i] * kscale[k0 + 8 * i + (lane >> 3)]; }
#pragma unroll
    for (int i = 0; i < 8; ++i) { const int kk = 8 * i + (lane >> 3);
#pragma unroll
        for (int j = 0; j < 4; ++j) scr[kk * 33 + n4 + j] = v[i][j]; }
    LDS_WAIT(); asm volatile("" ::: "memory");
    const int c = lane & 7;
#pragma unroll
    for (int j = 0; j < 4; ++j) { const int n = (lane >> 3) + 8 * j; const LAS float* s = scr + (8 * c) * 33 + n;
        v4u o; o.x = cvt_pk_bf16(s[0 * 33], s[1 * 33]); o.y = cvt_pk_bf16(s[2 * 33], s[3 * 33]); o.z = cvt_pk_bf16(s[4 * 33], s[5 * 33]); o.w = cvt_pk_bf16(s[6 * 33], s[7 * 33]);
        *(v4u*)(WT + (size_t)(n_dst0 + n) * Kdst + k0 + 8 * c) = o; }
    LDS_WAIT(); asm volatile("" ::: "memory");
}

#define XB_TMO      128
#define XB_XCNT(j)  (256  + 64 * (j))
#define XB_XSUB(j)  (1280 + 64 * (j))
#define XB_XGEN(j)  (2304 + 64 * (j))
#define XB_TOP      3328
#define XB_TOPGEN   3392
#define XCD_BAR_WORDS 3456
#define XB_SPIN_CAP (1u << 18)
__device__ __forceinline__ unsigned xb_ld(unsigned* p)              { return __hip_atomic_load(p, __ATOMIC_RELAXED, __HIP_MEMORY_SCOPE_AGENT); }
__device__ __forceinline__ unsigned xb_add(unsigned* p, unsigned v) { return __hip_atomic_fetch_add(p, v, __ATOMIC_RELAXED, __HIP_MEMORY_SCOPE_AGENT); }
__device__ __forceinline__ unsigned xb_xcc_id() { return (unsigned)__builtin_amdgcn_s_getreg((3 << 11) | 20) & 0xFu; }
#define XB_SPIN(cond, bar) do { unsigned _sp = 0; while (cond) { __builtin_amdgcn_s_sleep(1); \
    if ((++_sp & 255u) == 0u) { if (xb_ld(&(bar)[XB_TMO])) break; if (_sp > XB_SPIN_CAP) { atomicAdd(&(bar)[XB_TMO], 1u); break; } } } } while (0)
struct XcdBarrier { unsigned* bar; unsigned x; volatile LAS unsigned* st; };
__device__ __forceinline__ XcdBarrier xcd_barrier_post(unsigned* bar, volatile LAS unsigned* st) {
    XcdBarrier b; b.bar = bar; b.x = xb_xcc_id(); b.st = st;
    if (threadIdx.x == 0) (void)xb_add(&bar[XB_XCNT(b.x)], 1u);
    return b;
}
__device__ __forceinline__ void xcd_barrier_complete(unsigned* bar, unsigned x, unsigned& nloc, unsigned& nx) {
    const unsigned G = gridDim.x * gridDim.y * gridDim.z;
    unsigned sum, cnt, mine, sp = 0u;
    for (;;) {
        sum = 0u; cnt = 0u; mine = 0u;
#pragma unroll
        for (unsigned j = 0; j < 16; ++j) { const unsigned c = xb_ld(&bar[XB_XCNT(j)]); sum += c; cnt += (c > 0u) ? 1u : 0u; mine = (j == x) ? c : mine; }
        if (sum == G) break;
        __builtin_amdgcn_s_sleep(1);
        if ((++sp & 255u) == 0u) { if (xb_ld(&bar[XB_TMO])) break; if (sp > XB_SPIN_CAP) { atomicAdd(&bar[XB_TMO], 1u); break; } }
    }
    nloc = mine > 0u ? mine : 1u; nx = cnt > 0u ? cnt : 1u;
}
__device__ __forceinline__ void xcd_barrier(const XcdBarrier& b) {
    asm volatile("s_waitcnt vmcnt(0)" ::: "memory");
    __syncthreads();
    if (threadIdx.x == 0) {
        unsigned* bar = b.bar;
        __builtin_amdgcn_s_waitcnt(0);
        unsigned nloc = b.st[0], nx = b.st[1];
        if (nloc == 0u) { xcd_barrier_complete(bar, b.x, nloc, nx); b.st[0] = nloc; b.st[1] = nx; }
        const unsigned old = xb_add(&bar[XB_XSUB(b.x)], 1u);
        const unsigned gen = old / nloc;
        if (old + 1u == (gen + 1u) * nloc) {
            __builtin_amdgcn_fence(__ATOMIC_RELEASE, "agent");
            asm volatile("s_waitcnt vmcnt(0)" ::: "memory");
            const unsigned og = xb_add(&bar[XB_TOP], 1u);
            const unsigned tg = og / nx;
            if (og + 1u == (tg + 1u) * nx) xb_add(&bar[XB_TOPGEN], 1u);
            else XB_SPIN(xb_ld(&bar[XB_TOPGEN]) == tg, bar);
            __builtin_amdgcn_fence(__ATOMIC_ACQUIRE, "agent");
            xb_add(&bar[XB_XGEN(b.x)], 1u);
            asm volatile("s_waitcnt vmcnt(0)" ::: "memory");
        } else {
            XB_SPIN(xb_ld(&bar[XB_XGEN(b.x)]) == gen, bar);
            __builtin_amdgcn_fence(__ATOMIC_ACQUIRE, "agent");
            asm volatile("s_waitcnt vmcnt(0)" ::: "memory");
        }
    }
    __syncthreads();
}

template <int W>
__device__ __forceinline__ void pool_item(const bf16* src, bf16* dst, int tl) {
    v4u rw[W + 7];
#pragma unroll
    for (int k = 0; k < W + 7; ++k) rw[k] = (tl + k - (W - 1) >= 0) ? *(const v4u*)(src + (ptrdiff_t)(k - (W - 1)) * DPOOL) : (v4u){0u, 0u, 0u, 0u};
    f32x4 s0 = {0.f, 0.f, 0.f, 0.f}, s1 = s0;
#pragma unroll
    for (int k = 0; k < W - 1; ++k) { f32x4 a, c; pg8::unpack8(rw[k], a, c); s0 += a; s1 += c; }
#pragma unroll
    for (int i = 0; i < 8; ++i) { f32x4 a, c; pg8::unpack8(rw[W - 1 + i], a, c); s0 += a; s1 += c;
        const int t = tl + i; const int cnt = (t + 1 < W) ? t + 1 : W; const float inv = 1.0f / (float)cnt;
        *(v4u*)(dst + (size_t)i * DPOOL) = pg8::pack8(s0 * inv - a, s1 * inv - c);
        f32x4 a2, c2; pg8::unpack8(rw[i], a2, c2); s0 -= a2; s1 -= c2; }
}
__device__ __forceinline__ void scan_local16(const bf16* lap, const bf16* bbp, f32x4 (&S)[2], f32x4 (&H)[2]) {
    S[0] = S[1] = H[0] = H[1] = (f32x4){0.f, 0.f, 0.f, 0.f};
#pragma unroll
    for (int i0 = 0; i0 < 16; i0 += 8) { v4u lw[8], bw[8];
#pragma unroll
        for (int i = 0; i < 8; ++i) { lw[i] = *(const v4u*)(lap + (size_t)(i0 + i) * DRNN); bw[i] = *(const v4u*)(bbp + (size_t)(i0 + i) * DRNN); }
#pragma unroll
        for (int i = 0; i < 8; ++i) { f32x4 l[2], bq[2]; pg8::unpack8(lw[i], l[0], l[1]); pg8::unpack8(bw[i], bq[0], bq[1]);
#pragma unroll
            for (int n = 0; n < 2; ++n)
#pragma unroll
                for (int j = 0; j < 4; ++j) { H[n][j] = __expf(l[n][j]) * H[n][j] + bq[n][j]; S[n][j] += l[n][j]; } } }
}

__global__ void __launch_bounds__(NTHR, 2) fwd_kernel(Args args) {
    extern __shared__ __attribute__((aligned(16))) unsigned char lds_raw[];
    LAS unsigned char* lds = (LAS unsigned char*)lds_raw;
    const int tid = threadIdx.x, lane = tid & 63, wave = __builtin_amdgcn_readfirstlane(tid >> 6);
    const int G = gridDim.x, bx = blockIdx.x;
    unsigned char* ws = args.ws;
    const int lo = args.ph_lo, hi = args.ph_hi;
#ifndef PHASE_MASK
#define PHASE_MASK 0x7ff
#endif
#define IN(k) (((PHASE_MASK >> (k)) & 1) && lo <= (k) && (k) < hi)
#ifndef REPEAT_MASK
#define REPEAT_MASK 0
#endif
#define REPS(k) (((REPEAT_MASK >> (k)) & 1) ? 2 : 1)
#ifndef PROBE_PHASE
#define PROBE_PHASE -1
#endif
#define PROBE_MULT 4
    unsigned long long tp0 = 0, tp1 = 0;
#define TSTART(k) do { if ((k) == PROBE_PHASE) tp0 = __builtin_amdgcn_s_memrealtime(); } while (0)
#define TEND(k) do { if ((k) == PROBE_PHASE) tp1 = __builtin_amdgcn_s_memrealtime(); } while (0)
#define GSYNC() xcd_barrier(bar)
#define SEAM(k) do { if (IN(k) && IN((k) + 1)) { GSYNC(); } } while (0)

    const float* x = args.in[I_X];
    bf16* WIN = (bf16*)(ws + WS_WIN); bf16* WFI = (bf16*)(ws + WS_WFI); bf16* WFO = (bf16*)(ws + WS_WFO); bf16* WCAT = (bf16*)(ws + WS_WCAT);
    bf16* WO = (bf16*)(ws + WS_WO); bf16* WGRP = (bf16*)(ws + WS_WGRP); bf16* WGATE = (bf16*)(ws + WS_WGATE);
    bf16* XN = (bf16*)(ws + WS_R1); bf16* X1B = XN;
    bf16* CAT = (bf16*)(ws + WS_CAT); bf16* V = CAT + 512;
    bf16* UP = (bf16*)(ws + WS_R2);
    bf16* UR = (bf16*)(ws + WS_R3); bf16* LA = UR;
    bf16* UG = (bf16*)(ws + WS_R4);
    bf16* POOLED = (bf16*)(ws + WS_R7); bf16* BB = (bf16*)(ws + WS_R8);
    bf16* MIXB = (bf16*)(ws + WS_MIXB); bf16* ACT = (bf16*)(ws + WS_ACT);
    float* SSQ = (float*)(ws + WS_SSQ); float* CS = (float*)(ws + WS_CS); float* CH = (float*)(ws + WS_CH);
    bf16* G0 = (bf16*)args.out; bf16* G1 = G0 + (size_t)M * 1024;
    float* X1 = args.out;

#ifndef EXTRA_SYNCS
#define EXTRA_SYNCS 0
#endif
    if (PROBE_PHASE == 99) tp0 = __builtin_amdgcn_s_memrealtime();
    volatile LAS unsigned* MISC = (volatile LAS unsigned*)(lds + 131072 + 1024);
    if (tid < 32) MISC[tid] = 0u;
    __syncthreads();
    XcdBarrier bar = xcd_barrier_post((unsigned*)ws, MISC + 8);
    if (lo < 0) cg::this_grid().sync();
    for (int i = 0; i < EXTRA_SYNCS; ++i) GSYNC();
    TSTART(0);
    if (IN(0)) for (int rep = 0; rep < REPS(0); ++rep) { if (rep) GSYNC();
        LAS float* scr = (LAS float*)(lds + wave * 16384);
        const int gw = bx * NWAVES + wave, NGW = G * NWAVES;
        constexpr int I_IN = 16 * (DIN / 32), I_FI = 16 * (2 * DFF / 32), I_FO = (DFF / 64) * (D / 32), I_RO = 16 * 32, I_WO = 16 * 32, I_PO = 8 * 32;
        constexpr int NITEMS = I_IN + I_FI + I_FO + I_RO + I_WO + I_PO;
        for (int it = gw; it < NITEMS; it += NGW) {
            int r = it;
            if (r < I_IN) { const int nblk = DIN / 32, kb = r / nblk, nb = r % nblk, nd = 32 * nb; int ns = nd;
                if (nd >= 2560) { const int q = nd - 2560, pq = q >> 8, j0 = q & 255; ns = 2560 + (j0 < 128 ? 128 * pq + j0 : 1024 + 128 * pq + (j0 - 128)); }
                transpose_item(args.in[I_W_IN], DIN, D, WIN, 64 * kb, ns, nd, nullptr, scr, lane); continue; } r -= I_IN;
            if (r < I_FI) { const int nblk = 2 * DFF / 32, kb = r / nblk, nb = r % nblk, nd = 32 * nb, pn = nd >> 8, j0 = nd & 255;
                const int ns = j0 < 128 ? 128 * pn + j0 : DFF + 128 * pn + (j0 - 128);
                transpose_item(args.in[I_W_FFN_IN], 2 * DFF, D, WFI, 64 * kb, ns, nd, args.in[I_NORM_FFN], scr, lane); continue; } r -= I_FI;
            if (r < I_FO) { const int nblk = D / 32, kb = r / nblk, nb = r % nblk; transpose_item(args.in[I_W_FFN_OUT], D, DFF, WFO, 64 * kb, 32 * nb, 32 * nb, nullptr, scr, lane); continue; } r -= I_FO;
            if (r < I_RO) { const int nblk = D / 32, kb = r / nblk, nb = r % nblk; transpose_item(args.in[I_W_RNN_OUT], D, 1536, WCAT + 512, 64 * kb, 32 * nb, 32 * nb, nullptr, scr, lane); continue; } r -= I_RO;
            if (r < I_WO) { const int nblk = D / 32, kb = r / nblk, nb = r % nblk; transpose_item(args.in[I_W_O], D, D, WO, 64 * kb, 32 * nb, 32 * nb, nullptr, scr, lane); continue; } r -= I_WO;
            { const int nblk = D / 32, kb = r / nblk, nb = r % nblk; transpose_item(args.in[I_W_POOL_OUT], D, 1536, WCAT, 64 * kb, 32 * nb, 32 * nb, nullptr, scr, lane); }
        }
        {
            const int gt = bx * NTHR + tid, NT = G * NTHR;
            const float* wg = args.in[I_W_GRP];
            for (int e = gt; e < 512 * 32; e += NT) { const int n = e >> 5, kc = (e & 31) * 8, g = n >> 7, nn = n & 127; float v[8];
#pragma unroll
                for (int j = 0; j < 8; ++j) { const int kk = kc + j - (g & 1) * 128; v[j] = (kk >= 0 && kk < 128) ? wg[((size_t)g * 128 + kk) * 128 + nn] : 0.f; }
                v4u o; o.x = cvt_pk_bf16(v[0], v[1]); o.y = cvt_pk_bf16(v[2], v[3]); o.z = cvt_pk_bf16(v[4], v[5]); o.w = cvt_pk_bf16(v[6], v[7]);
                *(v4u*)(WGRP + (size_t)n * 256 + kc) = o; }
            const float* wa = args.in[I_W_RG_A]; const float* wx = args.in[I_W_RG_X];
            for (int e = gt; e < 2048 * 16; e += NT) { const int n = e >> 4, kc = (e & 15) * 8, h = n >> 8, j = n & 255; const float* src = j < 128 ? wa : wx; const int jj = j & 127; float v[8];
#pragma unroll
                for (int q = 0; q < 8; ++q) v[q] = src[((size_t)h * 128 + kc + q) * 128 + jj];
                v4u o; o.x = cvt_pk_bf16(v[0], v[1]); o.y = cvt_pk_bf16(v[2], v[3]); o.z = cvt_pk_bf16(v[4], v[5]); o.w = cvt_pk_bf16(v[6], v[7]);
                *(v4u*)(WGATE + (size_t)n * 128 + kc) = o; }
        }
        { const int gt = bx * NTHR + tid; if (gt < DRNN) { const float z = -args.in[I_LAMBDA][gt]; ((float*)(ws + WS_SP8))[gt] = -8.0f * (fmaxf(z, 0.f) + log1pf(expf(-fabsf(z)))); } }
        const float* gmix = args.in[I_NORM_MIX];
        f32x4 gv[4];
#pragma unroll
        for (int j = 0; j < 4; ++j) gv[j] = ((const f32x4*)gmix)[lane + 64 * j];
        for (int m = gw; m < M; m += 2 * NGW) {
            const int m1 = (m + NGW < M) ? m + NGW : m;
            const f32x4* xr0 = (const f32x4*)(x + (size_t)m * D) + lane; const f32x4* xr1 = (const f32x4*)(x + (size_t)m1 * D) + lane; f32x4 v0[4], v1[4]; float s0 = 0.f, s1 = 0.f;
#pragma unroll
            for (int j = 0; j < 4; ++j) { v0[j] = xr0[64 * j]; v1[j] = xr1[64 * j]; }
#pragma unroll
            for (int j = 0; j < 4; ++j) { s0 += (v0[j].x * v0[j].x + v0[j].y * v0[j].y) + (v0[j].z * v0[j].z + v0[j].w * v0[j].w); s1 += (v1[j].x * v1[j].x + v1[j].y * v1[j].y) + (v1[j].z * v1[j].z + v1[j].w * v1[j].w); }
            const float rs0 = 1.0f / sqrtf(wave_sum(s0) * (1.f / D) + EPS), rs1 = 1.0f / sqrtf(wave_sum(s1) * (1.f / D) + EPS);
            v2u* o0 = (v2u*)(XN + (size_t)m * D) + lane; v2u* o1 = (v2u*)(XN + (size_t)m1 * D) + lane;
#pragma unroll
            for (int j = 0; j < 4; ++j) { const f32x4 y0 = v0[j] * rs0 * gv[j], y1 = v1[j] * rs1 * gv[j]; v2u w0, w1; w0.x = cvt_pk_bf16(y0.x, y0.y); w0.y = cvt_pk_bf16(y0.z, y0.w); w1.x = cvt_pk_bf16(y1.x, y1.y); w1.y = cvt_pk_bf16(y1.z, y1.w); o0[64 * j] = w0; o1[64 * j] = w1; }
        }
        __syncthreads();
    }
    SEAM(0);
    TEND(0);

    TSTART(1);
    if (IN(1)) for (int rep = 0; rep < REPS(1); ++rep) { if (rep) GSYNC();
        pg8::Gemm g{XN, WIN, M, 4096, D, D, D, 0, 0}; pg8::StaticOrder S; S.init(M, 4096, G, bx);
        pg8::EpiProj E{UP, UR, UG, G0, G1, 0};
        pg8::gemm_phase<pg8::EpiProj, true>(lds, g, S, E);
    }
    SEAM(1);
    TEND(1);

    TSTART(2);
    if (IN(2)) for (int rep = 0; rep < REPS(2); ++rep) { if (rep) GSYNC();
        { const int gw = bx * NWAVES + wave, NGW = G * NWAVES;
          for (int wi = gw; wi < (M / 32) * 4; wi += NGW) { const int g = wi & 3, t0 = (wi >> 2) * 32 + (lane >> 4) * 8, co = g * 16 + (lane & 15);
              const bf16* src = UP + (size_t)t0 * DPOOL + co * 8; bf16* dst = POOLED + (size_t)t0 * DPOOL + co * 8; const int tl = t0 & (SEQ - 1);
              if (g == 0) pool_item<2>(src, dst, tl); else if (g == 1) pool_item<4>(src, dst, tl); else if (g == 2) pool_item<8>(src, dst, tl); else pool_item<16>(src, dst, tl); } }
        { const int gt = bx * NTHR + tid, NT = G * NTHR;
          for (int it = gt; it < (M / 8) * 128; it += NT) { const int co = it & 127, t0 = (it >> 7) * 8, tl = t0 & (SEQ - 1);
              const bf16* src = UR + (size_t)t0 * DRNN + co * 8; bf16* dst = V + (size_t)t0 * 1536 + co * 8;
              const float* cw = args.in[I_CONV_W] + co * 8; const float* cb = args.in[I_CONV_B] + co * 8;
              v4u rw[11];
#pragma unroll
              for (int k = 0; k < 11; ++k) rw[k] = (k >= 3 || tl != 0) ? *(const v4u*)(src + (ptrdiff_t)(k - 3) * DRNN) : (v4u){0u, 0u, 0u, 0u};
              f32x4 w0[2], w1[2], w2[2], w3[2], bb[2];
#pragma unroll
              for (int n = 0; n < 2; ++n) { w0[n] = *(const f32x4*)(cw + 4 * n); w1[n] = *(const f32x4*)(cw + 1024 + 4 * n); w2[n] = *(const f32x4*)(cw + 2048 + 4 * n); w3[n] = *(const f32x4*)(cw + 3072 + 4 * n); bb[n] = *(const f32x4*)(cb + 4 * n); }
#pragma unroll
              for (int i = 0; i < 8; ++i) { f32x4 a[2], b[2], c[2], d[2]; pg8::unpack8(rw[i], a[0], a[1]); pg8::unpack8(rw[i + 1], b[0], b[1]); pg8::unpack8(rw[i + 2], c[0], c[1]); pg8::unpack8(rw[i + 3], d[0], d[1]);
                  *(v4u*)(dst + (size_t)i * 1536) = pg8::pack8(bb[0] + w0[0] * a[0] + w1[0] * b[0] + w2[0] * c[0] + w3[0] * d[0], bb[1] + w0[1] * a[1] + w1[1] * b[1] + w2[1] * c[1] + w3[1] * d[1]); }
          } }
    }
    SEAM(2);
    TEND(2);

    TSTART(3);
    if (IN(3)) for (int rep = 0; rep < REPS(3); ++rep) { if (rep) GSYNC();
        const bool uneven = (G == 256);
        {
          pg8::Gemm g{XN, WIN + (size_t)4096 * D, M, 512, D, D, D, 0, 0}; pg8::StaticOrder S; S.init(M, 512, G, bx);
          pg8::EpiProj E{UP, UR, UG, G0, G1, 16};
          pg8::gemm_phase<pg8::EpiProj, true>(lds, g, S, E); }
        { pg8::Gemm g{POOLED, WGRP, M, 512, 256, 512, 256, 0, 256}; pg8::StaticOrder S; S.init(M, 512, G, (bx + G / 2) % G);
          pg8::EpiGrp E{CAT, 1536, args.in[I_POOL_SCALE]};
          pg8::gemm_phase<pg8::EpiGrp, true>(lds, g, S, E); }
        { pg8::Gemm g{V, WGATE, M, 2048, 128, 1536, 128, 0, 128}; pg8::StaticOrder S; S.init(M, 2048, G, bx);
          if (uneven) { if (bx < 128) { S.lin_base = bx; S.lin_cnt = 1; } else { S.lin_base = 128 + (bx - 128) * 3; S.lin_cnt = 3; } }
          pg8::EpiGate E{V, LA, BB, args.in[I_B_RG_A], args.in[I_B_RG_X], (const float*)(ws + WS_SP8)};
          pg8::gemm_phase<pg8::EpiGate, true>(lds, g, S, E); }
    }
    SEAM(3);
    TEND(3);

    TSTART(4);
    TEND(4);

    TSTART(5);
    if (IN(5)) for (int rep = 0; rep < REPS(5); ++rep) { if (rep) GSYNC();
        LAS float* PAS = (LAS float*)lds; LAS float* PAH = PAS + 8 * 512; LAS float* PBS = PAH + 8 * 512; LAS float* PBH = PBS + 8 * 512;
        unsigned* flags = (unsigned*)ws + 8192;
        for (int bi = bx; bi < NB * SCAN_NC * 2; bi += G) { const int hh = bi & 1, c = (bi >> 1) % SCAN_NC, b = bi / (2 * SCAN_NC);
            const size_t off = ((size_t)b * SEQ + (size_t)c * SCAN_T + wave * 16) * DRNN + hh * 512 + lane * 8;
            v4u lwk[16], bwk[16];
#pragma unroll
            for (int i = 0; i < 16; ++i) { lwk[i] = *(const v4u*)(LA + off + (size_t)i * DRNN); bwk[i] = *(const v4u*)(BB + off + (size_t)i * DRNN); }
            { f32x4 S[2] = {{0.f, 0.f, 0.f, 0.f}, {0.f, 0.f, 0.f, 0.f}}, H[2] = {{0.f, 0.f, 0.f, 0.f}, {0.f, 0.f, 0.f, 0.f}};
#pragma unroll
              for (int i = 0; i < 16; ++i) { f32x4 l[2], bq[2]; pg8::unpack8(lwk[i], l[0], l[1]); pg8::unpack8(bwk[i], bq[0], bq[1]);
#pragma unroll
                  for (int n = 0; n < 2; ++n)
#pragma unroll
                      for (int j = 0; j < 4; ++j) { H[n][j] = __expf(l[n][j]) * H[n][j] + bq[n][j]; S[n][j] += l[n][j]; } }
              *(LAS f32x4*)(PBS + wave * 512 + lane * 8) = S[0]; *(LAS f32x4*)(PBS + wave * 512 + lane * 8 + 4) = S[1];
              *(LAS f32x4*)(PBH + wave * 512 + lane * 8) = H[0]; *(LAS f32x4*)(PBH + wave * 512 + lane * 8 + 4) = H[1]; }
#pragma unroll
            for (int i = 0; i < 16; ++i) asm volatile("" : "+v"(lwk[i]), "+v"(bwk[i]));
            __syncthreads();
            { float h = 0.f, st = 0.f;
#pragma unroll
              for (int sb = 0; sb < 8; ++sb) { const float sv = PBS[sb * 512 + tid]; h = __expf(sv) * h + PBH[sb * 512 + tid]; st += sv; }
              const size_t co = ((size_t)b * SCAN_NC + c) * DRNN + hh * 512 + tid;
              __hip_atomic_store(CS + co, st, __ATOMIC_RELAXED, __HIP_MEMORY_SCOPE_AGENT); __hip_atomic_store(CH + co, h, __ATOMIC_RELAXED, __HIP_MEMORY_SCOPE_AGENT); }
            asm volatile("s_waitcnt vmcnt(0)" ::: "memory");
            __syncthreads();
            if (tid == 0) __hip_atomic_store(flags + ((b * 2 + hh) * SCAN_NC + c) * 16, 1u, __ATOMIC_RELAXED, __HIP_MEMORY_SCOPE_AGENT);
            { f32x4 S[2] = {{0.f, 0.f, 0.f, 0.f}, {0.f, 0.f, 0.f, 0.f}}, H[2] = {{0.f, 0.f, 0.f, 0.f}, {0.f, 0.f, 0.f, 0.f}};
              if (wave * 4 < c) {
                  for (int q = 0; q < 4; ++q) { const int cc = wave * 4 + q; if (cc < c) { unsigned* f = flags + ((b * 2 + hh) * SCAN_NC + cc) * 16; unsigned sp = 0;
                      while ((unsigned)__builtin_amdgcn_readfirstlane(__hip_atomic_load(f, __ATOMIC_RELAXED, __HIP_MEMORY_SCOPE_AGENT)) == 0u) { __builtin_amdgcn_s_sleep(1); if (++sp > (1u << 20)) break; } } }
                  __builtin_amdgcn_fence(__ATOMIC_ACQUIRE, "agent");
#pragma unroll
                  for (int q0 = 0; q0 < 4; q0 += 2) { f32x4 cs[2][2], ch[2][2];
#pragma unroll
                      for (int q = 0; q < 2; ++q) { const int cc = wave * 4 + q0 + q; const size_t co = ((size_t)b * SCAN_NC + (cc < c ? cc : 0)) * DRNN + hh * 512 + lane * 8;
                          cs[q][0] = *(const f32x4*)(CS + co); cs[q][1] = *(const f32x4*)(CS + co + 4); ch[q][0] = *(const f32x4*)(CH + co); ch[q][1] = *(const f32x4*)(CH + co + 4); }
#pragma unroll
                      for (int q = 0; q < 2; ++q) { if (wave * 4 + q0 + q < c) {
#pragma unroll
                          for (int n = 0; n < 2; ++n)
#pragma unroll
                              for (int j = 0; j < 4; ++j) { H[n][j] = __expf(cs[q][n][j]) * H[n][j] + ch[q][n][j]; S[n][j] += cs[q][n][j]; } } }
                      asm volatile("" ::: "memory"); }
              }
              *(LAS f32x4*)(PAS + wave * 512 + lane * 8) = S[0]; *(LAS f32x4*)(PAS + wave * 512 + lane * 8 + 4) = S[1];
              *(LAS f32x4*)(PAH + wave * 512 + lane * 8) = H[0]; *(LAS f32x4*)(PAH + wave * 512 + lane * 8 + 4) = H[1]; }
            __syncthreads();
            f32x4 h[2] = {{0.f, 0.f, 0.f, 0.f}, {0.f, 0.f, 0.f, 0.f}};
#pragma unroll
            for (int sb = 0; sb < 8; ++sb) {
#pragma unroll
                for (int n = 0; n < 2; ++n) { const f32x4 sv = *(const LAS f32x4*)(PAS + sb * 512 + lane * 8 + 4 * n), hv = *(const LAS f32x4*)(PAH + sb * 512 + lane * 8 + 4 * n);
#pragma unroll
                    for (int j = 0; j < 4; ++j) h[n][j] = __expf(sv[j]) * h[n][j] + hv[j]; } }
            for (int sb = 0; sb < wave; ++sb) {
#pragma unroll
                for (int n = 0; n < 2; ++n) { const f32x4 sv = *(const LAS f32x4*)(PBS + sb * 512 + lane * 8 + 4 * n), hv = *(const LAS f32x4*)(PBH + sb * 512 + lane * 8 + 4 * n);
#pragma unroll
                    for (int j = 0; j < 4; ++j) h[n][j] = __expf(sv[j]) * h[n][j] + hv[j]; } }
            const bf16* ugp = UG + off;
            bf16* hgp = CAT + ((size_t)b * SEQ + (size_t)c * SCAN_T + wave * 16) * 1536 + 512 + hh * 512 + lane * 8;
#pragma unroll
            for (int i0 = 0; i0 < 16; i0 += 8) { v4u gw8[8];
#pragma unroll
                for (int i = 0; i < 8; ++i) gw8[i] = *(const v4u*)(ugp + (size_t)(i0 + i) * DRNN);
#pragma unroll
                for (int i = 0; i < 8; ++i) { f32x4 l[2], bq[2], gq[2], o[2]; pg8::unpack8(lwk[i0 + i], l[0], l[1]); pg8::unpack8(bwk[i0 + i], bq[0], bq[1]); pg8::unpack8(gw8[i], gq[0], gq[1]);
#pragma unroll
                    for (int n = 0; n < 2; ++n)
#pragma unroll
                        for (int j = 0; j < 4; ++j) { h[n][j] = __expf(l[n][j]) * h[n][j] + bq[n][j]; o[n][j] = h[n][j] * pg8::gelu_tanh_(gq[n][j]); }
                    *(v4u*)(hgp + (size_t)(i0 + i) * 1536) = pg8::pack8(o[0], o[1]); } }
            __syncthreads();
        }
    }
    SEAM(5);
    TEND(5);

    TSTART(6);
    if (IN(6)) for (int rep = 0; rep < REPS(6); ++rep) { if (rep) GSYNC();
        pg8::Gemm g{CAT, WCAT, M, D, 1536, 1536, 1536, 0, 0}; pg8::StaticOrder S; S.init(M, D, G, bx);
        pg8::EpiMix E{G0, G1, MIXB};
        pg8::gemm_phase<pg8::EpiMix, true, 8>(lds, g, S, E);
    }
    SEAM(6);
    TEND(6);

    TSTART(7);
    if (IN(7)) for (int rep = 0; rep < REPS(7); ++rep) { if (rep) GSYNC();
        pg8::Gemm g{MIXB, WO, M, D, D, D, D, 0, 0}; pg8::StaticOrder S; S.init(M, D, G, bx);
        pg8::EpiRes1 E{x, X1B, SSQ};
        pg8::gemm_phase<pg8::EpiRes1, true>(lds, g, S, E);
    }
    SEAM(7);
    TEND(7);

    TSTART(8);
    if (IN(8)) for (int rep = 0; rep < REPS(8); ++rep) { if (rep) GSYNC();
        pg8::Gemm g{X1B, WFI, M, 2 * DFF, D, D, D, 0, 0}; pg8::StaticOrder S; S.init(M, 2 * DFF, G, bx);
        LAS float* RSL = (LAS float*)(lds + 133120);
        { const int r = tid & 255;
          for (int i = tid >> 8; i < 8; i += 2) { pg8::Unit u; if (!S.next(i, u)) break;
              const f32x4* sp = (const f32x4*)(SSQ + (size_t)(u.pm * 256 + r) * 16); const f32x4 st = (sp[0] + sp[1]) + (sp[2] + sp[3]);
              RSL[i * 256 + r] = __builtin_amdgcn_rsqf(((st[0] + st[1]) + (st[2] + st[3])) * (1.0f / 1024.0f) + 1e-6f); }
          __syncthreads(); }
        pg8::EpiSwiglu E{RSL, ACT};
        pg8::gemm_phase<pg8::EpiSwiglu, true>(lds, g, S, E);
    }
    SEAM(8);
    TEND(8);

    TSTART(9);
    if (IN(9)) for (int rep = 0; rep < REPS(9); ++rep) { if (rep) GSYNC();
        pg8::Gemm g{ACT, WFO, M, D, DFF, DFF, DFF, 0, 0}; pg8::StaticOrder S; S.init(M, D, G, bx);
        if (G == 256) { pg8::EpiFinal E{X1B, X1, (float*)(ws + WS_SSQ2), (unsigned*)ws + 4096, args.in[I_NORM_FINAL]};
            pg8::gemm_phase<pg8::EpiFinal, true>(lds, g, S, E); }
        else { pg8::EpiRes2 E{X1B, X1};
            pg8::gemm_phase<pg8::EpiRes2, true>(lds, g, S, E); }
    }
    if (G != 256) SEAM(9);
    TEND(9);

    TSTART(10);
    if (IN(10) && G != 256) for (int rep = 0; rep < REPS(10); ++rep) { if (rep) GSYNC();
        const int gw = bx * NWAVES + wave, NGW = G * NWAVES;
        const float* gf = args.in[I_NORM_FINAL]; f32x4 gv[4];
#pragma unroll
        for (int j = 0; j < 4; ++j) gv[j] = ((const f32x4*)gf)[lane + 64 * j];
        for (int m = gw; m < M; m += NGW) {
            f32x4* xr = (f32x4*)(X1 + (size_t)m * D) + lane; f32x4 v[4]; float s = 0.f;
#pragma unroll
            for (int j = 0; j < 4; ++j) { v[j] = xr[64 * j]; s += (v[j].x * v[j].x + v[j].y * v[j].y) + (v[j].z * v[j].z + v[j].w * v[j].w); }
            const float rs = 1.0f / sqrtf(wave_sum(s) * (1.f / D) + EPS);
#pragma unroll
            for (int j = 0; j < 4; ++j) xr[64 * j] = v[j] * rs * gv[j];
        }
    }
    if (PROBE_PHASE == 10 || PROBE_PHASE == 99) tp1 = __builtin_amdgcn_s_memrealtime();
    if (PROBE_PHASE >= 0 && bx == 0 && tid == 0) { const unsigned long long dt = (tp1 - tp0) * PROBE_MULT, te = __builtin_amdgcn_s_memrealtime(); while (__builtin_amdgcn_s_memrealtime() - te < dt) __builtin_amdgcn_s_sleep(8); }
#undef IN
#undef SEAM
}

extern "C" void kernel_launch(void* const* d_in, const int* in_sizes, int n_in, void* d_out, int out_size, void* d_ws, size_t ws_size, hipStream_t stream) {
    static int grid = 0;
    if (grid == 0) {
        if (n_in != 19 || out_size != M * D || ws_size < WS_END) { fprintf(stderr, "kernel_launch: unexpected shapes (n_in %d out %d ws %zu)\n", n_in, out_size, ws_size); grid = -1; return; }
        int dev = 0, cus = 0, per_cu = 0;
        hipGetDevice(&dev);
        hipDeviceGetAttribute(&cus, hipDeviceAttributeMultiprocessorCount, dev);
        if (hipFuncSetAttribute((const void*)fwd_kernel, hipFuncAttributeMaxDynamicSharedMemorySize, LDS_BYTES) != hipSuccess) { fprintf(stderr, "kernel_launch: hipFuncSetAttribute failed\n"); grid = -1; return; }
        if (hipOccupancyMaxActiveBlocksPerMultiprocessor(&per_cu, (const void*)fwd_kernel, NTHR, LDS_BYTES) != hipSuccess || per_cu < 1) { fprintf(stderr, "kernel_launch: occupancy query says %d\n", per_cu); per_cu = 1; }
        (void)hipGetLastError();
        grid = cus * 1;
        fprintf(stderr, "kernel_launch: grid %d (cus %d, per_cu %d)\n", grid, cus, per_cu);
    }
    if (grid < 0) return;
    if (hipMemsetAsync(d_ws, 0, 49152, stream) != hipSuccess) { fprintf(stderr, "kernel_launch: memset failed\n"); return; }
    Args a{};
    for (int i = 0; i < 19; ++i) a.in[i] = (const float*)d_in[i];
    a.out = (float*)d_out; a.ws = (unsigned char*)d_ws;
#if MK_PER_PHASE
    for (int p = 0; p < NPH; ++p) { a.ph_lo = p; a.ph_hi = p + 1; hipLaunchKernelGGL(fwd_kernel, dim3(grid), dim3(NTHR), LDS_BYTES, stream, a); }
#else
    a.ph_lo = 0; a.ph_hi = NPH;
    void* kargs[] = {&a};
    hipError_t e = hipLaunchCooperativeKernel((const void*)fwd_kernel, dim3(grid), dim3(NTHR), kargs, LDS_BYTES, stream);
    if (e != hipSuccess) fprintf(stderr, "cooperative launch failed: %s (grid %d)\n", hipGetErrorString(e), grid);
#endif
}
```

```cpp
#include <hip/hip_runtime.h>
#include <hip/hip_cooperative_groups.h>
#include <cstdio>
#include <cstdint>
namespace cg = cooperative_groups;

#ifndef MK_PER_PHASE
#define MK_PER_PHASE 0
#endif

namespace pg8 {
#define PG8_LAS __attribute__((address_space(3)))
typedef unsigned short bf16_t;
typedef short bf16x8 __attribute__((ext_vector_type(8)));
typedef float f32x4 __attribute__((ext_vector_type(4)));
typedef float f32x2 __attribute__((ext_vector_type(2)));
typedef unsigned u32x4 __attribute__((ext_vector_type(4)));
typedef unsigned u32x2 __attribute__((ext_vector_type(2)));
constexpr int BM = 256, BK = 64, HALF = 128, HTB = HALF * BK * 2, STAGE_BYTES = 8 * HTB, NXCD = 8, WGM = 8;

__host__ __device__ __forceinline__ int lds_byte(int r, int c) { const int st = (r >> 4) * 2 + (c >> 5), rr = r & 15, cc = c & 31, ob = rr * 64 + cc * 2; return st * 1024 + (ob ^ (((ob >> 9) & 1) << 5)); }
__host__ __device__ __forceinline__ void stage_rc(int b, int& R, int& C) { const int st = b / 1024, sb = b % 1024, swz = sb ^ (((sb >> 9) & 1) << 5); R = (st >> 1) * 16 + swz / 64; C = (st & 1) * 32 + (swz % 64) / 2; }
__host__ __device__ __forceinline__ int perm32(int rho) { const int n = rho >> 4, i = rho & 15; return 8 * (i >> 2) + 4 * n + (i & 3); }

struct Unit { int pm, pn, rh, idx; };
struct Gemm { const bf16_t* A; const bf16_t* Bt; int M, N, K, lda, ldb, ash, amul; };

struct StaticOrder {
    int nM, nN, nwg, G, c, limit, lin_base, lin_cnt;
    __host__ __device__ void init(int M, int N, int G_, int c_) { nM = M / BM; nN = N / BM; nwg = nM * nN; G = G_; c = c_; limit = nwg; lin_base = 0; lin_cnt = -1; }
    __host__ __device__ void map(int L, Unit& u) const {
        int wgid = L; { const int q = nwg / NXCD, r = nwg % NXCD, xcd = wgid % NXCD, off = wgid / NXCD; wgid = (xcd < r ? xcd * (q + 1) : r * (q + 1) + (xcd - r) * q) + off; }
        const int nig = WGM * nN, gid = wgid / nig, fm = gid * WGM, gsz = (nM - fm) < WGM ? (nM - fm) : WGM;
        u.pm = fm + ((wgid % nig) % gsz); u.pn = (wgid % nig) / gsz; u.rh = 0;
    }
    __host__ __device__ bool next(int i, Unit& u) const {
        u.idx = i;
        if (lin_cnt >= 0) { if (i >= lin_cnt) return false; map(lin_base + i, u); return true; }
        const long L = (long)i * G + c; if (L >= limit) return false;
        map((int)L, u); return true;
    }
};

__device__ __forceinline__ unsigned cvt_pk_bf16(float lo, float hi) { unsigned r; asm volatile("v_cvt_pk_bf16_f32 %0, %1, %2" : "=v"(r) : "v"(lo), "v"(hi)); return r; }
__device__ __forceinline__ float bf_lo(unsigned w) { return __uint_as_float(w << 16); }
__device__ __forceinline__ float bf_hi(unsigned w) { return __uint_as_float(w & 0xffff0000u); }
__device__ __forceinline__ float sigmoidf_(float x) { return __builtin_amdgcn_rcpf(1.0f + __expf(-x)); }
__device__ __forceinline__ float gelu_tanh_(float x) { const float z = 1.5957691216057308f * (x + 0.044715f * x * x * x); return x * sigmoidf_(z); }
__device__ __forceinline__ u32x4 pack8(const f32x4 a, const f32x4 b) { u32x4 w; w.x = cvt_pk_bf16(a[0], a[1]); w.y = cvt_pk_bf16(a[2], a[3]); w.z = cvt_pk_bf16(b[0], b[1]); w.w = cvt_pk_bf16(b[2], b[3]); return w; }
__device__ __forceinline__ void unpack8(const u32x4 w, f32x4& a, f32x4& b) { a = (f32x4){bf_lo(w.x), bf_hi(w.x), bf_lo(w.y), bf_hi(w.y)}; b = (f32x4){bf_lo(w.z), bf_hi(w.z), bf_lo(w.w), bf_hi(w.w)}; }

#define EPI_ROWS_BEGIN _Pragma("unroll") for (int ai = 0; ai < NAI; ++ai) _Pragma("unroll") for (int m = 0; m < 4; ++m) { const int row = u.pm * BM + u.rh + ai * HALF + wr * 64 + m * 16 + fr;
#define EPI_ROWS_END }

struct EpiProj {
    bf16_t *UP, *UR, *UG, *RB, *G1; int pn_off;
    template <int NAI> __device__ __forceinline__ void run(const f32x4 (&acc)[2][2][4][2], const Unit& u, int wr, int wc, int fr, int fq) const {
        const int pn = u.pn + pn_off;
        if (pn < 10) {
            bf16_t* base; int ldc, colt;
            if (pn < 2) { base = UP; ldc = 512; colt = pn * 256; }
            else if (pn < 6) { base = UR; ldc = 1024; colt = (pn - 2) * 256; }
            else { base = UG; ldc = 1024; colt = (pn - 6) * 256; }
            const int col0 = colt + wc * 32 + 8 * fq;
            EPI_ROWS_BEGIN
                bf16_t* rowp = base + (unsigned)((unsigned)row * (unsigned)ldc + (unsigned)col0);
#pragma unroll
                for (int bj = 0; bj < 2; ++bj) *(u32x4*)(rowp + bj * HALF) = pack8(acc[ai][bj][m][0], acc[ai][bj][m][1]);
            EPI_ROWS_END
        } else {
            const int ch0 = (pn - 10) * 128 + wc * 32 + 8 * fq;
            EPI_ROWS_BEGIN
                const unsigned off = (unsigned)row * 1024u + (unsigned)ch0; f32x4 rr[2], gg[2];
#pragma unroll
                for (int n = 0; n < 2; ++n)
#pragma unroll
                    for (int j = 0; j < 4; ++j) { const float d0 = 1.0f + fminf(__expf(-acc[ai][0][m][n][j]), 1e18f), d1 = 1.0f + fminf(__expf(-acc[ai][1][m][n][j]), 1e18f);
                        gg[n][j] = __builtin_amdgcn_rcpf(d1); rr[n][j] = d1 * __builtin_amdgcn_rcpf(d0); }
                *(u32x4*)(RB + off) = pack8(rr[0], rr[1]); *(u32x4*)(G1 + off) = pack8(gg[0], gg[1]);
            EPI_ROWS_END
        }
    }
};
struct EpiGrp {
    bf16_t* O; int ldc; const float* scale;
    template <int NAI> __device__ __forceinline__ void run(const f32x4 (&acc)[2][2][4][2], const Unit& u, int wr, int wc, int fr, int fq) const {
        const int col0 = u.pn * BM + wc * 32 + 8 * fq;
        f32x4 sc[2][2];
#pragma unroll
        for (int bj = 0; bj < 2; ++bj)
#pragma unroll
            for (int n = 0; n < 2; ++n) sc[bj][n] = *(const f32x4*)(scale + col0 + bj * HALF + 4 * n);
        EPI_ROWS_BEGIN
            bf16_t* rowp = O + (unsigned)((unsigned)row * (unsigned)ldc + (unsigned)col0);
#pragma unroll
            for (int bj = 0; bj < 2; ++bj) *(u32x4*)(rowp + bj * HALF) = pack8(acc[ai][bj][m][0] * sc[bj][0], acc[ai][bj][m][1] * sc[bj][1]);
        EPI_ROWS_END
    }
};
struct EpiGate {
    const bf16_t* V; bf16_t *LA, *BB; const float *b_a, *b_x, *sp8;
    template <int NAI> __device__ __forceinline__ void run(const f32x4 (&acc)[2][2][4][2], const Unit& u, int wr, int wc, int fr, int fq) const {
        const int ch0 = u.pn * 128 + wc * 32 + 8 * fq;
        f32x4 ba[2], bx[2], sp[2];
#pragma unroll
        for (int n = 0; n < 2; ++n) { ba[n] = *(const f32x4*)(b_a + ch0 + 4 * n); bx[n] = *(const f32x4*)(b_x + ch0 + 4 * n); sp[n] = *(const f32x4*)(sp8 + ch0 + 4 * n); }
        EPI_ROWS_BEGIN
            const unsigned off = (unsigned)row * 1024u + (unsigned)ch0;
            const u32x4 vw = *(const u32x4*)(V + ((unsigned)row * 1536u + (unsigned)ch0)); f32x4 vv[2]; unpack8(vw, vv[0], vv[1]);
            f32x4 la[2], bb[2];
#pragma unroll
            for (int n = 0; n < 2; ++n)
#pragma unroll
                for (int j = 0; j < 4; ++j) {
                    const float r = sigmoidf_(acc[ai][0][m][n][j] + ba[n][j]), ig = sigmoidf_(acc[ai][1][m][n][j] + bx[n][j]);
                    const float l = sp[n][j] * r, x2 = 2.0f * l;
                    const float em1 = (x2 > -0.125f) ? x2 * (1.0f + 0.5f * x2 * (1.0f + 0.33333334f * x2 * (1.0f + 0.25f * x2 * (1.0f + 0.2f * x2)))) : (__expf(x2) - 1.0f);
                    la[n][j] = l; bb[n][j] = __builtin_amdgcn_sqrtf(fmaxf(-em1, 0.f)) * ig * vv[n][j]; }
            *(u32x4*)(LA + off) = pack8(la[0], la[1]); *(u32x4*)(BB + off) = pack8(bb[0], bb[1]);
            asm volatile("" ::: "memory");
        EPI_ROWS_END
    }
};
struct EpiMix {
    const bf16_t *RB, *G1; bf16_t* MIXB;
    __device__ __forceinline__ void mid(f32x4 (&acc)[2][2][4][2], const Unit& u0, int wr, int wc, int fr, int fq) const {
        constexpr int NAI = 2; Unit u = u0; asm volatile("" : "+s"(u.pm), "+s"(u.pn));
        const int col0 = u.pn * BM + wc * 32 + 8 * fq;
        EPI_ROWS_BEGIN
            const unsigned off = (unsigned)row * 1024u + (unsigned)col0;
#pragma unroll
            for (int bj = 0; bj < 2; ++bj) { f32x4 r[2]; unpack8(*(const u32x4*)(RB + off + bj * HALF), r[0], r[1]); acc[ai][bj][m][0] *= r[0]; acc[ai][bj][m][1] *= r[1]; }
        EPI_ROWS_END
    }
    template <int NAI> __device__ __forceinline__ void run(const f32x4 (&acc)[2][2][4][2], const Unit& u, int wr, int wc, int fr, int fq) const {
        const int col0 = u.pn * BM + wc * 32 + 8 * fq;
        EPI_ROWS_BEGIN
            const unsigned off = (unsigned)row * 1024u + (unsigned)col0;
#pragma unroll
            for (int bj = 0; bj < 2; ++bj) { f32x4 g[2]; unpack8(*(const u32x4*)(G1 + off + bj * HALF), g[0], g[1]);
                *(u32x4*)(MIXB + off + bj * HALF) = pack8(g[0] * acc[ai][bj][m][0], g[1] * acc[ai][bj][m][1]); }
        EPI_ROWS_END
    }
};
struct EpiRes1 {
    const float* X; bf16_t* X1B; float* SSQ;
    template <int NAI> __device__ __forceinline__ void run(const f32x4 (&acc)[2][2][4][2], const Unit& u, int wr, int wc, int fr, int fq) const {
        const int col0 = u.pn * BM + wc * 32 + 8 * fq;
        EPI_ROWS_BEGIN
            const unsigned off = (unsigned)row * 1024u + (unsigned)col0; float ss = 0.f;
#pragma unroll
            for (int bj = 0; bj < 2; ++bj) {
                const f32x4 a = *(const f32x4*)(X + off + bj * HALF) + acc[ai][bj][m][0], b = *(const f32x4*)(X + off + bj * HALF + 4) + acc[ai][bj][m][1];
                *(u32x4*)(X1B + off + bj * HALF) = pack8(a, b);
                ss += (a[0] * a[0] + a[1] * a[1]) + (a[2] * a[2] + a[3] * a[3]) + (b[0] * b[0] + b[1] * b[1]) + (b[2] * b[2] + b[3] * b[3]); }
            ss += __shfl_xor(ss, 16); ss += __shfl_xor(ss, 32);
            if (fq == 0) SSQ[(unsigned)row * 16u + (unsigned)(u.pn * 4 + wc)] = ss;
        EPI_ROWS_END
    }
};
struct EpiSwiglu {
    const PG8_LAS float* RSL; bf16_t* ACT;
    template <int NAI> __device__ __forceinline__ void run(const f32x4 (&acc)[2][2][4][2], const Unit& u, int wr, int wc, int fr, int fq) const {
        const int col0 = u.pn * 128 + wc * 32 + 8 * fq;
        const PG8_LAS float* rt = RSL + u.idx * 256 + wr * 64 + fr;
        EPI_ROWS_BEGIN
            const float rs = rt[ai * HALF + m * 16];
            f32x4 o[2];
#pragma unroll
            for (int n = 0; n < 2; ++n)
#pragma unroll
                for (int j = 0; j < 4; ++j) { const float g = acc[ai][0][m][n][j] * rs, up = acc[ai][1][m][n][j] * rs; o[n][j] = g * sigmoidf_(g) * up; }
            __builtin_nontemporal_store(pack8(o[0], o[1]), (u32x4*)(ACT + (unsigned)((unsigned)row * 2816u + (unsigned)col0)));
        EPI_ROWS_END
    }
};
struct EpiRes2 {
    const bf16_t* X1B; float* OUT;
    template <int NAI> __device__ __forceinline__ void run(const f32x4 (&acc)[2][2][4][2], const Unit& u, int wr, int wc, int fr, int fq) const {
        const int col0 = u.pn * BM + wc * 32 + 8 * fq;
        EPI_ROWS_BEGIN
            const unsigned off = (unsigned)row * 1024u + (unsigned)col0;
#pragma unroll
            for (int bj = 0; bj < 2; ++bj) { f32x4 xa, xb; unpack8(*(const u32x4*)(X1B + off + bj * HALF), xa, xb);
                *(f32x4*)(OUT + off + bj * HALF) = xa + acc[ai][bj][m][0]; *(f32x4*)(OUT + off + bj * HALF + 4) = xb + acc[ai][bj][m][1]; }
        EPI_ROWS_END
    }
};

struct EpiFinal {
    const bf16_t* X1B; float* OUT; float* SSQ2; unsigned* cnt; const float* gfin;
    template <int NAI> __device__ __forceinline__ void run(f32x4 (&acc)[2][2][4][2], const Unit& u, int wr, int wc, int fr, int fq) const {
        const int col0 = u.pn * BM + wc * 32 + 8 * fq;
        EPI_ROWS_BEGIN
            const unsigned off = (unsigned)row * 1024u + (unsigned)col0; float ss = 0.f;
#pragma unroll
            for (int bj = 0; bj < 2; ++bj) { f32x4 xa, xb; unpack8(*(const u32x4*)(X1B + off + bj * HALF), xa, xb);
                const f32x4 a = xa + acc[ai][bj][m][0], b = xb + acc[ai][bj][m][1]; acc[ai][bj][m][0] = a; acc[ai][bj][m][1] = b;
                ss += (a[0] * a[0] + a[1] * a[1]) + (a[2] * a[2] + a[3] * a[3]) + (b[0] * b[0] + b[1] * b[1]) + (b[2] * b[2] + b[3] * b[3]); }
            ss += __shfl_xor(ss, 16); ss += __shfl_xor(ss, 32);
            if (fq == 0) __hip_atomic_store(SSQ2 + (unsigned)row * 16u + (unsigned)(u.pn * 4 + wc), ss, __ATOMIC_RELAXED, __HIP_MEMORY_SCOPE_AGENT);
        EPI_ROWS_END
        asm volatile("s_waitcnt vmcnt(0)" ::: "memory");
        unsigned* c = cnt + 64 * u.pm;
        if ((threadIdx.x & 63) == 0) __hip_atomic_fetch_add(c, 1u, __ATOMIC_RELAXED, __HIP_MEMORY_SCOPE_AGENT);
        { unsigned sp = 0;
          while ((unsigned)__builtin_amdgcn_readfirstlane(__hip_atomic_load(c, __ATOMIC_RELAXED, __HIP_MEMORY_SCOPE_AGENT)) < 32u) { __builtin_amdgcn_s_sleep(2); if (++sp > (1u << 20)) break; } }
        __builtin_amdgcn_fence(__ATOMIC_ACQUIRE, "agent");
        f32x4 gv[2][2];
#pragma unroll
        for (int bj = 0; bj < 2; ++bj)
#pragma unroll
            for (int n = 0; n < 2; ++n) gv[bj][n] = *(const f32x4*)(gfin + col0 + bj * HALF + 4 * n);
        EPI_ROWS_BEGIN
            const unsigned off = (unsigned)row * 1024u + (unsigned)col0;
            const unsigned long long* sl = (const unsigned long long*)(SSQ2 + (unsigned)row * 16u + (unsigned)(4 * fq));
            const unsigned long long w0 = __hip_atomic_load(sl, __ATOMIC_RELAXED, __HIP_MEMORY_SCOPE_AGENT), w1 = __hip_atomic_load(sl + 1, __ATOMIC_RELAXED, __HIP_MEMORY_SCOPE_AGENT);
            float sq = (__uint_as_float((unsigned)w0) + __uint_as_float((unsigned)(w0 >> 32))) + (__uint_as_float((unsigned)w1) + __uint_as_float((unsigned)(w1 >> 32)));
            sq += __shfl_xor(sq, 16); sq += __shfl_xor(sq, 32);
            const float rs = 1.0f / sqrtf(sq * (1.0f / 1024.0f) + 1e-6f);
#pragma unroll
            for (int bj = 0; bj < 2; ++bj) { *(f32x4*)(OUT + off + bj * HALF) = acc[ai][bj][m][0] * rs * gv[bj][0]; *(f32x4*)(OUT + off + bj * HALF + 4) = acc[ai][bj][m][1] * rs * gv[bj][1]; }
        EPI_ROWS_END
    }
};

template <class Epi, bool ALIGN_EPI, int MID_T = -1>
__device__ __forceinline__ void gemm_phase(PG8_LAS unsigned char* lds, const Gemm g, const StaticOrder& S, const Epi& E) {
    const int tid = threadIdx.x, wid = __builtin_amdgcn_readfirstlane(tid >> 6), lane = tid & 63, wr = wid >> 2, wc = wid & 3, fr = lane & 15, fq = lane >> 4;
    int nt = g.K / BK; asm volatile("" : "+s"(nt));
    unsigned voffA[2], voffB[2];
#pragma unroll
    for (int i = 0; i < 2; ++i) { int R, C; stage_rc(tid * 16 + i * 8192, R, C); const int Rb = (R & ~31) + perm32(R & 31);
        voffA[i] = (unsigned)(R * g.lda + C) * 2u; voffB[i] = (unsigned)(Rb * g.ldb + C) * 2u; }
    const size_t kstep = (size_t)(BK * 2);
    const size_t hstepA = (size_t)HALF * g.lda * 2, hstepB = (size_t)HALF * g.ldb * 2;
    const size_t tstepA = 2 * hstepA, tstepB = 2 * hstepB;
    const unsigned ldsw = (unsigned)wid * 1024u;
    const int aoff = lds_byte(wr * 64 + fr, fq * 8), boff = lds_byte(wc * 32 + fr, fq * 8);
#define PG8_SA(b, h) (((b) * 2 + (h)) * HTB)
#define PG8_SB(b, h) ((4 + (b) * 2 + (h)) * HTB)
#define PG8_STAGE(bufoff, gbase, voff) do { _Pragma("unroll") for (int _i = 0; _i < 2; ++_i) \
        __builtin_amdgcn_global_load_lds((const unsigned*)((const char*)(gbase) + (voff)[_i]), (PG8_LAS unsigned*)(lds + (bufoff) + ldsw + _i * 8192), 16, 0, 0); } while (0)
#define PG8_LDA(dst, b, h) do { _Pragma("unroll") for (int m = 0; m < 4; ++m) _Pragma("unroll") for (int k = 0; k < 2; ++k) dst[m][k] = *(const PG8_LAS bf16x8*)(lds + PG8_SA(b, h) + aoff + m * 2048 + k * 1024); } while (0)
#define PG8_LDB(dst, b, h) do { _Pragma("unroll") for (int n = 0; n < 2; ++n) _Pragma("unroll") for (int k = 0; k < 2; ++k) dst[n][k] = *(const PG8_LAS bf16x8*)(lds + PG8_SB(b, h) + boff + n * 2048 + k * 1024); } while (0)
#define PG8_MMA(ai, bj, At, Bt) do { __builtin_amdgcn_s_setprio(1); _Pragma("unroll") for (int m = 0; m < 4; ++m) _Pragma("unroll") for (int n = 0; n < 2; ++n) _Pragma("unroll") for (int k = 0; k < 2; ++k) \
        acc[ai][bj][m][n] = __builtin_amdgcn_mfma_f32_16x16x32_bf16(Bt[n][k], At[m][k], acc[ai][bj][m][n], 0, 0, 0); __builtin_amdgcn_s_setprio(0); } while (0)
#define PG8_WAIT_V(n) asm volatile("s_waitcnt vmcnt(" #n ")" ::: "memory")
#define PG8_WAIT_L(n) asm volatile("s_waitcnt lgkmcnt(" #n ")" ::: "memory")
#define PG8_BAR __builtin_amdgcn_s_barrier()
#define PG8_SCHED __builtin_amdgcn_sched_barrier(0)
    Unit cur, nxt; int ui = 0;
    if (!S.next(0, cur)) return;
    f32x4 acc[2][2][4][2];
#pragma unroll
    for (int a = 0; a < 2; ++a)
#pragma unroll
        for (int b = 0; b < 2; ++b)
#pragma unroll
            for (int m = 0; m < 4; ++m)
#pragma unroll
                for (int n = 0; n < 2; ++n) acc[a][b][m][n] = (f32x4){0.f, 0.f, 0.f, 0.f};
    bf16x8 At[4][2], B0[2][2], B1[2][2];
    const char* cA = (const char*)g.A + (size_t)cur.pm * tstepA + (size_t)((cur.pn >> g.ash) * g.amul) * 2; const char* cB = (const char*)g.Bt + (size_t)cur.pn * tstepB;
    PG8_STAGE(PG8_SB(0, 0), cB, voffB); PG8_STAGE(PG8_SB(0, 1), cB + hstepB, voffB); PG8_STAGE(PG8_SA(0, 0), cA, voffA); PG8_STAGE(PG8_SA(0, 1), cA + hstepA, voffA);
    if (wr == 1) PG8_BAR;
    PG8_WAIT_V(2); PG8_BAR;
    PG8_STAGE(PG8_SB(1, 0), cB + kstep, voffB); PG8_STAGE(PG8_SA(1, 0), cA + kstep, voffA); PG8_STAGE(PG8_SB(1, 1), cB + hstepB + kstep, voffB);
    PG8_WAIT_V(6); PG8_BAR;
    for (;;) {
        const bool has_next = S.next(ui + 1, nxt);
        const char* nA = has_next ? (const char*)g.A + (size_t)nxt.pm * tstepA + (size_t)((nxt.pn >> g.ash) * g.amul) * 2 : cA; const char* nB = has_next ? (const char*)g.Bt + (size_t)nxt.pn * tstepB : cB;
        for (int t = 0; t < nt; t += 2) {
            const bool last = (t == nt - 2);
            if constexpr (MID_T >= 0) { if (t == MID_T) E.mid(acc, cur, wr, wc, fr, fq); }
            const char* a1 = cA + (size_t)(t + 1) * kstep;
            const char* a2 = last ? nA : cA + (size_t)(t + 2) * kstep; const char* b2 = last ? nB : cB + (size_t)(t + 2) * kstep;
            const char* a3 = a2 + kstep; const char* b3 = b2 + kstep;
            PG8_LDB(B0, 0, 0); PG8_LDB(B1, 0, 1); PG8_SCHED; PG8_LDA(At, 0, 0); PG8_STAGE(PG8_SA(1, 1), a1 + hstepA, voffA);
            PG8_WAIT_V(8); PG8_WAIT_L(0); PG8_BAR; PG8_MMA(0, 0, At, B0); PG8_MMA(0, 1, At, B1); PG8_BAR; PG8_SCHED;
            PG8_LDA(At, 0, 1); PG8_STAGE(PG8_SB(0, 0), b2, voffB); PG8_STAGE(PG8_SB(0, 1), b2 + hstepB, voffB); PG8_STAGE(PG8_SA(0, 0), a2, voffA);
            PG8_WAIT_V(8); PG8_WAIT_L(0); PG8_BAR; PG8_MMA(1, 0, At, B0); PG8_MMA(1, 1, At, B1); PG8_BAR; PG8_SCHED;
            PG8_LDB(B0, 1, 0); PG8_LDB(B1, 1, 1); PG8_SCHED; PG8_LDA(At, 1, 0); PG8_STAGE(PG8_SA(0, 1), a2 + hstepA, voffA);
            PG8_WAIT_V(8); PG8_WAIT_L(0); PG8_BAR; PG8_MMA(0, 0, At, B0); PG8_MMA(0, 1, At, B1); PG8_BAR; PG8_SCHED;
            PG8_LDA(At, 1, 1); PG8_STAGE(PG8_SB(1, 0), b3, voffB); PG8_STAGE(PG8_SB(1, 1), b3 + hstepB, voffB); PG8_STAGE(PG8_SA(1, 0), a3, voffA);
            PG8_WAIT_V(8); PG8_WAIT_L(0); PG8_BAR; PG8_MMA(1, 0, At, B0); PG8_MMA(1, 1, At, B1); PG8_BAR; PG8_SCHED;
        }
        if constexpr (ALIGN_EPI) { if (wr == 0) PG8_BAR; }
        E.template run<2>(acc, cur, wr, wc, fr, fq);
        if (!has_next) break;
#pragma unroll
        for (int a = 0; a < 2; ++a)
#pragma unroll
            for (int b = 0; b < 2; ++b)
#pragma unroll
                for (int m = 0; m < 4; ++m)
#pragma unroll
                    for (int n = 0; n < 2; ++n) acc[a][b][m][n] = (f32x4){0.f, 0.f, 0.f, 0.f};
        cur = nxt; cA = nA; cB = nB; ++ui;
        if constexpr (ALIGN_EPI) { if (wr == 1) PG8_BAR; }
    }
    PG8_WAIT_V(0);
    if constexpr (!ALIGN_EPI) { if (wr == 0) PG8_BAR; }
    PG8_BAR;
#undef PG8_SA
#undef PG8_SB
#undef PG8_STAGE
#undef PG8_LDA
#undef PG8_LDB
#undef PG8_MMA
#undef PG8_WAIT_V
#undef PG8_WAIT_L
#undef PG8_BAR
#undef PG8_SCHED
}

template <class Epi>
__device__ __forceinline__ void gemm_half(PG8_LAS unsigned char* lds, const Gemm g, const Unit u, const Epi& E) {
    const int tid = threadIdx.x, wid = __builtin_amdgcn_readfirstlane(tid >> 6), lane = tid & 63, wr = wid >> 2, wc = wid & 3, fr = lane & 15, fq = lane >> 4;
    int nt = g.K / BK; asm volatile("" : "+s"(nt));
    unsigned voffA[2], voffB[2];
#pragma unroll
    for (int i = 0; i < 2; ++i) { int R, C; stage_rc(tid * 16 + i * 8192, R, C); const int Rb = (R & ~31) + perm32(R & 31);
        voffA[i] = (unsigned)(R * g.lda + C) * 2u; voffB[i] = (unsigned)(Rb * g.ldb + C) * 2u; }
    const size_t kstep = (size_t)(BK * 2);
    const size_t hstepA = (size_t)HALF * g.lda * 2, hstepB = (size_t)HALF * g.ldb * 2;
    const unsigned ldsw = (unsigned)wid * 1024u;
    const int aoff = lds_byte(wr * 64 + fr, fq * 8), boff = lds_byte(wc * 32 + fr, fq * 8);
#define PG8_SA(b, h) (((b) * 2 + (h)) * HTB)
#define PG8_SB(b, h) ((4 + (b) * 2 + (h)) * HTB)
#define PG8_STAGE(bufoff, gbase, voff) do { _Pragma("unroll") for (int _i = 0; _i < 2; ++_i) \
        __builtin_amdgcn_global_load_lds((const unsigned*)((const char*)(gbase) + (voff)[_i]), (PG8_LAS unsigned*)(lds + (bufoff) + ldsw + _i * 8192), 16, 0, 0); } while (0)
#define PG8_LDA(dst, b, h) do { _Pragma("unroll") for (int m = 0; m < 4; ++m) _Pragma("unroll") for (int k = 0; k < 2; ++k) dst[m][k] = *(const PG8_LAS bf16x8*)(lds + PG8_SA(b, h) + aoff + m * 2048 + k * 1024); } while (0)
#define PG8_LDB(dst, b, h) do { _Pragma("unroll") for (int n = 0; n < 2; ++n) _Pragma("unroll") for (int k = 0; k < 2; ++k) dst[n][k] = *(const PG8_LAS bf16x8*)(lds + PG8_SB(b, h) + boff + n * 2048 + k * 1024); } while (0)
#define PG8_MMA(ai, bj, At, Bt) do { __builtin_amdgcn_s_setprio(1); _Pragma("unroll") for (int m = 0; m < 4; ++m) _Pragma("unroll") for (int n = 0; n < 2; ++n) _Pragma("unroll") for (int k = 0; k < 2; ++k) \
        acc[ai][bj][m][n] = __builtin_amdgcn_mfma_f32_16x16x32_bf16(Bt[n][k], At[m][k], acc[ai][bj][m][n], 0, 0, 0); __builtin_amdgcn_s_setprio(0); } while (0)
#define PG8_WAIT_V(n) asm volatile("s_waitcnt vmcnt(" #n ")" ::: "memory")
#define PG8_WAIT_L(n) asm volatile("s_waitcnt lgkmcnt(" #n ")" ::: "memory")
#define PG8_BAR __builtin_amdgcn_s_barrier()
#define PG8_SCHED __builtin_amdgcn_sched_barrier(0)
    f32x4 acc[2][2][4][2];
#pragma unroll
    for (int a = 0; a < 2; ++a)
#pragma unroll
        for (int b = 0; b < 2; ++b)
#pragma unroll
            for (int m = 0; m < 4; ++m)
#pragma unroll
                for (int n = 0; n < 2; ++n) acc[a][b][m][n] = (f32x4){0.f, 0.f, 0.f, 0.f};
    bf16x8 At[4][2], B0[2][2], B1[2][2];
    const char* cA = (const char*)g.A + ((size_t)u.pm * BM + u.rh) * g.lda * 2 + (size_t)((u.pn >> g.ash) * g.amul) * 2; const char* cB = (const char*)g.Bt + (size_t)u.pn * 2 * hstepB;
    PG8_STAGE(PG8_SB(0, 0), cB, voffB); PG8_STAGE(PG8_SB(0, 1), cB + hstepB, voffB); PG8_STAGE(PG8_SA(0, 0), cA, voffA);
    PG8_STAGE(PG8_SB(1, 0), cB + kstep, voffB); PG8_STAGE(PG8_SB(1, 1), cB + hstepB + kstep, voffB); PG8_STAGE(PG8_SA(1, 0), cA + kstep, voffA);
    PG8_WAIT_V(6); PG8_BAR;
#define PG8_HALF_STEP(b, tt) do { \
        PG8_LDB(B0, b, 0); PG8_LDB(B1, b, 1); PG8_LDA(At, b, 0); PG8_WAIT_L(0); PG8_BAR; PG8_SCHED; \
        const bool more_ = (tt) + 2 < nt; \
        if (more_) { const char* b2 = cB + (size_t)((tt) + 2) * kstep; const char* a2 = cA + (size_t)((tt) + 2) * kstep; \
            PG8_STAGE(PG8_SB(b, 0), b2, voffB); PG8_STAGE(PG8_SB(b, 1), b2 + hstepB, voffB); PG8_STAGE(PG8_SA(b, 0), a2, voffA); } \
        PG8_MMA(0, 0, At, B0); PG8_MMA(0, 1, At, B1); \
        if (more_) PG8_WAIT_V(6); else PG8_WAIT_V(0); \
        PG8_BAR; PG8_SCHED; } while (0)
    for (int t = 0; t < nt; t += 2) { PG8_HALF_STEP(0, t); PG8_HALF_STEP(1, t + 1); }
    E.template run<1>(acc, u, wr, wc, fr, fq);
    PG8_BAR;
#undef PG8_HALF_STEP
#undef PG8_SA
#undef PG8_SB
#undef PG8_STAGE
#undef PG8_LDA
#undef PG8_LDB
#undef PG8_MMA
#undef PG8_WAIT_V
#undef PG8_WAIT_L
#undef PG8_BAR
#undef PG8_SCHED
}
}

constexpr int NWAVES = 8, NTHR = 512;
constexpr int M = 16384, SEQ = 4096, NB = 4, D = 1024, DPOOL = 512, DRNN = 1024, DIN = 4608, DFF = 2816;
constexpr float EPS = 1e-6f;
constexpr int NPH = 11;
constexpr int SCAN_T = 128, SCAN_NC = SEQ / SCAN_T;

constexpr size_t MiB = 1u << 20;
constexpr size_t WS_SP8 = 512 * 1024;
constexpr size_t WS_SSQ = 1 * MiB;
constexpr size_t WS_SSQ2 = 2 * MiB;
constexpr size_t WS_CS = 2 * MiB, WS_CH = 3 * MiB;
constexpr size_t WS_WIN = 4 * MiB;
constexpr size_t WS_WFI = 13 * MiB;
constexpr size_t WS_WFO = 24 * MiB;
constexpr size_t WS_WCAT = WS_WFO + 5632 * 1024;
constexpr size_t WS_WO = WS_WCAT + 3 * MiB;
constexpr size_t WS_WGRP = WS_WO + 2 * MiB;
constexpr size_t WS_WGATE = WS_WGRP + MiB / 4;
constexpr size_t WS_R1 = 36 * MiB;
constexpr size_t WS_R2 = 68 * MiB;
constexpr size_t WS_R3 = 84 * MiB;
constexpr size_t WS_R4 = 116 * MiB;
constexpr size_t WS_R7 = 148 * MiB;
constexpr size_t WS_R8 = 164 * MiB;
constexpr size_t WS_CAT = 196 * MiB;
constexpr size_t WS_MIXB = 148 * MiB;
constexpr size_t WS_ACT = 68 * MiB;
constexpr size_t WS_END = 244 * MiB;

constexpr int LDS_BYTES = 147456;

#define LAS __attribute__((address_space(3)))
typedef unsigned short bf16;
typedef unsigned v4u __attribute__((ext_vector_type(4)));
typedef unsigned v2u __attribute__((ext_vector_type(2)));
typedef float f32x4 __attribute__((ext_vector_type(4)));
typedef float f32x2 __attribute__((ext_vector_type(2)));
#define LDS_WAIT() asm volatile("s_waitcnt lgkmcnt(0)" ::: "memory")
using pg8::cvt_pk_bf16; using pg8::bf_lo; using pg8::bf_hi;

struct Args { const float* in[19]; float* out; unsigned char* ws; int ph_lo, ph_hi; };
enum { I_X = 0, I_NORM_MIX, I_W_IN, I_W_GRP, I_POOL_SCALE, I_W_POOL_OUT, I_CONV_W, I_CONV_B, I_W_RG_A, I_B_RG_A, I_W_RG_X, I_B_RG_X, I_LAMBDA, I_W_RNN_OUT, I_W_O, I_NORM_FFN, I_W_FFN_IN, I_W_FFN_OUT, I_NORM_FINAL };

__device__ __forceinline__ float wave_sum(float v) {
#pragma unroll
    for (int o = 1; o < 64; o <<= 1) v += __shfl_xor(v, o);
    return v;
}

__device__ __forceinline__ void transpose_item(const float* W, int Nsrc, int Kdst, bf16* WT, int k0, int n_src0, int n_dst0, const float* kscale, LAS float* scr, int lane) {
    f32x4 v[8]; const int n4 = (lane & 7) * 4;
#pragma unroll
    for (int i = 0; i < 8; ++i) { const int kk = 8 * i + (lane >> 3); v[i] = *(const f32x4*)(W + (size_t)(k0 + kk) * Nsrc + n_src0 + n4); }
    if (kscale) {
#pragma unroll
        for (int i = 0; i < 8; ++i) v[i] = v[i] * kscale[k0 + 8 * i + (lane >> 3)]; }
#pragma unroll
    for (int i = 0; i < 8; ++i) { const int kk = 8 * i + (lane >> 3);
#pragma unroll
        for (int j = 0; j < 4; ++j) scr[kk * 33 + n4 + j] = v[i][j]; }
    LDS_WAIT(); asm volatile("" ::: "memory");
    const int c = lane & 7;
#pragma unroll
    for (int j = 0; j < 4; ++j) { const int n = (lane >> 3) + 8 * j; const LAS float* s = scr + (8 * c) * 33 + n;
        v4u o; o.x = cvt_pk_bf16(s[0 * 33], s[1 * 33]); o.y = cvt_pk_bf16(s[2 * 33], s[3 * 33]); o.z = cvt_pk_bf16(s[4 * 33], s[5 * 33]); o.w = cvt_pk_bf16(s[6 * 33], s[7 * 33]);
        *(v4u*)(WT + (size_t)(n_dst0 + n) * Kdst + k0 + 8 * c) = o; }
    LDS_WAIT(); asm volatile("" ::: "memory");
}

#define XB_TMO      128
#define XB_XCNT(j)  (256  + 64 * (j))
#define XB_XSUB(j)  (1280 + 64 * (j))
#define XB_XGEN(j)  (2304 + 64 * (j))
#define XB_TOP      3328
#define XB_TOPGEN   3392
#define XCD_BAR_WORDS 3456
#define XB_SPIN_CAP (1u << 18)
__device__ __forceinline__ unsigned xb_ld(unsigned* p)              { return __hip_atomic_load(p, __ATOMIC_RELAXED, __HIP_MEMORY_SCOPE_AGENT); }
__device__ __forceinline__ unsigned xb_add(unsigned* p, unsigned v) { return __hip_atomic_fetch_add(p, v, __ATOMIC_RELAXED, __HIP_MEMORY_SCOPE_AGENT); }
__device__ __forceinline__ unsigned xb_xcc_id() { return (unsigned)__builtin_amdgcn_s_getreg((3 << 11) | 20) & 0xFu; }
#define XB_SPIN(cond, bar) do { unsigned _sp = 0; while (cond) { __builtin_amdgcn_s_sleep(1); \
    if ((++_sp & 255u) == 0u) { if (xb_ld(&(bar)[XB_TMO])) break; if (_sp > XB_SPIN_CAP) { atomicAdd(&(bar)[XB_TMO], 1u); break; } } } } while (0)
struct XcdBarrier { unsigned* bar; unsigned x; volatile LAS unsigned* st; };
__device__ __forceinline__ XcdBarrier xcd_barrier_post(unsigned* bar, volatile LAS unsigned* st) {
    XcdBarrier b; b.bar = bar; b.x = xb_xcc_id(); b.st = st;
    if (threadIdx.x == 0) (void)xb_add(&bar[XB_XCNT(b.x)], 1u);
    return b;
}
__device__ __forceinline__ void xcd_barrier_complete(unsigned* bar, unsigned x, unsigned& nloc, unsigned& nx) {
    const unsigned G = gridDim.x * gridDim.y * gridDim.z;
    unsigned sum, cnt, mine, sp = 0u;
    for (;;) {
        sum = 0u; cnt = 0u; mine = 0u;
#pragma unroll
        for (unsigned j = 0; j < 16; ++j) { const unsigned c = xb_ld(&bar[XB_XCNT(j)]); sum += c; cnt += (c > 0u) ? 1u : 0u; mine = (j == x) ? c : mine; }
        if (sum == G) break;
        __builtin_amdgcn_s_sleep(1);
        if ((++sp & 255u) == 0u) { if (xb_ld(&bar[XB_TMO])) break; if (sp > XB_SPIN_CAP) { atomicAdd(&bar[XB_TMO], 1u); break; } }
    }
    nloc = mine > 0u ? mine : 1u; nx = cnt > 0u ? cnt : 1u;
}
__device__ __forceinline__ void xcd_barrier(const XcdBarrier& b) {
    asm volatile("s_waitcnt vmcnt(0)" ::: "memory");
    __syncthreads();
    if (threadIdx.x == 0) {
        unsigned* bar = b.bar;
        __builtin_amdgcn_s_waitcnt(0);
        unsigned nloc = b.st[0], nx = b.st[1];
        if (nloc == 0u) { xcd_barrier_complete(bar, b.x, nloc, nx); b.st[0] = nloc; b.st[1] = nx; }
        const unsigned old = xb_add(&bar[XB_XSUB(b.x)], 1u);
        const unsigned gen = old / nloc;
        if (old + 1u == (gen + 1u) * nloc) {
            __builtin_amdgcn_fence(__ATOMIC_RELEASE, "agent");
            asm volatile("s_waitcnt vmcnt(0)" ::: "memory");
            const unsigned og = xb_add(&bar[XB_TOP], 1u);
            const unsigned tg = og / nx;
            if (og + 1u == (tg + 1u) * nx) xb_add(&bar[XB_TOPGEN], 1u);
            else XB_SPIN(xb_ld(&bar[XB_TOPGEN]) == tg, bar);
            __builtin_amdgcn_fence(__ATOMIC_ACQUIRE, "agent");
            xb_add(&bar[XB_XGEN(b.x)], 1u);
            asm volatile("s_waitcnt vmcnt(0)" ::: "memory");
        } else {
            XB_SPIN(xb_ld(&bar[XB_XGEN(b.x)]) == gen, bar);
            __builtin_amdgcn_fence(__ATOMIC_ACQUIRE, "agent");
            asm volatile("s_waitcnt vmcnt(0)" ::: "memory");
        }
    }
    __syncthreads();
}

template <int W>
__device__ __forceinline__ void pool_item(const bf16* src, bf16* dst, int tl) {
    v4u rw[W + 7];
#pragma unroll
    for (int k = 0; k < W + 7; ++k) rw[k] = (tl + k - (W - 1) >= 0) ? *(const v4u*)(src + (ptrdiff_t)(k - (W - 1)) * DPOOL) : (v4u){0u, 0u, 0u, 0u};
    f32x4 s0 = {0.f, 0.f, 0.f, 0.f}, s1 = s0;
#pragma unroll
    for (int k = 0; k < W - 1; ++k) { f32x4 a, c; pg8::unpack8(rw[k], a, c); s0 += a; s1 += c; }
#pragma unroll
    for (int i = 0; i < 8; ++i) { f32x4 a, c; pg8::unpack8(rw[W - 1 + i], a, c); s0 += a; s1 += c;
        const int t = tl + i; const int cnt = (t + 1 < W) ? t + 1 : W; const float inv = 1.0f / (float)cnt;
        *(v4u*)(dst + (size_t)i * DPOOL) = pg8::pack8(s0 * inv - a, s1 * inv - c);
        f32x4 a2, c2; pg8::unpack8(rw[i], a2, c2); s0 -= a2; s1 -= c2; }
}
__device__ __forceinline__ void scan_local16(const bf16* lap, const bf16* bbp, f32x4 (&S)[2], f32x4 (&H)[2]) {
    S[0] = S[1] = H[0] = H[1] = (f32x4){0.f, 0.f, 0.f, 0.f};
#pragma unroll
    for (int i0 = 0; i0 < 16; i0 += 8) { v4u lw[8], bw[8];
#pragma unroll
        for (int i = 0; i < 8; ++i) { lw[i] = *(const v4u*)(lap + (size_t)(i0 + i) * DRNN); bw[i] = *(const v4u*)(bbp + (size_t)(i0 + i) * DRNN); }
#pragma unroll
        for (int i = 0; i < 8; ++i) { f32x4 l[2], bq[2]; pg8::unpack8(lw[i], l[0], l[1]); pg8::unpack8(bw[i], bq[0], bq[1]);
#pragma unroll
            for (int n = 0; n < 2; ++n)
#pragma unroll
                for (int j = 0; j < 4; ++j) { H[n][j] = __expf(l[n][j]) * H[n][j] + bq[n][j]; S[n][j] += l[n][j]; } } }
}

__global__ void __launch_bounds__(NTHR, 2) fwd_kernel(Args args) {
    extern __shared__ __attribute__((aligned(16))) unsigned char lds_raw[];
    LAS unsigned char* lds = (LAS unsigned char*)lds_raw;
    const int tid = threadIdx.x, lane = tid & 63, wave = __builtin_amdgcn_readfirstlane(tid >> 6);
    const int G = gridDim.x, bx = blockIdx.x;
    unsigned char* ws = args.ws;
    const int lo = args.ph_lo, hi = args.ph_hi;
#ifndef PHASE_MASK
#define PHASE_MASK 0x7ff
#endif
#define IN(k) (((PHASE_MASK >> (k)) & 1) && lo <= (k) && (k) < hi)
#ifndef REPEAT_MASK
#define REPEAT_MASK 0
#endif
#define REPS(k) (((REPEAT_MASK >> (k)) & 1) ? 2 : 1)
#ifndef PROBE_PHASE
#define PROBE_PHASE -1
#endif
#define PROBE_MULT 4
    unsigned long long tp0 = 0, tp1 = 0;
#define TSTART(k) do { if ((k) == PROBE_PHASE) tp0 = __builtin_amdgcn_s_memrealtime(); } while (0)
#define TEND(k) do { if ((k) == PROBE_PHASE) tp1 = __builtin_amdgcn_s_memrealtime(); } while (0)
#define GSYNC() xcd_barrier(bar)
#define SEAM(k) do { if (IN(k) && IN((k) + 1)) { GSYNC(); } } while (0)

    const float* x = args.in[I_X];
    bf16* WIN = (bf16*)(ws + WS_WIN); bf16* WFI = (bf16*)(ws + WS_WFI); bf16* WFO = (bf16*)(ws + WS_WFO); bf16* WCAT = (bf16*)(ws + WS_WCAT);
    bf16* WO = (bf16*)(ws + WS_WO); bf16* WGRP = (bf16*)(ws + WS_WGRP); bf16* WGATE = (bf16*)(ws + WS_WGATE);
    bf16* XN = (bf16*)(ws + WS_R1); bf16* X1B = XN;
    bf16* CAT = (bf16*)(ws + WS_CAT); bf16* V = CAT + 512;
    bf16* UP = (bf16*)(ws + WS_R2);
    bf16* UR = (bf16*)(ws + WS_R3); bf16* LA = UR;
    bf16* UG = (bf16*)(ws + WS_R4);
    bf16* POOLED = (bf16*)(ws + WS_R7); bf16* BB = (bf16*)(ws + WS_R8);
    bf16* MIXB = (bf16*)(ws + WS_MIXB); bf16* ACT = (bf16*)(ws + WS_ACT);
    float* SSQ = (float*)(ws + WS_SSQ); float* CS = (float*)(ws + WS_CS); float* CH = (float*)(ws + WS_CH);
    bf16* G0 = (bf16*)args.out; bf16* G1 = G0 + (size_t)M * 1024;
    float* X1 = args.out;

#ifndef EXTRA_SYNCS
#define EXTRA_SYNCS 0
#endif
    if (PROBE_PHASE == 99) tp0 = __builtin_amdgcn_s_memrealtime();
    volatile LAS unsigned* MISC = (volatile LAS unsigned*)(lds + 131072 + 1024);
    if (tid < 32) MISC[tid] = 0u;
    __syncthreads();
    XcdBarrier bar = xcd_barrier_post((unsigned*)ws, MISC + 8);
    if (lo < 0) cg::this_grid().sync();
    for (int i = 0; i < EXTRA_SYNCS; ++i) GSYNC();
    TSTART(0);
    if (IN(0)) for (int rep = 0; rep < REPS(0); ++rep) { if (rep) GSYNC();
        LAS float* scr = (LAS float*)(lds + wave * 16384);
        const int gw = bx * NWAVES + wave, NGW = G * NWAVES;
        constexpr int I_IN = 16 * (DIN / 32), I_FI = 16 * (2 * DFF / 32), I_FO = (DFF / 64) * (D / 32), I_RO = 16 * 32, I_WO = 16 * 32, I_PO = 8 * 32;
        constexpr int NITEMS = I_IN + I_FI + I_FO + I_RO + I_WO + I_PO;
        for (int it = gw; it < NITEMS; it += NGW) {
            int r = it;
            if (r < I_IN) { const int nblk = DIN / 32, kb = r / nblk, nb = r % nblk, nd = 32 * nb; int ns = nd;
                if (nd >= 2560) { const int q = nd - 2560, pq = q >> 8, j0 = q & 255; ns = 2560 + (j0 < 128 ? 128 * pq + j0 : 1024 + 128 * pq + (j0 - 128)); }
                transpose_item(args.in[I_W_IN], DIN, D, WIN, 64 * kb, ns, nd, nullptr, scr, lane); continue; } r -= I_IN;
            if (r < I_FI) { const int nblk = 2 * DFF / 32, kb = r / nblk, nb = r % nblk, nd = 32 * nb, pn = nd >> 8, j0 = nd & 255;
                const int ns = j0 < 128 ? 128 * pn + j0 : DFF + 128 * pn + (j0 - 128);
                transpose_item(args.in[I_W_FFN_IN], 2 * DFF, D, WFI, 64 * kb, ns, nd, args.in[I_NORM_FFN], scr, lane); continue; } r -= I_FI;
            if (r < I_FO) { const int nblk = D / 32, kb = r / nblk, nb = r % nblk; transpose_item(args.in[I_W_FFN_OUT], D, DFF, WFO, 64 * kb, 32 * nb, 32 * nb, nullptr, scr, lane); continue; } r -= I_FO;
            if (r < I_RO) { const int nblk = D / 32, kb = r / nblk, nb = r % nblk; transpose_item(args.in[I_W_RNN_OUT], D, 1536, WCAT + 512, 64 * kb, 32 * nb, 32 * nb, nullptr, scr, lane); continue; } r -= I_RO;
            if (r < I_WO) { const int nblk = D / 32, kb = r / nblk, nb = r % nblk; transpose_item(args.in[I_W_O], D, D, WO, 64 * kb, 32 * nb, 32 * nb, nullptr, scr, lane); continue; } r -= I_WO;
            { const int nblk = D / 32, kb = r / nblk, nb = r % nblk; transpose_item(args.in[I_W_POOL_OUT], D, 1536, WCAT, 64 * kb, 32 * nb, 32 * nb, nullptr, scr, lane); }
        }
        {
            const int gt = bx * NTHR + tid, NT = G * NTHR;
            const float* wg = args.in[I_W_GRP];
            for (int e = gt; e < 512 * 32; e += NT) { const int n = e >> 5, kc = (e & 31) * 8, g = n >> 7, nn = n & 127; float v[8];
#pragma unroll
                for (int j = 0; j < 8; ++j) { const int kk = kc + j - (g & 1) * 128; v[j] = (kk >= 0 && kk < 128) ? wg[((size_t)g * 128 + kk) * 128 + nn] : 0.f; }
                v4u o; o.x = cvt_pk_bf16(v[0], v[1]); o.y = cvt_pk_bf16(v[2], v[3]); o.z = cvt_pk_bf16(v[4], v[5]); o.w = cvt_pk_bf16(v[6], v[7]);
                *(v4u*)(WGRP + (size_t)n * 256 + kc) = o; }
            const float* wa = args.in[I_W_RG_A]; const float* wx = args.in[I_W_RG_X];
            for (int e = gt; e < 2048 * 16; e += NT) { const int n = e >> 4, kc = (e & 15) * 8, h = n >> 8, j = n & 255; const float* src = j < 128 ? wa : wx; const int jj = j & 127; float v[8];
#pragma unroll
                for (int q = 0; q < 8; ++q) v[q] = src[((size_t)h * 128 + kc + q) * 128 + jj];
                v4u o; o.x = cvt_pk_bf16(v[0], v[1]); o.y = cvt_pk_bf16(v[2], v[3]); o.z = cvt_pk_bf16(v[4], v[5]); o.w = cvt_pk_bf16(v[6], v[7]);
                *(v4u*)(WGATE + (size_t)n * 128 + kc) = o; }
        }
        { const int gt = bx * NTHR + tid; if (gt < DRNN) { const float z = -args.in[I_LAMBDA][gt]; ((float*)(ws + WS_SP8))[gt] = -8.0f * (fmaxf(z, 0.f) + log1pf(expf(-fabsf(z)))); } }
        const float* gmix = args.in[I_NORM_MIX];
        f32x4 gv[4];
#pragma unroll
        for (int j = 0; j < 4; ++j) gv[j] = ((const f32x4*)gmix)[lane + 64 * j];
        for (int m = gw; m < M; m += 2 * NGW) {
            const int m1 = (m + NGW < M) ? m + NGW : m;
            const f32x4* xr0 = (const f32x4*)(x + (size_t)m * D) + lane; const f32x4* xr1 = (const f32x4*)(x + (size_t)m1 * D) + lane; f32x4 v0[4], v1[4]; float s0 = 0.f, s1 = 0.f;
#pragma unroll
            for (int j = 0; j < 4; ++j) { v0[j] = xr0[64 * j]; v1[j] = xr1[64 * j]; }
#pragma unroll
            for (int j = 0; j < 4; ++j) { s0 += (v0[j].x * v0[j].x + v0[j].y * v0[j].y) + (v0[j].z * v0[j].z + v0[j].w * v0[j].w); s1 += (v1[j].x * v1[j].x + v1[j].y * v1[j].y) + (v1[j].z * v1[j].z + v1[j].w * v1[j].w); }
            const float rs0 = 1.0f / sqrtf(wave_sum(s0) * (1.f / D) + EPS), rs1 = 1.0f / sqrtf(wave_sum(s1) * (1.f / D) + EPS);
            v2u* o0 = (v2u*)(XN + (size_t)m * D) + lane; v2u* o1 = (v2u*)(XN + (size_t)m1 * D) + lane;
#pragma unroll
            for (int j = 0; j < 4; ++j) { const f32x4 y0 = v0[j] * rs0 * gv[j], y1 = v1[j] * rs1 * gv[j]; v2u w0, w1; w0.x = cvt_pk_bf16(y0.x, y0.y); w0.y = cvt_pk_bf16(y0.z, y0.w); w1.x = cvt_pk_bf16(y1.x, y1.y); w1.y = cvt_pk_bf16(y1.z, y1.w); o0[64 * j] = w0; o1[64 * j] = w1; }
        }
        __syncthreads();
    }
    SEAM(0);
    TEND(0);

    TSTART(1);
    if (IN(1)) for (int rep = 0; rep < REPS(1); ++rep) { if (rep) GSYNC();
        pg8::Gemm g{XN, WIN, M, 4096, D, D, D, 0, 0}; pg8::StaticOrder S; S.init(M, 4096, G, bx);
        pg8::EpiProj E{UP, UR, UG, G0, G1, 0};
        pg8::gemm_phase<pg8::EpiProj, true>(lds, g, S, E);
    }
    SEAM(1);
    TEND(1);

    TSTART(2);
    if (IN(2)) for (int rep = 0; rep < REPS(2); ++rep) { if (rep) GSYNC();
        { const int gw = bx * NWAVES + wave, NGW = G * NWAVES;
          for (int wi = gw; wi < (M / 32) * 4; wi += NGW) { const int g = wi & 3, t0 = (wi >> 2) * 32 + (lane >> 4) * 8, co = g * 16 + (lane & 15);
              const bf16* src = UP + (size_t)t0 * DPOOL + co * 8; bf16* dst = POOLED + (size_t)t0 * DPOOL + co * 8; const int tl = t0 & (SEQ - 1);
              if (g == 0) pool_item<2>(src, dst, tl); else if (g == 1) pool_item<4>(src, dst, tl); else if (g == 2) pool_item<8>(src, dst, tl); else pool_item<16>(src, dst, tl); } }
        { const int gt = bx * NTHR + tid, NT = G * NTHR;
          for (int it = gt; it < (M / 8) * 128; it += NT) { const int co = it & 127, t0 = (it >> 7) * 8, tl = t0 & (SEQ - 1);
              const bf16* src = UR + (size_t)t0 * DRNN + co * 8; bf16* dst = V + (size_t)t0 * 1536 + co * 8;
              const float* cw = args.in[I_CONV_W] + co * 8; const float* cb = args.in[I_CONV_B] + co * 8;
              v4u rw[11];
#pragma unroll
              for (int k = 0; k < 11; ++k) rw[k] = (k >= 3 || tl != 0) ? *(const v4u*)(src + (ptrdiff_t)(k - 3) * DRNN) : (v4u){0u, 0u, 0u, 0u};
              f32x4 w0[2], w1[2], w2[2], w3[2], bb[2];
#pragma unroll
              for (int n = 0; n < 2; ++n) { w0[n] = *(const f32x4*)(cw + 4 * n); w1[n] = *(const f32x4*)(cw + 1024 + 4 * n); w2[n] = *(const f32x4*)(cw + 2048 + 4 * n); w3[n] = *(const f32x4*)(cw + 3072 + 4 * n); bb[n] = *(const f32x4*)(cb + 4 * n); }
#pragma unroll
              for (int i = 0; i < 8; ++i) { f32x4 a[2], b[2], c[2], d[2]; pg8::unpack8(rw[i], a[0], a[1]); pg8::unpack8(rw[i + 1], b[0], b[1]); pg8::unpack8(rw[i + 2], c[0], c[1]); pg8::unpack8(rw[i + 3], d[0], d[1]);
                  *(v4u*)(dst + (size_t)i * 1536) = pg8::pack8(bb[0] + w0[0] * a[0] + w1[0] * b[0] + w2[0] * c[0] + w3[0] * d[0], bb[1] + w0[1] * a[1] + w1[1] * b[1] + w2[1] * c[1] + w3[1] * d[1]); }
          } }
    }
    SEAM(2);
    TEND(2);

    TSTART(3);
    if (IN(3)) for (int rep = 0; rep < REPS(3); ++rep) { if (rep) GSYNC();
        const bool uneven = (G == 256);
        {
          pg8::Gemm g{XN, WIN + (size_t)4096 * D, M, 512, D, D, D, 0, 0}; pg8::StaticOrder S; S.init(M, 512, G, bx);
          pg8::EpiProj E{UP, UR, UG, G0, G1, 16};
          pg8::gemm_phase<pg8::EpiProj, true>(lds, g, S, E); }
        { pg8::Gemm g{POOLED, WGRP, M, 512, 256, 512, 256, 0, 256}; pg8::StaticOrder S; S.init(M, 512, G, (bx + G / 2) % G);
          pg8::EpiGrp E{CAT, 1536, args.in[I_POOL_SCALE]};
          pg8::gemm_phase<pg8::EpiGrp, true>(lds, g, S, E); }
        { pg8::Gemm g{V, WGATE, M, 2048, 128, 1536, 128, 0, 128}; pg8::StaticOrder S; S.init(M, 2048, G, bx);
          if (uneven) { if (bx < 128) { S.lin_base = bx; S.lin_cnt = 1; } else { S.lin_base = 128 + (bx - 128) * 3; S.lin_cnt = 3; } }
          pg8::EpiGate E{V, LA, BB, args.in[I_B_RG_A], args.in[I_B_RG_X], (const float*)(ws + WS_SP8)};
          pg8::gemm_phase<pg8::EpiGate, true>(lds, g, S, E); }
    }
    SEAM(3);
    TEND(3);

    TSTART(4);
    TEND(4);

    TSTART(5);
    if (IN(5)) for (int rep = 0; rep < REPS(5); ++rep) { if (rep) GSYNC();
        LAS float* PAS = (LAS float*)lds; LAS float* PAH = PAS + 8 * 512; LAS float* PBS = PAH + 8 * 512; LAS float* PBH = PBS + 8 * 512;
        unsigned* flags = (unsigned*)ws + 8192;
        for (int bi = bx; bi < NB * SCAN_NC * 2; bi += G) { const int hh = bi & 1, c = (bi >> 1) % SCAN_NC, b = bi / (2 * SCAN_NC);
            const size_t off = ((size_t)b * SEQ + (size_t)c * SCAN_T + wave * 16) * DRNN + hh * 512 + lane * 8;
            v4u lwk[16], bwk[16];
#pragma unroll
            for (int i = 0; i < 16; ++i) { lwk[i] = *(const v4u*)(LA + off + (size_t)i * DRNN); bwk[i] = *(const v4u*)(BB + off + (size_t)i * DRNN); }
            { f32x4 S[2] = {{0.f, 0.f, 0.f, 0.f}, {0.f, 0.f, 0.f, 0.f}}, H[2] = {{0.f, 0.f, 0.f, 0.f}, {0.f, 0.f, 0.f, 0.f}};
#pragma unroll
              for (int i = 0; i < 16; ++i) { f32x4 l[2], bq[2]; pg8::unpack8(lwk[i], l[0], l[1]); pg8::unpack8(bwk[i], bq[0], bq[1]);
#pragma unroll
                  for (int n = 0; n < 2; ++n)
#pragma unroll
                      for (int j = 0; j < 4; ++j) { H[n][j] = __expf(l[n][j]) * H[n][j] + bq[n][j]; S[n][j] += l[n][j]; } }
              *(LAS f32x4*)(PBS + wave * 512 + lane * 8) = S[0]; *(LAS f32x4*)(PBS + wave * 512 + lane * 8 + 4) = S[1];
              *(LAS f32x4*)(PBH + wave * 512 + lane * 8) = H[0]; *(LAS f32x4*)(PBH + wave * 512 + lane * 8 + 4) = H[1]; }
#pragma unroll
            for (int i = 0; i < 16; ++i) asm volatile("" : "+v"(lwk[i]), "+v"(bwk[i]));
            __syncthreads();
            { float h = 0.f, st = 0.f;
#pragma unroll
              for (int sb = 0; sb < 8; ++sb) { const float sv = PBS[sb * 512 + tid]; h = __expf(sv) * h + PBH[sb * 512 + tid]; st += sv; }
              const size_t co = ((size_t)b * SCAN_NC + c) * DRNN + hh * 512 + tid;
              __hip_atomic_store(CS + co, st, __ATOMIC_RELAXED, __HIP_MEMORY_SCOPE_AGENT); __hip_atomic_store(CH + co, h, __ATOMIC_RELAXED, __HIP_MEMORY_SCOPE_AGENT); }
            asm volatile("s_waitcnt vmcnt(0)" ::: "memory");
            __syncthreads();
            if (tid == 0) __hip_atomic_store(flags + ((b * 2 + hh) * SCAN_NC + c) * 16, 1u, __ATOMIC_RELAXED, __HIP_MEMORY_SCOPE_AGENT);
            { f32x4 S[2] = {{0.f, 0.f, 0.f, 0.f}, {0.f, 0.f, 0.f, 0.f}}, H[2] = {{0.f, 0.f, 0.f, 0.f}, {0.f, 0.f, 0.f, 0.f}};
              if (wave * 4 < c) {
                  for (int q = 0; q < 4; ++q) { const int cc = wave * 4 + q; if (cc < c) { unsigned* f = flags + ((b * 2 + hh) * SCAN_NC + cc) * 16; unsigned sp = 0;
                      while ((unsigned)__builtin_amdgcn_readfirstlane(__hip_atomic_load(f, __ATOMIC_RELAXED, __HIP_MEMORY_SCOPE_AGENT)) == 0u) { __builtin_amdgcn_s_sleep(1); if (++sp > (1u << 20)) break; } } }
                  __builtin_amdgcn_fence(__ATOMIC_ACQUIRE, "agent");
#pragma unroll
                  for (int q0 = 0; q0 < 4; q0 += 2) { f32x4 cs[2][2], ch[2][2];
#pragma unroll
                      for (int q = 0; q < 2; ++q) { const int cc = wave * 4 + q0 + q; const size_t co = ((size_t)b * SCAN_NC + (cc < c ? cc : 0)) * DRNN + hh * 512 + lane * 8;
                          cs[q][0] = *(const f32x4*)(CS + co); cs[q][1] = *(const f32x4*)(CS + co + 4); ch[q][0] = *(const f32x4*)(CH + co); ch[q][1] = *(const f32x4*)(CH + co + 4); }
#pragma unroll
                      for (int q = 0; q < 2; ++q) { if (wave * 4 + q0 + q < c) {
#pragma unroll
                          for (int n = 0; n < 2; ++n)
#pragma unroll
                              for (int j = 0; j < 4; ++j) { H[n][j] = __expf(cs[q][n][j]) * H[n][j] + ch[q][n][j]; S[n][j] += cs[q][n][j]; } } }
                      asm volatile("" ::: "memory"); }
              }
              *(LAS f32x4*)(PAS + wave * 512 + lane * 8) = S[0]; *(LAS f32x4*)(PAS + wave * 512 + lane * 8 + 4) = S[1];
              *(LAS f32x4*)(PAH + wave * 512 + lane * 8) = H[0]; *(LAS f32x4*)(PAH + wave * 512 + lane * 8 + 4) = H[1]; }
            __syncthreads();
            f32x4 h[2] = {{0.f, 0.f, 0.f, 0.f}, {0.f, 0.f, 0.f, 0.f}};
#pragma unroll
            for (int sb = 0; sb < 8; ++sb) {
#pragma unroll
                for (int n = 0; n < 2; ++n) { const f32x4 sv = *(const LAS f32x4*)(PAS + sb * 512 + lane * 8 + 4 * n), hv = *(const LAS f32x4*)(PAH + sb * 512 + lane * 8 + 4 * n);
#pragma unroll
                    for (int j = 0; j < 4; ++j) h[n][j] = __expf(sv[j]) * h[n][j] + hv[j]; } }
            for (int sb = 0; sb < wave; ++sb) {
#pragma unroll
                for (int n = 0; n < 2; ++n) { const f32x4 sv = *(const LAS f32x4*)(PBS + sb * 512 + lane * 8 + 4 * n), hv = *(const LAS f32x4*)(PBH + sb * 512 + lane * 8 + 4 * n);
#pragma unroll
                    for (int j = 0; j < 4; ++j) h[n][j] = __expf(sv[j]) * h[n][j] + hv[j]; } }
            const bf16* ugp = UG + off;
            bf16* hgp = CAT + ((size_t)b * SEQ + (size_t)c * SCAN_T + wave * 16) * 1536 + 512 + hh * 512 + lane * 8;
#pragma unroll
            for (int i0 = 0; i0 < 16; i0 += 8) { v4u gw8[8];
#pragma unroll
                for (int i = 0; i < 8; ++i) gw8[i] = *(const v4u*)(ugp + (size_t)(i0 + i) * DRNN);
#pragma unroll
                for (int i = 0; i < 8; ++i) { f32x4 l[2], bq[2], gq[2], o[2]; pg8::unpack8(lwk[i0 + i], l[0], l[1]); pg8::unpack8(bwk[i0 + i], bq[0], bq[1]); pg8::unpack8(gw8[i], gq[0], gq[1]);
#pragma unroll
                    for (int n = 0; n < 2; ++n)
#pragma unroll
                        for (int j = 0; j < 4; ++j) { h[n][j] = __expf(l[n][j]) * h[n][j] + bq[n][j]; o[n][j] = h[n][j] * pg8::gelu_tanh_(gq[n][j]); }
                    *(v4u*)(hgp + (size_t)(i0 + i) * 1536) = pg8::pack8(o[0], o[1]); } }
            __syncthreads();
        }
    }
    SEAM(5);
    TEND(5);

    TSTART(6);
    if (IN(6)) for (int rep = 0; rep < REPS(6); ++rep) { if (rep) GSYNC();
        pg8::Gemm g{CAT, WCAT, M, D, 1536, 1536, 1536, 0, 0}; pg8::StaticOrder S; S.init(M, D, G, bx);
        pg8::EpiMix E{G0, G1, MIXB};
        pg8::gemm_phase<pg8::EpiMix, true, 8>(lds, g, S, E);
    }
    SEAM(6);
    TEND(6);

    TSTART(7);
    if (IN(7)) for (int rep = 0; rep < REPS(7); ++rep) { if (rep) GSYNC();
        pg8::Gemm g{MIXB, WO, M, D, D, D, D, 0, 0}; pg8::StaticOrder S; S.init(M, D, G, bx);
        pg8::EpiRes1 E{x, X1B, SSQ};
        pg8::gemm_phase<pg8::EpiRes1, true>(lds, g, S, E);
    }
    SEAM(7);
    TEND(7);

    TSTART(8);
    if (IN(8)) for (int rep = 0; rep < REPS(8); ++rep) { if (rep) GSYNC();
        pg8::Gemm g{X1B, WFI, M, 2 * DFF, D, D, D, 0, 0}; pg8::StaticOrder S; S.init(M, 2 * DFF, G, bx);
        LAS float* RSL = (LAS float*)(lds + 133120);
        { const int r = tid & 255;
          for (int i = tid >> 8; i < 8; i += 2) { pg8::Unit u; if (!S.next(i, u)) break;
              const f32x4* sp = (const f32x4*)(SSQ + (size_t)(u.pm * 256 + r) * 16); const f32x4 st = (sp[0] + sp[1]) + (sp[2] + sp[3]);
              RSL[i * 256 + r] = __builtin_amdgcn_rsqf(((st[0] + st[1]) + (st[2] + st[3])) * (1.0f / 1024.0f) + 1e-6f); }
          __syncthreads(); }
        pg8::EpiSwiglu E{RSL, ACT};
        pg8::gemm_phase<pg8::EpiSwiglu, true>(lds, g, S, E);
    }
    SEAM(8);
    TEND(8);

    TSTART(9);
    if (IN(9)) for (int rep = 0; rep < REPS(9); ++rep) { if (rep) GSYNC();
        pg8::Gemm g{ACT, WFO, M, D, DFF, DFF, DFF, 0, 0}; pg8::StaticOrder S; S.init(M, D, G, bx);
        if (G == 256) { pg8::EpiFinal E{X1B, X1, (float*)(ws + WS_SSQ2), (unsigned*)ws + 4096, args.in[I_NORM_FINAL]};
            pg8::gemm_phase<pg8::EpiFinal, true>(lds, g, S, E); }
        else { pg8::EpiRes2 E{X1B, X1};
            pg8::gemm_phase<pg8::EpiRes2, true>(lds, g, S, E); }
    }
    if (G != 256) SEAM(9);
    TEND(9);

    TSTART(10);
    if (IN(10) && G != 256) for (int rep = 0; rep < REPS(10); ++rep) { if (rep) GSYNC();
        const int gw = bx * NWAVES + wave, NGW = G * NWAVES;
        const float* gf = args.in[I_NORM_FINAL]; f32x4 gv[4];
#pragma unroll
        for (int j = 0; j < 4; ++j) gv[j] = ((const f32x4*)gf)[lane + 64 * j];
        for (int m = gw; m < M; m += NGW) {
            f32x4* xr = (f32x4*)(X1 + (size_t)m * D) + lane; f32x4 v[4]; float s = 0.f;
#pragma unroll
            for (int j = 0; j < 4; ++j) { v[j] = xr[64 * j]; s += (v[j].x * v[j].x + v[j].y * v[j].y) + (v[j].z * v[j].z + v[j].w * v[j].w); }
            const float rs = 1.0f / sqrtf(wave_sum(s) * (1.f / D) + EPS);
#pragma unroll
            for (int j = 0; j < 4; ++j) xr[64 * j] = v[j] * rs * gv[j];
        }
    }
    if (PROBE_PHASE == 10 || PROBE_PHASE == 99) tp1 = __builtin_amdgcn_s_memrealtime();
    if (PROBE_PHASE >= 0 && bx == 0 && tid == 0) { const unsigned long long dt = (tp1 - tp0) * PROBE_MULT, te = __builtin_amdgcn_s_memrealtime(); while (__builtin_amdgcn_s_memrealtime() - te < dt) __builtin_amdgcn_s_sleep(8); }
#undef IN
#undef SEAM
}

extern "C" void kernel_launch(void* const* d_in, const int* in_sizes, int n_in, void* d_out, int out_size, void* d_ws, size_t ws_size, hipStream_t stream) {
    static int grid = 0;
    if (grid == 0) {
        if (n_in != 19 || out_size != M * D || ws_size < WS_END) { fprintf(stderr, "kernel_launch: unexpected shapes (n_in %d out %d ws %zu)\n", n_in, out_size, ws_size); grid = -1; return; }
        int dev = 0, cus = 0, per_cu = 0;
        hipGetDevice(&dev);
        hipDeviceGetAttribute(&cus, hipDeviceAttributeMultiprocessorCount, dev);
        if (hipFuncSetAttribute((const void*)fwd_kernel, hipFuncAttributeMaxDynamicSharedMemorySize, LDS_BYTES) != hipSuccess) { fprintf(stderr, "kernel_launch: hipFuncSetAttribute failed\n"); grid = -1; return; }
        if (hipOccupancyMaxActiveBlocksPerMultiprocessor(&per_cu, (const void*)fwd_kernel, NTHR, LDS_BYTES) != hipSuccess || per_cu < 1) { fprintf(stderr, "kernel_launch: occupancy query says %d\n", per_cu); per_cu = 1; }
        (void)hipGetLastError();
        grid = cus * 1;
        fprintf(stderr, "kernel_launch: grid %d (cus %d, per_cu %d)\n", grid, cus, per_cu);
    }
    if (grid < 0) return;
    if (hipMemsetAsync(d_ws, 0, 49152, stream) != hipSuccess) { fprintf(stderr, "kernel_launch: memset failed\n"); return; }
    Args a{};
    for (int i = 0; i < 19; ++i) a.in[i] = (const float*)d_in[i];
    a.out = (float*)d_out; a.ws = (unsigned char*)d_ws;
#if MK_PER_PHASE
    for (int p = 0; p < NPH; ++p) { a.ph_lo = p; a.ph_hi = p + 1; hipLaunchKernelGGL(fwd_kernel, dim3(grid), dim3(NTHR), LDS_BYTES, stream, a); }
#else
    a.ph_lo = 0; a.ph_hi = NPH;
    void* kargs[] = {&a};
    hipError_t e = hipLaunchCooperativeKernel((const void*)fwd_kernel, dim3(grid), dim3(NTHR), kargs, LDS_BYTES, stream);
    if (e != hipSuccess) fprintf(stderr, "cooperative launch failed: %s (grid %d)\n", hipGetErrorString(e), grid);
#endif
}
```

```cpp
#include <hip/hip_runtime.h>
#include <hip/hip_cooperative_groups.h>
#include <cstdio>
#include <cstdint>
namespace cg = cooperative_groups;

#ifndef MK_PER_PHASE
#define MK_PER_PHASE 0
#endif

namespace pg8 {
#define PG8_LAS __attribute__((address_space(3)))
typedef unsigned short bf16_t;
typedef short bf16x8 __attribute__((ext_vector_type(8)));
typedef float f32x4 __attribute__((ext_vector_type(4)));
typedef float f32x2 __attribute__((ext_vector_type(2)));
typedef unsigned u32x4 __attribute__((ext_vector_type(4)));
typedef unsigned u32x2 __attribute__((ext_vector_type(2)));
constexpr int BM = 256, BK = 64, HALF = 128, HTB = HALF * BK * 2, STAGE_BYTES = 8 * HTB, NXCD = 8, WGM = 8;

__host__ __device__ __forceinline__ int lds_byte(int r, int c) { const int st = (r >> 4) * 2 + (c >> 5), rr = r & 15, cc = c & 31, ob = rr * 64 + cc * 2; return st * 1024 + (ob ^ (((ob >> 9) & 1) << 5)); }
__host__ __device__ __forceinline__ void stage_rc(int b, int& R, int& C) { const int st = b / 1024, sb = b % 1024, swz = sb ^ (((sb >> 9) & 1) << 5); R = (st >> 1) * 16 + swz / 64; C = (st & 1) * 32 + (swz % 64) / 2; }
__host__ __device__ __forceinline__ int perm32(int rho) { const int n = rho >> 4, i = rho & 15; return 8 * (i >> 2) + 4 * n + (i & 3); }

struct Unit { int pm, pn, rh, idx; };
struct Gemm { const bf16_t* A; const bf16_t* Bt; int M, N, K, lda, ldb, ash, amul; };

struct StaticOrder {
    int nM, nN, nwg, G, c, limit, lin_base, lin_cnt;
    __host__ __device__ void init(int M, int N, int G_, int c_) { nM = M / BM; nN = N / BM; nwg = nM * nN; G = G_; c = c_; limit = nwg; lin_base = 0; lin_cnt = -1; }
    __host__ __device__ void map(int L, Unit& u) const {
        int wgid = L; { const int q = nwg / NXCD, r = nwg % NXCD, xcd = wgid % NXCD, off = wgid / NXCD; wgid = (xcd < r ? xcd * (q + 1) : r * (q + 1) + (xcd - r) * q) + off; }
        const int nig = WGM * nN, gid = wgid / nig, fm = gid * WGM, gsz = (nM - fm) < WGM ? (nM - fm) : WGM;
        u.pm = fm + ((wgid % nig) % gsz); u.pn = (wgid % nig) / gsz; u.rh = 0;
    }
    __host__ __device__ bool next(int i, Unit& u) const {
        u.idx = i;
        if (lin_cnt >= 0) { if (i >= lin_cnt) return false; map(lin_base + i, u); return true; }
        const long L = (long)i * G + c; if (L >= limit) return false;
        map((int)L, u); return true;
    }
};

__device__ __forceinline__ unsigned cvt_pk_bf16(float lo, float hi) { unsigned r; asm volatile("v_cvt_pk_bf16_f32 %0, %1, %2" : "=v"(r) : "v"(lo), "v"(hi)); return r; }
__device__ __forceinline__ float bf_lo(unsigned w) { return __uint_as_float(w << 16); }
__device__ __forceinline__ float bf_hi(unsigned w) { return __uint_as_float(w & 0xffff0000u); }
__device__ __forceinline__ float sigmoidf_(float x) { return __builtin_amdgcn_rcpf(1.0f + __expf(-x)); }
__device__ __forceinline__ float gelu_tanh_(float x) { const float z = 1.5957691216057308f * (x + 0.044715f * x * x * x); return x * sigmoidf_(z); }
__device__ __forceinline__ u32x4 pack8(const f32x4 a, const f32x4 b) { u32x4 w; w.x = cvt_pk_bf16(a[0], a[1]); w.y = cvt_pk_bf16(a[2], a[3]); w.z = cvt_pk_bf16(b[0], b[1]); w.w = cvt_pk_bf16(b[2], b[3]); return w; }
__device__ __forceinline__ void unpack8(const u32x4 w, f32x4& a, f32x4& b) { a = (f32x4){bf_lo(w.x), bf_hi(w.x), bf_lo(w.y), bf_hi(w.y)}; b = (f32x4){bf_lo(w.z), bf_hi(w.z), bf_lo(w.w), bf_hi(w.w)}; }

#define EPI_ROWS_BEGIN _Pragma("unroll") for (int ai = 0; ai < NAI; ++ai) _Pragma("unroll") for (int m = 0; m < 4; ++m) { const int row = u.pm * BM + u.rh + ai * HALF + wr * 64 + m * 16 + fr;
#define EPI_ROWS_END }

struct EpiProj {
    bf16_t *UP, *UR, *UG, *RB, *G1; int pn_off;
    template <int NAI> __device__ __forceinline__ void run(const f32x4 (&acc)[2][2][4][2], const Unit& u, int wr, int wc, int fr, int fq) const {
        const int pn = u.pn + pn_off;
        if (pn < 10) {
            bf16_t* base; int ldc, colt;
            if (pn < 2) { base = UP; ldc = 512; colt = pn * 256; }
            else if (pn < 6) { base = UR; ldc = 1024; colt = (pn - 2) * 256; }
            else { base = UG; ldc = 1024; colt = (pn - 6) * 256; }
            const int col0 = colt + wc * 32 + 8 * fq;
            EPI_ROWS_BEGIN
                bf16_t* rowp = base + (unsigned)((unsigned)row * (unsigned)ldc + (unsigned)col0);
#pragma unroll
                for (int bj = 0; bj < 2; ++bj) *(u32x4*)(rowp + bj * HALF) = pack8(acc[ai][bj][m][0], acc[ai][bj][m][1]);
            EPI_ROWS_END
        } else {
            const int ch0 = (pn - 10) * 128 + wc * 32 + 8 * fq;
            EPI_ROWS_BEGIN
                const unsigned off = (unsigned)row * 1024u + (unsigned)ch0; f32x4 rr[2], gg[2];
#pragma unroll
                for (int n = 0; n < 2; ++n)
#pragma unroll
                    for (int j = 0; j < 4; ++j) { const float d0 = 1.0f + fminf(__expf(-acc[ai][0][m][n][j]), 1e18f), d1 = 1.0f + fminf(__expf(-acc[ai][1][m][n][j]), 1e18f);
                        gg[n][j] = __builtin_amdgcn_rcpf(d1); rr[n][j] = d1 * __builtin_amdgcn_rcpf(d0); }
                *(u32x4*)(RB + off) = pack8(rr[0], rr[1]); *(u32x4*)(G1 + off) = pack8(gg[0], gg[1]);
            EPI_ROWS_END
        }
    }
};
struct EpiGrp {
    bf16_t* O; int ldc; const float* scale;
    template <int NAI> __device__ __forceinline__ void run(const f32x4 (&acc)[2][2][4][2], const Unit& u, int wr, int wc, int fr, int fq) const {
        const int col0 = u.pn * BM + wc * 32 + 8 * fq;
        f32x4 sc[2][2];
#pragma unroll
        for (int bj = 0; bj < 2; ++bj)
#pragma unroll
            for (int n = 0; n < 2; ++n) sc[bj][n] = *(const f32x4*)(scale + col0 + bj * HALF + 4 * n);
        EPI_ROWS_BEGIN
            bf16_t* rowp = O + (unsigned)((unsigned)row * (unsigned)ldc + (unsigned)col0);
#pragma unroll
            for (int bj = 0; bj < 2; ++bj) *(u32x4*)(rowp + bj * HALF) = pack8(acc[ai][bj][m][0] * sc[bj][0], acc[ai][bj][m][1] * sc[bj][1]);
        EPI_ROWS_END
    }
};
struct EpiGate {
    const bf16_t* V; bf16_t *LA, *BB; const float *b_a, *b_x, *sp8;
    template <int NAI> __device__ __forceinline__ void run(const f32x4 (&acc)[2][2][4][2], const Unit& u, int wr, int wc, int fr, int fq) const {
        const int ch0 = u.pn * 128 + wc * 32 + 8 * fq;
        f32x4 ba[2], bx[2], sp[2];
#pragma unroll
        for (int n = 0; n < 2; ++n) { ba[n] = *(const f32x4*)(b_a + ch0 + 4 * n); bx[n] = *(const f32x4*)(b_x + ch0 + 4 * n); sp[n] = *(const f32x4*)(sp8 + ch0 + 4 * n); }
        EPI_ROWS_BEGIN
            const unsigned off = (unsigned)row * 1024u + (unsigned)ch0;
            const u32x4 vw = *(const u32x4*)(V + ((unsigned)row * 1536u + (unsigned)ch0)); f32x4 vv[2]; unpack8(vw, vv[0], vv[1]);
            f32x4 la[2], bb[2];
#pragma unroll
            for (int n = 0; n < 2; ++n)
#pragma unroll
                for (int j = 0; j < 4; ++j) {
                    const float r = sigmoidf_(acc[ai][0][m][n][j] + ba[n][j]), ig = sigmoidf_(acc[ai][1][m][n][j] + bx[n][j]);
                    const float l = sp[n][j] * r, x2 = 2.0f * l;
                    const float em1 = (x2 > -0.125f) ? x2 * (1.0f + 0.5f * x2 * (1.0f + 0.33333334f * x2 * (1.0f + 0.25f * x2 * (1.0f + 0.2f * x2)))) : (__expf(x2) - 1.0f);
                    la[n][j] = l; bb[n][j] = __builtin_amdgcn_sqrtf(fmaxf(-em1, 0.f)) * ig * vv[n][j]; }
            *(u32x4*)(LA + off) = pack8(la[0], la[1]); *(u32x4*)(BB + off) = pack8(bb[0], bb[1]);
            asm volatile("" ::: "memory");
        EPI_ROWS_END
    }
};
struct EpiMix {
    const bf16_t *RB, *G1; bf16_t* MIXB;
    __device__ __forceinline__ void mid(f32x4 (&acc)[2][2][4][2], const Unit& u0, int wr, int wc, int fr, int fq) const {
        constexpr int NAI = 2; Unit u = u0; asm volatile("" : "+s"(u.pm), "+s"(u.pn));
        const int col0 = u.pn * BM + wc * 32 + 8 * fq;
        EPI_ROWS_BEGIN
            const unsigned off = (unsigned)row * 1024u + (unsigned)col0;
#pragma unroll
            for (int bj = 0; bj < 2; ++bj) { f32x4 r[2]; unpack8(*(const u32x4*)(RB + off + bj * HALF), r[0], r[1]); acc[ai][bj][m][0] *= r[0]; acc[ai][bj][m][1] *= r[1]; }
        EPI_ROWS_END
    }
    template <int NAI> __device__ __forceinline__ void run(const f32x4 (&acc)[2][2][4][2], const Unit& u, int wr, int wc, int fr, int fq) const {
        const int col0 = u.pn * BM + wc * 32 + 8 * fq;
        EPI_ROWS_BEGIN
            const unsigned off = (unsigned)row * 1024u + (unsigned)col0;
#pragma unroll
            for (int bj = 0; bj < 2; ++bj) { f32x4 g[2]; unpack8(*(const u32x4*)(G1 + off + bj * HALF), g[0], g[1]);
                *(u32x4*)(MIXB + off + bj * HALF) = pack8(g[0] * acc[ai][bj][m][0], g[1] * acc[ai][bj][m][1]); }
        EPI_ROWS_END
    }
};
struct EpiRes1 {
    const float* X; bf16_t* X1B; float* SSQ;
    template <int NAI> __device__ __forceinline__ void run(const f32x4 (&acc)[2][2][4][2], const Unit& u, int wr, int wc, int fr, int fq) const {
        const int col0 = u.pn * BM + wc * 32 + 8 * fq;
        EPI_ROWS_BEGIN
            const unsigned off = (unsigned)row * 1024u + (unsigned)col0; float ss = 0.f;
#pragma unroll
            for (int bj = 0; bj < 2; ++bj) {
                const f32x4 a = *(const f32x4*)(X + off + bj * HALF) + acc[ai][bj][m][0], b = *(const f32x4*)(X + off + bj * HALF + 4) + acc[ai][bj][m][1];
                *(u32x4*)(X1B + off + bj * HALF) = pack8(a, b);
                ss += (a[0] * a[0] + a[1] * a[1]) + (a[2] * a[2] + a[3] * a[3]) + (b[0] * b[0] + b[1] * b[1]) + (b[2] * b[2] + b[3] * b[3]); }
            ss += __shfl_xor(ss, 16); ss += __shfl_xor(ss, 32);
            if (fq == 0) SSQ[(unsigned)row * 16u + (unsigned)(u.pn * 4 + wc)] = ss;
        EPI_ROWS_END
    }
};
struct EpiSwiglu {
    const PG8_LAS float* RSL; bf16_t* ACT;
    template <int NAI> __device__ __forceinline__ void run(const f32x4 (&acc)[2][2][4][2], const Unit& u, int wr, int wc, int fr, int fq) const {
        const int col0 = u.pn * 128 + wc * 32 + 8 * fq;
        const PG8_LAS float* rt = RSL + u.idx * 256 + wr * 64 + fr;
        EPI_ROWS_BEGIN
            const float rs = rt[ai * HALF + m * 16];
            f32x4 o[2];
#pragma unroll
            for (int n = 0; n < 2; ++n)
#pragma unroll
                for (int j = 0; j < 4; ++j) { const float g = acc[ai][0][m][n][j] * rs, up = acc[ai][1][m][n][j] * rs; o[n][j] = g * sigmoidf_(g) * up; }
            __builtin_nontemporal_store(pack8(o[0], o[1]), (u32x4*)(ACT + (unsigned)((unsigned)row * 2816u + (unsigned)col0)));
        EPI_ROWS_END
    }
};
struct EpiRes2 {
    const bf16_t* X1B; float* OUT;
    template <int NAI> __device__ __forceinline__ void run(const f32x4 (&acc)[2][2][4][2], const Unit& u, int wr, int wc, int fr, int fq) const {
        const int col0 = u.pn * BM + wc * 32 + 8 * fq;
        EPI_ROWS_BEGIN
            const unsigned off = (unsigned)row * 1024u + (unsigned)col0;
#pragma unroll
            for (int bj = 0; bj < 2; ++bj) { f32x4 xa, xb; unpack8(*(const u32x4*)(X1B + off + bj * HALF), xa, xb);
                *(f32x4*)(OUT + off + bj * HALF) = xa + acc[ai][bj][m][0]; *(f32x4*)(OUT + off + bj * HALF + 4) = xb + acc[ai][bj][m][1]; }
        EPI_ROWS_END
    }
};

struct EpiFinal {
    const bf16_t* X1B; float* OUT; float* SSQ2; unsigned* cnt; const float* gfin;
    template <int NAI> __device__ __forceinline__ void run(f32x4 (&acc)[2][2][4][2], const Unit& u, int wr, int wc, int fr, int fq) const {
        const int col0 = u.pn * BM + wc * 32 + 8 * fq;
        EPI_ROWS_BEGIN
            const unsigned off = (unsigned)row * 1024u + (unsigned)col0; float ss = 0.f;
#pragma unroll
            for (int bj = 0; bj < 2; ++bj) { f32x4 xa, xb; unpack8(*(const u32x4*)(X1B + off + bj * HALF), xa, xb);
                const f32x4 a = xa + acc[ai][bj][m][0], b = xb + acc[ai][bj][m][1]; acc[ai][bj][m][0] = a; acc[ai][bj][m][1] = b;
                ss += (a[0] * a[0] + a[1] * a[1]) + (a[2] * a[2] + a[3] * a[3]) + (b[0] * b[0] + b[1] * b[1]) + (b[2] * b[2] + b[3] * b[3]); }
            ss += __shfl_xor(ss, 16); ss += __shfl_xor(ss, 32);
            if (fq == 0) __hip_atomic_store(SSQ2 + (unsigned)row * 16u + (unsigned)(u.pn * 4 + wc), ss, __ATOMIC_RELAXED, __HIP_MEMORY_SCOPE_AGENT);
        EPI_ROWS_END
        asm volatile("s_waitcnt vmcnt(0)" ::: "memory");
        unsigned* c = cnt + 64 * u.pm;
        if ((threadIdx.x & 63) == 0) __hip_atomic_fetch_add(c, 1u, __ATOMIC_RELAXED, __HIP_MEMORY_SCOPE_AGENT);
        { unsigned sp = 0;
          while ((unsigned)__builtin_amdgcn_readfirstlane(__hip_atomic_load(c, __ATOMIC_RELAXED, __HIP_MEMORY_SCOPE_AGENT)) < 32u) { __builtin_amdgcn_s_sleep(2); if (++sp > (1u << 20)) break; } }
        __builtin_amdgcn_fence(__ATOMIC_ACQUIRE, "agent");
        f32x4 gv[2][2];
#pragma unroll
        for (int bj = 0; bj < 2; ++bj)
#pragma unroll
            for (int n = 0; n < 2; ++n) gv[bj][n] = *(const f32x4*)(gfin + col0 + bj * HALF + 4 * n);
        EPI_ROWS_BEGIN
            const unsigned off = (unsigned)row * 1024u + (unsigned)col0;
            const unsigned long long* sl = (const unsigned long long*)(SSQ2 + (unsigned)row * 16u + (unsigned)(4 * fq));
            const unsigned long long w0 = __hip_atomic_load(sl, __ATOMIC_RELAXED, __HIP_MEMORY_SCOPE_AGENT), w1 = __hip_atomic_load(sl + 1, __ATOMIC_RELAXED, __HIP_MEMORY_SCOPE_AGENT);
            float sq = (__uint_as_float((unsigned)w0) + __uint_as_float((unsigned)(w0 >> 32))) + (__uint_as_float((unsigned)w1) + __uint_as_float((unsigned)(w1 >> 32)));
            sq += __shfl_xor(sq, 16); sq += __shfl_xor(sq, 32);
            const float rs = 1.0f / sqrtf(sq * (1.0f / 1024.0f) + 1e-6f);
#pragma unroll
            for (int bj = 0; bj < 2; ++bj) { *(f32x4*)(OUT + off + bj * HALF) = acc[ai][bj][m][0] * rs * gv[bj][0]; *(f32x4*)(OUT + off + bj * HALF + 4) = acc[ai][bj][m][1] * rs * gv[bj][1]; }
        EPI_ROWS_END
    }
};

template <class Epi, bool ALIGN_EPI, int MID_T = -1>
__device__ __forceinline__ void gemm_phase(PG8_LAS unsigned char* lds, const Gemm g, const StaticOrder& S, const Epi& E) {
    const int tid = threadIdx.x, wid = __builtin_amdgcn_readfirstlane(tid >> 6), lane = tid & 63, wr = wid >> 2, wc = wid & 3, fr = lane & 15, fq = lane >> 4;
    int nt = g.K / BK; asm volatile("" : "+s"(nt));
    unsigned voffA[2], voffB[2];
#pragma unroll
    for (int i = 0; i < 2; ++i) { int R, C; stage_rc(tid * 16 + i * 8192, R, C); const int Rb = (R & ~31) + perm32(R & 31);
        voffA[i] = (unsigned)(R * g.lda + C) * 2u; voffB[i] = (unsigned)(Rb * g.ldb + C) * 2u; }
    const size_t kstep = (size_t)(BK * 2);
    const size_t hstepA = (size_t)HALF * g.lda * 2, hstepB = (size_t)HALF * g.ldb * 2;
    const size_t tstepA = 2 * hstepA, tstepB = 2 * hstepB;
    const unsigned ldsw = (unsigned)wid * 1024u;
    const int aoff = lds_byte(wr * 64 + fr, fq * 8), boff = lds_byte(wc * 32 + fr, fq * 8);
#define PG8_SA(b, h) (((b) * 2 + (h)) * HTB)
#define PG8_SB(b, h) ((4 + (b) * 2 + (h)) * HTB)
#define PG8_STAGE(bufoff, gbase, voff) do { _Pragma("unroll") for (int _i = 0; _i < 2; ++_i) \
        __builtin_amdgcn_global_load_lds((const unsigned*)((const char*)(gbase) + (voff)[_i]), (PG8_LAS unsigned*)(lds + (bufoff) + ldsw + _i * 8192), 16, 0, 0); } while (0)
#define PG8_LDA(dst, b, h) do { _Pragma("unroll") for (int m = 0; m < 4; ++m) _Pragma("unroll") for (int k = 0; k < 2; ++k) dst[m][k] = *(const PG8_LAS bf16x8*)(lds + PG8_SA(b, h) + aoff + m * 2048 + k * 1024); } while (0)
#define PG8_LDB(dst, b, h) do { _Pragma("unroll") for (int n = 0; n < 2; ++n) _Pragma("unroll") for (int k = 0; k < 2; ++k) dst[n][k] = *(const PG8_LAS bf16x8*)(lds + PG8_SB(b, h) + boff + n * 2048 + k * 1024); } while (0)
#define PG8_MMA(ai, bj, At, Bt) do { __builtin_amdgcn_s_setprio(1); _Pragma("unroll") for (int m = 0; m < 4; ++m) _Pragma("unroll") for (int n = 0; n < 2; ++n) _Pragma("unroll") for (int k = 0; k < 2; ++k) \
        acc[ai][bj][m][n] = __builtin_amdgcn_mfma_f32_16x16x32_bf16(Bt[n][k], At[m][k], acc[ai][bj][m][n], 0, 0, 0); __builtin_amdgcn_s_setprio(0); } while (0)
#define PG8_WAIT_V(n) asm volatile("s_waitcnt vmcnt(" #n ")" ::: "memory")
#define PG8_WAIT_L(n) asm volatile("s_waitcnt lgkmcnt(" #n ")" ::: "memory")
#define PG8_BAR __builtin_amdgcn_s_barrier()
#define PG8_SCHED __builtin_amdgcn_sched_barrier(0)
    Unit cur, nxt; int ui = 0;
    if (!S.next(0, cur)) return;
    f32x4 acc[2][2][4][2];
#pragma unroll
    for (int a = 0; a < 2; ++a)
#pragma unroll
        for (int b = 0; b < 2; ++b)
#pragma unroll
            for (int m = 0; m < 4; ++m)
#pragma unroll
                for (int n = 0; n < 2; ++n) acc[a][b][m][n] = (f32x4){0.f, 0.f, 0.f, 0.f};
    bf16x8 At[4][2], B0[2][2], B1[2][2];
    const char* cA = (const char*)g.A + (size_t)cur.pm * tstepA + (size_t)((cur.pn >> g.ash) * g.amul) * 2; const char* cB = (const char*)g.Bt + (size_t)cur.pn * tstepB;
    PG8_STAGE(PG8_SB(0, 0), cB, voffB); PG8_STAGE(PG8_SB(0, 1), cB + hstepB, voffB); PG8_STAGE(PG8_SA(0, 0), cA, voffA); PG8_STAGE(PG8_SA(0, 1), cA + hstepA, voffA);
    if (wr == 1) PG8_BAR;
    PG8_WAIT_V(2); PG8_BAR;
    PG8_STAGE(PG8_SB(1, 0), cB + kstep, voffB); PG8_STAGE(PG8_SA(1, 0), cA + kstep, voffA); PG8_STAGE(PG8_SB(1, 1), cB + hstepB + kstep, voffB);
    PG8_WAIT_V(6); PG8_BAR;
    for (;;) {
        const bool has_next = S.next(ui + 1, nxt);
        const char* nA = has_next ? (const char*)g.A + (size_t)nxt.pm * tstepA + (size_t)((nxt.pn >> g.ash) * g.amul) * 2 : cA; const char* nB = has_next ? (const char*)g.Bt + (size_t)nxt.pn * tstepB : cB;
        for (int t = 0; t < nt; t += 2) {
            const bool last = (t == nt - 2);
            if constexpr (MID_T >= 0) { if (t == MID_T) E.mid(acc, cur, wr, wc, fr, fq); }
            const char* a1 = cA + (size_t)(t + 1) * kstep;
            const char* a2 = last ? nA : cA + (size_t)(t + 2) * kstep; const char* b2 = last ? nB : cB + (size_t)(t + 2) * kstep;
            const char* a3 = a2 + kstep; const char* b3 = b2 + kstep;
            PG8_LDB(B0, 0, 0); PG8_LDB(B1, 0, 1); PG8_SCHED; PG8_LDA(At, 0, 0); PG8_STAGE(PG8_SA(1, 1), a1 + hstepA, voffA);
            PG8_WAIT_V(8); PG8_WAIT_L(0); PG8_BAR; PG8_MMA(0, 0, At, B0); PG8_MMA(0, 1, At, B1); PG8_BAR; PG8_SCHED;
            PG8_LDA(At, 0, 1); PG8_STAGE(PG8_SB(0, 0), b2, voffB); PG8_STAGE(PG8_SB(0, 1), b2 + hstepB, voffB); PG8_STAGE(PG8_SA(0, 0), a2, voffA);
            PG8_WAIT_V(8); PG8_WAIT_L(0); PG8_BAR; PG8_MMA(1, 0, At, B0); PG8_MMA(1, 1, At, B1); PG8_BAR; PG8_SCHED;
            PG8_LDB(B0, 1, 0); PG8_LDB(B1, 1, 1); PG8_SCHED; PG8_LDA(At, 1, 0); PG8_STAGE(PG8_SA(0, 1), a2 + hstepA, voffA);
            PG8_WAIT_V(8); PG8_WAIT_L(0); PG8_BAR; PG8_MMA(0, 0, At, B0); PG8_MMA(0, 1, At, B1); PG8_BAR; PG8_SCHED;
            PG8_LDA(At, 1, 1); PG8_STAGE(PG8_SB(1, 0), b3, voffB); PG8_STAGE(PG8_SB(1, 1), b3 + hstepB, voffB); PG8_STAGE(PG8_SA(1, 0), a3, voffA);
            PG8_WAIT_V(8); PG8_WAIT_L(0); PG8_BAR; PG8_MMA(1, 0, At, B0); PG8_MMA(1, 1, At, B1); PG8_BAR; PG8_SCHED;
        }
        if constexpr (ALIGN_EPI) { if (wr == 0) PG8_BAR; }
        E.template run<2>(acc, cur, wr, wc, fr, fq);
        if (!has_next) break;
#pragma unroll
        for (int a = 0; a < 2; ++a)
#pragma unroll
            for (int b = 0; b < 2; ++b)
#pragma unroll
                for (int m = 0; m < 4; ++m)
#pragma unroll
                    for (int n = 0; n < 2; ++n) acc[a][b][m][n] = (f32x4){0.f, 0.f, 0.f, 0.f};
        cur = nxt; cA = nA; cB = nB; ++ui;
        if constexpr (ALIGN_EPI) { if (wr == 1) PG8_BAR; }
    }
    PG8_WAIT_V(0);
    if constexpr (!ALIGN_EPI) { if (wr == 0) PG8_BAR; }
    PG8_BAR;
#undef PG8_SA
#undef PG8_SB
#undef PG8_STAGE
#undef PG8_LDA
#undef PG8_LDB
#undef PG8_MMA
#undef PG8_WAIT_V
#undef PG8_WAIT_L
#undef PG8_BAR
#undef PG8_SCHED
}

template <class Epi>
__device__ __forceinline__ void gemm_half(PG8_LAS unsigned char* lds, const Gemm g, const Unit u, const Epi& E) {
    const int tid = threadIdx.x, wid = __builtin_amdgcn_readfirstlane(tid >> 6), lane = tid & 63, wr = wid >> 2, wc = wid & 3, fr = lane & 15, fq = lane >> 4;
    int nt = g.K / BK; asm volatile("" : "+s"(nt));
    unsigned voffA[2], voffB[2];
#pragma unroll
    for (int i = 0; i < 2; ++i) { int R, C; stage_rc(tid * 16 + i * 8192, R, C); const int Rb = (R & ~31) + perm32(R & 31);
        voffA[i] = (unsigned)(R * g.lda + C) * 2u; voffB[i] = (unsigned)(Rb * g.ldb + C) * 2u; }
    const size_t kstep = (size_t)(BK * 2);
    const size_t hstepA = (size_t)HALF * g.lda * 2, hstepB = (size_t)HALF * g.ldb * 2;
    const unsigned ldsw = (unsigned)wid * 1024u;
    const int aoff = lds_byte(wr * 64 + fr, fq * 8), boff = lds_byte(wc * 32 + fr, fq * 8);
#define PG8_SA(b, h) (((b) * 2 + (h)) * HTB)
#define PG8_SB(b, h) ((4 + (b) * 2 + (h)) * HTB)
#define PG8_STAGE(bufoff, gbase, voff) do { _Pragma("unroll") for (int _i = 0; _i < 2; ++_i) \
        __builtin_amdgcn_global_load_lds((const unsigned*)((const char*)(gbase) + (voff)[_i]), (PG8_LAS unsigned*)(lds + (bufoff) + ldsw + _i * 8192), 16, 0, 0); } while (0)
#define PG8_LDA(dst, b, h) do { _Pragma("unroll") for (int m = 0; m < 4; ++m) _Pragma("unroll") for (int k = 0; k < 2; ++k) dst[m][k] = *(const PG8_LAS bf16x8*)(lds + PG8_SA(b, h) + aoff + m * 2048 + k * 1024); } while (0)
#define PG8_LDB(dst, b, h) do { _Pragma("unroll") for (int n = 0; n < 2; ++n) _Pragma("unroll") for (int k = 0; k < 2; ++k) dst[n][k] = *(const PG8_LAS bf16x8*)(lds + PG8_SB(b, h) + boff + n * 2048 + k * 1024); } while (0)
#define PG8_MMA(ai, bj, At, Bt) do { __builtin_amdgcn_s_setprio(1); _Pragma("unroll") for (int m = 0; m < 4; ++m) _Pragma("unroll") for (int n = 0; n < 2; ++n) _Pragma("unroll") for (int k = 0; k < 2; ++k) \
        acc[ai][bj][m][n] = __builtin_amdgcn_mfma_f32_16x16x32_bf16(Bt[n][k], At[m][k], acc[ai][bj][m][n], 0, 0, 0); __builtin_amdgcn_s_setprio(0); } while (0)
#define PG8_WAIT_V(n) asm volatile("s_waitcnt vmcnt(" #n ")" ::: "memory")
#define PG8_WAIT_L(n) asm volatile("s_waitcnt lgkmcnt(" #n ")" ::: "memory")
#define PG8_BAR __builtin_amdgcn_s_barrier()
#define PG8_SCHED __builtin_amdgcn_sched_barrier(0)
    f32x4 acc[2][2][4][2];
#pragma unroll
    for (int a = 0; a < 2; ++a)
#pragma unroll
        for (int b = 0; b < 2; ++b)
#pragma unroll
            for (int m = 0; m < 4; ++m)
#pragma unroll
                for (int n = 0; n < 2; ++n) acc[a][b][m][n] = (f32x4){0.f, 0.f, 0.f, 0.f};
    bf16x8 At[4][2], B0[2][2], B1[2][2];
    const char* cA = (const char*)g.A + ((size_t)u.pm * BM + u.rh) * g.lda * 2 + (size_t)((u.pn >> g.ash) * g.amul) * 2; const char* cB = (const char*)g.Bt + (size_t)u.pn * 2 * hstepB;
    PG8_STAGE(PG8_SB(0, 0), cB, voffB); PG8_STAGE(PG8_SB(0, 1), cB + hstepB, voffB); PG8_STAGE(PG8_SA(0, 0), cA, voffA);
    PG8_STAGE(PG8_SB(1, 0), cB + kstep, voffB); PG8_STAGE(PG8_SB(1, 1), cB + hstepB + kstep, voffB); PG8_STAGE(PG8_SA(1, 0), cA + kstep, voffA);
    PG8_WAIT_V(6); PG8_BAR;
#define PG8_HALF_STEP(b, tt) do { \
        PG8_LDB(B0, b, 0); PG8_LDB(B1, b, 1); PG8_LDA(At, b, 0); PG8_WAIT_L(0); PG8_BAR; PG8_SCHED; \
        const bool more_ = (tt) + 2 < nt; \
        if (more_) { const char* b2 = cB + (size_t)((tt) + 2) * kstep; const char* a2 = cA + (size_t)((tt) + 2) * kstep; \
            PG8_STAGE(PG8_SB(b, 0), b2, voffB); PG8_STAGE(PG8_SB(b, 1), b2 + hstepB, voffB); PG8_STAGE(PG8_SA(b, 0), a2, voffA); } \
        PG8_MMA(0, 0, At, B0); PG8_MMA(0, 1, At, B1); \
        if (more_) PG8_WAIT_V(6); else PG8_WAIT_V(0); \
        PG8_BAR; PG8_SCHED; } while (0)
    for (int t = 0; t < nt; t += 2) { PG8_HALF_STEP(0, t); PG8_HALF_STEP(1, t + 1); }
    E.template run<1>(acc, u, wr, wc, fr, fq);
    PG8_BAR;
#undef PG8_HALF_STEP
#undef PG8_SA
#undef PG8_SB
#undef PG8_STAGE
#undef PG8_LDA
#undef PG8_LDB
#undef PG8_MMA
#undef PG8_WAIT_V
#undef PG8_WAIT_L
#undef PG8_BAR
#undef PG8_SCHED
}
}

constexpr int NWAVES = 8, NTHR = 512;
constexpr int M = 16384, SEQ = 4096, NB = 4, D = 1024, DPOOL = 512, DRNN = 1024, DIN = 4608, DFF = 2816;
constexpr float EPS = 1e-6f;
constexpr int NPH = 11;
constexpr int SCAN_T = 128, SCAN_NC = SEQ / SCAN_T;

constexpr size_t MiB = 1u << 20;
constexpr size_t WS_SP8 = 512 * 1024;
constexpr size_t WS_SSQ = 1 * MiB;
constexpr size_t WS_SSQ2 = 2 * MiB;
constexpr size_t WS_CS = 2 * MiB, WS_CH = 3 * MiB;
constexpr size_t WS_WIN = 4 * MiB;
constexpr size_t WS_WFI = 13 * MiB;
constexpr size_t WS_WFO = 24 * MiB;
constexpr size_t WS_WCAT = WS_WFO + 5632 * 1024;
constexpr size_t WS_WO = WS_WCAT + 3 * MiB;
constexpr size_t WS_WGRP = WS_WO + 2 * MiB;
constexpr size_t WS_WGATE = WS_WGRP + MiB / 4;
constexpr size_t WS_R1 = 36 * MiB;
constexpr size_t WS_R2 = 68 * MiB;
constexpr size_t WS_R3 = 84 * MiB;
constexpr size_t WS_R4 = 116 * MiB;
constexpr size_t WS_R7 = 148 * MiB;
constexpr size_t WS_R8 = 164 * MiB;
constexpr size_t WS_CAT = 196 * MiB;
constexpr size_t WS_MIXB = 148 * MiB;
constexpr size_t WS_ACT = 68 * MiB;
constexpr size_t WS_END = 244 * MiB;

constexpr int LDS_BYTES = 147456;

#define LAS __attribute__((address_space(3)))
typedef unsigned short bf16;
typedef unsigned v4u __attribute__((ext_vector_type(4)));
typedef unsigned v2u __attribute__((ext_vector_type(2)));
typedef float f32x4 __attribute__((ext_vector_type(4)));
typedef float f32x2 __attribute__((ext_vector_type(2)));
#define LDS_WAIT() asm volatile("s_waitcnt lgkmcnt(0)" ::: "memory")
using pg8::cvt_pk_bf16; using pg8::bf_lo; using pg8::bf_hi;

struct Args { const float* in[19]; float* out; unsigned char* ws; int ph_lo, ph_hi; };
enum { I_X = 0, I_NORM_MIX, I_W_IN, I_W_GRP, I_POOL_SCALE, I_W_POOL_OUT, I_CONV_W, I_CONV_B, I_W_RG_A, I_B_RG_A, I_W_RG_X, I_B_RG_X, I_LAMBDA, I_W_RNN_OUT, I_W_O, I_NORM_FFN, I_W_FFN_IN, I_W_FFN_OUT, I_NORM_FINAL };

__device__ __forceinline__ float wave_sum(float v) {
#pragma unroll
    for (int o = 1; o < 64; o <<= 1) v += __shfl_xor(v, o);
    return v;
}

__device__ __forceinline__ void transpose_item(const float* W, int Nsrc, int Kdst, bf16* WT, int k0, int n_src0, int n_dst0, const float* kscale, LAS float* scr, int lane) {
    f32x4 v[8]; const int n4 = (lane & 7) * 4;
#pragma unroll
    for (int i = 0; i < 8; ++i) { const int kk = 8 * i + (lane >> 3); v[i] = *(const f32x4*)(W + (size_t)(k0 + kk) * Nsrc + n_src0 + n4); }
    if (kscale) {
#pragma unroll
        for (int i = 0; i < 8; ++i) v[i] = v[i] * kscale[k0 + 8 * i + (lane >> 3)]; }
#pragma unroll
    for (int i = 0; i < 8; ++i) { const int kk = 8 * i + (lane >> 3);
#pragma unroll
        for (int j = 0; j < 4; ++j) scr[kk * 33 + n4 + j] = v[i][j]; }
    LDS_WAIT(); asm volatile("" ::: "memory");
    const int c = lane & 7;
#pragma unroll
    for (int j = 0; j < 4; ++j) { const int n = (lane >> 3) + 8 * j; const LAS float* s = scr + (8 * c) * 33 + n;
        v4u o; o.x = cvt_pk_bf16(s[0 * 33], s[1 * 33]); o.y = cvt_pk_bf16(s[2 * 33], s[3 * 33]); o.z = cvt_pk_bf16(s[4 * 33], s[5 * 33]); o.w = cvt_pk_bf16(s[6 * 33], s[7 * 33]);
        *(v4u*)(WT + (size_t)(n_dst0 + n) * Kdst + k0 + 8 * c) = o; }
    LDS_WAIT(); asm volatile("" ::: "memory");
}

#define XB_TMO      128
#define XB_XCNT(j)  (256  + 64 * (j))
#define XB_XSUB(j)  (1280 + 64 * (j))
#define XB_XGEN(j)  (2304 + 64 * (j))
#define XB_TOP      3328
#define XB_TOPGEN   3392
#define XCD_BAR_WORDS 3456
#define XB_SPIN_CAP (1u << 18)
__device__ __forceinline__ unsigned xb_ld(unsigned* p)              { return __hip_atomic_load(p, __ATOMIC_RELAXED, __HIP_MEMORY_SCOPE_AGENT); }
__device__ __forceinline__ unsigned xb_add(unsigned* p, unsigned v) { return __hip_atomic_fetch_add(p, v, __ATOMIC_RELAXED, __HIP_MEMORY_SCOPE_AGENT); }
__device__ __forceinline__ unsigned xb_xcc_id() { return (unsigned)__builtin_amdgcn_s_getreg((3 << 11) | 20) & 0xFu; }
#define XB_SPIN(cond, bar) do { unsigned _sp = 0; while (cond) { __builtin_amdgcn_s_sleep(1); \
    if ((++_sp & 255u) == 0u) { if (xb_ld(&(bar)[XB_TMO])) break; if (_sp > XB_SPIN_CAP) { atomicAdd(&(bar)[XB_TMO], 1u); break; } } } } while (0)
struct XcdBarrier { unsigned* bar; unsigned x; volatile LAS unsigned* st; };
__device__ __forceinline__ XcdBarrier xcd_barrier_post(unsigned* bar, volatile LAS unsigned* st) {
    XcdBarrier b; b.bar = bar; b.x = xb_xcc_id(); b.st = st;
    if (threadIdx.x == 0) (void)xb_add(&bar[XB_XCNT(b.x)], 1u);
    return b;
}
__device__ __forceinline__ void xcd_barrier_complete(unsigned* bar, unsigned x, unsigned& nloc, unsigned& nx) {
    const unsigned G = gridDim.x * gridDim.y * gridDim.z;
    unsigned sum, cnt, mine, sp = 0u;
    for (;;) {
        sum = 0u; cnt = 0u; mine = 0u;
#pragma unroll
        for (unsigned j = 0; j < 16; ++j) { const unsigned c = xb_ld(&bar[XB_XCNT(j)]); sum += c; cnt += (c > 0u) ? 1u : 0u; mine = (j == x) ? c : mine; }
        if (sum == G) break;
        __builtin_amdgcn_s_sleep(1);
        if ((++sp & 255u) == 0u) { if (xb_ld(&bar[XB_TMO])) break; if (sp > XB_SPIN_CAP) { atomicAdd(&bar[XB_TMO], 1u); break; } }
    }
    nloc = mine > 0u ? mine : 1u; nx = cnt > 0u ? cnt : 1u;
}
__device__ __forceinline__ void xcd_barrier(const XcdBarrier& b) {
    asm volatile("s_waitcnt vmcnt(0)" ::: "memory");
    __syncthreads();
    if (threadIdx.x == 0) {
        unsigned* bar = b.bar;
        __builtin_amdgcn_s_waitcnt(0);
        unsigned nloc = b.st[0], nx = b.st[1];
        if (nloc == 0u) { xcd_barrier_complete(bar, b.x, nloc, nx); b.st[0] = nloc; b.st[1] = nx; }
        const unsigned old = xb_add(&bar[XB_XSUB(b.x)], 1u);
        const unsigned gen = old / nloc;
        if (old + 1u == (gen + 1u) * nloc) {
            __builtin_amdgcn_fence(__ATOMIC_RELEASE, "agent");
            asm volatile("s_waitcnt vmcnt(0)" ::: "memory");
            const unsigned og = xb_add(&bar[XB_TOP], 1u);
            const unsigned tg = og / nx;
            if (og + 1u == (tg + 1u) * nx) xb_add(&bar[XB_TOPGEN], 1u);
            else XB_SPIN(xb_ld(&bar[XB_TOPGEN]) == tg, bar);
            __builtin_amdgcn_fence(__ATOMIC_ACQUIRE, "agent");
            xb_add(&bar[XB_XGEN(b.x)], 1u);
            asm volatile("s_waitcnt vmcnt(0)" ::: "memory");
        } else {
            XB_SPIN(xb_ld(&bar[XB_XGEN(b.x)]) == gen, bar);
            __builtin_amdgcn_fence(__ATOMIC_ACQUIRE, "agent");
            asm volatile("s_waitcnt vmcnt(0)" ::: "memory");
        }
    }
    __syncthreads();
}

template <int W>
__device__ __forceinline__ void pool_item(const bf16* src, bf16* dst, int tl) {
    v4u rw[W + 7];
#pragma unroll
    for (int k = 0; k < W + 7; ++k) rw[k] = (tl + k - (W - 1) >= 0) ? *(const v4u*)(src + (ptrdiff_t)(k - (W - 1)) * DPOOL) : (v4u){0u, 0u, 0u, 0u};
    f32x4 s0 = {0.f, 0.f, 0.f, 0.f}, s1 = s0;
#pragma unroll
    for (int k = 0; k < W - 1; ++k) { f32x4 a, c; pg8::unpack8(rw[k], a, c); s0 += a; s1 += c; }
#pragma unroll
    for (int i = 0; i < 8; ++i) { f32x4 a, c; pg8::unpack8(rw[W - 1 + i], a, c); s0 += a; s1 += c;
        const int t = tl + i; const int cnt = (t + 1 < W) ? t + 1 : W; const float inv = 1.0f / (float)cnt;
        *(v4u*)(dst + (size_t)i * DPOOL) = pg8::pack8(s0 * inv - a, s1 * inv - c);
        f32x4 a2, c2; pg8::unpack8(rw[i], a2, c2); s0 -= a2; s1 -= c2; }
}
__device__ __forceinline__ void scan_local16(const bf16* lap, const bf16* bbp, f32x4 (&S)[2], f32x4 (&H)[2]) {
    S[0] = S[1] = H[0] = H[1] = (f32x4){0.f, 0.f, 0.f, 0.f};
#pragma unroll
    for (int i0 = 0; i0 < 16; i0 += 8) { v4u lw[8], bw[8];
#pragma unroll
        for (int i = 0; i < 8; ++i) { lw[i] = *(const v4u*)(lap + (size_t)(i0 + i) * DRNN); bw[i] = *(const v4u*)(bbp + (size_t)(i0 + i) * DRNN); }
#pragma unroll
        for (int i = 0; i < 8; ++i) { f32x4 l[2], bq[2]; pg8::unpack8(lw[i], l[0], l[1]); pg8::unpack8(bw[i], bq[0], bq[1]);
#pragma unroll
            for (int n = 0; n < 2; ++n)
#pragma unroll
                for (int j = 0; j < 4; ++j) { H[n][j] = __expf(l[n][j]) * H[n][j] + bq[n][j]; S[n][j] += l[n][j]; } } }
}

__global__ void __launch_bounds__(NTHR, 2) fwd_kernel(Args args) {
    extern __shared__ __attribute__((aligned(16))) unsigned char lds_raw[];
    LAS unsigned char* lds = (LAS unsigned char*)lds_raw;
    const int tid = threadIdx.x, lane = tid & 63, wave = __builtin_amdgcn_readfirstlane(tid >> 6);
    const int G = gridDim.x, bx = blockIdx.x;
    unsigned char* ws = args.ws;
    const int lo = args.ph_lo, hi = args.ph_hi;
#ifndef PHASE_MASK
#define PHASE_MASK 0x7ff
#endif
#define IN(k) (((PHASE_MASK >> (k)) & 1) && lo <= (k) && (k) < hi)
#ifndef REPEAT_MASK
#define REPEAT_MASK 0
#endif
#define REPS(k) (((REPEAT_MASK >> (k)) & 1) ? 2 : 1)
#ifndef PROBE_PHASE
#define PROBE_PHASE -1
#endif
#define PROBE_MULT 4
    unsigned long long tp0 = 0, tp1 = 0;
#define TSTART(k) do { if ((k) == PROBE_PHASE) tp0 = __builtin_amdgcn_s_memrealtime(); } while (0)
#define TEND(k) do { if ((k) == PROBE_PHASE) tp1 = __builtin_amdgcn_s_memrealtime(); } while (0)
#define GSYNC() xcd_barrier(bar)
#define SEAM(k) do { if (IN(k) && IN((k) + 1)) { GSYNC(); } } while (0)

    const float* x = args.in[I_X];
    bf16* WIN = (bf16*)(ws + WS_WIN); bf16* WFI = (bf16*)(ws + WS_WFI); bf16* WFO = (bf16*)(ws + WS_WFO); bf16* WCAT = (bf16*)(ws + WS_WCAT);
    bf16* WO = (bf16*)(ws + WS_WO); bf16* WGRP = (bf16*)(ws + WS_WGRP); bf16* WGATE = (bf16*)(ws + WS_WGATE);
    bf16* XN = (bf16*)(ws + WS_R1); bf16* X1B = XN;
    bf16* CAT = (bf16*)(ws + WS_CAT); bf16* V = CAT + 512;
    bf16* UP = (bf16*)(ws + WS_R2);
    bf16* UR = (bf16*)(ws + WS_R3); bf16* LA = UR;
    bf16* UG = (bf16*)(ws + WS_R4);
    bf16* POOLED = (bf16*)(ws + WS_R7); bf16* BB = (bf16*)(ws + WS_R8);
    bf16* MIXB = (bf16*)(ws + WS_MIXB); bf16* ACT = (bf16*)(ws + WS_ACT);
    float* SSQ = (float*)(ws + WS_SSQ); float* CS = (float*)(ws + WS_CS); float* CH = (float*)(ws + WS_CH);
    bf16* G0 = (bf16*)args.out; bf16* G1 = G0 + (size_t)M * 1024;
    float* X1 = args.out;

#ifndef EXTRA_SYNCS
#define EXTRA_SYNCS 0
#endif
    if (PROBE_PHASE == 99) tp0 = __builtin_amdgcn_s_memrealtime();
    volatile LAS unsigned* MISC = (volatile LAS unsigned*)(lds + 131072 + 1024);
    if (tid < 32) MISC[tid] = 0u;
    __syncthreads();
    XcdBarrier bar = xcd_barrier_post((unsigned*)ws, MISC + 8);
    if (lo < 0) cg::this_grid().sync();
    for (int i = 0; i < EXTRA_SYNCS; ++i) GSYNC();
    TSTART(0);
    if (IN(0)) for (int rep = 0; rep < REPS(0); ++rep) { if (rep) GSYNC();
        LAS float* scr = (LAS float*)(lds + wave * 16384);
        const int gw = bx * NWAVES + wave, NGW = G * NWAVES;
        constexpr int I_IN = 16 * (DIN / 32), I_FI = 16 * (2 * DFF / 32), I_FO = (DFF / 64) * (D / 32), I_RO = 16 * 32, I_WO = 16 * 32, I_PO = 8 * 32;
        constexpr int NITEMS = I_IN + I_FI + I_FO + I_RO + I_WO + I_PO;
        for (int it = gw; it < NITEMS; it += NGW) {
            int r = it;
            if (r < I_IN) { const int nblk = DIN / 32, kb = r / nblk, nb = r % nblk, nd = 32 * nb; int ns = nd;
                if (nd >= 2560) { const int q = nd - 2560, pq = q >> 8, j0 = q & 255; ns = 2560 + (j0 < 128 ? 128 * pq + j0 : 1024 + 128 * pq + (j0 - 128)); }
                transpose_item(args.in[I_W_IN], DIN, D, WIN, 64 * kb, ns, nd, nullptr, scr, lane); continue; } r -= I_IN;
            if (r < I_FI) { const int nblk = 2 * DFF / 32, kb = r / nblk, nb = r % nblk, nd = 32 * nb, pn = nd >> 8, j0 = nd & 255;
                const int ns = j0 < 128 ? 128 * pn + j0 : DFF + 128 * pn + (j0 - 128);
                transpose_item(args.in[I_W_FFN_IN], 2 * DFF, D, WFI, 64 * kb, ns, nd, args.in[I_NORM_FFN], scr, lane); continue; } r -= I_FI;
            if (r < I_FO) { if (G != 256) { const int nblk = D / 32, kb = r / nblk, nb = r % nblk; transpose_item(args.in[I_W_FFN_OUT], D, DFF, WFO, 64 * kb, 32 * nb, 32 * nb, nullptr, scr, lane); } continue; } r -= I_FO;
            if (r < I_RO) { const int nblk = D / 32, kb = r / nblk, nb = r % nblk; transpose_item(args.in[I_W_RNN_OUT], D, 1536, WCAT + 512, 64 * kb, 32 * nb, 32 * nb, nullptr, scr, lane); continue; } r -= I_RO;
            if (r < I_WO) { const int nblk = D / 32, kb = r / nblk, nb = r % nblk; transpose_item(args.in[I_W_O], D, D, WO, 64 * kb, 32 * nb, 32 * nb, nullptr, scr, lane); continue; } r -= I_WO;
            { const int nblk = D / 32, kb = r / nblk, nb = r % nblk; transpose_item(args.in[I_W_POOL_OUT], D, 1536, WCAT, 64 * kb, 32 * nb, 32 * nb, nullptr, scr, lane); }
        }
        {
            const int gt = bx * NTHR + tid, NT = G * NTHR;
            const float* wg = args.in[I_W_GRP];
            for (int e = gt; e < 512 * 32; e += NT) { const int n = e >> 5, kc = (e & 31) * 8, g = n >> 7, nn = n & 127; float v[8];
#pragma unroll
                for (int j = 0; j < 8; ++j) { const int kk = kc + j - (g & 1) * 128; v[j] = (kk >= 0 && kk < 128) ? wg[((size_t)g * 128 + kk) * 128 + nn] : 0.f; }
                v4u o; o.x = cvt_pk_bf16(v[0], v[1]); o.y = cvt_pk_bf16(v[2], v[3]); o.z = cvt_pk_bf16(v[4], v[5]); o.w = cvt_pk_bf16(v[6], v[7]);
                *(v4u*)(WGRP + (size_t)n * 256 + kc) = o; }
            const float* wa = args.in[I_W_RG_A]; const float* wx = args.in[I_W_RG_X];
            for (int e = gt; e < 2048 * 16; e += NT) { const int n = e >> 4, kc = (e & 15) * 8, h = n >> 8, j = n & 255; const float* src = j < 128 ? wa : wx; const int jj = j & 127; float v[8];
#pragma unroll
                for (int q = 0; q < 8; ++q) v[q] = src[((size_t)h * 128 + kc + q) * 128 + jj];
                v4u o; o.x = cvt_pk_bf16(v[0], v[1]); o.y = cvt_pk_bf16(v[2], v[3]); o.z = cvt_pk_bf16(v[4], v[5]); o.w = cvt_pk_bf16(v[6], v[7]);
                *(v4u*)(WGATE + (size_t)n * 128 + kc) = o; }
        }
        { const int gt = bx * NTHR + tid; if (gt < DRNN) { const float z = -args.in[I_LAMBDA][gt]; ((float*)(ws + WS_SP8))[gt] = -8.0f * (fmaxf(z, 0.f) + log1pf(expf(-fabsf(z)))); } }
        const float* gmix = args.in[I_NORM_MIX];
        f32x4 gv[4];
#pragma unroll
        for (int j = 0; j < 4; ++j) gv[j] = ((const f32x4*)gmix)[lane + 64 * j];
        for (int m = gw; m < M; m += 2 * NGW) {
            const int m1 = (m + NGW < M) ? m + NGW : m;
            const f32x4* xr0 = (const f32x4*)(x + (size_t)m * D) + lane; const f32x4* xr1 = (const f32x4*)(x + (size_t)m1 * D) + lane; f32x4 v0[4], v1[4]; float s0 = 0.f, s1 = 0.f;
#pragma unroll
            for (int j = 0; j < 4; ++j) { v0[j] = xr0[64 * j]; v1[j] = xr1[64 * j]; }
#pragma unroll
            for (int j = 0; j < 4; ++j) { s0 += (v0[j].x * v0[j].x + v0[j].y * v0[j].y) + (v0[j].z * v0[j].z + v0[j].w * v0[j].w); s1 += (v1[j].x * v1[j].x + v1[j].y * v1[j].y) + (v1[j].z * v1[j].z + v1[j].w * v1[j].w); }
            const float rs0 = 1.0f / sqrtf(wave_sum(s0) * (1.f / D) + EPS), rs1 = 1.0f / sqrtf(wave_sum(s1) * (1.f / D) + EPS);
            v2u* o0 = (v2u*)(XN + (size_t)m * D) + lane; v2u* o1 = (v2u*)(XN + (size_t)m1 * D) + lane;
#pragma unroll
            for (int j = 0; j < 4; ++j) { const f32x4 y0 = v0[j] * rs0 * gv[j], y1 = v1[j] * rs1 * gv[j]; v2u w0, w1; w0.x = cvt_pk_bf16(y0.x, y0.y); w0.y = cvt_pk_bf16(y0.z, y0.w); w1.x = cvt_pk_bf16(y1.x, y1.y); w1.y = cvt_pk_bf16(y1.z, y1.w); o0[64 * j] = w0; o1[64 * j] = w1; }
        }
        __syncthreads();
    }
    SEAM(0);
    TEND(0);

    TSTART(1);
    if (IN(1)) for (int rep = 0; rep < REPS(1); ++rep) { if (rep) GSYNC();
        pg8::Gemm g{XN, WIN, M, 4096, D, D, D, 0, 0}; pg8::StaticOrder S; S.init(M, 4096, G, bx);
        pg8::EpiProj E{UP, UR, UG, G0, G1, 0};
        pg8::gemm_phase<pg8::EpiProj, true>(lds, g, S, E);
    }
    SEAM(1);
    TEND(1);

    TSTART(2);
    if (IN(2)) for (int rep = 0; rep < REPS(2); ++rep) { if (rep) GSYNC();
        { const int gw = bx * NWAVES + wave, NGW = G * NWAVES;
          for (int wi = gw; wi < (M / 32) * 4; wi += NGW) { const int g = wi & 3, t0 = (wi >> 2) * 32 + (lane >> 4) * 8, co = g * 16 + (lane & 15);
              const bf16* src = UP + (size_t)t0 * DPOOL + co * 8; bf16* dst = POOLED + (size_t)t0 * DPOOL + co * 8; const int tl = t0 & (SEQ - 1);
              if (g == 0) pool_item<2>(src, dst, tl); else if (g == 1) pool_item<4>(src, dst, tl); else if (g == 2) pool_item<8>(src, dst, tl); else pool_item<16>(src, dst, tl); } }
        { const int gt = bx * NTHR + tid, NT = G * NTHR;
          for (int it = gt; it < (M / 8) * 128; it += NT) { const int co = it & 127, t0 = (it >> 7) * 8, tl = t0 & (SEQ - 1);
              const bf16* src = UR + (size_t)t0 * DRNN + co * 8; bf16* dst = V + (size_t)t0 * 1536 + co * 8;
              const float* cw = args.in[I_CONV_W] + co * 8; const float* cb = args.in[I_CONV_B] + co * 8;
              v4u rw[11];
#pragma unroll
              for (int k = 0; k < 11; ++k) rw[k] = (k >= 3 || tl != 0) ? *(const v4u*)(src + (ptrdiff_t)(k - 3) * DRNN) : (v4u){0u, 0u, 0u, 0u};
              f32x4 w0[2], w1[2], w2[2], w3[2], bb[2];
#pragma unroll
              for (int n = 0; n < 2; ++n) { w0[n] = *(const f32x4*)(cw + 4 * n); w1[n] = *(const f32x4*)(cw + 1024 + 4 * n); w2[n] = *(const f32x4*)(cw + 2048 + 4 * n); w3[n] = *(const f32x4*)(cw + 3072 + 4 * n); bb[n] = *(const f32x4*)(cb + 4 * n); }
#pragma unroll
              for (int i = 0; i < 8; ++i) { f32x4 a[2], b[2], c[2], d[2]; pg8::unpack8(rw[i], a[0], a[1]); pg8::unpack8(rw[i + 1], b[0], b[1]); pg8::unpack8(rw[i + 2], c[0], c[1]); pg8::unpack8(rw[i + 3], d[0], d[1]);
                  *(v4u*)(dst + (size_t)i * 1536) = pg8::pack8(bb[0] + w0[0] * a[0] + w1[0] * b[0] + w2[0] * c[0] + w3[0] * d[0], bb[1] + w0[1] * a[1] + w1[1] * b[1] + w2[1] * c[1] + w3[1] * d[1]); }
          } }
    }
    SEAM(2);
    TEND(2);

    TSTART(3);
    if (IN(3)) for (int rep = 0; rep < REPS(3); ++rep) { if (rep) GSYNC();
        const bool uneven = (G == 256);
        {
          pg8::Gemm g{XN, WIN + (size_t)4096 * D, M, 512, D, D, D, 0, 0}; pg8::StaticOrder S; S.init(M, 512, G, bx);
          pg8::EpiProj E{UP, UR, UG, G0, G1, 16};
          pg8::gemm_phase<pg8::EpiProj, true>(lds, g, S, E); }
        { pg8::Gemm g{POOLED, WGRP, M, 512, 256, 512, 256, 0, 256}; pg8::StaticOrder S; S.init(M, 512, G, (bx + G / 2) % G);
          pg8::EpiGrp E{CAT, 1536, args.in[I_POOL_SCALE]};
          pg8::gemm_phase<pg8::EpiGrp, true>(lds, g, S, E); }
        { pg8::Gemm g{V, WGATE, M, 2048, 128, 1536, 128, 0, 128}; pg8::StaticOrder S; S.init(M, 2048, G, bx);
          if (uneven) { if (bx < 128) { S.lin_base = bx; S.lin_cnt = 1; } else { S.lin_base = 128 + (bx - 128) * 3; S.lin_cnt = 3; } }
          pg8::EpiGate E{V, LA, BB, args.in[I_B_RG_A], args.in[I_B_RG_X], (const float*)(ws + WS_SP8)};
          pg8::gemm_phase<pg8::EpiGate, true>(lds, g, S, E); }
    }
    SEAM(3);
    TEND(3);

    TSTART(4);
    TEND(4);

    TSTART(5);
    if (IN(5)) for (int rep = 0; rep < REPS(5); ++rep) { if (rep) GSYNC();
        LAS float* PAS = (LAS float*)lds; LAS float* PAH = PAS + 8 * 512; LAS float* PBS = PAH + 8 * 512; LAS float* PBH = PBS + 8 * 512;
        unsigned* flags = (unsigned*)ws + 8192;
        for (int bi = bx; bi < NB * SCAN_NC * 2; bi += G) { const int hh = bi & 1, c = (bi >> 1) % SCAN_NC, b = bi / (2 * SCAN_NC);
            const size_t off = ((size_t)b * SEQ + (size_t)c * SCAN_T + wave * 16) * DRNN + hh * 512 + lane * 8;
            v4u lwk[16], bwk[16];
#pragma unroll
            for (int i = 0; i < 16; ++i) { lwk[i] = *(const v4u*)(LA + off + (size_t)i * DRNN); bwk[i] = *(const v4u*)(BB + off + (size_t)i * DRNN); }
            { f32x4 S[2] = {{0.f, 0.f, 0.f, 0.f}, {0.f, 0.f, 0.f, 0.f}}, H[2] = {{0.f, 0.f, 0.f, 0.f}, {0.f, 0.f, 0.f, 0.f}};
#pragma unroll
              for (int i = 0; i < 16; ++i) { f32x4 l[2], bq[2]; pg8::unpack8(lwk[i], l[0], l[1]); pg8::unpack8(bwk[i], bq[0], bq[1]);
#pragma unroll
                  for (int n = 0; n < 2; ++n)
#pragma unroll
                      for (int j = 0; j < 4; ++j) { H[n][j] = __expf(l[n][j]) * H[n][j] + bq[n][j]; S[n][j] += l[n][j]; } }
              *(LAS f32x4*)(PBS + wave * 512 + lane * 8) = S[0]; *(LAS f32x4*)(PBS + wave * 512 + lane * 8 + 4) = S[1];
              *(LAS f32x4*)(PBH + wave * 512 + lane * 8) = H[0]; *(LAS f32x4*)(PBH + wave * 512 + lane * 8 + 4) = H[1]; }
#pragma unroll
            for (int i = 0; i < 16; ++i) asm volatile("" : "+v"(lwk[i]), "+v"(bwk[i]));
            __syncthreads();
            { float h = 0.f, st = 0.f;
#pragma unroll
              for (int sb = 0; sb < 8; ++sb) { const float sv = PBS[sb * 512 + tid]; h = __expf(sv) * h + PBH[sb * 512 + tid]; st += sv; }
              const size_t co = ((size_t)b * SCAN_NC + c) * DRNN + hh * 512 + tid;
              __hip_atomic_store(CS + co, st, __ATOMIC_RELAXED, __HIP_MEMORY_SCOPE_AGENT); __hip_atomic_store(CH + co, h, __ATOMIC_RELAXED, __HIP_MEMORY_SCOPE_AGENT); }
            asm volatile("s_waitcnt vmcnt(0)" ::: "memory");
            __syncthreads();
            if (tid == 0) __hip_atomic_store(flags + ((b * 2 + hh) * SCAN_NC + c) * 16, 1u, __ATOMIC_RELAXED, __HIP_MEMORY_SCOPE_AGENT);
            { f32x4 S[2] = {{0.f, 0.f, 0.f, 0.f}, {0.f, 0.f, 0.f, 0.f}}, H[2] = {{0.f, 0.f, 0.f, 0.f}, {0.f, 0.f, 0.f, 0.f}};
              if (wave * 4 < c) {
                  for (int q = 0; q < 4; ++q) { const int cc = wave * 4 + q; if (cc < c) { unsigned* f = flags + ((b * 2 + hh) * SCAN_NC + cc) * 16; unsigned sp = 0;
                      while ((unsigned)__builtin_amdgcn_readfirstlane(__hip_atomic_load(f, __ATOMIC_RELAXED, __HIP_MEMORY_SCOPE_AGENT)) == 0u) { __builtin_amdgcn_s_sleep(1); if (++sp > (1u << 20)) break; } } }
                  __builtin_amdgcn_fence(__ATOMIC_ACQUIRE, "agent");
#pragma unroll
                  for (int q0 = 0; q0 < 4; q0 += 2) { f32x4 cs[2][2], ch[2][2];
#pragma unroll
                      for (int q = 0; q < 2; ++q) { const int cc = wave * 4 + q0 + q; const size_t co = ((size_t)b * SCAN_NC + (cc < c ? cc : 0)) * DRNN + hh * 512 + lane * 8;
                          cs[q][0] = *(const f32x4*)(CS + co); cs[q][1] = *(const f32x4*)(CS + co + 4); ch[q][0] = *(const f32x4*)(CH + co); ch[q][1] = *(const f32x4*)(CH + co + 4); }
#pragma unroll
                      for (int q = 0; q < 2; ++q) { if (wave * 4 + q0 + q < c) {
#pragma unroll
                          for (int n = 0; n < 2; ++n)
#pragma unroll
                              for (int j = 0; j < 4; ++j) { H[n][j] = __expf(cs[q][n][j]) * H[n][j] + ch[q][n][j]; S[n][j] += cs[q][n][j]; } } }
                      asm volatile("" ::: "memory"); }
              }
              *(LAS f32x4*)(PAS + wave * 512 + lane * 8) = S[0]; *(LAS f32x4*)(PAS + wave * 512 + lane * 8 + 4) = S[1];
              *(LAS f32x4*)(PAH + wave * 512 + lane * 8) = H[0]; *(LAS f32x4*)(PAH + wave * 512 + lane * 8 + 4) = H[1]; }
            __syncthreads();
            f32x4 h[2] = {{0.f, 0.f, 0.f, 0.f}, {0.f, 0.f, 0.f, 0.f}};
#pragma unroll
            for (int sb = 0; sb < 8; ++sb) {
#pragma unroll
                for (int n = 0; n < 2; ++n) { const f32x4 sv = *(const LAS f32x4*)(PAS + sb * 512 + lane * 8 + 4 * n), hv = *(const LAS f32x4*)(PAH + sb * 512 + lane * 8 + 4 * n);
#pragma unroll
                    for (int j = 0; j < 4; ++j) h[n][j] = __expf(sv[j]) * h[n][j] + hv[j]; } }
            for (int sb = 0; sb < wave; ++sb) {
#pragma unroll
                for (int n = 0; n < 2; ++n) { const f32x4 sv = *(const LAS f32x4*)(PBS + sb * 512 + lane * 8 + 4 * n), hv = *(const LAS f32x4*)(PBH + sb * 512 + lane * 8 + 4 * n);
#pragma unroll
                    for (int j = 0; j < 4; ++j) h[n][j] = __expf(sv[j]) * h[n][j] + hv[j]; } }
            const bf16* ugp = UG + off;
            bf16* hgp = CAT + ((size_t)b * SEQ + (size_t)c * SCAN_T + wave * 16) * 1536 + 512 + hh * 512 + lane * 8;
#pragma unroll
            for (int i0 = 0; i0 < 16; i0 += 8) { v4u gw8[8];
#pragma unroll
                for (int i = 0; i < 8; ++i) gw8[i] = *(const v4u*)(ugp + (size_t)(i0 + i) * DRNN);
#pragma unroll
                for (int i = 0; i < 8; ++i) { f32x4 l[2], bq[2], gq[2], o[2]; pg8::unpack8(lwk[i0 + i], l[0], l[1]); pg8::unpack8(bwk[i0 + i], bq[0], bq[1]); pg8::unpack8(gw8[i], gq[0], gq[1]);
#pragma unroll
                    for (int n = 0; n < 2; ++n)
#pragma unroll
                        for (int j = 0; j < 4; ++j) { h[n][j] = __expf(l[n][j]) * h[n][j] + bq[n][j]; o[n][j] = h[n][j] * pg8::gelu_tanh_(gq[n][j]); }
                    *(v4u*)(hgp + (size_t)(i0 + i) * 1536) = pg8::pack8(o[0], o[1]); } }
            __syncthreads();
        }
    }
    SEAM(5);
    TEND(5);

    TSTART(6);
    if (IN(6)) for (int rep = 0; rep < REPS(6); ++rep) { if (rep) GSYNC();
        pg8::Gemm g{CAT, WCAT, M, D, 1536, 1536, 1536, 0, 0}; pg8::StaticOrder S; S.init(M, D, G, bx);
        pg8::EpiMix E{G0, G1, MIXB};
        pg8::gemm_phase<pg8::EpiMix, true, 8>(lds, g, S, E);
    }
    SEAM(6);
    TEND(6);

    TSTART(7);
    if (IN(7)) for (int rep = 0; rep < REPS(7); ++rep) { if (rep) GSYNC();
        pg8::Gemm g{MIXB, WO, M, D, D, D, D, 0, 0}; pg8::StaticOrder S; S.init(M, D, G, bx);
        pg8::EpiRes1 E{x, X1B, SSQ};
        pg8::gemm_phase<pg8::EpiRes1, true>(lds, g, S, E);
    }
    SEAM(7);
    TEND(7);

    TSTART(8);
    if (IN(8)) for (int rep = 0; rep < REPS(8); ++rep) { if (rep) GSYNC();
        pg8::Gemm g{X1B, WFI, M, 2 * DFF, D, D, D, 0, 0}; pg8::StaticOrder S; S.init(M, 2 * DFF, G, bx);
        LAS float* RSL = (LAS float*)(lds + 133120);
        { const int r = tid & 255;
          for (int i = tid >> 8; i < 8; i += 2) { pg8::Unit u; if (!S.next(i, u)) break;
              const f32x4* sp = (const f32x4*)(SSQ + (size_t)(u.pm * 256 + r) * 16); const f32x4 st = (sp[0] + sp[1]) + (sp[2] + sp[3]);
              RSL[i * 256 + r] = __builtin_amdgcn_rsqf(((st[0] + st[1]) + (st[2] + st[3])) * (1.0f / 1024.0f) + 1e-6f); }
          __syncthreads(); }
        pg8::EpiSwiglu E{RSL, ACT};
        pg8::gemm_phase<pg8::EpiSwiglu, true>(lds, g, S, E);
        if (G == 256 && bx >= 128) {
            LAS float* scr = (LAS float*)(lds + wave * 16384); constexpr int I_FO = (DFF / 64) * (D / 32);
            for (int r = (bx - 128) * NWAVES + wave; r < I_FO; r += 128 * NWAVES) { const int nblk = D / 32, kb = r / nblk, nb = r % nblk;
                transpose_item(args.in[I_W_FFN_OUT], D, DFF, WFO, 64 * kb, 32 * nb, 32 * nb, nullptr, scr, lane); }
        }
    }
    SEAM(8);
    TEND(8);

    TSTART(9);
    if (IN(9)) for (int rep = 0; rep < REPS(9); ++rep) { if (rep) GSYNC();
        pg8::Gemm g{ACT, WFO, M, D, DFF, DFF, DFF, 0, 0}; pg8::StaticOrder S; S.init(M, D, G, bx);
        if (G == 256) { pg8::EpiFinal E{X1B, X1, (float*)(ws + WS_SSQ2), (unsigned*)ws + 4096, args.in[I_NORM_FINAL]};
            pg8::gemm_phase<pg8::EpiFinal, true>(lds, g, S, E); }
        else { pg8::EpiRes2 E{X1B, X1};
            pg8::gemm_phase<pg8::EpiRes2, true>(lds, g, S, E); }
    }
    if (G != 256) SEAM(9);
    TEND(9);

    TSTART(10);
    if (IN(10) && G != 256) for (int rep = 0; rep < REPS(10); ++rep) { if (rep) GSYNC();
        const int gw = bx * NWAVES + wave, NGW = G * NWAVES;
        const float* gf = args.in[I_NORM_FINAL]; f32x4 gv[4];
#pragma unroll
        for (int j = 0; j < 4; ++j) gv[j] = ((const f32x4*)gf)[lane + 64 * j];
        for (int m = gw; m < M; m += NGW) {
            f32x4* xr = (f32x4*)(X1 + (size_t)m * D) + lane; f32x4 v[4]; float s = 0.f;
#pragma unroll
            for (int j = 0; j < 4; ++j) { v[j] = xr[64 * j]; s += (v[j].x * v[j].x + v[j].y * v[j].y) + (v[j].z * v[j].z + v[j].w * v[j].w); }
            const float rs = 1.0f / sqrtf(wave_sum(s) * (1.f / D) + EPS);
#pragma unroll
            for (int j = 0; j < 4; ++j) xr[64 * j] = v[j] * rs * gv[j];
        }
    }
    if (PROBE_PHASE == 10 || PROBE_PHASE == 99) tp1 = __builtin_amdgcn_s_memrealtime();
    if (PROBE_PHASE >= 0 && bx == 0 && tid == 0) { const unsigned long long dt = (tp1 - tp0) * PROBE_MULT, te = __builtin_amdgcn_s_memrealtime(); while (__builtin_amdgcn_s_memrealtime() - te < dt) __builtin_amdgcn_s_sleep(8); }
#undef IN
#undef SEAM
}

extern "C" void kernel_launch(void* const* d_in, const int* in_sizes, int n_in, void* d_out, int out_size, void* d_ws, size_t ws_size, hipStream_t stream) {
    static int grid = 0;
    if (grid == 0) {
        if (n_in != 19 || out_size != M * D || ws_size < WS_END) { fprintf(stderr, "kernel_launch: unexpected shapes (n_in %d out %d ws %zu)\n", n_in, out_size, ws_size); grid = -1; return; }
        int dev = 0, cus = 0, per_cu = 0;
        hipGetDevice(&dev);
        hipDeviceGetAttribute(&cus, hipDeviceAttributeMultiprocessorCount, dev);
        if (hipFuncSetAttribute((const void*)fwd_kernel, hipFuncAttributeMaxDynamicSharedMemorySize, LDS_BYTES) != hipSuccess) { fprintf(stderr, "kernel_launch: hipFuncSetAttribute failed\n"); grid = -1; return; }
        if (hipOccupancyMaxActiveBlocksPerMultiprocessor(&per_cu, (const void*)fwd_kernel, NTHR, LDS_BYTES) != hipSuccess || per_cu < 1) { fprintf(stderr, "kernel_launch: occupancy query says %d\n", per_cu); per_cu = 1; }
        (void)hipGetLastError();
        grid = cus * 1;
        fprintf(stderr, "kernel_launch: grid %d (cus %d, per_cu %d)\n", grid, cus, per_cu);
    }
    if (grid < 0) return;
    if (hipMemsetAsync(d_ws, 0, 49152, stream) != hipSuccess) { fprintf(stderr, "kernel_launch: memset failed\n"); return; }
    Args a{};
    for (int i = 0; i < 19; ++i) a.in[i] = (const float*)d_in[i];
    a.out = (float*)d_out; a.ws = (unsigned char*)d_ws;
#if MK_PER_PHASE
    for (int p = 0; p < NPH; ++p) { a.ph_lo = p; a.ph_hi = p + 1; hipLaunchKernelGGL(fwd_kernel, dim3(grid), dim3(NTHR), LDS_BYTES, stream, a); }
#else
    a.ph_lo = 0; a.ph_hi = NPH;
    void* kargs[] = {&a};
    hipError_t e = hipLaunchCooperativeKernel((const void*)fwd_kernel, dim3(grid), dim3(NTHR), kargs, LDS_BYTES, stream);
    if (e != hipSuccess) fprintf(stderr, "cooperative launch failed: %s (grid %d)\n", hipGetErrorString(e), grid);
#endif
}
```

```cpp
#include <hip/hip_runtime.h>
#include <hip/hip_cooperative_groups.h>
#include <cstdio>
#include <cstdint>
namespace cg = cooperative_groups;

#ifndef MK_PER_PHASE
#define MK_PER_PHASE 0
#endif

namespace pg8 {
#define PG8_LAS __attribute__((address_space(3)))
typedef unsigned short bf16_t;
typedef short bf16x8 __attribute__((ext_vector_type(8)));
typedef float f32x4 __attribute__((ext_vector_type(4)));
typedef float f32x2 __attribute__((ext_vector_type(2)));
typedef unsigned u32x4 __attribute__((ext_vector_type(4)));
typedef unsigned u32x2 __attribute__((ext_vector_type(2)));
constexpr int BM = 256, BK = 64, HALF = 128, HTB = HALF * BK * 2, STAGE_BYTES = 8 * HTB, NXCD = 8, WGM = 8;

__host__ __device__ __forceinline__ int lds_byte(int r, int c) { const int st = (r >> 4) * 2 + (c >> 5), rr = r & 15, cc = c & 31, ob = rr * 64 + cc * 2; return st * 1024 + (ob ^ (((ob >> 9) & 1) << 5)); }
__host__ __device__ __forceinline__ void stage_rc(int b, int& R, int& C) { const int st = b / 1024, sb = b % 1024, swz = sb ^ (((sb >> 9) & 1) << 5); R = (st >> 1) * 16 + swz / 64; C = (st & 1) * 32 + (swz % 64) / 2; }
__host__ __device__ __forceinline__ int perm32(int rho) { const int n = rho >> 4, i = rho & 15; return 8 * (i >> 2) + 4 * n + (i & 3); }

struct Unit { int pm, pn, rh, idx; };
struct Gemm { const bf16_t* A; const bf16_t* Bt; int M, N, K, lda, ldb, ash, amul; };

struct StaticOrder {
    int nM, nN, nwg, G, c, limit, lin_base, lin_cnt;
    __host__ __device__ __forceinline__ void init(int M, int N, int G_, int c_) { nM = M / BM; nN = N / BM; nwg = nM * nN; G = G_; c = c_; limit = nwg; lin_base = 0; lin_cnt = -1; }
    __host__ __device__ __forceinline__ void map(int L, Unit& u) const {
        int wgid = L; { const int q = nwg / NXCD, r = nwg % NXCD, xcd = wgid % NXCD, off = wgid / NXCD; wgid = (xcd < r ? xcd * (q + 1) : r * (q + 1) + (xcd - r) * q) + off; }
        const int nig = WGM * nN, gid = wgid / nig, fm = gid * WGM, gsz = (nM - fm) < WGM ? (nM - fm) : WGM;
        u.pm = fm + ((wgid % nig) % gsz); u.pn = (wgid % nig) / gsz; u.rh = 0;
    }
    __host__ __device__ __forceinline__ bool next(int i, Unit& u) const {
        u.idx = i;
        if (lin_cnt >= 0) { if (i >= lin_cnt) return false; map(lin_base + i, u); return true; }
        const long L = (long)i * G + c; if (L >= limit) return false;
        map((int)L, u); return true;
    }
};

__device__ __forceinline__ unsigned cvt_pk_bf16(float lo, float hi) { unsigned r; asm volatile("v_cvt_pk_bf16_f32 %0, %1, %2" : "=v"(r) : "v"(lo), "v"(hi)); return r; }
__device__ __forceinline__ float bf_lo(unsigned w) { return __uint_as_float(w << 16); }
__device__ __forceinline__ float bf_hi(unsigned w) { return __uint_as_float(w & 0xffff0000u); }
__device__ __forceinline__ float sigmoidf_(float x) { return __builtin_amdgcn_rcpf(1.0f + __expf(-x)); }
__device__ __forceinline__ float gelu_tanh_(float x) { const float z = 1.5957691216057308f * (x + 0.044715f * x * x * x); return x * sigmoidf_(z); }
__device__ __forceinline__ u32x4 pack8(const f32x4 a, const f32x4 b) { u32x4 w; w.x = cvt_pk_bf16(a[0], a[1]); w.y = cvt_pk_bf16(a[2], a[3]); w.z = cvt_pk_bf16(b[0], b[1]); w.w = cvt_pk_bf16(b[2], b[3]); return w; }
__device__ __forceinline__ void unpack8(const u32x4 w, f32x4& a, f32x4& b) { a = (f32x4){bf_lo(w.x), bf_hi(w.x), bf_lo(w.y), bf_hi(w.y)}; b = (f32x4){bf_lo(w.z), bf_hi(w.z), bf_lo(w.w), bf_hi(w.w)}; }

#define EPI_ROWS_BEGIN _Pragma("unroll") for (int ai = 0; ai < NAI; ++ai) _Pragma("unroll") for (int m = 0; m < 4; ++m) { const int row = u.pm * BM + u.rh + ai * HALF + wr * 64 + m * 16 + fr;
#define EPI_ROWS_END }

struct EpiProj {
    bf16_t *UP, *UR, *UG, *RB, *G1; int pn_off;
    template <int NAI> __device__ __forceinline__ void run(const f32x4 (&acc)[2][2][4][2], const Unit& u, int wr, int wc, int fr, int fq) const {
        const int pn = u.pn + pn_off;
        if (pn < 10) {
            bf16_t* base; int ldc, colt;
            if (pn < 2) { base = UP; ldc = 512; colt = pn * 256; }
            else if (pn < 6) { base = UR; ldc = 1024; colt = (pn - 2) * 256; }
            else { base = UG; ldc = 1024; colt = (pn - 6) * 256; }
            const int col0 = colt + wc * 32 + 8 * fq;
            EPI_ROWS_BEGIN
                bf16_t* rowp = base + (unsigned)((unsigned)row * (unsigned)ldc + (unsigned)col0);
#pragma unroll
                for (int bj = 0; bj < 2; ++bj) *(u32x4*)(rowp + bj * HALF) = pack8(acc[ai][bj][m][0], acc[ai][bj][m][1]);
            EPI_ROWS_END
        } else {
            const int ch0 = (pn - 10) * 128 + wc * 32 + 8 * fq;
            EPI_ROWS_BEGIN
                const unsigned off = (unsigned)row * 1024u + (unsigned)ch0; f32x4 rr[2], gg[2];
#pragma unroll
                for (int n = 0; n < 2; ++n)
#pragma unroll
                    for (int j = 0; j < 4; ++j) { const float d0 = 1.0f + fminf(__expf(-acc[ai][0][m][n][j]), 1e18f), d1 = 1.0f + fminf(__expf(-acc[ai][1][m][n][j]), 1e18f);
                        const float q = __builtin_amdgcn_rcpf(d0 * d1); gg[n][j] = d0 * q; rr[n][j] = d1 * d1 * q; }
                *(u32x4*)(RB + off) = pack8(rr[0], rr[1]); *(u32x4*)(G1 + off) = pack8(gg[0], gg[1]);
            EPI_ROWS_END
        }
    }
};
struct EpiGrp {
    bf16_t* O; int ldc; const float* scale;
    template <int NAI> __device__ __forceinline__ void run(const f32x4 (&acc)[2][2][4][2], const Unit& u, int wr, int wc, int fr, int fq) const {
        const int col0 = u.pn * BM + wc * 32 + 8 * fq;
        f32x4 sc[2][2];
#pragma unroll
        for (int bj = 0; bj < 2; ++bj)
#pragma unroll
            for (int n = 0; n < 2; ++n) sc[bj][n] = *(const f32x4*)(scale + col0 + bj * HALF + 4 * n);
        EPI_ROWS_BEGIN
            bf16_t* rowp = O + (unsigned)((unsigned)row * (unsigned)ldc + (unsigned)col0);
#pragma unroll
            for (int bj = 0; bj < 2; ++bj) *(u32x4*)(rowp + bj * HALF) = pack8(acc[ai][bj][m][0] * sc[bj][0], acc[ai][bj][m][1] * sc[bj][1]);
        EPI_ROWS_END
    }
};
struct EpiGate {
    const bf16_t* V; bf16_t *LA, *BB; const float *b_a, *b_x, *sp8;
    template <int NAI, bool EXACT> __device__ __forceinline__ void rows(const f32x4 (&acc)[2][2][4][2], const Unit& u, int wr, int fr, int ch0, const f32x4 (&ba)[2], const f32x4 (&bx)[2], const f32x4 (&sp)[2]) const {
        EPI_ROWS_BEGIN
            const unsigned off = (unsigned)row * 1024u + (unsigned)ch0;
            const u32x4 vw = *(const u32x4*)(V + ((unsigned)row * 1536u + (unsigned)ch0)); f32x4 vv[2]; unpack8(vw, vv[0], vv[1]);
            f32x4 la[2], bb[2];
#pragma unroll
            for (int n = 0; n < 2; ++n)
#pragma unroll
                for (int j = 0; j < 4; ++j) {
                    const float r = sigmoidf_(acc[ai][0][m][n][j] + ba[n][j]), ig = sigmoidf_(acc[ai][1][m][n][j] + bx[n][j]);
                    const float l = sp[n][j] * r, x2 = 2.0f * l;
                    const float poly = x2 * (1.0f + 0.5f * x2 * (1.0f + 0.33333334f * x2 * (1.0f + 0.25f * x2 * (1.0f + 0.2f * x2 * (1.0f + 0.16666667f * x2)))));
                    const float em1 = EXACT ? ((x2 > -0.25f) ? poly : (__expf(x2) - 1.0f)) : poly;
                    la[n][j] = l; bb[n][j] = __builtin_amdgcn_sqrtf(fmaxf(-em1, 0.f)) * ig * vv[n][j]; }
            *(u32x4*)(LA + off) = pack8(la[0], la[1]); *(u32x4*)(BB + off) = pack8(bb[0], bb[1]);
            asm volatile("" ::: "memory");
        EPI_ROWS_END
    }
    template <int NAI> __device__ __forceinline__ void run(const f32x4 (&acc)[2][2][4][2], const Unit& u, int wr, int wc, int fr, int fq) const {
        const int ch0 = u.pn * 128 + wc * 32 + 8 * fq;
        f32x4 ba[2], bx[2], sp[2]; bool big = false;
#pragma unroll
        for (int n = 0; n < 2; ++n) { ba[n] = *(const f32x4*)(b_a + ch0 + 4 * n); bx[n] = *(const f32x4*)(b_x + ch0 + 4 * n); sp[n] = *(const f32x4*)(sp8 + ch0 + 4 * n);
#pragma unroll
            for (int j = 0; j < 4; ++j) big = big || !(sp[n][j] >= -0.125f); }
        if (__builtin_amdgcn_ballot_w64(big) != 0ull) rows<NAI, true>(acc, u, wr, fr, ch0, ba, bx, sp);
        else rows<NAI, false>(acc, u, wr, fr, ch0, ba, bx, sp);
    }
};
struct EpiMix {
    const bf16_t *RB, *G1; bf16_t* MIXB;
    __device__ __forceinline__ void mid(f32x4 (&acc)[2][2][4][2], const Unit& u0, int wr, int wc, int fr, int fq) const {
        constexpr int NAI = 2; Unit u = u0; asm volatile("" : "+s"(u.pm), "+s"(u.pn));
        const int col0 = u.pn * BM + wc * 32 + 8 * fq;
        EPI_ROWS_BEGIN
            const unsigned off = (unsigned)row * 1024u + (unsigned)col0;
#pragma unroll
            for (int bj = 0; bj < 2; ++bj) { f32x4 r[2]; unpack8(*(const u32x4*)(RB + off + bj * HALF), r[0], r[1]); acc[ai][bj][m][0] *= r[0]; acc[ai][bj][m][1] *= r[1]; }
        EPI_ROWS_END
    }
    template <int NAI> __device__ __forceinline__ void run(const f32x4 (&acc)[2][2][4][2], const Unit& u, int wr, int wc, int fr, int fq) const {
        const int col0 = u.pn * BM + wc * 32 + 8 * fq;
        EPI_ROWS_BEGIN
            const unsigned off = (unsigned)row * 1024u + (unsigned)col0;
#pragma unroll
            for (int bj = 0; bj < 2; ++bj) { f32x4 g[2]; unpack8(*(const u32x4*)(G1 + off + bj * HALF), g[0], g[1]);
                *(u32x4*)(MIXB + off + bj * HALF) = pack8(g[0] * acc[ai][bj][m][0], g[1] * acc[ai][bj][m][1]); }
        EPI_ROWS_END
    }
};
struct EpiRes1 {
    const float* X; bf16_t* X1B; float* SSQ;
    template <int NAI> __device__ __forceinline__ void run(const f32x4 (&acc)[2][2][4][2], const Unit& u, int wr, int wc, int fr, int fq) const {
        const int col0 = u.pn * BM + wc * 32 + 8 * fq;
        EPI_ROWS_BEGIN
            const unsigned off = (unsigned)row * 1024u + (unsigned)col0; float ss = 0.f;
#pragma unroll
            for (int bj = 0; bj < 2; ++bj) {
                const f32x4 a = *(const f32x4*)(X + off + bj * HALF) + acc[ai][bj][m][0], b = *(const f32x4*)(X + off + bj * HALF + 4) + acc[ai][bj][m][1];
                *(u32x4*)(X1B + off + bj * HALF) = pack8(a, b);
                ss += (a[0] * a[0] + a[1] * a[1]) + (a[2] * a[2] + a[3] * a[3]) + (b[0] * b[0] + b[1] * b[1]) + (b[2] * b[2] + b[3] * b[3]); }
            ss += __shfl_xor(ss, 16); ss += __shfl_xor(ss, 32);
            if (fq == 0) SSQ[(unsigned)row * 16u + (unsigned)(u.pn * 4 + wc)] = ss;
        EPI_ROWS_END
    }
};
struct EpiSwiglu {
    const PG8_LAS float* RSL; bf16_t* ACT;
    template <int NAI> __device__ __forceinline__ void run(const f32x4 (&acc)[2][2][4][2], const Unit& u, int wr, int wc, int fr, int fq) const {
        const int col0 = u.pn * 128 + wc * 32 + 8 * fq;
        const PG8_LAS float* rt = RSL + u.idx * 256 + wr * 64 + fr;
        EPI_ROWS_BEGIN
            const float rs = rt[ai * HALF + m * 16];
            f32x4 o[2];
#pragma unroll
            for (int n = 0; n < 2; ++n)
#pragma unroll
                for (int j = 0; j < 4; ++j) { const float g = acc[ai][0][m][n][j] * rs, up = acc[ai][1][m][n][j] * rs; o[n][j] = g * sigmoidf_(g) * up; }
            __builtin_nontemporal_store(pack8(o[0], o[1]), (u32x4*)(ACT + (unsigned)((unsigned)row * 2816u + (unsigned)col0)));
        EPI_ROWS_END
    }
};
struct EpiRes2 {
    const bf16_t* X1B; float* OUT;
    template <int NAI> __device__ __forceinline__ void run(const f32x4 (&acc)[2][2][4][2], const Unit& u, int wr, int wc, int fr, int fq) const {
        const int col0 = u.pn * BM + wc * 32 + 8 * fq;
        EPI_ROWS_BEGIN
            const unsigned off = (unsigned)row * 1024u + (unsigned)col0;
#pragma unroll
            for (int bj = 0; bj < 2; ++bj) { f32x4 xa, xb; unpack8(*(const u32x4*)(X1B + off + bj * HALF), xa, xb);
                *(f32x4*)(OUT + off + bj * HALF) = xa + acc[ai][bj][m][0]; *(f32x4*)(OUT + off + bj * HALF + 4) = xb + acc[ai][bj][m][1]; }
        EPI_ROWS_END
    }
};

struct EpiFinal {
    const bf16_t* X1B; float* OUT; float* SSQ2; unsigned* cnt; const float* gfin;
    template <int NAI> __device__ __forceinline__ void run(f32x4 (&acc)[2][2][4][2], const Unit& u, int wr, int wc, int fr, int fq) const {
        const int col0 = u.pn * BM + wc * 32 + 8 * fq;
        EPI_ROWS_BEGIN
            const unsigned off = (unsigned)row * 1024u + (unsigned)col0; float ss = 0.f;
#pragma unroll
            for (int bj = 0; bj < 2; ++bj) { f32x4 xa, xb; unpack8(*(const u32x4*)(X1B + off + bj * HALF), xa, xb);
                const f32x4 a = xa + acc[ai][bj][m][0], b = xb + acc[ai][bj][m][1]; acc[ai][bj][m][0] = a; acc[ai][bj][m][1] = b;
                ss += (a[0] * a[0] + a[1] * a[1]) + (a[2] * a[2] + a[3] * a[3]) + (b[0] * b[0] + b[1] * b[1]) + (b[2] * b[2] + b[3] * b[3]); }
            ss += __shfl_xor(ss, 16); ss += __shfl_xor(ss, 32);
            if (fq == 0) __hip_atomic_store(SSQ2 + (unsigned)row * 16u + (unsigned)(u.pn * 4 + wc), ss, __ATOMIC_RELAXED, __HIP_MEMORY_SCOPE_AGENT);
        EPI_ROWS_END
        asm volatile("s_waitcnt vmcnt(0)" ::: "memory");
        unsigned* c = cnt + 64 * u.pm;
        if ((threadIdx.x & 63) == 0) __hip_atomic_fetch_add(c, 1u, __ATOMIC_RELAXED, __HIP_MEMORY_SCOPE_AGENT);
        { unsigned sp = 0;
          while ((unsigned)__builtin_amdgcn_readfirstlane(__hip_atomic_load(c, __ATOMIC_RELAXED, __HIP_MEMORY_SCOPE_AGENT)) < 32u) { __builtin_amdgcn_s_sleep(2); if (++sp > (1u << 20)) break; } }
        __builtin_amdgcn_fence(__ATOMIC_ACQUIRE, "agent");
        f32x4 gv[2][2];
#pragma unroll
        for (int bj = 0; bj < 2; ++bj)
#pragma unroll
            for (int n = 0; n < 2; ++n) gv[bj][n] = *(const f32x4*)(gfin + col0 + bj * HALF + 4 * n);
        EPI_ROWS_BEGIN
            const unsigned off = (unsigned)row * 1024u + (unsigned)col0;
            const unsigned long long* sl = (const unsigned long long*)(SSQ2 + (unsigned)row * 16u + (unsigned)(4 * fq));
            const unsigned long long w0 = __hip_atomic_load(sl, __ATOMIC_RELAXED, __HIP_MEMORY_SCOPE_AGENT), w1 = __hip_atomic_load(sl + 1, __ATOMIC_RELAXED, __HIP_MEMORY_SCOPE_AGENT);
            float sq = (__uint_as_float((unsigned)w0) + __uint_as_float((unsigned)(w0 >> 32))) + (__uint_as_float((unsigned)w1) + __uint_as_float((unsigned)(w1 >> 32)));
            sq += __shfl_xor(sq, 16); sq += __shfl_xor(sq, 32);
            const float rs = 1.0f / sqrtf(sq * (1.0f / 1024.0f) + 1e-6f);
#pragma unroll
            for (int bj = 0; bj < 2; ++bj) { *(f32x4*)(OUT + off + bj * HALF) = acc[ai][bj][m][0] * rs * gv[bj][0]; *(f32x4*)(OUT + off + bj * HALF + 4) = acc[ai][bj][m][1] * rs * gv[bj][1]; }
        EPI_ROWS_END
    }
};

template <class Epi, bool ALIGN_EPI, int MID_T = -1>
__device__ __forceinline__ void gemm_phase(PG8_LAS unsigned char* lds, const Gemm g, const StaticOrder& S, const Epi& E) {
    const int tid = threadIdx.x, wid = __builtin_amdgcn_readfirstlane(tid >> 6), lane = tid & 63, wr = wid >> 2, wc = wid & 3, fr = lane & 15, fq = lane >> 4;
    int nt = g.K / BK; asm volatile("" : "+s"(nt));
    unsigned voffA[2], voffB[2];
#pragma unroll
    for (int i = 0; i < 2; ++i) { int R, C; stage_rc(tid * 16 + i * 8192, R, C); const int Rb = (R & ~31) + perm32(R & 31);
        voffA[i] = (unsigned)(R * g.lda + C) * 2u; voffB[i] = (unsigned)(Rb * g.ldb + C) * 2u; }
    const size_t kstep = (size_t)(BK * 2);
    const size_t hstepA = (size_t)HALF * g.lda * 2, hstepB = (size_t)HALF * g.ldb * 2;
    const size_t tstepA = 2 * hstepA, tstepB = 2 * hstepB;
    const unsigned ldsw = (unsigned)wid * 1024u;
    const int aoff = lds_byte(wr * 64 + fr, fq * 8), boff = lds_byte(wc * 32 + fr, fq * 8);
#define PG8_SA(b, h) (((b) * 2 + (h)) * HTB)
#define PG8_SB(b, h) ((4 + (b) * 2 + (h)) * HTB)
#define PG8_STAGE(bufoff, gbase, voff) do { _Pragma("unroll") for (int _i = 0; _i < 2; ++_i) \
        __builtin_amdgcn_global_load_lds((const unsigned*)((const char*)(gbase) + (voff)[_i]), (PG8_LAS unsigned*)(lds + (bufoff) + ldsw + _i * 8192), 16, 0, 0); } while (0)
#define PG8_LDA(dst, b, h) do { _Pragma("unroll") for (int m = 0; m < 4; ++m) _Pragma("unroll") for (int k = 0; k < 2; ++k) dst[m][k] = *(const PG8_LAS bf16x8*)(lds + PG8_SA(b, h) + aoff + m * 2048 + k * 1024); } while (0)
#define PG8_LDB(dst, b, h) do { _Pragma("unroll") for (int n = 0; n < 2; ++n) _Pragma("unroll") for (int k = 0; k < 2; ++k) dst[n][k] = *(const PG8_LAS bf16x8*)(lds + PG8_SB(b, h) + boff + n * 2048 + k * 1024); } while (0)
#define PG8_MMA(ai, bj, At, Bt) do { __builtin_amdgcn_s_setprio(1); _Pragma("unroll") for (int m = 0; m < 4; ++m) _Pragma("unroll") for (int n = 0; n < 2; ++n) _Pragma("unroll") for (int k = 0; k < 2; ++k) \
        acc[ai][bj][m][n] = __builtin_amdgcn_mfma_f32_16x16x32_bf16(Bt[n][k], At[m][k], acc[ai][bj][m][n], 0, 0, 0); __builtin_amdgcn_s_setprio(0); } while (0)
#define PG8_WAIT_V(n) asm volatile("s_waitcnt vmcnt(" #n ")" ::: "memory")
#define PG8_WAIT_L(n) asm volatile("s_waitcnt lgkmcnt(" #n ")" ::: "memory")
#define PG8_BAR __builtin_amdgcn_s_barrier()
#define PG8_SCHED __builtin_amdgcn_sched_barrier(0)
    Unit cur, nxt; int ui = 0;
    if (!S.next(0, cur)) return;
    f32x4 acc[2][2][4][2];
#pragma unroll
    for (int a = 0; a < 2; ++a)
#pragma unroll
        for (int b = 0; b < 2; ++b)
#pragma unroll
            for (int m = 0; m < 4; ++m)
#pragma unroll
                for (int n = 0; n < 2; ++n) acc[a][b][m][n] = (f32x4){0.f, 0.f, 0.f, 0.f};
    bf16x8 At[4][2], B0[2][2], B1[2][2];
    const char* cA = (const char*)g.A + (size_t)cur.pm * tstepA + (size_t)((cur.pn >> g.ash) * g.amul) * 2; const char* cB = (const char*)g.Bt + (size_t)cur.pn * tstepB;
    PG8_STAGE(PG8_SB(0, 0), cB, voffB); PG8_STAGE(PG8_SB(0, 1), cB + hstepB, voffB); PG8_STAGE(PG8_SA(0, 0), cA, voffA); PG8_STAGE(PG8_SA(0, 1), cA + hstepA, voffA);
    if (wr == 1) PG8_BAR;
    PG8_WAIT_V(2); PG8_BAR;
    PG8_STAGE(PG8_SB(1, 0), cB + kstep, voffB); PG8_STAGE(PG8_SA(1, 0), cA + kstep, voffA); PG8_STAGE(PG8_SB(1, 1), cB + hstepB + kstep, voffB);
    PG8_WAIT_V(6); PG8_BAR;
    for (;;) {
        const bool has_next = S.next(ui + 1, nxt);
        const char* nA = has_next ? (const char*)g.A + (size_t)nxt.pm * tstepA + (size_t)((nxt.pn >> g.ash) * g.amul) * 2 : cA; const char* nB = has_next ? (const char*)g.Bt + (size_t)nxt.pn * tstepB : cB;
        for (int t = 0; t < nt; t += 2) {
            const bool last = (t == nt - 2);
            if constexpr (MID_T >= 0) { if (t == MID_T) E.mid(acc, cur, wr, wc, fr, fq); }
            const char* a1 = cA + (size_t)(t + 1) * kstep;
            const char* a2 = last ? nA : cA + (size_t)(t + 2) * kstep; const char* b2 = last ? nB : cB + (size_t)(t + 2) * kstep;
            const char* a3 = a2 + kstep; const char* b3 = b2 + kstep;
            PG8_LDB(B0, 0, 0); PG8_LDB(B1, 0, 1); PG8_SCHED; PG8_LDA(At, 0, 0); PG8_STAGE(PG8_SA(1, 1), a1 + hstepA, voffA);
            PG8_WAIT_V(8); PG8_WAIT_L(0); PG8_BAR; PG8_MMA(0, 0, At, B0); PG8_MMA(0, 1, At, B1); PG8_BAR; PG8_SCHED;
            PG8_LDA(At, 0, 1); PG8_STAGE(PG8_SB(0, 0), b2, voffB); PG8_STAGE(PG8_SB(0, 1), b2 + hstepB, voffB); PG8_STAGE(PG8_SA(0, 0), a2, voffA);
            PG8_WAIT_V(8); PG8_WAIT_L(0); PG8_BAR; PG8_MMA(1, 0, At, B0); PG8_MMA(1, 1, At, B1); PG8_BAR; PG8_SCHED;
            PG8_LDB(B0, 1, 0); PG8_LDB(B1, 1, 1); PG8_SCHED; PG8_LDA(At, 1, 0); PG8_STAGE(PG8_SA(0, 1), a2 + hstepA, voffA);
            PG8_WAIT_V(8); PG8_WAIT_L(0); PG8_BAR; PG8_MMA(0, 0, At, B0); PG8_MMA(0, 1, At, B1); PG8_BAR; PG8_SCHED;
            PG8_LDA(At, 1, 1); PG8_STAGE(PG8_SB(1, 0), b3, voffB); PG8_STAGE(PG8_SB(1, 1), b3 + hstepB, voffB); PG8_STAGE(PG8_SA(1, 0), a3, voffA);
            PG8_WAIT_V(8); PG8_WAIT_L(0); PG8_BAR; PG8_MMA(1, 0, At, B0); PG8_MMA(1, 1, At, B1); PG8_BAR; PG8_SCHED;
        }
        if constexpr (ALIGN_EPI) { if (wr == 0) PG8_BAR; }
        E.template run<2>(acc, cur, wr, wc, fr, fq);
        if (!has_next) break;
#pragma unroll
        for (int a = 0; a < 2; ++a)
#pragma unroll
            for (int b = 0; b < 2; ++b)
#pragma unroll
                for (int m = 0; m < 4; ++m)
#pragma unroll
                    for (int n = 0; n < 2; ++n) acc[a][b][m][n] = (f32x4){0.f, 0.f, 0.f, 0.f};
        cur = nxt; cA = nA; cB = nB; ++ui;
        if constexpr (ALIGN_EPI) { if (wr == 1) PG8_BAR; }
    }
    PG8_WAIT_V(0);
    if constexpr (!ALIGN_EPI) { if (wr == 0) PG8_BAR; }
    PG8_BAR;
#undef PG8_SA
#undef PG8_SB
#undef PG8_STAGE
#undef PG8_LDA
#undef PG8_LDB
#undef PG8_MMA
#undef PG8_WAIT_V
#undef PG8_WAIT_L
#undef PG8_BAR
#undef PG8_SCHED
}

template <class Epi>
__device__ __forceinline__ void gemm_half(PG8_LAS unsigned char* lds, const Gemm g, const Unit u, const Epi& E) {
    const int tid = threadIdx.x, wid = __builtin_amdgcn_readfirstlane(tid >> 6), lane = tid & 63, wr = wid >> 2, wc = wid & 3, fr = lane & 15, fq = lane >> 4;
    int nt = g.K / BK; asm volatile("" : "+s"(nt));
    unsigned voffA[2], voffB[2];
#pragma unroll
    for (int i = 0; i < 2; ++i) { int R, C; stage_rc(tid * 16 + i * 8192, R, C); const int Rb = (R & ~31) + perm32(R & 31);
        voffA[i] = (unsigned)(R * g.lda + C) * 2u; voffB[i] = (unsigned)(Rb * g.ldb + C) * 2u; }
    const size_t kstep = (size_t)(BK * 2);
    const size_t hstepA = (size_t)HALF * g.lda * 2, hstepB = (size_t)HALF * g.ldb * 2;
    const unsigned ldsw = (unsigned)wid * 1024u;
    const int aoff = lds_byte(wr * 64 + fr, fq * 8), boff = lds_byte(wc * 32 + fr, fq * 8);
#define PG8_SA(b, h) (((b) * 2 + (h)) * HTB)
#define PG8_SB(b, h) ((4 + (b) * 2 + (h)) * HTB)
#define PG8_STAGE(bufoff, gbase, voff) do { _Pragma("unroll") for (int _i = 0; _i < 2; ++_i) \
        __builtin_amdgcn_global_load_lds((const unsigned*)((const char*)(gbase) + (voff)[_i]), (PG8_LAS unsigned*)(lds + (bufoff) + ldsw + _i * 8192), 16, 0, 0); } while (0)
#define PG8_LDA(dst, b, h) do { _Pragma("unroll") for (int m = 0; m < 4; ++m) _Pragma("unroll") for (int k = 0; k < 2; ++k) dst[m][k] = *(const PG8_LAS bf16x8*)(lds + PG8_SA(b, h) + aoff + m * 2048 + k * 1024); } while (0)
#define PG8_LDB(dst, b, h) do { _Pragma("unroll") for (int n = 0; n < 2; ++n) _Pragma("unroll") for (int k = 0; k < 2; ++k) dst[n][k] = *(const PG8_LAS bf16x8*)(lds + PG8_SB(b, h) + boff + n * 2048 + k * 1024); } while (0)
#define PG8_MMA(ai, bj, At, Bt) do { __builtin_amdgcn_s_setprio(1); _Pragma("unroll") for (int m = 0; m < 4; ++m) _Pragma("unroll") for (int n = 0; n < 2; ++n) _Pragma("unroll") for (int k = 0; k < 2; ++k) \
        acc[ai][bj][m][n] = __builtin_amdgcn_mfma_f32_16x16x32_bf16(Bt[n][k], At[m][k], acc[ai][bj][m][n], 0, 0, 0); __builtin_amdgcn_s_setprio(0); } while (0)
#define PG8_WAIT_V(n) asm volatile("s_waitcnt vmcnt(" #n ")" ::: "memory")
#define PG8_WAIT_L(n) asm volatile("s_waitcnt lgkmcnt(" #n ")" ::: "memory")
#define PG8_BAR __builtin_amdgcn_s_barrier()
#define PG8_SCHED __builtin_amdgcn_sched_barrier(0)
    f32x4 acc[2][2][4][2];
#pragma unroll
    for (int a = 0; a < 2; ++a)
#pragma unroll
        for (int b = 0; b < 2; ++b)
#pragma unroll
            for (int m = 0; m < 4; ++m)
#pragma unroll
                for (int n = 0; n < 2; ++n) acc[a][b][m][n] = (f32x4){0.f, 0.f, 0.f, 0.f};
    bf16x8 At[4][2], B0[2][2], B1[2][2];
    const char* cA = (const char*)g.A + ((size_t)u.pm * BM + u.rh) * g.lda * 2 + (size_t)((u.pn >> g.ash) * g.amul) * 2; const char* cB = (const char*)g.Bt + (size_t)u.pn * 2 * hstepB;
    PG8_STAGE(PG8_SB(0, 0), cB, voffB); PG8_STAGE(PG8_SB(0, 1), cB + hstepB, voffB); PG8_STAGE(PG8_SA(0, 0), cA, voffA);
    PG8_STAGE(PG8_SB(1, 0), cB + kstep, voffB); PG8_STAGE(PG8_SB(1, 1), cB + hstepB + kstep, voffB); PG8_STAGE(PG8_SA(1, 0), cA + kstep, voffA);
    PG8_WAIT_V(6); PG8_BAR;
#define PG8_HALF_STEP(b, tt) do { \
        PG8_LDB(B0, b, 0); PG8_LDB(B1, b, 1); PG8_LDA(At, b, 0); PG8_WAIT_L(0); PG8_BAR; PG8_SCHED; \
        const bool more_ = (tt) + 2 < nt; \
        if (more_) { const char* b2 = cB + (size_t)((tt) + 2) * kstep; const char* a2 = cA + (size_t)((tt) + 2) * kstep; \
            PG8_STAGE(PG8_SB(b, 0), b2, voffB); PG8_STAGE(PG8_SB(b, 1), b2 + hstepB, voffB); PG8_STAGE(PG8_SA(b, 0), a2, voffA); } \
        PG8_MMA(0, 0, At, B0); PG8_MMA(0, 1, At, B1); \
        if (more_) PG8_WAIT_V(6); else PG8_WAIT_V(0); \
        PG8_BAR; PG8_SCHED; } while (0)
    for (int t = 0; t < nt; t += 2) { PG8_HALF_STEP(0, t); PG8_HALF_STEP(1, t + 1); }
    E.template run<1>(acc, u, wr, wc, fr, fq);
    PG8_BAR;
#undef PG8_HALF_STEP
#undef PG8_SA
#undef PG8_SB
#undef PG8_STAGE
#undef PG8_LDA
#undef PG8_LDB
#undef PG8_MMA
#undef PG8_WAIT_V
#undef PG8_WAIT_L
#undef PG8_BAR
#undef PG8_SCHED
}
}

constexpr int NWAVES = 8, NTHR = 512;
constexpr int M = 16384, SEQ = 4096, NB = 4, D = 1024, DPOOL = 512, DRNN = 1024, DIN = 4608, DFF = 2816;
constexpr float EPS = 1e-6f;
constexpr int NPH = 11;
constexpr int SCAN_T = 128, SCAN_NC = SEQ / SCAN_T;

constexpr size_t MiB = 1u << 20;
constexpr size_t WS_SP8 = 512 * 1024;
constexpr size_t WS_SSQ = 1 * MiB;
constexpr size_t WS_SSQ2 = 2 * MiB;
constexpr size_t WS_CS = 2 * MiB, WS_CH = 3 * MiB;
constexpr size_t WS_WIN = 4 * MiB;
constexpr size_t WS_WFI = 13 * MiB;
constexpr size_t WS_WFO = 24 * MiB;
constexpr size_t WS_WCAT = WS_WFO + 5632 * 1024;
constexpr size_t WS_WO = WS_WCAT + 3 * MiB;
constexpr size_t WS_WGRP = WS_WO + 2 * MiB;
constexpr size_t WS_WGATE = WS_WGRP + MiB / 4;
constexpr size_t WS_R1 = 36 * MiB;
constexpr size_t WS_R2 = 68 * MiB;
constexpr size_t WS_R3 = 84 * MiB;
constexpr size_t WS_R4 = 116 * MiB;
constexpr size_t WS_R7 = 148 * MiB;
constexpr size_t WS_R8 = 164 * MiB;
constexpr size_t WS_CAT = 196 * MiB;
constexpr size_t WS_MIXB = 148 * MiB;
constexpr size_t WS_ACT = 68 * MiB;
constexpr size_t WS_END = 244 * MiB;

constexpr int LDS_BYTES = 147456;

#define LAS __attribute__((address_space(3)))
typedef unsigned short bf16;
typedef unsigned v4u __attribute__((ext_vector_type(4)));
typedef unsigned v2u __attribute__((ext_vector_type(2)));
typedef float f32x4 __attribute__((ext_vector_type(4)));
typedef float f32x2 __attribute__((ext_vector_type(2)));
#define LDS_WAIT() asm volatile("s_waitcnt lgkmcnt(0)" ::: "memory")
using pg8::cvt_pk_bf16; using pg8::bf_lo; using pg8::bf_hi;

struct Args { const float* in[19]; float* out; unsigned char* ws; int ph_lo, ph_hi; };
enum { I_X = 0, I_NORM_MIX, I_W_IN, I_W_GRP, I_POOL_SCALE, I_W_POOL_OUT, I_CONV_W, I_CONV_B, I_W_RG_A, I_B_RG_A, I_W_RG_X, I_B_RG_X, I_LAMBDA, I_W_RNN_OUT, I_W_O, I_NORM_FFN, I_W_FFN_IN, I_W_FFN_OUT, I_NORM_FINAL };

__device__ __forceinline__ float wave_sum(float v) {
#pragma unroll
    for (int o = 1; o < 64; o <<= 1) v += __shfl_xor(v, o);
    return v;
}

__device__ __forceinline__ void transpose_item(const float* W, int Nsrc, int Kdst, bf16* WT, int k0, int n_src0, int n_dst0, const float* kscale, LAS float* scr, int lane) {
    f32x4 v[8]; const int n4 = (lane & 7) * 4;
#pragma unroll
    for (int i = 0; i < 8; ++i) { const int kk = 8 * i + (lane >> 3); v[i] = *(const f32x4*)(W + (size_t)(k0 + kk) * Nsrc + n_src0 + n4); }
    if (kscale) {
#pragma unroll
        for (int i = 0; i < 8; ++i) v[i] = v[i] * kscale[k0 + 8 * i + (lane >> 3)]; }
#pragma unroll
    for (int i = 0; i < 8; ++i) { const int kk = 8 * i + (lane >> 3);
#pragma unroll
        for (int j = 0; j < 4; ++j) scr[kk * 33 + n4 + j] = v[i][j]; }
    LDS_WAIT(); asm volatile("" ::: "memory");
    const int c = lane & 7;
#pragma unroll
    for (int j = 0; j < 4; ++j) { const int n = (lane >> 3) + 8 * j; const LAS float* s = scr + (8 * c) * 33 + n;
        v4u o; o.x = cvt_pk_bf16(s[0 * 33], s[1 * 33]); o.y = cvt_pk_bf16(s[2 * 33], s[3 * 33]); o.z = cvt_pk_bf16(s[4 * 33], s[5 * 33]); o.w = cvt_pk_bf16(s[6 * 33], s[7 * 33]);
        *(v4u*)(WT + (size_t)(n_dst0 + n) * Kdst + k0 + 8 * c) = o; }
    LDS_WAIT(); asm volatile("" ::: "memory");
}

#define XB_TMO      128
#define XB_XCNT(j)  (256  + 64 * (j))
#define XB_XSUB(j)  (1280 + 64 * (j))
#define XB_XGEN(j)  (2304 + 64 * (j))
#define XB_TOP      3328
#define XB_TOPGEN   3392
#define XCD_BAR_WORDS 3456
#define XB_SPIN_CAP (1u << 18)
__device__ __forceinline__ unsigned xb_ld(unsigned* p)              { return __hip_atomic_load(p, __ATOMIC_RELAXED, __HIP_MEMORY_SCOPE_AGENT); }
__device__ __forceinline__ unsigned xb_add(unsigned* p, unsigned v) { return __hip_atomic_fetch_add(p, v, __ATOMIC_RELAXED, __HIP_MEMORY_SCOPE_AGENT); }
__device__ __forceinline__ unsigned xb_xcc_id() { return (unsigned)__builtin_amdgcn_s_getreg((3 << 11) | 20) & 0xFu; }
#define XB_SPIN(cond, bar) do { unsigned _sp = 0; while (cond) { __builtin_amdgcn_s_sleep(1); \
    if ((++_sp & 255u) == 0u) { if (xb_ld(&(bar)[XB_TMO])) break; if (_sp > XB_SPIN_CAP) { atomicAdd(&(bar)[XB_TMO], 1u); break; } } } } while (0)
struct XcdBarrier { unsigned* bar; unsigned x; volatile LAS unsigned* st; };
__device__ __forceinline__ XcdBarrier xcd_barrier_post(unsigned* bar, volatile LAS unsigned* st) {
    XcdBarrier b; b.bar = bar; b.x = xb_xcc_id(); b.st = st;
    if (threadIdx.x == 0) (void)xb_add(&bar[XB_XCNT(b.x)], 1u);
    return b;
}
__device__ __forceinline__ void xcd_barrier_complete(unsigned* bar, unsigned x, unsigned& nloc, unsigned& nx) {
    const unsigned G = gridDim.x * gridDim.y * gridDim.z;
    unsigned sum, cnt, mine, sp = 0u;
    for (;;) {
        sum = 0u; cnt = 0u; mine = 0u;
#pragma unroll
        for (unsigned j = 0; j < 16; ++j) { const unsigned c = xb_ld(&bar[XB_XCNT(j)]); sum += c; cnt += (c > 0u) ? 1u : 0u; mine = (j == x) ? c : mine; }
        if (sum == G) break;
        __builtin_amdgcn_s_sleep(1);
        if ((++sp & 255u) == 0u) { if (xb_ld(&bar[XB_TMO])) break; if (sp > XB_SPIN_CAP) { atomicAdd(&bar[XB_TMO], 1u); break; } }
    }
    nloc = mine > 0u ? mine : 1u; nx = cnt > 0u ? cnt : 1u;
}
__device__ __forceinline__ void xcd_barrier(const XcdBarrier& b) {
    asm volatile("s_waitcnt vmcnt(0)" ::: "memory");
    __syncthreads();
    if (threadIdx.x == 0) {
        unsigned* bar = b.bar;
        __builtin_amdgcn_s_waitcnt(0);
        unsigned nloc = b.st[0], nx = b.st[1];
        if (nloc == 0u) { xcd_barrier_complete(bar, b.x, nloc, nx); b.st[0] = nloc; b.st[1] = nx; }
        const unsigned old = xb_add(&bar[XB_XSUB(b.x)], 1u);
        const unsigned gen = old / nloc;
        if (old + 1u == (gen + 1u) * nloc) {
            __builtin_amdgcn_fence(__ATOMIC_RELEASE, "agent");
            asm volatile("s_waitcnt vmcnt(0)" ::: "memory");
            const unsigned og = xb_add(&bar[XB_TOP], 1u);
            const unsigned tg = og / nx;
            if (og + 1u == (tg + 1u) * nx) xb_add(&bar[XB_TOPGEN], 1u);
            else XB_SPIN(xb_ld(&bar[XB_TOPGEN]) == tg, bar);
            __builtin_amdgcn_fence(__ATOMIC_ACQUIRE, "agent");
            xb_add(&bar[XB_XGEN(b.x)], 1u);
            asm volatile("s_waitcnt vmcnt(0)" ::: "memory");
        } else {
            XB_SPIN(xb_ld(&bar[XB_XGEN(b.x)]) == gen, bar);
            __builtin_amdgcn_fence(__ATOMIC_ACQUIRE, "agent");
            asm volatile("s_waitcnt vmcnt(0)" ::: "memory");
        }
    }
    __syncthreads();
}

template <int W>
__device__ __forceinline__ void pool_item(const bf16* src, bf16* dst, int tl) {
    v4u rw[W + 7];
#pragma unroll
    for (int k = 0; k < W + 7; ++k) rw[k] = (tl + k - (W - 1) >= 0) ? *(const v4u*)(src + (ptrdiff_t)(k - (W - 1)) * DPOOL) : (v4u){0u, 0u, 0u, 0u};
    f32x4 s0 = {0.f, 0.f, 0.f, 0.f}, s1 = s0;
#pragma unroll
    for (int k = 0; k < W - 1; ++k) { f32x4 a, c; pg8::unpack8(rw[k], a, c); s0 += a; s1 += c; }
#pragma unroll
    for (int i = 0; i < 8; ++i) { f32x4 a, c; pg8::unpack8(rw[W - 1 + i], a, c); s0 += a; s1 += c;
        const int t = tl + i; const int cnt = (t + 1 < W) ? t + 1 : W; const float inv = 1.0f / (float)cnt;
        *(v4u*)(dst + (size_t)i * DPOOL) = pg8::pack8(s0 * inv - a, s1 * inv - c);
        f32x4 a2, c2; pg8::unpack8(rw[i], a2, c2); s0 -= a2; s1 -= c2; }
}
__device__ __forceinline__ void scan_local16(const bf16* lap, const bf16* bbp, f32x4 (&S)[2], f32x4 (&H)[2]) {
    S[0] = S[1] = H[0] = H[1] = (f32x4){0.f, 0.f, 0.f, 0.f};
#pragma unroll
    for (int i0 = 0; i0 < 16; i0 += 8) { v4u lw[8], bw[8];
#pragma unroll
        for (int i = 0; i < 8; ++i) { lw[i] = *(const v4u*)(lap + (size_t)(i0 + i) * DRNN); bw[i] = *(const v4u*)(bbp + (size_t)(i0 + i) * DRNN); }
#pragma unroll
        for (int i = 0; i < 8; ++i) { f32x4 l[2], bq[2]; pg8::unpack8(lw[i], l[0], l[1]); pg8::unpack8(bw[i], bq[0], bq[1]);
#pragma unroll
            for (int n = 0; n < 2; ++n)
#pragma unroll
                for (int j = 0; j < 4; ++j) { H[n][j] = __expf(l[n][j]) * H[n][j] + bq[n][j]; S[n][j] += l[n][j]; } } }
}

__global__ void __launch_bounds__(NTHR, 2) fwd_kernel(Args args) {
    extern __shared__ __attribute__((aligned(16))) unsigned char lds_raw[];
    LAS unsigned char* lds = (LAS unsigned char*)lds_raw;
    const int tid = threadIdx.x, lane = tid & 63, wave = __builtin_amdgcn_readfirstlane(tid >> 6);
    const int G = gridDim.x, bx = blockIdx.x;
    unsigned char* ws = args.ws;
    const int lo = args.ph_lo, hi = args.ph_hi;
#ifndef PHASE_MASK
#define PHASE_MASK 0x7ff
#endif
#define IN(k) (((PHASE_MASK >> (k)) & 1) && lo <= (k) && (k) < hi)
#ifndef REPEAT_MASK
#define REPEAT_MASK 0
#endif
#define REPS(k) (((REPEAT_MASK >> (k)) & 1) ? 2 : 1)
#ifndef PROBE_PHASE
#define PROBE_PHASE -1
#endif
#define PROBE_MULT 4
    unsigned long long tp0 = 0, tp1 = 0;
#define TSTART(k) do { if ((k) == PROBE_PHASE) tp0 = __builtin_amdgcn_s_memrealtime(); } while (0)
#define TEND(k) do { if ((k) == PROBE_PHASE) tp1 = __builtin_amdgcn_s_memrealtime(); } while (0)
#define GSYNC() xcd_barrier(bar)
#define SEAM(k) do { if (IN(k) && IN((k) + 1)) { GSYNC(); } } while (0)

    const float* x = args.in[I_X];
    bf16* WIN = (bf16*)(ws + WS_WIN); bf16* WFI = (bf16*)(ws + WS_WFI); bf16* WFO = (bf16*)(ws + WS_WFO); bf16* WCAT = (bf16*)(ws + WS_WCAT);
    bf16* WO = (bf16*)(ws + WS_WO); bf16* WGRP = (bf16*)(ws + WS_WGRP); bf16* WGATE = (bf16*)(ws + WS_WGATE);
    bf16* XN = (bf16*)(ws + WS_R1); bf16* X1B = XN;
    bf16* CAT = (bf16*)(ws + WS_CAT); bf16* V = CAT + 512;
    bf16* UP = (bf16*)(ws + WS_R2);
    bf16* UR = (bf16*)(ws + WS_R3); bf16* LA = UR;
    bf16* UG = (bf16*)(ws + WS_R4);
    bf16* POOLED = (bf16*)(ws + WS_R7); bf16* BB = (bf16*)(ws + WS_R8);
    bf16* MIXB = (bf16*)(ws + WS_MIXB); bf16* ACT = (bf16*)(ws + WS_ACT);
    float* SSQ = (float*)(ws + WS_SSQ); float* CS = (float*)(ws + WS_CS); float* CH = (float*)(ws + WS_CH);
    bf16* G0 = (bf16*)args.out; bf16* G1 = G0 + (size_t)M * 1024;
    float* X1 = args.out;

#ifndef EXTRA_SYNCS
#define EXTRA_SYNCS 0
#endif
    if (PROBE_PHASE == 99) tp0 = __builtin_amdgcn_s_memrealtime();
    volatile LAS unsigned* MISC = (volatile LAS unsigned*)(lds + 131072 + 1024);
    if (tid < 32) MISC[tid] = 0u;
    __syncthreads();
    XcdBarrier bar = xcd_barrier_post((unsigned*)ws, MISC + 8);
    if (lo < 0) cg::this_grid().sync();
    for (int i = 0; i < EXTRA_SYNCS; ++i) GSYNC();
    TSTART(0);
    if (IN(0)) for (int rep = 0; rep < REPS(0); ++rep) { if (rep) GSYNC();
        LAS float* scr = (LAS float*)(lds + wave * 16384);
        const int gw = bx * NWAVES + wave, NGW = G * NWAVES;
        constexpr int I_IN = 16 * (DIN / 32), I_FI = 16 * (2 * DFF / 32), I_FO = (DFF / 64) * (D / 32), I_RO = 16 * 32, I_WO = 16 * 32, I_PO = 8 * 32;
        constexpr int NITEMS = I_IN + I_FI + I_FO + I_RO + I_WO + I_PO;
        for (int it = gw; it < NITEMS; it += NGW) {
            int r = it;
            if (r < I_IN) { const int nblk = DIN / 32, kb = r / nblk, nb = r % nblk, nd = 32 * nb; int ns = nd;
                if (nd >= 2560) { const int q = nd - 2560, pq = q >> 8, j0 = q & 255; ns = 2560 + (j0 < 128 ? 128 * pq + j0 : 1024 + 128 * pq + (j0 - 128)); }
                transpose_item(args.in[I_W_IN], DIN, D, WIN, 64 * kb, ns, nd, nullptr, scr, lane); continue; } r -= I_IN;
            if (r < I_FI) { const int nblk = 2 * DFF / 32, kb = r / nblk, nb = r % nblk, nd = 32 * nb, pn = nd >> 8, j0 = nd & 255;
                const int ns = j0 < 128 ? 128 * pn + j0 : DFF + 128 * pn + (j0 - 128);
                transpose_item(args.in[I_W_FFN_IN], 2 * DFF, D, WFI, 64 * kb, ns, nd, args.in[I_NORM_FFN], scr, lane); continue; } r -= I_FI;
            if (r < I_FO) { if (G != 256) { const int nblk = D / 32, kb = r / nblk, nb = r % nblk; transpose_item(args.in[I_W_FFN_OUT], D, DFF, WFO, 64 * kb, 32 * nb, 32 * nb, nullptr, scr, lane); } continue; } r -= I_FO;
            if (r < I_RO) { const int nblk = D / 32, kb = r / nblk, nb = r % nblk; transpose_item(args.in[I_W_RNN_OUT], D, 1536, WCAT + 512, 64 * kb, 32 * nb, 32 * nb, nullptr, scr, lane); continue; } r -= I_RO;
            if (r < I_WO) { const int nblk = D / 32, kb = r / nblk, nb = r % nblk; transpose_item(args.in[I_W_O], D, D, WO, 64 * kb, 32 * nb, 32 * nb, nullptr, scr, lane); continue; } r -= I_WO;
            { const int nblk = D / 32, kb = r / nblk, nb = r % nblk; transpose_item(args.in[I_W_POOL_OUT], D, 1536, WCAT, 64 * kb, 32 * nb, 32 * nb, nullptr, scr, lane); }
        }
        {
            const int gt = bx * NTHR + tid, NT = G * NTHR;
            const float* wg = args.in[I_W_GRP];
            for (int e = gt; e < 512 * 32; e += NT) { const int n = e >> 5, kc = (e & 31) * 8, g = n >> 7, nn = n & 127; float v[8];
#pragma unroll
                for (int j = 0; j < 8; ++j) { const int kk = kc + j - (g & 1) * 128; v[j] = (kk >= 0 && kk < 128) ? wg[((size_t)g * 128 + kk) * 128 + nn] : 0.f; }
                v4u o; o.x = cvt_pk_bf16(v[0], v[1]); o.y = cvt_pk_bf16(v[2], v[3]); o.z = cvt_pk_bf16(v[4], v[5]); o.w = cvt_pk_bf16(v[6], v[7]);
                *(v4u*)(WGRP + (size_t)n * 256 + kc) = o; }
            const float* wa = args.in[I_W_RG_A]; const float* wx = args.in[I_W_RG_X];
            for (int e = gt; e < 2048 * 16; e += NT) { const int n = e >> 4, kc = (e & 15) * 8, h = n >> 8, j = n & 255; const float* src = j < 128 ? wa : wx; const int jj = j & 127; float v[8];
#pragma unroll
                for (int q = 0; q < 8; ++q) v[q] = src[((size_t)h * 128 + kc + q) * 128 + jj];
                v4u o; o.x = cvt_pk_bf16(v[0], v[1]); o.y = cvt_pk_bf16(v[2], v[3]); o.z = cvt_pk_bf16(v[4], v[5]); o.w = cvt_pk_bf16(v[6], v[7]);
                *(v4u*)(WGATE + (size_t)n * 128 + kc) = o; }
        }
        { const int gt = bx * NTHR + tid; if (gt < DRNN) { const float z = -args.in[I_LAMBDA][gt]; ((float*)(ws + WS_SP8))[gt] = -8.0f * (fmaxf(z, 0.f) + log1pf(expf(-fabsf(z)))); } }
        const float* gmix = args.in[I_NORM_MIX];
        f32x4 gv[4];
#pragma unroll
        for (int j = 0; j < 4; ++j) gv[j] = ((const f32x4*)gmix)[lane + 64 * j];
        for (int m = gw; m < M; m += 2 * NGW) {
            const int m1 = (m + NGW < M) ? m + NGW : m;
            const f32x4* xr0 = (const f32x4*)(x + (size_t)m * D) + lane; const f32x4* xr1 = (const f32x4*)(x + (size_t)m1 * D) + lane; f32x4 v0[4], v1[4]; float s0 = 0.f, s1 = 0.f;
#pragma unroll
            for (int j = 0; j < 4; ++j) { v0[j] = xr0[64 * j]; v1[j] = xr1[64 * j]; }
#pragma unroll
            for (int j = 0; j < 4; ++j) { s0 += (v0[j].x * v0[j].x + v0[j].y * v0[j].y) + (v0[j].z * v0[j].z + v0[j].w * v0[j].w); s1 += (v1[j].x * v1[j].x + v1[j].y * v1[j].y) + (v1[j].z * v1[j].z + v1[j].w * v1[j].w); }
            const float rs0 = 1.0f / sqrtf(wave_sum(s0) * (1.f / D) + EPS), rs1 = 1.0f / sqrtf(wave_sum(s1) * (1.f / D) + EPS);
            v2u* o0 = (v2u*)(XN + (size_t)m * D) + lane; v2u* o1 = (v2u*)(XN + (size_t)m1 * D) + lane;
#pragma unroll
            for (int j = 0; j < 4; ++j) { const f32x4 y0 = v0[j] * rs0 * gv[j], y1 = v1[j] * rs1 * gv[j]; v2u w0, w1; w0.x = cvt_pk_bf16(y0.x, y0.y); w0.y = cvt_pk_bf16(y0.z, y0.w); w1.x = cvt_pk_bf16(y1.x, y1.y); w1.y = cvt_pk_bf16(y1.z, y1.w); o0[64 * j] = w0; o1[64 * j] = w1; }
        }
        __syncthreads();
    }
    SEAM(0);
    TEND(0);

    TSTART(1);
    if (IN(1)) for (int rep = 0; rep < REPS(1); ++rep) { if (rep) GSYNC();
        pg8::Gemm g{XN, WIN, M, 4096, D, D, D, 0, 0}; pg8::StaticOrder S; S.init(M, 4096, G, bx);
        pg8::EpiProj E{UP, UR, UG, G0, G1, 0};
        pg8::gemm_phase<pg8::EpiProj, true>(lds, g, S, E);
    }
    SEAM(1);
    TEND(1);

    TSTART(2);
    if (IN(2)) for (int rep = 0; rep < REPS(2); ++rep) { if (rep) GSYNC();
        { const int gw = bx * NWAVES + wave, NGW = G * NWAVES;
          for (int wi = gw; wi < (M / 32) * 4; wi += NGW) { const int g = wi & 3, t0 = (wi >> 2) * 32 + (lane >> 4) * 8, co = g * 16 + (lane & 15);
              const bf16* src = UP + (size_t)t0 * DPOOL + co * 8; bf16* dst = POOLED + (size_t)t0 * DPOOL + co * 8; const int tl = t0 & (SEQ - 1);
              if (g == 0) pool_item<2>(src, dst, tl); else if (g == 1) pool_item<4>(src, dst, tl); else if (g == 2) pool_item<8>(src, dst, tl); else pool_item<16>(src, dst, tl); } }
        { const int gt = bx * NTHR + tid, NT = G * NTHR;
          for (int it = gt; it < (M / 8) * 128; it += NT) { const int co = it & 127, t0 = (it >> 7) * 8, tl = t0 & (SEQ - 1);
              const bf16* src = UR + (size_t)t0 * DRNN + co * 8; bf16* dst = V + (size_t)t0 * 1536 + co * 8;
              const float* cw = args.in[I_CONV_W] + co * 8; const float* cb = args.in[I_CONV_B] + co * 8;
              v4u rw[11];
#pragma unroll
              for (int k = 0; k < 11; ++k) rw[k] = (k >= 3 || tl != 0) ? *(const v4u*)(src + (ptrdiff_t)(k - 3) * DRNN) : (v4u){0u, 0u, 0u, 0u};
              f32x4 w0[2], w1[2], w2[2], w3[2], bb[2];
#pragma unroll
              for (int n = 0; n < 2; ++n) { w0[n] = *(const f32x4*)(cw + 4 * n); w1[n] = *(const f32x4*)(cw + 1024 + 4 * n); w2[n] = *(const f32x4*)(cw + 2048 + 4 * n); w3[n] = *(const f32x4*)(cw + 3072 + 4 * n); bb[n] = *(const f32x4*)(cb + 4 * n); }
#pragma unroll
              for (int i = 0; i < 8; ++i) { f32x4 a[2], b[2], c[2], d[2]; pg8::unpack8(rw[i], a[0], a[1]); pg8::unpack8(rw[i + 1], b[0], b[1]); pg8::unpack8(rw[i + 2], c[0], c[1]); pg8::unpack8(rw[i + 3], d[0], d[1]);
                  *(v4u*)(dst + (size_t)i * 1536) = pg8::pack8(bb[0] + w0[0] * a[0] + w1[0] * b[0] + w2[0] * c[0] + w3[0] * d[0], bb[1] + w0[1] * a[1] + w1[1] * b[1] + w2[1] * c[1] + w3[1] * d[1]); }
          } }
    }
    SEAM(2);
    TEND(2);

    TSTART(3);
    if (IN(3)) for (int rep = 0; rep < REPS(3); ++rep) { if (rep) GSYNC();
        const bool uneven = (G == 256);
        {
          pg8::Gemm g{XN, WIN + (size_t)4096 * D, M, 512, D, D, D, 0, 0}; pg8::StaticOrder S; S.init(M, 512, G, bx);
          pg8::EpiProj E{UP, UR, UG, G0, G1, 16};
          pg8::gemm_phase<pg8::EpiProj, true>(lds, g, S, E); }
        { pg8::Gemm g{POOLED, WGRP, M, 512, 256, 512, 256, 0, 256}; pg8::StaticOrder S; S.init(M, 512, G, (bx + G / 2) % G);
          pg8::EpiGrp E{CAT, 1536, args.in[I_POOL_SCALE]};
          pg8::gemm_phase<pg8::EpiGrp, true>(lds, g, S, E); }
        { pg8::Gemm g{V, WGATE, M, 2048, 128, 1536, 128, 0, 128}; pg8::StaticOrder S; S.init(M, 2048, G, bx);
          if (uneven) { if (bx < 128) { S.lin_base = bx; S.lin_cnt = 1; } else { S.lin_base = 128 + (bx - 128) * 3; S.lin_cnt = 3; } }
          pg8::EpiGate E{V, LA, BB, args.in[I_B_RG_A], args.in[I_B_RG_X], (const float*)(ws + WS_SP8)};
          pg8::gemm_phase<pg8::EpiGate, true>(lds, g, S, E); }
    }
    SEAM(3);
    TEND(3);

    TSTART(4);
    TEND(4);

    TSTART(5);
    if (IN(5)) for (int rep = 0; rep < REPS(5); ++rep) { if (rep) GSYNC();
        LAS float* PAS = (LAS float*)lds; LAS float* PAH = PAS + 8 * 512; LAS float* PBS = PAH + 8 * 512; LAS float* PBH = PBS + 8 * 512;
        unsigned* flags = (unsigned*)ws + 8192;
        for (int bi = bx; bi < NB * SCAN_NC * 2; bi += G) { const int hh = bi & 1, c = (bi >> 1) % SCAN_NC, b = bi / (2 * SCAN_NC);
            const size_t off = ((size_t)b * SEQ + (size_t)c * SCAN_T + wave * 16) * DRNN + hh * 512 + lane * 8;
            v4u lwk[16], bwk[16];
#pragma unroll
            for (int i = 0; i < 16; ++i) { lwk[i] = *(const v4u*)(LA + off + (size_t)i * DRNN); bwk[i] = *(const v4u*)(BB + off + (size_t)i * DRNN); }
            { f32x4 S[2] = {{0.f, 0.f, 0.f, 0.f}, {0.f, 0.f, 0.f, 0.f}}, H[2] = {{0.f, 0.f, 0.f, 0.f}, {0.f, 0.f, 0.f, 0.f}};
#pragma unroll
              for (int i = 0; i < 16; ++i) { f32x4 l[2], bq[2]; pg8::unpack8(lwk[i], l[0], l[1]); pg8::unpack8(bwk[i], bq[0], bq[1]);
#pragma unroll
                  for (int n = 0; n < 2; ++n)
#pragma unroll
                      for (int j = 0; j < 4; ++j) { H[n][j] = __expf(l[n][j]) * H[n][j] + bq[n][j]; S[n][j] += l[n][j]; } }
              *(LAS f32x4*)(PBS + wave * 512 + lane * 8) = S[0]; *(LAS f32x4*)(PBS + wave * 512 + lane * 8 + 4) = S[1];
              *(LAS f32x4*)(PBH + wave * 512 + lane * 8) = H[0]; *(LAS f32x4*)(PBH + wave * 512 + lane * 8 + 4) = H[1]; }
#pragma unroll
            for (int i = 0; i < 16; ++i) asm volatile("" : "+v"(lwk[i]), "+v"(bwk[i]));
            __syncthreads();
            { float h = 0.f, st = 0.f;
#pragma unroll
              for (int sb = 0; sb < 8; ++sb) { const float sv = PBS[sb * 512 + tid]; h = __expf(sv) * h + PBH[sb * 512 + tid]; st += sv; }
              const size_t co = ((size_t)b * SCAN_NC + c) * DRNN + hh * 512 + tid;
              __hip_atomic_store(CS + co, st, __ATOMIC_RELAXED, __HIP_MEMORY_SCOPE_AGENT); __hip_atomic_store(CH + co, h, __ATOMIC_RELAXED, __HIP_MEMORY_SCOPE_AGENT); }
            asm volatile("s_waitcnt vmcnt(0)" ::: "memory");
            __syncthreads();
            if (tid == 0) __hip_atomic_store(flags + ((b * 2 + hh) * SCAN_NC + c) * 16, 1u, __ATOMIC_RELAXED, __HIP_MEMORY_SCOPE_AGENT);
            { f32x4 S[2] = {{0.f, 0.f, 0.f, 0.f}, {0.f, 0.f, 0.f, 0.f}}, H[2] = {{0.f, 0.f, 0.f, 0.f}, {0.f, 0.f, 0.f, 0.f}};
              if (wave * 4 < c) {
                  for (int q = 0; q < 4; ++q) { const int cc = wave * 4 + q; if (cc < c) { unsigned* f = flags + ((b * 2 + hh) * SCAN_NC + cc) * 16; unsigned sp = 0;
                      while ((unsigned)__builtin_amdgcn_readfirstlane(__hip_atomic_load(f, __ATOMIC_RELAXED, __HIP_MEMORY_SCOPE_AGENT)) == 0u) { __builtin_amdgcn_s_sleep(1); if (++sp > (1u << 20)) break; } } }
                  __builtin_amdgcn_fence(__ATOMIC_ACQUIRE, "agent");
#pragma unroll
                  for (int q0 = 0; q0 < 4; q0 += 2) { f32x4 cs[2][2], ch[2][2];
#pragma unroll
                      for (int q = 0; q < 2; ++q) { const int cc = wave * 4 + q0 + q; const size_t co = ((size_t)b * SCAN_NC + (cc < c ? cc : 0)) * DRNN + hh * 512 + lane * 8;
                          cs[q][0] = *(const f32x4*)(CS + co); cs[q][1] = *(const f32x4*)(CS + co + 4); ch[q][0] = *(const f32x4*)(CH + co); ch[q][1] = *(const f32x4*)(CH + co + 4); }
#pragma unroll
                      for (int q = 0; q < 2; ++q) { if (wave * 4 + q0 + q < c) {
#pragma unroll
                          for (int n = 0; n < 2; ++n)
#pragma unroll
                              for (int j = 0; j < 4; ++j) { H[n][j] = __expf(cs[q][n][j]) * H[n][j] + ch[q][n][j]; S[n][j] += cs[q][n][j]; } } }
                      asm volatile("" ::: "memory"); }
              }
              *(LAS f32x4*)(PAS + wave * 512 + lane * 8) = S[0]; *(LAS f32x4*)(PAS + wave * 512 + lane * 8 + 4) = S[1];
              *(LAS f32x4*)(PAH + wave * 512 + lane * 8) = H[0]; *(LAS f32x4*)(PAH + wave * 512 + lane * 8 + 4) = H[1]; }
            __syncthreads();
            f32x4 h[2] = {{0.f, 0.f, 0.f, 0.f}, {0.f, 0.f, 0.f, 0.f}};
#pragma unroll
            for (int sb = 0; sb < 8; ++sb) {
#pragma unroll
                for (int n = 0; n < 2; ++n) { const f32x4 sv = *(const LAS f32x4*)(PAS + sb * 512 + lane * 8 + 4 * n), hv = *(const LAS f32x4*)(PAH + sb * 512 + lane * 8 + 4 * n);
#pragma unroll
                    for (int j = 0; j < 4; ++j) h[n][j] = __expf(sv[j]) * h[n][j] + hv[j]; } }
            for (int sb = 0; sb < wave; ++sb) {
#pragma unroll
                for (int n = 0; n < 2; ++n) { const f32x4 sv = *(const LAS f32x4*)(PBS + sb * 512 + lane * 8 + 4 * n), hv = *(const LAS f32x4*)(PBH + sb * 512 + lane * 8 + 4 * n);
#pragma unroll
                    for (int j = 0; j < 4; ++j) h[n][j] = __expf(sv[j]) * h[n][j] + hv[j]; } }
            const bf16* ugp = UG + off;
            bf16* hgp = CAT + ((size_t)b * SEQ + (size_t)c * SCAN_T + wave * 16) * 1536 + 512 + hh * 512 + lane * 8;
#pragma unroll
            for (int i0 = 0; i0 < 16; i0 += 8) { v4u gw8[8];
#pragma unroll
                for (int i = 0; i < 8; ++i) gw8[i] = *(const v4u*)(ugp + (size_t)(i0 + i) * DRNN);
#pragma unroll
                for (int i = 0; i < 8; ++i) { f32x4 l[2], bq[2], gq[2], o[2]; pg8::unpack8(lwk[i0 + i], l[0], l[1]); pg8::unpack8(bwk[i0 + i], bq[0], bq[1]); pg8::unpack8(gw8[i], gq[0], gq[1]);
#pragma unroll
                    for (int n = 0; n < 2; ++n)
#pragma unroll
                        for (int j = 0; j < 4; ++j) { h[n][j] = __expf(l[n][j]) * h[n][j] + bq[n][j]; o[n][j] = h[n][j] * pg8::gelu_tanh_(gq[n][j]); }
                    *(v4u*)(hgp + (size_t)(i0 + i) * 1536) = pg8::pack8(o[0], o[1]); } }
            __syncthreads();
        }
    }
    SEAM(5);
    TEND(5);

    TSTART(6);
    if (IN(6)) for (int rep = 0; rep < REPS(6); ++rep) { if (rep) GSYNC();
        pg8::Gemm g{CAT, WCAT, M, D, 1536, 1536, 1536, 0, 0}; pg8::StaticOrder S; S.init(M, D, G, bx);
        pg8::EpiMix E{G0, G1, MIXB};
        pg8::gemm_phase<pg8::EpiMix, true, 8>(lds, g, S, E);
    }
    SEAM(6);
    TEND(6);

    TSTART(7);
    if (IN(7)) for (int rep = 0; rep < REPS(7); ++rep) { if (rep) GSYNC();
        pg8::Gemm g{MIXB, WO, M, D, D, D, D, 0, 0}; pg8::StaticOrder S; S.init(M, D, G, bx);
        pg8::EpiRes1 E{x, X1B, SSQ};
        pg8::gemm_phase<pg8::EpiRes1, true>(lds, g, S, E);
    }
    SEAM(7);
    TEND(7);

    TSTART(8);
    if (IN(8)) for (int rep = 0; rep < REPS(8); ++rep) { if (rep) GSYNC();
        pg8::Gemm g{X1B, WFI, M, 2 * DFF, D, D, D, 0, 0}; pg8::StaticOrder S; S.init(M, 2 * DFF, G, bx);
        LAS float* RSL = (LAS float*)(lds + 133120);
        { const int r = tid & 255;
          for (int i = tid >> 8; i < 8; i += 2) { pg8::Unit u; if (!S.next(i, u)) break;
              const f32x4* sp = (const f32x4*)(SSQ + (size_t)(u.pm * 256 + r) * 16); const f32x4 st = (sp[0] + sp[1]) + (sp[2] + sp[3]);
              RSL[i * 256 + r] = __builtin_amdgcn_rsqf(((st[0] + st[1]) + (st[2] + st[3])) * (1.0f / 1024.0f) + 1e-6f); }
          __syncthreads(); }
        pg8::EpiSwiglu E{RSL, ACT};
        pg8::gemm_phase<pg8::EpiSwiglu, true>(lds, g, S, E);
        if (G == 256 && bx >= 128) {
            LAS float* scr = (LAS float*)(lds + wave * 16384); constexpr int I_FO = (DFF / 64) * (D / 32);
            for (int r = (bx - 128) * NWAVES + wave; r < I_FO; r += 128 * NWAVES) { const int nblk = D / 32, kb = r / nblk, nb = r % nblk;
                transpose_item(args.in[I_W_FFN_OUT], D, DFF, WFO, 64 * kb, 32 * nb, 32 * nb, nullptr, scr, lane); }
        }
    }
    SEAM(8);
    TEND(8);

    TSTART(9);
    if (IN(9)) for (int rep = 0; rep < REPS(9); ++rep) { if (rep) GSYNC();
        pg8::Gemm g{ACT, WFO, M, D, DFF, DFF, DFF, 0, 0}; pg8::StaticOrder S; S.init(M, D, G, bx);
        if (G == 256) { pg8::EpiFinal E{X1B, X1, (float*)(ws + WS_SSQ2), (unsigned*)ws + 4096, args.in[I_NORM_FINAL]};
            pg8::gemm_phase<pg8::EpiFinal, true>(lds, g, S, E); }
        else { pg8::EpiRes2 E{X1B, X1};
            pg8::gemm_phase<pg8::EpiRes2, true>(lds, g, S, E); }
    }
    if (G != 256) SEAM(9);
    TEND(9);

    TSTART(10);
    if (IN(10) && G != 256) for (int rep = 0; rep < REPS(10); ++rep) { if (rep) GSYNC();
        const int gw = bx * NWAVES + wave, NGW = G * NWAVES;
        const float* gf = args.in[I_NORM_FINAL]; f32x4 gv[4];
#pragma unroll
        for (int j = 0; j < 4; ++j) gv[j] = ((const f32x4*)gf)[lane + 64 * j];
        for (int m = gw; m < M; m += NGW) {
            f32x4* xr = (f32x4*)(X1 + (size_t)m * D) + lane; f32x4 v[4]; float s = 0.f;
#pragma unroll
            for (int j = 0; j < 4; ++j) { v[j] = xr[64 * j]; s += (v[j].x * v[j].x + v[j].y * v[j].y) + (v[j].z * v[j].z + v[j].w * v[j].w); }
            const float rs = 1.0f / sqrtf(wave_sum(s) * (1.f / D) + EPS);
#pragma unroll
            for (int j = 0; j < 4; ++j) xr[64 * j] = v[j] * rs * gv[j];
        }
    }
    if (PROBE_PHASE == 10 || PROBE_PHASE == 99) tp1 = __builtin_amdgcn_s_memrealtime();
    if (PROBE_PHASE >= 0 && bx == 0 && tid == 0) { const unsigned long long dt = (tp1 - tp0) * PROBE_MULT, te = __builtin_amdgcn_s_memrealtime(); while (__builtin_amdgcn_s_memrealtime() - te < dt) __builtin_amdgcn_s_sleep(8); }
#undef IN
#undef SEAM
}

extern "C" void kernel_launch(void* const* d_in, const int* in_sizes, int n_in, void* d_out, int out_size, void* d_ws, size_t ws_size, hipStream_t stream) {
    static int grid = 0;
    if (grid == 0) {
        if (n_in != 19 || out_size != M * D || ws_size < WS_END) { fprintf(stderr, "kernel_launch: unexpected shapes (n_in %d out %d ws %zu)\n", n_in, out_size, ws_size); grid = -1; return; }
        int dev = 0, cus = 0, per_cu = 0;
        hipGetDevice(&dev);
        hipDeviceGetAttribute(&cus, hipDeviceAttributeMultiprocessorCount, dev);
        if (hipFuncSetAttribute((const void*)fwd_kernel, hipFuncAttributeMaxDynamicSharedMemorySize, LDS_BYTES) != hipSuccess) { fprintf(stderr, "kernel_launch: hipFuncSetAttribute failed\n"); grid = -1; return; }
        if (hipOccupancyMaxActiveBlocksPerMultiprocessor(&per_cu, (const void*)fwd_kernel, NTHR, LDS_BYTES) != hipSuccess || per_cu < 1) { fprintf(stderr, "kernel_launch: occupancy query says %d\n", per_cu); per_cu = 1; }
        (void)hipGetLastError();
        grid = cus * 1;
        fprintf(stderr, "kernel_launch: grid %d (cus %d, per_cu %d)\n", grid, cus, per_cu);
    }
    if (grid < 0) return;
    if (hipMemsetAsync(d_ws, 0, 49152, stream) != hipSuccess) { fprintf(stderr, "kernel_launch: memset failed\n"); return; }
    Args a{};
    for (int i = 0; i < 19; ++i) a.in[i] = (const float*)d_in[i];
    a.out = (float*)d_out; a.ws = (unsigned char*)d_ws;
#if MK_PER_PHASE
    for (int p = 0; p < NPH; ++p) { a.ph_lo = p; a.ph_hi = p + 1; hipLaunchKernelGGL(fwd_kernel, dim3(grid), dim3(NTHR), LDS_BYTES, stream, a); }
#else
    a.ph_lo = 0; a.ph_hi = NPH;
    void* kargs[] = {&a};
    hipError_t e = hipLaunchCooperativeKernel((const void*)fwd_kernel, dim3(grid), dim3(NTHR), kargs, LDS_BYTES, stream);
    if (e != hipSuccess) fprintf(stderr, "cooperative launch failed: %s (grid %d)\n", hipGetErrorString(e), grid);
#endif
}
```

```cpp
#include <hip/hip_runtime.h>
#include <hip/hip_cooperative_groups.h>
#include <cstdio>
#include <cstdint>
namespace cg = cooperative_groups;

#ifndef MK_PER_PHASE
#define MK_PER_PHASE 0
#endif

namespace pg8 {
#define PG8_LAS __attribute__((address_space(3)))
typedef unsigned short bf16_t;
typedef short bf16x8 __attribute__((ext_vector_type(8)));
typedef float f32x4 __attribute__((ext_vector_type(4)));
typedef float f32x2 __attribute__((ext_vector_type(2)));
typedef unsigned u32x4 __attribute__((ext_vector_type(4)));
typedef unsigned u32x2 __attribute__((ext_vector_type(2)));
constexpr int BM = 256, BK = 64, HALF = 128, HTB = HALF * BK * 2, STAGE_BYTES = 8 * HTB, NXCD = 8, WGM = 8;

__host__ __device__ __forceinline__ int lds_byte(int r, int c) { const int st = (r >> 4) * 2 + (c >> 5), rr = r & 15, cc = c & 31, ob = rr * 64 + cc * 2; return st * 1024 + (ob ^ (((ob >> 9) & 1) << 5)); }
__host__ __device__ __forceinline__ void stage_rc(int b, int& R, int& C) { const int st = b / 1024, sb = b % 1024, swz = sb ^ (((sb >> 9) & 1) << 5); R = (st >> 1) * 16 + swz / 64; C = (st & 1) * 32 + (swz % 64) / 2; }
__host__ __device__ __forceinline__ int perm32(int rho) { const int n = rho >> 4, i = rho & 15; return 8 * (i >> 2) + 4 * n + (i & 3); }

struct Unit { int pm, pn, rh, idx; };
struct Gemm { const bf16_t* A; const bf16_t* Bt; int M, N, K, lda, ldb, ash, amul; };

struct StaticOrder {
    int nM, nN, nwg, G, c, limit, lin_base, lin_cnt;
    __host__ __device__ __forceinline__ void init(int M, int N, int G_, int c_) { nM = M / BM; nN = N / BM; nwg = nM * nN; G = G_; c = c_; limit = nwg; lin_base = 0; lin_cnt = -1; }
    __host__ __device__ __forceinline__ void map(int L, Unit& u) const {
        int wgid = L; { const int q = nwg / NXCD, r = nwg % NXCD, xcd = wgid % NXCD, off = wgid / NXCD; wgid = (xcd < r ? xcd * (q + 1) : r * (q + 1) + (xcd - r) * q) + off; }
        const int nig = WGM * nN, gid = wgid / nig, fm = gid * WGM, gsz = (nM - fm) < WGM ? (nM - fm) : WGM;
        u.pm = fm + ((wgid % nig) % gsz); u.pn = (wgid % nig) / gsz; u.rh = 0;
    }
    __host__ __device__ __forceinline__ bool next(int i, Unit& u) const {
        u.idx = i;
        if (lin_cnt >= 0) { if (i >= lin_cnt) return false; map(lin_base + i, u); return true; }
        const long L = (long)i * G + c; if (L >= limit) return false;
        map((int)L, u); return true;
    }
};

__device__ __forceinline__ unsigned cvt_pk_bf16(float lo, float hi) { unsigned r; asm volatile("v_cvt_pk_bf16_f32 %0, %1, %2" : "=v"(r) : "v"(lo), "v"(hi)); return r; }
__device__ __forceinline__ float bf_lo(unsigned w) { return __uint_as_float(w << 16); }
__device__ __forceinline__ float bf_hi(unsigned w) { return __uint_as_float(w & 0xffff0000u); }
__device__ __forceinline__ float sigmoidf_(float x) { return __builtin_amdgcn_rcpf(1.0f + __expf(-x)); }
__device__ __forceinline__ float gelu_tanh_(float x) { const float z = 1.5957691216057308f * (x + 0.044715f * x * x * x); return x * sigmoidf_(z); }
__device__ __forceinline__ u32x4 pack8(const f32x4 a, const f32x4 b) { u32x4 w; w.x = cvt_pk_bf16(a[0], a[1]); w.y = cvt_pk_bf16(a[2], a[3]); w.z = cvt_pk_bf16(b[0], b[1]); w.w = cvt_pk_bf16(b[2], b[3]); return w; }
__device__ __forceinline__ void unpack8(const u32x4 w, f32x4& a, f32x4& b) { a = (f32x4){bf_lo(w.x), bf_hi(w.x), bf_lo(w.y), bf_hi(w.y)}; b = (f32x4){bf_lo(w.z), bf_hi(w.z), bf_lo(w.w), bf_hi(w.w)}; }

#define EPI_ROWS_BEGIN _Pragma("unroll") for (int ai = 0; ai < NAI; ++ai) _Pragma("unroll") for (int m = 0; m < 4; ++m) { const int row = u.pm * BM + u.rh + ai * HALF + wr * 64 + m * 16 + fr;
#define EPI_ROWS_END }

struct EpiProj {
    bf16_t *UP, *UR, *UG, *RB, *G1; int pn_off;
    template <int NAI> __device__ __forceinline__ void run(const f32x4 (&acc)[2][2][4][2], const Unit& u, int wr, int wc, int fr, int fq) const {
        const int pn = u.pn + pn_off;
        if (pn < 10) {
            bf16_t* base; int ldc, colt;
            if (pn < 2) { base = UP; ldc = 512; colt = pn * 256; }
            else if (pn < 6) { base = UR; ldc = 1024; colt = (pn - 2) * 256; }
            else { base = UG; ldc = 1024; colt = (pn - 6) * 256; }
            const int col0 = colt + wc * 32 + 8 * fq;
            EPI_ROWS_BEGIN
                bf16_t* rowp = base + (unsigned)((unsigned)row * (unsigned)ldc + (unsigned)col0);
#pragma unroll
                for (int bj = 0; bj < 2; ++bj) *(u32x4*)(rowp + bj * HALF) = pack8(acc[ai][bj][m][0], acc[ai][bj][m][1]);
            EPI_ROWS_END
        } else {
            const int ch0 = (pn - 10) * 128 + wc * 32 + 8 * fq;
            EPI_ROWS_BEGIN
                const unsigned off = (unsigned)row * 1024u + (unsigned)ch0; f32x4 rr[2], gg[2];
#pragma unroll
                for (int n = 0; n < 2; ++n)
#pragma unroll
                    for (int j = 0; j < 4; ++j) { const float d0 = 1.0f + fminf(__expf(-acc[ai][0][m][n][j]), 1e18f), d1 = 1.0f + fminf(__expf(-acc[ai][1][m][n][j]), 1e18f);
                        const float q = __builtin_amdgcn_rcpf(d0 * d1); gg[n][j] = d0 * q; rr[n][j] = d1 * d1 * q; }
                *(u32x4*)(RB + off) = pack8(rr[0], rr[1]); *(u32x4*)(G1 + off) = pack8(gg[0], gg[1]);
            EPI_ROWS_END
        }
    }
};
struct EpiGrp {
    bf16_t* O; int ldc; const float* scale;
    template <int NAI> __device__ __forceinline__ void run(const f32x4 (&acc)[2][2][4][2], const Unit& u, int wr, int wc, int fr, int fq) const {
        const int col0 = u.pn * BM + wc * 32 + 8 * fq;
        f32x4 sc[2][2];
#pragma unroll
        for (int bj = 0; bj < 2; ++bj)
#pragma unroll
            for (int n = 0; n < 2; ++n) sc[bj][n] = *(const f32x4*)(scale + col0 + bj * HALF + 4 * n);
        EPI_ROWS_BEGIN
            bf16_t* rowp = O + (unsigned)((unsigned)row * (unsigned)ldc + (unsigned)col0);
#pragma unroll
            for (int bj = 0; bj < 2; ++bj) *(u32x4*)(rowp + bj * HALF) = pack8(acc[ai][bj][m][0] * sc[bj][0], acc[ai][bj][m][1] * sc[bj][1]);
        EPI_ROWS_END
    }
};
struct EpiGate {
    const bf16_t* V; bf16_t *LA, *BB; const float *b_a, *b_x, *sp8;
    template <int NAI, bool EXACT> __device__ __forceinline__ void rows(const f32x4 (&acc)[2][2][4][2], const Unit& u, int wr, int fr, int ch0, const f32x4 (&ba)[2], const f32x4 (&bx)[2], const f32x4 (&sp)[2]) const {
        u32x4 vwk[2][4];
        EPI_ROWS_BEGIN
            vwk[ai][m] = *(const u32x4*)(V + ((unsigned)row * 1536u + (unsigned)ch0));
        EPI_ROWS_END
        EPI_ROWS_BEGIN
            const unsigned off = (unsigned)row * 1024u + (unsigned)ch0;
            f32x4 vv[2]; unpack8(vwk[ai][m], vv[0], vv[1]);
            f32x4 la[2], bb[2];
#pragma unroll
            for (int n = 0; n < 2; ++n)
#pragma unroll
                for (int j = 0; j < 4; ++j) {
                    const float r = sigmoidf_(acc[ai][0][m][n][j] + ba[n][j]), ig = sigmoidf_(acc[ai][1][m][n][j] + bx[n][j]);
                    const float l = sp[n][j] * r, x2 = 2.0f * l;
                    const float poly = x2 * (1.0f + 0.5f * x2 * (1.0f + 0.33333334f * x2 * (1.0f + 0.25f * x2 * (1.0f + 0.2f * x2 * (1.0f + 0.16666667f * x2)))));
                    const float em1 = EXACT ? ((x2 > -0.25f) ? poly : (__expf(x2) - 1.0f)) : poly;
                    la[n][j] = l; bb[n][j] = __builtin_amdgcn_sqrtf(fmaxf(-em1, 0.f)) * ig * vv[n][j]; }
            *(u32x4*)(LA + off) = pack8(la[0], la[1]); *(u32x4*)(BB + off) = pack8(bb[0], bb[1]);
        EPI_ROWS_END
    }
    template <int NAI> __device__ __forceinline__ void run(const f32x4 (&acc)[2][2][4][2], const Unit& u, int wr, int wc, int fr, int fq) const {
        const int ch0 = u.pn * 128 + wc * 32 + 8 * fq;
        f32x4 ba[2], bx[2], sp[2]; bool big = false;
#pragma unroll
        for (int n = 0; n < 2; ++n) { ba[n] = *(const f32x4*)(b_a + ch0 + 4 * n); bx[n] = *(const f32x4*)(b_x + ch0 + 4 * n); sp[n] = *(const f32x4*)(sp8 + ch0 + 4 * n);
#pragma unroll
            for (int j = 0; j < 4; ++j) big = big || !(sp[n][j] >= -0.125f); }
        if (__builtin_amdgcn_ballot_w64(big) != 0ull) rows<NAI, true>(acc, u, wr, fr, ch0, ba, bx, sp);
        else rows<NAI, false>(acc, u, wr, fr, ch0, ba, bx, sp);
    }
};
struct EpiMix {
    const bf16_t *RB, *G1; bf16_t* MIXB;
    __device__ __forceinline__ void mid(f32x4 (&acc)[2][2][4][2], const Unit& u0, int wr, int wc, int fr, int fq) const {
        constexpr int NAI = 2; Unit u = u0; asm volatile("" : "+s"(u.pm), "+s"(u.pn));
        const int col0 = u.pn * BM + wc * 32 + 8 * fq;
        u32x4 rw[2][4][2];
        EPI_ROWS_BEGIN
            const unsigned off = (unsigned)row * 1024u + (unsigned)col0;
#pragma unroll
            for (int bj = 0; bj < 2; ++bj) rw[ai][m][bj] = *(const u32x4*)(RB + off + bj * HALF);
        EPI_ROWS_END
        EPI_ROWS_BEGIN
#pragma unroll
            for (int bj = 0; bj < 2; ++bj) { f32x4 r[2]; unpack8(rw[ai][m][bj], r[0], r[1]); acc[ai][bj][m][0] *= r[0]; acc[ai][bj][m][1] *= r[1]; }
            (void)row;
        EPI_ROWS_END
    }
    template <int NAI> __device__ __forceinline__ void run(const f32x4 (&acc)[2][2][4][2], const Unit& u, int wr, int wc, int fr, int fq) const {
        const int col0 = u.pn * BM + wc * 32 + 8 * fq;
        u32x4 gw[2][4][2];
        EPI_ROWS_BEGIN
            const unsigned off = (unsigned)row * 1024u + (unsigned)col0;
#pragma unroll
            for (int bj = 0; bj < 2; ++bj) gw[ai][m][bj] = *(const u32x4*)(G1 + off + bj * HALF);
        EPI_ROWS_END
        EPI_ROWS_BEGIN
            const unsigned off = (unsigned)row * 1024u + (unsigned)col0;
#pragma unroll
            for (int bj = 0; bj < 2; ++bj) { f32x4 g[2]; unpack8(gw[ai][m][bj], g[0], g[1]);
                *(u32x4*)(MIXB + off + bj * HALF) = pack8(g[0] * acc[ai][bj][m][0], g[1] * acc[ai][bj][m][1]); }
        EPI_ROWS_END
    }
};
struct EpiRes1 {
    const float* X; bf16_t* X1B; float* SSQ;
    template <int NAI> __device__ __forceinline__ void run(const f32x4 (&acc)[2][2][4][2], const Unit& u, int wr, int wc, int fr, int fq) const {
        const int col0 = u.pn * BM + wc * 32 + 8 * fq;
#pragma unroll
        for (int ai = 0; ai < NAI; ++ai) {
            f32x4 xv[4][2][2];
#pragma unroll
            for (int m = 0; m < 4; ++m) { const unsigned off = (unsigned)(u.pm * BM + u.rh + ai * HALF + wr * 64 + m * 16 + fr) * 1024u + (unsigned)col0;
#pragma unroll
                for (int bj = 0; bj < 2; ++bj) { xv[m][bj][0] = *(const f32x4*)(X + off + bj * HALF); xv[m][bj][1] = *(const f32x4*)(X + off + bj * HALF + 4); } }
#pragma unroll
            for (int m = 0; m < 4; ++m) { const int row = u.pm * BM + u.rh + ai * HALF + wr * 64 + m * 16 + fr; const unsigned off = (unsigned)row * 1024u + (unsigned)col0; float ss = 0.f;
#pragma unroll
                for (int bj = 0; bj < 2; ++bj) {
                    const f32x4 a = xv[m][bj][0] + acc[ai][bj][m][0], b = xv[m][bj][1] + acc[ai][bj][m][1];
                    *(u32x4*)(X1B + off + bj * HALF) = pack8(a, b);
                    ss += (a[0] * a[0] + a[1] * a[1]) + (a[2] * a[2] + a[3] * a[3]) + (b[0] * b[0] + b[1] * b[1]) + (b[2] * b[2] + b[3] * b[3]); }
                ss += __shfl_xor(ss, 16); ss += __shfl_xor(ss, 32);
                if (fq == 0) SSQ[(unsigned)row * 16u + (unsigned)(u.pn * 4 + wc)] = ss; }
        }
    }
};
struct EpiSwiglu {
    const PG8_LAS float* RSL; bf16_t* ACT;
    template <int NAI> __device__ __forceinline__ void run(const f32x4 (&acc)[2][2][4][2], const Unit& u, int wr, int wc, int fr, int fq) const {
        const int col0 = u.pn * 128 + wc * 32 + 8 * fq;
        const PG8_LAS float* rt = RSL + u.idx * 256 + wr * 64 + fr;
        EPI_ROWS_BEGIN
            const float rs = rt[ai * HALF + m * 16];
            f32x4 o[2];
#pragma unroll
            for (int n = 0; n < 2; ++n)
#pragma unroll
                for (int j = 0; j < 4; ++j) { const float g = acc[ai][0][m][n][j] * rs, up = acc[ai][1][m][n][j] * rs; o[n][j] = g * sigmoidf_(g) * up; }
            __builtin_nontemporal_store(pack8(o[0], o[1]), (u32x4*)(ACT + (unsigned)((unsigned)row * 2816u + (unsigned)col0)));
        EPI_ROWS_END
    }
};
struct EpiRes2 {
    const bf16_t* X1B; float* OUT;
    template <int NAI> __device__ __forceinline__ void run(const f32x4 (&acc)[2][2][4][2], const Unit& u, int wr, int wc, int fr, int fq) const {
        const int col0 = u.pn * BM + wc * 32 + 8 * fq;
        EPI_ROWS_BEGIN
            const unsigned off = (unsigned)row * 1024u + (unsigned)col0;
#pragma unroll
            for (int bj = 0; bj < 2; ++bj) { f32x4 xa, xb; unpack8(*(const u32x4*)(X1B + off + bj * HALF), xa, xb);
                *(f32x4*)(OUT + off + bj * HALF) = xa + acc[ai][bj][m][0]; *(f32x4*)(OUT + off + bj * HALF + 4) = xb + acc[ai][bj][m][1]; }
        EPI_ROWS_END
    }
};

struct EpiFinal {
    const bf16_t* X1B; float* OUT; float* SSQ2; unsigned* cnt; const float* gfin;
    template <int NAI> __device__ __forceinline__ void run(f32x4 (&acc)[2][2][4][2], const Unit& u, int wr, int wc, int fr, int fq) const {
        const int col0 = u.pn * BM + wc * 32 + 8 * fq;
        { u32x4 xw[2][4][2];
          EPI_ROWS_BEGIN
              const unsigned off = (unsigned)row * 1024u + (unsigned)col0;
#pragma unroll
              for (int bj = 0; bj < 2; ++bj) xw[ai][m][bj] = *(const u32x4*)(X1B + off + bj * HALF);
          EPI_ROWS_END
          EPI_ROWS_BEGIN
              float ss = 0.f;
#pragma unroll
              for (int bj = 0; bj < 2; ++bj) { f32x4 xa, xb; unpack8(xw[ai][m][bj], xa, xb);
                  const f32x4 a = xa + acc[ai][bj][m][0], b = xb + acc[ai][bj][m][1]; acc[ai][bj][m][0] = a; acc[ai][bj][m][1] = b;
                  ss += (a[0] * a[0] + a[1] * a[1]) + (a[2] * a[2] + a[3] * a[3]) + (b[0] * b[0] + b[1] * b[1]) + (b[2] * b[2] + b[3] * b[3]); }
              ss += __shfl_xor(ss, 16); ss += __shfl_xor(ss, 32);
              if (fq == 0) __hip_atomic_store(SSQ2 + (unsigned)row * 16u + (unsigned)(u.pn * 4 + wc), ss, __ATOMIC_RELAXED, __HIP_MEMORY_SCOPE_AGENT);
          EPI_ROWS_END }
        asm volatile("s_waitcnt vmcnt(0)" ::: "memory");
        unsigned* c = cnt + 64 * u.pm;
        if ((threadIdx.x & 63) == 0) __hip_atomic_fetch_add(c, 1u, __ATOMIC_RELAXED, __HIP_MEMORY_SCOPE_AGENT);
        f32x4 gv[2][2];
#pragma unroll
        for (int bj = 0; bj < 2; ++bj)
#pragma unroll
            for (int n = 0; n < 2; ++n) gv[bj][n] = *(const f32x4*)(gfin + col0 + bj * HALF + 4 * n);
        { unsigned sp = 0;
          while ((unsigned)__builtin_amdgcn_readfirstlane(__hip_atomic_load(c, __ATOMIC_RELAXED, __HIP_MEMORY_SCOPE_AGENT)) < 32u) { __builtin_amdgcn_s_sleep(2); if (++sp > (1u << 20)) break; } }
        __builtin_amdgcn_fence(__ATOMIC_ACQUIRE, "agent");
        unsigned long long w0[2][4], w1[2][4];
        EPI_ROWS_BEGIN
            const unsigned long long* sl = (const unsigned long long*)(SSQ2 + (unsigned)row * 16u + (unsigned)(4 * fq));
            w0[ai][m] = __hip_atomic_load(sl, __ATOMIC_RELAXED, __HIP_MEMORY_SCOPE_AGENT); w1[ai][m] = __hip_atomic_load(sl + 1, __ATOMIC_RELAXED, __HIP_MEMORY_SCOPE_AGENT);
        EPI_ROWS_END
        EPI_ROWS_BEGIN
            const unsigned off = (unsigned)row * 1024u + (unsigned)col0;
            float sq = (__uint_as_float((unsigned)w0[ai][m]) + __uint_as_float((unsigned)(w0[ai][m] >> 32))) + (__uint_as_float((unsigned)w1[ai][m]) + __uint_as_float((unsigned)(w1[ai][m] >> 32)));
            sq += __shfl_xor(sq, 16); sq += __shfl_xor(sq, 32);
            const float rs = 1.0f / sqrtf(sq * (1.0f / 1024.0f) + 1e-6f);
#pragma unroll
            for (int bj = 0; bj < 2; ++bj) { *(f32x4*)(OUT + off + bj * HALF) = acc[ai][bj][m][0] * rs * gv[bj][0]; *(f32x4*)(OUT + off + bj * HALF + 4) = acc[ai][bj][m][1] * rs * gv[bj][1]; }
        EPI_ROWS_END
    }
};

template <class Epi, bool ALIGN_EPI, int MID_T = -1>
__device__ __forceinline__ void gemm_phase(PG8_LAS unsigned char* lds, const Gemm g, const StaticOrder& S, const Epi& E) {
    const int tid = threadIdx.x, wid = __builtin_amdgcn_readfirstlane(tid >> 6), lane = tid & 63, wr = wid >> 2, wc = wid & 3, fr = lane & 15, fq = lane >> 4;
    int nt = g.K / BK; asm volatile("" : "+s"(nt));
    unsigned voffA[2], voffB[2];
#pragma unroll
    for (int i = 0; i < 2; ++i) { int R, C; stage_rc(tid * 16 + i * 8192, R, C); const int Rb = (R & ~31) + perm32(R & 31);
        voffA[i] = (unsigned)(R * g.lda + C) * 2u; voffB[i] = (unsigned)(Rb * g.ldb + C) * 2u; }
    const size_t kstep = (size_t)(BK * 2);
    const size_t hstepA = (size_t)HALF * g.lda * 2, hstepB = (size_t)HALF * g.ldb * 2;
    const size_t tstepA = 2 * hstepA, tstepB = 2 * hstepB;
    const unsigned ldsw = (unsigned)wid * 1024u;
    const int aoff = lds_byte(wr * 64 + fr, fq * 8), boff = lds_byte(wc * 32 + fr, fq * 8);
#define PG8_SA(b, h) (((b) * 2 + (h)) * HTB)
#define PG8_SB(b, h) ((4 + (b) * 2 + (h)) * HTB)
#define PG8_STAGE(bufoff, gbase, voff) do { _Pragma("unroll") for (int _i = 0; _i < 2; ++_i) \
        __builtin_amdgcn_global_load_lds((const unsigned*)((const char*)(gbase) + (voff)[_i]), (PG8_LAS unsigned*)(lds + (bufoff) + ldsw + _i * 8192), 16, 0, 0); } while (0)
#define PG8_LDA(dst, b, h) do { _Pragma("unroll") for (int m = 0; m < 4; ++m) _Pragma("unroll") for (int k = 0; k < 2; ++k) dst[m][k] = *(const PG8_LAS bf16x8*)(lds + PG8_SA(b, h) + aoff + m * 2048 + k * 1024); } while (0)
#define PG8_LDB(dst, b, h) do { _Pragma("unroll") for (int n = 0; n < 2; ++n) _Pragma("unroll") for (int k = 0; k < 2; ++k) dst[n][k] = *(const PG8_LAS bf16x8*)(lds + PG8_SB(b, h) + boff + n * 2048 + k * 1024); } while (0)
#define PG8_MMA(ai, bj, At, Bt) do { __builtin_amdgcn_s_setprio(1); _Pragma("unroll") for (int m = 0; m < 4; ++m) _Pragma("unroll") for (int n = 0; n < 2; ++n) _Pragma("unroll") for (int k = 0; k < 2; ++k) \
        acc[ai][bj][m][n] = __builtin_amdgcn_mfma_f32_16x16x32_bf16(Bt[n][k], At[m][k], acc[ai][bj][m][n], 0, 0, 0); __builtin_amdgcn_s_setprio(0); } while (0)
#define PG8_WAIT_V(n) asm volatile("s_waitcnt vmcnt(" #n ")" ::: "memory")
#define PG8_WAIT_L(n) asm volatile("s_waitcnt lgkmcnt(" #n ")" ::: "memory")
#define PG8_BAR __builtin_amdgcn_s_barrier()
#define PG8_SCHED __builtin_amdgcn_sched_barrier(0)
    Unit cur, nxt; int ui = 0;
    if (!S.next(0, cur)) return;
    f32x4 acc[2][2][4][2];
#pragma unroll
    for (int a = 0; a < 2; ++a)
#pragma unroll
        for (int b = 0; b < 2; ++b)
#pragma unroll
            for (int m = 0; m < 4; ++m)
#pragma unroll
                for (int n = 0; n < 2; ++n) acc[a][b][m][n] = (f32x4){0.f, 0.f, 0.f, 0.f};
    bf16x8 At[4][2], B0[2][2], B1[2][2];
    const char* cA = (const char*)g.A + (size_t)cur.pm * tstepA + (size_t)((cur.pn >> g.ash) * g.amul) * 2; const char* cB = (const char*)g.Bt + (size_t)cur.pn * tstepB;
    PG8_STAGE(PG8_SB(0, 0), cB, voffB); PG8_STAGE(PG8_SB(0, 1), cB + hstepB, voffB); PG8_STAGE(PG8_SA(0, 0), cA, voffA); PG8_STAGE(PG8_SA(0, 1), cA + hstepA, voffA);
    if (wr == 1) PG8_BAR;
    PG8_WAIT_V(2); PG8_BAR;
    PG8_STAGE(PG8_SB(1, 0), cB + kstep, voffB); PG8_STAGE(PG8_SA(1, 0), cA + kstep, voffA); PG8_STAGE(PG8_SB(1, 1), cB + hstepB + kstep, voffB);
    PG8_WAIT_V(6); PG8_BAR;
    for (;;) {
        const bool has_next = S.next(ui + 1, nxt);
        const char* nA = has_next ? (const char*)g.A + (size_t)nxt.pm * tstepA + (size_t)((nxt.pn >> g.ash) * g.amul) * 2 : cA; const char* nB = has_next ? (const char*)g.Bt + (size_t)nxt.pn * tstepB : cB;
        for (int t = 0; t < nt; t += 2) {
            const bool last = (t == nt - 2);
            if constexpr (MID_T >= 0) { if (t == MID_T) E.mid(acc, cur, wr, wc, fr, fq); }
            const char* a1 = cA + (size_t)(t + 1) * kstep;
            const char* a2 = last ? nA : cA + (size_t)(t + 2) * kstep; const char* b2 = last ? nB : cB + (size_t)(t + 2) * kstep;
            const char* a3 = a2 + kstep; const char* b3 = b2 + kstep;
            PG8_LDB(B0, 0, 0); PG8_LDB(B1, 0, 1); PG8_SCHED; PG8_LDA(At, 0, 0); PG8_STAGE(PG8_SA(1, 1), a1 + hstepA, voffA);
            PG8_WAIT_V(8); PG8_WAIT_L(0); PG8_BAR; PG8_MMA(0, 0, At, B0); PG8_MMA(0, 1, At, B1); PG8_BAR; PG8_SCHED;
            PG8_LDA(At, 0, 1); PG8_STAGE(PG8_SB(0, 0), b2, voffB); PG8_STAGE(PG8_SB(0, 1), b2 + hstepB, voffB); PG8_STAGE(PG8_SA(0, 0), a2, voffA);
            PG8_WAIT_V(8); PG8_WAIT_L(0); PG8_BAR; PG8_MMA(1, 0, At, B0); PG8_MMA(1, 1, At, B1); PG8_BAR; PG8_SCHED;
            PG8_LDB(B0, 1, 0); PG8_LDB(B1, 1, 1); PG8_SCHED; PG8_LDA(At, 1, 0); PG8_STAGE(PG8_SA(0, 1), a2 + hstepA, voffA);
            PG8_WAIT_V(8); PG8_WAIT_L(0); PG8_BAR; PG8_MMA(0, 0, At, B0); PG8_MMA(0, 1, At, B1); PG8_BAR; PG8_SCHED;
            PG8_LDA(At, 1, 1); PG8_STAGE(PG8_SB(1, 0), b3, voffB); PG8_STAGE(PG8_SB(1, 1), b3 + hstepB, voffB); PG8_STAGE(PG8_SA(1, 0), a3, voffA);
            PG8_WAIT_V(8); PG8_WAIT_L(0); PG8_BAR; PG8_MMA(1, 0, At, B0); PG8_MMA(1, 1, At, B1); PG8_BAR; PG8_SCHED;
        }
        if constexpr (ALIGN_EPI) { if (wr == 0) PG8_BAR; }
        E.template run<2>(acc, cur, wr, wc, fr, fq);
        if (!has_next) break;
#pragma unroll
        for (int a = 0; a < 2; ++a)
#pragma unroll
            for (int b = 0; b < 2; ++b)
#pragma unroll
                for (int m = 0; m < 4; ++m)
#pragma unroll
                    for (int n = 0; n < 2; ++n) acc[a][b][m][n] = (f32x4){0.f, 0.f, 0.f, 0.f};
        cur = nxt; cA = nA; cB = nB; ++ui;
        if constexpr (ALIGN_EPI) { if (wr == 1) PG8_BAR; }
    }
    PG8_WAIT_V(0);
    if constexpr (!ALIGN_EPI) { if (wr == 0) PG8_BAR; }
    PG8_BAR;
#undef PG8_SA
#undef PG8_SB
#undef PG8_STAGE
#undef PG8_LDA
#undef PG8_LDB
#undef PG8_MMA
#undef PG8_WAIT_V
#undef PG8_WAIT_L
#undef PG8_BAR
#undef PG8_SCHED
}

template <class Epi>
__device__ __forceinline__ void gemm_half(PG8_LAS unsigned char* lds, const Gemm g, const Unit u, const Epi& E) {
    const int tid = threadIdx.x, wid = __builtin_amdgcn_readfirstlane(tid >> 6), lane = tid & 63, wr = wid >> 2, wc = wid & 3, fr = lane & 15, fq = lane >> 4;
    int nt = g.K / BK; asm volatile("" : "+s"(nt));
    unsigned voffA[2], voffB[2];
#pragma unroll
    for (int i = 0; i < 2; ++i) { int R, C; stage_rc(tid * 16 + i * 8192, R, C); const int Rb = (R & ~31) + perm32(R & 31);
        voffA[i] = (unsigned)(R * g.lda + C) * 2u; voffB[i] = (unsigned)(Rb * g.ldb + C) * 2u; }
    const size_t kstep = (size_t)(BK * 2);
    const size_t hstepA = (size_t)HALF * g.lda * 2, hstepB = (size_t)HALF * g.ldb * 2;
    const unsigned ldsw = (unsigned)wid * 1024u;
    const int aoff = lds_byte(wr * 64 + fr, fq * 8), boff = lds_byte(wc * 32 + fr, fq * 8);
#define PG8_SA(b, h) (((b) * 2 + (h)) * HTB)
#define PG8_SB(b, h) ((4 + (b) * 2 + (h)) * HTB)
#define PG8_STAGE(bufoff, gbase, voff) do { _Pragma("unroll") for (int _i = 0; _i < 2; ++_i) \
        __builtin_amdgcn_global_load_lds((const unsigned*)((const char*)(gbase) + (voff)[_i]), (PG8_LAS unsigned*)(lds + (bufoff) + ldsw + _i * 8192), 16, 0, 0); } while (0)
#define PG8_LDA(dst, b, h) do { _Pragma("unroll") for (int m = 0; m < 4; ++m) _Pragma("unroll") for (int k = 0; k < 2; ++k) dst[m][k] = *(const PG8_LAS bf16x8*)(lds + PG8_SA(b, h) + aoff + m * 2048 + k * 1024); } while (0)
#define PG8_LDB(dst, b, h) do { _Pragma("unroll") for (int n = 0; n < 2; ++n) _Pragma("unroll") for (int k = 0; k < 2; ++k) dst[n][k] = *(const PG8_LAS bf16x8*)(lds + PG8_SB(b, h) + boff + n * 2048 + k * 1024); } while (0)
#define PG8_MMA(ai, bj, At, Bt) do { __builtin_amdgcn_s_setprio(1); _Pragma("unroll") for (int m = 0; m < 4; ++m) _Pragma("unroll") for (int n = 0; n < 2; ++n) _Pragma("unroll") for (int k = 0; k < 2; ++k) \
        acc[ai][bj][m][n] = __builtin_amdgcn_mfma_f32_16x16x32_bf16(Bt[n][k], At[m][k], acc[ai][bj][m][n], 0, 0, 0); __builtin_amdgcn_s_setprio(0); } while (0)
#define PG8_WAIT_V(n) asm volatile("s_waitcnt vmcnt(" #n ")" ::: "memory")
#define PG8_WAIT_L(n) asm volatile("s_waitcnt lgkmcnt(" #n ")" ::: "memory")
#define PG8_BAR __builtin_amdgcn_s_barrier()
#define PG8_SCHED __builtin_amdgcn_sched_barrier(0)
    f32x4 acc[2][2][4][2];
#pragma unroll
    for (int a = 0; a < 2; ++a)
#pragma unroll
        for (int b = 0; b < 2; ++b)
#pragma unroll
            for (int m = 0; m < 4; ++m)
#pragma unroll
                for (int n = 0; n < 2; ++n) acc[a][b][m][n] = (f32x4){0.f, 0.f, 0.f, 0.f};
    bf16x8 At[4][2], B0[2][2], B1[2][2];
    const char* cA = (const char*)g.A + ((size_t)u.pm * BM + u.rh) * g.lda * 2 + (size_t)((u.pn >> g.ash) * g.amul) * 2; const char* cB = (const char*)g.Bt + (size_t)u.pn * 2 * hstepB;
    PG8_STAGE(PG8_SB(0, 0), cB, voffB); PG8_STAGE(PG8_SB(0, 1), cB + hstepB, voffB); PG8_STAGE(PG8_SA(0, 0), cA, voffA);
    PG8_STAGE(PG8_SB(1, 0), cB + kstep, voffB); PG8_STAGE(PG8_SB(1, 1), cB + hstepB + kstep, voffB); PG8_STAGE(PG8_SA(1, 0), cA + kstep, voffA);
    PG8_WAIT_V(6); PG8_BAR;
#define PG8_HALF_STEP(b, tt) do { \
        PG8_LDB(B0, b, 0); PG8_LDB(B1, b, 1); PG8_LDA(At, b, 0); PG8_WAIT_L(0); PG8_BAR; PG8_SCHED; \
        const bool more_ = (tt) + 2 < nt; \
        if (more_) { const char* b2 = cB + (size_t)((tt) + 2) * kstep; const char* a2 = cA + (size_t)((tt) + 2) * kstep; \
            PG8_STAGE(PG8_SB(b, 0), b2, voffB); PG8_STAGE(PG8_SB(b, 1), b2 + hstepB, voffB); PG8_STAGE(PG8_SA(b, 0), a2, voffA); } \
        PG8_MMA(0, 0, At, B0); PG8_MMA(0, 1, At, B1); \
        if (more_) PG8_WAIT_V(6); else PG8_WAIT_V(0); \
        PG8_BAR; PG8_SCHED; } while (0)
    for (int t = 0; t < nt; t += 2) { PG8_HALF_STEP(0, t); PG8_HALF_STEP(1, t + 1); }
    E.template run<1>(acc, u, wr, wc, fr, fq);
    PG8_BAR;
#undef PG8_HALF_STEP
#undef PG8_SA
#undef PG8_SB
#undef PG8_STAGE
#undef PG8_LDA
#undef PG8_LDB
#undef PG8_MMA
#undef PG8_WAIT_V
#undef PG8_WAIT_L
#undef PG8_BAR
#undef PG8_SCHED
}
}

constexpr int NWAVES = 8, NTHR = 512;
constexpr int M = 16384, SEQ = 4096, NB = 4, D = 1024, DPOOL = 512, DRNN = 1024, DIN = 4608, DFF = 2816;
constexpr float EPS = 1e-6f;
constexpr int NPH = 11;
constexpr int SCAN_T = 128, SCAN_NC = SEQ / SCAN_T;

constexpr size_t MiB = 1u << 20;
constexpr size_t WS_SP8 = 512 * 1024;
constexpr size_t WS_SSQ = 1 * MiB;
constexpr size_t WS_SSQ2 = 2 * MiB;
constexpr size_t WS_CS = 2 * MiB, WS_CH = 3 * MiB;
constexpr size_t WS_WIN = 4 * MiB;
constexpr size_t WS_WFI = 13 * MiB;
constexpr size_t WS_WFO = 24 * MiB;
constexpr size_t WS_WCAT = WS_WFO + 5632 * 1024;
constexpr size_t WS_WO = WS_WCAT + 3 * MiB;
constexpr size_t WS_WGRP = WS_WO + 2 * MiB;
constexpr size_t WS_WGATE = WS_WGRP + MiB / 4;
constexpr size_t WS_R1 = 36 * MiB;
constexpr size_t WS_R2 = 68 * MiB;
constexpr size_t WS_R3 = 84 * MiB;
constexpr size_t WS_R4 = 116 * MiB;
constexpr size_t WS_R7 = 148 * MiB;
constexpr size_t WS_R8 = 164 * MiB;
constexpr size_t WS_CAT = 196 * MiB;
constexpr size_t WS_MIXB = 148 * MiB;
constexpr size_t WS_ACT = 68 * MiB;
constexpr size_t WS_END = 244 * MiB;

constexpr int LDS_BYTES = 147456;

#define LAS __attribute__((address_space(3)))
typedef unsigned short bf16;
typedef unsigned v4u __attribute__((ext_vector_type(4)));
typedef unsigned v2u __attribute__((ext_vector_type(2)));
typedef float f32x4 __attribute__((ext_vector_type(4)));
typedef float f32x2 __attribute__((ext_vector_type(2)));
#define LDS_WAIT() asm volatile("s_waitcnt lgkmcnt(0)" ::: "memory")
using pg8::cvt_pk_bf16; using pg8::bf_lo; using pg8::bf_hi;

struct Args { const float* in[19]; float* out; unsigned char* ws; int ph_lo, ph_hi; };
enum { I_X = 0, I_NORM_MIX, I_W_IN, I_W_GRP, I_POOL_SCALE, I_W_POOL_OUT, I_CONV_W, I_CONV_B, I_W_RG_A, I_B_RG_A, I_W_RG_X, I_B_RG_X, I_LAMBDA, I_W_RNN_OUT, I_W_O, I_NORM_FFN, I_W_FFN_IN, I_W_FFN_OUT, I_NORM_FINAL };

__device__ __forceinline__ float wave_sum(float v) {
#pragma unroll
    for (int o = 1; o < 64; o <<= 1) v += __shfl_xor(v, o);
    return v;
}

__device__ __forceinline__ void transpose_item(const float* W, int Nsrc, int Kdst, bf16* WT, int k0, int n_src0, int n_dst0, const float* kscale, LAS float* scr, int lane) {
    f32x4 v[8]; const int n4 = (lane & 7) * 4;
#pragma unroll
    for (int i = 0; i < 8; ++i) { const int kk = 8 * i + (lane >> 3); v[i] = *(const f32x4*)(W + (size_t)(k0 + kk) * Nsrc + n_src0 + n4); }
    if (kscale) {
#pragma unroll
        for (int i = 0; i < 8; ++i) v[i] = v[i] * kscale[k0 + 8 * i + (lane >> 3)]; }
#pragma unroll
    for (int i = 0; i < 8; ++i) { const int kk = 8 * i + (lane >> 3);
#pragma unroll
        for (int j = 0; j < 4; ++j) scr[kk * 33 + n4 + j] = v[i][j]; }
    LDS_WAIT(); asm volatile("" ::: "memory");
    const int c = lane & 7;
#pragma unroll
    for (int j = 0; j < 4; ++j) { const int n = (lane >> 3) + 8 * j; const LAS float* s = scr + (8 * c) * 33 + n;
        v4u o; o.x = cvt_pk_bf16(s[0 * 33], s[1 * 33]); o.y = cvt_pk_bf16(s[2 * 33], s[3 * 33]); o.z = cvt_pk_bf16(s[4 * 33], s[5 * 33]); o.w = cvt_pk_bf16(s[6 * 33], s[7 * 33]);
        *(v4u*)(WT + (size_t)(n_dst0 + n) * Kdst + k0 + 8 * c) = o; }
    LDS_WAIT(); asm volatile("" ::: "memory");
}

#define XB_TMO      128
#define XB_XCNT(j)  (256  + 64 * (j))
#define XB_XSUB(j)  (1280 + 64 * (j))
#define XB_XGEN(j)  (2304 + 64 * (j))
#define XB_TOP      3328
#define XB_TOPGEN   3392
#define XCD_BAR_WORDS 3456
#define XB_SPIN_CAP (1u << 18)
__device__ __forceinline__ unsigned xb_ld(unsigned* p)              { return __hip_atomic_load(p, __ATOMIC_RELAXED, __HIP_MEMORY_SCOPE_AGENT); }
__device__ __forceinline__ unsigned xb_add(unsigned* p, unsigned v) { return __hip_atomic_fetch_add(p, v, __ATOMIC_RELAXED, __HIP_MEMORY_SCOPE_AGENT); }
__device__ __forceinline__ unsigned xb_xcc_id() { return (unsigned)__builtin_amdgcn_s_getreg((3 << 11) | 20) & 0xFu; }
#define XB_SPIN(cond, bar) do { unsigned _sp = 0; while (cond) { __builtin_amdgcn_s_sleep(1); \
    if ((++_sp & 255u) == 0u) { if (xb_ld(&(bar)[XB_TMO])) break; if (_sp > XB_SPIN_CAP) { atomicAdd(&(bar)[XB_TMO], 1u); break; } } } } while (0)
struct XcdBarrier { unsigned* bar; unsigned x; volatile LAS unsigned* st; };
__device__ __forceinline__ XcdBarrier xcd_barrier_post(unsigned* bar, volatile LAS unsigned* st) {
    XcdBarrier b; b.bar = bar; b.x = xb_xcc_id(); b.st = st;
    if (threadIdx.x == 0) (void)xb_add(&bar[XB_XCNT(b.x)], 1u);
    return b;
}
__device__ __forceinline__ void xcd_barrier_complete(unsigned* bar, unsigned x, unsigned& nloc, unsigned& nx) {
    const unsigned G = gridDim.x * gridDim.y * gridDim.z;
    unsigned sum, cnt, mine, sp = 0u;
    for (;;) {
        sum = 0u; cnt = 0u; mine = 0u;
#pragma unroll
        for (unsigned j = 0; j < 16; ++j) { const unsigned c = xb_ld(&bar[XB_XCNT(j)]); sum += c; cnt += (c > 0u) ? 1u : 0u; mine = (j == x) ? c : mine; }
        if (sum == G) break;
        __builtin_amdgcn_s_sleep(1);
        if ((++sp & 255u) == 0u) { if (xb_ld(&bar[XB_TMO])) break; if (sp > XB_SPIN_CAP) { atomicAdd(&bar[XB_TMO], 1u); break; } }
    }
    nloc = mine > 0u ? mine : 1u; nx = cnt > 0u ? cnt : 1u;
}
__device__ __forceinline__ void xcd_barrier(const XcdBarrier& b) {
    asm volatile("s_waitcnt vmcnt(0)" ::: "memory");
    __syncthreads();
    if (threadIdx.x == 0) {
        unsigned* bar = b.bar;
        __builtin_amdgcn_s_waitcnt(0);
        unsigned nloc = b.st[0], nx = b.st[1];
        if (nloc == 0u) { xcd_barrier_complete(bar, b.x, nloc, nx); b.st[0] = nloc; b.st[1] = nx; }
        const unsigned old = xb_add(&bar[XB_XSUB(b.x)], 1u);
        const unsigned gen = old / nloc;
        if (old + 1u == (gen + 1u) * nloc) {
            __builtin_amdgcn_fence(__ATOMIC_RELEASE, "agent");
            asm volatile("s_waitcnt vmcnt(0)" ::: "memory");
            const unsigned og = xb_add(&bar[XB_TOP], 1u);
            const unsigned tg = og / nx;
            if (og + 1u == (tg + 1u) * nx) xb_add(&bar[XB_TOPGEN], 1u);
            else XB_SPIN(xb_ld(&bar[XB_TOPGEN]) == tg, bar);
            __builtin_amdgcn_fence(__ATOMIC_ACQUIRE, "agent");
            xb_add(&bar[XB_XGEN(b.x)], 1u);
            asm volatile("s_waitcnt vmcnt(0)" ::: "memory");
        } else {
            XB_SPIN(xb_ld(&bar[XB_XGEN(b.x)]) == gen, bar);
            __builtin_amdgcn_fence(__ATOMIC_ACQUIRE, "agent");
            asm volatile("s_waitcnt vmcnt(0)" ::: "memory");
        }
    }
    __syncthreads();
}

template <int W>
__device__ __forceinline__ void pool_item(const bf16* src, bf16* dst, int tl) {
    v4u rw[W + 7];
#pragma unroll
    for (int k = 0; k < W + 7; ++k) rw[k] = (tl + k - (W - 1) >= 0) ? *(const v4u*)(src + (ptrdiff_t)(k - (W - 1)) * DPOOL) : (v4u){0u, 0u, 0u, 0u};
    f32x4 s0 = {0.f, 0.f, 0.f, 0.f}, s1 = s0;
#pragma unroll
    for (int k = 0; k < W - 1; ++k) { f32x4 a, c; pg8::unpack8(rw[k], a, c); s0 += a; s1 += c; }
#pragma unroll
    for (int i = 0; i < 8; ++i) { f32x4 a, c; pg8::unpack8(rw[W - 1 + i], a, c); s0 += a; s1 += c;
        const int t = tl + i; const int cnt = (t + 1 < W) ? t + 1 : W; const float inv = 1.0f / (float)cnt;
        *(v4u*)(dst + (size_t)i * DPOOL) = pg8::pack8(s0 * inv - a, s1 * inv - c);
        f32x4 a2, c2; pg8::unpack8(rw[i], a2, c2); s0 -= a2; s1 -= c2; }
}
__device__ __forceinline__ void scan_local16(const bf16* lap, const bf16* bbp, f32x4 (&S)[2], f32x4 (&H)[2]) {
    S[0] = S[1] = H[0] = H[1] = (f32x4){0.f, 0.f, 0.f, 0.f};
#pragma unroll
    for (int i0 = 0; i0 < 16; i0 += 8) { v4u lw[8], bw[8];
#pragma unroll
        for (int i = 0; i < 8; ++i) { lw[i] = *(const v4u*)(lap + (size_t)(i0 + i) * DRNN); bw[i] = *(const v4u*)(bbp + (size_t)(i0 + i) * DRNN); }
#pragma unroll
        for (int i = 0; i < 8; ++i) { f32x4 l[2], bq[2]; pg8::unpack8(lw[i], l[0], l[1]); pg8::unpack8(bw[i], bq[0], bq[1]);
#pragma unroll
            for (int n = 0; n < 2; ++n)
#pragma unroll
                for (int j = 0; j < 4; ++j) { H[n][j] = __expf(l[n][j]) * H[n][j] + bq[n][j]; S[n][j] += l[n][j]; } } }
}

__global__ void __launch_bounds__(NTHR, 2) fwd_kernel(Args args) {
    extern __shared__ __attribute__((aligned(16))) unsigned char lds_raw[];
    LAS unsigned char* lds = (LAS unsigned char*)lds_raw;
    const int tid = threadIdx.x, lane = tid & 63, wave = __builtin_amdgcn_readfirstlane(tid >> 6);
    const int G = gridDim.x, bx = blockIdx.x;
    unsigned char* ws = args.ws;
    const int lo = args.ph_lo, hi = args.ph_hi;
#ifndef PHASE_MASK
#define PHASE_MASK 0x7ff
#endif
#define IN(k) (((PHASE_MASK >> (k)) & 1) && lo <= (k) && (k) < hi)
#ifndef REPEAT_MASK
#define REPEAT_MASK 0
#endif
#define REPS(k) (((REPEAT_MASK >> (k)) & 1) ? 2 : 1)
#ifndef PROBE_PHASE
#define PROBE_PHASE -1
#endif
#define PROBE_MULT 4
    unsigned long long tp0 = 0, tp1 = 0;
#define TSTART(k) do { if ((k) == PROBE_PHASE) tp0 = __builtin_amdgcn_s_memrealtime(); } while (0)
#define TEND(k) do { if ((k) == PROBE_PHASE) tp1 = __builtin_amdgcn_s_memrealtime(); } while (0)
#define GSYNC() xcd_barrier(bar)
#define SEAM(k) do { if (IN(k) && IN((k) + 1)) { GSYNC(); } } while (0)

    const float* x = args.in[I_X];
    bf16* WIN = (bf16*)(ws + WS_WIN); bf16* WFI = (bf16*)(ws + WS_WFI); bf16* WFO = (bf16*)(ws + WS_WFO); bf16* WCAT = (bf16*)(ws + WS_WCAT);
    bf16* WO = (bf16*)(ws + WS_WO); bf16* WGRP = (bf16*)(ws + WS_WGRP); bf16* WGATE = (bf16*)(ws + WS_WGATE);
    bf16* XN = (bf16*)(ws + WS_R1); bf16* X1B = XN;
    bf16* CAT = (bf16*)(ws + WS_CAT); bf16* V = CAT + 512;
    bf16* UP = (bf16*)(ws + WS_R2);
    bf16* UR = (bf16*)(ws + WS_R3); bf16* LA = UR;
    bf16* UG = (bf16*)(ws + WS_R4);
    bf16* POOLED = (bf16*)(ws + WS_R7); bf16* BB = (bf16*)(ws + WS_R8);
    bf16* MIXB = (bf16*)(ws + WS_MIXB); bf16* ACT = (bf16*)(ws + WS_ACT);
    float* SSQ = (float*)(ws + WS_SSQ); float* CS = (float*)(ws + WS_CS); float* CH = (float*)(ws + WS_CH);
    bf16* G0 = (bf16*)args.out; bf16* G1 = G0 + (size_t)M * 1024;
    float* X1 = args.out;

#ifndef EXTRA_SYNCS
#define EXTRA_SYNCS 0
#endif
    if (PROBE_PHASE == 99) tp0 = __builtin_amdgcn_s_memrealtime();
    volatile LAS unsigned* MISC = (volatile LAS unsigned*)(lds + 131072 + 1024);
    if (tid < 32) MISC[tid] = 0u;
    __syncthreads();
    XcdBarrier bar = xcd_barrier_post((unsigned*)ws, MISC + 8);
    if (lo < 0) cg::this_grid().sync();
    for (int i = 0; i < EXTRA_SYNCS; ++i) GSYNC();
    TSTART(0);
    if (IN(0)) for (int rep = 0; rep < REPS(0); ++rep) { if (rep) GSYNC();
        LAS float* scr = (LAS float*)(lds + wave * 16384);
        const int gw = bx * NWAVES + wave, NGW = G * NWAVES;
        constexpr int I_IN = 16 * (DIN / 32), I_FI = 16 * (2 * DFF / 32), I_FO = (DFF / 64) * (D / 32), I_RO = 16 * 32, I_WO = 16 * 32, I_PO = 8 * 32;
        constexpr int NITEMS = I_IN + I_FI + I_FO + I_RO + I_WO + I_PO;
        for (int it = gw; it < NITEMS; it += NGW) {
            int r = it;
            if (r < I_IN) { const int nblk = DIN / 32, kb = r / nblk, nb = r % nblk, nd = 32 * nb; int ns = nd;
                if (nd >= 2560) { const int q = nd - 2560, pq = q >> 8, j0 = q & 255; ns = 2560 + (j0 < 128 ? 128 * pq + j0 : 1024 + 128 * pq + (j0 - 128)); }
                transpose_item(args.in[I_W_IN], DIN, D, WIN, 64 * kb, ns, nd, nullptr, scr, lane); continue; } r -= I_IN;
            if (r < I_FI) { const int nblk = 2 * DFF / 32, kb = r / nblk, nb = r % nblk, nd = 32 * nb, pn = nd >> 8, j0 = nd & 255;
                const int ns = j0 < 128 ? 128 * pn + j0 : DFF + 128 * pn + (j0 - 128);
                transpose_item(args.in[I_W_FFN_IN], 2 * DFF, D, WFI, 64 * kb, ns, nd, args.in[I_NORM_FFN], scr, lane); continue; } r -= I_FI;
            if (r < I_FO) { if (G != 256) { const int nblk = D / 32, kb = r / nblk, nb = r % nblk; transpose_item(args.in[I_W_FFN_OUT], D, DFF, WFO, 64 * kb, 32 * nb, 32 * nb, nullptr, scr, lane); } continue; } r -= I_FO;
            if (r < I_RO) { const int nblk = D / 32, kb = r / nblk, nb = r % nblk; transpose_item(args.in[I_W_RNN_OUT], D, 1536, WCAT + 512, 64 * kb, 32 * nb, 32 * nb, nullptr, scr, lane); continue; } r -= I_RO;
            if (r < I_WO) { const int nblk = D / 32, kb = r / nblk, nb = r % nblk; transpose_item(args.in[I_W_O], D, D, WO, 64 * kb, 32 * nb, 32 * nb, nullptr, scr, lane); continue; } r -= I_WO;
            { const int nblk = D / 32, kb = r / nblk, nb = r % nblk; transpose_item(args.in[I_W_POOL_OUT], D, 1536, WCAT, 64 * kb, 32 * nb, 32 * nb, nullptr, scr, lane); }
        }
        {
            const int gt = bx * NTHR + tid, NT = G * NTHR;
            const float* wg = args.in[I_W_GRP];
            for (int e = gt; e < 512 * 32; e += NT) { const int n = e >> 5, kc = (e & 31) * 8, g = n >> 7, nn = n & 127; float v[8];
#pragma unroll
                for (int j = 0; j < 8; ++j) { const int kk = kc + j - (g & 1) * 128; v[j] = (kk >= 0 && kk < 128) ? wg[((size_t)g * 128 + kk) * 128 + nn] : 0.f; }
                v4u o; o.x = cvt_pk_bf16(v[0], v[1]); o.y = cvt_pk_bf16(v[2], v[3]); o.z = cvt_pk_bf16(v[4], v[5]); o.w = cvt_pk_bf16(v[6], v[7]);
                *(v4u*)(WGRP + (size_t)n * 256 + kc) = o; }
            const float* wa = args.in[I_W_RG_A]; const float* wx = args.in[I_W_RG_X];
            for (int e = gt; e < 2048 * 16; e += NT) { const int n = e >> 4, kc = (e & 15) * 8, h = n >> 8, j = n & 255; const float* src = j < 128 ? wa : wx; const int jj = j & 127; float v[8];
#pragma unroll
                for (int q = 0; q < 8; ++q) v[q] = src[((size_t)h * 128 + kc + q) * 128 + jj];
                v4u o; o.x = cvt_pk_bf16(v[0], v[1]); o.y = cvt_pk_bf16(v[2], v[3]); o.z = cvt_pk_bf16(v[4], v[5]); o.w = cvt_pk_bf16(v[6], v[7]);
                *(v4u*)(WGATE + (size_t)n * 128 + kc) = o; }
        }
        { const int gt = bx * NTHR + tid; if (gt < DRNN) { const float z = -args.in[I_LAMBDA][gt]; ((float*)(ws + WS_SP8))[gt] = -8.0f * (fmaxf(z, 0.f) + log1pf(expf(-fabsf(z)))); } }
        const float* gmix = args.in[I_NORM_MIX];
        f32x4 gv[4];
#pragma unroll
        for (int j = 0; j < 4; ++j) gv[j] = ((const f32x4*)gmix)[lane + 64 * j];
        for (int m = gw; m < M; m += 2 * NGW) {
            const int m1 = (m + NGW < M) ? m + NGW : m;
            const f32x4* xr0 = (const f32x4*)(x + (size_t)m * D) + lane; const f32x4* xr1 = (const f32x4*)(x + (size_t)m1 * D) + lane; f32x4 v0[4], v1[4]; float s0 = 0.f, s1 = 0.f;
#pragma unroll
            for (int j = 0; j < 4; ++j) { v0[j] = xr0[64 * j]; v1[j] = xr1[64 * j]; }
#pragma unroll
            for (int j = 0; j < 4; ++j) { s0 += (v0[j].x * v0[j].x + v0[j].y * v0[j].y) + (v0[j].z * v0[j].z + v0[j].w * v0[j].w); s1 += (v1[j].x * v1[j].x + v1[j].y * v1[j].y) + (v1[j].z * v1[j].z + v1[j].w * v1[j].w); }
            const float rs0 = 1.0f / sqrtf(wave_sum(s0) * (1.f / D) + EPS), rs1 = 1.0f / sqrtf(wave_sum(s1) * (1.f / D) + EPS);
            v2u* o0 = (v2u*)(XN + (size_t)m * D) + lane; v2u* o1 = (v2u*)(XN + (size_t)m1 * D) + lane;
#pragma unroll
            for (int j = 0; j < 4; ++j) { const f32x4 y0 = v0[j] * rs0 * gv[j], y1 = v1[j] * rs1 * gv[j]; v2u w0, w1; w0.x = cvt_pk_bf16(y0.x, y0.y); w0.y = cvt_pk_bf16(y0.z, y0.w); w1.x = cvt_pk_bf16(y1.x, y1.y); w1.y = cvt_pk_bf16(y1.z, y1.w); o0[64 * j] = w0; o1[64 * j] = w1; }
        }
        __syncthreads();
    }
    SEAM(0);
    TEND(0);

    TSTART(1);
    if (IN(1)) for (int rep = 0; rep < REPS(1); ++rep) { if (rep) GSYNC();
        pg8::Gemm g{XN, WIN, M, 4096, D, D, D, 0, 0}; pg8::StaticOrder S; S.init(M, 4096, G, bx);
        pg8::EpiProj E{UP, UR, UG, G0, G1, 0};
        pg8::gemm_phase<pg8::EpiProj, true>(lds, g, S, E);
    }
    SEAM(1);
    TEND(1);

    TSTART(2);
    if (IN(2)) for (int rep = 0; rep < REPS(2); ++rep) { if (rep) GSYNC();
        { const int gw = bx * NWAVES + wave, NGW = G * NWAVES;
          for (int wi = gw; wi < (M / 32) * 4; wi += NGW) { const int g = wi & 3, t0 = (wi >> 2) * 32 + (lane >> 4) * 8, co = g * 16 + (lane & 15);
              const bf16* src = UP + (size_t)t0 * DPOOL + co * 8; bf16* dst = POOLED + (size_t)t0 * DPOOL + co * 8; const int tl = t0 & (SEQ - 1);
              if (g == 0) pool_item<2>(src, dst, tl); else if (g == 1) pool_item<4>(src, dst, tl); else if (g == 2) pool_item<8>(src, dst, tl); else pool_item<16>(src, dst, tl); } }
        { const int gt = bx * NTHR + tid, NT = G * NTHR;
          for (int it = gt; it < (M / 8) * 128; it += NT) { const int co = it & 127, t0 = (it >> 7) * 8, tl = t0 & (SEQ - 1);
              const bf16* src = UR + (size_t)t0 * DRNN + co * 8; bf16* dst = V + (size_t)t0 * 1536 + co * 8;
              const float* cw = args.in[I_CONV_W] + co * 8; const float* cb = args.in[I_CONV_B] + co * 8;
              v4u rw[11];
#pragma unroll
              for (int k = 0; k < 11; ++k) rw[k] = (k >= 3 || tl != 0) ? *(const v4u*)(src + (ptrdiff_t)(k - 3) * DRNN) : (v4u){0u, 0u, 0u, 0u};
              f32x4 w0[2], w1[2], w2[2], w3[2], bb[2];
#pragma unroll
              for (int n = 0; n < 2; ++n) { w0[n] = *(const f32x4*)(cw + 4 * n); w1[n] = *(const f32x4*)(cw + 1024 + 4 * n); w2[n] = *(const f32x4*)(cw + 2048 + 4 * n); w3[n] = *(const f32x4*)(cw + 3072 + 4 * n); bb[n] = *(const f32x4*)(cb + 4 * n); }
#pragma unroll
              for (int i = 0; i < 8; ++i) { f32x4 a[2], b[2], c[2], d[2]; pg8::unpack8(rw[i], a[0], a[1]); pg8::unpack8(rw[i + 1], b[0], b[1]); pg8::unpack8(rw[i + 2], c[0], c[1]); pg8::unpack8(rw[i + 3], d[0], d[1]);
                  *(v4u*)(dst + (size_t)i * 1536) = pg8::pack8(bb[0] + w0[0] * a[0] + w1[0] * b[0] + w2[0] * c[0] + w3[0] * d[0], bb[1] + w0[1] * a[1] + w1[1] * b[1] + w2[1] * c[1] + w3[1] * d[1]); }
          } }
    }
    SEAM(2);
    TEND(2);

    TSTART(3);
    if (IN(3)) for (int rep = 0; rep < REPS(3); ++rep) { if (rep) GSYNC();
        const bool uneven = (G == 256);
        {
          pg8::Gemm g{XN, WIN + (size_t)4096 * D, M, 512, D, D, D, 0, 0}; pg8::StaticOrder S; S.init(M, 512, G, bx);
          pg8::EpiProj E{UP, UR, UG, G0, G1, 16};
          pg8::gemm_phase<pg8::EpiProj, true>(lds, g, S, E); }
        { pg8::Gemm g{POOLED, WGRP, M, 512, 256, 512, 256, 0, 256}; pg8::StaticOrder S; S.init(M, 512, G, (bx + G / 2) % G);
          pg8::EpiGrp E{CAT, 1536, args.in[I_POOL_SCALE]};
          pg8::gemm_phase<pg8::EpiGrp, true>(lds, g, S, E); }
        { pg8::Gemm g{V, WGATE, M, 2048, 128, 1536, 128, 0, 128}; pg8::StaticOrder S; S.init(M, 2048, G, bx);
          if (uneven) { if (bx < 128) { S.lin_base = bx; S.lin_cnt = 1; } else { S.lin_base = 128 + (bx - 128) * 3; S.lin_cnt = 3; } }
          pg8::EpiGate E{V, LA, BB, args.in[I_B_RG_A], args.in[I_B_RG_X], (const float*)(ws + WS_SP8)};
          pg8::gemm_phase<pg8::EpiGate, true>(lds, g, S, E); }
    }
    SEAM(3);
    TEND(3);

    TSTART(4);
    TEND(4);

    TSTART(5);
    if (IN(5)) for (int rep = 0; rep < REPS(5); ++rep) { if (rep) GSYNC();
        LAS float* PAS = (LAS float*)lds; LAS float* PAH = PAS + 8 * 512; LAS float* PBS = PAH + 8 * 512; LAS float* PBH = PBS + 8 * 512;
        unsigned* flags = (unsigned*)ws + 8192;
        for (int bi = bx; bi < NB * SCAN_NC * 2; bi += G) { const int hh = bi & 1, c = (bi >> 1) % SCAN_NC, b = bi / (2 * SCAN_NC);
            const size_t off = ((size_t)b * SEQ + (size_t)c * SCAN_T + wave * 16) * DRNN + hh * 512 + lane * 8;
            v4u lwk[16], bwk[16];
#pragma unroll
            for (int i = 0; i < 16; ++i) { lwk[i] = *(const v4u*)(LA + off + (size_t)i * DRNN); bwk[i] = *(const v4u*)(BB + off + (size_t)i * DRNN); }
            { f32x4 S[2] = {{0.f, 0.f, 0.f, 0.f}, {0.f, 0.f, 0.f, 0.f}}, H[2] = {{0.f, 0.f, 0.f, 0.f}, {0.f, 0.f, 0.f, 0.f}};
#pragma unroll
              for (int i = 0; i < 16; ++i) { f32x4 l[2], bq[2]; pg8::unpack8(lwk[i], l[0], l[1]); pg8::unpack8(bwk[i], bq[0], bq[1]);
#pragma unroll
                  for (int n = 0; n < 2; ++n)
#pragma unroll
                      for (int j = 0; j < 4; ++j) { H[n][j] = __expf(l[n][j]) * H[n][j] + bq[n][j]; S[n][j] += l[n][j]; } }
              *(LAS f32x4*)(PBS + wave * 512 + lane * 8) = S[0]; *(LAS f32x4*)(PBS + wave * 512 + lane * 8 + 4) = S[1];
              *(LAS f32x4*)(PBH + wave * 512 + lane * 8) = H[0]; *(LAS f32x4*)(PBH + wave * 512 + lane * 8 + 4) = H[1]; }
#pragma unroll
            for (int i = 0; i < 16; ++i) asm volatile("" : "+v"(lwk[i]), "+v"(bwk[i]));
            __syncthreads();
            { float h = 0.f, st = 0.f;
#pragma unroll
              for (int sb = 0; sb < 8; ++sb) { const float sv = PBS[sb * 512 + tid]; h = __expf(sv) * h + PBH[sb * 512 + tid]; st += sv; }
              const size_t co = ((size_t)b * SCAN_NC + c) * DRNN + hh * 512 + tid;
              __hip_atomic_store(CS + co, st, __ATOMIC_RELAXED, __HIP_MEMORY_SCOPE_AGENT); __hip_atomic_store(CH + co, h, __ATOMIC_RELAXED, __HIP_MEMORY_SCOPE_AGENT); }
            asm volatile("s_waitcnt vmcnt(0)" ::: "memory");
            __syncthreads();
            if (tid == 0) __hip_atomic_store(flags + ((b * 2 + hh) * SCAN_NC + c) * 16, 1u, __ATOMIC_RELAXED, __HIP_MEMORY_SCOPE_AGENT);
            { f32x4 S[2] = {{0.f, 0.f, 0.f, 0.f}, {0.f, 0.f, 0.f, 0.f}}, H[2] = {{0.f, 0.f, 0.f, 0.f}, {0.f, 0.f, 0.f, 0.f}};
              if (wave * 4 < c) {
                  for (int q = 0; q < 4; ++q) { const int cc = wave * 4 + q; if (cc < c) { unsigned* f = flags + ((b * 2 + hh) * SCAN_NC + cc) * 16; unsigned sp = 0;
                      while ((unsigned)__builtin_amdgcn_readfirstlane(__hip_atomic_load(f, __ATOMIC_RELAXED, __HIP_MEMORY_SCOPE_AGENT)) == 0u) { __builtin_amdgcn_s_sleep(1); if (++sp > (1u << 20)) break; } } }
                  __builtin_amdgcn_fence(__ATOMIC_ACQUIRE, "agent");
#pragma unroll
                  for (int q0 = 0; q0 < 4; q0 += 2) { f32x4 cs[2][2], ch[2][2];
#pragma unroll
                      for (int q = 0; q < 2; ++q) { const int cc = wave * 4 + q0 + q; const size_t co = ((size_t)b * SCAN_NC + (cc < c ? cc : 0)) * DRNN + hh * 512 + lane * 8;
                          cs[q][0] = *(const f32x4*)(CS + co); cs[q][1] = *(const f32x4*)(CS + co + 4); ch[q][0] = *(const f32x4*)(CH + co); ch[q][1] = *(const f32x4*)(CH + co + 4); }
#pragma unroll
                      for (int q = 0; q < 2; ++q) { if (wave * 4 + q0 + q < c) {
#pragma unroll
                          for (int n = 0; n < 2; ++n)
#pragma unroll
                              for (int j = 0; j < 4; ++j) { H[n][j] = __expf(cs[q][n][j]) * H[n][j] + ch[q][n][j]; S[n][j] += cs[q][n][j]; } } }
                      asm volatile("" ::: "memory"); }
              }
              *(LAS f32x4*)(PAS + wave * 512 + lane * 8) = S[0]; *(LAS f32x4*)(PAS + wave * 512 + lane * 8 + 4) = S[1];
              *(LAS f32x4*)(PAH + wave * 512 + lane * 8) = H[0]; *(LAS f32x4*)(PAH + wave * 512 + lane * 8 + 4) = H[1]; }
            __syncthreads();
            f32x4 h[2] = {{0.f, 0.f, 0.f, 0.f}, {0.f, 0.f, 0.f, 0.f}};
#pragma unroll
            for (int sb = 0; sb < 8; ++sb) {
#pragma unroll
                for (int n = 0; n < 2; ++n) { const f32x4 sv = *(const LAS f32x4*)(PAS + sb * 512 + lane * 8 + 4 * n), hv = *(const LAS f32x4*)(PAH + sb * 512 + lane * 8 + 4 * n);
#pragma unroll
                    for (int j = 0; j < 4; ++j) h[n][j] = __expf(sv[j]) * h[n][j] + hv[j]; } }
            for (int sb = 0; sb < wave; ++sb) {
#pragma unroll
                for (int n = 0; n < 2; ++n) { const f32x4 sv = *(const LAS f32x4*)(PBS + sb * 512 + lane * 8 + 4 * n), hv = *(const LAS f32x4*)(PBH + sb * 512 + lane * 8 + 4 * n);
#pragma unroll
                    for (int j = 0; j < 4; ++j) h[n][j] = __expf(sv[j]) * h[n][j] + hv[j]; } }
            const bf16* ugp = UG + off;
            bf16* hgp = CAT + ((size_t)b * SEQ + (size_t)c * SCAN_T + wave * 16) * 1536 + 512 + hh * 512 + lane * 8;
#pragma unroll
            for (int i0 = 0; i0 < 16; i0 += 8) { v4u gw8[8];
#pragma unroll
                for (int i = 0; i < 8; ++i) gw8[i] = *(const v4u*)(ugp + (size_t)(i0 + i) * DRNN);
#pragma unroll
                for (int i = 0; i < 8; ++i) { f32x4 l[2], bq[2], gq[2], o[2]; pg8::unpack8(lwk[i0 + i], l[0], l[1]); pg8::unpack8(bwk[i0 + i], bq[0], bq[1]); pg8::unpack8(gw8[i], gq[0], gq[1]);
#pragma unroll
                    for (int n = 0; n < 2; ++n)
#pragma unroll
                        for (int j = 0; j < 4; ++j) { h[n][j] = __expf(l[n][j]) * h[n][j] + bq[n][j]; o[n][j] = h[n][j] * pg8::gelu_tanh_(gq[n][j]); }
                    *(v4u*)(hgp + (size_t)(i0 + i) * 1536) = pg8::pack8(o[0], o[1]); } }
            __syncthreads();
        }
    }
    SEAM(5);
    TEND(5);

    TSTART(6);
    if (IN(6)) for (int rep = 0; rep < REPS(6); ++rep) { if (rep) GSYNC();
        pg8::Gemm g{CAT, WCAT, M, D, 1536, 1536, 1536, 0, 0}; pg8::StaticOrder S; S.init(M, D, G, bx);
        pg8::EpiMix E{G0, G1, MIXB};
        pg8::gemm_phase<pg8::EpiMix, true, 8>(lds, g, S, E);
    }
    SEAM(6);
    TEND(6);

    TSTART(7);
    if (IN(7)) for (int rep = 0; rep < REPS(7); ++rep) { if (rep) GSYNC();
        pg8::Gemm g{MIXB, WO, M, D, D, D, D, 0, 0}; pg8::StaticOrder S; S.init(M, D, G, bx);
        pg8::EpiRes1 E{x, X1B, SSQ};
        pg8::gemm_phase<pg8::EpiRes1, true>(lds, g, S, E);
    }
    SEAM(7);
    TEND(7);

    TSTART(8);
    if (IN(8)) for (int rep = 0; rep < REPS(8); ++rep) { if (rep) GSYNC();
        pg8::Gemm g{X1B, WFI, M, 2 * DFF, D, D, D, 0, 0}; pg8::StaticOrder S; S.init(M, 2 * DFF, G, bx);
        LAS float* RSL = (LAS float*)(lds + 133120);
        { const int r = tid & 255;
          for (int i = tid >> 8; i < 8; i += 2) { pg8::Unit u; if (!S.next(i, u)) break;
              const f32x4* sp = (const f32x4*)(SSQ + (size_t)(u.pm * 256 + r) * 16); const f32x4 st = (sp[0] + sp[1]) + (sp[2] + sp[3]);
              RSL[i * 256 + r] = __builtin_amdgcn_rsqf(((st[0] + st[1]) + (st[2] + st[3])) * (1.0f / 1024.0f) + 1e-6f); }
          __syncthreads(); }
        pg8::EpiSwiglu E{RSL, ACT};
        pg8::gemm_phase<pg8::EpiSwiglu, true>(lds, g, S, E);
        if (G == 256 && bx >= 128) {
            LAS float* scr = (LAS float*)(lds + wave * 16384); constexpr int I_FO = (DFF / 64) * (D / 32);
            for (int r = (bx - 128) * NWAVES + wave; r < I_FO; r += 128 * NWAVES) { const int nblk = D / 32, kb = r / nblk, nb = r % nblk;
                transpose_item(args.in[I_W_FFN_OUT], D, DFF, WFO, 64 * kb, 32 * nb, 32 * nb, nullptr, scr, lane); }
        }
    }
    SEAM(8);
    TEND(8);

    TSTART(9);
    if (IN(9)) for (int rep = 0; rep < REPS(9); ++rep) { if (rep) GSYNC();
        pg8::Gemm g{ACT, WFO, M, D, DFF, DFF, DFF, 0, 0}; pg8::StaticOrder S; S.init(M, D, G, bx);
        if (G == 256) { pg8::EpiFinal E{X1B, X1, (float*)(ws + WS_SSQ2), (unsigned*)ws + 4096, args.in[I_NORM_FINAL]};
            pg8::gemm_phase<pg8::EpiFinal, true>(lds, g, S, E); }
        else { pg8::EpiRes2 E{X1B, X1};
            pg8::gemm_phase<pg8::EpiRes2, true>(lds, g, S, E); }
    }
    if (G != 256) SEAM(9);
    TEND(9);

    TSTART(10);
    if (IN(10) && G != 256) for (int rep = 0; rep < REPS(10); ++rep) { if (rep) GSYNC();
        const int gw = bx * NWAVES + wave, NGW = G * NWAVES;
        const float* gf = args.in[I_NORM_FINAL]; f32x4 gv[4];
#pragma unroll
        for (int j = 0; j < 4; ++j) gv[j] = ((const f32x4*)gf)[lane + 64 * j];
        for (int m = gw; m < M; m += NGW) {
            f32x4* xr = (f32x4*)(X1 + (size_t)m * D) + lane; f32x4 v[4]; float s = 0.f;
#pragma unroll
            for (int j = 0; j < 4; ++j) { v[j] = xr[64 * j]; s += (v[j].x * v[j].x + v[j].y * v[j].y) + (v[j].z * v[j].z + v[j].w * v[j].w); }
            const float rs = 1.0f / sqrtf(wave_sum(s) * (1.f / D) + EPS);
#pragma unroll
            for (int j = 0; j < 4; ++j) xr[64 * j] = v[j] * rs * gv[j];
        }
    }
    if (PROBE_PHASE == 10 || PROBE_PHASE == 99) tp1 = __builtin_amdgcn_s_memrealtime();
    if (PROBE_PHASE >= 0 && bx == 0 && tid == 0) { const unsigned long long dt = (tp1 - tp0) * PROBE_MULT, te = __builtin_amdgcn_s_memrealtime(); while (__builtin_amdgcn_s_memrealtime() - te < dt) __builtin_amdgcn_s_sleep(8); }
#undef IN
#undef SEAM
}

extern "C" void kernel_launch(void* const* d_in, const int* in_sizes, int n_in, void* d_out, int out_size, void* d_ws, size_t ws_size, hipStream_t stream) {
    static int grid = 0;
    if (grid == 0) {
        if (n_in != 19 || out_size != M * D || ws_size < WS_END) { fprintf(stderr, "kernel_launch: unexpected shapes (n_in %d out %d ws %zu)\n", n_in, out_size, ws_size); grid = -1; return; }
        int dev = 0, cus = 0, per_cu = 0;
        hipGetDevice(&dev);
        hipDeviceGetAttribute(&cus, hipDeviceAttributeMultiprocessorCount, dev);
        if (hipFuncSetAttribute((const void*)fwd_kernel, hipFuncAttributeMaxDynamicSharedMemorySize, LDS_BYTES) != hipSuccess) { fprintf(stderr, "kernel_launch: hipFuncSetAttribute failed\n"); grid = -1; return; }
        if (hipOccupancyMaxActiveBlocksPerMultiprocessor(&per_cu, (const void*)fwd_kernel, NTHR, LDS_BYTES) != hipSuccess || per_cu < 1) { fprintf(stderr, "kernel_launch: occupancy query says %d\n", per_cu); per_cu = 1; }
        (void)hipGetLastError();
        grid = cus * 1;
        fprintf(stderr, "kernel_launch: grid %d (cus %d, per_cu %d)\n", grid, cus, per_cu);
    }
    if (grid < 0) return;
    if (hipMemsetAsync(d_ws, 0, 49152, stream) != hipSuccess) { fprintf(stderr, "kernel_launch: memset failed\n"); return; }
    Args a{};
    for (int i = 0; i < 19; ++i) a.in[i] = (const float*)d_in[i];
    a.out = (float*)d_out; a.ws = (unsigned char*)d_ws;
#if MK_PER_PHASE
    for (int p = 0; p < NPH; ++p) { a.ph_lo = p; a.ph_hi = p + 1; hipLaunchKernelGGL(fwd_kernel, dim3(grid), dim3(NTHR), LDS_BYTES, stream, a); }
#else
    a.ph_lo = 0; a.ph_hi = NPH;
    void* kargs[] = {&a};
    hipError_t e = hipLaunchCooperativeKernel((const void*)fwd_kernel, dim3(grid), dim3(NTHR), kargs, LDS_BYTES, stream);
    if (e != hipSuccess) fprintf(stderr, "cooperative launch failed: %s (grid %d)\n", hipGetErrorString(e), grid);
#endif
}
```

```cpp
#include <hip/hip_runtime.h>
#include <hip/hip_cooperative_groups.h>
#include <cstdio>
#include <cstdint>
namespace cg = cooperative_groups;

#ifndef MK_PER_PHASE
#define MK_PER_PHASE 0
#endif

namespace pg8 {
#define PG8_LAS __attribute__((address_space(3)))
typedef unsigned short bf16_t;
typedef short bf16x8 __attribute__((ext_vector_type(8)));
typedef float f32x4 __attribute__((ext_vector_type(4)));
typedef float f32x2 __attribute__((ext_vector_type(2)));
typedef unsigned u32x4 __attribute__((ext_vector_type(4)));
typedef unsigned u32x2 __attribute__((ext_vector_type(2)));
constexpr int BM = 256, BK = 64, HALF = 128, HTB = HALF * BK * 2, STAGE_BYTES = 8 * HTB, NXCD = 8, WGM = 8;

__host__ __device__ __forceinline__ int lds_byte(int r, int c) { const int st = (r >> 4) * 2 + (c >> 5), rr = r & 15, cc = c & 31, ob = rr * 64 + cc * 2; return st * 1024 + (ob ^ (((ob >> 9) & 1) << 5)); }
__host__ __device__ __forceinline__ void stage_rc(int b, int& R, int& C) { const int st = b / 1024, sb = b % 1024, swz = sb ^ (((sb >> 9) & 1) << 5); R = (st >> 1) * 16 + swz / 64; C = (st & 1) * 32 + (swz % 64) / 2; }
__host__ __device__ __forceinline__ int perm32(int rho) { const int n = rho >> 4, i = rho & 15; return 8 * (i >> 2) + 4 * n + (i & 3); }

struct Unit { int pm, pn, rh, idx; };
struct Gemm { const bf16_t* A; const bf16_t* Bt; int M, N, K, lda, ldb, ash, amul; };

struct StaticOrder {
    int nM, nN, nwg, G, c, limit, lin_base, lin_cnt;
    __host__ __device__ __forceinline__ void init(int M, int N, int G_, int c_) { nM = M / BM; nN = N / BM; nwg = nM * nN; G = G_; c = c_; limit = nwg; lin_base = 0; lin_cnt = -1; }
    __host__ __device__ __forceinline__ void map(int L, Unit& u) const {
        int wgid = L; { const int q = nwg / NXCD, r = nwg % NXCD, xcd = wgid % NXCD, off = wgid / NXCD; wgid = (xcd < r ? xcd * (q + 1) : r * (q + 1) + (xcd - r) * q) + off; }
        const int nig = WGM * nN, gid = wgid / nig, fm = gid * WGM, gsz = (nM - fm) < WGM ? (nM - fm) : WGM;
        u.pm = fm + ((wgid % nig) % gsz); u.pn = (wgid % nig) / gsz; u.rh = 0;
    }
    __host__ __device__ __forceinline__ bool next(int i, Unit& u) const {
        u.idx = i;
        if (lin_cnt >= 0) { if (i >= lin_cnt) return false; map(lin_base + i, u); return true; }
        const long L = (long)i * G + c; if (L >= limit) return false;
        map((int)L, u); return true;
    }
};

__device__ __forceinline__ unsigned cvt_pk_bf16(float lo, float hi) { unsigned r; asm volatile("v_cvt_pk_bf16_f32 %0, %1, %2" : "=v"(r) : "v"(lo), "v"(hi)); return r; }
__device__ __forceinline__ float bf_lo(unsigned w) { return __uint_as_float(w << 16); }
__device__ __forceinline__ float bf_hi(unsigned w) { return __uint_as_float(w & 0xffff0000u); }
__device__ __forceinline__ float sigmoidf_(float x) { return __builtin_amdgcn_rcpf(1.0f + __expf(-x)); }
__device__ __forceinline__ float gelu_tanh_(float x) { const float z = 1.5957691216057308f * (x + 0.044715f * x * x * x); return x * sigmoidf_(z); }
__device__ __forceinline__ u32x4 pack8(const f32x4 a, const f32x4 b) { u32x4 w; w.x = cvt_pk_bf16(a[0], a[1]); w.y = cvt_pk_bf16(a[2], a[3]); w.z = cvt_pk_bf16(b[0], b[1]); w.w = cvt_pk_bf16(b[2], b[3]); return w; }
__device__ __forceinline__ void unpack8(const u32x4 w, f32x4& a, f32x4& b) { a = (f32x4){bf_lo(w.x), bf_hi(w.x), bf_lo(w.y), bf_hi(w.y)}; b = (f32x4){bf_lo(w.z), bf_hi(w.z), bf_lo(w.w), bf_hi(w.w)}; }

#define EPI_ROWS_BEGIN _Pragma("unroll") for (int ai = 0; ai < NAI; ++ai) _Pragma("unroll") for (int m = 0; m < 4; ++m) { const int row = u.pm * BM + u.rh + ai * HALF + wr * 64 + m * 16 + fr;
#define EPI_ROWS_END }

struct EpiProj {
    bf16_t *UP, *UR, *UG, *RB, *G1; int pn_off;
    template <int NAI> __device__ __forceinline__ void run(const f32x4 (&acc)[2][2][4][2], const Unit& u, int wr, int wc, int fr, int fq) const {
        const int pn = u.pn + pn_off;
        if (pn < 10) {
            bf16_t* base; int ldc, colt;
            if (pn < 2) { base = UP; ldc = 512; colt = pn * 256; }
            else if (pn < 6) { base = UR; ldc = 1024; colt = (pn - 2) * 256; }
            else { base = UG; ldc = 1024; colt = (pn - 6) * 256; }
            const int col0 = colt + wc * 32 + 8 * fq;
            EPI_ROWS_BEGIN
                bf16_t* rowp = base + (unsigned)((unsigned)row * (unsigned)ldc + (unsigned)col0);
#pragma unroll
                for (int bj = 0; bj < 2; ++bj) *(u32x4*)(rowp + bj * HALF) = pack8(acc[ai][bj][m][0], acc[ai][bj][m][1]);
            EPI_ROWS_END
        } else {
            const int ch0 = (pn - 10) * 128 + wc * 32 + 8 * fq;
            EPI_ROWS_BEGIN
                const unsigned off = (unsigned)row * 1024u + (unsigned)ch0; f32x4 rr[2], gg[2];
#pragma unroll
                for (int n = 0; n < 2; ++n)
#pragma unroll
                    for (int j = 0; j < 4; ++j) { const float d0 = 1.0f + fminf(__expf(-acc[ai][0][m][n][j]), 1e18f), d1 = 1.0f + fminf(__expf(-acc[ai][1][m][n][j]), 1e18f);
                        const float q = __builtin_amdgcn_rcpf(d0 * d1); gg[n][j] = d0 * q; rr[n][j] = d1 * d1 * q; }
                *(u32x4*)(RB + off) = pack8(rr[0], rr[1]); *(u32x4*)(G1 + off) = pack8(gg[0], gg[1]);
            EPI_ROWS_END
        }
    }
};
struct EpiGrp {
    bf16_t* O; int ldc; const float* scale;
    template <int NAI> __device__ __forceinline__ void run(const f32x4 (&acc)[2][2][4][2], const Unit& u, int wr, int wc, int fr, int fq) const {
        const int col0 = u.pn * BM + wc * 32 + 8 * fq;
        f32x4 sc[2][2];
#pragma unroll
        for (int bj = 0; bj < 2; ++bj)
#pragma unroll
            for (int n = 0; n < 2; ++n) sc[bj][n] = *(const f32x4*)(scale + col0 + bj * HALF + 4 * n);
        EPI_ROWS_BEGIN
            bf16_t* rowp = O + (unsigned)((unsigned)row * (unsigned)ldc + (unsigned)col0);
#pragma unroll
            for (int bj = 0; bj < 2; ++bj) *(u32x4*)(rowp + bj * HALF) = pack8(acc[ai][bj][m][0] * sc[bj][0], acc[ai][bj][m][1] * sc[bj][1]);
        EPI_ROWS_END
    }
};
struct EpiGate {
    const bf16_t* V; bf16_t *LA, *BB; const float *b_a, *b_x, *sp8;
    template <int NAI, bool EXACT> __device__ __forceinline__ void rows(const f32x4 (&acc)[2][2][4][2], const Unit& u, int wr, int fr, int ch0, const f32x4 (&ba)[2], const f32x4 (&bx)[2], const f32x4 (&sp)[2]) const {
        u32x4 vwk[2][4];
        EPI_ROWS_BEGIN
            vwk[ai][m] = *(const u32x4*)(V + ((unsigned)row * 1536u + (unsigned)ch0));
        EPI_ROWS_END
        EPI_ROWS_BEGIN
            const unsigned off = (unsigned)row * 1024u + (unsigned)ch0;
            f32x4 vv[2]; unpack8(vwk[ai][m], vv[0], vv[1]);
            f32x4 la[2], bb[2];
#pragma unroll
            for (int n = 0; n < 2; ++n)
#pragma unroll
                for (int j = 0; j < 4; ++j) {
                    const float r = sigmoidf_(acc[ai][0][m][n][j] + ba[n][j]), ig = sigmoidf_(acc[ai][1][m][n][j] + bx[n][j]);
                    const float l = sp[n][j] * r, x2 = 2.0f * l;
                    const float poly = x2 * (1.0f + 0.5f * x2 * (1.0f + 0.33333334f * x2 * (1.0f + 0.25f * x2 * (1.0f + 0.2f * x2 * (1.0f + 0.16666667f * x2)))));
                    const float em1 = EXACT ? ((x2 > -0.25f) ? poly : (__expf(x2) - 1.0f)) : poly;
                    la[n][j] = l; bb[n][j] = __builtin_amdgcn_sqrtf(fmaxf(-em1, 0.f)) * ig * vv[n][j]; }
            *(u32x4*)(LA + off) = pack8(la[0], la[1]); *(u32x4*)(BB + off) = pack8(bb[0], bb[1]);
        EPI_ROWS_END
    }
    template <int NAI> __device__ __forceinline__ void run(const f32x4 (&acc)[2][2][4][2], const Unit& u, int wr, int wc, int fr, int fq) const {
        const int ch0 = u.pn * 128 + wc * 32 + 8 * fq;
        f32x4 ba[2], bx[2], sp[2]; bool big = false;
#pragma unroll
        for (int n = 0; n < 2; ++n) { ba[n] = *(const f32x4*)(b_a + ch0 + 4 * n); bx[n] = *(const f32x4*)(b_x + ch0 + 4 * n); sp[n] = *(const f32x4*)(sp8 + ch0 + 4 * n);
#pragma unroll
            for (int j = 0; j < 4; ++j) big = big || !(sp[n][j] >= -0.125f); }
        if (__builtin_amdgcn_ballot_w64(big) != 0ull) rows<NAI, true>(acc, u, wr, fr, ch0, ba, bx, sp);
        else rows<NAI, false>(acc, u, wr, fr, ch0, ba, bx, sp);
    }
};
struct EpiMix {
    const bf16_t *RB, *G1; bf16_t* MIXB;
    __device__ __forceinline__ void mid(f32x4 (&acc)[2][2][4][2], const Unit& u0, int wr, int wc, int fr, int fq) const {
        constexpr int NAI = 2; Unit u = u0; asm volatile("" : "+s"(u.pm), "+s"(u.pn));
        const int col0 = u.pn * BM + wc * 32 + 8 * fq;
        u32x4 rw[2][4][2];
        EPI_ROWS_BEGIN
            const unsigned off = (unsigned)row * 1024u + (unsigned)col0;
#pragma unroll
            for (int bj = 0; bj < 2; ++bj) rw[ai][m][bj] = *(const u32x4*)(RB + off + bj * HALF);
        EPI_ROWS_END
        EPI_ROWS_BEGIN
#pragma unroll
            for (int bj = 0; bj < 2; ++bj) { f32x4 r[2]; unpack8(rw[ai][m][bj], r[0], r[1]); acc[ai][bj][m][0] *= r[0]; acc[ai][bj][m][1] *= r[1]; }
            (void)row;
        EPI_ROWS_END
    }
    template <int NAI> __device__ __forceinline__ void run(const f32x4 (&acc)[2][2][4][2], const Unit& u, int wr, int wc, int fr, int fq) const {
        const int col0 = u.pn * BM + wc * 32 + 8 * fq;
        u32x4 gw[2][4][2];
        EPI_ROWS_BEGIN
            const unsigned off = (unsigned)row * 1024u + (unsigned)col0;
#pragma unroll
            for (int bj = 0; bj < 2; ++bj) gw[ai][m][bj] = *(const u32x4*)(G1 + off + bj * HALF);
        EPI_ROWS_END
        EPI_ROWS_BEGIN
            const unsigned off = (unsigned)row * 1024u + (unsigned)col0;
#pragma unroll
            for (int bj = 0; bj < 2; ++bj) { f32x4 g[2]; unpack8(gw[ai][m][bj], g[0], g[1]);
                *(u32x4*)(MIXB + off + bj * HALF) = pack8(g[0] * acc[ai][bj][m][0], g[1] * acc[ai][bj][m][1]); }
        EPI_ROWS_END
    }
};
struct EpiRes1 {
    const bf16_t* XNB; const float* RSI; bf16_t* X1B; float* SSQ;
    template <int NAI> __device__ __forceinline__ void run(const f32x4 (&acc)[2][2][4][2], const Unit& u, int wr, int wc, int fr, int fq) const {
        const int col0 = u.pn * BM + wc * 32 + 8 * fq;
#pragma unroll
        for (int ai = 0; ai < NAI; ++ai) {
            u32x4 xw[4][2]; float qi[4];
#pragma unroll
            for (int m = 0; m < 4; ++m) { const int row = u.pm * BM + u.rh + ai * HALF + wr * 64 + m * 16 + fr; const unsigned off = (unsigned)row * 1024u + (unsigned)col0; qi[m] = RSI[row];
#pragma unroll
                for (int bj = 0; bj < 2; ++bj) xw[m][bj] = *(const u32x4*)(XNB + off + bj * HALF); }
            asm volatile("s_waitcnt vmcnt(0)" ::: "memory");
#pragma unroll
            for (int m = 0; m < 4; ++m) { const int row = u.pm * BM + u.rh + ai * HALF + wr * 64 + m * 16 + fr; const unsigned off = (unsigned)row * 1024u + (unsigned)col0; float ss = 0.f;
#pragma unroll
                for (int bj = 0; bj < 2; ++bj) { f32x4 xa, xb; unpack8(xw[m][bj], xa, xb);
                    const f32x4 a = xa * qi[m] + acc[ai][bj][m][0], b = xb * qi[m] + acc[ai][bj][m][1];
                    *(u32x4*)(X1B + off + bj * HALF) = pack8(a, b);
                    ss += (a[0] * a[0] + a[1] * a[1]) + (a[2] * a[2] + a[3] * a[3]) + (b[0] * b[0] + b[1] * b[1]) + (b[2] * b[2] + b[3] * b[3]); }
                ss += __shfl_xor(ss, 16); ss += __shfl_xor(ss, 32);
                if (fq == 0) SSQ[(unsigned)row * 16u + (unsigned)(u.pn * 4 + wc)] = ss; }
        }
    }
};
struct EpiSwiglu {
    const PG8_LAS float* RSL; bf16_t* ACT;
    template <int NAI> __device__ __forceinline__ void run(const f32x4 (&acc)[2][2][4][2], const Unit& u, int wr, int wc, int fr, int fq) const {
        const int col0 = u.pn * 128 + wc * 32 + 8 * fq;
        const PG8_LAS float* rt = RSL + u.idx * 256 + wr * 64 + fr;
        EPI_ROWS_BEGIN
            const float rs = rt[ai * HALF + m * 16];
            f32x4 o[2];
#pragma unroll
            for (int n = 0; n < 2; ++n)
#pragma unroll
                for (int j = 0; j < 4; ++j) { const float g = acc[ai][0][m][n][j] * rs, up = acc[ai][1][m][n][j] * rs; o[n][j] = g * sigmoidf_(g) * up; }
            __builtin_nontemporal_store(pack8(o[0], o[1]), (u32x4*)(ACT + (unsigned)((unsigned)row * 2816u + (unsigned)col0)));
        EPI_ROWS_END
    }
};
struct EpiRes2 {
    const bf16_t* X1B; float* OUT;
    template <int NAI> __device__ __forceinline__ void run(const f32x4 (&acc)[2][2][4][2], const Unit& u, int wr, int wc, int fr, int fq) const {
        const int col0 = u.pn * BM + wc * 32 + 8 * fq;
        EPI_ROWS_BEGIN
            const unsigned off = (unsigned)row * 1024u + (unsigned)col0;
#pragma unroll
            for (int bj = 0; bj < 2; ++bj) { f32x4 xa, xb; unpack8(*(const u32x4*)(X1B + off + bj * HALF), xa, xb);
                *(f32x4*)(OUT + off + bj * HALF) = xa + acc[ai][bj][m][0]; *(f32x4*)(OUT + off + bj * HALF + 4) = xb + acc[ai][bj][m][1]; }
        EPI_ROWS_END
    }
};

struct EpiFinal {
    const bf16_t* X1B; float* OUT; float* SSQ2; unsigned* cnt; const float* gfin;
    template <int NAI> __device__ __forceinline__ void run(f32x4 (&acc)[2][2][4][2], const Unit& u, int wr, int wc, int fr, int fq) const {
        const int col0 = u.pn * BM + wc * 32 + 8 * fq;
        { u32x4 xw[2][4][2];
          EPI_ROWS_BEGIN
              const unsigned off = (unsigned)row * 1024u + (unsigned)col0;
#pragma unroll
              for (int bj = 0; bj < 2; ++bj) xw[ai][m][bj] = *(const u32x4*)(X1B + off + bj * HALF);
          EPI_ROWS_END
          EPI_ROWS_BEGIN
              float ss = 0.f;
#pragma unroll
              for (int bj = 0; bj < 2; ++bj) { f32x4 xa, xb; unpack8(xw[ai][m][bj], xa, xb);
                  const f32x4 a = xa + acc[ai][bj][m][0], b = xb + acc[ai][bj][m][1]; acc[ai][bj][m][0] = a; acc[ai][bj][m][1] = b;
                  ss += (a[0] * a[0] + a[1] * a[1]) + (a[2] * a[2] + a[3] * a[3]) + (b[0] * b[0] + b[1] * b[1]) + (b[2] * b[2] + b[3] * b[3]); }
              ss += __shfl_xor(ss, 16); ss += __shfl_xor(ss, 32);
              if (fq == 0) __hip_atomic_store(SSQ2 + (unsigned)row * 16u + (unsigned)(u.pn * 4 + wc), ss, __ATOMIC_RELAXED, __HIP_MEMORY_SCOPE_AGENT);
          EPI_ROWS_END }
        asm volatile("s_waitcnt vmcnt(0)" ::: "memory");
        unsigned* c = cnt + 64 * u.pm;
        if ((threadIdx.x & 63) == 0) __hip_atomic_fetch_add(c, 1u, __ATOMIC_RELAXED, __HIP_MEMORY_SCOPE_AGENT);
        f32x4 gv[2][2];
#pragma unroll
        for (int bj = 0; bj < 2; ++bj)
#pragma unroll
            for (int n = 0; n < 2; ++n) gv[bj][n] = *(const f32x4*)(gfin + col0 + bj * HALF + 4 * n);
        { unsigned sp = 0;
          while ((unsigned)__builtin_amdgcn_readfirstlane(__hip_atomic_load(c, __ATOMIC_RELAXED, __HIP_MEMORY_SCOPE_AGENT)) < 32u) { __builtin_amdgcn_s_sleep(2); if (++sp > (1u << 20)) break; } }
        __builtin_amdgcn_fence(__ATOMIC_ACQUIRE, "agent");
        unsigned long long w0[2][4], w1[2][4];
        EPI_ROWS_BEGIN
            const unsigned long long* sl = (const unsigned long long*)(SSQ2 + (unsigned)row * 16u + (unsigned)(4 * fq));
            w0[ai][m] = __hip_atomic_load(sl, __ATOMIC_RELAXED, __HIP_MEMORY_SCOPE_AGENT); w1[ai][m] = __hip_atomic_load(sl + 1, __ATOMIC_RELAXED, __HIP_MEMORY_SCOPE_AGENT);
        EPI_ROWS_END
        EPI_ROWS_BEGIN
            const unsigned off = (unsigned)row * 1024u + (unsigned)col0;
            float sq = (__uint_as_float((unsigned)w0[ai][m]) + __uint_as_float((unsigned)(w0[ai][m] >> 32))) + (__uint_as_float((unsigned)w1[ai][m]) + __uint_as_float((unsigned)(w1[ai][m] >> 32)));
            sq += __shfl_xor(sq, 16); sq += __shfl_xor(sq, 32);
            const float rs = 1.0f / sqrtf(sq * (1.0f / 1024.0f) + 1e-6f);
#pragma unroll
            for (int bj = 0; bj < 2; ++bj) { *(f32x4*)(OUT + off + bj * HALF) = acc[ai][bj][m][0] * rs * gv[bj][0]; *(f32x4*)(OUT + off + bj * HALF + 4) = acc[ai][bj][m][1] * rs * gv[bj][1]; }
        EPI_ROWS_END
    }
};

template <class Epi, bool ALIGN_EPI, int MID_T = -1>
__device__ __forceinline__ void gemm_phase(PG8_LAS unsigned char* lds, const Gemm g, const StaticOrder& S, const Epi& E) {
    const int tid = threadIdx.x, wid = __builtin_amdgcn_readfirstlane(tid >> 6), lane = tid & 63, wr = wid >> 2, wc = wid & 3, fr = lane & 15, fq = lane >> 4;
    int nt = g.K / BK; asm volatile("" : "+s"(nt));
    unsigned voffA[2], voffB[2];
#pragma unroll
    for (int i = 0; i < 2; ++i) { int R, C; stage_rc(tid * 16 + i * 8192, R, C); const int Rb = (R & ~31) + perm32(R & 31);
        voffA[i] = (unsigned)(R * g.lda + C) * 2u; voffB[i] = (unsigned)(Rb * g.ldb + C) * 2u; }
    const size_t kstep = (size_t)(BK * 2);
    const size_t hstepA = (size_t)HALF * g.lda * 2, hstepB = (size_t)HALF * g.ldb * 2;
    const size_t tstepA = 2 * hstepA, tstepB = 2 * hstepB;
    const unsigned ldsw = (unsigned)wid * 1024u;
    const int aoff = lds_byte(wr * 64 + fr, fq * 8), boff = lds_byte(wc * 32 + fr, fq * 8);
#define PG8_SA(b, h) (((b) * 2 + (h)) * HTB)
#define PG8_SB(b, h) ((4 + (b) * 2 + (h)) * HTB)
#define PG8_STAGE(bufoff, gbase, voff) do { _Pragma("unroll") for (int _i = 0; _i < 2; ++_i) \
        __builtin_amdgcn_global_load_lds((const unsigned*)((const char*)(gbase) + (voff)[_i]), (PG8_LAS unsigned*)(lds + (bufoff) + ldsw + _i * 8192), 16, 0, 0); } while (0)
#define PG8_LDA(dst, b, h) do { _Pragma("unroll") for (int m = 0; m < 4; ++m) _Pragma("unroll") for (int k = 0; k < 2; ++k) dst[m][k] = *(const PG8_LAS bf16x8*)(lds + PG8_SA(b, h) + aoff + m * 2048 + k * 1024); } while (0)
#define PG8_LDB(dst, b, h) do { _Pragma("unroll") for (int n = 0; n < 2; ++n) _Pragma("unroll") for (int k = 0; k < 2; ++k) dst[n][k] = *(const PG8_LAS bf16x8*)(lds + PG8_SB(b, h) + boff + n * 2048 + k * 1024); } while (0)
#define PG8_MMA(ai, bj, At, Bt) do { __builtin_amdgcn_s_setprio(1); _Pragma("unroll") for (int m = 0; m < 4; ++m) _Pragma("unroll") for (int n = 0; n < 2; ++n) _Pragma("unroll") for (int k = 0; k < 2; ++k) \
        acc[ai][bj][m][n] = __builtin_amdgcn_mfma_f32_16x16x32_bf16(Bt[n][k], At[m][k], acc[ai][bj][m][n], 0, 0, 0); __builtin_amdgcn_s_setprio(0); } while (0)
#define PG8_WAIT_V(n) asm volatile("s_waitcnt vmcnt(" #n ")" ::: "memory")
#define PG8_WAIT_L(n) asm volatile("s_waitcnt lgkmcnt(" #n ")" ::: "memory")
#define PG8_BAR __builtin_amdgcn_s_barrier()
#define PG8_SCHED __builtin_amdgcn_sched_barrier(0)
    Unit cur, nxt; int ui = 0;
    if (!S.next(0, cur)) return;
    f32x4 acc[2][2][4][2];
#pragma unroll
    for (int a = 0; a < 2; ++a)
#pragma unroll
        for (int b = 0; b < 2; ++b)
#pragma unroll
            for (int m = 0; m < 4; ++m)
#pragma unroll
                for (int n = 0; n < 2; ++n) acc[a][b][m][n] = (f32x4){0.f, 0.f, 0.f, 0.f};
    bf16x8 At[4][2], B0[2][2], B1[2][2];
    const char* cA = (const char*)g.A + (size_t)cur.pm * tstepA + (size_t)((cur.pn >> g.ash) * g.amul) * 2; const char* cB = (const char*)g.Bt + (size_t)cur.pn * tstepB;
    PG8_STAGE(PG8_SB(0, 0), cB, voffB); PG8_STAGE(PG8_SB(0, 1), cB + hstepB, voffB); PG8_STAGE(PG8_SA(0, 0), cA, voffA); PG8_STAGE(PG8_SA(0, 1), cA + hstepA, voffA);
    if (wr == 1) PG8_BAR;
    PG8_WAIT_V(2); PG8_BAR;
    PG8_STAGE(PG8_SB(1, 0), cB + kstep, voffB); PG8_STAGE(PG8_SA(1, 0), cA + kstep, voffA); PG8_STAGE(PG8_SB(1, 1), cB + hstepB + kstep, voffB);
    PG8_WAIT_V(6); PG8_BAR;
    for (;;) {
        const bool has_next = S.next(ui + 1, nxt);
        const char* nA = has_next ? (const char*)g.A + (size_t)nxt.pm * tstepA + (size_t)((nxt.pn >> g.ash) * g.amul) * 2 : cA; const char* nB = has_next ? (const char*)g.Bt + (size_t)nxt.pn * tstepB : cB;
        for (int t = 0; t < nt; t += 2) {
            const bool last = (t == nt - 2);
            if constexpr (MID_T >= 0) { if (t == MID_T) E.mid(acc, cur, wr, wc, fr, fq); }
            const char* a1 = cA + (size_t)(t + 1) * kstep;
            const char* a2 = last ? nA : cA + (size_t)(t + 2) * kstep; const char* b2 = last ? nB : cB + (size_t)(t + 2) * kstep;
            const char* a3 = a2 + kstep; const char* b3 = b2 + kstep;
            PG8_LDB(B0, 0, 0); PG8_LDB(B1, 0, 1); PG8_SCHED; PG8_LDA(At, 0, 0); PG8_STAGE(PG8_SA(1, 1), a1 + hstepA, voffA);
            PG8_WAIT_V(8); PG8_WAIT_L(0); PG8_BAR; PG8_MMA(0, 0, At, B0); PG8_MMA(0, 1, At, B1); PG8_BAR; PG8_SCHED;
            PG8_LDA(At, 0, 1); PG8_STAGE(PG8_SB(0, 0), b2, voffB); PG8_STAGE(PG8_SB(0, 1), b2 + hstepB, voffB); PG8_STAGE(PG8_SA(0, 0), a2, voffA);
            PG8_WAIT_V(8); PG8_WAIT_L(0); PG8_BAR; PG8_MMA(1, 0, At, B0); PG8_MMA(1, 1, At, B1); PG8_BAR; PG8_SCHED;
            PG8_LDB(B0, 1, 0); PG8_LDB(B1, 1, 1); PG8_SCHED; PG8_LDA(At, 1, 0); PG8_STAGE(PG8_SA(0, 1), a2 + hstepA, voffA);
            PG8_WAIT_V(8); PG8_WAIT_L(0); PG8_BAR; PG8_MMA(0, 0, At, B0); PG8_MMA(0, 1, At, B1); PG8_BAR; PG8_SCHED;
            PG8_LDA(At, 1, 1); PG8_STAGE(PG8_SB(1, 0), b3, voffB); PG8_STAGE(PG8_SB(1, 1), b3 + hstepB, voffB); PG8_STAGE(PG8_SA(1, 0), a3, voffA);
            PG8_WAIT_V(8); PG8_WAIT_L(0); PG8_BAR; PG8_MMA(1, 0, At, B0); PG8_MMA(1, 1, At, B1); PG8_BAR; PG8_SCHED;
        }
        if constexpr (ALIGN_EPI) { if (wr == 0) PG8_BAR; }
        E.template run<2>(acc, cur, wr, wc, fr, fq);
        if (!has_next) break;
#pragma unroll
        for (int a = 0; a < 2; ++a)
#pragma unroll
            for (int b = 0; b < 2; ++b)
#pragma unroll
                for (int m = 0; m < 4; ++m)
#pragma unroll
                    for (int n = 0; n < 2; ++n) acc[a][b][m][n] = (f32x4){0.f, 0.f, 0.f, 0.f};
        cur = nxt; cA = nA; cB = nB; ++ui;
        if constexpr (ALIGN_EPI) { if (wr == 1) PG8_BAR; }
    }
    PG8_WAIT_V(0);
    if constexpr (!ALIGN_EPI) { if (wr == 0) PG8_BAR; }
    PG8_BAR;
#undef PG8_SA
#undef PG8_SB
#undef PG8_STAGE
#undef PG8_LDA
#undef PG8_LDB
#undef PG8_MMA
#undef PG8_WAIT_V
#undef PG8_WAIT_L
#undef PG8_BAR
#undef PG8_SCHED
}

template <class Epi>
__device__ __forceinline__ void gemm_half(PG8_LAS unsigned char* lds, const Gemm g, const Unit u, const Epi& E) {
    const int tid = threadIdx.x, wid = __builtin_amdgcn_readfirstlane(tid >> 6), lane = tid & 63, wr = wid >> 2, wc = wid & 3, fr = lane & 15, fq = lane >> 4;
    int nt = g.K / BK; asm volatile("" : "+s"(nt));
    unsigned voffA[2], voffB[2];
#pragma unroll
    for (int i = 0; i < 2; ++i) { int R, C; stage_rc(tid * 16 + i * 8192, R, C); const int Rb = (R & ~31) + perm32(R & 31);
        voffA[i] = (unsigned)(R * g.lda + C) * 2u; voffB[i] = (unsigned)(Rb * g.ldb + C) * 2u; }
    const size_t kstep = (size_t)(BK * 2);
    const size_t hstepA = (size_t)HALF * g.lda * 2, hstepB = (size_t)HALF * g.ldb * 2;
    const unsigned ldsw = (unsigned)wid * 1024u;
    const int aoff = lds_byte(wr * 64 + fr, fq * 8), boff = lds_byte(wc * 32 + fr, fq * 8);
#define PG8_SA(b, h) (((b) * 2 + (h)) * HTB)
#define PG8_SB(b, h) ((4 + (b) * 2 + (h)) * HTB)
#define PG8_STAGE(bufoff, gbase, voff) do { _Pragma("unroll") for (int _i = 0; _i < 2; ++_i) \
        __builtin_amdgcn_global_load_lds((const unsigned*)((const char*)(gbase) + (voff)[_i]), (PG8_LAS unsigned*)(lds + (bufoff) + ldsw + _i * 8192), 16, 0, 0); } while (0)
#define PG8_LDA(dst, b, h) do { _Pragma("unroll") for (int m = 0; m < 4; ++m) _Pragma("unroll") for (int k = 0; k < 2; ++k) dst[m][k] = *(const PG8_LAS bf16x8*)(lds + PG8_SA(b, h) + aoff + m * 2048 + k * 1024); } while (0)
#define PG8_LDB(dst, b, h) do { _Pragma("unroll") for (int n = 0; n < 2; ++n) _Pragma("unroll") for (int k = 0; k < 2; ++k) dst[n][k] = *(const PG8_LAS bf16x8*)(lds + PG8_SB(b, h) + boff + n * 2048 + k * 1024); } while (0)
#define PG8_MMA(ai, bj, At, Bt) do { __builtin_amdgcn_s_setprio(1); _Pragma("unroll") for (int m = 0; m < 4; ++m) _Pragma("unroll") for (int n = 0; n < 2; ++n) _Pragma("unroll") for (int k = 0; k < 2; ++k) \
        acc[ai][bj][m][n] = __builtin_amdgcn_mfma_f32_16x16x32_bf16(Bt[n][k], At[m][k], acc[ai][bj][m][n], 0, 0, 0); __builtin_amdgcn_s_setprio(0); } while (0)
#define PG8_WAIT_V(n) asm volatile("s_waitcnt vmcnt(" #n ")" ::: "memory")
#define PG8_WAIT_L(n) asm volatile("s_waitcnt lgkmcnt(" #n ")" ::: "memory")
#define PG8_BAR __builtin_amdgcn_s_barrier()
#define PG8_SCHED __builtin_amdgcn_sched_barrier(0)
    f32x4 acc[2][2][4][2];
#pragma unroll
    for (int a = 0; a < 2; ++a)
#pragma unroll
        for (int b = 0; b < 2; ++b)
#pragma unroll
            for (int m = 0; m < 4; ++m)
#pragma unroll
                for (int n = 0; n < 2; ++n) acc[a][b][m][n] = (f32x4){0.f, 0.f, 0.f, 0.f};
    bf16x8 At[4][2], B0[2][2], B1[2][2];
    const char* cA = (const char*)g.A + ((size_t)u.pm * BM + u.rh) * g.lda * 2 + (size_t)((u.pn >> g.ash) * g.amul) * 2; const char* cB = (const char*)g.Bt + (size_t)u.pn * 2 * hstepB;
    PG8_STAGE(PG8_SB(0, 0), cB, voffB); PG8_STAGE(PG8_SB(0, 1), cB + hstepB, voffB); PG8_STAGE(PG8_SA(0, 0), cA, voffA);
    PG8_STAGE(PG8_SB(1, 0), cB + kstep, voffB); PG8_STAGE(PG8_SB(1, 1), cB + hstepB + kstep, voffB); PG8_STAGE(PG8_SA(1, 0), cA + kstep, voffA);
    PG8_WAIT_V(6); PG8_BAR;
#define PG8_HALF_STEP(b, tt) do { \
        PG8_LDB(B0, b, 0); PG8_LDB(B1, b, 1); PG8_LDA(At, b, 0); PG8_WAIT_L(0); PG8_BAR; PG8_SCHED; \
        const bool more_ = (tt) + 2 < nt; \
        if (more_) { const char* b2 = cB + (size_t)((tt) + 2) * kstep; const char* a2 = cA + (size_t)((tt) + 2) * kstep; \
            PG8_STAGE(PG8_SB(b, 0), b2, voffB); PG8_STAGE(PG8_SB(b, 1), b2 + hstepB, voffB); PG8_STAGE(PG8_SA(b, 0), a2, voffA); } \
        PG8_MMA(0, 0, At, B0); PG8_MMA(0, 1, At, B1); \
        if (more_) PG8_WAIT_V(6); else PG8_WAIT_V(0); \
        PG8_BAR; PG8_SCHED; } while (0)
    for (int t = 0; t < nt; t += 2) { PG8_HALF_STEP(0, t); PG8_HALF_STEP(1, t + 1); }
    E.template run<1>(acc, u, wr, wc, fr, fq);
    PG8_BAR;
#undef PG8_HALF_STEP
#undef PG8_SA
#undef PG8_SB
#undef PG8_STAGE
#undef PG8_LDA
#undef PG8_LDB
#undef PG8_MMA
#undef PG8_WAIT_V
#undef PG8_WAIT_L
#undef PG8_BAR
#undef PG8_SCHED
}
}

constexpr int NWAVES = 8, NTHR = 512;
constexpr int M = 16384, SEQ = 4096, NB = 4, D = 1024, DPOOL = 512, DRNN = 1024, DIN = 4608, DFF = 2816;
constexpr float EPS = 1e-6f;
constexpr int NPH = 11;
constexpr int SCAN_T = 128, SCAN_NC = SEQ / SCAN_T;

constexpr size_t MiB = 1u << 20;
constexpr size_t WS_SP8 = 512 * 1024;
constexpr size_t WS_RSI = 576 * 1024;
constexpr size_t WS_SSQ = 1 * MiB;
constexpr size_t WS_SSQ2 = 2 * MiB;
constexpr size_t WS_CS = 2 * MiB, WS_CH = 3 * MiB;
constexpr size_t WS_WIN = 4 * MiB;
constexpr size_t WS_WFI = 13 * MiB;
constexpr size_t WS_WFO = 24 * MiB;
constexpr size_t WS_WCAT = WS_WFO + 5632 * 1024;
constexpr size_t WS_WO = WS_WCAT + 3 * MiB;
constexpr size_t WS_WGRP = WS_WO + 2 * MiB;
constexpr size_t WS_WGATE = WS_WGRP + MiB / 4;
constexpr size_t WS_R1 = 36 * MiB;
constexpr size_t WS_R2 = 68 * MiB;
constexpr size_t WS_R3 = 84 * MiB;
constexpr size_t WS_R4 = 116 * MiB;
constexpr size_t WS_R7 = 148 * MiB;
constexpr size_t WS_R8 = 164 * MiB;
constexpr size_t WS_CAT = 196 * MiB;
constexpr size_t WS_MIXB = 148 * MiB;
constexpr size_t WS_ACT = 68 * MiB;
constexpr size_t WS_END = 244 * MiB;

constexpr int LDS_BYTES = 147456;

#define LAS __attribute__((address_space(3)))
typedef unsigned short bf16;
typedef unsigned v4u __attribute__((ext_vector_type(4)));
typedef unsigned v2u __attribute__((ext_vector_type(2)));
typedef float f32x4 __attribute__((ext_vector_type(4)));
typedef float f32x2 __attribute__((ext_vector_type(2)));
#define LDS_WAIT() asm volatile("s_waitcnt lgkmcnt(0)" ::: "memory")
using pg8::cvt_pk_bf16; using pg8::bf_lo; using pg8::bf_hi;

struct Args { const float* in[19]; float* out; unsigned char* ws; int ph_lo, ph_hi; };
enum { I_X = 0, I_NORM_MIX, I_W_IN, I_W_GRP, I_POOL_SCALE, I_W_POOL_OUT, I_CONV_W, I_CONV_B, I_W_RG_A, I_B_RG_A, I_W_RG_X, I_B_RG_X, I_LAMBDA, I_W_RNN_OUT, I_W_O, I_NORM_FFN, I_W_FFN_IN, I_W_FFN_OUT, I_NORM_FINAL };

__device__ __forceinline__ float wave_sum(float v) {
#pragma unroll
    for (int o = 1; o < 64; o <<= 1) v += __shfl_xor(v, o);
    return v;
}

__device__ __forceinline__ void transpose_item(const float* W, int Nsrc, int Kdst, bf16* WT, int k0, int n_src0, int n_dst0, const float* kscale, LAS float* scr, int lane) {
    f32x4 v[8]; const int n4 = (lane & 7) * 4;
#pragma unroll
    for (int i = 0; i < 8; ++i) { const int kk = 8 * i + (lane >> 3); v[i] = *(const f32x4*)(W + (size_t)(k0 + kk) * Nsrc + n_src0 + n4); }
    if (kscale) {
#pragma unroll
        for (int i = 0; i < 8; ++i) v[i] = v[i] * kscale[k0 + 8 * i + (lane >> 3)]; }
#pragma unroll
    for (int i = 0; i < 8; ++i) { const int kk = 8 * i + (lane >> 3);
#pragma unroll
        for (int j = 0; j < 4; ++j) scr[kk * 33 + n4 + j] = v[i][j]; }
    LDS_WAIT(); asm volatile("" ::: "memory");
    const int c = lane & 7;
#pragma unroll
    for (int j = 0; j < 4; ++j) { const int n = (lane >> 3) + 8 * j; const LAS float* s = scr + (8 * c) * 33 + n;
        v4u o; o.x = cvt_pk_bf16(s[0 * 33], s[1 * 33]); o.y = cvt_pk_bf16(s[2 * 33], s[3 * 33]); o.z = cvt_pk_bf16(s[4 * 33], s[5 * 33]); o.w = cvt_pk_bf16(s[6 * 33], s[7 * 33]);
        *(v4u*)(WT + (size_t)(n_dst0 + n) * Kdst + k0 + 8 * c) = o; }
    LDS_WAIT(); asm volatile("" ::: "memory");
}

#define XB_TMO      128
#define XB_XCNT(j)  (256  + 64 * (j))
#define XB_XSUB(j)  (1280 + 64 * (j))
#define XB_XGEN(j)  (2304 + 64 * (j))
#define XB_TOP      3328
#define XB_TOPGEN   3392
#define XCD_BAR_WORDS 3456
#define XB_SPIN_CAP (1u << 18)
__device__ __forceinline__ unsigned xb_ld(unsigned* p)              { return __hip_atomic_load(p, __ATOMIC_RELAXED, __HIP_MEMORY_SCOPE_AGENT); }
__device__ __forceinline__ unsigned xb_add(unsigned* p, unsigned v) { return __hip_atomic_fetch_add(p, v, __ATOMIC_RELAXED, __HIP_MEMORY_SCOPE_AGENT); }
__device__ __forceinline__ unsigned xb_xcc_id() { return (unsigned)__builtin_amdgcn_s_getreg((3 << 11) | 20) & 0xFu; }
#define XB_SPIN(cond, bar) do { unsigned _sp = 0; while (cond) { __builtin_amdgcn_s_sleep(1); \
    if ((++_sp & 255u) == 0u) { if (xb_ld(&(bar)[XB_TMO])) break; if (_sp > XB_SPIN_CAP) { atomicAdd(&(bar)[XB_TMO], 1u); break; } } } } while (0)
struct XcdBarrier { unsigned* bar; unsigned x; volatile LAS unsigned* st; };
__device__ __forceinline__ XcdBarrier xcd_barrier_post(unsigned* bar, volatile LAS unsigned* st) {
    XcdBarrier b; b.bar = bar; b.x = xb_xcc_id(); b.st = st;
    if (threadIdx.x == 0) (void)xb_add(&bar[XB_XCNT(b.x)], 1u);
    return b;
}
__device__ __forceinline__ void xcd_barrier_complete(unsigned* bar, unsigned x, unsigned& nloc, unsigned& nx) {
    const unsigned G = gridDim.x * gridDim.y * gridDim.z;
    unsigned sum, cnt, mine, sp = 0u;
    for (;;) {
        sum = 0u; cnt = 0u; mine = 0u;
#pragma unroll
        for (unsigned j = 0; j < 16; ++j) { const unsigned c = xb_ld(&bar[XB_XCNT(j)]); sum += c; cnt += (c > 0u) ? 1u : 0u; mine = (j == x) ? c : mine; }
        if (sum == G) break;
        __builtin_amdgcn_s_sleep(1);
        if ((++sp & 255u) == 0u) { if (xb_ld(&bar[XB_TMO])) break; if (sp > XB_SPIN_CAP) { atomicAdd(&bar[XB_TMO], 1u); break; } }
    }
    nloc = mine > 0u ? mine : 1u; nx = cnt > 0u ? cnt : 1u;
}
__device__ __forceinline__ void xcd_barrier(const XcdBarrier& b) {
    asm volatile("s_waitcnt vmcnt(0)" ::: "memory");
    __syncthreads();
    if (threadIdx.x == 0) {
        unsigned* bar = b.bar;
        __builtin_amdgcn_s_waitcnt(0);
        unsigned nloc = b.st[0], nx = b.st[1];
        if (nloc == 0u) { xcd_barrier_complete(bar, b.x, nloc, nx); b.st[0] = nloc; b.st[1] = nx; }
        const unsigned old = xb_add(&bar[XB_XSUB(b.x)], 1u);
        const unsigned gen = old / nloc;
        if (old + 1u == (gen + 1u) * nloc) {
            __builtin_amdgcn_fence(__ATOMIC_RELEASE, "agent");
            asm volatile("s_waitcnt vmcnt(0)" ::: "memory");
            const unsigned og = xb_add(&bar[XB_TOP], 1u);
            const unsigned tg = og / nx;
            if (og + 1u == (tg + 1u) * nx) xb_add(&bar[XB_TOPGEN], 1u);
            else XB_SPIN(xb_ld(&bar[XB_TOPGEN]) == tg, bar);
            __builtin_amdgcn_fence(__ATOMIC_ACQUIRE, "agent");
            xb_add(&bar[XB_XGEN(b.x)], 1u);
            asm volatile("s_waitcnt vmcnt(0)" ::: "memory");
        } else {
            XB_SPIN(xb_ld(&bar[XB_XGEN(b.x)]) == gen, bar);
            __builtin_amdgcn_fence(__ATOMIC_ACQUIRE, "agent");
            asm volatile("s_waitcnt vmcnt(0)" ::: "memory");
        }
    }
    __syncthreads();
}

template <int W>
__device__ __forceinline__ void pool_item(const bf16* src, bf16* dst, int tl) {
    v4u rw[W + 7];
#pragma unroll
    for (int k = 0; k < W + 7; ++k) rw[k] = (tl + k - (W - 1) >= 0) ? *(const v4u*)(src + (ptrdiff_t)(k - (W - 1)) * DPOOL) : (v4u){0u, 0u, 0u, 0u};
    f32x4 s0 = {0.f, 0.f, 0.f, 0.f}, s1 = s0;
#pragma unroll
    for (int k = 0; k < W - 1; ++k) { f32x4 a, c; pg8::unpack8(rw[k], a, c); s0 += a; s1 += c; }
#pragma unroll
    for (int i = 0; i < 8; ++i) { f32x4 a, c; pg8::unpack8(rw[W - 1 + i], a, c); s0 += a; s1 += c;
        const int t = tl + i; const int cnt = (t + 1 < W) ? t + 1 : W; const float inv = 1.0f / (float)cnt;
        *(v4u*)(dst + (size_t)i * DPOOL) = pg8::pack8(s0 * inv - a, s1 * inv - c);
        f32x4 a2, c2; pg8::unpack8(rw[i], a2, c2); s0 -= a2; s1 -= c2; }
}
__device__ __forceinline__ void scan_local16(const bf16* lap, const bf16* bbp, f32x4 (&S)[2], f32x4 (&H)[2]) {
    S[0] = S[1] = H[0] = H[1] = (f32x4){0.f, 0.f, 0.f, 0.f};
#pragma unroll
    for (int i0 = 0; i0 < 16; i0 += 8) { v4u lw[8], bw[8];
#pragma unroll
        for (int i = 0; i < 8; ++i) { lw[i] = *(const v4u*)(lap + (size_t)(i0 + i) * DRNN); bw[i] = *(const v4u*)(bbp + (size_t)(i0 + i) * DRNN); }
#pragma unroll
        for (int i = 0; i < 8; ++i) { f32x4 l[2], bq[2]; pg8::unpack8(lw[i], l[0], l[1]); pg8::unpack8(bw[i], bq[0], bq[1]);
#pragma unroll
            for (int n = 0; n < 2; ++n)
#pragma unroll
                for (int j = 0; j < 4; ++j) { H[n][j] = __expf(l[n][j]) * H[n][j] + bq[n][j]; S[n][j] += l[n][j]; } } }
}

__global__ void __launch_bounds__(NTHR, 2) fwd_kernel(Args args) {
    extern __shared__ __attribute__((aligned(16))) unsigned char lds_raw[];
    LAS unsigned char* lds = (LAS unsigned char*)lds_raw;
    const int tid = threadIdx.x, lane = tid & 63, wave = __builtin_amdgcn_readfirstlane(tid >> 6);
    const int G = gridDim.x, bx = blockIdx.x;
    unsigned char* ws = args.ws;
    const int lo = args.ph_lo, hi = args.ph_hi;
#ifndef PHASE_MASK
#define PHASE_MASK 0x7ff
#endif
#define IN(k) (((PHASE_MASK >> (k)) & 1) && lo <= (k) && (k) < hi)
#ifndef REPEAT_MASK
#define REPEAT_MASK 0
#endif
#define REPS(k) (((REPEAT_MASK >> (k)) & 1) ? 2 : 1)
#ifndef PROBE_PHASE
#define PROBE_PHASE -1
#endif
#define PROBE_MULT 4
    unsigned long long tp0 = 0, tp1 = 0;
#define TSTART(k) do { if ((k) == PROBE_PHASE) tp0 = __builtin_amdgcn_s_memrealtime(); } while (0)
#define TEND(k) do { if ((k) == PROBE_PHASE) tp1 = __builtin_amdgcn_s_memrealtime(); } while (0)
#define GSYNC() xcd_barrier(bar)
#define SEAM(k) do { if (IN(k) && IN((k) + 1)) { GSYNC(); } } while (0)

    const float* x = args.in[I_X];
    bf16* WIN = (bf16*)(ws + WS_WIN); bf16* WFI = (bf16*)(ws + WS_WFI); bf16* WFO = (bf16*)(ws + WS_WFO); bf16* WCAT = (bf16*)(ws + WS_WCAT);
    bf16* WO = (bf16*)(ws + WS_WO); bf16* WGRP = (bf16*)(ws + WS_WGRP); bf16* WGATE = (bf16*)(ws + WS_WGATE);
    bf16* XN = (bf16*)(ws + WS_R1); bf16* X1B = XN;
    bf16* CAT = (bf16*)(ws + WS_CAT); bf16* V = CAT + 512;
    bf16* UP = (bf16*)(ws + WS_R2);
    bf16* UR = (bf16*)(ws + WS_R3); bf16* LA = UR;
    bf16* UG = (bf16*)(ws + WS_R4);
    bf16* POOLED = (bf16*)(ws + WS_R7); bf16* BB = (bf16*)(ws + WS_R8);
    bf16* MIXB = (bf16*)(ws + WS_MIXB); bf16* ACT = (bf16*)(ws + WS_ACT);
    float* SSQ = (float*)(ws + WS_SSQ); float* CS = (float*)(ws + WS_CS); float* CH = (float*)(ws + WS_CH);
    bf16* G0 = (bf16*)args.out; bf16* G1 = G0 + (size_t)M * 1024;
    float* X1 = args.out;

#ifndef EXTRA_SYNCS
#define EXTRA_SYNCS 0
#endif
    if (PROBE_PHASE == 99) tp0 = __builtin_amdgcn_s_memrealtime();
    volatile LAS unsigned* MISC = (volatile LAS unsigned*)(lds + 131072 + 1024);
    if (tid < 32) MISC[tid] = 0u;
    __syncthreads();
    XcdBarrier bar = xcd_barrier_post((unsigned*)ws, MISC + 8);
    if (lo < 0) cg::this_grid().sync();
    for (int i = 0; i < EXTRA_SYNCS; ++i) GSYNC();
    TSTART(0);
    if (IN(0)) for (int rep = 0; rep < REPS(0); ++rep) { if (rep) GSYNC();
        LAS float* scr = (LAS float*)(lds + wave * 16384);
        const int gw = bx * NWAVES + wave, NGW = G * NWAVES;
        constexpr int I_IN = 16 * (DIN / 32), I_FI = 16 * (2 * DFF / 32), I_FO = (DFF / 64) * (D / 32), I_RO = 16 * 32, I_WO = 16 * 32, I_PO = 8 * 32;
        constexpr int NITEMS = I_IN + I_FI + I_FO + I_RO + I_WO + I_PO;
        for (int it = gw; it < NITEMS; it += NGW) {
            int r = it;
            if (r < I_IN) { const int nblk = DIN / 32, kb = r / nblk, nb = r % nblk, nd = 32 * nb; int ns = nd;
                if (nd >= 2560) { const int q = nd - 2560, pq = q >> 8, j0 = q & 255; ns = 2560 + (j0 < 128 ? 128 * pq + j0 : 1024 + 128 * pq + (j0 - 128)); }
                transpose_item(args.in[I_W_IN], DIN, D, WIN, 64 * kb, ns, nd, args.in[I_NORM_MIX], scr, lane); continue; } r -= I_IN;
            if (r < I_FI) { const int nblk = 2 * DFF / 32, kb = r / nblk, nb = r % nblk, nd = 32 * nb, pn = nd >> 8, j0 = nd & 255;
                const int ns = j0 < 128 ? 128 * pn + j0 : DFF + 128 * pn + (j0 - 128);
                transpose_item(args.in[I_W_FFN_IN], 2 * DFF, D, WFI, 64 * kb, ns, nd, args.in[I_NORM_FFN], scr, lane); continue; } r -= I_FI;
            if (r < I_FO) { if (G != 256) { const int nblk = D / 32, kb = r / nblk, nb = r % nblk; transpose_item(args.in[I_W_FFN_OUT], D, DFF, WFO, 64 * kb, 32 * nb, 32 * nb, nullptr, scr, lane); } continue; } r -= I_FO;
            if (r < I_RO) { const int nblk = D / 32, kb = r / nblk, nb = r % nblk; transpose_item(args.in[I_W_RNN_OUT], D, 1536, WCAT + 512, 64 * kb, 32 * nb, 32 * nb, nullptr, scr, lane); continue; } r -= I_RO;
            if (r < I_WO) { const int nblk = D / 32, kb = r / nblk, nb = r % nblk; transpose_item(args.in[I_W_O], D, D, WO, 64 * kb, 32 * nb, 32 * nb, nullptr, scr, lane); continue; } r -= I_WO;
            { const int nblk = D / 32, kb = r / nblk, nb = r % nblk; transpose_item(args.in[I_W_POOL_OUT], D, 1536, WCAT, 64 * kb, 32 * nb, 32 * nb, nullptr, scr, lane); }
        }
        {
            const int gt = bx * NTHR + tid, NT = G * NTHR;
            const float* wg = args.in[I_W_GRP];
            for (int e = gt; e < 512 * 32; e += NT) { const int n = e >> 5, kc = (e & 31) * 8, g = n >> 7, nn = n & 127; float v[8];
#pragma unroll
                for (int j = 0; j < 8; ++j) { const int kk = kc + j - (g & 1) * 128; v[j] = (kk >= 0 && kk < 128) ? wg[((size_t)g * 128 + kk) * 128 + nn] : 0.f; }
                v4u o; o.x = cvt_pk_bf16(v[0], v[1]); o.y = cvt_pk_bf16(v[2], v[3]); o.z = cvt_pk_bf16(v[4], v[5]); o.w = cvt_pk_bf16(v[6], v[7]);
                *(v4u*)(WGRP + (size_t)n * 256 + kc) = o; }
            const float* wa = args.in[I_W_RG_A]; const float* wx = args.in[I_W_RG_X];
            for (int e = gt; e < 2048 * 16; e += NT) { const int n = e >> 4, kc = (e & 15) * 8, h = n >> 8, j = n & 255; const float* src = j < 128 ? wa : wx; const int jj = j & 127; float v[8];
#pragma unroll
                for (int q = 0; q < 8; ++q) v[q] = src[((size_t)h * 128 + kc + q) * 128 + jj];
                v4u o; o.x = cvt_pk_bf16(v[0], v[1]); o.y = cvt_pk_bf16(v[2], v[3]); o.z = cvt_pk_bf16(v[4], v[5]); o.w = cvt_pk_bf16(v[6], v[7]);
                *(v4u*)(WGATE + (size_t)n * 128 + kc) = o; }
        }
        { const int gt = bx * NTHR + tid; if (gt < DRNN) { const float z = -args.in[I_LAMBDA][gt]; ((float*)(ws + WS_SP8))[gt] = -8.0f * (fmaxf(z, 0.f) + log1pf(expf(-fabsf(z)))); } }
        float* RSI = (float*)(ws + WS_RSI);
        for (int m = gw; m < M; m += 2 * NGW) {
            const int m1 = (m + NGW < M) ? m + NGW : m;
            const f32x4* xr0 = (const f32x4*)(x + (size_t)m * D) + lane; const f32x4* xr1 = (const f32x4*)(x + (size_t)m1 * D) + lane; f32x4 v0[4], v1[4]; float s0 = 0.f, s1 = 0.f;
#pragma unroll
            for (int j = 0; j < 4; ++j) { v0[j] = xr0[64 * j]; v1[j] = xr1[64 * j]; }
#pragma unroll
            for (int j = 0; j < 4; ++j) { s0 += (v0[j].x * v0[j].x + v0[j].y * v0[j].y) + (v0[j].z * v0[j].z + v0[j].w * v0[j].w); s1 += (v1[j].x * v1[j].x + v1[j].y * v1[j].y) + (v1[j].z * v1[j].z + v1[j].w * v1[j].w); }
            const float q0 = sqrtf(wave_sum(s0) * (1.f / D) + EPS), q1 = sqrtf(wave_sum(s1) * (1.f / D) + EPS), rs0 = 1.0f / q0, rs1 = 1.0f / q1;
            if (lane == 0) { RSI[m] = q0; RSI[m1] = q1; }
            v2u* o0 = (v2u*)(XN + (size_t)m * D) + lane; v2u* o1 = (v2u*)(XN + (size_t)m1 * D) + lane;
#pragma unroll
            for (int j = 0; j < 4; ++j) { const f32x4 y0 = v0[j] * rs0, y1 = v1[j] * rs1; v2u w0, w1; w0.x = cvt_pk_bf16(y0.x, y0.y); w0.y = cvt_pk_bf16(y0.z, y0.w); w1.x = cvt_pk_bf16(y1.x, y1.y); w1.y = cvt_pk_bf16(y1.z, y1.w); o0[64 * j] = w0; o1[64 * j] = w1; }
        }
        __syncthreads();
    }
    SEAM(0);
    TEND(0);

    TSTART(1);
    if (IN(1)) for (int rep = 0; rep < REPS(1); ++rep) { if (rep) GSYNC();
        pg8::Gemm g{XN, WIN, M, 4096, D, D, D, 0, 0}; pg8::StaticOrder S; S.init(M, 4096, G, bx);
        pg8::EpiProj E{UP, UR, UG, G0, G1, 0};
        pg8::gemm_phase<pg8::EpiProj, true>(lds, g, S, E);
    }
    SEAM(1);
    TEND(1);

    TSTART(2);
    if (IN(2)) for (int rep = 0; rep < REPS(2); ++rep) { if (rep) GSYNC();
        { const int gw = bx * NWAVES + wave, NGW = G * NWAVES;
          for (int wi = gw; wi < (M / 32) * 4; wi += NGW) { const int g = wi & 3, t0 = (wi >> 2) * 32 + (lane >> 4) * 8, co = g * 16 + (lane & 15);
              const bf16* src = UP + (size_t)t0 * DPOOL + co * 8; bf16* dst = POOLED + (size_t)t0 * DPOOL + co * 8; const int tl = t0 & (SEQ - 1);
              if (g == 0) pool_item<2>(src, dst, tl); else if (g == 1) pool_item<4>(src, dst, tl); else if (g == 2) pool_item<8>(src, dst, tl); else pool_item<16>(src, dst, tl); } }
        { const int gt = bx * NTHR + tid, NT = G * NTHR;
          for (int it = gt; it < (M / 8) * 128; it += NT) { const int co = it & 127, t0 = (it >> 7) * 8, tl = t0 & (SEQ - 1);
              const bf16* src = UR + (size_t)t0 * DRNN + co * 8; bf16* dst = V + (size_t)t0 * 1536 + co * 8;
              const float* cw = args.in[I_CONV_W] + co * 8; const float* cb = args.in[I_CONV_B] + co * 8;
              v4u rw[11];
#pragma unroll
              for (int k = 0; k < 11; ++k) rw[k] = (k >= 3 || tl != 0) ? *(const v4u*)(src + (ptrdiff_t)(k - 3) * DRNN) : (v4u){0u, 0u, 0u, 0u};
              f32x4 w0[2], w1[2], w2[2], w3[2], bb[2];
#pragma unroll
              for (int n = 0; n < 2; ++n) { w0[n] = *(const f32x4*)(cw + 4 * n); w1[n] = *(const f32x4*)(cw + 1024 + 4 * n); w2[n] = *(const f32x4*)(cw + 2048 + 4 * n); w3[n] = *(const f32x4*)(cw + 3072 + 4 * n); bb[n] = *(const f32x4*)(cb + 4 * n); }
#pragma unroll
              for (int i = 0; i < 8; ++i) { f32x4 a[2], b[2], c[2], d[2]; pg8::unpack8(rw[i], a[0], a[1]); pg8::unpack8(rw[i + 1], b[0], b[1]); pg8::unpack8(rw[i + 2], c[0], c[1]); pg8::unpack8(rw[i + 3], d[0], d[1]);
                  *(v4u*)(dst + (size_t)i * 1536) = pg8::pack8(bb[0] + w0[0] * a[0] + w1[0] * b[0] + w2[0] * c[0] + w3[0] * d[0], bb[1] + w0[1] * a[1] + w1[1] * b[1] + w2[1] * c[1] + w3[1] * d[1]); }
          } }
    }
    SEAM(2);
    TEND(2);

    TSTART(3);
    if (IN(3)) for (int rep = 0; rep < REPS(3); ++rep) { if (rep) GSYNC();
        const bool uneven = (G == 256);
        {
          pg8::Gemm g{XN, WIN + (size_t)4096 * D, M, 512, D, D, D, 0, 0}; pg8::StaticOrder S; S.init(M, 512, G, bx);
          pg8::EpiProj E{UP, UR, UG, G0, G1, 16};
          pg8::gemm_phase<pg8::EpiProj, true>(lds, g, S, E); }
        { pg8::Gemm g{POOLED, WGRP, M, 512, 256, 512, 256, 0, 256}; pg8::StaticOrder S; S.init(M, 512, G, (bx + G / 2) % G);
          pg8::EpiGrp E{CAT, 1536, args.in[I_POOL_SCALE]};
          pg8::gemm_phase<pg8::EpiGrp, true>(lds, g, S, E); }
        { pg8::Gemm g{V, WGATE, M, 2048, 128, 1536, 128, 0, 128}; pg8::StaticOrder S; S.init(M, 2048, G, bx);
          if (uneven) { if (bx < 128) { S.lin_base = bx; S.lin_cnt = 1; } else { S.lin_base = 128 + (bx - 128) * 3; S.lin_cnt = 3; } }
          pg8::EpiGate E{V, LA, BB, args.in[I_B_RG_A], args.in[I_B_RG_X], (const float*)(ws + WS_SP8)};
          pg8::gemm_phase<pg8::EpiGate, true>(lds, g, S, E); }
    }
    SEAM(3);
    TEND(3);

    TSTART(4);
    TEND(4);

    TSTART(5);
    if (IN(5)) for (int rep = 0; rep < REPS(5); ++rep) { if (rep) GSYNC();
        LAS float* PAS = (LAS float*)lds; LAS float* PAH = PAS + 8 * 512; LAS float* PBS = PAH + 8 * 512; LAS float* PBH = PBS + 8 * 512;
        unsigned* flags = (unsigned*)ws + 8192;
        for (int bi = bx; bi < NB * SCAN_NC * 2; bi += G) { const int hh = bi & 1, c = (bi >> 1) % SCAN_NC, b = bi / (2 * SCAN_NC);
            const size_t off = ((size_t)b * SEQ + (size_t)c * SCAN_T + wave * 16) * DRNN + hh * 512 + lane * 8;
            v4u lwk[16], bwk[16];
#pragma unroll
            for (int i = 0; i < 16; ++i) { lwk[i] = *(const v4u*)(LA + off + (size_t)i * DRNN); bwk[i] = *(const v4u*)(BB + off + (size_t)i * DRNN); }
            { f32x4 S[2] = {{0.f, 0.f, 0.f, 0.f}, {0.f, 0.f, 0.f, 0.f}}, H[2] = {{0.f, 0.f, 0.f, 0.f}, {0.f, 0.f, 0.f, 0.f}};
#pragma unroll
              for (int i = 0; i < 16; ++i) { f32x4 l[2], bq[2]; pg8::unpack8(lwk[i], l[0], l[1]); pg8::unpack8(bwk[i], bq[0], bq[1]);
#pragma unroll
                  for (int n = 0; n < 2; ++n)
#pragma unroll
                      for (int j = 0; j < 4; ++j) { H[n][j] = __expf(l[n][j]) * H[n][j] + bq[n][j]; S[n][j] += l[n][j]; } }
              *(LAS f32x4*)(PBS + wave * 512 + lane * 8) = S[0]; *(LAS f32x4*)(PBS + wave * 512 + lane * 8 + 4) = S[1];
              *(LAS f32x4*)(PBH + wave * 512 + lane * 8) = H[0]; *(LAS f32x4*)(PBH + wave * 512 + lane * 8 + 4) = H[1]; }
#pragma unroll
            for (int i = 0; i < 16; ++i) asm volatile("" : "+v"(lwk[i]), "+v"(bwk[i]));
            __syncthreads();
            { float h = 0.f, st = 0.f;
#pragma unroll
              for (int sb = 0; sb < 8; ++sb) { const float sv = PBS[sb * 512 + tid]; h = __expf(sv) * h + PBH[sb * 512 + tid]; st += sv; }
              const size_t co = ((size_t)b * SCAN_NC + c) * DRNN + hh * 512 + tid;
              __hip_atomic_store(CS + co, st, __ATOMIC_RELAXED, __HIP_MEMORY_SCOPE_AGENT); __hip_atomic_store(CH + co, h, __ATOMIC_RELAXED, __HIP_MEMORY_SCOPE_AGENT); }
            asm volatile("s_waitcnt vmcnt(0)" ::: "memory");
            __syncthreads();
            if (tid == 0) __hip_atomic_store(flags + ((b * 2 + hh) * SCAN_NC + c) * 16, 1u, __ATOMIC_RELAXED, __HIP_MEMORY_SCOPE_AGENT);
            { f32x4 S[2] = {{0.f, 0.f, 0.f, 0.f}, {0.f, 0.f, 0.f, 0.f}}, H[2] = {{0.f, 0.f, 0.f, 0.f}, {0.f, 0.f, 0.f, 0.f}};
              if (wave * 4 < c) {
                  for (int q = 0; q < 4; ++q) { const int cc = wave * 4 + q; if (cc < c) { unsigned* f = flags + ((b * 2 + hh) * SCAN_NC + cc) * 16; unsigned sp = 0;
                      while ((unsigned)__builtin_amdgcn_readfirstlane(__hip_atomic_load(f, __ATOMIC_RELAXED, __HIP_MEMORY_SCOPE_AGENT)) == 0u) { __builtin_amdgcn_s_sleep(1); if (++sp > (1u << 20)) break; } } }
                  __builtin_amdgcn_fence(__ATOMIC_ACQUIRE, "agent");
#pragma unroll
                  for (int q0 = 0; q0 < 4; q0 += 2) { f32x4 cs[2][2], ch[2][2];
#pragma unroll
                      for (int q = 0; q < 2; ++q) { const int cc = wave * 4 + q0 + q; const size_t co = ((size_t)b * SCAN_NC + (cc < c ? cc : 0)) * DRNN + hh * 512 + lane * 8;
                          cs[q][0] = *(const f32x4*)(CS + co); cs[q][1] = *(const f32x4*)(CS + co + 4); ch[q][0] = *(const f32x4*)(CH + co); ch[q][1] = *(const f32x4*)(CH + co + 4); }
#pragma unroll
                      for (int q = 0; q < 2; ++q) { if (wave * 4 + q0 + q < c) {
#pragma unroll
                          for (int n = 0; n < 2; ++n)
#pragma unroll
                              for (int j = 0; j < 4; ++j) { H[n][j] = __expf(cs[q][n][j]) * H[n][j] + ch[q][n][j]; S[n][j] += cs[q][n][j]; } } }
                      asm volatile("" ::: "memory"); }
              }
              *(LAS f32x4*)(PAS + wave * 512 + lane * 8) = S[0]; *(LAS f32x4*)(PAS + wave * 512 + lane * 8 + 4) = S[1];
              *(LAS f32x4*)(PAH + wave * 512 + lane * 8) = H[0]; *(LAS f32x4*)(PAH + wave * 512 + lane * 8 + 4) = H[1]; }
            __syncthreads();
            f32x4 h[2] = {{0.f, 0.f, 0.f, 0.f}, {0.f, 0.f, 0.f, 0.f}};
#pragma unroll
            for (int sb = 0; sb < 8; ++sb) {
#pragma unroll
                for (int n = 0; n < 2; ++n) { const f32x4 sv = *(const LAS f32x4*)(PAS + sb * 512 + lane * 8 + 4 * n), hv = *(const LAS f32x4*)(PAH + sb * 512 + lane * 8 + 4 * n);
#pragma unroll
                    for (int j = 0; j < 4; ++j) h[n][j] = __expf(sv[j]) * h[n][j] + hv[j]; } }
            for (int sb = 0; sb < wave; ++sb) {
#pragma unroll
                for (int n = 0; n < 2; ++n) { const f32x4 sv = *(const LAS f32x4*)(PBS + sb * 512 + lane * 8 + 4 * n), hv = *(const LAS f32x4*)(PBH + sb * 512 + lane * 8 + 4 * n);
#pragma unroll
                    for (int j = 0; j < 4; ++j) h[n][j] = __expf(sv[j]) * h[n][j] + hv[j]; } }
            const bf16* ugp = UG + off;
            bf16* hgp = CAT + ((size_t)b * SEQ + (size_t)c * SCAN_T + wave * 16) * 1536 + 512 + hh * 512 + lane * 8;
            v4u gwk[16];
#pragma unroll
            for (int i = 0; i < 16; ++i) gwk[i] = *(const v4u*)(ugp + (size_t)i * DRNN);
#pragma unroll
            for (int i0 = 0; i0 < 16; i0 += 8) { const v4u* gw8 = gwk + i0;
#pragma unroll
                for (int i = 0; i < 8; ++i) { f32x4 l[2], bq[2], gq[2], o[2]; pg8::unpack8(lwk[i0 + i], l[0], l[1]); pg8::unpack8(bwk[i0 + i], bq[0], bq[1]); pg8::unpack8(gw8[i], gq[0], gq[1]);
#pragma unroll
                    for (int n = 0; n < 2; ++n)
#pragma unroll
                        for (int j = 0; j < 4; ++j) { h[n][j] = __expf(l[n][j]) * h[n][j] + bq[n][j]; o[n][j] = h[n][j] * pg8::gelu_tanh_(gq[n][j]); }
                    *(v4u*)(hgp + (size_t)(i0 + i) * 1536) = pg8::pack8(o[0], o[1]); } }
            __syncthreads();
        }
    }
    SEAM(5);
    TEND(5);

    TSTART(6);
    if (IN(6)) for (int rep = 0; rep < REPS(6); ++rep) { if (rep) GSYNC();
        pg8::Gemm g{CAT, WCAT, M, D, 1536, 1536, 1536, 0, 0}; pg8::StaticOrder S; S.init(M, D, G, bx);
        pg8::EpiMix E{G0, G1, MIXB};
        pg8::gemm_phase<pg8::EpiMix, true, 8>(lds, g, S, E);
    }
    SEAM(6);
    TEND(6);

    TSTART(7);
    if (IN(7)) for (int rep = 0; rep < REPS(7); ++rep) { if (rep) GSYNC();
        pg8::Gemm g{MIXB, WO, M, D, D, D, D, 0, 0}; pg8::StaticOrder S; S.init(M, D, G, bx);
        pg8::EpiRes1 E{XN, (const float*)(ws + WS_RSI), X1B, SSQ};
        pg8::gemm_phase<pg8::EpiRes1, true>(lds, g, S, E);
    }
    SEAM(7);
    TEND(7);

    TSTART(8);
    if (IN(8)) for (int rep = 0; rep < REPS(8); ++rep) { if (rep) GSYNC();
        pg8::Gemm g{X1B, WFI, M, 2 * DFF, D, D, D, 0, 0}; pg8::StaticOrder S; S.init(M, 2 * DFF, G, bx);
        LAS float* RSL = (LAS float*)(lds + 133120);
        { const int r = tid & 255;
          for (int i = tid >> 8; i < 8; i += 2) { pg8::Unit u; if (!S.next(i, u)) break;
              const f32x4* sp = (const f32x4*)(SSQ + (size_t)(u.pm * 256 + r) * 16); const f32x4 st = (sp[0] + sp[1]) + (sp[2] + sp[3]);
              RSL[i * 256 + r] = __builtin_amdgcn_rsqf(((st[0] + st[1]) + (st[2] + st[3])) * (1.0f / 1024.0f) + 1e-6f); }
          __syncthreads(); }
        pg8::EpiSwiglu E{RSL, ACT};
        pg8::gemm_phase<pg8::EpiSwiglu, true>(lds, g, S, E);
        if (G == 256 && bx >= 128) {
            LAS float* scr = (LAS float*)(lds + wave * 16384); constexpr int I_FO = (DFF / 64) * (D / 32);
            for (int r = (bx - 128) * NWAVES + wave; r < I_FO; r += 128 * NWAVES) { const int nblk = D / 32, kb = r / nblk, nb = r % nblk;
                transpose_item(args.in[I_W_FFN_OUT], D, DFF, WFO, 64 * kb, 32 * nb, 32 * nb, nullptr, scr, lane); }
        }
    }
    SEAM(8);
    TEND(8);

    TSTART(9);
    if (IN(9)) for (int rep = 0; rep < REPS(9); ++rep) { if (rep) GSYNC();
        pg8::Gemm g{ACT, WFO, M, D, DFF, DFF, DFF, 0, 0}; pg8::StaticOrder S; S.init(M, D, G, bx);
        if (G == 256) { pg8::EpiFinal E{X1B, X1, (float*)(ws + WS_SSQ2), (unsigned*)ws + 4096, args.in[I_NORM_FINAL]};
            pg8::gemm_phase<pg8::EpiFinal, true>(lds, g, S, E); }
        else { pg8::EpiRes2 E{X1B, X1};
            pg8::gemm_phase<pg8::EpiRes2, true>(lds, g, S, E); }
    }
    if (G != 256) SEAM(9);
    TEND(9);

    TSTART(10);
    if (IN(10) && G != 256) for (int rep = 0; rep < REPS(10); ++rep) { if (rep) GSYNC();
        const int gw = bx * NWAVES + wave, NGW = G * NWAVES;
        const float* gf = args.in[I_NORM_FINAL]; f32x4 gv[4];
#pragma unroll
        for (int j = 0; j < 4; ++j) gv[j] = ((const f32x4*)gf)[lane + 64 * j];
        for (int m = gw; m < M; m += NGW) {
            f32x4* xr = (f32x4*)(X1 + (size_t)m * D) + lane; f32x4 v[4]; float s = 0.f;
#pragma unroll
            for (int j = 0; j < 4; ++j) { v[j] = xr[64 * j]; s += (v[j].x * v[j].x + v[j].y * v[j].y) + (v[j].z * v[j].z + v[j].w * v[j].w); }
            const float rs = 1.0f / sqrtf(wave_sum(s) * (1.f / D) + EPS);
#pragma unroll
            for (int j = 0; j < 4; ++j) xr[64 * j] = v[j] * rs * gv[j];
        }
    }
    if (PROBE_PHASE == 10 || PROBE_PHASE == 99) tp1 = __builtin_amdgcn_s_memrealtime();
    if (PROBE_PHASE >= 0 && bx == 0 && tid == 0) { const unsigned long long dt = (tp1 - tp0) * PROBE_MULT, te = __builtin_amdgcn_s_memrealtime(); while (__builtin_amdgcn_s_memrealtime() - te < dt) __builtin_amdgcn_s_sleep(8); }
#undef IN
#undef SEAM
}

extern "C" void kernel_launch(void* const* d_in, const int* in_sizes, int n_in, void* d_out, int out_size, void* d_ws, size_t ws_size, hipStream_t stream) {
    static int grid = 0;
    if (grid == 0) {
        if (n_in != 19 || out_size != M * D || ws_size < WS_END) { fprintf(stderr, "kernel_launch: unexpected shapes (n_in %d out %d ws %zu)\n", n_in, out_size, ws_size); grid = -1; return; }
        int dev = 0, cus = 0, per_cu = 0;
        hipGetDevice(&dev);
        hipDeviceGetAttribute(&cus, hipDeviceAttributeMultiprocessorCount, dev);
        if (hipFuncSetAttribute((const void*)fwd_kernel, hipFuncAttributeMaxDynamicSharedMemorySize, LDS_BYTES) != hipSuccess) { fprintf(stderr, "kernel_launch: hipFuncSetAttribute failed\n"); grid = -1; return; }
        if (hipOccupancyMaxActiveBlocksPerMultiprocessor(&per_cu, (const void*)fwd_kernel, NTHR, LDS_BYTES) != hipSuccess || per_cu < 1) { fprintf(stderr, "kernel_launch: occupancy query says %d\n", per_cu); per_cu = 1; }
        (void)hipGetLastError();
        grid = cus * 1;
        fprintf(stderr, "kernel_launch: grid %d (cus %d, per_cu %d)\n", grid, cus, per_cu);
    }
    if (grid < 0) return;
    if (hipMemsetAsync(d_ws, 0, 49152, stream) != hipSuccess) { fprintf(stderr, "kernel_launch: memset failed\n"); return; }
    Args a{};
    for (int i = 0; i < 19; ++i) a.in[i] = (const float*)d_in[i];
    a.out = (float*)d_out; a.ws = (unsigned char*)d_ws;
#if MK_PER_PHASE
    for (int p = 0; p < NPH; ++p) { a.ph_lo = p; a.ph_hi = p + 1; hipLaunchKernelGGL(fwd_kernel, dim3(grid), dim3(NTHR), LDS_BYTES, stream, a); }
#else
    a.ph_lo = 0; a.ph_hi = NPH;
    void* kargs[] = {&a};
    hipError_t e = hipLaunchCooperativeKernel((const void*)fwd_kernel, dim3(grid), dim3(NTHR), kargs, LDS_BYTES, stream);
    if (e != hipSuccess) fprintf(stderr, "cooperative launch failed: %s (grid %d)\n", hipGetErrorString(e), grid);
#endif
}
```

```cpp
#include <hip/hip_runtime.h>
#include <hip/hip_cooperative_groups.h>
#include <cstdio>
#include <cstdint>
namespace cg = cooperative_groups;

#ifndef MK_PER_PHASE
#define MK_PER_PHASE 0
#endif

namespace pg8 {
#define PG8_LAS __attribute__((address_space(3)))
typedef unsigned short bf16_t;
typedef short bf16x8 __attribute__((ext_vector_type(8)));
typedef float f32x4 __attribute__((ext_vector_type(4)));
typedef float f32x2 __attribute__((ext_vector_type(2)));
typedef unsigned u32x4 __attribute__((ext_vector_type(4)));
typedef unsigned u32x2 __attribute__((ext_vector_type(2)));
constexpr int BM = 256, BK = 64, HALF = 128, HTB = HALF * BK * 2, STAGE_BYTES = 8 * HTB, NXCD = 8, WGM = 8;

__host__ __device__ __forceinline__ int lds_byte(int r, int c) { const int st = (r >> 4) * 2 + (c >> 5), rr = r & 15, cc = c & 31, ob = rr * 64 + cc * 2; return st * 1024 + (ob ^ (((ob >> 9) & 1) << 5)); }
__host__ __device__ __forceinline__ void stage_rc(int b, int& R, int& C) { const int st = b / 1024, sb = b % 1024, swz = sb ^ (((sb >> 9) & 1) << 5); R = (st >> 1) * 16 + swz / 64; C = (st & 1) * 32 + (swz % 64) / 2; }
__host__ __device__ __forceinline__ int perm32(int rho) { const int n = rho >> 4, i = rho & 15; return 8 * (i >> 2) + 4 * n + (i & 3); }

struct Unit { int pm, pn, rh, idx; };
struct Gemm { const bf16_t* A; const bf16_t* Bt; int M, N, K, lda, ldb, ash, amul; };

struct StaticOrder {
    int nM, nN, nwg, G, c, limit, lin_base, lin_cnt;
    __host__ __device__ __forceinline__ void init(int M, int N, int G_, int c_) { nM = M / BM; nN = N / BM; nwg = nM * nN; G = G_; c = c_; limit = nwg; lin_base = 0; lin_cnt = -1; }
    __host__ __device__ __forceinline__ void map(int L, Unit& u) const {
        int wgid = L; { const int q = nwg / NXCD, r = nwg % NXCD, xcd = wgid % NXCD, off = wgid / NXCD; wgid = (xcd < r ? xcd * (q + 1) : r * (q + 1) + (xcd - r) * q) + off; }
        const int nig = WGM * nN, gid = wgid / nig, fm = gid * WGM, gsz = (nM - fm) < WGM ? (nM - fm) : WGM;
        u.pm = fm + ((wgid % nig) % gsz); u.pn = (wgid % nig) / gsz; u.rh = 0;
    }
    __host__ __device__ __forceinline__ bool next(int i, Unit& u) const {
        u.idx = i;
        if (lin_cnt >= 0) { if (i >= lin_cnt) return false; map(lin_base + i, u); return true; }
        const long L = (long)i * G + c; if (L >= limit) return false;
        map((int)L, u); return true;
    }
};

__device__ __forceinline__ unsigned cvt_pk_bf16(float lo, float hi) { unsigned r; asm volatile("v_cvt_pk_bf16_f32 %0, %1, %2" : "=v"(r) : "v"(lo), "v"(hi)); return r; }
__device__ __forceinline__ float bf_lo(unsigned w) { return __uint_as_float(w << 16); }
__device__ __forceinline__ float bf_hi(unsigned w) { return __uint_as_float(w & 0xffff0000u); }
__device__ __forceinline__ float sigmoidf_(float x) { return __builtin_amdgcn_rcpf(1.0f + __expf(-x)); }
__device__ __forceinline__ float gelu_tanh_(float x) { const float z = 1.5957691216057308f * (x + 0.044715f * x * x * x); return x * sigmoidf_(z); }
__device__ __forceinline__ u32x4 pack8(const f32x4 a, const f32x4 b) { u32x4 w; w.x = cvt_pk_bf16(a[0], a[1]); w.y = cvt_pk_bf16(a[2], a[3]); w.z = cvt_pk_bf16(b[0], b[1]); w.w = cvt_pk_bf16(b[2], b[3]); return w; }
__device__ __forceinline__ void unpack8(const u32x4 w, f32x4& a, f32x4& b) { a = (f32x4){bf_lo(w.x), bf_hi(w.x), bf_lo(w.y), bf_hi(w.y)}; b = (f32x4){bf_lo(w.z), bf_hi(w.z), bf_lo(w.w), bf_hi(w.w)}; }

#define EPI_ROWS_BEGIN _Pragma("unroll") for (int ai = 0; ai < NAI; ++ai) _Pragma("unroll") for (int m = 0; m < 4; ++m) { const int row = u.pm * BM + u.rh + ai * HALF + wr * 64 + m * 16 + fr;
#define EPI_ROWS_END }

struct EpiProj {
    bf16_t *UP, *UR, *UG, *RB, *G1; int pn_off;
    template <int NAI> __device__ __forceinline__ void run(const f32x4 (&acc)[2][2][4][2], const Unit& u, int wr, int wc, int fr, int fq) const {
        const int pn = u.pn + pn_off;
        if (pn < 10) {
            bf16_t* base; int ldc, colt;
            if (pn < 2) { base = UP; ldc = 512; colt = pn * 256; }
            else if (pn < 6) { base = UR; ldc = 1024; colt = (pn - 2) * 256; }
            else { base = UG; ldc = 1024; colt = (pn - 6) * 256; }
            const int col0 = colt + wc * 32 + 8 * fq;
            EPI_ROWS_BEGIN
                bf16_t* rowp = base + (unsigned)((unsigned)row * (unsigned)ldc + (unsigned)col0);
#pragma unroll
                for (int bj = 0; bj < 2; ++bj) *(u32x4*)(rowp + bj * HALF) = pack8(acc[ai][bj][m][0], acc[ai][bj][m][1]);
            EPI_ROWS_END
        } else {
            const int ch0 = (pn - 10) * 128 + wc * 32 + 8 * fq;
            EPI_ROWS_BEGIN
                const unsigned off = (unsigned)row * 1024u + (unsigned)ch0; f32x4 rr[2], gg[2];
#pragma unroll
                for (int n = 0; n < 2; ++n)
#pragma unroll
                    for (int j = 0; j < 4; ++j) { const float d0 = 1.0f + fminf(__expf(-acc[ai][0][m][n][j]), 1e18f), d1 = 1.0f + fminf(__expf(-acc[ai][1][m][n][j]), 1e18f);
                        const float q = __builtin_amdgcn_rcpf(d0 * d1); gg[n][j] = d0 * q; rr[n][j] = d1 * d1 * q; }
                *(u32x4*)(RB + off) = pack8(rr[0], rr[1]); *(u32x4*)(G1 + off) = pack8(gg[0], gg[1]);
            EPI_ROWS_END
        }
    }
};
struct EpiGrp {
    bf16_t* O; int ldc; const float* scale;
    template <int NAI> __device__ __forceinline__ void run(const f32x4 (&acc)[2][2][4][2], const Unit& u, int wr, int wc, int fr, int fq) const {
        const int col0 = u.pn * BM + wc * 32 + 8 * fq;
        f32x4 sc[2][2];
#pragma unroll
        for (int bj = 0; bj < 2; ++bj)
#pragma unroll
            for (int n = 0; n < 2; ++n) sc[bj][n] = *(const f32x4*)(scale + col0 + bj * HALF + 4 * n);
        EPI_ROWS_BEGIN
            bf16_t* rowp = O + (unsigned)((unsigned)row * (unsigned)ldc + (unsigned)col0);
#pragma unroll
            for (int bj = 0; bj < 2; ++bj) *(u32x4*)(rowp + bj * HALF) = pack8(acc[ai][bj][m][0] * sc[bj][0], acc[ai][bj][m][1] * sc[bj][1]);
        EPI_ROWS_END
    }
};
struct EpiGate {
    const bf16_t* V; bf16_t *LA, *BB; const float *b_a, *b_x, *sp8;
    template <int NAI, bool EXACT> __device__ __forceinline__ void rows(const f32x4 (&acc)[2][2][4][2], const Unit& u, int wr, int fr, int ch0, const f32x4 (&ba)[2], const f32x4 (&bx)[2], const f32x4 (&sp)[2]) const {
        u32x4 vwk[2][4];
        EPI_ROWS_BEGIN
            vwk[ai][m] = *(const u32x4*)(V + ((unsigned)row * 1536u + (unsigned)ch0));
        EPI_ROWS_END
        EPI_ROWS_BEGIN
            const unsigned off = (unsigned)row * 1024u + (unsigned)ch0;
            f32x4 vv[2]; unpack8(vwk[ai][m], vv[0], vv[1]);
            f32x4 la[2], bb[2];
#pragma unroll
            for (int n = 0; n < 2; ++n)
#pragma unroll
                for (int j = 0; j < 4; ++j) {
                    const float r = sigmoidf_(acc[ai][0][m][n][j] + ba[n][j]), ig = sigmoidf_(acc[ai][1][m][n][j] + bx[n][j]);
                    const float l = sp[n][j] * r, x2 = 2.0f * l;
                    const float poly = x2 * (1.0f + 0.5f * x2 * (1.0f + 0.33333334f * x2 * (1.0f + 0.25f * x2 * (1.0f + 0.2f * x2 * (1.0f + 0.16666667f * x2)))));
                    const float em1 = EXACT ? ((x2 > -0.25f) ? poly : (__expf(x2) - 1.0f)) : poly;
                    la[n][j] = l; bb[n][j] = __builtin_amdgcn_sqrtf(fmaxf(-em1, 0.f)) * ig * vv[n][j]; }
            *(u32x4*)(LA + off) = pack8(la[0], la[1]); *(u32x4*)(BB + off) = pack8(bb[0], bb[1]);
        EPI_ROWS_END
    }
    template <int NAI> __device__ __forceinline__ void run(const f32x4 (&acc)[2][2][4][2], const Unit& u, int wr, int wc, int fr, int fq) const {
        const int ch0 = u.pn * 128 + wc * 32 + 8 * fq;
        f32x4 ba[2], bx[2], sp[2]; bool big = false;
#pragma unroll
        for (int n = 0; n < 2; ++n) { ba[n] = *(const f32x4*)(b_a + ch0 + 4 * n); bx[n] = *(const f32x4*)(b_x + ch0 + 4 * n); sp[n] = *(const f32x4*)(sp8 + ch0 + 4 * n);
#pragma unroll
            for (int j = 0; j < 4; ++j) big = big || !(sp[n][j] >= -0.125f); }
        if (__builtin_amdgcn_ballot_w64(big) != 0ull) rows<NAI, true>(acc, u, wr, fr, ch0, ba, bx, sp);
        else rows<NAI, false>(acc, u, wr, fr, ch0, ba, bx, sp);
    }
};
struct EpiMix {
    const bf16_t *RB, *G1; bf16_t* MIXB;
    __device__ __forceinline__ void mid(f32x4 (&acc)[2][2][4][2], const Unit& u0, int wr, int wc, int fr, int fq) const {
        constexpr int NAI = 2; Unit u = u0; asm volatile("" : "+s"(u.pm), "+s"(u.pn));
        const int col0 = u.pn * BM + wc * 32 + 8 * fq;
        u32x4 rw[2][4][2];
        EPI_ROWS_BEGIN
            const unsigned off = (unsigned)row * 1024u + (unsigned)col0;
#pragma unroll
            for (int bj = 0; bj < 2; ++bj) rw[ai][m][bj] = *(const u32x4*)(RB + off + bj * HALF);
        EPI_ROWS_END
        EPI_ROWS_BEGIN
#pragma unroll
            for (int bj = 0; bj < 2; ++bj) { f32x4 r[2]; unpack8(rw[ai][m][bj], r[0], r[1]); acc[ai][bj][m][0] *= r[0]; acc[ai][bj][m][1] *= r[1]; }
            (void)row;
        EPI_ROWS_END
    }
    template <int NAI> __device__ __forceinline__ void run(const f32x4 (&acc)[2][2][4][2], const Unit& u, int wr, int wc, int fr, int fq) const {
        const int col0 = u.pn * BM + wc * 32 + 8 * fq;
        u32x4 gw[2][4][2];
        EPI_ROWS_BEGIN
            const unsigned off = (unsigned)row * 1024u + (unsigned)col0;
#pragma unroll
            for (int bj = 0; bj < 2; ++bj) gw[ai][m][bj] = *(const u32x4*)(G1 + off + bj * HALF);
        EPI_ROWS_END
        EPI_ROWS_BEGIN
            const unsigned off = (unsigned)row * 1024u + (unsigned)col0;
#pragma unroll
            for (int bj = 0; bj < 2; ++bj) { f32x4 g[2]; unpack8(gw[ai][m][bj], g[0], g[1]);
                *(u32x4*)(MIXB + off + bj * HALF) = pack8(g[0] * acc[ai][bj][m][0], g[1] * acc[ai][bj][m][1]); }
        EPI_ROWS_END
    }
};
struct EpiRes1 {
    const bf16_t* XNB; const float* RSI; bf16_t* X1B; float* SSQ;
    template <int NAI> __device__ __forceinline__ void run(const f32x4 (&acc)[2][2][4][2], const Unit& u, int wr, int wc, int fr, int fq) const {
        const int col0 = u.pn * BM + wc * 32 + 8 * fq;
#pragma unroll
        for (int ai = 0; ai < NAI; ++ai) {
            u32x4 xw[4][2]; float qi[4];
#pragma unroll
            for (int m = 0; m < 4; ++m) { const int row = u.pm * BM + u.rh + ai * HALF + wr * 64 + m * 16 + fr; const unsigned off = (unsigned)row * 1024u + (unsigned)col0; qi[m] = RSI[row];
#pragma unroll
                for (int bj = 0; bj < 2; ++bj) xw[m][bj] = *(const u32x4*)(XNB + off + bj * HALF); }
            asm volatile("s_waitcnt vmcnt(0)" ::: "memory");
#pragma unroll
            for (int m = 0; m < 4; ++m) { const int row = u.pm * BM + u.rh + ai * HALF + wr * 64 + m * 16 + fr; const unsigned off = (unsigned)row * 1024u + (unsigned)col0; float ss = 0.f;
#pragma unroll
                for (int bj = 0; bj < 2; ++bj) { f32x4 xa, xb; unpack8(xw[m][bj], xa, xb);
                    const f32x4 a = xa * qi[m] + acc[ai][bj][m][0], b = xb * qi[m] + acc[ai][bj][m][1];
                    *(u32x4*)(X1B + off + bj * HALF) = pack8(a, b);
                    ss += (a[0] * a[0] + a[1] * a[1]) + (a[2] * a[2] + a[3] * a[3]) + (b[0] * b[0] + b[1] * b[1]) + (b[2] * b[2] + b[3] * b[3]); }
                ss += __shfl_xor(ss, 16); ss += __shfl_xor(ss, 32);
                if (fq == 0) SSQ[(unsigned)row * 16u + (unsigned)(u.pn * 4 + wc)] = ss; }
        }
    }
};
struct EpiSwiglu {
    const PG8_LAS float* RSL; bf16_t* ACT;
    template <int NAI> __device__ __forceinline__ void run(const f32x4 (&acc)[2][2][4][2], const Unit& u, int wr, int wc, int fr, int fq) const {
        const int col0 = u.pn * 128 + wc * 32 + 8 * fq;
        const PG8_LAS float* rt = RSL + u.idx * 256 + wr * 64 + fr;
        EPI_ROWS_BEGIN
            const float rs = rt[ai * HALF + m * 16];
            f32x4 o[2];
#pragma unroll
            for (int n = 0; n < 2; ++n)
#pragma unroll
                for (int j = 0; j < 4; ++j) { const float g = acc[ai][0][m][n][j] * rs, up = acc[ai][1][m][n][j] * rs; o[n][j] = g * sigmoidf_(g) * up; }
            __builtin_nontemporal_store(pack8(o[0], o[1]), (u32x4*)(ACT + (unsigned)((unsigned)row * 2816u + (unsigned)col0)));
        EPI_ROWS_END
    }
};
struct EpiRes2 {
    const bf16_t* X1B; float* OUT;
    template <int NAI> __device__ __forceinline__ void run(const f32x4 (&acc)[2][2][4][2], const Unit& u, int wr, int wc, int fr, int fq) const {
        const int col0 = u.pn * BM + wc * 32 + 8 * fq;
        EPI_ROWS_BEGIN
            const unsigned off = (unsigned)row * 1024u + (unsigned)col0;
#pragma unroll
            for (int bj = 0; bj < 2; ++bj) { f32x4 xa, xb; unpack8(*(const u32x4*)(X1B + off + bj * HALF), xa, xb);
                *(f32x4*)(OUT + off + bj * HALF) = xa + acc[ai][bj][m][0]; *(f32x4*)(OUT + off + bj * HALF + 4) = xb + acc[ai][bj][m][1]; }
        EPI_ROWS_END
    }
};

struct EpiFinal {
    const bf16_t* X1B; float* OUT; float* SSQ2; unsigned* cnt; const float* gfin;
    template <int NAI> __device__ __forceinline__ void run(f32x4 (&acc)[2][2][4][2], const Unit& u, int wr, int wc, int fr, int fq) const {
        const int col0 = u.pn * BM + wc * 32 + 8 * fq;
        { u32x4 xw[2][4][2];
          EPI_ROWS_BEGIN
              const unsigned off = (unsigned)row * 1024u + (unsigned)col0;
#pragma unroll
              for (int bj = 0; bj < 2; ++bj) xw[ai][m][bj] = *(const u32x4*)(X1B + off + bj * HALF);
          EPI_ROWS_END
          EPI_ROWS_BEGIN
              float ss = 0.f;
#pragma unroll
              for (int bj = 0; bj < 2; ++bj) { f32x4 xa, xb; unpack8(xw[ai][m][bj], xa, xb);
                  const f32x4 a = xa + acc[ai][bj][m][0], b = xb + acc[ai][bj][m][1]; acc[ai][bj][m][0] = a; acc[ai][bj][m][1] = b;
                  ss += (a[0] * a[0] + a[1] * a[1]) + (a[2] * a[2] + a[3] * a[3]) + (b[0] * b[0] + b[1] * b[1]) + (b[2] * b[2] + b[3] * b[3]); }
              ss += __shfl_xor(ss, 16); ss += __shfl_xor(ss, 32);
              if (fq == 0) __hip_atomic_store(SSQ2 + (unsigned)row * 16u + (unsigned)(u.pn * 4 + wc), ss, __ATOMIC_RELAXED, __HIP_MEMORY_SCOPE_AGENT);
          EPI_ROWS_END }
        asm volatile("s_waitcnt vmcnt(0)" ::: "memory");
        unsigned* c = cnt + 64 * u.pm;
        if ((threadIdx.x & 63) == 0) __hip_atomic_fetch_add(c, 1u, __ATOMIC_RELAXED, __HIP_MEMORY_SCOPE_AGENT);
        f32x4 gv[2][2];
#pragma unroll
        for (int bj = 0; bj < 2; ++bj)
#pragma unroll
            for (int n = 0; n < 2; ++n) gv[bj][n] = *(const f32x4*)(gfin + col0 + bj * HALF + 4 * n);
        { unsigned sp = 0;
          while ((unsigned)__builtin_amdgcn_readfirstlane(__hip_atomic_load(c, __ATOMIC_RELAXED, __HIP_MEMORY_SCOPE_AGENT)) < 32u) { __builtin_amdgcn_s_sleep(2); if (++sp > (1u << 20)) break; } }
        __builtin_amdgcn_fence(__ATOMIC_ACQUIRE, "agent");
        unsigned long long w0[2][4], w1[2][4];
        EPI_ROWS_BEGIN
            const unsigned long long* sl = (const unsigned long long*)(SSQ2 + (unsigned)row * 16u + (unsigned)(4 * fq));
            w0[ai][m] = __hip_atomic_load(sl, __ATOMIC_RELAXED, __HIP_MEMORY_SCOPE_AGENT); w1[ai][m] = __hip_atomic_load(sl + 1, __ATOMIC_RELAXED, __HIP_MEMORY_SCOPE_AGENT);
        EPI_ROWS_END
        EPI_ROWS_BEGIN
            const unsigned off = (unsigned)row * 1024u + (unsigned)col0;
            float sq = (__uint_as_float((unsigned)w0[ai][m]) + __uint_as_float((unsigned)(w0[ai][m] >> 32))) + (__uint_as_float((unsigned)w1[ai][m]) + __uint_as_float((unsigned)(w1[ai][m] >> 32)));
            sq += __shfl_xor(sq, 16); sq += __shfl_xor(sq, 32);
            const float rs = 1.0f / sqrtf(sq * (1.0f / 1024.0f) + 1e-6f);
#pragma unroll
            for (int bj = 0; bj < 2; ++bj) { *(f32x4*)(OUT + off + bj * HALF) = acc[ai][bj][m][0] * rs * gv[bj][0]; *(f32x4*)(OUT + off + bj * HALF + 4) = acc[ai][bj][m][1] * rs * gv[bj][1]; }
        EPI_ROWS_END
    }
};

template <class Epi, bool ALIGN_EPI, int MID_T = -1>
__device__ __forceinline__ void gemm_phase(PG8_LAS unsigned char* lds, const Gemm g, const StaticOrder& S, const Epi& E) {
    const int tid = threadIdx.x, wid = __builtin_amdgcn_readfirstlane(tid >> 6), lane = tid & 63, wr = wid >> 2, wc = wid & 3, fr = lane & 15, fq = lane >> 4;
    int nt = g.K / BK; asm volatile("" : "+s"(nt));
    unsigned voffA[2], voffB[2];
#pragma unroll
    for (int i = 0; i < 2; ++i) { int R, C; stage_rc(tid * 16 + i * 8192, R, C); const int Rb = (R & ~31) + perm32(R & 31);
        voffA[i] = (unsigned)(R * g.lda + C) * 2u; voffB[i] = (unsigned)(Rb * g.ldb + C) * 2u; }
    const size_t kstep = (size_t)(BK * 2);
    const size_t hstepA = (size_t)HALF * g.lda * 2, hstepB = (size_t)HALF * g.ldb * 2;
    const size_t tstepA = 2 * hstepA, tstepB = 2 * hstepB;
    const unsigned ldsw = (unsigned)wid * 1024u;
    const int aoff = lds_byte(wr * 64 + fr, fq * 8), boff = lds_byte(wc * 32 + fr, fq * 8);
#define PG8_SA(b, h) (((b) * 2 + (h)) * HTB)
#define PG8_SB(b, h) ((4 + (b) * 2 + (h)) * HTB)
#define PG8_STAGE(bufoff, gbase, voff) do { _Pragma("unroll") for (int _i = 0; _i < 2; ++_i) \
        __builtin_amdgcn_global_load_lds((const unsigned*)((const char*)(gbase) + (voff)[_i]), (PG8_LAS unsigned*)(lds + (bufoff) + ldsw + _i * 8192), 16, 0, 0); } while (0)
#define PG8_LDA(dst, b, h) do { _Pragma("unroll") for (int m = 0; m < 4; ++m) _Pragma("unroll") for (int k = 0; k < 2; ++k) dst[m][k] = *(const PG8_LAS bf16x8*)(lds + PG8_SA(b, h) + aoff + m * 2048 + k * 1024); } while (0)
#define PG8_LDB(dst, b, h) do { _Pragma("unroll") for (int n = 0; n < 2; ++n) _Pragma("unroll") for (int k = 0; k < 2; ++k) dst[n][k] = *(const PG8_LAS bf16x8*)(lds + PG8_SB(b, h) + boff + n * 2048 + k * 1024); } while (0)
#define PG8_MMA(ai, bj, At, Bt) do { __builtin_amdgcn_s_setprio(1); _Pragma("unroll") for (int m = 0; m < 4; ++m) _Pragma("unroll") for (int n = 0; n < 2; ++n) _Pragma("unroll") for (int k = 0; k < 2; ++k) \
        acc[ai][bj][m][n] = __builtin_amdgcn_mfma_f32_16x16x32_bf16(Bt[n][k], At[m][k], acc[ai][bj][m][n], 0, 0, 0); __builtin_amdgcn_s_setprio(0); } while (0)
#define PG8_WAIT_V(n) asm volatile("s_waitcnt vmcnt(" #n ")" ::: "memory")
#define PG8_WAIT_L(n) asm volatile("s_waitcnt lgkmcnt(" #n ")" ::: "memory")
#define PG8_BAR __builtin_amdgcn_s_barrier()
#define PG8_SCHED __builtin_amdgcn_sched_barrier(0)
    Unit cur, nxt; int ui = 0;
    if (!S.next(0, cur)) return;
    f32x4 acc[2][2][4][2];
#pragma unroll
    for (int a = 0; a < 2; ++a)
#pragma unroll
        for (int b = 0; b < 2; ++b)
#pragma unroll
            for (int m = 0; m < 4; ++m)
#pragma unroll
                for (int n = 0; n < 2; ++n) acc[a][b][m][n] = (f32x4){0.f, 0.f, 0.f, 0.f};
    bf16x8 At[4][2], B0[2][2], B1[2][2];
    const char* cA = (const char*)g.A + (size_t)cur.pm * tstepA + (size_t)((cur.pn >> g.ash) * g.amul) * 2; const char* cB = (const char*)g.Bt + (size_t)cur.pn * tstepB;
    PG8_STAGE(PG8_SB(0, 0), cB, voffB); PG8_STAGE(PG8_SB(0, 1), cB + hstepB, voffB); PG8_STAGE(PG8_SA(0, 0), cA, voffA); PG8_STAGE(PG8_SA(0, 1), cA + hstepA, voffA);
    if (wr == 1) PG8_BAR;
    PG8_WAIT_V(2); PG8_BAR;
    PG8_STAGE(PG8_SB(1, 0), cB + kstep, voffB); PG8_STAGE(PG8_SA(1, 0), cA + kstep, voffA); PG8_STAGE(PG8_SB(1, 1), cB + hstepB + kstep, voffB);
    PG8_WAIT_V(6); PG8_BAR;
    for (;;) {
        const bool has_next = S.next(ui + 1, nxt);
        const char* nA = has_next ? (const char*)g.A + (size_t)nxt.pm * tstepA + (size_t)((nxt.pn >> g.ash) * g.amul) * 2 : cA; const char* nB = has_next ? (const char*)g.Bt + (size_t)nxt.pn * tstepB : cB;
        for (int t = 0; t < nt; t += 2) {
            const bool last = (t == nt - 2);
            if constexpr (MID_T >= 0) { if (t == MID_T) E.mid(acc, cur, wr, wc, fr, fq); }
            const char* a1 = cA + (size_t)(t + 1) * kstep;
            const char* a2 = last ? nA : cA + (size_t)(t + 2) * kstep; const char* b2 = last ? nB : cB + (size_t)(t + 2) * kstep;
            const char* a3 = a2 + kstep; const char* b3 = b2 + kstep;
            PG8_LDB(B0, 0, 0); PG8_LDB(B1, 0, 1); PG8_SCHED; PG8_LDA(At, 0, 0); PG8_STAGE(PG8_SA(1, 1), a1 + hstepA, voffA);
            PG8_WAIT_V(8); PG8_WAIT_L(0); PG8_BAR; PG8_MMA(0, 0, At, B0); PG8_MMA(0, 1, At, B1); PG8_BAR; PG8_SCHED;
            PG8_LDA(At, 0, 1); PG8_STAGE(PG8_SB(0, 0), b2, voffB); PG8_STAGE(PG8_SB(0, 1), b2 + hstepB, voffB); PG8_STAGE(PG8_SA(0, 0), a2, voffA);
            PG8_WAIT_V(8); PG8_WAIT_L(0); PG8_BAR; PG8_MMA(1, 0, At, B0); PG8_MMA(1, 1, At, B1); PG8_BAR; PG8_SCHED;
            PG8_LDB(B0, 1, 0); PG8_LDB(B1, 1, 1); PG8_SCHED; PG8_LDA(At, 1, 0); PG8_STAGE(PG8_SA(0, 1), a2 + hstepA, voffA);
            PG8_WAIT_V(8); PG8_WAIT_L(0); PG8_BAR; PG8_MMA(0, 0, At, B0); PG8_MMA(0, 1, At, B1); PG8_BAR; PG8_SCHED;
            PG8_LDA(At, 1, 1); PG8_STAGE(PG8_SB(1, 0), b3, voffB); PG8_STAGE(PG8_SB(1, 1), b3 + hstepB, voffB); PG8_STAGE(PG8_SA(1, 0), a3, voffA);
            PG8_WAIT_V(8); PG8_WAIT_L(0); PG8_BAR; PG8_MMA(1, 0, At, B0); PG8_MMA(1, 1, At, B1); PG8_BAR; PG8_SCHED;
        }
        if constexpr (ALIGN_EPI) { if (wr == 0) PG8_BAR; }
        E.template run<2>(acc, cur, wr, wc, fr, fq);
        if (!has_next) break;
#pragma unroll
        for (int a = 0; a < 2; ++a)
#pragma unroll
            for (int b = 0; b < 2; ++b)
#pragma unroll
                for (int m = 0; m < 4; ++m)
#pragma unroll
                    for (int n = 0; n < 2; ++n) acc[a][b][m][n] = (f32x4){0.f, 0.f, 0.f, 0.f};
        cur = nxt; cA = nA; cB = nB; ++ui;
        if constexpr (ALIGN_EPI) { if (wr == 1) PG8_BAR; }
    }
    PG8_WAIT_V(0);
    if constexpr (!ALIGN_EPI) { if (wr == 0) PG8_BAR; }
    PG8_BAR;
#undef PG8_SA
#undef PG8_SB
#undef PG8_STAGE
#undef PG8_LDA
#undef PG8_LDB
#undef PG8_MMA
#undef PG8_WAIT_V
#undef PG8_WAIT_L
#undef PG8_BAR
#undef PG8_SCHED
}

template <class Epi>
__device__ __forceinline__ void gemm_half(PG8_LAS unsigned char* lds, const Gemm g, const Unit u, const Epi& E) {
    const int tid = threadIdx.x, wid = __builtin_amdgcn_readfirstlane(tid >> 6), lane = tid & 63, wr = wid >> 2, wc = wid & 3, fr = lane & 15, fq = lane >> 4;
    int nt = g.K / BK; asm volatile("" : "+s"(nt));
    unsigned voffA[2], voffB[2];
#pragma unroll
    for (int i = 0; i < 2; ++i) { int R, C; stage_rc(tid * 16 + i * 8192, R, C); const int Rb = (R & ~31) + perm32(R & 31);
        voffA[i] = (unsigned)(R * g.lda + C) * 2u; voffB[i] = (unsigned)(Rb * g.ldb + C) * 2u; }
    const size_t kstep = (size_t)(BK * 2);
    const size_t hstepA = (size_t)HALF * g.lda * 2, hstepB = (size_t)HALF * g.ldb * 2;
    const unsigned ldsw = (unsigned)wid * 1024u;
    const int aoff = lds_byte(wr * 64 + fr, fq * 8), boff = lds_byte(wc * 32 + fr, fq * 8);
#define PG8_SA(b, h) (((b) * 2 + (h)) * HTB)
#define PG8_SB(b, h) ((4 + (b) * 2 + (h)) * HTB)
#define PG8_STAGE(bufoff, gbase, voff) do { _Pragma("unroll") for (int _i = 0; _i < 2; ++_i) \
        __builtin_amdgcn_global_load_lds((const unsigned*)((const char*)(gbase) + (voff)[_i]), (PG8_LAS unsigned*)(lds + (bufoff) + ldsw + _i * 8192), 16, 0, 0); } while (0)
#define PG8_LDA(dst, b, h) do { _Pragma("unroll") for (int m = 0; m < 4; ++m) _Pragma("unroll") for (int k = 0; k < 2; ++k) dst[m][k] = *(const PG8_LAS bf16x8*)(lds + PG8_SA(b, h) + aoff + m * 2048 + k * 1024); } while (0)
#define PG8_LDB(dst, b, h) do { _Pragma("unroll") for (int n = 0; n < 2; ++n) _Pragma("unroll") for (int k = 0; k < 2; ++k) dst[n][k] = *(const PG8_LAS bf16x8*)(lds + PG8_SB(b, h) + boff + n * 2048 + k * 1024); } while (0)
#define PG8_MMA(ai, bj, At, Bt) do { __builtin_amdgcn_s_setprio(1); _Pragma("unroll") for (int m = 0; m < 4; ++m) _Pragma("unroll") for (int n = 0; n < 2; ++n) _Pragma("unroll") for (int k = 0; k < 2; ++k) \
        acc[ai][bj][m][n] = __builtin_amdgcn_mfma_f32_16x16x32_bf16(Bt[n][k], At[m][k], acc[ai][bj][m][n], 0, 0, 0); __builtin_amdgcn_s_setprio(0); } while (0)
#define PG8_WAIT_V(n) asm volatile("s_waitcnt vmcnt(" #n ")" ::: "memory")
#define PG8_WAIT_L(n) asm volatile("s_waitcnt lgkmcnt(" #n ")" ::: "memory")
#define PG8_BAR __builtin_amdgcn_s_barrier()
#define PG8_SCHED __builtin_amdgcn_sched_barrier(0)
    f32x4 acc[2][2][4][2];
#pragma unroll
    for (int a = 0; a < 2; ++a)
#pragma unroll
        for (int b = 0; b < 2; ++b)
#pragma unroll
            for (int m = 0; m < 4; ++m)
#pragma unroll
                for (int n = 0; n < 2; ++n) acc[a][b][m][n] = (f32x4){0.f, 0.f, 0.f, 0.f};
    bf16x8 At[4][2], B0[2][2], B1[2][2];
    const char* cA = (const char*)g.A + ((size_t)u.pm * BM + u.rh) * g.lda * 2 + (size_t)((u.pn >> g.ash) * g.amul) * 2; const char* cB = (const char*)g.Bt + (size_t)u.pn * 2 * hstepB;
    PG8_STAGE(PG8_SB(0, 0), cB, voffB); PG8_STAGE(PG8_SB(0, 1), cB + hstepB, voffB); PG8_STAGE(PG8_SA(0, 0), cA, voffA);
    PG8_STAGE(PG8_SB(1, 0), cB + kstep, voffB); PG8_STAGE(PG8_SB(1, 1), cB + hstepB + kstep, voffB); PG8_STAGE(PG8_SA(1, 0), cA + kstep, voffA);
    PG8_WAIT_V(6); PG8_BAR;
#define PG8_HALF_STEP(b, tt) do { \
        PG8_LDB(B0, b, 0); PG8_LDB(B1, b, 1); PG8_LDA(At, b, 0); PG8_WAIT_L(0); PG8_BAR; PG8_SCHED; \
        const bool more_ = (tt) + 2 < nt; \
        if (more_) { const char* b2 = cB + (size_t)((tt) + 2) * kstep; const char* a2 = cA + (size_t)((tt) + 2) * kstep; \
            PG8_STAGE(PG8_SB(b, 0), b2, voffB); PG8_STAGE(PG8_SB(b, 1), b2 + hstepB, voffB); PG8_STAGE(PG8_SA(b, 0), a2, voffA); } \
        PG8_MMA(0, 0, At, B0); PG8_MMA(0, 1, At, B1); \
        if (more_) PG8_WAIT_V(6); else PG8_WAIT_V(0); \
        PG8_BAR; PG8_SCHED; } while (0)
    for (int t = 0; t < nt; t += 2) { PG8_HALF_STEP(0, t); PG8_HALF_STEP(1, t + 1); }
    E.template run<1>(acc, u, wr, wc, fr, fq);
    PG8_BAR;
#undef PG8_HALF_STEP
#undef PG8_SA
#undef PG8_SB
#undef PG8_STAGE
#undef PG8_LDA
#undef PG8_LDB
#undef PG8_MMA
#undef PG8_WAIT_V
#undef PG8_WAIT_L
#undef PG8_BAR
#undef PG8_SCHED
}
}

constexpr int NWAVES = 8, NTHR = 512;
constexpr int M = 16384, SEQ = 4096, NB = 4, D = 1024, DPOOL = 512, DRNN = 1024, DIN = 4608, DFF = 2816;
constexpr float EPS = 1e-6f;
constexpr int NPH = 11;
constexpr int SCAN_T = 128, SCAN_NC = SEQ / SCAN_T;

constexpr size_t MiB = 1u << 20;
constexpr size_t WS_SP8 = 512 * 1024;
constexpr size_t WS_RSI = 576 * 1024;
constexpr size_t WS_SSQ = 1 * MiB;
constexpr size_t WS_SSQ2 = 2 * MiB;
constexpr size_t WS_CS = 2 * MiB, WS_CH = 3 * MiB;
constexpr size_t WS_WIN = 4 * MiB;
constexpr size_t WS_WFI = 13 * MiB;
constexpr size_t WS_WFO = 24 * MiB;
constexpr size_t WS_WCAT = WS_WFO + 5632 * 1024;
constexpr size_t WS_WO = WS_WCAT + 3 * MiB;
constexpr size_t WS_WGRP = WS_WO + 2 * MiB;
constexpr size_t WS_WGATE = WS_WGRP + MiB / 4;
constexpr size_t WS_R1 = 36 * MiB;
constexpr size_t WS_R2 = 68 * MiB;
constexpr size_t WS_R3 = 84 * MiB;
constexpr size_t WS_R4 = 116 * MiB;
constexpr size_t WS_R7 = 148 * MiB;
constexpr size_t WS_R8 = 164 * MiB;
constexpr size_t WS_CAT = 196 * MiB;
constexpr size_t WS_MIXB = 148 * MiB;
constexpr size_t WS_ACT = 68 * MiB;
constexpr size_t WS_END = 244 * MiB;

constexpr int LDS_BYTES = 147456;

#define LAS __attribute__((address_space(3)))
typedef unsigned short bf16;
typedef unsigned v4u __attribute__((ext_vector_type(4)));
typedef unsigned v2u __attribute__((ext_vector_type(2)));
typedef float f32x4 __attribute__((ext_vector_type(4)));
typedef float f32x2 __attribute__((ext_vector_type(2)));
#define LDS_WAIT() asm volatile("s_waitcnt lgkmcnt(0)" ::: "memory")
using pg8::cvt_pk_bf16; using pg8::bf_lo; using pg8::bf_hi;

struct Args { const float* in[19]; float* out; unsigned char* ws; int ph_lo, ph_hi; };
enum { I_X = 0, I_NORM_MIX, I_W_IN, I_W_GRP, I_POOL_SCALE, I_W_POOL_OUT, I_CONV_W, I_CONV_B, I_W_RG_A, I_B_RG_A, I_W_RG_X, I_B_RG_X, I_LAMBDA, I_W_RNN_OUT, I_W_O, I_NORM_FFN, I_W_FFN_IN, I_W_FFN_OUT, I_NORM_FINAL };

__device__ __forceinline__ float wave_sum(float v) {
#pragma unroll
    for (int o = 1; o < 64; o <<= 1) v += __shfl_xor(v, o);
    return v;
}

__device__ __forceinline__ void transpose_item(const float* W, int Nsrc, int Kdst, bf16* WT, int k0, int n_src0, int n_dst0, const float* kscale, LAS float* scr, int lane) {
    f32x4 v[8]; const int n4 = (lane & 7) * 4;
#pragma unroll
    for (int i = 0; i < 8; ++i) { const int kk = 8 * i + (lane >> 3); v[i] = *(const f32x4*)(W + (size_t)(k0 + kk) * Nsrc + n_src0 + n4); }
    if (kscale) {
#pragma unroll
        for (int i = 0; i < 8; ++i) v[i] = v[i] * kscale[k0 + 8 * i + (lane >> 3)]; }
#pragma unroll
    for (int i = 0; i < 8; ++i) { const int kk = 8 * i + (lane >> 3);
#pragma unroll
        for (int j = 0; j < 4; ++j) scr[kk * 33 + n4 + j] = v[i][j]; }
    LDS_WAIT(); asm volatile("" ::: "memory");
    const int c = lane & 7;
#pragma unroll
    for (int j = 0; j < 4; ++j) { const int n = (lane >> 3) + 8 * j; const LAS float* s = scr + (8 * c) * 33 + n;
        v4u o; o.x = cvt_pk_bf16(s[0 * 33], s[1 * 33]); o.y = cvt_pk_bf16(s[2 * 33], s[3 * 33]); o.z = cvt_pk_bf16(s[4 * 33], s[5 * 33]); o.w = cvt_pk_bf16(s[6 * 33], s[7 * 33]);
        *(v4u*)(WT + (size_t)(n_dst0 + n) * Kdst + k0 + 8 * c) = o; }
    LDS_WAIT(); asm volatile("" ::: "memory");
}

#define XB_TMO      128
#define XB_XCNT(j)  (256  + 64 * (j))
#define XB_XSUB(j)  (1280 + 64 * (j))
#define XB_XGEN(j)  (2304 + 64 * (j))
#define XB_TOP      3328
#define XB_TOPGEN   3392
#define XCD_BAR_WORDS 3456
#define XB_SPIN_CAP (1u << 18)
__device__ __forceinline__ unsigned xb_ld(unsigned* p)              { return __hip_atomic_load(p, __ATOMIC_RELAXED, __HIP_MEMORY_SCOPE_AGENT); }
__device__ __forceinline__ unsigned xb_add(unsigned* p, unsigned v) { return __hip_atomic_fetch_add(p, v, __ATOMIC_RELAXED, __HIP_MEMORY_SCOPE_AGENT); }
__device__ __forceinline__ unsigned xb_xcc_id() { return (unsigned)__builtin_amdgcn_s_getreg((3 << 11) | 20) & 0xFu; }
#define XB_SPIN(cond, bar) do { unsigned _sp = 0; while (cond) { __builtin_amdgcn_s_sleep(1); \
    if ((++_sp & 255u) == 0u) { if (xb_ld(&(bar)[XB_TMO])) break; if (_sp > XB_SPIN_CAP) { atomicAdd(&(bar)[XB_TMO], 1u); break; } } } } while (0)
struct XcdBarrier { unsigned* bar; unsigned x; volatile LAS unsigned* st; };
__device__ __forceinline__ XcdBarrier xcd_barrier_post(unsigned* bar, volatile LAS unsigned* st) {
    XcdBarrier b; b.bar = bar; b.x = xb_xcc_id(); b.st = st;
    if (threadIdx.x == 0) (void)xb_add(&bar[XB_XCNT(b.x)], 1u);
    return b;
}
__device__ __forceinline__ void xcd_barrier_complete(unsigned* bar, unsigned x, unsigned& nloc, unsigned& nx) {
    const unsigned G = gridDim.x * gridDim.y * gridDim.z;
    unsigned sum, cnt, mine, sp = 0u;
    for (;;) {
        sum = 0u; cnt = 0u; mine = 0u;
#pragma unroll
        for (unsigned j = 0; j < 16; ++j) { const unsigned c = xb_ld(&bar[XB_XCNT(j)]); sum += c; cnt += (c > 0u) ? 1u : 0u; mine = (j == x) ? c : mine; }
        if (sum == G) break;
        __builtin_amdgcn_s_sleep(1);
        if ((++sp & 255u) == 0u) { if (xb_ld(&bar[XB_TMO])) break; if (sp > XB_SPIN_CAP) { atomicAdd(&bar[XB_TMO], 1u); break; } }
    }
    nloc = mine > 0u ? mine : 1u; nx = cnt > 0u ? cnt : 1u;
}
__device__ __forceinline__ void xcd_barrier(const XcdBarrier& b) {
    asm volatile("s_waitcnt vmcnt(0)" ::: "memory");
    __syncthreads();
    if (threadIdx.x == 0) {
        unsigned* bar = b.bar;
        __builtin_amdgcn_s_waitcnt(0);
        unsigned nloc = b.st[0], nx = b.st[1];
        if (nloc == 0u) { xcd_barrier_complete(bar, b.x, nloc, nx); b.st[0] = nloc; b.st[1] = nx; }
        const unsigned old = xb_add(&bar[XB_XSUB(b.x)], 1u);
        const unsigned gen = old / nloc;
        if (old + 1u == (gen + 1u) * nloc) {
            __builtin_amdgcn_fence(__ATOMIC_RELEASE, "agent");
            asm volatile("s_waitcnt vmcnt(0)" ::: "memory");
            const unsigned og = xb_add(&bar[XB_TOP], 1u);
            const unsigned tg = og / nx;
            if (og + 1u == (tg + 1u) * nx) xb_add(&bar[XB_TOPGEN], 1u);
            else XB_SPIN(xb_ld(&bar[XB_TOPGEN]) == tg, bar);
            __builtin_amdgcn_fence(__ATOMIC_ACQUIRE, "agent");
            xb_add(&bar[XB_XGEN(b.x)], 1u);
            asm volatile("s_waitcnt vmcnt(0)" ::: "memory");
        } else {
            XB_SPIN(xb_ld(&bar[XB_XGEN(b.x)]) == gen, bar);
            __builtin_amdgcn_fence(__ATOMIC_ACQUIRE, "agent");
            asm volatile("s_waitcnt vmcnt(0)" ::: "memory");
        }
    }
    __syncthreads();
}

template <int W>
__device__ __forceinline__ void pool_item(const bf16* src, bf16* dst, int tl) {
    v4u rw[W + 7];
#pragma unroll
    for (int k = 0; k < W + 7; ++k) rw[k] = (tl + k - (W - 1) >= 0) ? *(const v4u*)(src + (ptrdiff_t)(k - (W - 1)) * DPOOL) : (v4u){0u, 0u, 0u, 0u};
    f32x4 s0 = {0.f, 0.f, 0.f, 0.f}, s1 = s0;
#pragma unroll
    for (int k = 0; k < W - 1; ++k) { f32x4 a, c; pg8::unpack8(rw[k], a, c); s0 += a; s1 += c; }
#pragma unroll
    for (int i = 0; i < 8; ++i) { f32x4 a, c; pg8::unpack8(rw[W - 1 + i], a, c); s0 += a; s1 += c;
        const int t = tl + i; const int cnt = (t + 1 < W) ? t + 1 : W; const float inv = 1.0f / (float)cnt;
        *(v4u*)(dst + (size_t)i * DPOOL) = pg8::pack8(s0 * inv - a, s1 * inv - c);
        f32x4 a2, c2; pg8::unpack8(rw[i], a2, c2); s0 -= a2; s1 -= c2; }
}
__device__ __forceinline__ void scan_local16(const bf16* lap, const bf16* bbp, f32x4 (&S)[2], f32x4 (&H)[2]) {
    S[0] = S[1] = H[0] = H[1] = (f32x4){0.f, 0.f, 0.f, 0.f};
#pragma unroll
    for (int i0 = 0; i0 < 16; i0 += 8) { v4u lw[8], bw[8];
#pragma unroll
        for (int i = 0; i < 8; ++i) { lw[i] = *(const v4u*)(lap + (size_t)(i0 + i) * DRNN); bw[i] = *(const v4u*)(bbp + (size_t)(i0 + i) * DRNN); }
#pragma unroll
        for (int i = 0; i < 8; ++i) { f32x4 l[2], bq[2]; pg8::unpack8(lw[i], l[0], l[1]); pg8::unpack8(bw[i], bq[0], bq[1]);
#pragma unroll
            for (int n = 0; n < 2; ++n)
#pragma unroll
                for (int j = 0; j < 4; ++j) { H[n][j] = __expf(l[n][j]) * H[n][j] + bq[n][j]; S[n][j] += l[n][j]; } } }
}

__device__ __forceinline__ void conv_item(const bf16* UR, bf16* V, const float* convw, const float* convb, int t0, int co) {
    const int tl = t0 & (SEQ - 1);
    const bf16* src = UR + (size_t)t0 * DRNN + co * 8; bf16* dst = V + (size_t)t0 * 1536 + co * 8;
    const float* cw = convw + co * 8; const float* cb = convb + co * 8;
    v4u rw[11];
#pragma unroll
    for (int k = 0; k < 11; ++k) rw[k] = (k >= 3 || tl != 0) ? *(const v4u*)(src + (ptrdiff_t)(k - 3) * DRNN) : (v4u){0u, 0u, 0u, 0u};
    f32x4 w0[2], w1[2], w2[2], w3[2], bb[2];
#pragma unroll
    for (int n = 0; n < 2; ++n) { w0[n] = *(const f32x4*)(cw + 4 * n); w1[n] = *(const f32x4*)(cw + 1024 + 4 * n); w2[n] = *(const f32x4*)(cw + 2048 + 4 * n); w3[n] = *(const f32x4*)(cw + 3072 + 4 * n); bb[n] = *(const f32x4*)(cb + 4 * n); }
#pragma unroll
    for (int i = 0; i < 8; ++i) { f32x4 a[2], b[2], c[2], d[2]; pg8::unpack8(rw[i], a[0], a[1]); pg8::unpack8(rw[i + 1], b[0], b[1]); pg8::unpack8(rw[i + 2], c[0], c[1]); pg8::unpack8(rw[i + 3], d[0], d[1]);
        *(v4u*)(dst + (size_t)i * 1536) = pg8::pack8(bb[0] + w0[0] * a[0] + w1[0] * b[0] + w2[0] * c[0] + w3[0] * d[0], bb[1] + w0[1] * a[1] + w1[1] * b[1] + w2[1] * c[1] + w3[1] * d[1]); }
}
__device__ __forceinline__ void pool_witem(const bf16* UP, bf16* POOLED, int g, int tblk, int lane) {
    const int t0 = tblk + (lane >> 4) * 8, co = g * 16 + (lane & 15);
    const bf16* src = UP + (size_t)t0 * DPOOL + co * 8; bf16* dst = POOLED + (size_t)t0 * DPOOL + co * 8; const int tl = t0 & (SEQ - 1);
    if (g == 0) pool_item<2>(src, dst, tl); else if (g == 1) pool_item<4>(src, dst, tl); else if (g == 2) pool_item<8>(src, dst, tl); else pool_item<16>(src, dst, tl);
}

__global__ void __launch_bounds__(NTHR, 2) fwd_kernel(Args args) {
    extern __shared__ __attribute__((aligned(16))) unsigned char lds_raw[];
    LAS unsigned char* lds = (LAS unsigned char*)lds_raw;
    const int tid = threadIdx.x, lane = tid & 63, wave = __builtin_amdgcn_readfirstlane(tid >> 6);
    const int G = gridDim.x, bx = blockIdx.x;
    unsigned char* ws = args.ws;
    const int lo = args.ph_lo, hi = args.ph_hi;
#ifndef PHASE_MASK
#define PHASE_MASK 0x7ff
#endif
#define IN(k) (((PHASE_MASK >> (k)) & 1) && lo <= (k) && (k) < hi)
#ifndef REPEAT_MASK
#define REPEAT_MASK 0
#endif
#define REPS(k) (((REPEAT_MASK >> (k)) & 1) ? 2 : 1)
#ifndef PROBE_PHASE
#define PROBE_PHASE -1
#endif
#define PROBE_MULT 4
    unsigned long long tp0 = 0, tp1 = 0;
#define TSTART(k) do { if ((k) == PROBE_PHASE) tp0 = __builtin_amdgcn_s_memrealtime(); } while (0)
#define TEND(k) do { if ((k) == PROBE_PHASE) tp1 = __builtin_amdgcn_s_memrealtime(); } while (0)
#define GSYNC() xcd_barrier(bar)
#define SEAM(k) do { if (IN(k) && IN((k) + 1)) { GSYNC(); } } while (0)

    const float* x = args.in[I_X];
    bf16* WIN = (bf16*)(ws + WS_WIN); bf16* WFI = (bf16*)(ws + WS_WFI); bf16* WFO = (bf16*)(ws + WS_WFO); bf16* WCAT = (bf16*)(ws + WS_WCAT);
    bf16* WO = (bf16*)(ws + WS_WO); bf16* WGRP = (bf16*)(ws + WS_WGRP); bf16* WGATE = (bf16*)(ws + WS_WGATE);
    bf16* XN = (bf16*)(ws + WS_R1); bf16* X1B = XN;
    bf16* CAT = (bf16*)(ws + WS_CAT); bf16* V = CAT + 512;
    bf16* UP = (bf16*)(ws + WS_R2);
    bf16* UR = (bf16*)(ws + WS_R3); bf16* LA = UR;
    bf16* UG = (bf16*)(ws + WS_R4);
    bf16* POOLED = (bf16*)(ws + WS_R7); bf16* BB = (bf16*)(ws + WS_R8);
    bf16* MIXB = (bf16*)(ws + WS_MIXB); bf16* ACT = (bf16*)(ws + WS_ACT);
    float* SSQ = (float*)(ws + WS_SSQ); float* CS = (float*)(ws + WS_CS); float* CH = (float*)(ws + WS_CH);
    bf16* G0 = (bf16*)args.out; bf16* G1 = G0 + (size_t)M * 1024;
    float* X1 = args.out;

#ifndef EXTRA_SYNCS
#define EXTRA_SYNCS 0
#endif
    if (PROBE_PHASE == 99) tp0 = __builtin_amdgcn_s_memrealtime();
    volatile LAS unsigned* MISC = (volatile LAS unsigned*)(lds + 131072 + 1024);
    if (tid < 32) MISC[tid] = 0u;
    __syncthreads();
    XcdBarrier bar = xcd_barrier_post((unsigned*)ws, MISC + 8);
    if (lo < 0) cg::this_grid().sync();
    for (int i = 0; i < EXTRA_SYNCS; ++i) GSYNC();
    TSTART(0);
    if (IN(0)) for (int rep = 0; rep < REPS(0); ++rep) { if (rep) GSYNC();
        LAS float* scr = (LAS float*)(lds + wave * 16384);
        const int gw = bx * NWAVES + wave, NGW = G * NWAVES;
        constexpr int I_IN = 16 * (DIN / 32), I_FI = 16 * (2 * DFF / 32), I_FO = (DFF / 64) * (D / 32), I_RO = 16 * 32, I_WO = 16 * 32, I_PO = 8 * 32;
        constexpr int NITEMS = I_IN + I_FI + I_FO + I_RO + I_WO + I_PO;
        for (int it = gw; it < NITEMS; it += NGW) {
            int r = it;
            if (r < I_IN) { const int nblk = DIN / 32, kb = r / nblk, nb = r % nblk, nd = 32 * nb; int ns = nd;
                if (nd >= 2560) { const int q = nd - 2560, pq = q >> 8, j0 = q & 255; ns = 2560 + (j0 < 128 ? 128 * pq + j0 : 1024 + 128 * pq + (j0 - 128)); }
                transpose_item(args.in[I_W_IN], DIN, D, WIN, 64 * kb, ns, nd, args.in[I_NORM_MIX], scr, lane); continue; } r -= I_IN;
            if (r < I_FI) { const int nblk = 2 * DFF / 32, kb = r / nblk, nb = r % nblk, nd = 32 * nb, pn = nd >> 8, j0 = nd & 255;
                const int ns = j0 < 128 ? 128 * pn + j0 : DFF + 128 * pn + (j0 - 128);
                transpose_item(args.in[I_W_FFN_IN], 2 * DFF, D, WFI, 64 * kb, ns, nd, args.in[I_NORM_FFN], scr, lane); continue; } r -= I_FI;
            if (r < I_FO) { if (G != 256) { const int nblk = D / 32, kb = r / nblk, nb = r % nblk; transpose_item(args.in[I_W_FFN_OUT], D, DFF, WFO, 64 * kb, 32 * nb, 32 * nb, nullptr, scr, lane); } continue; } r -= I_FO;
            if (r < I_RO) { const int nblk = D / 32, kb = r / nblk, nb = r % nblk; transpose_item(args.in[I_W_RNN_OUT], D, 1536, WCAT + 512, 64 * kb, 32 * nb, 32 * nb, nullptr, scr, lane); continue; } r -= I_RO;
            if (r < I_WO) { const int nblk = D / 32, kb = r / nblk, nb = r % nblk; transpose_item(args.in[I_W_O], D, D, WO, 64 * kb, 32 * nb, 32 * nb, nullptr, scr, lane); continue; } r -= I_WO;
            { const int nblk = D / 32, kb = r / nblk, nb = r % nblk; transpose_item(args.in[I_W_POOL_OUT], D, 1536, WCAT, 64 * kb, 32 * nb, 32 * nb, nullptr, scr, lane); }
        }
        {
            const int gt = bx * NTHR + tid, NT = G * NTHR;
            const float* wg = args.in[I_W_GRP];
            for (int e = gt; e < 512 * 32; e += NT) { const int n = e >> 5, kc = (e & 31) * 8, g = n >> 7, nn = n & 127; float v[8];
#pragma unroll
                for (int j = 0; j < 8; ++j) { const int kk = kc + j - (g & 1) * 128; v[j] = (kk >= 0 && kk < 128) ? wg[((size_t)g * 128 + kk) * 128 + nn] : 0.f; }
                v4u o; o.x = cvt_pk_bf16(v[0], v[1]); o.y = cvt_pk_bf16(v[2], v[3]); o.z = cvt_pk_bf16(v[4], v[5]); o.w = cvt_pk_bf16(v[6], v[7]);
                *(v4u*)(WGRP + (size_t)n * 256 + kc) = o; }
            const float* wa = args.in[I_W_RG_A]; const float* wx = args.in[I_W_RG_X];
            for (int e = gt; e < 2048 * 16; e += NT) { const int n = e >> 4, kc = (e & 15) * 8, h = n >> 8, j = n & 255; const float* src = j < 128 ? wa : wx; const int jj = j & 127; float v[8];
#pragma unroll
                for (int q = 0; q < 8; ++q) v[q] = src[((size_t)h * 128 + kc + q) * 128 + jj];
                v4u o; o.x = cvt_pk_bf16(v[0], v[1]); o.y = cvt_pk_bf16(v[2], v[3]); o.z = cvt_pk_bf16(v[4], v[5]); o.w = cvt_pk_bf16(v[6], v[7]);
                *(v4u*)(WGATE + (size_t)n * 128 + kc) = o; }
        }
        { const int gt = bx * NTHR + tid; if (gt < DRNN) { const float z = -args.in[I_LAMBDA][gt]; ((float*)(ws + WS_SP8))[gt] = -8.0f * (fmaxf(z, 0.f) + log1pf(expf(-fabsf(z)))); } }
        float* RSI = (float*)(ws + WS_RSI);
        for (int m = gw; m < M; m += 2 * NGW) {
            const int m1 = (m + NGW < M) ? m + NGW : m;
            const f32x4* xr0 = (const f32x4*)(x + (size_t)m * D) + lane; const f32x4* xr1 = (const f32x4*)(x + (size_t)m1 * D) + lane; f32x4 v0[4], v1[4]; float s0 = 0.f, s1 = 0.f;
#pragma unroll
            for (int j = 0; j < 4; ++j) { v0[j] = xr0[64 * j]; v1[j] = xr1[64 * j]; }
#pragma unroll
            for (int j = 0; j < 4; ++j) { s0 += (v0[j].x * v0[j].x + v0[j].y * v0[j].y) + (v0[j].z * v0[j].z + v0[j].w * v0[j].w); s1 += (v1[j].x * v1[j].x + v1[j].y * v1[j].y) + (v1[j].z * v1[j].z + v1[j].w * v1[j].w); }
            const float q0 = sqrtf(wave_sum(s0) * (1.f / D) + EPS), q1 = sqrtf(wave_sum(s1) * (1.f / D) + EPS), rs0 = 1.0f / q0, rs1 = 1.0f / q1;
            if (lane == 0) { RSI[m] = q0; RSI[m1] = q1; }
            v2u* o0 = (v2u*)(XN + (size_t)m * D) + lane; v2u* o1 = (v2u*)(XN + (size_t)m1 * D) + lane;
#pragma unroll
            for (int j = 0; j < 4; ++j) { const f32x4 y0 = v0[j] * rs0, y1 = v1[j] * rs1; v2u w0, w1; w0.x = cvt_pk_bf16(y0.x, y0.y); w0.y = cvt_pk_bf16(y0.z, y0.w); w1.x = cvt_pk_bf16(y1.x, y1.y); w1.y = cvt_pk_bf16(y1.z, y1.w); o0[64 * j] = w0; o1[64 * j] = w1; }
        }
        __syncthreads();
    }
    SEAM(0);
    TEND(0);

    TSTART(1);
    if (IN(1)) for (int rep = 0; rep < REPS(1); ++rep) { if (rep) GSYNC();
        pg8::Gemm g{XN, WIN, M, 4096, D, D, D, 0, 0}; pg8::StaticOrder S; S.init(M, 4096, G, bx);
        pg8::EpiProj E{UP, UR, UG, G0, G1, 0};
        pg8::gemm_phase<pg8::EpiProj, true>(lds, g, S, E);
    }
    SEAM(1);
    TEND(1);

    TSTART(2);
    if (IN(2) && G != 256) for (int rep = 0; rep < REPS(2); ++rep) { if (rep) GSYNC();
        { const int gw = bx * NWAVES + wave, NGW = G * NWAVES;
          for (int wi = gw; wi < (M / 32) * 4; wi += NGW) pool_witem(UP, POOLED, wi & 3, (wi >> 2) * 32, lane); }
        { const int gt = bx * NTHR + tid, NT = G * NTHR;
          for (int it = gt; it < (M / 8) * 128; it += NT) conv_item(UR, V, args.in[I_CONV_W], args.in[I_CONV_B], (it >> 7) * 8, it & 127); }
    }
    if (G != 256)     SEAM(2);
    TEND(2);

    TSTART(3);
    if (IN(3)) for (int rep = 0; rep < REPS(3); ++rep) { if (rep) GSYNC();
        const bool fusedp2 = (G == 256);
        if (fusedp2) {
            { pg8::StaticOrder Sg; Sg.init(M, 512, G, (bx + G / 2) % G); pg8::Unit u;
              if (Sg.next(0, u)) { for (int wi = wave; wi < 16; wi += NWAVES) pool_witem(UP, POOLED, 2 * u.pn + (wi & 1), u.pm * 256 + (wi >> 1) * 32, lane); } }
            { pg8::StaticOrder Sv; Sv.init(M, 2048, G, bx); Sv.lin_base = bx * 2; Sv.lin_cnt = 2;
              for (int i = 0; i < 2; ++i) { pg8::Unit u; if (Sv.next(i, u)) conv_item(UR, V, args.in[I_CONV_W], args.in[I_CONV_B], u.pm * 256 + (tid >> 4) * 8, u.pn * 16 + (tid & 15)); } }
            asm volatile("s_waitcnt vmcnt(0)" ::: "memory"); __syncthreads();
        }
        {
          pg8::Gemm g{XN, WIN + (size_t)4096 * D, M, 512, D, D, D, 0, 0}; pg8::StaticOrder S; S.init(M, 512, G, bx);
          pg8::EpiProj E{UP, UR, UG, G0, G1, 16};
          pg8::gemm_phase<pg8::EpiProj, true>(lds, g, S, E); }
        { pg8::Gemm g{POOLED, WGRP, M, 512, 256, 512, 256, 0, 256}; pg8::StaticOrder S; S.init(M, 512, G, (bx + G / 2) % G);
          pg8::EpiGrp E{CAT, 1536, args.in[I_POOL_SCALE]};
          pg8::gemm_phase<pg8::EpiGrp, true>(lds, g, S, E); }
        { pg8::Gemm g{V, WGATE, M, 2048, 128, 1536, 128, 0, 128}; pg8::StaticOrder S; S.init(M, 2048, G, bx);
          if (fusedp2) { S.lin_base = bx * 2; S.lin_cnt = 2; }
          pg8::EpiGate E{V, LA, BB, args.in[I_B_RG_A], args.in[I_B_RG_X], (const float*)(ws + WS_SP8)};
          pg8::gemm_phase<pg8::EpiGate, true>(lds, g, S, E); }
    }
    SEAM(3);
    TEND(3);

    TSTART(4);
    TEND(4);

    TSTART(5);
    if (IN(5)) for (int rep = 0; rep < REPS(5); ++rep) { if (rep) GSYNC();
        LAS float* PAS = (LAS float*)lds; LAS float* PAH = PAS + 8 * 512; LAS float* PBS = PAH + 8 * 512; LAS float* PBH = PBS + 8 * 512;
        unsigned* flags = (unsigned*)ws + 8192;
        for (int bi = bx; bi < NB * SCAN_NC * 2; bi += G) { const int hh = bi & 1, c = (bi >> 1) % SCAN_NC, b = bi / (2 * SCAN_NC);
            const size_t off = ((size_t)b * SEQ + (size_t)c * SCAN_T + wave * 16) * DRNN + hh * 512 + lane * 8;
            v4u lwk[16], bwk[16];
#pragma unroll
            for (int i = 0; i < 16; ++i) { lwk[i] = *(const v4u*)(LA + off + (size_t)i * DRNN); bwk[i] = *(const v4u*)(BB + off + (size_t)i * DRNN); }
            { f32x4 S[2] = {{0.f, 0.f, 0.f, 0.f}, {0.f, 0.f, 0.f, 0.f}}, H[2] = {{0.f, 0.f, 0.f, 0.f}, {0.f, 0.f, 0.f, 0.f}};
#pragma unroll
              for (int i = 0; i < 16; ++i) { f32x4 l[2], bq[2]; pg8::unpack8(lwk[i], l[0], l[1]); pg8::unpack8(bwk[i], bq[0], bq[1]);
#pragma unroll
                  for (int n = 0; n < 2; ++n)
#pragma unroll
                      for (int j = 0; j < 4; ++j) { H[n][j] = __expf(l[n][j]) * H[n][j] + bq[n][j]; S[n][j] += l[n][j]; } }
              *(LAS f32x4*)(PBS + wave * 512 + lane * 8) = S[0]; *(LAS f32x4*)(PBS + wave * 512 + lane * 8 + 4) = S[1];
              *(LAS f32x4*)(PBH + wave * 512 + lane * 8) = H[0]; *(LAS f32x4*)(PBH + wave * 512 + lane * 8 + 4) = H[1]; }
#pragma unroll
            for (int i = 0; i < 16; ++i) asm volatile("" : "+v"(lwk[i]), "+v"(bwk[i]));
            __syncthreads();
            { float h = 0.f, st = 0.f;
#pragma unroll
              for (int sb = 0; sb < 8; ++sb) { const float sv = PBS[sb * 512 + tid]; h = __expf(sv) * h + PBH[sb * 512 + tid]; st += sv; }
              const size_t co = ((size_t)b * SCAN_NC + c) * DRNN + hh * 512 + tid;
              __hip_atomic_store(CS + co, st, __ATOMIC_RELAXED, __HIP_MEMORY_SCOPE_AGENT); __hip_atomic_store(CH + co, h, __ATOMIC_RELAXED, __HIP_MEMORY_SCOPE_AGENT); }
            asm volatile("s_waitcnt vmcnt(0)" ::: "memory");
            __syncthreads();
            if (tid == 0) __hip_atomic_store(flags + ((b * 2 + hh) * SCAN_NC + c) * 16, 1u, __ATOMIC_RELAXED, __HIP_MEMORY_SCOPE_AGENT);
            { f32x4 S[2] = {{0.f, 0.f, 0.f, 0.f}, {0.f, 0.f, 0.f, 0.f}}, H[2] = {{0.f, 0.f, 0.f, 0.f}, {0.f, 0.f, 0.f, 0.f}};
              if (wave * 4 < c) {
                  for (int q = 0; q < 4; ++q) { const int cc = wave * 4 + q; if (cc < c) { unsigned* f = flags + ((b * 2 + hh) * SCAN_NC + cc) * 16; unsigned sp = 0;
                      while ((unsigned)__builtin_amdgcn_readfirstlane(__hip_atomic_load(f, __ATOMIC_RELAXED, __HIP_MEMORY_SCOPE_AGENT)) == 0u) { __builtin_amdgcn_s_sleep(1); if (++sp > (1u << 20)) break; } } }
                  __builtin_amdgcn_fence(__ATOMIC_ACQUIRE, "agent");
#pragma unroll
                  for (int q0 = 0; q0 < 4; q0 += 2) { f32x4 cs[2][2], ch[2][2];
#pragma unroll
                      for (int q = 0; q < 2; ++q) { const int cc = wave * 4 + q0 + q; const size_t co = ((size_t)b * SCAN_NC + (cc < c ? cc : 0)) * DRNN + hh * 512 + lane * 8;
                          cs[q][0] = *(const f32x4*)(CS + co); cs[q][1] = *(const f32x4*)(CS + co + 4); ch[q][0] = *(const f32x4*)(CH + co); ch[q][1] = *(const f32x4*)(CH + co + 4); }
#pragma unroll
                      for (int q = 0; q < 2; ++q) { if (wave * 4 + q0 + q < c) {
#pragma unroll
                          for (int n = 0; n < 2; ++n)
#pragma unroll
                              for (int j = 0; j < 4; ++j) { H[n][j] = __expf(cs[q][n][j]) * H[n][j] + ch[q][n][j]; S[n][j] += cs[q][n][j]; } } }
                      asm volatile("" ::: "memory"); }
              }
              *(LAS f32x4*)(PAS + wave * 512 + lane * 8) = S[0]; *(LAS f32x4*)(PAS + wave * 512 + lane * 8 + 4) = S[1];
              *(LAS f32x4*)(PAH + wave * 512 + lane * 8) = H[0]; *(LAS f32x4*)(PAH + wave * 512 + lane * 8 + 4) = H[1]; }
            __syncthreads();
            f32x4 h[2] = {{0.f, 0.f, 0.f, 0.f}, {0.f, 0.f, 0.f, 0.f}};
#pragma unroll
            for (int sb = 0; sb < 8; ++sb) {
#pragma unroll
                for (int n = 0; n < 2; ++n) { const f32x4 sv = *(const LAS f32x4*)(PAS + sb * 512 + lane * 8 + 4 * n), hv = *(const LAS f32x4*)(PAH + sb * 512 + lane * 8 + 4 * n);
#pragma unroll
                    for (int j = 0; j < 4; ++j) h[n][j] = __expf(sv[j]) * h[n][j] + hv[j]; } }
            for (int sb = 0; sb < wave; ++sb) {
#pragma unroll
                for (int n = 0; n < 2; ++n) { const f32x4 sv = *(const LAS f32x4*)(PBS + sb * 512 + lane * 8 + 4 * n), hv = *(const LAS f32x4*)(PBH + sb * 512 + lane * 8 + 4 * n);
#pragma unroll
                    for (int j = 0; j < 4; ++j) h[n][j] = __expf(sv[j]) * h[n][j] + hv[j]; } }
            const bf16* ugp = UG + off;
            bf16* hgp = CAT + ((size_t)b * SEQ + (size_t)c * SCAN_T + wave * 16) * 1536 + 512 + hh * 512 + lane * 8;
            v4u gwk[16];
#pragma unroll
            for (int i = 0; i < 16; ++i) gwk[i] = *(const v4u*)(ugp + (size_t)i * DRNN);
#pragma unroll
            for (int i0 = 0; i0 < 16; i0 += 8) { const v4u* gw8 = gwk + i0;
#pragma unroll
                for (int i = 0; i < 8; ++i) { f32x4 l[2], bq[2], gq[2], o[2]; pg8::unpack8(lwk[i0 + i], l[0], l[1]); pg8::unpack8(bwk[i0 + i], bq[0], bq[1]); pg8::unpack8(gw8[i], gq[0], gq[1]);
#pragma unroll
                    for (int n = 0; n < 2; ++n)
#pragma unroll
                        for (int j = 0; j < 4; ++j) { h[n][j] = __expf(l[n][j]) * h[n][j] + bq[n][j]; o[n][j] = h[n][j] * pg8::gelu_tanh_(gq[n][j]); }
                    *(v4u*)(hgp + (size_t)(i0 + i) * 1536) = pg8::pack8(o[0], o[1]); } }
            __syncthreads();
        }
    }
    SEAM(5);
    TEND(5);

    TSTART(6);
    if (IN(6)) for (int rep = 0; rep < REPS(6); ++rep) { if (rep) GSYNC();
        pg8::Gemm g{CAT, WCAT, M, D, 1536, 1536, 1536, 0, 0}; pg8::StaticOrder S; S.init(M, D, G, bx);
        pg8::EpiMix E{G0, G1, MIXB};
        pg8::gemm_phase<pg8::EpiMix, true, 8>(lds, g, S, E);
    }
    SEAM(6);
    TEND(6);

    TSTART(7);
    if (IN(7)) for (int rep = 0; rep < REPS(7); ++rep) { if (rep) GSYNC();
        pg8::Gemm g{MIXB, WO, M, D, D, D, D, 0, 0}; pg8::StaticOrder S; S.init(M, D, G, bx);
        pg8::EpiRes1 E{XN, (const float*)(ws + WS_RSI), X1B, SSQ};
        pg8::gemm_phase<pg8::EpiRes1, true>(lds, g, S, E);
    }
    SEAM(7);
    TEND(7);

    TSTART(8);
    if (IN(8)) for (int rep = 0; rep < REPS(8); ++rep) { if (rep) GSYNC();
        pg8::Gemm g{X1B, WFI, M, 2 * DFF, D, D, D, 0, 0}; pg8::StaticOrder S; S.init(M, 2 * DFF, G, bx);
        LAS float* RSL = (LAS float*)(lds + 133120);
        { const int r = tid & 255;
          for (int i = tid >> 8; i < 8; i += 2) { pg8::Unit u; if (!S.next(i, u)) break;
              const f32x4* sp = (const f32x4*)(SSQ + (size_t)(u.pm * 256 + r) * 16); const f32x4 st = (sp[0] + sp[1]) + (sp[2] + sp[3]);
              RSL[i * 256 + r] = __builtin_amdgcn_rsqf(((st[0] + st[1]) + (st[2] + st[3])) * (1.0f / 1024.0f) + 1e-6f); }
          __syncthreads(); }
        pg8::EpiSwiglu E{RSL, ACT};
        pg8::gemm_phase<pg8::EpiSwiglu, true>(lds, g, S, E);
        if (G == 256 && bx >= 128) {
            LAS float* scr = (LAS float*)(lds + wave * 16384); constexpr int I_FO = (DFF / 64) * (D / 32);
            for (int r = (bx - 128) * NWAVES + wave; r < I_FO; r += 128 * NWAVES) { const int nblk = D / 32, kb = r / nblk, nb = r % nblk;
                transpose_item(args.in[I_W_FFN_OUT], D, DFF, WFO, 64 * kb, 32 * nb, 32 * nb, nullptr, scr, lane); }
        }
    }
    SEAM(8);
    TEND(8);

    TSTART(9);
    if (IN(9)) for (int rep = 0; rep < REPS(9); ++rep) { if (rep) GSYNC();
        pg8::Gemm g{ACT, WFO, M, D, DFF, DFF, DFF, 0, 0}; pg8::StaticOrder S; S.init(M, D, G, bx);
        if (G == 256) { pg8::EpiFinal E{X1B, X1, (float*)(ws + WS_SSQ2), (unsigned*)ws + 4096, args.in[I_NORM_FINAL]};
            pg8::gemm_phase<pg8::EpiFinal, true>(lds, g, S, E); }
        else { pg8::EpiRes2 E{X1B, X1};
            pg8::gemm_phase<pg8::EpiRes2, true>(lds, g, S, E); }
    }
    if (G != 256) SEAM(9);
    TEND(9);

    TSTART(10);
    if (IN(10) && G != 256) for (int rep = 0; rep < REPS(10); ++rep) { if (rep) GSYNC();
        const int gw = bx * NWAVES + wave, NGW = G * NWAVES;
        const float* gf = args.in[I_NORM_FINAL]; f32x4 gv[4];
#pragma unroll
        for (int j = 0; j < 4; ++j) gv[j] = ((const f32x4*)gf)[lane + 64 * j];
        for (int m = gw; m < M; m += NGW) {
            f32x4* xr = (f32x4*)(X1 + (size_t)m * D) + lane; f32x4 v[4]; float s = 0.f;
#pragma unroll
            for (int j = 0; j < 4; ++j) { v[j] = xr[64 * j]; s += (v[j].x * v[j].x + v[j].y * v[j].y) + (v[j].z * v[j].z + v[j].w * v[j].w); }
            const float rs = 1.0f / sqrtf(wave_sum(s) * (1.f / D) + EPS);
#pragma unroll
            for (int j = 0; j < 4; ++j) xr[64 * j] = v[j] * rs * gv[j];
        }
    }
    if (PROBE_PHASE == 10 || PROBE_PHASE == 99) tp1 = __builtin_amdgcn_s_memrealtime();
    if (PROBE_PHASE >= 0 && bx == 0 && tid == 0) { const unsigned long long dt = (tp1 - tp0) * PROBE_MULT, te = __builtin_amdgcn_s_memrealtime(); while (__builtin_amdgcn_s_memrealtime() - te < dt) __builtin_amdgcn_s_sleep(8); }
#undef IN
#undef SEAM
}

extern "C" void kernel_launch(void* const* d_in, const int* in_sizes, int n_in, void* d_out, int out_size, void* d_ws, size_t ws_size, hipStream_t stream) {
    static int grid = 0;
    if (grid == 0) {
        if (n_in != 19 || out_size != M * D || ws_size < WS_END) { fprintf(stderr, "kernel_launch: unexpected shapes (n_in %d out %d ws %zu)\n", n_in, out_size, ws_size); grid = -1; return; }
        int dev = 0, cus = 0, per_cu = 0;
        hipGetDevice(&dev);
        hipDeviceGetAttribute(&cus, hipDeviceAttributeMultiprocessorCount, dev);
        if (hipFuncSetAttribute((const void*)fwd_kernel, hipFuncAttributeMaxDynamicSharedMemorySize, LDS_BYTES) != hipSuccess) { fprintf(stderr, "kernel_launch: hipFuncSetAttribute failed\n"); grid = -1; return; }
        if (hipOccupancyMaxActiveBlocksPerMultiprocessor(&per_cu, (const void*)fwd_kernel, NTHR, LDS_BYTES) != hipSuccess || per_cu < 1) { fprintf(stderr, "kernel_launch: occupancy query says %d\n", per_cu); per_cu = 1; }
        (void)hipGetLastError();
        grid = cus * 1;
        fprintf(stderr, "kernel_launch: grid %d (cus %d, per_cu %d)\n", grid, cus, per_cu);
    }
    if (grid < 0) return;
    if (hipMemsetAsync(d_ws, 0, 49152, stream) != hipSuccess) { fprintf(stderr, "kernel_launch: memset failed\n"); return; }
    Args a{};
    for (int i = 0; i < 19; ++i) a.in[i] = (const float*)d_in[i];
    a.out = (float*)d_out; a.ws = (unsigned char*)d_ws;
#if MK_PER_PHASE
    for (int p = 0; p < NPH; ++p) { a.ph_lo = p; a.ph_hi = p + 1; hipLaunchKernelGGL(fwd_kernel, dim3(grid), dim3(NTHR), LDS_BYTES, stream, a); }
#else
    a.ph_lo = 0; a.ph_hi = NPH;
    void* kargs[] = {&a};
    hipError_t e = hipLaunchCooperativeKernel((const void*)fwd_kernel, dim3(grid), dim3(NTHR), kargs, LDS_BYTES, stream);
    if (e != hipSuccess) fprintf(stderr, "cooperative launch failed: %s (grid %d)\n", hipGetErrorString(e), grid);
#endif
}
```

```cpp
#include <hip/hip_runtime.h>
#include <hip/hip_cooperative_groups.h>
#include <cstdio>
#include <cstdint>
namespace cg = cooperative_groups;

#ifndef MK_PER_PHASE
#define MK_PER_PHASE 0
#endif

namespace pg8 {
#define PG8_LAS __attribute__((address_space(3)))
typedef unsigned short bf16_t;
typedef short bf16x8 __attribute__((ext_vector_type(8)));
typedef float f32x4 __attribute__((ext_vector_type(4)));
typedef float f32x2 __attribute__((ext_vector_type(2)));
typedef unsigned u32x4 __attribute__((ext_vector_type(4)));
typedef unsigned u32x2 __attribute__((ext_vector_type(2)));
constexpr int BM = 256, BK = 64, HALF = 128, HTB = HALF * BK * 2, STAGE_BYTES = 8 * HTB, NXCD = 8, WGM = 8;

__host__ __device__ __forceinline__ int lds_byte(int r, int c) { const int st = (r >> 4) * 2 + (c >> 5), rr = r & 15, cc = c & 31, ob = rr * 64 + cc * 2; return st * 1024 + (ob ^ (((ob >> 9) & 1) << 5)); }
__host__ __device__ __forceinline__ void stage_rc(int b, int& R, int& C) { const int st = b / 1024, sb = b % 1024, swz = sb ^ (((sb >> 9) & 1) << 5); R = (st >> 1) * 16 + swz / 64; C = (st & 1) * 32 + (swz % 64) / 2; }
__host__ __device__ __forceinline__ int perm32(int rho) { const int n = rho >> 4, i = rho & 15; return 8 * (i >> 2) + 4 * n + (i & 3); }

struct Unit { int pm, pn, rh, idx; };
struct Gemm { const bf16_t* A; const bf16_t* Bt; int M, N, K, lda, ldb, ash, amul; };

struct StaticOrder {
    int nM, nN, nwg, G, c, limit, lin_base, lin_cnt;
    __host__ __device__ __forceinline__ void init(int M, int N, int G_, int c_) { nM = M / BM; nN = N / BM; nwg = nM * nN; G = G_; c = c_; limit = nwg; lin_base = 0; lin_cnt = -1; }
    __host__ __device__ __forceinline__ void map(int L, Unit& u) const {
        int wgid = L; { const int q = nwg / NXCD, r = nwg % NXCD, xcd = wgid % NXCD, off = wgid / NXCD; wgid = (xcd < r ? xcd * (q + 1) : r * (q + 1) + (xcd - r) * q) + off; }
        const int nig = WGM * nN, gid = wgid / nig, fm = gid * WGM, gsz = (nM - fm) < WGM ? (nM - fm) : WGM;
        u.pm = fm + ((wgid % nig) % gsz); u.pn = (wgid % nig) / gsz; u.rh = 0;
    }
    __host__ __device__ __forceinline__ bool next(int i, Unit& u) const {
        u.idx = i;
        if (lin_cnt >= 0) { if (i >= lin_cnt) return false; map(lin_base + i, u); return true; }
        const long L = (long)i * G + c; if (L >= limit) return false;
        map((int)L, u); return true;
    }
};

__device__ __forceinline__ unsigned cvt_pk_bf16(float lo, float hi) { unsigned r; asm volatile("v_cvt_pk_bf16_f32 %0, %1, %2" : "=v"(r) : "v"(lo), "v"(hi)); return r; }
__device__ __forceinline__ float bf_lo(unsigned w) { return __uint_as_float(w << 16); }
__device__ __forceinline__ float bf_hi(unsigned w) { return __uint_as_float(w & 0xffff0000u); }
__device__ __forceinline__ float sigmoidf_(float x) { return __builtin_amdgcn_rcpf(1.0f + __expf(-x)); }
__device__ __forceinline__ float gelu_tanh_(float x) { const float z = 1.5957691216057308f * (x + 0.044715f * x * x * x); return x * sigmoidf_(z); }
__device__ __forceinline__ u32x4 pack8(const f32x4 a, const f32x4 b) { u32x4 w; w.x = cvt_pk_bf16(a[0], a[1]); w.y = cvt_pk_bf16(a[2], a[3]); w.z = cvt_pk_bf16(b[0], b[1]); w.w = cvt_pk_bf16(b[2], b[3]); return w; }
__device__ __forceinline__ void unpack8(const u32x4 w, f32x4& a, f32x4& b) { a = (f32x4){bf_lo(w.x), bf_hi(w.x), bf_lo(w.y), bf_hi(w.y)}; b = (f32x4){bf_lo(w.z), bf_hi(w.z), bf_lo(w.w), bf_hi(w.w)}; }

#define EPI_ROWS_BEGIN _Pragma("unroll") for (int ai = 0; ai < NAI; ++ai) _Pragma("unroll") for (int m = 0; m < 4; ++m) { const int row = u.pm * BM + u.rh + ai * HALF + wr * 64 + m * 16 + fr;
#define EPI_ROWS_END }

struct EpiProj {
    bf16_t *UP, *UR, *UG, *RB, *G1; int pn_off;
    template <int NAI> __device__ __forceinline__ void run(const f32x4 (&acc)[2][2][4][2], const Unit& u, int wr, int wc, int fr, int fq) const {
        const int pn = u.pn + pn_off;
        if (pn < 10) {
            bf16_t* base; int ldc, colt;
            if (pn < 2) { base = UP; ldc = 512; colt = pn * 256; }
            else if (pn < 6) { base = UR; ldc = 1024; colt = (pn - 2) * 256; }
            else { base = UG; ldc = 1024; colt = (pn - 6) * 256; }
            const int col0 = colt + wc * 32 + 8 * fq;
            EPI_ROWS_BEGIN
                bf16_t* rowp = base + (unsigned)((unsigned)row * (unsigned)ldc + (unsigned)col0);
#pragma unroll
                for (int bj = 0; bj < 2; ++bj) *(u32x4*)(rowp + bj * HALF) = pack8(acc[ai][bj][m][0], acc[ai][bj][m][1]);
            EPI_ROWS_END
        } else {
            const int ch0 = (pn - 10) * 128 + wc * 32 + 8 * fq;
            EPI_ROWS_BEGIN
                const unsigned off = (unsigned)row * 1024u + (unsigned)ch0; f32x4 rr[2], gg[2];
#pragma unroll
                for (int n = 0; n < 2; ++n)
#pragma unroll
                    for (int j = 0; j < 4; ++j) { const float d0 = 1.0f + fminf(__expf(-acc[ai][0][m][n][j]), 1e18f), d1 = 1.0f + fminf(__expf(-acc[ai][1][m][n][j]), 1e18f);
                        const float q = __builtin_amdgcn_rcpf(d0 * d1); gg[n][j] = d0 * q; rr[n][j] = d1 * d1 * q; }
                *(u32x4*)(RB + off) = pack8(rr[0], rr[1]); *(u32x4*)(G1 + off) = pack8(gg[0], gg[1]);
            EPI_ROWS_END
        }
    }
};
struct EpiGrp {
    bf16_t* O; int ldc; const float* scale;
    template <int NAI> __device__ __forceinline__ void run(const f32x4 (&acc)[2][2][4][2], const Unit& u, int wr, int wc, int fr, int fq) const {
        const int col0 = u.pn * BM + wc * 32 + 8 * fq;
        f32x4 sc[2][2];
#pragma unroll
        for (int bj = 0; bj < 2; ++bj)
#pragma unroll
            for (int n = 0; n < 2; ++n) sc[bj][n] = *(const f32x4*)(scale + col0 + bj * HALF + 4 * n);
        EPI_ROWS_BEGIN
            bf16_t* rowp = O + (unsigned)((unsigned)row * (unsigned)ldc + (unsigned)col0);
#pragma unroll
            for (int bj = 0; bj < 2; ++bj) *(u32x4*)(rowp + bj * HALF) = pack8(acc[ai][bj][m][0] * sc[bj][0], acc[ai][bj][m][1] * sc[bj][1]);
        EPI_ROWS_END
    }
};
struct EpiGate {
    const bf16_t* V; bf16_t *LA, *BB; const float *b_a, *b_x, *sp8;
    template <int NAI, bool EXACT> __device__ __forceinline__ void rows(const f32x4 (&acc)[2][2][4][2], const Unit& u, int wr, int fr, int ch0, const f32x4 (&ba)[2], const f32x4 (&bx)[2], const f32x4 (&sp)[2]) const {
        u32x4 vwk[2][4];
        EPI_ROWS_BEGIN
            vwk[ai][m] = *(const u32x4*)(V + ((unsigned)row * 1536u + (unsigned)ch0));
        EPI_ROWS_END
        EPI_ROWS_BEGIN
            const unsigned off = (unsigned)row * 1024u + (unsigned)ch0;
            f32x4 vv[2]; unpack8(vwk[ai][m], vv[0], vv[1]);
            f32x4 la[2], bb[2];
#pragma unroll
            for (int n = 0; n < 2; ++n)
#pragma unroll
                for (int j = 0; j < 4; ++j) {
                    const float r = sigmoidf_(acc[ai][0][m][n][j] + ba[n][j]), ig = sigmoidf_(acc[ai][1][m][n][j] + bx[n][j]);
                    const float l = sp[n][j] * r, x2 = 2.0f * l;
                    const float poly = x2 * (1.0f + 0.5f * x2 * (1.0f + 0.33333334f * x2 * (1.0f + 0.25f * x2 * (1.0f + 0.2f * x2 * (1.0f + 0.16666667f * x2)))));
                    const float em1 = EXACT ? ((x2 > -0.25f) ? poly : (__expf(x2) - 1.0f)) : poly;
                    la[n][j] = l; bb[n][j] = __builtin_amdgcn_sqrtf(fmaxf(-em1, 0.f)) * ig * vv[n][j]; }
            *(u32x4*)(LA + ((unsigned)row * 1536u + (unsigned)ch0)) = pack8(la[0], la[1]); *(u32x4*)(BB + off) = pack8(bb[0], bb[1]);
        EPI_ROWS_END
    }
    template <int NAI> __device__ __forceinline__ void run(const f32x4 (&acc)[2][2][4][2], const Unit& u, int wr, int wc, int fr, int fq) const {
        const int ch0 = u.pn * 128 + wc * 32 + 8 * fq;
        f32x4 ba[2], bx[2], sp[2]; bool big = false;
#pragma unroll
        for (int n = 0; n < 2; ++n) { ba[n] = *(const f32x4*)(b_a + ch0 + 4 * n); bx[n] = *(const f32x4*)(b_x + ch0 + 4 * n); sp[n] = *(const f32x4*)(sp8 + ch0 + 4 * n);
#pragma unroll
            for (int j = 0; j < 4; ++j) big = big || !(sp[n][j] >= -0.125f); }
        if (__builtin_amdgcn_ballot_w64(big) != 0ull) rows<NAI, true>(acc, u, wr, fr, ch0, ba, bx, sp);
        else rows<NAI, false>(acc, u, wr, fr, ch0, ba, bx, sp);
    }
};
struct EpiMix {
    const bf16_t *RB, *G1; bf16_t* MIXB;
    __device__ __forceinline__ void mid(f32x4 (&acc)[2][2][4][2], const Unit& u0, int wr, int wc, int fr, int fq) const {
        constexpr int NAI = 2; Unit u = u0; asm volatile("" : "+s"(u.pm), "+s"(u.pn));
        const int col0 = u.pn * BM + wc * 32 + 8 * fq;
        u32x4 rw[2][4][2];
        EPI_ROWS_BEGIN
            const unsigned off = (unsigned)row * 1024u + (unsigned)col0;
#pragma unroll
            for (int bj = 0; bj < 2; ++bj) rw[ai][m][bj] = *(const u32x4*)(RB + off + bj * HALF);
        EPI_ROWS_END
        EPI_ROWS_BEGIN
#pragma unroll
            for (int bj = 0; bj < 2; ++bj) { f32x4 r[2]; unpack8(rw[ai][m][bj], r[0], r[1]); acc[ai][bj][m][0] *= r[0]; acc[ai][bj][m][1] *= r[1]; }
            (void)row;
        EPI_ROWS_END
    }
    template <int NAI> __device__ __forceinline__ void run(const f32x4 (&acc)[2][2][4][2], const Unit& u, int wr, int wc, int fr, int fq) const {
        const int col0 = u.pn * BM + wc * 32 + 8 * fq;
        u32x4 gw[2][4][2];
        EPI_ROWS_BEGIN
            const unsigned off = (unsigned)row * 1024u + (unsigned)col0;
#pragma unroll
            for (int bj = 0; bj < 2; ++bj) gw[ai][m][bj] = *(const u32x4*)(G1 + off + bj * HALF);
        EPI_ROWS_END
        EPI_ROWS_BEGIN
            const unsigned off = (unsigned)row * 1024u + (unsigned)col0;
#pragma unroll
            for (int bj = 0; bj < 2; ++bj) { f32x4 g[2]; unpack8(gw[ai][m][bj], g[0], g[1]);
                *(u32x4*)(MIXB + off + bj * HALF) = pack8(g[0] * acc[ai][bj][m][0], g[1] * acc[ai][bj][m][1]); }
        EPI_ROWS_END
    }
};
struct EpiRes1 {
    const bf16_t* XNB; const float* RSI; bf16_t* X1B; float* SSQ;
    template <int NAI> __device__ __forceinline__ void run(const f32x4 (&acc)[2][2][4][2], const Unit& u, int wr, int wc, int fr, int fq) const {
        const int col0 = u.pn * BM + wc * 32 + 8 * fq;
#pragma unroll
        for (int ai = 0; ai < NAI; ++ai) {
            u32x4 xw[4][2]; float qi[4];
#pragma unroll
            for (int m = 0; m < 4; ++m) { const int row = u.pm * BM + u.rh + ai * HALF + wr * 64 + m * 16 + fr; const unsigned off = (unsigned)row * 1024u + (unsigned)col0; qi[m] = RSI[row];
#pragma unroll
                for (int bj = 0; bj < 2; ++bj) xw[m][bj] = *(const u32x4*)(XNB + off + bj * HALF); }
            asm volatile("s_waitcnt vmcnt(0)" ::: "memory");
#pragma unroll
            for (int m = 0; m < 4; ++m) { const int row = u.pm * BM + u.rh + ai * HALF + wr * 64 + m * 16 + fr; const unsigned off = (unsigned)row * 1024u + (unsigned)col0; float ss = 0.f;
#pragma unroll
                for (int bj = 0; bj < 2; ++bj) { f32x4 xa, xb; unpack8(xw[m][bj], xa, xb);
                    const f32x4 a = xa * qi[m] + acc[ai][bj][m][0], b = xb * qi[m] + acc[ai][bj][m][1];
                    *(u32x4*)(X1B + off + bj * HALF) = pack8(a, b);
                    ss += (a[0] * a[0] + a[1] * a[1]) + (a[2] * a[2] + a[3] * a[3]) + (b[0] * b[0] + b[1] * b[1]) + (b[2] * b[2] + b[3] * b[3]); }
                ss += __shfl_xor(ss, 16); ss += __shfl_xor(ss, 32);
                if (fq == 0) SSQ[(unsigned)row * 16u + (unsigned)(u.pn * 4 + wc)] = ss; }
        }
    }
};
struct EpiSwiglu {
    const PG8_LAS float* RSL; bf16_t* ACT;
    template <int NAI> __device__ __forceinline__ void run(const f32x4 (&acc)[2][2][4][2], const Unit& u, int wr, int wc, int fr, int fq) const {
        const int col0 = u.pn * 128 + wc * 32 + 8 * fq;
        const PG8_LAS float* rt = RSL + u.idx * 256 + wr * 64 + fr;
        EPI_ROWS_BEGIN
            const float rs = rt[ai * HALF + m * 16];
            f32x4 o[2];
#pragma unroll
            for (int n = 0; n < 2; ++n)
#pragma unroll
                for (int j = 0; j < 4; ++j) { const float g = acc[ai][0][m][n][j] * rs, up = acc[ai][1][m][n][j] * rs; o[n][j] = g * sigmoidf_(g) * up; }
            __builtin_nontemporal_store(pack8(o[0], o[1]), (u32x4*)(ACT + (unsigned)((unsigned)row * 2816u + (unsigned)col0)));
        EPI_ROWS_END
    }
};
struct EpiRes2 {
    const bf16_t* X1B; float* OUT;
    template <int NAI> __device__ __forceinline__ void run(const f32x4 (&acc)[2][2][4][2], const Unit& u, int wr, int wc, int fr, int fq) const {
        const int col0 = u.pn * BM + wc * 32 + 8 * fq;
        EPI_ROWS_BEGIN
            const unsigned off = (unsigned)row * 1024u + (unsigned)col0;
#pragma unroll
            for (int bj = 0; bj < 2; ++bj) { f32x4 xa, xb; unpack8(*(const u32x4*)(X1B + off + bj * HALF), xa, xb);
                *(f32x4*)(OUT + off + bj * HALF) = xa + acc[ai][bj][m][0]; *(f32x4*)(OUT + off + bj * HALF + 4) = xb + acc[ai][bj][m][1]; }
        EPI_ROWS_END
    }
};

struct EpiFinal {
    const bf16_t* X1B; float* OUT; float* SSQ2; unsigned* cnt; const float* gfin;
    template <int NAI> __device__ __forceinline__ void run(f32x4 (&acc)[2][2][4][2], const Unit& u, int wr, int wc, int fr, int fq) const {
        const int col0 = u.pn * BM + wc * 32 + 8 * fq;
        { u32x4 xw[2][4][2];
          EPI_ROWS_BEGIN
              const unsigned off = (unsigned)row * 1024u + (unsigned)col0;
#pragma unroll
              for (int bj = 0; bj < 2; ++bj) xw[ai][m][bj] = *(const u32x4*)(X1B + off + bj * HALF);
          EPI_ROWS_END
          EPI_ROWS_BEGIN
              float ss = 0.f;
#pragma unroll
              for (int bj = 0; bj < 2; ++bj) { f32x4 xa, xb; unpack8(xw[ai][m][bj], xa, xb);
                  const f32x4 a = xa + acc[ai][bj][m][0], b = xb + acc[ai][bj][m][1]; acc[ai][bj][m][0] = a; acc[ai][bj][m][1] = b;
                  ss += (a[0] * a[0] + a[1] * a[1]) + (a[2] * a[2] + a[3] * a[3]) + (b[0] * b[0] + b[1] * b[1]) + (b[2] * b[2] + b[3] * b[3]); }
              ss += __shfl_xor(ss, 16); ss += __shfl_xor(ss, 32);
              if (fq == 0) __hip_atomic_store(SSQ2 + (unsigned)row * 16u + (unsigned)(u.pn * 4 + wc), ss, __ATOMIC_RELAXED, __HIP_MEMORY_SCOPE_AGENT);
          EPI_ROWS_END }
        asm volatile("s_waitcnt vmcnt(0)" ::: "memory");
        unsigned* c = cnt + 64 * u.pm;
        if ((threadIdx.x & 63) == 0) __hip_atomic_fetch_add(c, 1u, __ATOMIC_RELAXED, __HIP_MEMORY_SCOPE_AGENT);
        f32x4 gv[2][2];
#pragma unroll
        for (int bj = 0; bj < 2; ++bj)
#pragma unroll
            for (int n = 0; n < 2; ++n) gv[bj][n] = *(const f32x4*)(gfin + col0 + bj * HALF + 4 * n);
        { unsigned sp = 0;
          while ((unsigned)__builtin_amdgcn_readfirstlane(__hip_atomic_load(c, __ATOMIC_RELAXED, __HIP_MEMORY_SCOPE_AGENT)) < 32u) { __builtin_amdgcn_s_sleep(2); if (++sp > (1u << 20)) break; } }
        __builtin_amdgcn_fence(__ATOMIC_ACQUIRE, "agent");
        unsigned long long w0[2][4], w1[2][4];
        EPI_ROWS_BEGIN
            const unsigned long long* sl = (const unsigned long long*)(SSQ2 + (unsigned)row * 16u + (unsigned)(4 * fq));
            w0[ai][m] = __hip_atomic_load(sl, __ATOMIC_RELAXED, __HIP_MEMORY_SCOPE_AGENT); w1[ai][m] = __hip_atomic_load(sl + 1, __ATOMIC_RELAXED, __HIP_MEMORY_SCOPE_AGENT);
        EPI_ROWS_END
        EPI_ROWS_BEGIN
            const unsigned off = (unsigned)row * 1024u + (unsigned)col0;
            float sq = (__uint_as_float((unsigned)w0[ai][m]) + __uint_as_float((unsigned)(w0[ai][m] >> 32))) + (__uint_as_float((unsigned)w1[ai][m]) + __uint_as_float((unsigned)(w1[ai][m] >> 32)));
            sq += __shfl_xor(sq, 16); sq += __shfl_xor(sq, 32);
            const float rs = 1.0f / sqrtf(sq * (1.0f / 1024.0f) + 1e-6f);
#pragma unroll
            for (int bj = 0; bj < 2; ++bj) { *(f32x4*)(OUT + off + bj * HALF) = acc[ai][bj][m][0] * rs * gv[bj][0]; *(f32x4*)(OUT + off + bj * HALF + 4) = acc[ai][bj][m][1] * rs * gv[bj][1]; }
        EPI_ROWS_END
    }
};

template <class Epi, bool ALIGN_EPI, int MID_T = -1>
__device__ __forceinline__ void gemm_phase(PG8_LAS unsigned char* lds, const Gemm g, const StaticOrder& S, const Epi& E) {
    const int tid = threadIdx.x, wid = __builtin_amdgcn_readfirstlane(tid >> 6), lane = tid & 63, wr = wid >> 2, wc = wid & 3, fr = lane & 15, fq = lane >> 4;
    int nt = g.K / BK; asm volatile("" : "+s"(nt));
    unsigned voffA[2], voffB[2];
#pragma unroll
    for (int i = 0; i < 2; ++i) { int R, C; stage_rc(tid * 16 + i * 8192, R, C); const int Rb = (R & ~31) + perm32(R & 31);
        voffA[i] = (unsigned)(R * g.lda + C) * 2u; voffB[i] = (unsigned)(Rb * g.ldb + C) * 2u; }
    const size_t kstep = (size_t)(BK * 2);
    const size_t hstepA = (size_t)HALF * g.lda * 2, hstepB = (size_t)HALF * g.ldb * 2;
    const size_t tstepA = 2 * hstepA, tstepB = 2 * hstepB;
    const unsigned ldsw = (unsigned)wid * 1024u;
    const int aoff = lds_byte(wr * 64 + fr, fq * 8), boff = lds_byte(wc * 32 + fr, fq * 8);
#define PG8_SA(b, h) (((b) * 2 + (h)) * HTB)
#define PG8_SB(b, h) ((4 + (b) * 2 + (h)) * HTB)
#define PG8_STAGE(bufoff, gbase, voff) do { _Pragma("unroll") for (int _i = 0; _i < 2; ++_i) \
        __builtin_amdgcn_global_load_lds((const unsigned*)((const char*)(gbase) + (voff)[_i]), (PG8_LAS unsigned*)(lds + (bufoff) + ldsw + _i * 8192), 16, 0, 0); } while (0)
#define PG8_LDA(dst, b, h) do { _Pragma("unroll") for (int m = 0; m < 4; ++m) _Pragma("unroll") for (int k = 0; k < 2; ++k) dst[m][k] = *(const PG8_LAS bf16x8*)(lds + PG8_SA(b, h) + aoff + m * 2048 + k * 1024); } while (0)
#define PG8_LDB(dst, b, h) do { _Pragma("unroll") for (int n = 0; n < 2; ++n) _Pragma("unroll") for (int k = 0; k < 2; ++k) dst[n][k] = *(const PG8_LAS bf16x8*)(lds + PG8_SB(b, h) + boff + n * 2048 + k * 1024); } while (0)
#define PG8_MMA(ai, bj, At, Bt) do { __builtin_amdgcn_s_setprio(1); _Pragma("unroll") for (int m = 0; m < 4; ++m) _Pragma("unroll") for (int n = 0; n < 2; ++n) _Pragma("unroll") for (int k = 0; k < 2; ++k) \
        acc[ai][bj][m][n] = __builtin_amdgcn_mfma_f32_16x16x32_bf16(Bt[n][k], At[m][k], acc[ai][bj][m][n], 0, 0, 0); __builtin_amdgcn_s_setprio(0); } while (0)
#define PG8_WAIT_V(n) asm volatile("s_waitcnt vmcnt(" #n ")" ::: "memory")
#define PG8_WAIT_L(n) asm volatile("s_waitcnt lgkmcnt(" #n ")" ::: "memory")
#define PG8_BAR __builtin_amdgcn_s_barrier()
#define PG8_SCHED __builtin_amdgcn_sched_barrier(0)
    Unit cur, nxt; int ui = 0;
    if (!S.next(0, cur)) return;
    f32x4 acc[2][2][4][2];
#pragma unroll
    for (int a = 0; a < 2; ++a)
#pragma unroll
        for (int b = 0; b < 2; ++b)
#pragma unroll
            for (int m = 0; m < 4; ++m)
#pragma unroll
                for (int n = 0; n < 2; ++n) acc[a][b][m][n] = (f32x4){0.f, 0.f, 0.f, 0.f};
    bf16x8 At[4][2], B0[2][2], B1[2][2];
    const char* cA = (const char*)g.A + (size_t)cur.pm * tstepA + (size_t)((cur.pn >> g.ash) * g.amul) * 2; const char* cB = (const char*)g.Bt + (size_t)cur.pn * tstepB;
    PG8_STAGE(PG8_SB(0, 0), cB, voffB); PG8_STAGE(PG8_SB(0, 1), cB + hstepB, voffB); PG8_STAGE(PG8_SA(0, 0), cA, voffA); PG8_STAGE(PG8_SA(0, 1), cA + hstepA, voffA);
    if (wr == 1) PG8_BAR;
    PG8_WAIT_V(2); PG8_BAR;
    PG8_STAGE(PG8_SB(1, 0), cB + kstep, voffB); PG8_STAGE(PG8_SA(1, 0), cA + kstep, voffA); PG8_STAGE(PG8_SB(1, 1), cB + hstepB + kstep, voffB);
    PG8_WAIT_V(6); PG8_BAR;
    for (;;) {
        const bool has_next = S.next(ui + 1, nxt);
        const char* nA = has_next ? (const char*)g.A + (size_t)nxt.pm * tstepA + (size_t)((nxt.pn >> g.ash) * g.amul) * 2 : cA; const char* nB = has_next ? (const char*)g.Bt + (size_t)nxt.pn * tstepB : cB;
        for (int t = 0; t < nt; t += 2) {
            const bool last = (t == nt - 2);
            if constexpr (MID_T >= 0) { if (t == MID_T) E.mid(acc, cur, wr, wc, fr, fq); }
            const char* a1 = cA + (size_t)(t + 1) * kstep;
            const char* a2 = last ? nA : cA + (size_t)(t + 2) * kstep; const char* b2 = last ? nB : cB + (size_t)(t + 2) * kstep;
            const char* a3 = a2 + kstep; const char* b3 = b2 + kstep;
            PG8_LDB(B0, 0, 0); PG8_LDB(B1, 0, 1); PG8_SCHED; PG8_LDA(At, 0, 0); PG8_STAGE(PG8_SA(1, 1), a1 + hstepA, voffA);
            PG8_WAIT_V(8); PG8_WAIT_L(0); PG8_BAR; PG8_MMA(0, 0, At, B0); PG8_MMA(0, 1, At, B1); PG8_BAR; PG8_SCHED;
            PG8_LDA(At, 0, 1); PG8_STAGE(PG8_SB(0, 0), b2, voffB); PG8_STAGE(PG8_SB(0, 1), b2 + hstepB, voffB); PG8_STAGE(PG8_SA(0, 0), a2, voffA);
            PG8_WAIT_V(8); PG8_WAIT_L(0); PG8_BAR; PG8_MMA(1, 0, At, B0); PG8_MMA(1, 1, At, B1); PG8_BAR; PG8_SCHED;
            PG8_LDB(B0, 1, 0); PG8_LDB(B1, 1, 1); PG8_SCHED; PG8_LDA(At, 1, 0); PG8_STAGE(PG8_SA(0, 1), a2 + hstepA, voffA);
            PG8_WAIT_V(8); PG8_WAIT_L(0); PG8_BAR; PG8_MMA(0, 0, At, B0); PG8_MMA(0, 1, At, B1); PG8_BAR; PG8_SCHED;
            PG8_LDA(At, 1, 1); PG8_STAGE(PG8_SB(1, 0), b3, voffB); PG8_STAGE(PG8_SB(1, 1), b3 + hstepB, voffB); PG8_STAGE(PG8_SA(1, 0), a3, voffA);
            PG8_WAIT_V(8); PG8_WAIT_L(0); PG8_BAR; PG8_MMA(1, 0, At, B0); PG8_MMA(1, 1, At, B1); PG8_BAR; PG8_SCHED;
        }
        if constexpr (ALIGN_EPI) { if (wr == 0) PG8_BAR; }
        E.template run<2>(acc, cur, wr, wc, fr, fq);
        if (!has_next) break;
#pragma unroll
        for (int a = 0; a < 2; ++a)
#pragma unroll
            for (int b = 0; b < 2; ++b)
#pragma unroll
                for (int m = 0; m < 4; ++m)
#pragma unroll
                    for (int n = 0; n < 2; ++n) acc[a][b][m][n] = (f32x4){0.f, 0.f, 0.f, 0.f};
        cur = nxt; cA = nA; cB = nB; ++ui;
        if constexpr (ALIGN_EPI) { if (wr == 1) PG8_BAR; }
    }
    PG8_WAIT_V(0);
    if constexpr (!ALIGN_EPI) { if (wr == 0) PG8_BAR; }
    PG8_BAR;
#undef PG8_SA
#undef PG8_SB
#undef PG8_STAGE
#undef PG8_LDA
#undef PG8_LDB
#undef PG8_MMA
#undef PG8_WAIT_V
#undef PG8_WAIT_L
#undef PG8_BAR
#undef PG8_SCHED
}

template <class Epi>
__device__ __forceinline__ void gemm_half(PG8_LAS unsigned char* lds, const Gemm g, const Unit u, const Epi& E) {
    const int tid = threadIdx.x, wid = __builtin_amdgcn_readfirstlane(tid >> 6), lane = tid & 63, wr = wid >> 2, wc = wid & 3, fr = lane & 15, fq = lane >> 4;
    int nt = g.K / BK; asm volatile("" : "+s"(nt));
    unsigned voffA[2], voffB[2];
#pragma unroll
    for (int i = 0; i < 2; ++i) { int R, C; stage_rc(tid * 16 + i * 8192, R, C); const int Rb = (R & ~31) + perm32(R & 31);
        voffA[i] = (unsigned)(R * g.lda + C) * 2u; voffB[i] = (unsigned)(Rb * g.ldb + C) * 2u; }
    const size_t kstep = (size_t)(BK * 2);
    const size_t hstepA = (size_t)HALF * g.lda * 2, hstepB = (size_t)HALF * g.ldb * 2;
    const unsigned ldsw = (unsigned)wid * 1024u;
    const int aoff = lds_byte(wr * 64 + fr, fq * 8), boff = lds_byte(wc * 32 + fr, fq * 8);
#define PG8_SA(b, h) (((b) * 2 + (h)) * HTB)
#define PG8_SB(b, h) ((4 + (b) * 2 + (h)) * HTB)
#define PG8_STAGE(bufoff, gbase, voff) do { _Pragma("unroll") for (int _i = 0; _i < 2; ++_i) \
        __builtin_amdgcn_global_load_lds((const unsigned*)((const char*)(gbase) + (voff)[_i]), (PG8_LAS unsigned*)(lds + (bufoff) + ldsw + _i * 8192), 16, 0, 0); } while (0)
#define PG8_LDA(dst, b, h) do { _Pragma("unroll") for (int m = 0; m < 4; ++m) _Pragma("unroll") for (int k = 0; k < 2; ++k) dst[m][k] = *(const PG8_LAS bf16x8*)(lds + PG8_SA(b, h) + aoff + m * 2048 + k * 1024); } while (0)
#define PG8_LDB(dst, b, h) do { _Pragma("unroll") for (int n = 0; n < 2; ++n) _Pragma("unroll") for (int k = 0; k < 2; ++k) dst[n][k] = *(const PG8_LAS bf16x8*)(lds + PG8_SB(b, h) + boff + n * 2048 + k * 1024); } while (0)
#define PG8_MMA(ai, bj, At, Bt) do { __builtin_amdgcn_s_setprio(1); _Pragma("unroll") for (int m = 0; m < 4; ++m) _Pragma("unroll") for (int n = 0; n < 2; ++n) _Pragma("unroll") for (int k = 0; k < 2; ++k) \
        acc[ai][bj][m][n] = __builtin_amdgcn_mfma_f32_16x16x32_bf16(Bt[n][k], At[m][k], acc[ai][bj][m][n], 0, 0, 0); __builtin_amdgcn_s_setprio(0); } while (0)
#define PG8_WAIT_V(n) asm volatile("s_waitcnt vmcnt(" #n ")" ::: "memory")
#define PG8_WAIT_L(n) asm volatile("s_waitcnt lgkmcnt(" #n ")" ::: "memory")
#define PG8_BAR __builtin_amdgcn_s_barrier()
#define PG8_SCHED __builtin_amdgcn_sched_barrier(0)
    f32x4 acc[2][2][4][2];
#pragma unroll
    for (int a = 0; a < 2; ++a)
#pragma unroll
        for (int b = 0; b < 2; ++b)
#pragma unroll
            for (int m = 0; m < 4; ++m)
#pragma unroll
                for (int n = 0; n < 2; ++n) acc[a][b][m][n] = (f32x4){0.f, 0.f, 0.f, 0.f};
    bf16x8 At[4][2], B0[2][2], B1[2][2];
    const char* cA = (const char*)g.A + ((size_t)u.pm * BM + u.rh) * g.lda * 2 + (size_t)((u.pn >> g.ash) * g.amul) * 2; const char* cB = (const char*)g.Bt + (size_t)u.pn * 2 * hstepB;
    PG8_STAGE(PG8_SB(0, 0), cB, voffB); PG8_STAGE(PG8_SB(0, 1), cB + hstepB, voffB); PG8_STAGE(PG8_SA(0, 0), cA, voffA);
    PG8_STAGE(PG8_SB(1, 0), cB + kstep, voffB); PG8_STAGE(PG8_SB(1, 1), cB + hstepB + kstep, voffB); PG8_STAGE(PG8_SA(1, 0), cA + kstep, voffA);
    PG8_WAIT_V(6); PG8_BAR;
#define PG8_HALF_STEP(b, tt) do { \
        PG8_LDB(B0, b, 0); PG8_LDB(B1, b, 1); PG8_LDA(At, b, 0); PG8_WAIT_L(0); PG8_BAR; PG8_SCHED; \
        const bool more_ = (tt) + 2 < nt; \
        if (more_) { const char* b2 = cB + (size_t)((tt) + 2) * kstep; const char* a2 = cA + (size_t)((tt) + 2) * kstep; \
            PG8_STAGE(PG8_SB(b, 0), b2, voffB); PG8_STAGE(PG8_SB(b, 1), b2 + hstepB, voffB); PG8_STAGE(PG8_SA(b, 0), a2, voffA); } \
        PG8_MMA(0, 0, At, B0); PG8_MMA(0, 1, At, B1); \
        if (more_) PG8_WAIT_V(6); else PG8_WAIT_V(0); \
        PG8_BAR; PG8_SCHED; } while (0)
    for (int t = 0; t < nt; t += 2) { PG8_HALF_STEP(0, t); PG8_HALF_STEP(1, t + 1); }
    E.template run<1>(acc, u, wr, wc, fr, fq);
    PG8_BAR;
#undef PG8_HALF_STEP
#undef PG8_SA
#undef PG8_SB
#undef PG8_STAGE
#undef PG8_LDA
#undef PG8_LDB
#undef PG8_MMA
#undef PG8_WAIT_V
#undef PG8_WAIT_L
#undef PG8_BAR
#undef PG8_SCHED
}
}

constexpr int NWAVES = 8, NTHR = 512;
constexpr int M = 16384, SEQ = 4096, NB = 4, D = 1024, DPOOL = 512, DRNN = 1024, DIN = 4608, DFF = 2816;
constexpr float EPS = 1e-6f;
constexpr int NPH = 11;
constexpr int SCAN_T = 128, SCAN_NC = SEQ / SCAN_T;

constexpr size_t MiB = 1u << 20;
constexpr size_t WS_SP8 = 512 * 1024;
constexpr size_t WS_RSI = 576 * 1024;
constexpr size_t WS_SSQ = 1 * MiB;
constexpr size_t WS_SSQ2 = 2 * MiB;
constexpr size_t WS_CS = 2 * MiB, WS_CH = 3 * MiB;
constexpr size_t WS_WIN = 4 * MiB;
constexpr size_t WS_WFI = 13 * MiB;
constexpr size_t WS_WFO = 24 * MiB;
constexpr size_t WS_WCAT = WS_WFO + 5632 * 1024;
constexpr size_t WS_WO = WS_WCAT + 3 * MiB;
constexpr size_t WS_WGRP = WS_WO + 2 * MiB;
constexpr size_t WS_WGATE = WS_WGRP + MiB / 4;
constexpr size_t WS_R1 = 36 * MiB;
constexpr size_t WS_R2 = 68 * MiB;
constexpr size_t WS_R3 = 84 * MiB;
constexpr size_t WS_R4 = 116 * MiB;
constexpr size_t WS_R7 = 148 * MiB;
constexpr size_t WS_R8 = 164 * MiB;
constexpr size_t WS_CAT = 196 * MiB;
constexpr size_t WS_MIXB = 148 * MiB;
constexpr size_t WS_ACT = 68 * MiB;
constexpr size_t WS_END = 244 * MiB;

constexpr int LDS_BYTES = 147456;

#define LAS __attribute__((address_space(3)))
typedef unsigned short bf16;
typedef unsigned v4u __attribute__((ext_vector_type(4)));
typedef unsigned v2u __attribute__((ext_vector_type(2)));
typedef float f32x4 __attribute__((ext_vector_type(4)));
typedef float f32x2 __attribute__((ext_vector_type(2)));
#define LDS_WAIT() asm volatile("s_waitcnt lgkmcnt(0)" ::: "memory")
using pg8::cvt_pk_bf16; using pg8::bf_lo; using pg8::bf_hi;

struct Args { const float* in[19]; float* out; unsigned char* ws; int ph_lo, ph_hi; };
enum { I_X = 0, I_NORM_MIX, I_W_IN, I_W_GRP, I_POOL_SCALE, I_W_POOL_OUT, I_CONV_W, I_CONV_B, I_W_RG_A, I_B_RG_A, I_W_RG_X, I_B_RG_X, I_LAMBDA, I_W_RNN_OUT, I_W_O, I_NORM_FFN, I_W_FFN_IN, I_W_FFN_OUT, I_NORM_FINAL };

__device__ __forceinline__ float wave_sum(float v) {
#pragma unroll
    for (int o = 1; o < 64; o <<= 1) v += __shfl_xor(v, o);
    return v;
}

__device__ __forceinline__ void transpose_item(const float* W, int Nsrc, int Kdst, bf16* WT, int k0, int n_src0, int n_dst0, const float* kscale, LAS float* scr, int lane) {
    f32x4 v[8]; const int n4 = (lane & 7) * 4;
#pragma unroll
    for (int i = 0; i < 8; ++i) { const int kk = 8 * i + (lane >> 3); v[i] = *(const f32x4*)(W + (size_t)(k0 + kk) * Nsrc + n_src0 + n4); }
    if (kscale) {
#pragma unroll
        for (int i = 0; i < 8; ++i) v[i] = v[i] * kscale[k0 + 8 * i + (lane >> 3)]; }
#pragma unroll
    for (int i = 0; i < 8; ++i) { const int kk = 8 * i + (lane >> 3);
#pragma unroll
        for (int j = 0; j < 4; ++j) scr[kk * 33 + n4 + j] = v[i][j]; }
    LDS_WAIT(); asm volatile("" ::: "memory");
    const int c = lane & 7;
#pragma unroll
    for (int j = 0; j < 4; ++j) { const int n = (lane >> 3) + 8 * j; const LAS float* s = scr + (8 * c) * 33 + n;
        v4u o; o.x = cvt_pk_bf16(s[0 * 33], s[1 * 33]); o.y = cvt_pk_bf16(s[2 * 33], s[3 * 33]); o.z = cvt_pk_bf16(s[4 * 33], s[5 * 33]); o.w = cvt_pk_bf16(s[6 * 33], s[7 * 33]);
        *(v4u*)(WT + (size_t)(n_dst0 + n) * Kdst + k0 + 8 * c) = o; }
    LDS_WAIT(); asm volatile("" ::: "memory");
}

#define XB_TMO      128
#define XB_XCNT(j)  (256  + 64 * (j))
#define XB_XSUB(j)  (1280 + 64 * (j))
#define XB_XGEN(j)  (2304 + 64 * (j))
#define XB_TOP      3328
#define XB_TOPGEN   3392
#define XCD_BAR_WORDS 3456
#define XB_SPIN_CAP (1u << 18)
__device__ __forceinline__ unsigned xb_ld(unsigned* p)              { return __hip_atomic_load(p, __ATOMIC_RELAXED, __HIP_MEMORY_SCOPE_AGENT); }
__device__ __forceinline__ unsigned xb_add(unsigned* p, unsigned v) { return __hip_atomic_fetch_add(p, v, __ATOMIC_RELAXED, __HIP_MEMORY_SCOPE_AGENT); }
__device__ __forceinline__ unsigned xb_xcc_id() { return (unsigned)__builtin_amdgcn_s_getreg((3 << 11) | 20) & 0xFu; }
#define XB_SPIN(cond, bar) do { unsigned _sp = 0; while (cond) { __builtin_amdgcn_s_sleep(1); \
    if ((++_sp & 255u) == 0u) { if (xb_ld(&(bar)[XB_TMO])) break; if (_sp > XB_SPIN_CAP) { atomicAdd(&(bar)[XB_TMO], 1u); break; } } } } while (0)
struct XcdBarrier { unsigned* bar; unsigned x; volatile LAS unsigned* st; };
__device__ __forceinline__ XcdBarrier xcd_barrier_post(unsigned* bar, volatile LAS unsigned* st) {
    XcdBarrier b; b.bar = bar; b.x = xb_xcc_id(); b.st = st;
    if (threadIdx.x == 0) (void)xb_add(&bar[XB_XCNT(b.x)], 1u);
    return b;
}
__device__ __forceinline__ void xcd_barrier_complete(unsigned* bar, unsigned x, unsigned& nloc, unsigned& nx) {
    const unsigned G = gridDim.x * gridDim.y * gridDim.z;
    unsigned sum, cnt, mine, sp = 0u;
    for (;;) {
        sum = 0u; cnt = 0u; mine = 0u;
#pragma unroll
        for (unsigned j = 0; j < 16; ++j) { const unsigned c = xb_ld(&bar[XB_XCNT(j)]); sum += c; cnt += (c > 0u) ? 1u : 0u; mine = (j == x) ? c : mine; }
        if (sum == G) break;
        __builtin_amdgcn_s_sleep(1);
        if ((++sp & 255u) == 0u) { if (xb_ld(&bar[XB_TMO])) break; if (sp > XB_SPIN_CAP) { atomicAdd(&bar[XB_TMO], 1u); break; } }
    }
    nloc = mine > 0u ? mine : 1u; nx = cnt > 0u ? cnt : 1u;
}
__device__ __forceinline__ void xcd_barrier(const XcdBarrier& b) {
    asm volatile("s_waitcnt vmcnt(0)" ::: "memory");
    __syncthreads();
    if (threadIdx.x == 0) {
        unsigned* bar = b.bar;
        __builtin_amdgcn_s_waitcnt(0);
        unsigned nloc = b.st[0], nx = b.st[1];
        if (nloc == 0u) { xcd_barrier_complete(bar, b.x, nloc, nx); b.st[0] = nloc; b.st[1] = nx; }
        const unsigned old = xb_add(&bar[XB_XSUB(b.x)], 1u);
        const unsigned gen = old / nloc;
        if (old + 1u == (gen + 1u) * nloc) {
            __builtin_amdgcn_fence(__ATOMIC_RELEASE, "agent");
            asm volatile("s_waitcnt vmcnt(0)" ::: "memory");
            const unsigned og = xb_add(&bar[XB_TOP], 1u);
            const unsigned tg = og / nx;
            if (og + 1u == (tg + 1u) * nx) xb_add(&bar[XB_TOPGEN], 1u);
            else XB_SPIN(xb_ld(&bar[XB_TOPGEN]) == tg, bar);
            __builtin_amdgcn_fence(__ATOMIC_ACQUIRE, "agent");
            xb_add(&bar[XB_XGEN(b.x)], 1u);
            asm volatile("s_waitcnt vmcnt(0)" ::: "memory");
        } else {
            XB_SPIN(xb_ld(&bar[XB_XGEN(b.x)]) == gen, bar);
            __builtin_amdgcn_fence(__ATOMIC_ACQUIRE, "agent");
            asm volatile("s_waitcnt vmcnt(0)" ::: "memory");
        }
    }
    __syncthreads();
}

template <int W>
__device__ __forceinline__ void pool_item(const bf16* src, bf16* dst, int tl) {
    v4u rw[W + 7];
#pragma unroll
    for (int k = 0; k < W + 7; ++k) rw[k] = (tl + k - (W - 1) >= 0) ? *(const v4u*)(src + (ptrdiff_t)(k - (W - 1)) * DPOOL) : (v4u){0u, 0u, 0u, 0u};
    f32x4 s0 = {0.f, 0.f, 0.f, 0.f}, s1 = s0;
#pragma unroll
    for (int k = 0; k < W - 1; ++k) { f32x4 a, c; pg8::unpack8(rw[k], a, c); s0 += a; s1 += c; }
#pragma unroll
    for (int i = 0; i < 8; ++i) { f32x4 a, c; pg8::unpack8(rw[W - 1 + i], a, c); s0 += a; s1 += c;
        const int t = tl + i; const int cnt = (t + 1 < W) ? t + 1 : W; const float inv = 1.0f / (float)cnt;
        *(v4u*)(dst + (size_t)i * DPOOL) = pg8::pack8(s0 * inv - a, s1 * inv - c);
        f32x4 a2, c2; pg8::unpack8(rw[i], a2, c2); s0 -= a2; s1 -= c2; }
}
__device__ __forceinline__ void scan_local16(const bf16* lap, const bf16* bbp, f32x4 (&S)[2], f32x4 (&H)[2]) {
    S[0] = S[1] = H[0] = H[1] = (f32x4){0.f, 0.f, 0.f, 0.f};
#pragma unroll
    for (int i0 = 0; i0 < 16; i0 += 8) { v4u lw[8], bw[8];
#pragma unroll
        for (int i = 0; i < 8; ++i) { lw[i] = *(const v4u*)(lap + (size_t)(i0 + i) * DRNN); bw[i] = *(const v4u*)(bbp + (size_t)(i0 + i) * DRNN); }
#pragma unroll
        for (int i = 0; i < 8; ++i) { f32x4 l[2], bq[2]; pg8::unpack8(lw[i], l[0], l[1]); pg8::unpack8(bw[i], bq[0], bq[1]);
#pragma unroll
            for (int n = 0; n < 2; ++n)
#pragma unroll
                for (int j = 0; j < 4; ++j) { H[n][j] = __expf(l[n][j]) * H[n][j] + bq[n][j]; S[n][j] += l[n][j]; } } }
}

__device__ __forceinline__ void conv_item(const bf16* UR, bf16* V, const float* convw, const float* convb, int t0, int co) {
    const int tl = t0 & (SEQ - 1);
    const bf16* src = UR + (size_t)t0 * DRNN + co * 8; bf16* dst = V + (size_t)t0 * 1536 + co * 8;
    const float* cw = convw + co * 8; const float* cb = convb + co * 8;
    v4u rw[11];
#pragma unroll
    for (int k = 0; k < 11; ++k) rw[k] = (k >= 3 || tl != 0) ? *(const v4u*)(src + (ptrdiff_t)(k - 3) * DRNN) : (v4u){0u, 0u, 0u, 0u};
    f32x4 w0[2], w1[2], w2[2], w3[2], bb[2];
#pragma unroll
    for (int n = 0; n < 2; ++n) { w0[n] = *(const f32x4*)(cw + 4 * n); w1[n] = *(const f32x4*)(cw + 1024 + 4 * n); w2[n] = *(const f32x4*)(cw + 2048 + 4 * n); w3[n] = *(const f32x4*)(cw + 3072 + 4 * n); bb[n] = *(const f32x4*)(cb + 4 * n); }
#pragma unroll
    for (int i = 0; i < 8; ++i) { f32x4 a[2], b[2], c[2], d[2]; pg8::unpack8(rw[i], a[0], a[1]); pg8::unpack8(rw[i + 1], b[0], b[1]); pg8::unpack8(rw[i + 2], c[0], c[1]); pg8::unpack8(rw[i + 3], d[0], d[1]);
        *(v4u*)(dst + (size_t)i * 1536) = pg8::pack8(bb[0] + w0[0] * a[0] + w1[0] * b[0] + w2[0] * c[0] + w3[0] * d[0], bb[1] + w0[1] * a[1] + w1[1] * b[1] + w2[1] * c[1] + w3[1] * d[1]); }
}
__device__ __forceinline__ void pool_witem(const bf16* UP, bf16* POOLED, int g, int tblk, int lane) {
    const int t0 = tblk + (lane >> 4) * 8, co = g * 16 + (lane & 15);
    const bf16* src = UP + (size_t)t0 * DPOOL + co * 8; bf16* dst = POOLED + (size_t)t0 * DPOOL + co * 8; const int tl = t0 & (SEQ - 1);
    if (g == 0) pool_item<2>(src, dst, tl); else if (g == 1) pool_item<4>(src, dst, tl); else if (g == 2) pool_item<8>(src, dst, tl); else pool_item<16>(src, dst, tl);
}

__global__ void __launch_bounds__(NTHR, 2) fwd_kernel(Args args) {
    extern __shared__ __attribute__((aligned(16))) unsigned char lds_raw[];
    LAS unsigned char* lds = (LAS unsigned char*)lds_raw;
    const int tid = threadIdx.x, lane = tid & 63, wave = __builtin_amdgcn_readfirstlane(tid >> 6);
    const int G = gridDim.x, bx = blockIdx.x;
    unsigned char* ws = args.ws;
    const int lo = args.ph_lo, hi = args.ph_hi;
#ifndef PHASE_MASK
#define PHASE_MASK 0x7ff
#endif
#define IN(k) (((PHASE_MASK >> (k)) & 1) && lo <= (k) && (k) < hi)
#ifndef REPEAT_MASK
#define REPEAT_MASK 0
#endif
#define REPS(k) (((REPEAT_MASK >> (k)) & 1) ? 2 : 1)
#ifndef PROBE_PHASE
#define PROBE_PHASE -1
#endif
#define PROBE_MULT 4
    unsigned long long tp0 = 0, tp1 = 0;
#define TSTART(k) do { if ((k) == PROBE_PHASE) tp0 = __builtin_amdgcn_s_memrealtime(); } while (0)
#define TEND(k) do { if ((k) == PROBE_PHASE) tp1 = __builtin_amdgcn_s_memrealtime(); } while (0)
#define GSYNC() xcd_barrier(bar)
#define SEAM(k) do { if (IN(k) && IN((k) + 1)) { GSYNC(); } } while (0)

    const float* x = args.in[I_X];
    bf16* WIN = (bf16*)(ws + WS_WIN); bf16* WFI = (bf16*)(ws + WS_WFI); bf16* WFO = (bf16*)(ws + WS_WFO); bf16* WCAT = (bf16*)(ws + WS_WCAT);
    bf16* WO = (bf16*)(ws + WS_WO); bf16* WGRP = (bf16*)(ws + WS_WGRP); bf16* WGATE = (bf16*)(ws + WS_WGATE);
    bf16* XN = (bf16*)(ws + WS_R1); bf16* X1B = XN;
    bf16* CAT = (bf16*)(ws + WS_CAT); bf16* V = CAT + 512; bf16* LA = V;
    bf16* UP = (bf16*)(ws + WS_R2);
    bf16* UR = (bf16*)(ws + WS_R3);
    bf16* UG = (bf16*)(ws + WS_R4);
    bf16* POOLED = (bf16*)(ws + WS_R7); bf16* BB = (bf16*)(ws + WS_R8);
    bf16* MIXB = (bf16*)(ws + WS_MIXB); bf16* ACT = (bf16*)(ws + WS_ACT);
    float* SSQ = (float*)(ws + WS_SSQ); float* CS = (float*)(ws + WS_CS); float* CH = (float*)(ws + WS_CH);
    bf16* G0 = (bf16*)args.out; bf16* G1 = G0 + (size_t)M * 1024;
    float* X1 = args.out;

#ifndef EXTRA_SYNCS
#define EXTRA_SYNCS 0
#endif
    if (PROBE_PHASE == 99) tp0 = __builtin_amdgcn_s_memrealtime();
    volatile LAS unsigned* MISC = (volatile LAS unsigned*)(lds + 131072 + 1024);
    if (tid < 32) MISC[tid] = 0u;
    __syncthreads();
    XcdBarrier bar = xcd_barrier_post((unsigned*)ws, MISC + 8);
    if (lo < 0) cg::this_grid().sync();
    for (int i = 0; i < EXTRA_SYNCS; ++i) GSYNC();
    TSTART(0);
    if (IN(0)) for (int rep = 0; rep < REPS(0); ++rep) { if (rep) GSYNC();
        LAS float* scr = (LAS float*)(lds + wave * 16384);
        const int gw = bx * NWAVES + wave, NGW = G * NWAVES;
        constexpr int I_IN = 16 * (DIN / 32), I_FI = 16 * (2 * DFF / 32), I_FO = (DFF / 64) * (D / 32), I_RO = 16 * 32, I_WO = 16 * 32, I_PO = 8 * 32;
        constexpr int NITEMS = I_IN + I_FI + I_FO + I_RO + I_WO + I_PO;
        for (int it = gw; it < NITEMS; it += NGW) {
            int r = it;
            if (r < I_IN) { const int nblk = DIN / 32, kb = r / nblk, nb = r % nblk, nd = 32 * nb; int ns = nd;
                if (nd >= 2560) { const int q = nd - 2560, pq = q >> 8, j0 = q & 255; ns = 2560 + (j0 < 128 ? 128 * pq + j0 : 1024 + 128 * pq + (j0 - 128)); }
                transpose_item(args.in[I_W_IN], DIN, D, WIN, 64 * kb, ns, nd, args.in[I_NORM_MIX], scr, lane); continue; } r -= I_IN;
            if (r < I_FI) { const int nblk = 2 * DFF / 32, kb = r / nblk, nb = r % nblk, nd = 32 * nb, pn = nd >> 8, j0 = nd & 255;
                const int ns = j0 < 128 ? 128 * pn + j0 : DFF + 128 * pn + (j0 - 128);
                transpose_item(args.in[I_W_FFN_IN], 2 * DFF, D, WFI, 64 * kb, ns, nd, args.in[I_NORM_FFN], scr, lane); continue; } r -= I_FI;
            if (r < I_FO) { if (G != 256) { const int nblk = D / 32, kb = r / nblk, nb = r % nblk; transpose_item(args.in[I_W_FFN_OUT], D, DFF, WFO, 64 * kb, 32 * nb, 32 * nb, nullptr, scr, lane); } continue; } r -= I_FO;
            if (r < I_RO) { const int nblk = D / 32, kb = r / nblk, nb = r % nblk; transpose_item(args.in[I_W_RNN_OUT], D, 1536, WCAT + 512, 64 * kb, 32 * nb, 32 * nb, nullptr, scr, lane); continue; } r -= I_RO;
            if (r < I_WO) { const int nblk = D / 32, kb = r / nblk, nb = r % nblk; transpose_item(args.in[I_W_O], D, D, WO, 64 * kb, 32 * nb, 32 * nb, nullptr, scr, lane); continue; } r -= I_WO;
            { const int nblk = D / 32, kb = r / nblk, nb = r % nblk; transpose_item(args.in[I_W_POOL_OUT], D, 1536, WCAT, 64 * kb, 32 * nb, 32 * nb, nullptr, scr, lane); }
        }
        {
            const int gt = bx * NTHR + tid, NT = G * NTHR;
            const float* wg = args.in[I_W_GRP];
            for (int e = gt; e < 512 * 32; e += NT) { const int n = e >> 5, kc = (e & 31) * 8, g = n >> 7, nn = n & 127; float v[8];
#pragma unroll
                for (int j = 0; j < 8; ++j) { const int kk = kc + j - (g & 1) * 128; v[j] = (kk >= 0 && kk < 128) ? wg[((size_t)g * 128 + kk) * 128 + nn] : 0.f; }
                v4u o; o.x = cvt_pk_bf16(v[0], v[1]); o.y = cvt_pk_bf16(v[2], v[3]); o.z = cvt_pk_bf16(v[4], v[5]); o.w = cvt_pk_bf16(v[6], v[7]);
                *(v4u*)(WGRP + (size_t)n * 256 + kc) = o; }
            const float* wa = args.in[I_W_RG_A]; const float* wx = args.in[I_W_RG_X];
            for (int e = gt; e < 2048 * 16; e += NT) { const int n = e >> 4, kc = (e & 15) * 8, h = n >> 8, j = n & 255; const float* src = j < 128 ? wa : wx; const int jj = j & 127; float v[8];
#pragma unroll
                for (int q = 0; q < 8; ++q) v[q] = src[((size_t)h * 128 + kc + q) * 128 + jj];
                v4u o; o.x = cvt_pk_bf16(v[0], v[1]); o.y = cvt_pk_bf16(v[2], v[3]); o.z = cvt_pk_bf16(v[4], v[5]); o.w = cvt_pk_bf16(v[6], v[7]);
                *(v4u*)(WGATE + (size_t)n * 128 + kc) = o; }
        }
        { const int gt = bx * NTHR + tid; if (gt < DRNN) { const float z = -args.in[I_LAMBDA][gt]; ((float*)(ws + WS_SP8))[gt] = -8.0f * (fmaxf(z, 0.f) + log1pf(expf(-fabsf(z)))); } }
        float* RSI = (float*)(ws + WS_RSI);
        for (int m = gw; m < M; m += 2 * NGW) {
            const int m1 = (m + NGW < M) ? m + NGW : m;
            const f32x4* xr0 = (const f32x4*)(x + (size_t)m * D) + lane; const f32x4* xr1 = (const f32x4*)(x + (size_t)m1 * D) + lane; f32x4 v0[4], v1[4]; float s0 = 0.f, s1 = 0.f;
#pragma unroll
            for (int j = 0; j < 4; ++j) { v0[j] = xr0[64 * j]; v1[j] = xr1[64 * j]; }
#pragma unroll
            for (int j = 0; j < 4; ++j) { s0 += (v0[j].x * v0[j].x + v0[j].y * v0[j].y) + (v0[j].z * v0[j].z + v0[j].w * v0[j].w); s1 += (v1[j].x * v1[j].x + v1[j].y * v1[j].y) + (v1[j].z * v1[j].z + v1[j].w * v1[j].w); }
            const float q0 = sqrtf(wave_sum(s0) * (1.f / D) + EPS), q1 = sqrtf(wave_sum(s1) * (1.f / D) + EPS), rs0 = 1.0f / q0, rs1 = 1.0f / q1;
            if (lane == 0) { RSI[m] = q0; RSI[m1] = q1; }
            v2u* o0 = (v2u*)(XN + (size_t)m * D) + lane; v2u* o1 = (v2u*)(XN + (size_t)m1 * D) + lane;
#pragma unroll
            for (int j = 0; j < 4; ++j) { const f32x4 y0 = v0[j] * rs0, y1 = v1[j] * rs1; v2u w0, w1; w0.x = cvt_pk_bf16(y0.x, y0.y); w0.y = cvt_pk_bf16(y0.z, y0.w); w1.x = cvt_pk_bf16(y1.x, y1.y); w1.y = cvt_pk_bf16(y1.z, y1.w); o0[64 * j] = w0; o1[64 * j] = w1; }
        }
        __syncthreads();
    }
    SEAM(0);
    TEND(0);

    TSTART(1);
    if (IN(1)) for (int rep = 0; rep < REPS(1); ++rep) { if (rep) GSYNC();
        pg8::Gemm g{XN, WIN, M, 4096, D, D, D, 0, 0}; pg8::StaticOrder S; S.init(M, 4096, G, bx);
        pg8::EpiProj E{UP, UR, UG, G0, G1, 0};
        pg8::gemm_phase<pg8::EpiProj, true>(lds, g, S, E);
    }
    SEAM(1);
    TEND(1);

    TSTART(2);
    if (IN(2) && G != 256) for (int rep = 0; rep < REPS(2); ++rep) { if (rep) GSYNC();
        { const int gw = bx * NWAVES + wave, NGW = G * NWAVES;
          for (int wi = gw; wi < (M / 32) * 4; wi += NGW) pool_witem(UP, POOLED, wi & 3, (wi >> 2) * 32, lane); }
        { const int gt = bx * NTHR + tid, NT = G * NTHR;
          for (int it = gt; it < (M / 8) * 128; it += NT) conv_item(UR, V, args.in[I_CONV_W], args.in[I_CONV_B], (it >> 7) * 8, it & 127); }
    }
    if (G != 256)     SEAM(2);
    TEND(2);

    TSTART(3);
    if (IN(3)) for (int rep = 0; rep < REPS(3); ++rep) { if (rep) GSYNC();
        const bool fusedp2 = (G == 256);
        if (fusedp2) {
            { pg8::StaticOrder Sg; Sg.init(M, 512, G, (bx + G / 2) % G); pg8::Unit u;
              if (Sg.next(0, u)) { for (int wi = wave; wi < 16; wi += NWAVES) pool_witem(UP, POOLED, 2 * u.pn + (wi & 1), u.pm * 256 + (wi >> 1) * 32, lane); } }
            { pg8::StaticOrder Sv; Sv.init(M, 2048, G, bx); Sv.lin_base = bx * 2; Sv.lin_cnt = 2;
              for (int i = 0; i < 2; ++i) { pg8::Unit u; if (Sv.next(i, u)) conv_item(UR, V, args.in[I_CONV_W], args.in[I_CONV_B], u.pm * 256 + (tid >> 4) * 8, u.pn * 16 + (tid & 15)); } }
            asm volatile("s_waitcnt vmcnt(0)" ::: "memory"); __syncthreads();
        }
        {
          pg8::Gemm g{XN, WIN + (size_t)4096 * D, M, 512, D, D, D, 0, 0}; pg8::StaticOrder S; S.init(M, 512, G, bx);
          pg8::EpiProj E{UP, UR, UG, G0, G1, 16};
          pg8::gemm_phase<pg8::EpiProj, true>(lds, g, S, E); }
        { pg8::Gemm g{POOLED, WGRP, M, 512, 256, 512, 256, 0, 256}; pg8::StaticOrder S; S.init(M, 512, G, (bx + G / 2) % G);
          pg8::EpiGrp E{CAT, 1536, args.in[I_POOL_SCALE]};
          pg8::gemm_phase<pg8::EpiGrp, true>(lds, g, S, E); }
        { pg8::Gemm g{V, WGATE, M, 2048, 128, 1536, 128, 0, 128}; pg8::StaticOrder S; S.init(M, 2048, G, bx);
          if (fusedp2) { S.lin_base = bx * 2; S.lin_cnt = 2; }
          pg8::EpiGate E{V, LA, BB, args.in[I_B_RG_A], args.in[I_B_RG_X], (const float*)(ws + WS_SP8)};
          pg8::gemm_phase<pg8::EpiGate, true>(lds, g, S, E); }
    }
    SEAM(3);
    TEND(3);

    TSTART(4);
    TEND(4);

    TSTART(5);
    if (IN(5)) for (int rep = 0; rep < REPS(5); ++rep) { if (rep) GSYNC();
        LAS float* PAS = (LAS float*)lds; LAS float* PAH = PAS + 8 * 512; LAS float* PBS = PAH + 8 * 512; LAS float* PBH = PBS + 8 * 512;
        unsigned* flags = (unsigned*)ws + 8192;
        for (int bi = bx; bi < NB * SCAN_NC * 2; bi += G) { const int hh = bi & 1, c = (bi >> 1) % SCAN_NC, b = bi / (2 * SCAN_NC);
            const size_t off = ((size_t)b * SEQ + (size_t)c * SCAN_T + wave * 16) * DRNN + hh * 512 + lane * 8;
            v4u lwk[16], bwk[16];
            const size_t offL = ((size_t)b * SEQ + (size_t)c * SCAN_T + wave * 16) * 1536 + hh * 512 + lane * 8;
#pragma unroll
            for (int i = 0; i < 16; ++i) { lwk[i] = *(const v4u*)(LA + offL + (size_t)i * 1536); bwk[i] = *(const v4u*)(BB + off + (size_t)i * DRNN); }
            { f32x4 S[2] = {{0.f, 0.f, 0.f, 0.f}, {0.f, 0.f, 0.f, 0.f}}, H[2] = {{0.f, 0.f, 0.f, 0.f}, {0.f, 0.f, 0.f, 0.f}};
#pragma unroll
              for (int i = 0; i < 16; ++i) { f32x4 l[2], bq[2]; pg8::unpack8(lwk[i], l[0], l[1]); pg8::unpack8(bwk[i], bq[0], bq[1]);
#pragma unroll
                  for (int n = 0; n < 2; ++n)
#pragma unroll
                      for (int j = 0; j < 4; ++j) { H[n][j] = __expf(l[n][j]) * H[n][j] + bq[n][j]; S[n][j] += l[n][j]; } }
              *(LAS f32x4*)(PBS + wave * 512 + lane * 8) = S[0]; *(LAS f32x4*)(PBS + wave * 512 + lane * 8 + 4) = S[1];
              *(LAS f32x4*)(PBH + wave * 512 + lane * 8) = H[0]; *(LAS f32x4*)(PBH + wave * 512 + lane * 8 + 4) = H[1]; }
#pragma unroll
            for (int i = 0; i < 16; ++i) asm volatile("" : "+v"(lwk[i]), "+v"(bwk[i]));
            __syncthreads();
            { float h = 0.f, st = 0.f;
#pragma unroll
              for (int sb = 0; sb < 8; ++sb) { const float sv = PBS[sb * 512 + tid]; h = __expf(sv) * h + PBH[sb * 512 + tid]; st += sv; }
              const size_t co = ((size_t)b * SCAN_NC + c) * DRNN + hh * 512 + tid;
              __hip_atomic_store(CS + co, st, __ATOMIC_RELAXED, __HIP_MEMORY_SCOPE_AGENT); __hip_atomic_store(CH + co, h, __ATOMIC_RELAXED, __HIP_MEMORY_SCOPE_AGENT); }
            asm volatile("s_waitcnt vmcnt(0)" ::: "memory");
            __syncthreads();
            if (tid == 0) __hip_atomic_store(flags + ((b * 2 + hh) * SCAN_NC + c) * 16, 1u, __ATOMIC_RELAXED, __HIP_MEMORY_SCOPE_AGENT);
            { f32x4 S[2] = {{0.f, 0.f, 0.f, 0.f}, {0.f, 0.f, 0.f, 0.f}}, H[2] = {{0.f, 0.f, 0.f, 0.f}, {0.f, 0.f, 0.f, 0.f}};
              if (wave * 4 < c) {
                  for (int q = 0; q < 4; ++q) { const int cc = wave * 4 + q; if (cc < c) { unsigned* f = flags + ((b * 2 + hh) * SCAN_NC + cc) * 16; unsigned sp = 0;
                      while ((unsigned)__builtin_amdgcn_readfirstlane(__hip_atomic_load(f, __ATOMIC_RELAXED, __HIP_MEMORY_SCOPE_AGENT)) == 0u) { __builtin_amdgcn_s_sleep(1); if (++sp > (1u << 20)) break; } } }
                  __builtin_amdgcn_fence(__ATOMIC_ACQUIRE, "agent");
#pragma unroll
                  for (int q0 = 0; q0 < 4; q0 += 2) { f32x4 cs[2][2], ch[2][2];
#pragma unroll
                      for (int q = 0; q < 2; ++q) { const int cc = wave * 4 + q0 + q; const size_t co = ((size_t)b * SCAN_NC + (cc < c ? cc : 0)) * DRNN + hh * 512 + lane * 8;
                          cs[q][0] = *(const f32x4*)(CS + co); cs[q][1] = *(const f32x4*)(CS + co + 4); ch[q][0] = *(const f32x4*)(CH + co); ch[q][1] = *(const f32x4*)(CH + co + 4); }
#pragma unroll
                      for (int q = 0; q < 2; ++q) { if (wave * 4 + q0 + q < c) {
#pragma unroll
                          for (int n = 0; n < 2; ++n)
#pragma unroll
                              for (int j = 0; j < 4; ++j) { H[n][j] = __expf(cs[q][n][j]) * H[n][j] + ch[q][n][j]; S[n][j] += cs[q][n][j]; } } }
                      asm volatile("" ::: "memory"); }
              }
              *(LAS f32x4*)(PAS + wave * 512 + lane * 8) = S[0]; *(LAS f32x4*)(PAS + wave * 512 + lane * 8 + 4) = S[1];
              *(LAS f32x4*)(PAH + wave * 512 + lane * 8) = H[0]; *(LAS f32x4*)(PAH + wave * 512 + lane * 8 + 4) = H[1]; }
            __syncthreads();
            f32x4 h[2] = {{0.f, 0.f, 0.f, 0.f}, {0.f, 0.f, 0.f, 0.f}};
#pragma unroll
            for (int sb = 0; sb < 8; ++sb) {
#pragma unroll
                for (int n = 0; n < 2; ++n) { const f32x4 sv = *(const LAS f32x4*)(PAS + sb * 512 + lane * 8 + 4 * n), hv = *(const LAS f32x4*)(PAH + sb * 512 + lane * 8 + 4 * n);
#pragma unroll
                    for (int j = 0; j < 4; ++j) h[n][j] = __expf(sv[j]) * h[n][j] + hv[j]; } }
            for (int sb = 0; sb < wave; ++sb) {
#pragma unroll
                for (int n = 0; n < 2; ++n) { const f32x4 sv = *(const LAS f32x4*)(PBS + sb * 512 + lane * 8 + 4 * n), hv = *(const LAS f32x4*)(PBH + sb * 512 + lane * 8 + 4 * n);
#pragma unroll
                    for (int j = 0; j < 4; ++j) h[n][j] = __expf(sv[j]) * h[n][j] + hv[j]; } }
            const bf16* ugp = UG + off;
            bf16* hgp = CAT + ((size_t)b * SEQ + (size_t)c * SCAN_T + wave * 16) * 1536 + 512 + hh * 512 + lane * 8;
            v4u gwk[16];
#pragma unroll
            for (int i = 0; i < 16; ++i) gwk[i] = *(const v4u*)(ugp + (size_t)i * DRNN);
#pragma unroll
            for (int i0 = 0; i0 < 16; i0 += 8) { const v4u* gw8 = gwk + i0;
#pragma unroll
                for (int i = 0; i < 8; ++i) { f32x4 l[2], bq[2], gq[2], o[2]; pg8::unpack8(lwk[i0 + i], l[0], l[1]); pg8::unpack8(bwk[i0 + i], bq[0], bq[1]); pg8::unpack8(gw8[i], gq[0], gq[1]);
#pragma unroll
                    for (int n = 0; n < 2; ++n)
#pragma unroll
                        for (int j = 0; j < 4; ++j) { h[n][j] = __expf(l[n][j]) * h[n][j] + bq[n][j]; o[n][j] = h[n][j] * pg8::gelu_tanh_(gq[n][j]); }
                    *(v4u*)(hgp + (size_t)(i0 + i) * 1536) = pg8::pack8(o[0], o[1]); } }
            __syncthreads();
        }
    }
    SEAM(5);
    TEND(5);

    TSTART(6);
    if (IN(6)) for (int rep = 0; rep < REPS(6); ++rep) { if (rep) GSYNC();
        pg8::Gemm g{CAT, WCAT, M, D, 1536, 1536, 1536, 0, 0}; pg8::StaticOrder S; S.init(M, D, G, bx);
        pg8::EpiMix E{G0, G1, MIXB};
        pg8::gemm_phase<pg8::EpiMix, true, 8>(lds, g, S, E);
    }
    SEAM(6);
    TEND(6);

    TSTART(7);
    if (IN(7)) for (int rep = 0; rep < REPS(7); ++rep) { if (rep) GSYNC();
        pg8::Gemm g{MIXB, WO, M, D, D, D, D, 0, 0}; pg8::StaticOrder S; S.init(M, D, G, bx);
        pg8::EpiRes1 E{XN, (const float*)(ws + WS_RSI), X1B, SSQ};
        pg8::gemm_phase<pg8::EpiRes1, true>(lds, g, S, E);
    }
    SEAM(7);
    TEND(7);

    TSTART(8);
    if (IN(8)) for (int rep = 0; rep < REPS(8); ++rep) { if (rep) GSYNC();
        pg8::Gemm g{X1B, WFI, M, 2 * DFF, D, D, D, 0, 0}; pg8::StaticOrder S; S.init(M, 2 * DFF, G, bx);
        LAS float* RSL = (LAS float*)(lds + 133120);
        { const int r = tid & 255;
          for (int i = tid >> 8; i < 8; i += 2) { pg8::Unit u; if (!S.next(i, u)) break;
              const f32x4* sp = (const f32x4*)(SSQ + (size_t)(u.pm * 256 + r) * 16); const f32x4 st = (sp[0] + sp[1]) + (sp[2] + sp[3]);
              RSL[i * 256 + r] = __builtin_amdgcn_rsqf(((st[0] + st[1]) + (st[2] + st[3])) * (1.0f / 1024.0f) + 1e-6f); }
          __syncthreads(); }
        pg8::EpiSwiglu E{RSL, ACT};
        pg8::gemm_phase<pg8::EpiSwiglu, true>(lds, g, S, E);
        if (G == 256 && bx >= 128) {
            LAS float* scr = (LAS float*)(lds + wave * 16384); constexpr int I_FO = (DFF / 64) * (D / 32);
            for (int r = (bx - 128) * NWAVES + wave; r < I_FO; r += 128 * NWAVES) { const int nblk = D / 32, kb = r / nblk, nb = r % nblk;
                transpose_item(args.in[I_W_FFN_OUT], D, DFF, WFO, 64 * kb, 32 * nb, 32 * nb, nullptr, scr, lane); }
        }
    }
    SEAM(8);
    TEND(8);

    TSTART(9);
    if (IN(9)) for (int rep = 0; rep < REPS(9); ++rep) { if (rep) GSYNC();
        pg8::Gemm g{ACT, WFO, M, D, DFF, DFF, DFF, 0, 0}; pg8::StaticOrder S; S.init(M, D, G, bx);
        if (G == 256) { pg8::EpiFinal E{X1B, X1, (float*)(ws + WS_SSQ2), (unsigned*)ws + 4096, args.in[I_NORM_FINAL]};
            pg8::gemm_phase<pg8::EpiFinal, true>(lds, g, S, E); }
        else { pg8::EpiRes2 E{X1B, X1};
            pg8::gemm_phase<pg8::EpiRes2, true>(lds, g, S, E); }
    }
    if (G != 256) SEAM(9);
    TEND(9);

    TSTART(10);
    if (IN(10) && G != 256) for (int rep = 0; rep < REPS(10); ++rep) { if (rep) GSYNC();
        const int gw = bx * NWAVES + wave, NGW = G * NWAVES;
        const float* gf = args.in[I_NORM_FINAL]; f32x4 gv[4];
#pragma unroll
        for (int j = 0; j < 4; ++j) gv[j] = ((const f32x4*)gf)[lane + 64 * j];
        for (int m = gw; m < M; m += NGW) {
            f32x4* xr = (f32x4*)(X1 + (size_t)m * D) + lane; f32x4 v[4]; float s = 0.f;
#pragma unroll
            for (int j = 0; j < 4; ++j) { v[j] = xr[64 * j]; s += (v[j].x * v[j].x + v[j].y * v[j].y) + (v[j].z * v[j].z + v[j].w * v[j].w); }
            const float rs = 1.0f / sqrtf(wave_sum(s) * (1.f / D) + EPS);
#pragma unroll
            for (int j = 0; j < 4; ++j) xr[64 * j] = v[j] * rs * gv[j];
        }
    }
    if (PROBE_PHASE == 10 || PROBE_PHASE == 99) tp1 = __builtin_amdgcn_s_memrealtime();
    if (PROBE_PHASE >= 0 && bx == 0 && tid == 0) { const unsigned long long dt = (tp1 - tp0) * PROBE_MULT, te = __builtin_amdgcn_s_memrealtime(); while (__builtin_amdgcn_s_memrealtime() - te < dt) __builtin_amdgcn_s_sleep(8); }
#undef IN
#undef SEAM
}

extern "C" void kernel_launch(void* const* d_in, const int* in_sizes, int n_in, void* d_out, int out_size, void* d_ws, size_t ws_size, hipStream_t stream) {
    static int grid = 0;
    if (grid == 0) {
        if (n_in != 19 || out_size != M * D || ws_size < WS_END) { fprintf(stderr, "kernel_launch: unexpected shapes (n_in %d out %d ws %zu)\n", n_in, out_size, ws_size); grid = -1; return; }
        int dev = 0, cus = 0, per_cu = 0;
        hipGetDevice(&dev);
        hipDeviceGetAttribute(&cus, hipDeviceAttributeMultiprocessorCount, dev);
        if (hipFuncSetAttribute((const void*)fwd_kernel, hipFuncAttributeMaxDynamicSharedMemorySize, LDS_BYTES) != hipSuccess) { fprintf(stderr, "kernel_launch: hipFuncSetAttribute failed\n"); grid = -1; return; }
        if (hipOccupancyMaxActiveBlocksPerMultiprocessor(&per_cu, (const void*)fwd_kernel, NTHR, LDS_BYTES) != hipSuccess || per_cu < 1) { fprintf(stderr, "kernel_launch: occupancy query says %d\n", per_cu); per_cu = 1; }
        (void)hipGetLastError();
        grid = cus * 1;
        fprintf(stderr, "kernel_launch: grid %d (cus %d, per_cu %d)\n", grid, cus, per_cu);
    }
    if (grid < 0) return;
    if (hipMemsetAsync(d_ws, 0, 49152, stream) != hipSuccess) { fprintf(stderr, "kernel_launch: memset failed\n"); return; }
    Args a{};
    for (int i = 0; i < 19; ++i) a.in[i] = (const float*)d_in[i];
    a.out = (float*)d_out; a.ws = (unsigned char*)d_ws;
#if MK_PER_PHASE
    for (int p = 0; p < NPH; ++p) { a.ph_lo = p; a.ph_hi = p + 1; hipLaunchKernelGGL(fwd_kernel, dim3(grid), dim3(NTHR), LDS_BYTES, stream, a); }
#else
    a.ph_lo = 0; a.ph_hi = NPH;
    void* kargs[] = {&a};
    hipError_t e = hipLaunchCooperativeKernel((const void*)fwd_kernel, dim3(grid), dim3(NTHR), kargs, LDS_BYTES, stream);
    if (e != hipSuccess) fprintf(stderr, "cooperative launch failed: %s (grid %d)\n", hipGetErrorString(e), grid);
#endif
}
```

```cpp
#include <hip/hip_runtime.h>
#include <hip/hip_cooperative_groups.h>
#include <cstdio>
#include <cstdint>
namespace cg = cooperative_groups;

#ifndef FG_VLDS
#define FG_VLDS 1
#endif
#ifndef MK_PER_PHASE
#define MK_PER_PHASE 0
#endif

namespace pg8 {
#define PG8_LAS __attribute__((address_space(3)))
typedef unsigned short bf16_t;
typedef short bf16x8 __attribute__((ext_vector_type(8)));
typedef float f32x4 __attribute__((ext_vector_type(4)));
typedef float f32x2 __attribute__((ext_vector_type(2)));
typedef unsigned u32x4 __attribute__((ext_vector_type(4)));
typedef unsigned u32x2 __attribute__((ext_vector_type(2)));
constexpr int BM = 256, BK = 64, HALF = 128, HTB = HALF * BK * 2, STAGE_BYTES = 8 * HTB, NXCD = 8, WGM = 8;

__host__ __device__ __forceinline__ int lds_byte(int r, int c) { const int st = (r >> 4) * 2 + (c >> 5), rr = r & 15, cc = c & 31, ob = rr * 64 + cc * 2; return st * 1024 + (ob ^ (((ob >> 9) & 1) << 5)); }
__host__ __device__ __forceinline__ void stage_rc(int b, int& R, int& C) { const int st = b / 1024, sb = b % 1024, swz = sb ^ (((sb >> 9) & 1) << 5); R = (st >> 1) * 16 + swz / 64; C = (st & 1) * 32 + (swz % 64) / 2; }
__host__ __device__ __forceinline__ int perm32(int rho) { const int n = rho >> 4, i = rho & 15; return 8 * (i >> 2) + 4 * n + (i & 3); }

struct Unit { int pm, pn, rh, idx; };
struct Gemm { const bf16_t* A; const bf16_t* Bt; int M, N, K, lda, ldb, ash, amul; };

struct StaticOrder {
    int nM, nN, nwg, G, c, limit, lin_base, lin_cnt;
    __host__ __device__ __forceinline__ void init(int M, int N, int G_, int c_) { nM = M / BM; nN = N / BM; nwg = nM * nN; G = G_; c = c_; limit = nwg; lin_base = 0; lin_cnt = -1; }
    __host__ __device__ __forceinline__ void map(int L, Unit& u) const {
        int wgid = L; { const int q = nwg / NXCD, r = nwg % NXCD, xcd = wgid % NXCD, off = wgid / NXCD; wgid = (xcd < r ? xcd * (q + 1) : r * (q + 1) + (xcd - r) * q) + off; }
        const int nig = WGM * nN, gid = wgid / nig, fm = gid * WGM, gsz = (nM - fm) < WGM ? (nM - fm) : WGM;
        u.pm = fm + ((wgid % nig) % gsz); u.pn = (wgid % nig) / gsz; u.rh = 0;
    }
    __host__ __device__ __forceinline__ bool next(int i, Unit& u) const {
        u.idx = i;
        if (lin_cnt >= 0) { if (i >= lin_cnt) return false; map(lin_base + i, u); return true; }
        const long L = (long)i * G + c; if (L >= limit) return false;
        map((int)L, u); return true;
    }
};

__device__ __forceinline__ unsigned cvt_pk_bf16(float lo, float hi) { unsigned r; asm volatile("v_cvt_pk_bf16_f32 %0, %1, %2" : "=v"(r) : "v"(lo), "v"(hi)); return r; }
__device__ __forceinline__ float bf_lo(unsigned w) { return __uint_as_float(w << 16); }
__device__ __forceinline__ float bf_hi(unsigned w) { return __uint_as_float(w & 0xffff0000u); }
__device__ __forceinline__ float sigmoidf_(float x) { return __builtin_amdgcn_rcpf(1.0f + __expf(-x)); }
__device__ __forceinline__ float gelu_tanh_(float x) { const float z = 1.5957691216057308f * (x + 0.044715f * x * x * x); return x * sigmoidf_(z); }
__device__ __forceinline__ u32x4 pack8(const f32x4 a, const f32x4 b) { u32x4 w; w.x = cvt_pk_bf16(a[0], a[1]); w.y = cvt_pk_bf16(a[2], a[3]); w.z = cvt_pk_bf16(b[0], b[1]); w.w = cvt_pk_bf16(b[2], b[3]); return w; }
__device__ __forceinline__ void unpack8(const u32x4 w, f32x4& a, f32x4& b) { a = (f32x4){bf_lo(w.x), bf_hi(w.x), bf_lo(w.y), bf_hi(w.y)}; b = (f32x4){bf_lo(w.z), bf_hi(w.z), bf_lo(w.w), bf_hi(w.w)}; }

#define EPI_ROWS_BEGIN _Pragma("unroll") for (int ai = 0; ai < NAI; ++ai) _Pragma("unroll") for (int m = 0; m < 4; ++m) { const int row = u.pm * BM + u.rh + ai * HALF + wr * 64 + m * 16 + fr;
#define EPI_ROWS_END }

struct EpiProj {
    bf16_t *UP, *UR, *UG, *RB, *G1; int pn_off;
    template <int NAI> __device__ __forceinline__ void run(const f32x4 (&acc)[2][2][4][2], const Unit& u, int wr, int wc, int fr, int fq) const {
        const int pn = u.pn + pn_off;
        if (pn < 10) {
            bf16_t* base; int ldc, colt;
            if (pn < 2) { base = UP; ldc = 512; colt = pn * 256; }
            else if (pn < 6) { base = UR; ldc = 1024; colt = (pn - 2) * 256; }
            else { base = UG; ldc = 1024; colt = (pn - 6) * 256; }
            const int col0 = colt + wc * 32 + 8 * fq;
            EPI_ROWS_BEGIN
                bf16_t* rowp = base + (unsigned)((unsigned)row * (unsigned)ldc + (unsigned)col0);
#pragma unroll
                for (int bj = 0; bj < 2; ++bj) *(u32x4*)(rowp + bj * HALF) = pack8(acc[ai][bj][m][0], acc[ai][bj][m][1]);
            EPI_ROWS_END
        } else {
            const int ch0 = (pn - 10) * 128 + wc * 32 + 8 * fq;
            EPI_ROWS_BEGIN
                const unsigned off = (unsigned)row * 1024u + (unsigned)ch0; f32x4 rr[2], gg[2];
#pragma unroll
                for (int n = 0; n < 2; ++n)
#pragma unroll
                    for (int j = 0; j < 4; ++j) { const float d0 = 1.0f + fminf(__expf(-acc[ai][0][m][n][j]), 1e18f), d1 = 1.0f + fminf(__expf(-acc[ai][1][m][n][j]), 1e18f);
                        const float q = __builtin_amdgcn_rcpf(d0 * d1); gg[n][j] = d0 * q; rr[n][j] = d1 * d1 * q; }
                *(u32x4*)(RB + off) = pack8(rr[0], rr[1]); *(u32x4*)(G1 + off) = pack8(gg[0], gg[1]);
            EPI_ROWS_END
        }
    }
};
struct EpiGrp {
    bf16_t* O; int ldc; const float* scale;
    template <int NAI> __device__ __forceinline__ void run(const f32x4 (&acc)[2][2][4][2], const Unit& u, int wr, int wc, int fr, int fq) const {
        const int col0 = u.pn * BM + wc * 32 + 8 * fq;
        f32x4 sc[2][2];
#pragma unroll
        for (int bj = 0; bj < 2; ++bj)
#pragma unroll
            for (int n = 0; n < 2; ++n) sc[bj][n] = *(const f32x4*)(scale + col0 + bj * HALF + 4 * n);
        EPI_ROWS_BEGIN
            bf16_t* rowp = O + (unsigned)((unsigned)row * (unsigned)ldc + (unsigned)col0);
#pragma unroll
            for (int bj = 0; bj < 2; ++bj) *(u32x4*)(rowp + bj * HALF) = pack8(acc[ai][bj][m][0] * sc[bj][0], acc[ai][bj][m][1] * sc[bj][1]);
        EPI_ROWS_END
    }
};
struct EpiGate {
    const bf16_t* V; bf16_t *LA, *BB; const float *b_a, *b_x, *sp8;
    const PG8_LAS unsigned char* vlds = nullptr; bool use_lds = false;
    template <int NAI, bool EXACT> __device__ __forceinline__ void rows(const f32x4 (&acc)[2][2][4][2], const Unit& u, int wr, int fr, int ch0, const f32x4 (&ba)[2], const f32x4 (&bx)[2], const f32x4 (&sp)[2]) const {
        u32x4 vwk[2][4];
        EPI_ROWS_BEGIN
            if (use_lds) vwk[ai][m] = *(const PG8_LAS u32x4*)(vlds + (((ch0 >> 6) & 1) * 2 + ai) * HTB + lds_byte((row & 127), (ch0 & 63)));
            else vwk[ai][m] = *(const u32x4*)(V + ((unsigned)row * 1536u + (unsigned)ch0));
        EPI_ROWS_END
        EPI_ROWS_BEGIN
            const unsigned off = (unsigned)row * 1024u + (unsigned)ch0;
            f32x4 vv[2]; unpack8(vwk[ai][m], vv[0], vv[1]);
            f32x4 la[2], bb[2];
#pragma unroll
            for (int n = 0; n < 2; ++n)
#pragma unroll
                for (int j = 0; j < 4; ++j) {
                    const float r = sigmoidf_(acc[ai][0][m][n][j] + ba[n][j]), ig = sigmoidf_(acc[ai][1][m][n][j] + bx[n][j]);
                    const float l = sp[n][j] * r, x2 = 2.0f * l;
                    const float poly = x2 * (1.0f + 0.5f * x2 * (1.0f + 0.33333334f * x2 * (1.0f + 0.25f * x2 * (1.0f + 0.2f * x2 * (1.0f + 0.16666667f * x2)))));
                    const float em1 = EXACT ? ((x2 > -0.25f) ? poly : (__expf(x2) - 1.0f)) : poly;
                    la[n][j] = l; bb[n][j] = __builtin_amdgcn_sqrtf(fmaxf(-em1, 0.f)) * ig * vv[n][j]; }
            *(u32x4*)(LA + ((unsigned)row * 1536u + (unsigned)ch0)) = pack8(la[0], la[1]); *(u32x4*)(BB + off) = pack8(bb[0], bb[1]);
        EPI_ROWS_END
    }
    template <int NAI> __device__ __forceinline__ void run(const f32x4 (&acc)[2][2][4][2], const Unit& u, int wr, int wc, int fr, int fq) const {
        const int ch0 = u.pn * 128 + wc * 32 + 8 * fq;
        f32x4 ba[2], bx[2], sp[2]; bool big = false;
#pragma unroll
        for (int n = 0; n < 2; ++n) { ba[n] = *(const f32x4*)(b_a + ch0 + 4 * n); bx[n] = *(const f32x4*)(b_x + ch0 + 4 * n); sp[n] = *(const f32x4*)(sp8 + ch0 + 4 * n);
#pragma unroll
            for (int j = 0; j < 4; ++j) big = big || !(sp[n][j] >= -0.125f); }
        if (__builtin_amdgcn_ballot_w64(big) != 0ull) rows<NAI, true>(acc, u, wr, fr, ch0, ba, bx, sp);
        else rows<NAI, false>(acc, u, wr, fr, ch0, ba, bx, sp);
    }
};
struct EpiMix {
    const bf16_t *RB, *G1; bf16_t* MIXB;
    __device__ __forceinline__ void mid(f32x4 (&acc)[2][2][4][2], const Unit& u0, int wr, int wc, int fr, int fq) const {
        constexpr int NAI = 2; Unit u = u0; asm volatile("" : "+s"(u.pm), "+s"(u.pn));
        const int col0 = u.pn * BM + wc * 32 + 8 * fq;
        u32x4 rw[2][4][2];
        EPI_ROWS_BEGIN
            const unsigned off = (unsigned)row * 1024u + (unsigned)col0;
#pragma unroll
            for (int bj = 0; bj < 2; ++bj) rw[ai][m][bj] = *(const u32x4*)(RB + off + bj * HALF);
        EPI_ROWS_END
        EPI_ROWS_BEGIN
#pragma unroll
            for (int bj = 0; bj < 2; ++bj) { f32x4 r[2]; unpack8(rw[ai][m][bj], r[0], r[1]); acc[ai][bj][m][0] *= r[0]; acc[ai][bj][m][1] *= r[1]; }
            (void)row;
        EPI_ROWS_END
    }
    template <int NAI> __device__ __forceinline__ void run(const f32x4 (&acc)[2][2][4][2], const Unit& u, int wr, int wc, int fr, int fq) const {
        const int col0 = u.pn * BM + wc * 32 + 8 * fq;
        u32x4 gw[2][4][2];
        EPI_ROWS_BEGIN
            const unsigned off = (unsigned)row * 1024u + (unsigned)col0;
#pragma unroll
            for (int bj = 0; bj < 2; ++bj) gw[ai][m][bj] = *(const u32x4*)(G1 + off + bj * HALF);
        EPI_ROWS_END
        EPI_ROWS_BEGIN
            const unsigned off = (unsigned)row * 1024u + (unsigned)col0;
#pragma unroll
            for (int bj = 0; bj < 2; ++bj) { f32x4 g[2]; unpack8(gw[ai][m][bj], g[0], g[1]);
                *(u32x4*)(MIXB + off + bj * HALF) = pack8(g[0] * acc[ai][bj][m][0], g[1] * acc[ai][bj][m][1]); }
        EPI_ROWS_END
    }
};
struct EpiRes1 {
    const bf16_t* XNB; const float* RSI; bf16_t* X1B; float* SSQ;
    template <int NAI> __device__ __forceinline__ void run(const f32x4 (&acc)[2][2][4][2], const Unit& u, int wr, int wc, int fr, int fq) const {
        const int col0 = u.pn * BM + wc * 32 + 8 * fq;
#pragma unroll
        for (int ai = 0; ai < NAI; ++ai) {
            u32x4 xw[4][2]; float qi[4];
#pragma unroll
            for (int m = 0; m < 4; ++m) { const int row = u.pm * BM + u.rh + ai * HALF + wr * 64 + m * 16 + fr; const unsigned off = (unsigned)row * 1024u + (unsigned)col0; qi[m] = RSI[row];
#pragma unroll
                for (int bj = 0; bj < 2; ++bj) xw[m][bj] = *(const u32x4*)(XNB + off + bj * HALF); }
            asm volatile("s_waitcnt vmcnt(0)" ::: "memory");
#pragma unroll
            for (int m = 0; m < 4; ++m) { const int row = u.pm * BM + u.rh + ai * HALF + wr * 64 + m * 16 + fr; const unsigned off = (unsigned)row * 1024u + (unsigned)col0; float ss = 0.f;
#pragma unroll
                for (int bj = 0; bj < 2; ++bj) { f32x4 xa, xb; unpack8(xw[m][bj], xa, xb);
                    const f32x4 a = xa * qi[m] + acc[ai][bj][m][0], b = xb * qi[m] + acc[ai][bj][m][1];
                    *(u32x4*)(X1B + off + bj * HALF) = pack8(a, b);
                    ss += (a[0] * a[0] + a[1] * a[1]) + (a[2] * a[2] + a[3] * a[3]) + (b[0] * b[0] + b[1] * b[1]) + (b[2] * b[2] + b[3] * b[3]); }
                ss += __shfl_xor(ss, 16); ss += __shfl_xor(ss, 32);
                if (fq == 0) SSQ[(unsigned)row * 16u + (unsigned)(u.pn * 4 + wc)] = ss; }
        }
    }
};
struct EpiSwiglu {
    const PG8_LAS float* RSL; bf16_t* ACT;
    template <int NAI> __device__ __forceinline__ void run(const f32x4 (&acc)[2][2][4][2], const Unit& u, int wr, int wc, int fr, int fq) const {
        const int col0 = u.pn * 128 + wc * 32 + 8 * fq;
        const PG8_LAS float* rt = RSL + u.idx * 256 + wr * 64 + fr;
        EPI_ROWS_BEGIN
            const float rs = rt[ai * HALF + m * 16];
            f32x4 o[2];
#pragma unroll
            for (int n = 0; n < 2; ++n)
#pragma unroll
                for (int j = 0; j < 4; ++j) { const float g = acc[ai][0][m][n][j] * rs, up = acc[ai][1][m][n][j] * rs; o[n][j] = g * sigmoidf_(g) * up; }
            __builtin_nontemporal_store(pack8(o[0], o[1]), (u32x4*)(ACT + (unsigned)((unsigned)row * 2816u + (unsigned)col0)));
        EPI_ROWS_END
    }
};
struct EpiRes2 {
    const bf16_t* X1B; float* OUT;
    template <int NAI> __device__ __forceinline__ void run(const f32x4 (&acc)[2][2][4][2], const Unit& u, int wr, int wc, int fr, int fq) const {
        const int col0 = u.pn * BM + wc * 32 + 8 * fq;
        EPI_ROWS_BEGIN
            const unsigned off = (unsigned)row * 1024u + (unsigned)col0;
#pragma unroll
            for (int bj = 0; bj < 2; ++bj) { f32x4 xa, xb; unpack8(*(const u32x4*)(X1B + off + bj * HALF), xa, xb);
                *(f32x4*)(OUT + off + bj * HALF) = xa + acc[ai][bj][m][0]; *(f32x4*)(OUT + off + bj * HALF + 4) = xb + acc[ai][bj][m][1]; }
        EPI_ROWS_END
    }
};

struct EpiFinal {
    const bf16_t* X1B; float* OUT; float* SSQ2; unsigned* cnt; const float* gfin;
    template <int NAI> __device__ __forceinline__ void run(f32x4 (&acc)[2][2][4][2], const Unit& u, int wr, int wc, int fr, int fq) const {
        const int col0 = u.pn * BM + wc * 32 + 8 * fq;
        { u32x4 xw[2][4][2];
          EPI_ROWS_BEGIN
              const unsigned off = (unsigned)row * 1024u + (unsigned)col0;
#pragma unroll
              for (int bj = 0; bj < 2; ++bj) xw[ai][m][bj] = *(const u32x4*)(X1B + off + bj * HALF);
          EPI_ROWS_END
          EPI_ROWS_BEGIN
              float ss = 0.f;
#pragma unroll
              for (int bj = 0; bj < 2; ++bj) { f32x4 xa, xb; unpack8(xw[ai][m][bj], xa, xb);
                  const f32x4 a = xa + acc[ai][bj][m][0], b = xb + acc[ai][bj][m][1]; acc[ai][bj][m][0] = a; acc[ai][bj][m][1] = b;
                  ss += (a[0] * a[0] + a[1] * a[1]) + (a[2] * a[2] + a[3] * a[3]) + (b[0] * b[0] + b[1] * b[1]) + (b[2] * b[2] + b[3] * b[3]); }
              ss += __shfl_xor(ss, 16); ss += __shfl_xor(ss, 32);
              if (fq == 0) __hip_atomic_store(SSQ2 + (unsigned)row * 16u + (unsigned)(u.pn * 4 + wc), ss, __ATOMIC_RELAXED, __HIP_MEMORY_SCOPE_AGENT);
          EPI_ROWS_END }
        asm volatile("s_waitcnt vmcnt(0)" ::: "memory");
        unsigned* c = cnt + 64 * u.pm;
        if ((threadIdx.x & 63) == 0) __hip_atomic_fetch_add(c, 1u, __ATOMIC_RELAXED, __HIP_MEMORY_SCOPE_AGENT);
        f32x4 gv[2][2];
#pragma unroll
        for (int bj = 0; bj < 2; ++bj)
#pragma unroll
            for (int n = 0; n < 2; ++n) gv[bj][n] = *(const f32x4*)(gfin + col0 + bj * HALF + 4 * n);
        { unsigned sp = 0;
          while ((unsigned)__builtin_amdgcn_readfirstlane(__hip_atomic_load(c, __ATOMIC_RELAXED, __HIP_MEMORY_SCOPE_AGENT)) < 32u) { __builtin_amdgcn_s_sleep(2); if (++sp > (1u << 20)) break; } }
        __builtin_amdgcn_fence(__ATOMIC_ACQUIRE, "agent");
        unsigned long long w0[2][4], w1[2][4];
        EPI_ROWS_BEGIN
            const unsigned long long* sl = (const unsigned long long*)(SSQ2 + (unsigned)row * 16u + (unsigned)(4 * fq));
            w0[ai][m] = __hip_atomic_load(sl, __ATOMIC_RELAXED, __HIP_MEMORY_SCOPE_AGENT); w1[ai][m] = __hip_atomic_load(sl + 1, __ATOMIC_RELAXED, __HIP_MEMORY_SCOPE_AGENT);
        EPI_ROWS_END
        EPI_ROWS_BEGIN
            const unsigned off = (unsigned)row * 1024u + (unsigned)col0;
            float sq = (__uint_as_float((unsigned)w0[ai][m]) + __uint_as_float((unsigned)(w0[ai][m] >> 32))) + (__uint_as_float((unsigned)w1[ai][m]) + __uint_as_float((unsigned)(w1[ai][m] >> 32)));
            sq += __shfl_xor(sq, 16); sq += __shfl_xor(sq, 32);
            const float rs = 1.0f / sqrtf(sq * (1.0f / 1024.0f) + 1e-6f);
#pragma unroll
            for (int bj = 0; bj < 2; ++bj) { *(f32x4*)(OUT + off + bj * HALF) = acc[ai][bj][m][0] * rs * gv[bj][0]; *(f32x4*)(OUT + off + bj * HALF + 4) = acc[ai][bj][m][1] * rs * gv[bj][1]; }
        EPI_ROWS_END
    }
};

template <class Epi, bool ALIGN_EPI, int MID_T = -1>
__device__ __forceinline__ void gemm_phase(PG8_LAS unsigned char* lds, const Gemm g, const StaticOrder& S, const Epi& E) {
    const int tid = threadIdx.x, wid = __builtin_amdgcn_readfirstlane(tid >> 6), lane = tid & 63, wr = wid >> 2, wc = wid & 3, fr = lane & 15, fq = lane >> 4;
    int nt = g.K / BK; asm volatile("" : "+s"(nt));
    unsigned voffA[2], voffB[2];
#pragma unroll
    for (int i = 0; i < 2; ++i) { int R, C; stage_rc(tid * 16 + i * 8192, R, C); const int Rb = (R & ~31) + perm32(R & 31);
        voffA[i] = (unsigned)(R * g.lda + C) * 2u; voffB[i] = (unsigned)(Rb * g.ldb + C) * 2u; }
    const size_t kstep = (size_t)(BK * 2);
    const size_t hstepA = (size_t)HALF * g.lda * 2, hstepB = (size_t)HALF * g.ldb * 2;
    const size_t tstepA = 2 * hstepA, tstepB = 2 * hstepB;
    const unsigned ldsw = (unsigned)wid * 1024u;
    const int aoff = lds_byte(wr * 64 + fr, fq * 8), boff = lds_byte(wc * 32 + fr, fq * 8);
#define PG8_SA(b, h) (((b) * 2 + (h)) * HTB)
#define PG8_SB(b, h) ((4 + (b) * 2 + (h)) * HTB)
#define PG8_STAGE(bufoff, gbase, voff) do { _Pragma("unroll") for (int _i = 0; _i < 2; ++_i) \
        __builtin_amdgcn_global_load_lds((const unsigned*)((const char*)(gbase) + (voff)[_i]), (PG8_LAS unsigned*)(lds + (bufoff) + ldsw + _i * 8192), 16, 0, 0); } while (0)
#define PG8_LDA(dst, b, h) do { _Pragma("unroll") for (int m = 0; m < 4; ++m) _Pragma("unroll") for (int k = 0; k < 2; ++k) dst[m][k] = *(const PG8_LAS bf16x8*)(lds + PG8_SA(b, h) + aoff + m * 2048 + k * 1024); } while (0)
#define PG8_LDB(dst, b, h) do { _Pragma("unroll") for (int n = 0; n < 2; ++n) _Pragma("unroll") for (int k = 0; k < 2; ++k) dst[n][k] = *(const PG8_LAS bf16x8*)(lds + PG8_SB(b, h) + boff + n * 2048 + k * 1024); } while (0)
#define PG8_MMA(ai, bj, At, Bt) do { __builtin_amdgcn_s_setprio(1); _Pragma("unroll") for (int m = 0; m < 4; ++m) _Pragma("unroll") for (int n = 0; n < 2; ++n) _Pragma("unroll") for (int k = 0; k < 2; ++k) \
        acc[ai][bj][m][n] = __builtin_amdgcn_mfma_f32_16x16x32_bf16(Bt[n][k], At[m][k], acc[ai][bj][m][n], 0, 0, 0); __builtin_amdgcn_s_setprio(0); } while (0)
#define PG8_WAIT_V(n) asm volatile("s_waitcnt vmcnt(" #n ")" ::: "memory")
#define PG8_WAIT_L(n) asm volatile("s_waitcnt lgkmcnt(" #n ")" ::: "memory")
#define PG8_BAR __builtin_amdgcn_s_barrier()
#define PG8_SCHED __builtin_amdgcn_sched_barrier(0)
    Unit cur, nxt; int ui = 0;
    if (!S.next(0, cur)) return;
    f32x4 acc[2][2][4][2];
#pragma unroll
    for (int a = 0; a < 2; ++a)
#pragma unroll
        for (int b = 0; b < 2; ++b)
#pragma unroll
            for (int m = 0; m < 4; ++m)
#pragma unroll
                for (int n = 0; n < 2; ++n) acc[a][b][m][n] = (f32x4){0.f, 0.f, 0.f, 0.f};
    bf16x8 At[4][2], B0[2][2], B1[2][2];
    const char* cA = (const char*)g.A + (size_t)cur.pm * tstepA + (size_t)((cur.pn >> g.ash) * g.amul) * 2; const char* cB = (const char*)g.Bt + (size_t)cur.pn * tstepB;
    PG8_STAGE(PG8_SB(0, 0), cB, voffB); PG8_STAGE(PG8_SB(0, 1), cB + hstepB, voffB); PG8_STAGE(PG8_SA(0, 0), cA, voffA); PG8_STAGE(PG8_SA(0, 1), cA + hstepA, voffA);
    if (wr == 1) PG8_BAR;
    PG8_WAIT_V(2); PG8_BAR;
    PG8_STAGE(PG8_SB(1, 0), cB + kstep, voffB); PG8_STAGE(PG8_SA(1, 0), cA + kstep, voffA); PG8_STAGE(PG8_SB(1, 1), cB + hstepB + kstep, voffB);
    PG8_WAIT_V(6); PG8_BAR;
    for (;;) {
        const bool has_next = S.next(ui + 1, nxt);
        const char* nA = has_next ? (const char*)g.A + (size_t)nxt.pm * tstepA + (size_t)((nxt.pn >> g.ash) * g.amul) * 2 : cA; const char* nB = has_next ? (const char*)g.Bt + (size_t)nxt.pn * tstepB : cB;
        for (int t = 0; t < nt; t += 2) {
            const bool last = (t == nt - 2);
            if constexpr (MID_T >= 0) { if (t == MID_T) E.mid(acc, cur, wr, wc, fr, fq); }
            const char* a1 = cA + (size_t)(t + 1) * kstep;
            const char* a2 = last ? nA : cA + (size_t)(t + 2) * kstep; const char* b2 = last ? nB : cB + (size_t)(t + 2) * kstep;
            const char* a3 = a2 + kstep; const char* b3 = b2 + kstep;
            PG8_LDB(B0, 0, 0); PG8_LDB(B1, 0, 1); PG8_SCHED; PG8_LDA(At, 0, 0); PG8_STAGE(PG8_SA(1, 1), a1 + hstepA, voffA);
            PG8_WAIT_V(8); PG8_WAIT_L(0); PG8_BAR; PG8_MMA(0, 0, At, B0); PG8_MMA(0, 1, At, B1); PG8_BAR; PG8_SCHED;
            PG8_LDA(At, 0, 1); PG8_STAGE(PG8_SB(0, 0), b2, voffB); PG8_STAGE(PG8_SB(0, 1), b2 + hstepB, voffB); PG8_STAGE(PG8_SA(0, 0), a2, voffA);
            PG8_WAIT_V(8); PG8_WAIT_L(0); PG8_BAR; PG8_MMA(1, 0, At, B0); PG8_MMA(1, 1, At, B1); PG8_BAR; PG8_SCHED;
            PG8_LDB(B0, 1, 0); PG8_LDB(B1, 1, 1); PG8_SCHED; PG8_LDA(At, 1, 0); PG8_STAGE(PG8_SA(0, 1), a2 + hstepA, voffA);
            PG8_WAIT_V(8); PG8_WAIT_L(0); PG8_BAR; PG8_MMA(0, 0, At, B0); PG8_MMA(0, 1, At, B1); PG8_BAR; PG8_SCHED;
            PG8_LDA(At, 1, 1); PG8_STAGE(PG8_SB(1, 0), b3, voffB); PG8_STAGE(PG8_SB(1, 1), b3 + hstepB, voffB); PG8_STAGE(PG8_SA(1, 0), a3, voffA);
            PG8_WAIT_V(8); PG8_WAIT_L(0); PG8_BAR; PG8_MMA(1, 0, At, B0); PG8_MMA(1, 1, At, B1); PG8_BAR; PG8_SCHED;
        }
        if constexpr (ALIGN_EPI) { if (wr == 0) PG8_BAR; }
        E.template run<2>(acc, cur, wr, wc, fr, fq);
        if (!has_next) break;
#pragma unroll
        for (int a = 0; a < 2; ++a)
#pragma unroll
            for (int b = 0; b < 2; ++b)
#pragma unroll
                for (int m = 0; m < 4; ++m)
#pragma unroll
                    for (int n = 0; n < 2; ++n) acc[a][b][m][n] = (f32x4){0.f, 0.f, 0.f, 0.f};
        cur = nxt; cA = nA; cB = nB; ++ui;
        if constexpr (ALIGN_EPI) { if (wr == 1) PG8_BAR; }
    }
    PG8_WAIT_V(0);
    if constexpr (!ALIGN_EPI) { if (wr == 0) PG8_BAR; }
    PG8_BAR;
#undef PG8_SA
#undef PG8_SB
#undef PG8_STAGE
#undef PG8_LDA
#undef PG8_LDB
#undef PG8_MMA
#undef PG8_WAIT_V
#undef PG8_WAIT_L
#undef PG8_BAR
#undef PG8_SCHED
}

template <class Epi>
__device__ __forceinline__ void gemm_half(PG8_LAS unsigned char* lds, const Gemm g, const Unit u, const Epi& E) {
    const int tid = threadIdx.x, wid = __builtin_amdgcn_readfirstlane(tid >> 6), lane = tid & 63, wr = wid >> 2, wc = wid & 3, fr = lane & 15, fq = lane >> 4;
    int nt = g.K / BK; asm volatile("" : "+s"(nt));
    unsigned voffA[2], voffB[2];
#pragma unroll
    for (int i = 0; i < 2; ++i) { int R, C; stage_rc(tid * 16 + i * 8192, R, C); const int Rb = (R & ~31) + perm32(R & 31);
        voffA[i] = (unsigned)(R * g.lda + C) * 2u; voffB[i] = (unsigned)(Rb * g.ldb + C) * 2u; }
    const size_t kstep = (size_t)(BK * 2);
    const size_t hstepA = (size_t)HALF * g.lda * 2, hstepB = (size_t)HALF * g.ldb * 2;
    const unsigned ldsw = (unsigned)wid * 1024u;
    const int aoff = lds_byte(wr * 64 + fr, fq * 8), boff = lds_byte(wc * 32 + fr, fq * 8);
#define PG8_SA(b, h) (((b) * 2 + (h)) * HTB)
#define PG8_SB(b, h) ((4 + (b) * 2 + (h)) * HTB)
#define PG8_STAGE(bufoff, gbase, voff) do { _Pragma("unroll") for (int _i = 0; _i < 2; ++_i) \
        __builtin_amdgcn_global_load_lds((const unsigned*)((const char*)(gbase) + (voff)[_i]), (PG8_LAS unsigned*)(lds + (bufoff) + ldsw + _i * 8192), 16, 0, 0); } while (0)
#define PG8_LDA(dst, b, h) do { _Pragma("unroll") for (int m = 0; m < 4; ++m) _Pragma("unroll") for (int k = 0; k < 2; ++k) dst[m][k] = *(const PG8_LAS bf16x8*)(lds + PG8_SA(b, h) + aoff + m * 2048 + k * 1024); } while (0)
#define PG8_LDB(dst, b, h) do { _Pragma("unroll") for (int n = 0; n < 2; ++n) _Pragma("unroll") for (int k = 0; k < 2; ++k) dst[n][k] = *(const PG8_LAS bf16x8*)(lds + PG8_SB(b, h) + boff + n * 2048 + k * 1024); } while (0)
#define PG8_MMA(ai, bj, At, Bt) do { __builtin_amdgcn_s_setprio(1); _Pragma("unroll") for (int m = 0; m < 4; ++m) _Pragma("unroll") for (int n = 0; n < 2; ++n) _Pragma("unroll") for (int k = 0; k < 2; ++k) \
        acc[ai][bj][m][n] = __builtin_amdgcn_mfma_f32_16x16x32_bf16(Bt[n][k], At[m][k], acc[ai][bj][m][n], 0, 0, 0); __builtin_amdgcn_s_setprio(0); } while (0)
#define PG8_WAIT_V(n) asm volatile("s_waitcnt vmcnt(" #n ")" ::: "memory")
#define PG8_WAIT_L(n) asm volatile("s_waitcnt lgkmcnt(" #n ")" ::: "memory")
#define PG8_BAR __builtin_amdgcn_s_barrier()
#define PG8_SCHED __builtin_amdgcn_sched_barrier(0)
    f32x4 acc[2][2][4][2];
#pragma unroll
    for (int a = 0; a < 2; ++a)
#pragma unroll
        for (int b = 0; b < 2; ++b)
#pragma unroll
            for (int m = 0; m < 4; ++m)
#pragma unroll
                for (int n = 0; n < 2; ++n) acc[a][b][m][n] = (f32x4){0.f, 0.f, 0.f, 0.f};
    bf16x8 At[4][2], B0[2][2], B1[2][2];
    const char* cA = (const char*)g.A + ((size_t)u.pm * BM + u.rh) * g.lda * 2 + (size_t)((u.pn >> g.ash) * g.amul) * 2; const char* cB = (const char*)g.Bt + (size_t)u.pn * 2 * hstepB;
    PG8_STAGE(PG8_SB(0, 0), cB, voffB); PG8_STAGE(PG8_SB(0, 1), cB + hstepB, voffB); PG8_STAGE(PG8_SA(0, 0), cA, voffA);
    PG8_STAGE(PG8_SB(1, 0), cB + kstep, voffB); PG8_STAGE(PG8_SB(1, 1), cB + hstepB + kstep, voffB); PG8_STAGE(PG8_SA(1, 0), cA + kstep, voffA);
    PG8_WAIT_V(6); PG8_BAR;
#define PG8_HALF_STEP(b, tt) do { \
        PG8_LDB(B0, b, 0); PG8_LDB(B1, b, 1); PG8_LDA(At, b, 0); PG8_WAIT_L(0); PG8_BAR; PG8_SCHED; \
        const bool more_ = (tt) + 2 < nt; \
        if (more_) { const char* b2 = cB + (size_t)((tt) + 2) * kstep; const char* a2 = cA + (size_t)((tt) + 2) * kstep; \
            PG8_STAGE(PG8_SB(b, 0), b2, voffB); PG8_STAGE(PG8_SB(b, 1), b2 + hstepB, voffB); PG8_STAGE(PG8_SA(b, 0), a2, voffA); } \
        PG8_MMA(0, 0, At, B0); PG8_MMA(0, 1, At, B1); \
        if (more_) PG8_WAIT_V(6); else PG8_WAIT_V(0); \
        PG8_BAR; PG8_SCHED; } while (0)
    for (int t = 0; t < nt; t += 2) { PG8_HALF_STEP(0, t); PG8_HALF_STEP(1, t + 1); }
    E.template run<1>(acc, u, wr, wc, fr, fq);
    PG8_BAR;
#undef PG8_HALF_STEP
#undef PG8_SA
#undef PG8_SB
#undef PG8_STAGE
#undef PG8_LDA
#undef PG8_LDB
#undef PG8_MMA
#undef PG8_WAIT_V
#undef PG8_WAIT_L
#undef PG8_BAR
#undef PG8_SCHED
}
template <class Epi>
__device__ __forceinline__ void gate_unit_fused(PG8_LAS unsigned char* lds, const bf16_t* UR, const float* convw, const float* convb, const bf16_t* WG, const Epi& E, int pm, int h, bf16_t* Vg) {
    const int tid = threadIdx.x, wid = __builtin_amdgcn_readfirstlane(tid >> 6), lane = tid & 63, wr = wid >> 2, wc = wid & 3, fr = lane & 15, fq = lane >> 4;
    { const char* cB = (const char*)WG + (size_t)h * 256 * 128 * 2;
#pragma unroll
      for (int i = 0; i < 2; ++i) { int R, C; stage_rc(tid * 16 + i * 8192, R, C); const int Rb = (R & ~31) + perm32(R & 31); const unsigned vo = (unsigned)(Rb * 128 + C) * 2u;
#pragma unroll
          for (int kt = 0; kt < 2; ++kt)
#pragma unroll
              for (int hb = 0; hb < 2; ++hb)
                  __builtin_amdgcn_global_load_lds((const unsigned*)(cB + (size_t)hb * 128 * 128 * 2 + kt * 128 + vo), (PG8_LAS unsigned*)(lds + (4 + kt * 2 + hb) * HTB + wid * 1024 + i * 8192), 16, 0, 0); } }
    { const int to = tid >> 4, co = tid & 15, t0 = pm * 256 + to * 8, tl = t0 & 4095, cog = h * 16 + co;
      const bf16_t* src = UR + (size_t)t0 * 1024 + cog * 8; const float* cw = convw + cog * 8; const float* cb = convb + cog * 8;
      u32x4 rw[11];
#pragma unroll
      for (int k = 0; k < 11; ++k) rw[k] = (k >= 3 || tl != 0) ? *(const u32x4*)(src + (ptrdiff_t)(k - 3) * 1024) : (u32x4){0u, 0u, 0u, 0u};
      f32x4 w0[2], w1[2], w2[2], w3[2], bb[2];
#pragma unroll
      for (int n = 0; n < 2; ++n) { w0[n] = *(const f32x4*)(cw + 4 * n); w1[n] = *(const f32x4*)(cw + 1024 + 4 * n); w2[n] = *(const f32x4*)(cw + 2048 + 4 * n); w3[n] = *(const f32x4*)(cw + 3072 + 4 * n); bb[n] = *(const f32x4*)(cb + 4 * n); }
#pragma unroll
      for (int i = 0; i < 8; ++i) { f32x4 a[2], b[2], c[2], d[2]; unpack8(rw[i], a[0], a[1]); unpack8(rw[i + 1], b[0], b[1]); unpack8(rw[i + 2], c[0], c[1]); unpack8(rw[i + 3], d[0], d[1]);
          const int tr = to * 8 + i;
          const u32x4 cv = pack8(bb[0] + w0[0] * a[0] + w1[0] * b[0] + w2[0] * c[0] + w3[0] * d[0], bb[1] + w0[1] * a[1] + w1[1] * b[1] + w2[1] * c[1] + w3[1] * d[1]);
          *(PG8_LAS u32x4*)(lds + ((co >> 3) * 2 + (tr >> 7)) * HTB + lds_byte(tr & 127, (co & 7) * 8)) = cv;
          if (Vg) *(u32x4*)(Vg + (size_t)(t0 + i) * 1536 + cog * 8) = cv; } }
    asm volatile("s_waitcnt vmcnt(0) lgkmcnt(0)" ::: "memory"); __syncthreads(); __builtin_amdgcn_sched_barrier(0);
    f32x4 acc[2][2][4][2];
#pragma unroll
    for (int a = 0; a < 2; ++a)
#pragma unroll
        for (int b = 0; b < 2; ++b)
#pragma unroll
            for (int m = 0; m < 4; ++m)
#pragma unroll
                for (int n = 0; n < 2; ++n) acc[a][b][m][n] = (f32x4){0.f, 0.f, 0.f, 0.f};
    const int aoff = lds_byte(wr * 64 + fr, fq * 8), boff = lds_byte(wc * 32 + fr, fq * 8);
#pragma unroll
    for (int kt = 0; kt < 2; ++kt) {
#pragma unroll
        for (int ai = 0; ai < 2; ++ai) { bf16x8 At[4][2];
#pragma unroll
            for (int m = 0; m < 4; ++m)
#pragma unroll
                for (int k = 0; k < 2; ++k) At[m][k] = *(const PG8_LAS bf16x8*)(lds + (kt * 2 + ai) * HTB + aoff + m * 2048 + k * 1024);
#pragma unroll
            for (int bj = 0; bj < 2; ++bj) { bf16x8 Bf[2][2];
#pragma unroll
                for (int n = 0; n < 2; ++n)
#pragma unroll
                    for (int k = 0; k < 2; ++k) Bf[n][k] = *(const PG8_LAS bf16x8*)(lds + (4 + kt * 2 + bj) * HTB + boff + n * 2048 + k * 1024);
#pragma unroll
                for (int m = 0; m < 4; ++m)
#pragma unroll
                    for (int n = 0; n < 2; ++n)
#pragma unroll
                        for (int k = 0; k < 2; ++k) acc[ai][bj][m][n] = __builtin_amdgcn_mfma_f32_16x16x32_bf16(Bf[n][k], At[m][k], acc[ai][bj][m][n], 0, 0, 0);
                __builtin_amdgcn_sched_barrier(0); } } }
    Unit u; u.pm = pm; u.pn = h; u.rh = 0; u.idx = 0;
    E.template run<2>(acc, u, wr, wc, fr, fq);
    __syncthreads();
}
}

constexpr int NWAVES = 8, NTHR = 512;
constexpr int M = 16384, SEQ = 4096, NB = 4, D = 1024, DPOOL = 512, DRNN = 1024, DIN = 4608, DFF = 2816;
constexpr float EPS = 1e-6f;
constexpr int NPH = 11;
constexpr int SCAN_T = 128, SCAN_NC = SEQ / SCAN_T;

constexpr size_t MiB = 1u << 20;
constexpr size_t WS_SP8 = 512 * 1024;
constexpr size_t WS_RSI = 576 * 1024;
constexpr size_t WS_SSQ = 1 * MiB;
constexpr size_t WS_SSQ2 = 2 * MiB;
constexpr size_t WS_CS = 2 * MiB, WS_CH = 3 * MiB;
constexpr size_t WS_WIN = 4 * MiB;
constexpr size_t WS_WFI = 13 * MiB;
constexpr size_t WS_WFO = 24 * MiB;
constexpr size_t WS_WCAT = WS_WFO + 5632 * 1024;
constexpr size_t WS_WO = WS_WCAT + 3 * MiB;
constexpr size_t WS_WGRP = WS_WO + 2 * MiB;
constexpr size_t WS_WGATE = WS_WGRP + MiB / 4;
constexpr size_t WS_R1 = 36 * MiB;
constexpr size_t WS_R2 = 68 * MiB;
constexpr size_t WS_R3 = 84 * MiB;
constexpr size_t WS_R4 = 116 * MiB;
constexpr size_t WS_R7 = 148 * MiB;
constexpr size_t WS_R8 = 164 * MiB;
constexpr size_t WS_CAT = 196 * MiB;
constexpr size_t WS_MIXB = 148 * MiB;
constexpr size_t WS_ACT = 68 * MiB;
constexpr size_t WS_END = 244 * MiB;

constexpr int LDS_BYTES = 147456;

#define LAS __attribute__((address_space(3)))
typedef unsigned short bf16;
typedef unsigned v4u __attribute__((ext_vector_type(4)));
typedef unsigned v2u __attribute__((ext_vector_type(2)));
typedef float f32x4 __attribute__((ext_vector_type(4)));
typedef float f32x2 __attribute__((ext_vector_type(2)));
#define LDS_WAIT() asm volatile("s_waitcnt lgkmcnt(0)" ::: "memory")
using pg8::cvt_pk_bf16; using pg8::bf_lo; using pg8::bf_hi;

struct Args { const float* in[19]; float* out; unsigned char* ws; int ph_lo, ph_hi; };
enum { I_X = 0, I_NORM_MIX, I_W_IN, I_W_GRP, I_POOL_SCALE, I_W_POOL_OUT, I_CONV_W, I_CONV_B, I_W_RG_A, I_B_RG_A, I_W_RG_X, I_B_RG_X, I_LAMBDA, I_W_RNN_OUT, I_W_O, I_NORM_FFN, I_W_FFN_IN, I_W_FFN_OUT, I_NORM_FINAL };

__device__ __forceinline__ float wave_sum(float v) {
#pragma unroll
    for (int o = 1; o < 64; o <<= 1) v += __shfl_xor(v, o);
    return v;
}

__device__ __forceinline__ void transpose_item(const float* W, int Nsrc, int Kdst, bf16* WT, int k0, int n_src0, int n_dst0, const float* kscale, LAS float* scr, int lane) {
    f32x4 v[8]; const int n4 = (lane & 7) * 4;
#pragma unroll
    for (int i = 0; i < 8; ++i) { const int kk = 8 * i + (lane >> 3); v[i] = *(const f32x4*)(W + (size_t)(k0 + kk) * Nsrc + n_src0 + n4); }
    if (kscale) {
#pragma unroll
        for (int i = 0; i < 8; ++i) v[i] = v[i] * kscale[k0 + 8 * i + (lane >> 3)]; }
#pragma unroll
    for (int i = 0; i < 8; ++i) { const int kk = 8 * i + (lane >> 3);
#pragma unroll
        for (int j = 0; j < 4; ++j) scr[kk * 33 + n4 + j] = v[i][j]; }
    LDS_WAIT(); asm volatile("" ::: "memory");
    const int c = lane & 7;
#pragma unroll
    for (int j = 0; j < 4; ++j) { const int n = (lane >> 3) + 8 * j; const LAS float* s = scr + (8 * c) * 33 + n;
        v4u o; o.x = cvt_pk_bf16(s[0 * 33], s[1 * 33]); o.y = cvt_pk_bf16(s[2 * 33], s[3 * 33]); o.z = cvt_pk_bf16(s[4 * 33], s[5 * 33]); o.w = cvt_pk_bf16(s[6 * 33], s[7 * 33]);
        *(v4u*)(WT + (size_t)(n_dst0 + n) * Kdst + k0 + 8 * c) = o; }
    LDS_WAIT(); asm volatile("" ::: "memory");
}

#define XB_TMO      128
#define XB_XCNT(j)  (256  + 64 * (j))
#define XB_XSUB(j)  (1280 + 64 * (j))
#define XB_XGEN(j)  (2304 + 64 * (j))
#define XB_TOP      3328
#define XB_TOPGEN   3392
#define XCD_BAR_WORDS 3456
#define XB_SPIN_CAP (1u << 18)
__device__ __forceinline__ unsigned xb_ld(unsigned* p)              { return __hip_atomic_load(p, __ATOMIC_RELAXED, __HIP_MEMORY_SCOPE_AGENT); }
__device__ __forceinline__ unsigned xb_add(unsigned* p, unsigned v) { return __hip_atomic_fetch_add(p, v, __ATOMIC_RELAXED, __HIP_MEMORY_SCOPE_AGENT); }
__device__ __forceinline__ unsigned xb_xcc_id() { return (unsigned)__builtin_amdgcn_s_getreg((3 << 11) | 20) & 0xFu; }
#define XB_SPIN(cond, bar) do { unsigned _sp = 0; while (cond) { __builtin_amdgcn_s_sleep(1); \
    if ((++_sp & 255u) == 0u) { if (xb_ld(&(bar)[XB_TMO])) break; if (_sp > XB_SPIN_CAP) { atomicAdd(&(bar)[XB_TMO], 1u); break; } } } } while (0)
struct XcdBarrier { unsigned* bar; unsigned x; volatile LAS unsigned* st; };
__device__ __forceinline__ XcdBarrier xcd_barrier_post(unsigned* bar, volatile LAS unsigned* st) {
    XcdBarrier b; b.bar = bar; b.x = xb_xcc_id(); b.st = st;
    if (threadIdx.x == 0) (void)xb_add(&bar[XB_XCNT(b.x)], 1u);
    return b;
}
__device__ __forceinline__ void xcd_barrier_complete(unsigned* bar, unsigned x, unsigned& nloc, unsigned& nx) {
    const unsigned G = gridDim.x * gridDim.y * gridDim.z;
    unsigned sum, cnt, mine, sp = 0u;
    for (;;) {
        sum = 0u; cnt = 0u; mine = 0u;
#pragma unroll
        for (unsigned j = 0; j < 16; ++j) { const unsigned c = xb_ld(&bar[XB_XCNT(j)]); sum += c; cnt += (c > 0u) ? 1u : 0u; mine = (j == x) ? c : mine; }
        if (sum == G) break;
        __builtin_amdgcn_s_sleep(1);
        if ((++sp & 255u) == 0u) { if (xb_ld(&bar[XB_TMO])) break; if (sp > XB_SPIN_CAP) { atomicAdd(&bar[XB_TMO], 1u); break; } }
    }
    nloc = mine > 0u ? mine : 1u; nx = cnt > 0u ? cnt : 1u;
}
__device__ __forceinline__ void xcd_barrier(const XcdBarrier& b) {
    asm volatile("s_waitcnt vmcnt(0)" ::: "memory");
    __syncthreads();
    if (threadIdx.x == 0) {
        unsigned* bar = b.bar;
        __builtin_amdgcn_s_waitcnt(0);
        unsigned nloc = b.st[0], nx = b.st[1];
        if (nloc == 0u) { xcd_barrier_complete(bar, b.x, nloc, nx); b.st[0] = nloc; b.st[1] = nx; }
        const unsigned old = xb_add(&bar[XB_XSUB(b.x)], 1u);
        const unsigned gen = old / nloc;
        if (old + 1u == (gen + 1u) * nloc) {
            __builtin_amdgcn_fence(__ATOMIC_RELEASE, "agent");
            asm volatile("s_waitcnt vmcnt(0)" ::: "memory");
            const unsigned og = xb_add(&bar[XB_TOP], 1u);
            const unsigned tg = og / nx;
            if (og + 1u == (tg + 1u) * nx) xb_add(&bar[XB_TOPGEN], 1u);
            else XB_SPIN(xb_ld(&bar[XB_TOPGEN]) == tg, bar);
            __builtin_amdgcn_fence(__ATOMIC_ACQUIRE, "agent");
            xb_add(&bar[XB_XGEN(b.x)], 1u);
            asm volatile("s_waitcnt vmcnt(0)" ::: "memory");
        } else {
            XB_SPIN(xb_ld(&bar[XB_XGEN(b.x)]) == gen, bar);
            __builtin_amdgcn_fence(__ATOMIC_ACQUIRE, "agent");
            asm volatile("s_waitcnt vmcnt(0)" ::: "memory");
        }
    }
    __syncthreads();
}

template <int W>
__device__ __forceinline__ void pool_item(const bf16* src, bf16* dst, int tl) {
    v4u rw[W + 7];
#pragma unroll
    for (int k = 0; k < W + 7; ++k) rw[k] = (tl + k - (W - 1) >= 0) ? *(const v4u*)(src + (ptrdiff_t)(k - (W - 1)) * DPOOL) : (v4u){0u, 0u, 0u, 0u};
    f32x4 s0 = {0.f, 0.f, 0.f, 0.f}, s1 = s0;
#pragma unroll
    for (int k = 0; k < W - 1; ++k) { f32x4 a, c; pg8::unpack8(rw[k], a, c); s0 += a; s1 += c; }
#pragma unroll
    for (int i = 0; i < 8; ++i) { f32x4 a, c; pg8::unpack8(rw[W - 1 + i], a, c); s0 += a; s1 += c;
        const int t = tl + i; const int cnt = (t + 1 < W) ? t + 1 : W; const float inv = 1.0f / (float)cnt;
        *(v4u*)(dst + (size_t)i * DPOOL) = pg8::pack8(s0 * inv - a, s1 * inv - c);
        f32x4 a2, c2; pg8::unpack8(rw[i], a2, c2); s0 -= a2; s1 -= c2; }
}
__device__ __forceinline__ void scan_local16(const bf16* lap, const bf16* bbp, f32x4 (&S)[2], f32x4 (&H)[2]) {
    S[0] = S[1] = H[0] = H[1] = (f32x4){0.f, 0.f, 0.f, 0.f};
#pragma unroll
    for (int i0 = 0; i0 < 16; i0 += 8) { v4u lw[8], bw[8];
#pragma unroll
        for (int i = 0; i < 8; ++i) { lw[i] = *(const v4u*)(lap + (size_t)(i0 + i) * DRNN); bw[i] = *(const v4u*)(bbp + (size_t)(i0 + i) * DRNN); }
#pragma unroll
        for (int i = 0; i < 8; ++i) { f32x4 l[2], bq[2]; pg8::unpack8(lw[i], l[0], l[1]); pg8::unpack8(bw[i], bq[0], bq[1]);
#pragma unroll
            for (int n = 0; n < 2; ++n)
#pragma unroll
                for (int j = 0; j < 4; ++j) { H[n][j] = __expf(l[n][j]) * H[n][j] + bq[n][j]; S[n][j] += l[n][j]; } } }
}

__device__ __forceinline__ void conv_item(const bf16* UR, bf16* V, const float* convw, const float* convb, int t0, int co) {
    const int tl = t0 & (SEQ - 1);
    const bf16* src = UR + (size_t)t0 * DRNN + co * 8; bf16* dst = V + (size_t)t0 * 1536 + co * 8;
    const float* cw = convw + co * 8; const float* cb = convb + co * 8;
    v4u rw[11];
#pragma unroll
    for (int k = 0; k < 11; ++k) rw[k] = (k >= 3 || tl != 0) ? *(const v4u*)(src + (ptrdiff_t)(k - 3) * DRNN) : (v4u){0u, 0u, 0u, 0u};
    f32x4 w0[2], w1[2], w2[2], w3[2], bb[2];
#pragma unroll
    for (int n = 0; n < 2; ++n) { w0[n] = *(const f32x4*)(cw + 4 * n); w1[n] = *(const f32x4*)(cw + 1024 + 4 * n); w2[n] = *(const f32x4*)(cw + 2048 + 4 * n); w3[n] = *(const f32x4*)(cw + 3072 + 4 * n); bb[n] = *(const f32x4*)(cb + 4 * n); }
#pragma unroll
    for (int i = 0; i < 8; ++i) { f32x4 a[2], b[2], c[2], d[2]; pg8::unpack8(rw[i], a[0], a[1]); pg8::unpack8(rw[i + 1], b[0], b[1]); pg8::unpack8(rw[i + 2], c[0], c[1]); pg8::unpack8(rw[i + 3], d[0], d[1]);
        *(v4u*)(dst + (size_t)i * 1536) = pg8::pack8(bb[0] + w0[0] * a[0] + w1[0] * b[0] + w2[0] * c[0] + w3[0] * d[0], bb[1] + w0[1] * a[1] + w1[1] * b[1] + w2[1] * c[1] + w3[1] * d[1]); }
}
__device__ __forceinline__ void pool_witem(const bf16* UP, bf16* POOLED, int g, int tblk, int lane) {
    const int t0 = tblk + (lane >> 4) * 8, co = g * 16 + (lane & 15);
    const bf16* src = UP + (size_t)t0 * DPOOL + co * 8; bf16* dst = POOLED + (size_t)t0 * DPOOL + co * 8; const int tl = t0 & (SEQ - 1);
    if (g == 0) pool_item<2>(src, dst, tl); else if (g == 1) pool_item<4>(src, dst, tl); else if (g == 2) pool_item<8>(src, dst, tl); else pool_item<16>(src, dst, tl);
}

__global__ void __launch_bounds__(NTHR, 2) fwd_kernel(Args args) {
    extern __shared__ __attribute__((aligned(16))) unsigned char lds_raw[];
    LAS unsigned char* lds = (LAS unsigned char*)lds_raw;
    const int tid = threadIdx.x, lane = tid & 63, wave = __builtin_amdgcn_readfirstlane(tid >> 6);
    const int G = gridDim.x, bx = blockIdx.x;
    unsigned char* ws = args.ws;
    const int lo = args.ph_lo, hi = args.ph_hi;
#ifndef PHASE_MASK
#define PHASE_MASK 0x7ff
#endif
#define IN(k) (((PHASE_MASK >> (k)) & 1) && lo <= (k) && (k) < hi)
#ifndef REPEAT_MASK
#define REPEAT_MASK 0
#endif
#define REPS(k) (((REPEAT_MASK >> (k)) & 1) ? 2 : 1)
#ifndef PROBE_PHASE
#define PROBE_PHASE -1
#endif
#define PROBE_MULT 4
    unsigned long long tp0 = 0, tp1 = 0;
#define TSTART(k) do { if ((k) == PROBE_PHASE) tp0 = __builtin_amdgcn_s_memrealtime(); } while (0)
#define TEND(k) do { if ((k) == PROBE_PHASE) tp1 = __builtin_amdgcn_s_memrealtime(); } while (0)
#define GSYNC() xcd_barrier(bar)
#define SEAM(k) do { if (IN(k) && IN((k) + 1)) { GSYNC(); } } while (0)

    const float* x = args.in[I_X];
    bf16* WIN = (bf16*)(ws + WS_WIN); bf16* WFI = (bf16*)(ws + WS_WFI); bf16* WFO = (bf16*)(ws + WS_WFO); bf16* WCAT = (bf16*)(ws + WS_WCAT);
    bf16* WO = (bf16*)(ws + WS_WO); bf16* WGRP = (bf16*)(ws + WS_WGRP); bf16* WGATE = (bf16*)(ws + WS_WGATE);
    bf16* XN = (bf16*)(ws + WS_R1); bf16* X1B = XN;
    bf16* CAT = (bf16*)(ws + WS_CAT); bf16* V = CAT + 512; bf16* LA = V;
    bf16* UP = (bf16*)(ws + WS_R2);
    bf16* UR = (bf16*)(ws + WS_R3);
    bf16* UG = (bf16*)(ws + WS_R4);
    bf16* POOLED = (bf16*)(ws + WS_R7); bf16* BB = (bf16*)(ws + WS_R8);
    bf16* MIXB = (bf16*)(ws + WS_MIXB); bf16* ACT = (bf16*)(ws + WS_ACT);
    float* SSQ = (float*)(ws + WS_SSQ); float* CS = (float*)(ws + WS_CS); float* CH = (float*)(ws + WS_CH);
    bf16* G0 = (bf16*)args.out; bf16* G1 = G0 + (size_t)M * 1024;
    float* X1 = args.out;

#ifndef EXTRA_SYNCS
#define EXTRA_SYNCS 0
#endif
    if (PROBE_PHASE == 99) tp0 = __builtin_amdgcn_s_memrealtime();
    volatile LAS unsigned* MISC = (volatile LAS unsigned*)(lds + 131072 + 1024);
    if (tid < 32) MISC[tid] = 0u;
    __syncthreads();
    XcdBarrier bar = xcd_barrier_post((unsigned*)ws, MISC + 8);
    if (lo < 0) cg::this_grid().sync();
    for (int i = 0; i < EXTRA_SYNCS; ++i) GSYNC();
    TSTART(0);
    if (IN(0)) for (int rep = 0; rep < REPS(0); ++rep) { if (rep) GSYNC();
        LAS float* scr = (LAS float*)(lds + wave * 16384);
        const int gw = bx * NWAVES + wave, NGW = G * NWAVES;
        constexpr int I_IN = 16 * (DIN / 32), I_FI = 16 * (2 * DFF / 32), I_FO = (DFF / 64) * (D / 32), I_RO = 16 * 32, I_WO = 16 * 32, I_PO = 8 * 32;
        constexpr int NITEMS = I_IN + I_FI + I_FO + I_RO + I_WO + I_PO;
        for (int it = gw; it < NITEMS; it += NGW) {
            int r = it;
            if (r < I_IN) { const int nblk = DIN / 32, kb = r / nblk, nb = r % nblk, nd = 32 * nb; int ns = nd;
                if (nd >= 2560) { const int q = nd - 2560, pq = q >> 8, j0 = q & 255; ns = 2560 + (j0 < 128 ? 128 * pq + j0 : 1024 + 128 * pq + (j0 - 128)); }
                transpose_item(args.in[I_W_IN], DIN, D, WIN, 64 * kb, ns, nd, args.in[I_NORM_MIX], scr, lane); continue; } r -= I_IN;
            if (r < I_FI) { const int nblk = 2 * DFF / 32, kb = r / nblk, nb = r % nblk, nd = 32 * nb, pn = nd >> 8, j0 = nd & 255;
                const int ns = j0 < 128 ? 128 * pn + j0 : DFF + 128 * pn + (j0 - 128);
                transpose_item(args.in[I_W_FFN_IN], 2 * DFF, D, WFI, 64 * kb, ns, nd, args.in[I_NORM_FFN], scr, lane); continue; } r -= I_FI;
            if (r < I_FO) { if (G != 256) { const int nblk = D / 32, kb = r / nblk, nb = r % nblk; transpose_item(args.in[I_W_FFN_OUT], D, DFF, WFO, 64 * kb, 32 * nb, 32 * nb, nullptr, scr, lane); } continue; } r -= I_FO;
            if (r < I_RO) { const int nblk = D / 32, kb = r / nblk, nb = r % nblk; transpose_item(args.in[I_W_RNN_OUT], D, 1536, WCAT + 512, 64 * kb, 32 * nb, 32 * nb, nullptr, scr, lane); continue; } r -= I_RO;
            if (r < I_WO) { const int nblk = D / 32, kb = r / nblk, nb = r % nblk; transpose_item(args.in[I_W_O], D, D, WO, 64 * kb, 32 * nb, 32 * nb, nullptr, scr, lane); continue; } r -= I_WO;
            { const int nblk = D / 32, kb = r / nblk, nb = r % nblk; transpose_item(args.in[I_W_POOL_OUT], D, 1536, WCAT, 64 * kb, 32 * nb, 32 * nb, nullptr, scr, lane); }
        }
        {
            const int gt = bx * NTHR + tid, NT = G * NTHR;
            const float* wg = args.in[I_W_GRP];
            for (int e = gt; e < 512 * 32; e += NT) { const int n = e >> 5, kc = (e & 31) * 8, g = n >> 7, nn = n & 127; float v[8];
#pragma unroll
                for (int j = 0; j < 8; ++j) { const int kk = kc + j - (g & 1) * 128; v[j] = (kk >= 0 && kk < 128) ? wg[((size_t)g * 128 + kk) * 128 + nn] : 0.f; }
                v4u o; o.x = cvt_pk_bf16(v[0], v[1]); o.y = cvt_pk_bf16(v[2], v[3]); o.z = cvt_pk_bf16(v[4], v[5]); o.w = cvt_pk_bf16(v[6], v[7]);
                *(v4u*)(WGRP + (size_t)n * 256 + kc) = o; }
            const float* wa = args.in[I_W_RG_A]; const float* wx = args.in[I_W_RG_X];
            for (int e = gt; e < 2048 * 16; e += NT) { const int n = e >> 4, kc = (e & 15) * 8, h = n >> 8, j = n & 255; const float* src = j < 128 ? wa : wx; const int jj = j & 127; float v[8];
#pragma unroll
                for (int q = 0; q < 8; ++q) v[q] = src[((size_t)h * 128 + kc + q) * 128 + jj];
                v4u o; o.x = cvt_pk_bf16(v[0], v[1]); o.y = cvt_pk_bf16(v[2], v[3]); o.z = cvt_pk_bf16(v[4], v[5]); o.w = cvt_pk_bf16(v[6], v[7]);
                *(v4u*)(WGATE + (size_t)n * 128 + kc) = o; }
        }
        { const int gt = bx * NTHR + tid; if (gt < DRNN) { const float z = -args.in[I_LAMBDA][gt]; ((float*)(ws + WS_SP8))[gt] = -8.0f * (fmaxf(z, 0.f) + log1pf(expf(-fabsf(z)))); } }
        float* RSI = (float*)(ws + WS_RSI);
        for (int m = gw; m < M; m += 2 * NGW) {
            const int m1 = (m + NGW < M) ? m + NGW : m;
            const f32x4* xr0 = (const f32x4*)(x + (size_t)m * D) + lane; const f32x4* xr1 = (const f32x4*)(x + (size_t)m1 * D) + lane; f32x4 v0[4], v1[4]; float s0 = 0.f, s1 = 0.f;
#pragma unroll
            for (int j = 0; j < 4; ++j) { v0[j] = xr0[64 * j]; v1[j] = xr1[64 * j]; }
#pragma unroll
            for (int j = 0; j < 4; ++j) { s0 += (v0[j].x * v0[j].x + v0[j].y * v0[j].y) + (v0[j].z * v0[j].z + v0[j].w * v0[j].w); s1 += (v1[j].x * v1[j].x + v1[j].y * v1[j].y) + (v1[j].z * v1[j].z + v1[j].w * v1[j].w); }
            const float q0 = sqrtf(wave_sum(s0) * (1.f / D) + EPS), q1 = sqrtf(wave_sum(s1) * (1.f / D) + EPS), rs0 = 1.0f / q0, rs1 = 1.0f / q1;
            if (lane == 0) { RSI[m] = q0; RSI[m1] = q1; }
            v2u* o0 = (v2u*)(XN + (size_t)m * D) + lane; v2u* o1 = (v2u*)(XN + (size_t)m1 * D) + lane;
#pragma unroll
            for (int j = 0; j < 4; ++j) { const f32x4 y0 = v0[j] * rs0, y1 = v1[j] * rs1; v2u w0, w1; w0.x = cvt_pk_bf16(y0.x, y0.y); w0.y = cvt_pk_bf16(y0.z, y0.w); w1.x = cvt_pk_bf16(y1.x, y1.y); w1.y = cvt_pk_bf16(y1.z, y1.w); o0[64 * j] = w0; o1[64 * j] = w1; }
        }
        __syncthreads();
    }
    SEAM(0);
    TEND(0);

    TSTART(1);
    if (IN(1)) for (int rep = 0; rep < REPS(1); ++rep) { if (rep) GSYNC();
        pg8::Gemm g{XN, WIN, M, 4096, D, D, D, 0, 0}; pg8::StaticOrder S; S.init(M, 4096, G, bx);
        pg8::EpiProj E{UP, UR, UG, G0, G1, 0};
        pg8::gemm_phase<pg8::EpiProj, true>(lds, g, S, E);
    }
    SEAM(1);
    TEND(1);

    TSTART(2);
    if (IN(2) && G != 256) for (int rep = 0; rep < REPS(2); ++rep) { if (rep) GSYNC();
        { const int gw = bx * NWAVES + wave, NGW = G * NWAVES;
          for (int wi = gw; wi < (M / 32) * 4; wi += NGW) pool_witem(UP, POOLED, wi & 3, (wi >> 2) * 32, lane); }
        { const int gt = bx * NTHR + tid, NT = G * NTHR;
          for (int it = gt; it < (M / 8) * 128; it += NT) conv_item(UR, V, args.in[I_CONV_W], args.in[I_CONV_B], (it >> 7) * 8, it & 127); }
    }
    if (G != 256)     SEAM(2);
    TEND(2);

    TSTART(3);
    if (IN(3)) for (int rep = 0; rep < REPS(3); ++rep) { if (rep) GSYNC();
        const bool fusedp2 = (G == 256);
        if (fusedp2) {
            { pg8::StaticOrder Sg; Sg.init(M, 512, G, (bx + G / 2) % G); pg8::Unit u;
              if (Sg.next(0, u)) { for (int wi = wave; wi < 16; wi += NWAVES) pool_witem(UP, POOLED, 2 * u.pn + (wi & 1), u.pm * 256 + (wi >> 1) * 32, lane); } }
            asm volatile("s_waitcnt vmcnt(0)" ::: "memory"); __syncthreads();
        }
        {
          pg8::Gemm g{XN, WIN + (size_t)4096 * D, M, 512, D, D, D, 0, 0}; pg8::StaticOrder S; S.init(M, 512, G, bx);
          pg8::EpiProj E{UP, UR, UG, G0, G1, 16};
          pg8::gemm_phase<pg8::EpiProj, true>(lds, g, S, E); }
        { pg8::Gemm g{POOLED, WGRP, M, 512, 256, 512, 256, 0, 256}; pg8::StaticOrder S; S.init(M, 512, G, (bx + G / 2) % G);
          pg8::EpiGrp E{CAT, 1536, args.in[I_POOL_SCALE]};
          pg8::gemm_phase<pg8::EpiGrp, true>(lds, g, S, E); }
        { pg8::Gemm g{V, WGATE, M, 2048, 128, 1536, 128, 0, 128}; pg8::StaticOrder S; S.init(M, 2048, G, bx);
          if (fusedp2) { S.lin_base = bx * 2; S.lin_cnt = 2; }
          pg8::EpiGate E{V, LA, BB, args.in[I_B_RG_A], args.in[I_B_RG_X], (const float*)(ws + WS_SP8)};
          if (fusedp2) { E.vlds = lds; E.use_lds = true;
              for (int i = 0; i < 2; ++i) { pg8::Unit u; if (S.next(i, u)) pg8::gate_unit_fused<pg8::EpiGate>(lds, UR, args.in[I_CONV_W], args.in[I_CONV_B], WGATE, E, u.pm, u.pn, nullptr); } }
          else pg8::gemm_phase<pg8::EpiGate, true>(lds, g, S, E); }
    }
    SEAM(3);
    TEND(3);

    TSTART(4);
    TEND(4);

    TSTART(5);
    if (IN(5)) for (int rep = 0; rep < REPS(5); ++rep) { if (rep) GSYNC();
        LAS float* PAS = (LAS float*)lds; LAS float* PAH = PAS + 8 * 512; LAS float* PBS = PAH + 8 * 512; LAS float* PBH = PBS + 8 * 512;
        unsigned* flags = (unsigned*)ws + 8192;
        for (int bi = bx; bi < NB * SCAN_NC * 2; bi += G) { const int hh = bi & 1, c = (bi >> 1) % SCAN_NC, b = bi / (2 * SCAN_NC);
            const size_t off = ((size_t)b * SEQ + (size_t)c * SCAN_T + wave * 16) * DRNN + hh * 512 + lane * 8;
            v4u lwk[16], bwk[16];
            const size_t offL = ((size_t)b * SEQ + (size_t)c * SCAN_T + wave * 16) * 1536 + hh * 512 + lane * 8;
#pragma unroll
            for (int i = 0; i < 16; ++i) { lwk[i] = *(const v4u*)(LA + offL + (size_t)i * 1536); bwk[i] = *(const v4u*)(BB + off + (size_t)i * DRNN); }
            { f32x4 S[2] = {{0.f, 0.f, 0.f, 0.f}, {0.f, 0.f, 0.f, 0.f}}, H[2] = {{0.f, 0.f, 0.f, 0.f}, {0.f, 0.f, 0.f, 0.f}};
#pragma unroll
              for (int i = 0; i < 16; ++i) { f32x4 l[2], bq[2]; pg8::unpack8(lwk[i], l[0], l[1]); pg8::unpack8(bwk[i], bq[0], bq[1]);
#pragma unroll
                  for (int n = 0; n < 2; ++n)
#pragma unroll
                      for (int j = 0; j < 4; ++j) { H[n][j] = __expf(l[n][j]) * H[n][j] + bq[n][j]; S[n][j] += l[n][j]; } }
              *(LAS f32x4*)(PBS + wave * 512 + lane * 8) = S[0]; *(LAS f32x4*)(PBS + wave * 512 + lane * 8 + 4) = S[1];
              *(LAS f32x4*)(PBH + wave * 512 + lane * 8) = H[0]; *(LAS f32x4*)(PBH + wave * 512 + lane * 8 + 4) = H[1]; }
#pragma unroll
            for (int i = 0; i < 16; ++i) asm volatile("" : "+v"(lwk[i]), "+v"(bwk[i]));
            __syncthreads();
            { float h = 0.f, st = 0.f;
#pragma unroll
              for (int sb = 0; sb < 8; ++sb) { const float sv = PBS[sb * 512 + tid]; h = __expf(sv) * h + PBH[sb * 512 + tid]; st += sv; }
              const size_t co = ((size_t)b * SCAN_NC + c) * DRNN + hh * 512 + tid;
              __hip_atomic_store(CS + co, st, __ATOMIC_RELAXED, __HIP_MEMORY_SCOPE_AGENT); __hip_atomic_store(CH + co, h, __ATOMIC_RELAXED, __HIP_MEMORY_SCOPE_AGENT); }
            asm volatile("s_waitcnt vmcnt(0)" ::: "memory");
            __syncthreads();
            if (tid == 0) __hip_atomic_store(flags + ((b * 2 + hh) * SCAN_NC + c) * 16, 1u, __ATOMIC_RELAXED, __HIP_MEMORY_SCOPE_AGENT);
            { f32x4 S[2] = {{0.f, 0.f, 0.f, 0.f}, {0.f, 0.f, 0.f, 0.f}}, H[2] = {{0.f, 0.f, 0.f, 0.f}, {0.f, 0.f, 0.f, 0.f}};
              if (wave * 4 < c) {
                  for (int q = 0; q < 4; ++q) { const int cc = wave * 4 + q; if (cc < c) { unsigned* f = flags + ((b * 2 + hh) * SCAN_NC + cc) * 16; unsigned sp = 0;
                      while ((unsigned)__builtin_amdgcn_readfirstlane(__hip_atomic_load(f, __ATOMIC_RELAXED, __HIP_MEMORY_SCOPE_AGENT)) == 0u) { __builtin_amdgcn_s_sleep(1); if (++sp > (1u << 20)) break; } } }
                  __builtin_amdgcn_fence(__ATOMIC_ACQUIRE, "agent");
#pragma unroll
                  for (int q0 = 0; q0 < 4; q0 += 2) { f32x4 cs[2][2], ch[2][2];
#pragma unroll
                      for (int q = 0; q < 2; ++q) { const int cc = wave * 4 + q0 + q; const size_t co = ((size_t)b * SCAN_NC + (cc < c ? cc : 0)) * DRNN + hh * 512 + lane * 8;
                          cs[q][0] = *(const f32x4*)(CS + co); cs[q][1] = *(const f32x4*)(CS + co + 4); ch[q][0] = *(const f32x4*)(CH + co); ch[q][1] = *(const f32x4*)(CH + co + 4); }
#pragma unroll
                      for (int q = 0; q < 2; ++q) { if (wave * 4 + q0 + q < c) {
#pragma unroll
                          for (int n = 0; n < 2; ++n)
#pragma unroll
                              for (int j = 0; j < 4; ++j) { H[n][j] = __expf(cs[q][n][j]) * H[n][j] + ch[q][n][j]; S[n][j] += cs[q][n][j]; } } }
                      asm volatile("" ::: "memory"); }
              }
              *(LAS f32x4*)(PAS + wave * 512 + lane * 8) = S[0]; *(LAS f32x4*)(PAS + wave * 512 + lane * 8 + 4) = S[1];
              *(LAS f32x4*)(PAH + wave * 512 + lane * 8) = H[0]; *(LAS f32x4*)(PAH + wave * 512 + lane * 8 + 4) = H[1]; }
            __syncthreads();
            f32x4 h[2] = {{0.f, 0.f, 0.f, 0.f}, {0.f, 0.f, 0.f, 0.f}};
#pragma unroll
            for (int sb = 0; sb < 8; ++sb) {
#pragma unroll
                for (int n = 0; n < 2; ++n) { const f32x4 sv = *(const LAS f32x4*)(PAS + sb * 512 + lane * 8 + 4 * n), hv = *(const LAS f32x4*)(PAH + sb * 512 + lane * 8 + 4 * n);
#pragma unroll
                    for (int j = 0; j < 4; ++j) h[n][j] = __expf(sv[j]) * h[n][j] + hv[j]; } }
            for (int sb = 0; sb < wave; ++sb) {
#pragma unroll
                for (int n = 0; n < 2; ++n) { const f32x4 sv = *(const LAS f32x4*)(PBS + sb * 512 + lane * 8 + 4 * n), hv = *(const LAS f32x4*)(PBH + sb * 512 + lane * 8 + 4 * n);
#pragma unroll
                    for (int j = 0; j < 4; ++j) h[n][j] = __expf(sv[j]) * h[n][j] + hv[j]; } }
            const bf16* ugp = UG + off;
            bf16* hgp = CAT + ((size_t)b * SEQ + (size_t)c * SCAN_T + wave * 16) * 1536 + 512 + hh * 512 + lane * 8;
            v4u gwk[16];
#pragma unroll
            for (int i = 0; i < 16; ++i) gwk[i] = *(const v4u*)(ugp + (size_t)i * DRNN);
#pragma unroll
            for (int i0 = 0; i0 < 16; i0 += 8) { const v4u* gw8 = gwk + i0;
#pragma unroll
                for (int i = 0; i < 8; ++i) { f32x4 l[2], bq[2], gq[2], o[2]; pg8::unpack8(lwk[i0 + i], l[0], l[1]); pg8::unpack8(bwk[i0 + i], bq[0], bq[1]); pg8::unpack8(gw8[i], gq[0], gq[1]);
#pragma unroll
                    for (int n = 0; n < 2; ++n)
#pragma unroll
                        for (int j = 0; j < 4; ++j) { h[n][j] = __expf(l[n][j]) * h[n][j] + bq[n][j]; o[n][j] = h[n][j] * pg8::gelu_tanh_(gq[n][j]); }
                    *(v4u*)(hgp + (size_t)(i0 + i) * 1536) = pg8::pack8(o[0], o[1]); } }
            __syncthreads();
        }
    }
    SEAM(5);
    TEND(5);

    TSTART(6);
    if (IN(6)) for (int rep = 0; rep < REPS(6); ++rep) { if (rep) GSYNC();
        pg8::Gemm g{CAT, WCAT, M, D, 1536, 1536, 1536, 0, 0}; pg8::StaticOrder S; S.init(M, D, G, bx);
        pg8::EpiMix E{G0, G1, MIXB};
        pg8::gemm_phase<pg8::EpiMix, true, 8>(lds, g, S, E);
    }
    SEAM(6);
    TEND(6);

    TSTART(7);
    if (IN(7)) for (int rep = 0; rep < REPS(7); ++rep) { if (rep) GSYNC();
        pg8::Gemm g{MIXB, WO, M, D, D, D, D, 0, 0}; pg8::StaticOrder S; S.init(M, D, G, bx);
        pg8::EpiRes1 E{XN, (const float*)(ws + WS_RSI), X1B, SSQ};
        pg8::gemm_phase<pg8::EpiRes1, true>(lds, g, S, E);
    }
    SEAM(7);
    TEND(7);

    TSTART(8);
    if (IN(8)) for (int rep = 0; rep < REPS(8); ++rep) { if (rep) GSYNC();
        pg8::Gemm g{X1B, WFI, M, 2 * DFF, D, D, D, 0, 0}; pg8::StaticOrder S; S.init(M, 2 * DFF, G, bx);
        LAS float* RSL = (LAS float*)(lds + 133120);
        { const int r = tid & 255;
          for (int i = tid >> 8; i < 8; i += 2) { pg8::Unit u; if (!S.next(i, u)) break;
              const f32x4* sp = (const f32x4*)(SSQ + (size_t)(u.pm * 256 + r) * 16); const f32x4 st = (sp[0] + sp[1]) + (sp[2] + sp[3]);
              RSL[i * 256 + r] = __builtin_amdgcn_rsqf(((st[0] + st[1]) + (st[2] + st[3])) * (1.0f / 1024.0f) + 1e-6f); }
          __syncthreads(); }
        pg8::EpiSwiglu E{RSL, ACT};
        pg8::gemm_phase<pg8::EpiSwiglu, true>(lds, g, S, E);
        if (G == 256 && bx >= 128) {
            LAS float* scr = (LAS float*)(lds + wave * 16384); constexpr int I_FO = (DFF / 64) * (D / 32);
            for (int r = (bx - 128) * NWAVES + wave; r < I_FO; r += 128 * NWAVES) { const int nblk = D / 32, kb = r / nblk, nb = r % nblk;
                transpose_item(args.in[I_W_FFN_OUT], D, DFF, WFO, 64 * kb, 32 * nb, 32 * nb, nullptr, scr, lane); }
        }
    }
    SEAM(8);
    TEND(8);

    TSTART(9);
    if (IN(9)) for (int rep = 0; rep < REPS(9); ++rep) { if (rep) GSYNC();
        pg8::Gemm g{ACT, WFO, M, D, DFF, DFF, DFF, 0, 0}; pg8::StaticOrder S; S.init(M, D, G, bx);
        if (G == 256) { pg8::EpiFinal E{X1B, X1, (float*)(ws + WS_SSQ2), (unsigned*)ws + 4096, args.in[I_NORM_FINAL]};
            pg8::gemm_phase<pg8::EpiFinal, true>(lds, g, S, E); }
        else { pg8::EpiRes2 E{X1B, X1};
            pg8::gemm_phase<pg8::EpiRes2, true>(lds, g, S, E); }
    }
    if (G != 256) SEAM(9);
    TEND(9);

    TSTART(10);
    if (IN(10) && G != 256) for (int rep = 0; rep < REPS(10); ++rep) { if (rep) GSYNC();
        const int gw = bx * NWAVES + wave, NGW = G * NWAVES;
        const float* gf = args.in[I_NORM_FINAL]; f32x4 gv[4];
#pragma unroll
        for (int j = 0; j < 4; ++j) gv[j] = ((const f32x4*)gf)[lane + 64 * j];
        for (int m = gw; m < M; m += NGW) {
            f32x4* xr = (f32x4*)(X1 + (size_t)m * D) + lane; f32x4 v[4]; float s = 0.f;
#pragma unroll
            for (int j = 0; j < 4; ++j) { v[j] = xr[64 * j]; s += (v[j].x * v[j].x + v[j].y * v[j].y) + (v[j].z * v[j].z + v[j].w * v[j].w); }
            const float rs = 1.0f / sqrtf(wave_sum(s) * (1.f / D) + EPS);
#pragma unroll
            for (int j = 0; j < 4; ++j) xr[64 * j] = v[j] * rs * gv[j];
        }
    }
    if (PROBE_PHASE == 10 || PROBE_PHASE == 99) tp1 = __builtin_amdgcn_s_memrealtime();
    if (PROBE_PHASE >= 0 && bx == 0 && tid == 0) { const unsigned long long dt = (tp1 - tp0) * PROBE_MULT, te = __builtin_amdgcn_s_memrealtime(); while (__builtin_amdgcn_s_memrealtime() - te < dt) __builtin_amdgcn_s_sleep(8); }
#undef IN
#undef SEAM
}

extern "C" void kernel_launch(void* const* d_in, const int* in_sizes, int n_in, void* d_out, int out_size, void* d_ws, size_t ws_size, hipStream_t stream) {
    static int grid = 0;
    if (grid == 0) {
        if (n_in != 19 || out_size != M * D || ws_size < WS_END) { fprintf(stderr, "kernel_launch: unexpected shapes (n_in %d out %d ws %zu)\n", n_in, out_size, ws_size); grid = -1; return; }
        int dev = 0, cus = 0, per_cu = 0;
        hipGetDevice(&dev);
        hipDeviceGetAttribute(&cus, hipDeviceAttributeMultiprocessorCount, dev);
        if (hipFuncSetAttribute((const void*)fwd_kernel, hipFuncAttributeMaxDynamicSharedMemorySize, LDS_BYTES) != hipSuccess) { fprintf(stderr, "kernel_launch: hipFuncSetAttribute failed\n"); grid = -1; return; }
        if (hipOccupancyMaxActiveBlocksPerMultiprocessor(&per_cu, (const void*)fwd_kernel, NTHR, LDS_BYTES) != hipSuccess || per_cu < 1) { fprintf(stderr, "kernel_launch: occupancy query says %d\n", per_cu); per_cu = 1; }
        (void)hipGetLastError();
        grid = cus * 1;
        fprintf(stderr, "kernel_launch: grid %d (cus %d, per_cu %d)\n", grid, cus, per_cu);
    }
    if (grid < 0) return;
    if (hipMemsetAsync(d_ws, 0, 49152, stream) != hipSuccess) { fprintf(stderr, "kernel_launch: memset failed\n"); return; }
    Args a{};
    for (int i = 0; i < 19; ++i) a.in[i] = (const float*)d_in[i];
    a.out = (float*)d_out; a.ws = (unsigned char*)d_ws;
#if MK_PER_PHASE
    for (int p = 0; p < NPH; ++p) { a.ph_lo = p; a.ph_hi = p + 1; hipLaunchKernelGGL(fwd_kernel, dim3(grid), dim3(NTHR), LDS_BYTES, stream, a); }
#else
    a.ph_lo = 0; a.ph_hi = NPH;
    void* kargs[] = {&a};
    hipError_t e = hipLaunchCooperativeKernel((const void*)fwd_kernel, dim3(grid), dim3(NTHR), kargs, LDS_BYTES, stream);
    if (e != hipSuccess) fprintf(stderr, "cooperative launch failed: %s (grid %d)\n", hipGetErrorString(e), grid);
#endif
}
```

```cpp
#include <hip/hip_runtime.h>
#include <hip/hip_cooperative_groups.h>
#include <cstdio>
#include <cstdint>
namespace cg = cooperative_groups;

#ifndef FG_VLDS
#define FG_VLDS 1
#endif
#ifndef MK_PER_PHASE
#define MK_PER_PHASE 0
#endif

namespace pg8 {
#define PG8_LAS __attribute__((address_space(3)))
typedef unsigned short bf16_t;
typedef short bf16x8 __attribute__((ext_vector_type(8)));
typedef float f32x4 __attribute__((ext_vector_type(4)));
typedef float f32x2 __attribute__((ext_vector_type(2)));
typedef unsigned u32x4 __attribute__((ext_vector_type(4)));
typedef unsigned u32x2 __attribute__((ext_vector_type(2)));
constexpr int BM = 256, BK = 64, HALF = 128, HTB = HALF * BK * 2, STAGE_BYTES = 8 * HTB, NXCD = 8, WGM = 8;

__host__ __device__ __forceinline__ int lds_byte(int r, int c) { const int st = (r >> 4) * 2 + (c >> 5), rr = r & 15, cc = c & 31, ob = rr * 64 + cc * 2; return st * 1024 + (ob ^ (((ob >> 9) & 1) << 5)); }
__host__ __device__ __forceinline__ void stage_rc(int b, int& R, int& C) { const int st = b / 1024, sb = b % 1024, swz = sb ^ (((sb >> 9) & 1) << 5); R = (st >> 1) * 16 + swz / 64; C = (st & 1) * 32 + (swz % 64) / 2; }
__host__ __device__ __forceinline__ int perm32(int rho) { const int n = rho >> 4, i = rho & 15; return 8 * (i >> 2) + 4 * n + (i & 3); }

struct Unit { int pm, pn, rh, idx; };
struct Gemm { const bf16_t* A; const bf16_t* Bt; int M, N, K, lda, ldb, ash, amul; };

struct StaticOrder {
    int nM, nN, nwg, G, c, limit, lin_base, lin_cnt;
    __host__ __device__ __forceinline__ void init(int M, int N, int G_, int c_) { nM = M / BM; nN = N / BM; nwg = nM * nN; G = G_; c = c_; limit = nwg; lin_base = 0; lin_cnt = -1; }
    __host__ __device__ __forceinline__ void map(int L, Unit& u) const {
        int wgid = L; { const int q = nwg / NXCD, r = nwg % NXCD, xcd = wgid % NXCD, off = wgid / NXCD; wgid = (xcd < r ? xcd * (q + 1) : r * (q + 1) + (xcd - r) * q) + off; }
        const int nig = WGM * nN, gid = wgid / nig, fm = gid * WGM, gsz = (nM - fm) < WGM ? (nM - fm) : WGM;
        u.pm = fm + ((wgid % nig) % gsz); u.pn = (wgid % nig) / gsz; u.rh = 0;
    }
    __host__ __device__ __forceinline__ bool next(int i, Unit& u) const {
        u.idx = i;
        if (lin_cnt >= 0) { if (i >= lin_cnt) return false; map(lin_base + i, u); return true; }
        const long L = (long)i * G + c; if (L >= limit) return false;
        map((int)L, u); return true;
    }
};

__device__ __forceinline__ unsigned cvt_pk_bf16(float lo, float hi) { unsigned r; asm volatile("v_cvt_pk_bf16_f32 %0, %1, %2" : "=v"(r) : "v"(lo), "v"(hi)); return r; }
__device__ __forceinline__ float bf_lo(unsigned w) { return __uint_as_float(w << 16); }
__device__ __forceinline__ float bf_hi(unsigned w) { return __uint_as_float(w & 0xffff0000u); }
__device__ __forceinline__ float sigmoidf_(float x) { return __builtin_amdgcn_rcpf(1.0f + __expf(-x)); }
__device__ __forceinline__ float gelu_tanh_(float x) { const float z = 1.5957691216057308f * (x + 0.044715f * x * x * x); return x * sigmoidf_(z); }
__device__ __forceinline__ u32x4 pack8(const f32x4 a, const f32x4 b) { u32x4 w; w.x = cvt_pk_bf16(a[0], a[1]); w.y = cvt_pk_bf16(a[2], a[3]); w.z = cvt_pk_bf16(b[0], b[1]); w.w = cvt_pk_bf16(b[2], b[3]); return w; }
__device__ __forceinline__ void unpack8(const u32x4 w, f32x4& a, f32x4& b) { a = (f32x4){bf_lo(w.x), bf_hi(w.x), bf_lo(w.y), bf_hi(w.y)}; b = (f32x4){bf_lo(w.z), bf_hi(w.z), bf_lo(w.w), bf_hi(w.w)}; }

#define EPI_ROWS_BEGIN _Pragma("unroll") for (int ai = 0; ai < NAI; ++ai) _Pragma("unroll") for (int m = 0; m < 4; ++m) { const int row = u.pm * BM + u.rh + ai * HALF + wr * 64 + m * 16 + fr;
#define EPI_ROWS_END }

struct EpiProj {
    bf16_t *UP, *UR, *UG, *RB, *G1; int pn_off;
    template <int NAI> __device__ __forceinline__ void run(const f32x4 (&acc)[2][2][4][2], const Unit& u, int wr, int wc, int fr, int fq) const {
        const int pn = u.pn + pn_off;
        if (pn < 10) {
            bf16_t* base; int ldc, colt;
            if (pn < 2) { base = UP; ldc = 512; colt = pn * 256; }
            else if (pn < 6) { base = UR; ldc = 1024; colt = (pn - 2) * 256; }
            else { base = UG; ldc = 1024; colt = (pn - 6) * 256; }
            const int col0 = colt + wc * 32 + 8 * fq;
            EPI_ROWS_BEGIN
                bf16_t* rowp = base + (unsigned)((unsigned)row * (unsigned)ldc + (unsigned)col0);
#pragma unroll
                for (int bj = 0; bj < 2; ++bj) *(u32x4*)(rowp + bj * HALF) = pack8(acc[ai][bj][m][0], acc[ai][bj][m][1]);
            EPI_ROWS_END
        } else {
            const int ch0 = (pn - 10) * 128 + wc * 32 + 8 * fq;
            EPI_ROWS_BEGIN
                const unsigned off = (unsigned)row * 1024u + (unsigned)ch0; f32x4 rr[2], gg[2];
#pragma unroll
                for (int n = 0; n < 2; ++n)
#pragma unroll
                    for (int j = 0; j < 4; ++j) { const float d0 = 1.0f + fminf(__expf(-acc[ai][0][m][n][j]), 1e18f), d1 = 1.0f + fminf(__expf(-acc[ai][1][m][n][j]), 1e18f);
                        const float q = __builtin_amdgcn_rcpf(d0 * d1); gg[n][j] = d0 * q; rr[n][j] = d1 * d1 * q; }
                *(u32x4*)(RB + off) = pack8(rr[0], rr[1]); *(u32x4*)(G1 + off) = pack8(gg[0], gg[1]);
            EPI_ROWS_END
        }
    }
};
struct EpiGrp {
    bf16_t* O; int ldc; const float* scale;
    template <int NAI> __device__ __forceinline__ void run(const f32x4 (&acc)[2][2][4][2], const Unit& u, int wr, int wc, int fr, int fq) const {
        const int col0 = u.pn * BM + wc * 32 + 8 * fq;
        f32x4 sc[2][2];
#pragma unroll
        for (int bj = 0; bj < 2; ++bj)
#pragma unroll
            for (int n = 0; n < 2; ++n) sc[bj][n] = *(const f32x4*)(scale + col0 + bj * HALF + 4 * n);
        EPI_ROWS_BEGIN
            bf16_t* rowp = O + (unsigned)((unsigned)row * (unsigned)ldc + (unsigned)col0);
#pragma unroll
            for (int bj = 0; bj < 2; ++bj) *(u32x4*)(rowp + bj * HALF) = pack8(acc[ai][bj][m][0] * sc[bj][0], acc[ai][bj][m][1] * sc[bj][1]);
        EPI_ROWS_END
    }
};
struct EpiGate {
    const bf16_t* V; bf16_t *LA, *BB; const float *b_a, *b_x, *sp8;
    const PG8_LAS unsigned char* vlds = nullptr; bool use_lds = false;
    template <int NAI, bool EXACT> __device__ __forceinline__ void rows(const f32x4 (&acc)[2][2][4][2], const Unit& u, int wr, int fr, int ch0, const f32x4 (&ba)[2], const f32x4 (&bx)[2], const f32x4 (&sp)[2]) const {
        u32x4 vwk[2][4];
        EPI_ROWS_BEGIN
            if (use_lds) vwk[ai][m] = *(const PG8_LAS u32x4*)(vlds + (((ch0 >> 6) & 1) * 2 + ai) * HTB + lds_byte((row & 127), (ch0 & 63)));
            else vwk[ai][m] = *(const u32x4*)(V + ((unsigned)row * 1536u + (unsigned)ch0));
        EPI_ROWS_END
        EPI_ROWS_BEGIN
            const unsigned off = (unsigned)row * 1024u + (unsigned)ch0;
            f32x4 vv[2]; unpack8(vwk[ai][m], vv[0], vv[1]);
            f32x4 la[2], bb[2];
#pragma unroll
            for (int n = 0; n < 2; ++n)
#pragma unroll
                for (int j = 0; j < 4; ++j) {
                    const float r = sigmoidf_(acc[ai][0][m][n][j] + ba[n][j]), ig = sigmoidf_(acc[ai][1][m][n][j] + bx[n][j]);
                    const float l = sp[n][j] * r, x2 = 2.0f * l;
                    const float poly = x2 * (1.0f + 0.5f * x2 * (1.0f + 0.33333334f * x2 * (1.0f + 0.25f * x2 * (1.0f + 0.2f * x2 * (1.0f + 0.16666667f * x2)))));
                    const float em1 = EXACT ? ((x2 > -0.25f) ? poly : (__expf(x2) - 1.0f)) : poly;
                    la[n][j] = l; bb[n][j] = __builtin_amdgcn_sqrtf(fmaxf(-em1, 0.f)) * ig * vv[n][j]; }
            *(u32x4*)(LA + ((unsigned)row * 1536u + (unsigned)ch0)) = pack8(la[0], la[1]); *(u32x4*)(BB + off) = pack8(bb[0], bb[1]);
        EPI_ROWS_END
    }
    template <int NAI> __device__ __forceinline__ void run(const f32x4 (&acc)[2][2][4][2], const Unit& u, int wr, int wc, int fr, int fq) const {
        const int ch0 = u.pn * 128 + wc * 32 + 8 * fq;
        f32x4 ba[2], bx[2], sp[2]; bool big = false;
#pragma unroll
        for (int n = 0; n < 2; ++n) { ba[n] = *(const f32x4*)(b_a + ch0 + 4 * n); bx[n] = *(const f32x4*)(b_x + ch0 + 4 * n); sp[n] = *(const f32x4*)(sp8 + ch0 + 4 * n);
#pragma unroll
            for (int j = 0; j < 4; ++j) big = big || !(sp[n][j] >= -0.125f); }
        if (__builtin_amdgcn_ballot_w64(big) != 0ull) rows<NAI, true>(acc, u, wr, fr, ch0, ba, bx, sp);
        else rows<NAI, false>(acc, u, wr, fr, ch0, ba, bx, sp);
    }
};
struct EpiMix {
    const bf16_t *RB, *G1; bf16_t* MIXB;
    __device__ __forceinline__ void mid(f32x4 (&acc)[2][2][4][2], const Unit& u0, int wr, int wc, int fr, int fq) const {
        constexpr int NAI = 2; Unit u = u0; asm volatile("" : "+s"(u.pm), "+s"(u.pn));
        const int col0 = u.pn * BM + wc * 32 + 8 * fq;
        u32x4 rw[2][4][2];
        EPI_ROWS_BEGIN
            const unsigned off = (unsigned)row * 1024u + (unsigned)col0;
#pragma unroll
            for (int bj = 0; bj < 2; ++bj) rw[ai][m][bj] = *(const u32x4*)(RB + off + bj * HALF);
        EPI_ROWS_END
        EPI_ROWS_BEGIN
#pragma unroll
            for (int bj = 0; bj < 2; ++bj) { f32x4 r[2]; unpack8(rw[ai][m][bj], r[0], r[1]); acc[ai][bj][m][0] *= r[0]; acc[ai][bj][m][1] *= r[1]; }
            (void)row;
        EPI_ROWS_END
    }
    template <int NAI> __device__ __forceinline__ void run(const f32x4 (&acc)[2][2][4][2], const Unit& u, int wr, int wc, int fr, int fq) const {
        const int col0 = u.pn * BM + wc * 32 + 8 * fq;
        u32x4 gw[2][4][2];
        EPI_ROWS_BEGIN
            const unsigned off = (unsigned)row * 1024u + (unsigned)col0;
#pragma unroll
            for (int bj = 0; bj < 2; ++bj) gw[ai][m][bj] = *(const u32x4*)(G1 + off + bj * HALF);
        EPI_ROWS_END
        EPI_ROWS_BEGIN
            const unsigned off = (unsigned)row * 1024u + (unsigned)col0;
#pragma unroll
            for (int bj = 0; bj < 2; ++bj) { f32x4 g[2]; unpack8(gw[ai][m][bj], g[0], g[1]);
                *(u32x4*)(MIXB + off + bj * HALF) = pack8(g[0] * acc[ai][bj][m][0], g[1] * acc[ai][bj][m][1]); }
        EPI_ROWS_END
    }
};
struct EpiRes1 {
    const bf16_t* XNB; const float* RSI; bf16_t* X1B; float* SSQ;
    template <int NAI> __device__ __forceinline__ void run(const f32x4 (&acc)[2][2][4][2], const Unit& u, int wr, int wc, int fr, int fq) const {
        const int col0 = u.pn * BM + wc * 32 + 8 * fq;
#pragma unroll
        for (int ai = 0; ai < NAI; ++ai) {
            u32x4 xw[4][2]; float qi[4];
#pragma unroll
            for (int m = 0; m < 4; ++m) { const int row = u.pm * BM + u.rh + ai * HALF + wr * 64 + m * 16 + fr; const unsigned off = (unsigned)row * 1024u + (unsigned)col0; qi[m] = RSI[row];
#pragma unroll
                for (int bj = 0; bj < 2; ++bj) xw[m][bj] = *(const u32x4*)(XNB + off + bj * HALF); }
            asm volatile("s_waitcnt vmcnt(0)" ::: "memory");
#pragma unroll
            for (int m = 0; m < 4; ++m) { const int row = u.pm * BM + u.rh + ai * HALF + wr * 64 + m * 16 + fr; const unsigned off = (unsigned)row * 1024u + (unsigned)col0; float ss = 0.f;
#pragma unroll
                for (int bj = 0; bj < 2; ++bj) { f32x4 xa, xb; unpack8(xw[m][bj], xa, xb);
                    const f32x4 a = xa * qi[m] + acc[ai][bj][m][0], b = xb * qi[m] + acc[ai][bj][m][1];
                    *(u32x4*)(X1B + off + bj * HALF) = pack8(a, b);
                    ss += (a[0] * a[0] + a[1] * a[1]) + (a[2] * a[2] + a[3] * a[3]) + (b[0] * b[0] + b[1] * b[1]) + (b[2] * b[2] + b[3] * b[3]); }
                ss += __shfl_xor(ss, 16); ss += __shfl_xor(ss, 32);
                if (fq == 0) SSQ[(unsigned)row * 16u + (unsigned)(u.pn * 4 + wc)] = ss; }
        }
    }
};
struct EpiSwiglu {
    const PG8_LAS float* RSL; bf16_t* ACT;
    template <int NAI> __device__ __forceinline__ void run(const f32x4 (&acc)[2][2][4][2], const Unit& u, int wr, int wc, int fr, int fq) const {
        const int col0 = u.pn * 128 + wc * 32 + 8 * fq;
        const PG8_LAS float* rt = RSL + u.idx * 256 + wr * 64 + fr;
        EPI_ROWS_BEGIN
            const float rs = rt[ai * HALF + m * 16];
            f32x4 o[2];
#pragma unroll
            for (int n = 0; n < 2; ++n)
#pragma unroll
                for (int j = 0; j < 4; ++j) { const float g = acc[ai][0][m][n][j] * rs, up = acc[ai][1][m][n][j] * rs; o[n][j] = g * sigmoidf_(g) * up; }
            __builtin_nontemporal_store(pack8(o[0], o[1]), (u32x4*)(ACT + (unsigned)((unsigned)row * 2816u + (unsigned)col0)));
        EPI_ROWS_END
    }
};
struct EpiRes2 {
    const bf16_t* X1B; float* OUT;
    template <int NAI> __device__ __forceinline__ void run(const f32x4 (&acc)[2][2][4][2], const Unit& u, int wr, int wc, int fr, int fq) const {
        const int col0 = u.pn * BM + wc * 32 + 8 * fq;
        EPI_ROWS_BEGIN
            const unsigned off = (unsigned)row * 1024u + (unsigned)col0;
#pragma unroll
            for (int bj = 0; bj < 2; ++bj) { f32x4 xa, xb; unpack8(*(const u32x4*)(X1B + off + bj * HALF), xa, xb);
                *(f32x4*)(OUT + off + bj * HALF) = xa + acc[ai][bj][m][0]; *(f32x4*)(OUT + off + bj * HALF + 4) = xb + acc[ai][bj][m][1]; }
        EPI_ROWS_END
    }
};

struct EpiFinal {
    const bf16_t* X1B; float* OUT; float* SSQ2; unsigned* cnt; const float* gfin;
    template <int NAI> __device__ __forceinline__ void run(f32x4 (&acc)[2][2][4][2], const Unit& u, int wr, int wc, int fr, int fq) const {
        const int col0 = u.pn * BM + wc * 32 + 8 * fq;
        { u32x4 xw[2][4][2];
          EPI_ROWS_BEGIN
              const unsigned off = (unsigned)row * 1024u + (unsigned)col0;
#pragma unroll
              for (int bj = 0; bj < 2; ++bj) xw[ai][m][bj] = *(const u32x4*)(X1B + off + bj * HALF);
          EPI_ROWS_END
          EPI_ROWS_BEGIN
              float ss = 0.f;
#pragma unroll
              for (int bj = 0; bj < 2; ++bj) { f32x4 xa, xb; unpack8(xw[ai][m][bj], xa, xb);
                  const f32x4 a = xa + acc[ai][bj][m][0], b = xb + acc[ai][bj][m][1]; acc[ai][bj][m][0] = a; acc[ai][bj][m][1] = b;
                  ss += (a[0] * a[0] + a[1] * a[1]) + (a[2] * a[2] + a[3] * a[3]) + (b[0] * b[0] + b[1] * b[1]) + (b[2] * b[2] + b[3] * b[3]); }
              ss += __shfl_xor(ss, 16); ss += __shfl_xor(ss, 32);
              if (fq == 0) __hip_atomic_store(SSQ2 + (unsigned)row * 16u + (unsigned)(u.pn * 4 + wc), ss, __ATOMIC_RELAXED, __HIP_MEMORY_SCOPE_AGENT);
          EPI_ROWS_END }
        asm volatile("s_waitcnt vmcnt(0)" ::: "memory");
        unsigned* c = cnt + 64 * u.pm;
        if ((threadIdx.x & 63) == 0) __hip_atomic_fetch_add(c, 1u, __ATOMIC_RELAXED, __HIP_MEMORY_SCOPE_AGENT);
        f32x4 gv[2][2];
#pragma unroll
        for (int bj = 0; bj < 2; ++bj)
#pragma unroll
            for (int n = 0; n < 2; ++n) gv[bj][n] = *(const f32x4*)(gfin + col0 + bj * HALF + 4 * n);
        { unsigned sp = 0;
          while ((unsigned)__builtin_amdgcn_readfirstlane(__hip_atomic_load(c, __ATOMIC_RELAXED, __HIP_MEMORY_SCOPE_AGENT)) < 32u) { __builtin_amdgcn_s_sleep(2); if (++sp > (1u << 20)) break; } }
        __builtin_amdgcn_fence(__ATOMIC_ACQUIRE, "agent");
        unsigned long long w0[2][4], w1[2][4];
        EPI_ROWS_BEGIN
            const unsigned long long* sl = (const unsigned long long*)(SSQ2 + (unsigned)row * 16u + (unsigned)(4 * fq));
            w0[ai][m] = __hip_atomic_load(sl, __ATOMIC_RELAXED, __HIP_MEMORY_SCOPE_AGENT); w1[ai][m] = __hip_atomic_load(sl + 1, __ATOMIC_RELAXED, __HIP_MEMORY_SCOPE_AGENT);
        EPI_ROWS_END
        EPI_ROWS_BEGIN
            const unsigned off = (unsigned)row * 1024u + (unsigned)col0;
            float sq = (__uint_as_float((unsigned)w0[ai][m]) + __uint_as_float((unsigned)(w0[ai][m] >> 32))) + (__uint_as_float((unsigned)w1[ai][m]) + __uint_as_float((unsigned)(w1[ai][m] >> 32)));
            sq += __shfl_xor(sq, 16); sq += __shfl_xor(sq, 32);
            const float rs = 1.0f / sqrtf(sq * (1.0f / 1024.0f) + 1e-6f);
#pragma unroll
            for (int bj = 0; bj < 2; ++bj) { *(f32x4*)(OUT + off + bj * HALF) = acc[ai][bj][m][0] * rs * gv[bj][0]; *(f32x4*)(OUT + off + bj * HALF + 4) = acc[ai][bj][m][1] * rs * gv[bj][1]; }
        EPI_ROWS_END
    }
};

template <class Epi, bool ALIGN_EPI, int MID_T = -1>
__device__ __forceinline__ void gemm_phase(PG8_LAS unsigned char* lds, const Gemm g, const StaticOrder& S, const Epi& E) {
    const int tid = threadIdx.x, wid = __builtin_amdgcn_readfirstlane(tid >> 6), lane = tid & 63, wr = wid >> 2, wc = wid & 3, fr = lane & 15, fq = lane >> 4;
    int nt = g.K / BK; asm volatile("" : "+s"(nt));
    unsigned voffA[2], voffB[2];
#pragma unroll
    for (int i = 0; i < 2; ++i) { int R, C; stage_rc(tid * 16 + i * 8192, R, C); const int Rb = (R & ~31) + perm32(R & 31);
        voffA[i] = (unsigned)(R * g.lda + C) * 2u; voffB[i] = (unsigned)(Rb * g.ldb + C) * 2u; }
    const size_t kstep = (size_t)(BK * 2);
    const size_t hstepA = (size_t)HALF * g.lda * 2, hstepB = (size_t)HALF * g.ldb * 2;
    const size_t tstepA = 2 * hstepA, tstepB = 2 * hstepB;
    const unsigned ldsw = (unsigned)wid * 1024u;
    const int aoff = lds_byte(wr * 64 + fr, fq * 8), boff = lds_byte(wc * 32 + fr, fq * 8);
#define PG8_SA(b, h) (((b) * 2 + (h)) * HTB)
#define PG8_SB(b, h) ((4 + (b) * 2 + (h)) * HTB)
#define PG8_STAGE(bufoff, gbase, voff) do { _Pragma("unroll") for (int _i = 0; _i < 2; ++_i) \
        __builtin_amdgcn_global_load_lds((const unsigned*)((const char*)(gbase) + (voff)[_i]), (PG8_LAS unsigned*)(lds + (bufoff) + ldsw + _i * 8192), 16, 0, 0); } while (0)
#define PG8_LDA(dst, b, h) do { _Pragma("unroll") for (int m = 0; m < 4; ++m) _Pragma("unroll") for (int k = 0; k < 2; ++k) dst[m][k] = *(const PG8_LAS bf16x8*)(lds + PG8_SA(b, h) + aoff + m * 2048 + k * 1024); } while (0)
#define PG8_LDB(dst, b, h) do { _Pragma("unroll") for (int n = 0; n < 2; ++n) _Pragma("unroll") for (int k = 0; k < 2; ++k) dst[n][k] = *(const PG8_LAS bf16x8*)(lds + PG8_SB(b, h) + boff + n * 2048 + k * 1024); } while (0)
#define PG8_MMA(ai, bj, At, Bt) do { __builtin_amdgcn_s_setprio(1); _Pragma("unroll") for (int m = 0; m < 4; ++m) _Pragma("unroll") for (int n = 0; n < 2; ++n) _Pragma("unroll") for (int k = 0; k < 2; ++k) \
        acc[ai][bj][m][n] = __builtin_amdgcn_mfma_f32_16x16x32_bf16(Bt[n][k], At[m][k], acc[ai][bj][m][n], 0, 0, 0); __builtin_amdgcn_s_setprio(0); } while (0)
#define PG8_WAIT_V(n) asm volatile("s_waitcnt vmcnt(" #n ")" ::: "memory")
#define PG8_WAIT_L(n) asm volatile("s_waitcnt lgkmcnt(" #n ")" ::: "memory")
#define PG8_BAR __builtin_amdgcn_s_barrier()
#define PG8_SCHED __builtin_amdgcn_sched_barrier(0)
    Unit cur, nxt; int ui = 0;
    if (!S.next(0, cur)) return;
    f32x4 acc[2][2][4][2];
#pragma unroll
    for (int a = 0; a < 2; ++a)
#pragma unroll
        for (int b = 0; b < 2; ++b)
#pragma unroll
            for (int m = 0; m < 4; ++m)
#pragma unroll
                for (int n = 0; n < 2; ++n) acc[a][b][m][n] = (f32x4){0.f, 0.f, 0.f, 0.f};
    bf16x8 At[4][2], B0[2][2], B1[2][2];
    const char* cA = (const char*)g.A + (size_t)cur.pm * tstepA + (size_t)((cur.pn >> g.ash) * g.amul) * 2; const char* cB = (const char*)g.Bt + (size_t)cur.pn * tstepB;
    PG8_STAGE(PG8_SB(0, 0), cB, voffB); PG8_STAGE(PG8_SB(0, 1), cB + hstepB, voffB); PG8_STAGE(PG8_SA(0, 0), cA, voffA); PG8_STAGE(PG8_SA(0, 1), cA + hstepA, voffA);
    if (wr == 1) PG8_BAR;
    PG8_WAIT_V(2); PG8_BAR;
    PG8_STAGE(PG8_SB(1, 0), cB + kstep, voffB); PG8_STAGE(PG8_SA(1, 0), cA + kstep, voffA); PG8_STAGE(PG8_SB(1, 1), cB + hstepB + kstep, voffB);
    PG8_WAIT_V(6); PG8_BAR;
    for (;;) {
        const bool has_next = S.next(ui + 1, nxt);
        const char* nA = has_next ? (const char*)g.A + (size_t)nxt.pm * tstepA + (size_t)((nxt.pn >> g.ash) * g.amul) * 2 : cA; const char* nB = has_next ? (const char*)g.Bt + (size_t)nxt.pn * tstepB : cB;
        for (int t = 0; t < nt; t += 2) {
            const bool last = (t == nt - 2);
            if constexpr (MID_T >= 0) { if (t == MID_T) E.mid(acc, cur, wr, wc, fr, fq); }
            const char* a1 = cA + (size_t)(t + 1) * kstep;
            const char* a2 = last ? nA : cA + (size_t)(t + 2) * kstep; const char* b2 = last ? nB : cB + (size_t)(t + 2) * kstep;
            const char* a3 = a2 + kstep; const char* b3 = b2 + kstep;
            PG8_LDB(B0, 0, 0); PG8_LDB(B1, 0, 1); PG8_SCHED; PG8_LDA(At, 0, 0); PG8_STAGE(PG8_SA(1, 1), a1 + hstepA, voffA);
            PG8_WAIT_V(8); PG8_WAIT_L(0); PG8_BAR; PG8_MMA(0, 0, At, B0); PG8_MMA(0, 1, At, B1); PG8_BAR; PG8_SCHED;
            PG8_LDA(At, 0, 1); PG8_STAGE(PG8_SB(0, 0), b2, voffB); PG8_STAGE(PG8_SB(0, 1), b2 + hstepB, voffB); PG8_STAGE(PG8_SA(0, 0), a2, voffA);
            PG8_WAIT_V(8); PG8_WAIT_L(0); PG8_BAR; PG8_MMA(1, 0, At, B0); PG8_MMA(1, 1, At, B1); PG8_BAR; PG8_SCHED;
            PG8_LDB(B0, 1, 0); PG8_LDB(B1, 1, 1); PG8_SCHED; PG8_LDA(At, 1, 0); PG8_STAGE(PG8_SA(0, 1), a2 + hstepA, voffA);
            PG8_WAIT_V(8); PG8_WAIT_L(0); PG8_BAR; PG8_MMA(0, 0, At, B0); PG8_MMA(0, 1, At, B1); PG8_BAR; PG8_SCHED;
            PG8_LDA(At, 1, 1); PG8_STAGE(PG8_SB(1, 0), b3, voffB); PG8_STAGE(PG8_SB(1, 1), b3 + hstepB, voffB); PG8_STAGE(PG8_SA(1, 0), a3, voffA);
            PG8_WAIT_V(8); PG8_WAIT_L(0); PG8_BAR; PG8_MMA(1, 0, At, B0); PG8_MMA(1, 1, At, B1); PG8_BAR; PG8_SCHED;
        }
        if constexpr (ALIGN_EPI) { if (wr == 0) PG8_BAR; }
        E.template run<2>(acc, cur, wr, wc, fr, fq);
        if (!has_next) break;
#pragma unroll
        for (int a = 0; a < 2; ++a)
#pragma unroll
            for (int b = 0; b < 2; ++b)
#pragma unroll
                for (int m = 0; m < 4; ++m)
#pragma unroll
                    for (int n = 0; n < 2; ++n) acc[a][b][m][n] = (f32x4){0.f, 0.f, 0.f, 0.f};
        cur = nxt; cA = nA; cB = nB; ++ui;
        if constexpr (ALIGN_EPI) { if (wr == 1) PG8_BAR; }
    }
    PG8_WAIT_V(0);
    if constexpr (!ALIGN_EPI) { if (wr == 0) PG8_BAR; }
    PG8_BAR;
#undef PG8_SA
#undef PG8_SB
#undef PG8_STAGE
#undef PG8_LDA
#undef PG8_LDB
#undef PG8_MMA
#undef PG8_WAIT_V
#undef PG8_WAIT_L
#undef PG8_BAR
#undef PG8_SCHED
}

template <class Epi>
__device__ __forceinline__ void gemm_half(PG8_LAS unsigned char* lds, const Gemm g, const Unit u, const Epi& E) {
    const int tid = threadIdx.x, wid = __builtin_amdgcn_readfirstlane(tid >> 6), lane = tid & 63, wr = wid >> 2, wc = wid & 3, fr = lane & 15, fq = lane >> 4;
    int nt = g.K / BK; asm volatile("" : "+s"(nt));
    unsigned voffA[2], voffB[2];
#pragma unroll
    for (int i = 0; i < 2; ++i) { int R, C; stage_rc(tid * 16 + i * 8192, R, C); const int Rb = (R & ~31) + perm32(R & 31);
        voffA[i] = (unsigned)(R * g.lda + C) * 2u; voffB[i] = (unsigned)(Rb * g.ldb + C) * 2u; }
    const size_t kstep = (size_t)(BK * 2);
    const size_t hstepA = (size_t)HALF * g.lda * 2, hstepB = (size_t)HALF * g.ldb * 2;
    const unsigned ldsw = (unsigned)wid * 1024u;
    const int aoff = lds_byte(wr * 64 + fr, fq * 8), boff = lds_byte(wc * 32 + fr, fq * 8);
#define PG8_SA(b, h) (((b) * 2 + (h)) * HTB)
#define PG8_SB(b, h) ((4 + (b) * 2 + (h)) * HTB)
#define PG8_STAGE(bufoff, gbase, voff) do { _Pragma("unroll") for (int _i = 0; _i < 2; ++_i) \
        __builtin_amdgcn_global_load_lds((const unsigned*)((const char*)(gbase) + (voff)[_i]), (PG8_LAS unsigned*)(lds + (bufoff) + ldsw + _i * 8192), 16, 0, 0); } while (0)
#define PG8_LDA(dst, b, h) do { _Pragma("unroll") for (int m = 0; m < 4; ++m) _Pragma("unroll") for (int k = 0; k < 2; ++k) dst[m][k] = *(const PG8_LAS bf16x8*)(lds + PG8_SA(b, h) + aoff + m * 2048 + k * 1024); } while (0)
#define PG8_LDB(dst, b, h) do { _Pragma("unroll") for (int n = 0; n < 2; ++n) _Pragma("unroll") for (int k = 0; k < 2; ++k) dst[n][k] = *(const PG8_LAS bf16x8*)(lds + PG8_SB(b, h) + boff + n * 2048 + k * 1024); } while (0)
#define PG8_MMA(ai, bj, At, Bt) do { __builtin_amdgcn_s_setprio(1); _Pragma("unroll") for (int m = 0; m < 4; ++m) _Pragma("unroll") for (int n = 0; n < 2; ++n) _Pragma("unroll") for (int k = 0; k < 2; ++k) \
        acc[ai][bj][m][n] = __builtin_amdgcn_mfma_f32_16x16x32_bf16(Bt[n][k], At[m][k], acc[ai][bj][m][n], 0, 0, 0); __builtin_amdgcn_s_setprio(0); } while (0)
#define PG8_WAIT_V(n) asm volatile("s_waitcnt vmcnt(" #n ")" ::: "memory")
#define PG8_WAIT_L(n) asm volatile("s_waitcnt lgkmcnt(" #n ")" ::: "memory")
#define PG8_BAR __builtin_amdgcn_s_barrier()
#define PG8_SCHED __builtin_amdgcn_sched_barrier(0)
    f32x4 acc[2][2][4][2];
#pragma unroll
    for (int a = 0; a < 2; ++a)
#pragma unroll
        for (int b = 0; b < 2; ++b)
#pragma unroll
            for (int m = 0; m < 4; ++m)
#pragma unroll
                for (int n = 0; n < 2; ++n) acc[a][b][m][n] = (f32x4){0.f, 0.f, 0.f, 0.f};
    bf16x8 At[4][2], B0[2][2], B1[2][2];
    const char* cA = (const char*)g.A + ((size_t)u.pm * BM + u.rh) * g.lda * 2 + (size_t)((u.pn >> g.ash) * g.amul) * 2; const char* cB = (const char*)g.Bt + (size_t)u.pn * 2 * hstepB;
    PG8_STAGE(PG8_SB(0, 0), cB, voffB); PG8_STAGE(PG8_SB(0, 1), cB + hstepB, voffB); PG8_STAGE(PG8_SA(0, 0), cA, voffA);
    PG8_STAGE(PG8_SB(1, 0), cB + kstep, voffB); PG8_STAGE(PG8_SB(1, 1), cB + hstepB + kstep, voffB); PG8_STAGE(PG8_SA(1, 0), cA + kstep, voffA);
    PG8_WAIT_V(6); PG8_BAR;
#define PG8_HALF_STEP(b, tt) do { \
        PG8_LDB(B0, b, 0); PG8_LDB(B1, b, 1); PG8_LDA(At, b, 0); PG8_WAIT_L(0); PG8_BAR; PG8_SCHED; \
        const bool more_ = (tt) + 2 < nt; \
        if (more_) { const char* b2 = cB + (size_t)((tt) + 2) * kstep; const char* a2 = cA + (size_t)((tt) + 2) * kstep; \
            PG8_STAGE(PG8_SB(b, 0), b2, voffB); PG8_STAGE(PG8_SB(b, 1), b2 + hstepB, voffB); PG8_STAGE(PG8_SA(b, 0), a2, voffA); } \
        PG8_MMA(0, 0, At, B0); PG8_MMA(0, 1, At, B1); \
        if (more_) PG8_WAIT_V(6); else PG8_WAIT_V(0); \
        PG8_BAR; PG8_SCHED; } while (0)
    for (int t = 0; t < nt; t += 2) { PG8_HALF_STEP(0, t); PG8_HALF_STEP(1, t + 1); }
    E.template run<1>(acc, u, wr, wc, fr, fq);
    PG8_BAR;
#undef PG8_HALF_STEP
#undef PG8_SA
#undef PG8_SB
#undef PG8_STAGE
#undef PG8_LDA
#undef PG8_LDB
#undef PG8_MMA
#undef PG8_WAIT_V
#undef PG8_WAIT_L
#undef PG8_BAR
#undef PG8_SCHED
}
template <class Epi>
__device__ __forceinline__ void gate_unit_fused(PG8_LAS unsigned char* lds, const bf16_t* UR, const float* convw, const float* convb, const bf16_t* WG, const Epi& E, int pm, int h, bf16_t* Vg) {
    const int tid = threadIdx.x, wid = __builtin_amdgcn_readfirstlane(tid >> 6), lane = tid & 63, wr = wid >> 2, wc = wid & 3, fr = lane & 15, fq = lane >> 4;
    { const char* cB = (const char*)WG + (size_t)h * 256 * 128 * 2;
#pragma unroll
      for (int i = 0; i < 2; ++i) { int R, C; stage_rc(tid * 16 + i * 8192, R, C); const int Rb = (R & ~31) + perm32(R & 31); const unsigned vo = (unsigned)(Rb * 128 + C) * 2u;
#pragma unroll
          for (int kt = 0; kt < 2; ++kt)
#pragma unroll
              for (int hb = 0; hb < 2; ++hb)
                  __builtin_amdgcn_global_load_lds((const unsigned*)(cB + (size_t)hb * 128 * 128 * 2 + kt * 128 + vo), (PG8_LAS unsigned*)(lds + (4 + kt * 2 + hb) * HTB + wid * 1024 + i * 8192), 16, 0, 0); } }
    { const int to = tid >> 4, co = tid & 15, t0 = pm * 256 + to * 8, tl = t0 & 4095, cog = h * 16 + co;
      const bf16_t* src = UR + (size_t)t0 * 1024 + cog * 8; const float* cw = convw + cog * 8; const float* cb = convb + cog * 8;
      u32x4 rw[11];
#pragma unroll
      for (int k = 0; k < 11; ++k) rw[k] = (k >= 3 || tl != 0) ? *(const u32x4*)(src + (ptrdiff_t)(k - 3) * 1024) : (u32x4){0u, 0u, 0u, 0u};
      f32x4 w0[2], w1[2], w2[2], w3[2], bb[2];
#pragma unroll
      for (int n = 0; n < 2; ++n) { w0[n] = *(const f32x4*)(cw + 4 * n); w1[n] = *(const f32x4*)(cw + 1024 + 4 * n); w2[n] = *(const f32x4*)(cw + 2048 + 4 * n); w3[n] = *(const f32x4*)(cw + 3072 + 4 * n); bb[n] = *(const f32x4*)(cb + 4 * n); }
#pragma unroll
      for (int i = 0; i < 8; ++i) { f32x4 a[2], b[2], c[2], d[2]; unpack8(rw[i], a[0], a[1]); unpack8(rw[i + 1], b[0], b[1]); unpack8(rw[i + 2], c[0], c[1]); unpack8(rw[i + 3], d[0], d[1]);
          const int tr = to * 8 + i;
          const u32x4 cv = pack8(bb[0] + w0[0] * a[0] + w1[0] * b[0] + w2[0] * c[0] + w3[0] * d[0], bb[1] + w0[1] * a[1] + w1[1] * b[1] + w2[1] * c[1] + w3[1] * d[1]);
          *(PG8_LAS u32x4*)(lds + ((co >> 3) * 2 + (tr >> 7)) * HTB + lds_byte(tr & 127, (co & 7) * 8)) = cv;
          if (Vg) *(u32x4*)(Vg + (size_t)(t0 + i) * 1536 + cog * 8) = cv; } }
    asm volatile("s_waitcnt vmcnt(0) lgkmcnt(0)" ::: "memory"); __syncthreads(); __builtin_amdgcn_sched_barrier(0);
    f32x4 acc[2][2][4][2];
#pragma unroll
    for (int a = 0; a < 2; ++a)
#pragma unroll
        for (int b = 0; b < 2; ++b)
#pragma unroll
            for (int m = 0; m < 4; ++m)
#pragma unroll
                for (int n = 0; n < 2; ++n) acc[a][b][m][n] = (f32x4){0.f, 0.f, 0.f, 0.f};
    const int aoff = lds_byte(wr * 64 + fr, fq * 8), boff = lds_byte(wc * 32 + fr, fq * 8);
#pragma unroll
    for (int kt = 0; kt < 2; ++kt) {
#pragma unroll
        for (int ai = 0; ai < 2; ++ai) { bf16x8 At[4][2];
#pragma unroll
            for (int m = 0; m < 4; ++m)
#pragma unroll
                for (int k = 0; k < 2; ++k) At[m][k] = *(const PG8_LAS bf16x8*)(lds + (kt * 2 + ai) * HTB + aoff + m * 2048 + k * 1024);
#pragma unroll
            for (int bj = 0; bj < 2; ++bj) { bf16x8 Bf[2][2];
#pragma unroll
                for (int n = 0; n < 2; ++n)
#pragma unroll
                    for (int k = 0; k < 2; ++k) Bf[n][k] = *(const PG8_LAS bf16x8*)(lds + (4 + kt * 2 + bj) * HTB + boff + n * 2048 + k * 1024);
#pragma unroll
                for (int m = 0; m < 4; ++m)
#pragma unroll
                    for (int n = 0; n < 2; ++n)
#pragma unroll
                        for (int k = 0; k < 2; ++k) acc[ai][bj][m][n] = __builtin_amdgcn_mfma_f32_16x16x32_bf16(Bf[n][k], At[m][k], acc[ai][bj][m][n], 0, 0, 0);
                __builtin_amdgcn_sched_barrier(0); } } }
    Unit u; u.pm = pm; u.pn = h; u.rh = 0; u.idx = 0;
    E.template run<2>(acc, u, wr, wc, fr, fq);
    __syncthreads();
}
}

constexpr int NWAVES = 8, NTHR = 512;
constexpr int M = 16384, SEQ = 4096, NB = 4, D = 1024, DPOOL = 512, DRNN = 1024, DIN = 4608, DFF = 2816;
constexpr float EPS = 1e-6f;
constexpr int NPH = 11;
constexpr int SCAN_T = 128, SCAN_NC = SEQ / SCAN_T;

constexpr size_t MiB = 1u << 20;
constexpr size_t WS_SP8 = 512 * 1024;
constexpr size_t WS_RSI = 576 * 1024;
constexpr size_t WS_SSQ = 1 * MiB;
constexpr size_t WS_SSQ2 = 2 * MiB;
constexpr size_t WS_CS = 2 * MiB, WS_CH = 3 * MiB;
constexpr size_t WS_WIN = 4 * MiB;
constexpr size_t WS_WFI = 13 * MiB;
constexpr size_t WS_WFO = 24 * MiB;
constexpr size_t WS_WCAT = WS_WFO + 5632 * 1024;
constexpr size_t WS_WO = WS_WCAT + 3 * MiB;
constexpr size_t WS_WGRP = WS_WO + 2 * MiB;
constexpr size_t WS_WGATE = WS_WGRP + MiB / 4;
constexpr size_t WS_R1 = 36 * MiB;
constexpr size_t WS_R2 = 68 * MiB;
constexpr size_t WS_R3 = 84 * MiB;
constexpr size_t WS_R4 = 116 * MiB;
constexpr size_t WS_R7 = 148 * MiB;
constexpr size_t WS_R8 = 164 * MiB;
constexpr size_t WS_CAT = 196 * MiB;
constexpr size_t WS_MIXB = 148 * MiB;
constexpr size_t WS_ACT = 68 * MiB;
constexpr size_t WS_END = 244 * MiB;

constexpr int LDS_BYTES = 147456;

#define LAS __attribute__((address_space(3)))
typedef unsigned short bf16;
typedef unsigned v4u __attribute__((ext_vector_type(4)));
typedef unsigned v2u __attribute__((ext_vector_type(2)));
typedef float f32x4 __attribute__((ext_vector_type(4)));
typedef float f32x2 __attribute__((ext_vector_type(2)));
#define LDS_WAIT() asm volatile("s_waitcnt lgkmcnt(0)" ::: "memory")
using pg8::cvt_pk_bf16; using pg8::bf_lo; using pg8::bf_hi;

struct Args { const float* in[19]; float* out; unsigned char* ws; int ph_lo, ph_hi; };
enum { I_X = 0, I_NORM_MIX, I_W_IN, I_W_GRP, I_POOL_SCALE, I_W_POOL_OUT, I_CONV_W, I_CONV_B, I_W_RG_A, I_B_RG_A, I_W_RG_X, I_B_RG_X, I_LAMBDA, I_W_RNN_OUT, I_W_O, I_NORM_FFN, I_W_FFN_IN, I_W_FFN_OUT, I_NORM_FINAL };

__device__ __forceinline__ float wave_sum(float v) {
#pragma unroll
    for (int o = 1; o < 64; o <<= 1) v += __shfl_xor(v, o);
    return v;
}

__device__ __forceinline__ void transpose_item(const float* W, int Nsrc, int Kdst, bf16* WT, int k0, int n_src0, int n_dst0, const float* kscale, LAS float* scr, int lane) {
    f32x4 v[8]; const int n4 = (lane & 7) * 4;
#pragma unroll
    for (int i = 0; i < 8; ++i) { const int kk = 8 * i + (lane >> 3); v[i] = *(const f32x4*)(W + (size_t)(k0 + kk) * Nsrc + n_src0 + n4); }
    if (kscale) {
#pragma unroll
        for (int i = 0; i < 8; ++i) v[i] = v[i] * kscale[k0 + 8 * i + (lane >> 3)]; }
#pragma unroll
    for (int i = 0; i < 8; ++i) { const int kk = 8 * i + (lane >> 3);
#pragma unroll
        for (int j = 0; j < 4; ++j) scr[kk * 33 + n4 + j] = v[i][j]; }
    LDS_WAIT(); asm volatile("" ::: "memory");
    const int c = lane & 7;
#pragma unroll
    for (int j = 0; j < 4; ++j) { const int n = (lane >> 3) + 8 * j; const LAS float* s = scr + (8 * c) * 33 + n;
        v4u o; o.x = cvt_pk_bf16(s[0 * 33], s[1 * 33]); o.y = cvt_pk_bf16(s[2 * 33], s[3 * 33]); o.z = cvt_pk_bf16(s[4 * 33], s[5 * 33]); o.w = cvt_pk_bf16(s[6 * 33], s[7 * 33]);
        *(v4u*)(WT + (size_t)(n_dst0 + n) * Kdst + k0 + 8 * c) = o; }
    LDS_WAIT(); asm volatile("" ::: "memory");
}

#define XB_TMO      128
#define XB_XCNT(j)  (256  + 64 * (j))
#define XB_XSUB(j)  (1280 + 64 * (j))
#define XB_XGEN(j)  (2304 + 64 * (j))
#define XB_TOP      3328
#define XB_TOPGEN   3392
#define XCD_BAR_WORDS 3456
#define XB_SPIN_CAP (1u << 18)
__device__ __forceinline__ unsigned xb_ld(unsigned* p)              { return __hip_atomic_load(p, __ATOMIC_RELAXED, __HIP_MEMORY_SCOPE_AGENT); }
__device__ __forceinline__ unsigned xb_add(unsigned* p, unsigned v) { return __hip_atomic_fetch_add(p, v, __ATOMIC_RELAXED, __HIP_MEMORY_SCOPE_AGENT); }
__device__ __forceinline__ unsigned xb_xcc_id() { return (unsigned)__builtin_amdgcn_s_getreg((3 << 11) | 20) & 0xFu; }
#define XB_SPIN(cond, bar) do { unsigned _sp = 0; while (cond) { __builtin_amdgcn_s_sleep(1); \
    if ((++_sp & 255u) == 0u) { if (xb_ld(&(bar)[XB_TMO])) break; if (_sp > XB_SPIN_CAP) { atomicAdd(&(bar)[XB_TMO], 1u); break; } } } } while (0)
struct XcdBarrier { unsigned* bar; unsigned x; volatile LAS unsigned* st; };
__device__ __forceinline__ XcdBarrier xcd_barrier_post(unsigned* bar, volatile LAS unsigned* st) {
    XcdBarrier b; b.bar = bar; b.x = xb_xcc_id(); b.st = st;
    if (threadIdx.x == 0) (void)xb_add(&bar[XB_XCNT(b.x)], 1u);
    return b;
}
__device__ __forceinline__ void xcd_barrier_complete(unsigned* bar, unsigned x, unsigned& nloc, unsigned& nx) {
    const unsigned G = gridDim.x * gridDim.y * gridDim.z;
    unsigned sum, cnt, mine, sp = 0u;
    for (;;) {
        sum = 0u; cnt = 0u; mine = 0u;
#pragma unroll
        for (unsigned j = 0; j < 16; ++j) { const unsigned c = xb_ld(&bar[XB_XCNT(j)]); sum += c; cnt += (c > 0u) ? 1u : 0u; mine = (j == x) ? c : mine; }
        if (sum == G) break;
        __builtin_amdgcn_s_sleep(1);
        if ((++sp & 255u) == 0u) { if (xb_ld(&bar[XB_TMO])) break; if (sp > XB_SPIN_CAP) { atomicAdd(&bar[XB_TMO], 1u); break; } }
    }
    nloc = mine > 0u ? mine : 1u; nx = cnt > 0u ? cnt : 1u;
}
__device__ __forceinline__ void xcd_barrier(const XcdBarrier& b) {
    asm volatile("s_waitcnt vmcnt(0)" ::: "memory");
    __syncthreads();
    if (threadIdx.x == 0) {
        unsigned* bar = b.bar;
        __builtin_amdgcn_s_waitcnt(0);
        unsigned nloc = b.st[0], nx = b.st[1];
        if (nloc == 0u) { xcd_barrier_complete(bar, b.x, nloc, nx); b.st[0] = nloc; b.st[1] = nx; }
        const unsigned old = xb_add(&bar[XB_XSUB(b.x)], 1u);
        const unsigned gen = old / nloc;
        if (old + 1u == (gen + 1u) * nloc) {
            __builtin_amdgcn_fence(__ATOMIC_RELEASE, "agent");
            asm volatile("s_waitcnt vmcnt(0)" ::: "memory");
            const unsigned og = xb_add(&bar[XB_TOP], 1u);
            const unsigned tg = og / nx;
            if (og + 1u == (tg + 1u) * nx) xb_add(&bar[XB_TOPGEN], 1u);
            else XB_SPIN(xb_ld(&bar[XB_TOPGEN]) == tg, bar);
            __builtin_amdgcn_fence(__ATOMIC_ACQUIRE, "agent");
            xb_add(&bar[XB_XGEN(b.x)], 1u);
            asm volatile("s_waitcnt vmcnt(0)" ::: "memory");
        } else {
            XB_SPIN(xb_ld(&bar[XB_XGEN(b.x)]) == gen, bar);
            __builtin_amdgcn_fence(__ATOMIC_ACQUIRE, "agent");
            asm volatile("s_waitcnt vmcnt(0)" ::: "memory");
        }
    }
    __syncthreads();
}

template <int W>
__device__ __forceinline__ void pool_item(const bf16* src, bf16* dst, int tl) {
    v4u rw[W + 7];
#pragma unroll
    for (int k = 0; k < W + 7; ++k) rw[k] = (tl + k - (W - 1) >= 0) ? *(const v4u*)(src + (ptrdiff_t)(k - (W - 1)) * DPOOL) : (v4u){0u, 0u, 0u, 0u};
    f32x4 s0 = {0.f, 0.f, 0.f, 0.f}, s1 = s0;
#pragma unroll
    for (int k = 0; k < W - 1; ++k) { f32x4 a, c; pg8::unpack8(rw[k], a, c); s0 += a; s1 += c; }
#pragma unroll
    for (int i = 0; i < 8; ++i) { f32x4 a, c; pg8::unpack8(rw[W - 1 + i], a, c); s0 += a; s1 += c;
        const int t = tl + i; const int cnt = (t + 1 < W) ? t + 1 : W; const float inv = 1.0f / (float)cnt;
        *(v4u*)(dst + (size_t)i * DPOOL) = pg8::pack8(s0 * inv - a, s1 * inv - c);
        f32x4 a2, c2; pg8::unpack8(rw[i], a2, c2); s0 -= a2; s1 -= c2; }
}
__device__ __forceinline__ void scan_local16(const bf16* lap, const bf16* bbp, f32x4 (&S)[2], f32x4 (&H)[2]) {
    S[0] = S[1] = H[0] = H[1] = (f32x4){0.f, 0.f, 0.f, 0.f};
#pragma unroll
    for (int i0 = 0; i0 < 16; i0 += 8) { v4u lw[8], bw[8];
#pragma unroll
        for (int i = 0; i < 8; ++i) { lw[i] = *(const v4u*)(lap + (size_t)(i0 + i) * DRNN); bw[i] = *(const v4u*)(bbp + (size_t)(i0 + i) * DRNN); }
#pragma unroll
        for (int i = 0; i < 8; ++i) { f32x4 l[2], bq[2]; pg8::unpack8(lw[i], l[0], l[1]); pg8::unpack8(bw[i], bq[0], bq[1]);
#pragma unroll
            for (int n = 0; n < 2; ++n)
#pragma unroll
                for (int j = 0; j < 4; ++j) { H[n][j] = __expf(l[n][j]) * H[n][j] + bq[n][j]; S[n][j] += l[n][j]; } } }
}

__device__ __forceinline__ void conv_item(const bf16* UR, bf16* V, const float* convw, const float* convb, int t0, int co) {
    const int tl = t0 & (SEQ - 1);
    const bf16* src = UR + (size_t)t0 * DRNN + co * 8; bf16* dst = V + (size_t)t0 * 1536 + co * 8;
    const float* cw = convw + co * 8; const float* cb = convb + co * 8;
    v4u rw[11];
#pragma unroll
    for (int k = 0; k < 11; ++k) rw[k] = (k >= 3 || tl != 0) ? *(const v4u*)(src + (ptrdiff_t)(k - 3) * DRNN) : (v4u){0u, 0u, 0u, 0u};
    f32x4 w0[2], w1[2], w2[2], w3[2], bb[2];
#pragma unroll
    for (int n = 0; n < 2; ++n) { w0[n] = *(const f32x4*)(cw + 4 * n); w1[n] = *(const f32x4*)(cw + 1024 + 4 * n); w2[n] = *(const f32x4*)(cw + 2048 + 4 * n); w3[n] = *(const f32x4*)(cw + 3072 + 4 * n); bb[n] = *(const f32x4*)(cb + 4 * n); }
#pragma unroll
    for (int i = 0; i < 8; ++i) { f32x4 a[2], b[2], c[2], d[2]; pg8::unpack8(rw[i], a[0], a[1]); pg8::unpack8(rw[i + 1], b[0], b[1]); pg8::unpack8(rw[i + 2], c[0], c[1]); pg8::unpack8(rw[i + 3], d[0], d[1]);
        *(v4u*)(dst + (size_t)i * 1536) = pg8::pack8(bb[0] + w0[0] * a[0] + w1[0] * b[0] + w2[0] * c[0] + w3[0] * d[0], bb[1] + w0[1] * a[1] + w1[1] * b[1] + w2[1] * c[1] + w3[1] * d[1]); }
}
__device__ __forceinline__ void pool_witem(const bf16* UP, bf16* POOLED, int g, int tblk, int lane) {
    const int t0 = tblk + (lane >> 4) * 8, co = g * 16 + (lane & 15);
    const bf16* src = UP + (size_t)t0 * DPOOL + co * 8; bf16* dst = POOLED + (size_t)t0 * DPOOL + co * 8; const int tl = t0 & (SEQ - 1);
    if (g == 0) pool_item<2>(src, dst, tl); else if (g == 1) pool_item<4>(src, dst, tl); else if (g == 2) pool_item<8>(src, dst, tl); else pool_item<16>(src, dst, tl);
}

__global__ void __launch_bounds__(NTHR, 2) fwd_kernel(Args args) {
    extern __shared__ __attribute__((aligned(16))) unsigned char lds_raw[];
    LAS unsigned char* lds = (LAS unsigned char*)lds_raw;
    const int tid = threadIdx.x, lane = tid & 63, wave = __builtin_amdgcn_readfirstlane(tid >> 6);
    const int G = gridDim.x, bx = blockIdx.x;
    unsigned char* ws = args.ws;
    const int lo = args.ph_lo, hi = args.ph_hi;
#ifndef PHASE_MASK
#define PHASE_MASK 0x7ff
#endif
#define IN(k) (((PHASE_MASK >> (k)) & 1) && lo <= (k) && (k) < hi)
#ifndef REPEAT_MASK
#define REPEAT_MASK 0
#endif
#define REPS(k) (((REPEAT_MASK >> (k)) & 1) ? 2 : 1)
#ifndef PROBE_PHASE
#define PROBE_PHASE -1
#endif
#define PROBE_MULT 4
    unsigned long long tp0 = 0, tp1 = 0;
#define TSTART(k) do { if ((k) == PROBE_PHASE) tp0 = __builtin_amdgcn_s_memrealtime(); } while (0)
#define TEND(k) do { if ((k) == PROBE_PHASE) tp1 = __builtin_amdgcn_s_memrealtime(); } while (0)
#define GSYNC() xcd_barrier(bar)
#define SEAM(k) do { if (IN(k) && IN((k) + 1)) { GSYNC(); } } while (0)

    const float* x = args.in[I_X];
    bf16* WIN = (bf16*)(ws + WS_WIN); bf16* WFI = (bf16*)(ws + WS_WFI); bf16* WFO = (bf16*)(ws + WS_WFO); bf16* WCAT = (bf16*)(ws + WS_WCAT);
    bf16* WO = (bf16*)(ws + WS_WO); bf16* WGRP = (bf16*)(ws + WS_WGRP); bf16* WGATE = (bf16*)(ws + WS_WGATE);
    bf16* XN = (bf16*)(ws + WS_R1); bf16* X1B = XN;
    bf16* CAT = (bf16*)(ws + WS_CAT); bf16* V = CAT + 512; bf16* LA = V;
    bf16* UP = (bf16*)(ws + WS_R2);
    bf16* UR = (bf16*)(ws + WS_R3);
    bf16* UG = (bf16*)(ws + WS_R4);
    bf16* POOLED = (bf16*)(ws + WS_R7); bf16* BB = (bf16*)(ws + WS_R8);
    bf16* MIXB = (bf16*)(ws + WS_MIXB); bf16* ACT = (bf16*)(ws + WS_ACT);
    float* SSQ = (float*)(ws + WS_SSQ); float* CS = (float*)(ws + WS_CS); float* CH = (float*)(ws + WS_CH);
    bf16* G0 = (bf16*)args.out; bf16* G1 = G0 + (size_t)M * 1024;
    float* X1 = args.out;

#ifndef EXTRA_SYNCS
#define EXTRA_SYNCS 0
#endif
    if (PROBE_PHASE == 99) tp0 = __builtin_amdgcn_s_memrealtime();
    volatile LAS unsigned* MISC = (volatile LAS unsigned*)(lds + 131072 + 1024);
    if (tid < 32) MISC[tid] = 0u;
    __syncthreads();
    XcdBarrier bar = xcd_barrier_post((unsigned*)ws, MISC + 8);
    if (lo < 0) cg::this_grid().sync();
    for (int i = 0; i < EXTRA_SYNCS; ++i) GSYNC();
    TSTART(0);
    if (IN(0)) for (int rep = 0; rep < REPS(0); ++rep) { if (rep) GSYNC();
        LAS float* scr = (LAS float*)(lds + wave * 16384);
        const int gw = bx * NWAVES + wave, NGW = G * NWAVES;
        constexpr int I_IN = 16 * (DIN / 32), I_FI = 16 * (2 * DFF / 32), I_FO = (DFF / 64) * (D / 32), I_RO = 16 * 32, I_WO = 16 * 32, I_PO = 8 * 32;
        constexpr int NITEMS = I_IN + I_FI + I_FO + I_RO + I_WO + I_PO;
        for (int it = gw; it < NITEMS; it += NGW) {
            int r = it;
            if (r < I_IN) { const int nblk = DIN / 32, kb = r / nblk, nb = r % nblk, nd = 32 * nb; int ns = nd;
                if (nd >= 2560) { const int q = nd - 2560, pq = q >> 8, j0 = q & 255; ns = 2560 + (j0 < 128 ? 128 * pq + j0 : 1024 + 128 * pq + (j0 - 128)); }
                transpose_item(args.in[I_W_IN], DIN, D, WIN, 64 * kb, ns, nd, args.in[I_NORM_MIX], scr, lane); continue; } r -= I_IN;
            if (r < I_FI) { const int nblk = 2 * DFF / 32, kb = r / nblk, nb = r % nblk, nd = 32 * nb, pn = nd >> 8, j0 = nd & 255;
                const int ns = j0 < 128 ? 128 * pn + j0 : DFF + 128 * pn + (j0 - 128);
                transpose_item(args.in[I_W_FFN_IN], 2 * DFF, D, WFI, 64 * kb, ns, nd, args.in[I_NORM_FFN], scr, lane); continue; } r -= I_FI;
            if (r < I_FO) { if (G != 256) { const int nblk = D / 32, kb = r / nblk, nb = r % nblk; transpose_item(args.in[I_W_FFN_OUT], D, DFF, WFO, 64 * kb, 32 * nb, 32 * nb, nullptr, scr, lane); } continue; } r -= I_FO;
            if (G == 256 && r < I_RO + I_WO + I_PO) continue;
            if (r < I_RO) { const int nblk = D / 32, kb = r / nblk, nb = r % nblk; transpose_item(args.in[I_W_RNN_OUT], D, 1536, WCAT + 512, 64 * kb, 32 * nb, 32 * nb, nullptr, scr, lane); continue; } r -= I_RO;
            if (r < I_WO) { const int nblk = D / 32, kb = r / nblk, nb = r % nblk; transpose_item(args.in[I_W_O], D, D, WO, 64 * kb, 32 * nb, 32 * nb, nullptr, scr, lane); continue; } r -= I_WO;
            { const int nblk = D / 32, kb = r / nblk, nb = r % nblk; transpose_item(args.in[I_W_POOL_OUT], D, 1536, WCAT, 64 * kb, 32 * nb, 32 * nb, nullptr, scr, lane); }
        }
        {
            const int gt = bx * NTHR + tid, NT = G * NTHR;
            const float* wg = args.in[I_W_GRP];
            for (int e = gt; e < 512 * 32; e += NT) { const int n = e >> 5, kc = (e & 31) * 8, g = n >> 7, nn = n & 127; float v[8];
#pragma unroll
                for (int j = 0; j < 8; ++j) { const int kk = kc + j - (g & 1) * 128; v[j] = (kk >= 0 && kk < 128) ? wg[((size_t)g * 128 + kk) * 128 + nn] : 0.f; }
                v4u o; o.x = cvt_pk_bf16(v[0], v[1]); o.y = cvt_pk_bf16(v[2], v[3]); o.z = cvt_pk_bf16(v[4], v[5]); o.w = cvt_pk_bf16(v[6], v[7]);
                *(v4u*)(WGRP + (size_t)n * 256 + kc) = o; }
            const float* wa = args.in[I_W_RG_A]; const float* wx = args.in[I_W_RG_X];
            for (int e = gt; e < 2048 * 16; e += NT) { const int n = e >> 4, kc = (e & 15) * 8, h = n >> 8, j = n & 255; const float* src = j < 128 ? wa : wx; const int jj = j & 127; float v[8];
#pragma unroll
                for (int q = 0; q < 8; ++q) v[q] = src[((size_t)h * 128 + kc + q) * 128 + jj];
                v4u o; o.x = cvt_pk_bf16(v[0], v[1]); o.y = cvt_pk_bf16(v[2], v[3]); o.z = cvt_pk_bf16(v[4], v[5]); o.w = cvt_pk_bf16(v[6], v[7]);
                *(v4u*)(WGATE + (size_t)n * 128 + kc) = o; }
        }
        { const int gt = bx * NTHR + tid; if (gt < DRNN) { const float z = -args.in[I_LAMBDA][gt]; ((float*)(ws + WS_SP8))[gt] = -8.0f * (fmaxf(z, 0.f) + log1pf(expf(-fabsf(z)))); } }
        float* RSI = (float*)(ws + WS_RSI);
        for (int m = gw; m < M; m += 2 * NGW) {
            const int m1 = (m + NGW < M) ? m + NGW : m;
            const f32x4* xr0 = (const f32x4*)(x + (size_t)m * D) + lane; const f32x4* xr1 = (const f32x4*)(x + (size_t)m1 * D) + lane; f32x4 v0[4], v1[4]; float s0 = 0.f, s1 = 0.f;
#pragma unroll
            for (int j = 0; j < 4; ++j) { v0[j] = xr0[64 * j]; v1[j] = xr1[64 * j]; }
#pragma unroll
            for (int j = 0; j < 4; ++j) { s0 += (v0[j].x * v0[j].x + v0[j].y * v0[j].y) + (v0[j].z * v0[j].z + v0[j].w * v0[j].w); s1 += (v1[j].x * v1[j].x + v1[j].y * v1[j].y) + (v1[j].z * v1[j].z + v1[j].w * v1[j].w); }
            const float q0 = sqrtf(wave_sum(s0) * (1.f / D) + EPS), q1 = sqrtf(wave_sum(s1) * (1.f / D) + EPS), rs0 = 1.0f / q0, rs1 = 1.0f / q1;
            if (lane == 0) { RSI[m] = q0; RSI[m1] = q1; }
            v2u* o0 = (v2u*)(XN + (size_t)m * D) + lane; v2u* o1 = (v2u*)(XN + (size_t)m1 * D) + lane;
#pragma unroll
            for (int j = 0; j < 4; ++j) { const f32x4 y0 = v0[j] * rs0, y1 = v1[j] * rs1; v2u w0, w1; w0.x = cvt_pk_bf16(y0.x, y0.y); w0.y = cvt_pk_bf16(y0.z, y0.w); w1.x = cvt_pk_bf16(y1.x, y1.y); w1.y = cvt_pk_bf16(y1.z, y1.w); o0[64 * j] = w0; o1[64 * j] = w1; }
        }
        __syncthreads();
    }
    SEAM(0);
    TEND(0);

    TSTART(1);
    if (IN(1)) for (int rep = 0; rep < REPS(1); ++rep) { if (rep) GSYNC();
        pg8::Gemm g{XN, WIN, M, 4096, D, D, D, 0, 0}; pg8::StaticOrder S; S.init(M, 4096, G, bx);
        pg8::EpiProj E{UP, UR, UG, G0, G1, 0};
        pg8::gemm_phase<pg8::EpiProj, true>(lds, g, S, E);
    }
    SEAM(1);
    TEND(1);

    TSTART(2);
    if (IN(2) && G != 256) for (int rep = 0; rep < REPS(2); ++rep) { if (rep) GSYNC();
        { const int gw = bx * NWAVES + wave, NGW = G * NWAVES;
          for (int wi = gw; wi < (M / 32) * 4; wi += NGW) pool_witem(UP, POOLED, wi & 3, (wi >> 2) * 32, lane); }
        { const int gt = bx * NTHR + tid, NT = G * NTHR;
          for (int it = gt; it < (M / 8) * 128; it += NT) conv_item(UR, V, args.in[I_CONV_W], args.in[I_CONV_B], (it >> 7) * 8, it & 127); }
    }
    if (G != 256)     SEAM(2);
    TEND(2);

    TSTART(3);
    if (IN(3)) for (int rep = 0; rep < REPS(3); ++rep) { if (rep) GSYNC();
        const bool fusedp2 = (G == 256);
        if (fusedp2) {
            { pg8::StaticOrder Sg; Sg.init(M, 512, G, (bx + G / 2) % G); pg8::Unit u;
              if (Sg.next(0, u)) { for (int wi = wave; wi < 16; wi += NWAVES) pool_witem(UP, POOLED, 2 * u.pn + (wi & 1), u.pm * 256 + (wi >> 1) * 32, lane); } }
            asm volatile("s_waitcnt vmcnt(0)" ::: "memory"); __syncthreads();
        }
        {
          pg8::Gemm g{XN, WIN + (size_t)4096 * D, M, 512, D, D, D, 0, 0}; pg8::StaticOrder S; S.init(M, 512, G, bx);
          pg8::EpiProj E{UP, UR, UG, G0, G1, 16};
          pg8::gemm_phase<pg8::EpiProj, true>(lds, g, S, E); }
        { pg8::Gemm g{POOLED, WGRP, M, 512, 256, 512, 256, 0, 256}; pg8::StaticOrder S; S.init(M, 512, G, (bx + G / 2) % G);
          pg8::EpiGrp E{CAT, 1536, args.in[I_POOL_SCALE]};
          pg8::gemm_phase<pg8::EpiGrp, true>(lds, g, S, E); }
        { pg8::Gemm g{V, WGATE, M, 2048, 128, 1536, 128, 0, 128}; pg8::StaticOrder S; S.init(M, 2048, G, bx);
          if (fusedp2) { S.lin_base = bx * 2; S.lin_cnt = 2; }
          pg8::EpiGate E{V, LA, BB, args.in[I_B_RG_A], args.in[I_B_RG_X], (const float*)(ws + WS_SP8)};
          if (fusedp2) { E.vlds = lds; E.use_lds = true;
              for (int i = 0; i < 2; ++i) { pg8::Unit u; if (S.next(i, u)) pg8::gate_unit_fused<pg8::EpiGate>(lds, UR, args.in[I_CONV_W], args.in[I_CONV_B], WGATE, E, u.pm, u.pn, nullptr); } }
          else pg8::gemm_phase<pg8::EpiGate, true>(lds, g, S, E); }
        if (fusedp2 && bx >= 128) {
            LAS float* scr = (LAS float*)(lds + wave * 16384); constexpr int J_RO = 16 * 32, J_WO = 16 * 32, J_PO = 8 * 32;
            for (int it = (bx - 128) * NWAVES + wave; it < J_RO + J_WO + J_PO; it += 128 * NWAVES) { int r = it; const int nblk = D / 32;
                if (r < J_RO) { const int kb = r / nblk, nb = r % nblk; transpose_item(args.in[I_W_RNN_OUT], D, 1536, WCAT + 512, 64 * kb, 32 * nb, 32 * nb, nullptr, scr, lane); continue; } r -= J_RO;
                if (r < J_WO) { const int kb = r / nblk, nb = r % nblk; transpose_item(args.in[I_W_O], D, D, WO, 64 * kb, 32 * nb, 32 * nb, nullptr, scr, lane); continue; } r -= J_WO;
                { const int kb = r / nblk, nb = r % nblk; transpose_item(args.in[I_W_POOL_OUT], D, 1536, WCAT, 64 * kb, 32 * nb, 32 * nb, nullptr, scr, lane); } }
        }
    }
    SEAM(3);
    TEND(3);

    TSTART(4);
    TEND(4);

    TSTART(5);
    if (IN(5)) for (int rep = 0; rep < REPS(5); ++rep) { if (rep) GSYNC();
        LAS float* PAS = (LAS float*)lds; LAS float* PAH = PAS + 8 * 512; LAS float* PBS = PAH + 8 * 512; LAS float* PBH = PBS + 8 * 512;
        unsigned* flags = (unsigned*)ws + 8192;
        for (int bi = bx; bi < NB * SCAN_NC * 2; bi += G) { const int hh = bi & 1, c = (bi >> 1) % SCAN_NC, b = bi / (2 * SCAN_NC);
            const size_t off = ((size_t)b * SEQ + (size_t)c * SCAN_T + wave * 16) * DRNN + hh * 512 + lane * 8;
            v4u lwk[16], bwk[16];
            const size_t offL = ((size_t)b * SEQ + (size_t)c * SCAN_T + wave * 16) * 1536 + hh * 512 + lane * 8;
#pragma unroll
            for (int i = 0; i < 16; ++i) { lwk[i] = *(const v4u*)(LA + offL + (size_t)i * 1536); bwk[i] = *(const v4u*)(BB + off + (size_t)i * DRNN); }
            { f32x4 S[2] = {{0.f, 0.f, 0.f, 0.f}, {0.f, 0.f, 0.f, 0.f}}, H[2] = {{0.f, 0.f, 0.f, 0.f}, {0.f, 0.f, 0.f, 0.f}};
#pragma unroll
              for (int i = 0; i < 16; ++i) { f32x4 l[2], bq[2]; pg8::unpack8(lwk[i], l[0], l[1]); pg8::unpack8(bwk[i], bq[0], bq[1]);
#pragma unroll
                  for (int n = 0; n < 2; ++n)
#pragma unroll
                      for (int j = 0; j < 4; ++j) { H[n][j] = __expf(l[n][j]) * H[n][j] + bq[n][j]; S[n][j] += l[n][j]; } }
              *(LAS f32x4*)(PBS + wave * 512 + lane * 8) = S[0]; *(LAS f32x4*)(PBS + wave * 512 + lane * 8 + 4) = S[1];
              *(LAS f32x4*)(PBH + wave * 512 + lane * 8) = H[0]; *(LAS f32x4*)(PBH + wave * 512 + lane * 8 + 4) = H[1]; }
#pragma unroll
            for (int i = 0; i < 16; ++i) asm volatile("" : "+v"(lwk[i]), "+v"(bwk[i]));
            __syncthreads();
            { float h = 0.f, st = 0.f;
#pragma unroll
              for (int sb = 0; sb < 8; ++sb) { const float sv = PBS[sb * 512 + tid]; h = __expf(sv) * h + PBH[sb * 512 + tid]; st += sv; }
              const size_t co = ((size_t)b * SCAN_NC + c) * DRNN + hh * 512 + tid;
              __hip_atomic_store(CS + co, st, __ATOMIC_RELAXED, __HIP_MEMORY_SCOPE_AGENT); __hip_atomic_store(CH + co, h, __ATOMIC_RELAXED, __HIP_MEMORY_SCOPE_AGENT); }
            asm volatile("s_waitcnt vmcnt(0)" ::: "memory");
            __syncthreads();
            if (tid == 0) __hip_atomic_store(flags + ((b * 2 + hh) * SCAN_NC + c) * 16, 1u, __ATOMIC_RELAXED, __HIP_MEMORY_SCOPE_AGENT);
            { f32x4 S[2] = {{0.f, 0.f, 0.f, 0.f}, {0.f, 0.f, 0.f, 0.f}}, H[2] = {{0.f, 0.f, 0.f, 0.f}, {0.f, 0.f, 0.f, 0.f}};
              if (wave * 4 < c) {
                  for (int q = 0; q < 4; ++q) { const int cc = wave * 4 + q; if (cc < c) { unsigned* f = flags + ((b * 2 + hh) * SCAN_NC + cc) * 16; unsigned sp = 0;
                      while ((unsigned)__builtin_amdgcn_readfirstlane(__hip_atomic_load(f, __ATOMIC_RELAXED, __HIP_MEMORY_SCOPE_AGENT)) == 0u) { __builtin_amdgcn_s_sleep(1); if (++sp > (1u << 20)) break; } } }
                  __builtin_amdgcn_fence(__ATOMIC_ACQUIRE, "agent");
#pragma unroll
                  for (int q0 = 0; q0 < 4; q0 += 2) { f32x4 cs[2][2], ch[2][2];
#pragma unroll
                      for (int q = 0; q < 2; ++q) { const int cc = wave * 4 + q0 + q; const size_t co = ((size_t)b * SCAN_NC + (cc < c ? cc : 0)) * DRNN + hh * 512 + lane * 8;
                          cs[q][0] = *(const f32x4*)(CS + co); cs[q][1] = *(const f32x4*)(CS + co + 4); ch[q][0] = *(const f32x4*)(CH + co); ch[q][1] = *(const f32x4*)(CH + co + 4); }
#pragma unroll
                      for (int q = 0; q < 2; ++q) { if (wave * 4 + q0 + q < c) {
#pragma unroll
                          for (int n = 0; n < 2; ++n)
#pragma unroll
                              for (int j = 0; j < 4; ++j) { H[n][j] = __expf(cs[q][n][j]) * H[n][j] + ch[q][n][j]; S[n][j] += cs[q][n][j]; } } }
                      asm volatile("" ::: "memory"); }
              }
              *(LAS f32x4*)(PAS + wave * 512 + lane * 8) = S[0]; *(LAS f32x4*)(PAS + wave * 512 + lane * 8 + 4) = S[1];
              *(LAS f32x4*)(PAH + wave * 512 + lane * 8) = H[0]; *(LAS f32x4*)(PAH + wave * 512 + lane * 8 + 4) = H[1]; }
            __syncthreads();
            f32x4 h[2] = {{0.f, 0.f, 0.f, 0.f}, {0.f, 0.f, 0.f, 0.f}};
#pragma unroll
            for (int sb = 0; sb < 8; ++sb) {
#pragma unroll
                for (int n = 0; n < 2; ++n) { const f32x4 sv = *(const LAS f32x4*)(PAS + sb * 512 + lane * 8 + 4 * n), hv = *(const LAS f32x4*)(PAH + sb * 512 + lane * 8 + 4 * n);
#pragma unroll
                    for (int j = 0; j < 4; ++j) h[n][j] = __expf(sv[j]) * h[n][j] + hv[j]; } }
            for (int sb = 0; sb < wave; ++sb) {
#pragma unroll
                for (int n = 0; n < 2; ++n) { const f32x4 sv = *(const LAS f32x4*)(PBS + sb * 512 + lane * 8 + 4 * n), hv = *(const LAS f32x4*)(PBH + sb * 512 + lane * 8 + 4 * n);
#pragma unroll
                    for (int j = 0; j < 4; ++j) h[n][j] = __expf(sv[j]) * h[n][j] + hv[j]; } }
            const bf16* ugp = UG + off;
            bf16* hgp = CAT + ((size_t)b * SEQ + (size_t)c * SCAN_T + wave * 16) * 1536 + 512 + hh * 512 + lane * 8;
            v4u gwk[16];
#pragma unroll
            for (int i = 0; i < 16; ++i) gwk[i] = *(const v4u*)(ugp + (size_t)i * DRNN);
#pragma unroll
            for (int i0 = 0; i0 < 16; i0 += 8) { const v4u* gw8 = gwk + i0;
#pragma unroll
                for (int i = 0; i < 8; ++i) { f32x4 l[2], bq[2], gq[2], o[2]; pg8::unpack8(lwk[i0 + i], l[0], l[1]); pg8::unpack8(bwk[i0 + i], bq[0], bq[1]); pg8::unpack8(gw8[i], gq[0], gq[1]);
#pragma unroll
                    for (int n = 0; n < 2; ++n)
#pragma unroll
                        for (int j = 0; j < 4; ++j) { h[n][j] = __expf(l[n][j]) * h[n][j] + bq[n][j]; o[n][j] = h[n][j] * pg8::gelu_tanh_(gq[n][j]); }
                    *(v4u*)(hgp + (size_t)(i0 + i) * 1536) = pg8::pack8(o[0], o[1]); } }
            __syncthreads();
        }
    }
    SEAM(5);
    TEND(5);

    TSTART(6);
    if (IN(6)) for (int rep = 0; rep < REPS(6); ++rep) { if (rep) GSYNC();
        pg8::Gemm g{CAT, WCAT, M, D, 1536, 1536, 1536, 0, 0}; pg8::StaticOrder S; S.init(M, D, G, bx);
        pg8::EpiMix E{G0, G1, MIXB};
        pg8::gemm_phase<pg8::EpiMix, true, 8>(lds, g, S, E);
    }
    SEAM(6);
    TEND(6);

    TSTART(7);
    if (IN(7)) for (int rep = 0; rep < REPS(7); ++rep) { if (rep) GSYNC();
        pg8::Gemm g{MIXB, WO, M, D, D, D, D, 0, 0}; pg8::StaticOrder S; S.init(M, D, G, bx);
        pg8::EpiRes1 E{XN, (const float*)(ws + WS_RSI), X1B, SSQ};
        pg8::gemm_phase<pg8::EpiRes1, true>(lds, g, S, E);
    }
    SEAM(7);
    TEND(7);

    TSTART(8);
    if (IN(8)) for (int rep = 0; rep < REPS(8); ++rep) { if (rep) GSYNC();
        pg8::Gemm g{X1B, WFI, M, 2 * DFF, D, D, D, 0, 0}; pg8::StaticOrder S; S.init(M, 2 * DFF, G, bx);
        LAS float* RSL = (LAS float*)(lds + 133120);
        { const int r = tid & 255;
          for (int i = tid >> 8; i < 8; i += 2) { pg8::Unit u; if (!S.next(i, u)) break;
              const f32x4* sp = (const f32x4*)(SSQ + (size_t)(u.pm * 256 + r) * 16); const f32x4 st = (sp[0] + sp[1]) + (sp[2] + sp[3]);
              RSL[i * 256 + r] = __builtin_amdgcn_rsqf(((st[0] + st[1]) + (st[2] + st[3])) * (1.0f / 1024.0f) + 1e-6f); }
          __syncthreads(); }
        pg8::EpiSwiglu E{RSL, ACT};
        pg8::gemm_phase<pg8::EpiSwiglu, true>(lds, g, S, E);
        if (G == 256 && bx >= 128) {
            LAS float* scr = (LAS float*)(lds + wave * 16384); constexpr int I_FO = (DFF / 64) * (D / 32);
            for (int r = (bx - 128) * NWAVES + wave; r < I_FO; r += 128 * NWAVES) { const int nblk = D / 32, kb = r / nblk, nb = r % nblk;
                transpose_item(args.in[I_W_FFN_OUT], D, DFF, WFO, 64 * kb, 32 * nb, 32 * nb, nullptr, scr, lane); }
        }
    }
    SEAM(8);
    TEND(8);

    TSTART(9);
    if (IN(9)) for (int rep = 0; rep < REPS(9); ++rep) { if (rep) GSYNC();
        pg8::Gemm g{ACT, WFO, M, D, DFF, DFF, DFF, 0, 0}; pg8::StaticOrder S; S.init(M, D, G, bx);
        if (G == 256) { pg8::EpiFinal E{X1B, X1, (float*)(ws + WS_SSQ2), (unsigned*)ws + 4096, args.in[I_NORM_FINAL]};
            pg8::gemm_phase<pg8::EpiFinal, true>(lds, g, S, E); }
        else { pg8::EpiRes2 E{X1B, X1};
            pg8::gemm_phase<pg8::EpiRes2, true>(lds, g, S, E); }
    }
    if (G != 256) SEAM(9);
    TEND(9);

    TSTART(10);
    if (IN(10) && G != 256) for (int rep = 0; rep < REPS(10); ++rep) { if (rep) GSYNC();
        const int gw = bx * NWAVES + wave, NGW = G * NWAVES;
        const float* gf = args.in[I_NORM_FINAL]; f32x4 gv[4];
#pragma unroll
        for (int j = 0; j < 4; ++j) gv[j] = ((const f32x4*)gf)[lane + 64 * j];
        for (int m = gw; m < M; m += NGW) {
            f32x4* xr = (f32x4*)(X1 + (size_t)m * D) + lane; f32x4 v[4]; float s = 0.f;
#pragma unroll
            for (int j = 0; j < 4; ++j) { v[j] = xr[64 * j]; s += (v[j].x * v[j].x + v[j].y * v[j].y) + (v[j].z * v[j].z + v[j].w * v[j].w); }
            const float rs = 1.0f / sqrtf(wave_sum(s) * (1.f / D) + EPS);
#pragma unroll
            for (int j = 0; j < 4; ++j) xr[64 * j] = v[j] * rs * gv[j];
        }
    }
    if (PROBE_PHASE == 10 || PROBE_PHASE == 99) tp1 = __builtin_amdgcn_s_memrealtime();
    if (PROBE_PHASE >= 0 && bx == 0 && tid == 0) { const unsigned long long dt = (tp1 - tp0) * PROBE_MULT, te = __builtin_amdgcn_s_memrealtime(); while (__builtin_amdgcn_s_memrealtime() - te < dt) __builtin_amdgcn_s_sleep(8); }
#undef IN
#undef SEAM
}

extern "C" void kernel_launch(void* const* d_in, const int* in_sizes, int n_in, void* d_out, int out_size, void* d_ws, size_t ws_size, hipStream_t stream) {
    static int grid = 0;
    if (grid == 0) {
        if (n_in != 19 || out_size != M * D || ws_size < WS_END) { fprintf(stderr, "kernel_launch: unexpected shapes (n_in %d out %d ws %zu)\n", n_in, out_size, ws_size); grid = -1; return; }
        int dev = 0, cus = 0, per_cu = 0;
        hipGetDevice(&dev);
        hipDeviceGetAttribute(&cus, hipDeviceAttributeMultiprocessorCount, dev);
        if (hipFuncSetAttribute((const void*)fwd_kernel, hipFuncAttributeMaxDynamicSharedMemorySize, LDS_BYTES) != hipSuccess) { fprintf(stderr, "kernel_launch: hipFuncSetAttribute failed\n"); grid = -1; return; }
        if (hipOccupancyMaxActiveBlocksPerMultiprocessor(&per_cu, (const void*)fwd_kernel, NTHR, LDS_BYTES) != hipSuccess || per_cu < 1) { fprintf(stderr, "kernel_launch: occupancy query says %d\n", per_cu); per_cu = 1; }
        (void)hipGetLastError();
        grid = cus * 1;
        fprintf(stderr, "kernel_launch: grid %d (cus %d, per_cu %d)\n", grid, cus, per_cu);
    }
    if (grid < 0) return;
    if (hipMemsetAsync(d_ws, 0, 49152, stream) != hipSuccess) { fprintf(stderr, "kernel_launch: memset failed\n"); return; }
    Args a{};
    for (int i = 0; i < 19; ++i) a.in[i] = (const float*)d_in[i];
    a.out = (float*)d_out; a.ws = (unsigned char*)d_ws;
#if MK_PER_PHASE
    for (int p = 0; p < NPH; ++p) { a.ph_lo = p; a.ph_hi = p + 1; hipLaunchKernelGGL(fwd_kernel, dim3(grid), dim3(NTHR), LDS_BYTES, stream, a); }
#else
    a.ph_lo = 0; a.ph_hi = NPH;
    void* kargs[] = {&a};
    hipError_t e = hipLaunchCooperativeKernel((const void*)fwd_kernel, dim3(grid), dim3(NTHR), kargs, LDS_BYTES, stream);
    if (e != hipSuccess) fprintf(stderr, "cooperative launch failed: %s (grid %d)\n", hipGetErrorString(e), grid);
#endif
}
```

```cpp
#include <hip/hip_runtime.h>
#include <hip/hip_cooperative_groups.h>
#include <cstdio>
#include <cstdint>
namespace cg = cooperative_groups;

#ifndef FG_VLDS
#define FG_VLDS 1
#endif
#ifndef MK_PER_PHASE
#define MK_PER_PHASE 0
#endif

namespace pg8 {
#define PG8_LAS __attribute__((address_space(3)))
typedef unsigned short bf16_t;
typedef short bf16x8 __attribute__((ext_vector_type(8)));
typedef float f32x4 __attribute__((ext_vector_type(4)));
typedef float f32x2 __attribute__((ext_vector_type(2)));
typedef unsigned u32x4 __attribute__((ext_vector_type(4)));
typedef unsigned u32x2 __attribute__((ext_vector_type(2)));
constexpr int BM = 256, BK = 64, HALF = 128, HTB = HALF * BK * 2, STAGE_BYTES = 8 * HTB, NXCD = 8, WGM = 8;

__host__ __device__ __forceinline__ int lds_byte(int r, int c) { const int st = (r >> 4) * 2 + (c >> 5), rr = r & 15, cc = c & 31, ob = rr * 64 + cc * 2; return st * 1024 + (ob ^ (((ob >> 9) & 1) << 5)); }
__host__ __device__ __forceinline__ void stage_rc(int b, int& R, int& C) { const int st = b / 1024, sb = b % 1024, swz = sb ^ (((sb >> 9) & 1) << 5); R = (st >> 1) * 16 + swz / 64; C = (st & 1) * 32 + (swz % 64) / 2; }
__host__ __device__ __forceinline__ int perm32(int rho) { const int n = rho >> 4, i = rho & 15; return 8 * (i >> 2) + 4 * n + (i & 3); }

struct Unit { int pm, pn, rh, idx; };
struct Gemm { const bf16_t* A; const bf16_t* Bt; int M, N, K, lda, ldb, ash, amul; };

struct StaticOrder {
    int nM, nN, nwg, G, c, limit, lin_base, lin_cnt;
    __host__ __device__ __forceinline__ void init(int M, int N, int G_, int c_) { nM = M / BM; nN = N / BM; nwg = nM * nN; G = G_; c = c_; limit = nwg; lin_base = 0; lin_cnt = -1; }
    __host__ __device__ __forceinline__ void map(int L, Unit& u) const {
        int wgid = L; { const int q = nwg / NXCD, r = nwg % NXCD, xcd = wgid % NXCD, off = wgid / NXCD; wgid = (xcd < r ? xcd * (q + 1) : r * (q + 1) + (xcd - r) * q) + off; }
        const int nig = WGM * nN, gid = wgid / nig, fm = gid * WGM, gsz = (nM - fm) < WGM ? (nM - fm) : WGM;
        u.pm = fm + ((wgid % nig) % gsz); u.pn = (wgid % nig) / gsz; u.rh = 0;
    }
    __host__ __device__ __forceinline__ bool next(int i, Unit& u) const {
        u.idx = i;
        if (lin_cnt >= 0) { if (i >= lin_cnt) return false; map(lin_base + i, u); return true; }
        const long L = (long)i * G + c; if (L >= limit) return false;
        map((int)L, u); return true;
    }
};

__device__ __forceinline__ unsigned cvt_pk_bf16(float lo, float hi) { unsigned r; asm volatile("v_cvt_pk_bf16_f32 %0, %1, %2" : "=v"(r) : "v"(lo), "v"(hi)); return r; }
__device__ __forceinline__ float bf_lo(unsigned w) { return __uint_as_float(w << 16); }
__device__ __forceinline__ float bf_hi(unsigned w) { return __uint_as_float(w & 0xffff0000u); }
__device__ __forceinline__ float sigmoidf_(float x) { return __builtin_amdgcn_rcpf(1.0f + __expf(-x)); }
__device__ __forceinline__ float gelu_tanh_(float x) { const float z = 1.5957691216057308f * (x + 0.044715f * x * x * x); return x * sigmoidf_(z); }
__device__ __forceinline__ u32x4 pack8(const f32x4 a, const f32x4 b) { u32x4 w; w.x = cvt_pk_bf16(a[0], a[1]); w.y = cvt_pk_bf16(a[2], a[3]); w.z = cvt_pk_bf16(b[0], b[1]); w.w = cvt_pk_bf16(b[2], b[3]); return w; }
__device__ __forceinline__ void unpack8(const u32x4 w, f32x4& a, f32x4& b) { a = (f32x4){bf_lo(w.x), bf_hi(w.x), bf_lo(w.y), bf_hi(w.y)}; b = (f32x4){bf_lo(w.z), bf_hi(w.z), bf_lo(w.w), bf_hi(w.w)}; }

#define EPI_ROWS_BEGIN _Pragma("unroll") for (int ai = 0; ai < NAI; ++ai) _Pragma("unroll") for (int m = 0; m < 4; ++m) { const int row = u.pm * BM + u.rh + ai * HALF + wr * 64 + m * 16 + fr;
#define EPI_ROWS_END }

struct EpiProj {
    bf16_t *UP, *UR, *UG, *RB, *G1; int pn_off;
    template <int NAI> __device__ __forceinline__ void run(const f32x4 (&acc)[2][2][4][2], const Unit& u, int wr, int wc, int fr, int fq) const {
        const int pn = u.pn + pn_off;
        if (pn < 10) {
            bf16_t* base; int ldc, colt;
            if (pn < 2) { base = UP; ldc = 512; colt = pn * 256; }
            else if (pn < 6) { base = UR; ldc = 1024; colt = (pn - 2) * 256; }
            else { base = UG; ldc = 1024; colt = (pn - 6) * 256; }
            const int col0 = colt + wc * 32 + 8 * fq;
            EPI_ROWS_BEGIN
                bf16_t* rowp = base + (unsigned)((unsigned)row * (unsigned)ldc + (unsigned)col0);
#pragma unroll
                for (int bj = 0; bj < 2; ++bj) *(u32x4*)(rowp + bj * HALF) = pack8(acc[ai][bj][m][0], acc[ai][bj][m][1]);
            EPI_ROWS_END
        } else {
            const int ch0 = (pn - 10) * 128 + wc * 32 + 8 * fq;
            EPI_ROWS_BEGIN
                const unsigned off = (unsigned)row * 1024u + (unsigned)ch0; f32x4 rr[2], gg[2];
#pragma unroll
                for (int n = 0; n < 2; ++n)
#pragma unroll
                    for (int j = 0; j < 4; ++j) { const float d0 = 1.0f + fminf(__expf(-acc[ai][0][m][n][j]), 1e18f), d1 = 1.0f + fminf(__expf(-acc[ai][1][m][n][j]), 1e18f);
                        const float q = __builtin_amdgcn_rcpf(d0 * d1); gg[n][j] = d0 * q; rr[n][j] = d1 * d1 * q; }
                *(u32x4*)(RB + off) = pack8(rr[0], rr[1]); *(u32x4*)(G1 + off) = pack8(gg[0], gg[1]);
            EPI_ROWS_END
        }
    }
};
struct EpiGrp {
    bf16_t* O; int ldc; const float* scale;
    template <int NAI> __device__ __forceinline__ void run(const f32x4 (&acc)[2][2][4][2], const Unit& u, int wr, int wc, int fr, int fq) const {
        const int col0 = u.pn * BM + wc * 32 + 8 * fq;
        f32x4 sc[2][2];
#pragma unroll
        for (int bj = 0; bj < 2; ++bj)
#pragma unroll
            for (int n = 0; n < 2; ++n) sc[bj][n] = *(const f32x4*)(scale + col0 + bj * HALF + 4 * n);
        EPI_ROWS_BEGIN
            bf16_t* rowp = O + (unsigned)((unsigned)row * (unsigned)ldc + (unsigned)col0);
#pragma unroll
            for (int bj = 0; bj < 2; ++bj) *(u32x4*)(rowp + bj * HALF) = pack8(acc[ai][bj][m][0] * sc[bj][0], acc[ai][bj][m][1] * sc[bj][1]);
        EPI_ROWS_END
    }
};
struct EpiGate {
    const bf16_t* V; bf16_t *LA, *BB; const float *b_a, *b_x, *sp8;
    const PG8_LAS unsigned char* vlds = nullptr; bool use_lds = false;
    template <int NAI, bool EXACT> __device__ __forceinline__ void rows(const f32x4 (&acc)[2][2][4][2], const Unit& u, int wr, int fr, int ch0, const f32x4 (&ba)[2], const f32x4 (&bx)[2], const f32x4 (&sp)[2]) const {
        u32x4 vwk[2][4];
        EPI_ROWS_BEGIN
            if (use_lds) vwk[ai][m] = *(const PG8_LAS u32x4*)(vlds + (((ch0 >> 6) & 1) * 2 + ai) * HTB + lds_byte((row & 127), (ch0 & 63)));
            else vwk[ai][m] = *(const u32x4*)(V + ((unsigned)row * 1536u + (unsigned)ch0));
        EPI_ROWS_END
        EPI_ROWS_BEGIN
            const unsigned off = (unsigned)row * 1024u + (unsigned)ch0;
            f32x4 vv[2]; unpack8(vwk[ai][m], vv[0], vv[1]);
            f32x4 la[2], bb[2];
#pragma unroll
            for (int n = 0; n < 2; ++n)
#pragma unroll
                for (int j = 0; j < 4; ++j) {
                    const float r = sigmoidf_(acc[ai][0][m][n][j] + ba[n][j]), ig = sigmoidf_(acc[ai][1][m][n][j] + bx[n][j]);
                    const float l = sp[n][j] * r, x2 = 2.0f * l;
                    const float poly = x2 * (1.0f + 0.5f * x2 * (1.0f + 0.33333334f * x2 * (1.0f + 0.25f * x2 * (1.0f + 0.2f * x2 * (1.0f + 0.16666667f * x2)))));
                    const float em1 = EXACT ? ((x2 > -0.25f) ? poly : (__expf(x2) - 1.0f)) : poly;
                    la[n][j] = l; bb[n][j] = __builtin_amdgcn_sqrtf(fmaxf(-em1, 0.f)) * ig * vv[n][j]; }
            *(u32x4*)(LA + ((unsigned)row * 1536u + (unsigned)ch0)) = pack8(la[0], la[1]); *(u32x4*)(BB + off) = pack8(bb[0], bb[1]);
        EPI_ROWS_END
    }
    template <int NAI> __device__ __forceinline__ void run(const f32x4 (&acc)[2][2][4][2], const Unit& u, int wr, int wc, int fr, int fq) const {
        const int ch0 = u.pn * 128 + wc * 32 + 8 * fq;
        f32x4 ba[2], bx[2], sp[2]; bool big = false;
#pragma unroll
        for (int n = 0; n < 2; ++n) { ba[n] = *(const f32x4*)(b_a + ch0 + 4 * n); bx[n] = *(const f32x4*)(b_x + ch0 + 4 * n); sp[n] = *(const f32x4*)(sp8 + ch0 + 4 * n);
#pragma unroll
            for (int j = 0; j < 4; ++j) big = big || !(sp[n][j] >= -0.125f); }
        if (__builtin_amdgcn_ballot_w64(big) != 0ull) rows<NAI, true>(acc, u, wr, fr, ch0, ba, bx, sp);
        else rows<NAI, false>(acc, u, wr, fr, ch0, ba, bx, sp);
    }
};
struct EpiMix {
    const bf16_t *RB, *G1; bf16_t* MIXB;
    __device__ __forceinline__ void mid(f32x4 (&acc)[2][2][4][2], const Unit& u0, int wr, int wc, int fr, int fq) const {
        constexpr int NAI = 2; Unit u = u0; asm volatile("" : "+s"(u.pm), "+s"(u.pn));
        const int col0 = u.pn * BM + wc * 32 + 8 * fq;
        u32x4 rw[2][4][2];
        EPI_ROWS_BEGIN
            const unsigned off = (unsigned)row * 1024u + (unsigned)col0;
#pragma unroll
            for (int bj = 0; bj < 2; ++bj) rw[ai][m][bj] = *(const u32x4*)(RB + off + bj * HALF);
        EPI_ROWS_END
        EPI_ROWS_BEGIN
#pragma unroll
            for (int bj = 0; bj < 2; ++bj) { f32x4 r[2]; unpack8(rw[ai][m][bj], r[0], r[1]); acc[ai][bj][m][0] *= r[0]; acc[ai][bj][m][1] *= r[1]; }
            (void)row;
        EPI_ROWS_END
    }
    template <int NAI> __device__ __forceinline__ void run(const f32x4 (&acc)[2][2][4][2], const Unit& u, int wr, int wc, int fr, int fq) const {
        const int col0 = u.pn * BM + wc * 32 + 8 * fq;
        u32x4 gw[2][4][2];
        EPI_ROWS_BEGIN
            const unsigned off = (unsigned)row * 1024u + (unsigned)col0;
#pragma unroll
            for (int bj = 0; bj < 2; ++bj) gw[ai][m][bj] = *(const u32x4*)(G1 + off + bj * HALF);
        EPI_ROWS_END
        EPI_ROWS_BEGIN
            const unsigned off = (unsigned)row * 1024u + (unsigned)col0;
#pragma unroll
            for (int bj = 0; bj < 2; ++bj) { f32x4 g[2]; unpack8(gw[ai][m][bj], g[0], g[1]);
                *(u32x4*)(MIXB + off + bj * HALF) = pack8(g[0] * acc[ai][bj][m][0], g[1] * acc[ai][bj][m][1]); }
        EPI_ROWS_END
    }
};
struct EpiRes1 {
    const bf16_t* XNB; const float* RSI; bf16_t* X1B; float* SSQ;
    template <int NAI> __device__ __forceinline__ void run(const f32x4 (&acc)[2][2][4][2], const Unit& u, int wr, int wc, int fr, int fq) const {
        const int col0 = u.pn * BM + wc * 32 + 8 * fq;
#pragma unroll
        for (int ai = 0; ai < NAI; ++ai) {
            u32x4 xw[4][2]; float qi[4];
#pragma unroll
            for (int m = 0; m < 4; ++m) { const int row = u.pm * BM + u.rh + ai * HALF + wr * 64 + m * 16 + fr; const unsigned off = (unsigned)row * 1024u + (unsigned)col0; qi[m] = RSI[row];
#pragma unroll
                for (int bj = 0; bj < 2; ++bj) xw[m][bj] = *(const u32x4*)(XNB + off + bj * HALF); }
            asm volatile("s_waitcnt vmcnt(0)" ::: "memory");
#pragma unroll
            for (int m = 0; m < 4; ++m) { const int row = u.pm * BM + u.rh + ai * HALF + wr * 64 + m * 16 + fr; const unsigned off = (unsigned)row * 1024u + (unsigned)col0; float ss = 0.f;
#pragma unroll
                for (int bj = 0; bj < 2; ++bj) { f32x4 xa, xb; unpack8(xw[m][bj], xa, xb);
                    const f32x4 a = xa * qi[m] + acc[ai][bj][m][0], b = xb * qi[m] + acc[ai][bj][m][1];
                    *(u32x4*)(X1B + off + bj * HALF) = pack8(a, b);
                    ss += (a[0] * a[0] + a[1] * a[1]) + (a[2] * a[2] + a[3] * a[3]) + (b[0] * b[0] + b[1] * b[1]) + (b[2] * b[2] + b[3] * b[3]); }
                ss += __shfl_xor(ss, 16); ss += __shfl_xor(ss, 32);
                if (fq == 0) SSQ[(unsigned)row * 16u + (unsigned)(u.pn * 4 + wc)] = ss; }
        }
    }
};
struct EpiSwiglu {
    const PG8_LAS float* RSL; bf16_t* ACT;
    template <int NAI> __device__ __forceinline__ void run(const f32x4 (&acc)[2][2][4][2], const Unit& u, int wr, int wc, int fr, int fq) const {
        const int col0 = u.pn * 128 + wc * 32 + 8 * fq;
        const PG8_LAS float* rt = RSL + u.idx * 256 + wr * 64 + fr;
        EPI_ROWS_BEGIN
            const float rs = rt[ai * HALF + m * 16];
            f32x4 o[2];
#pragma unroll
            for (int n = 0; n < 2; ++n)
#pragma unroll
                for (int j = 0; j < 4; ++j) { const float g = acc[ai][0][m][n][j] * rs, up = acc[ai][1][m][n][j] * rs; o[n][j] = g * sigmoidf_(g) * up; }
            __builtin_nontemporal_store(pack8(o[0], o[1]), (u32x4*)(ACT + (unsigned)((unsigned)row * 2816u + (unsigned)col0)));
        EPI_ROWS_END
    }
};
struct EpiRes2 {
    const bf16_t* X1B; float* OUT;
    template <int NAI> __device__ __forceinline__ void run(const f32x4 (&acc)[2][2][4][2], const Unit& u, int wr, int wc, int fr, int fq) const {
        const int col0 = u.pn * BM + wc * 32 + 8 * fq;
        EPI_ROWS_BEGIN
            const unsigned off = (unsigned)row * 1024u + (unsigned)col0;
#pragma unroll
            for (int bj = 0; bj < 2; ++bj) { f32x4 xa, xb; unpack8(*(const u32x4*)(X1B + off + bj * HALF), xa, xb);
                *(f32x4*)(OUT + off + bj * HALF) = xa + acc[ai][bj][m][0]; *(f32x4*)(OUT + off + bj * HALF + 4) = xb + acc[ai][bj][m][1]; }
        EPI_ROWS_END
    }
};

struct EpiFinal {
    const bf16_t* X1B; float* OUT; float* SSQ2; unsigned* cnt; const float* gfin;
    template <int NAI> __device__ __forceinline__ void run(f32x4 (&acc)[2][2][4][2], const Unit& u, int wr, int wc, int fr, int fq) const {
        const int col0 = u.pn * BM + wc * 32 + 8 * fq;
        { u32x4 xw[2][4][2];
          EPI_ROWS_BEGIN
              const unsigned off = (unsigned)row * 1024u + (unsigned)col0;
#pragma unroll
              for (int bj = 0; bj < 2; ++bj) xw[ai][m][bj] = *(const u32x4*)(X1B + off + bj * HALF);
          EPI_ROWS_END
          EPI_ROWS_BEGIN
              float ss = 0.f;
#pragma unroll
              for (int bj = 0; bj < 2; ++bj) { f32x4 xa, xb; unpack8(xw[ai][m][bj], xa, xb);
                  const f32x4 a = xa + acc[ai][bj][m][0], b = xb + acc[ai][bj][m][1]; acc[ai][bj][m][0] = a; acc[ai][bj][m][1] = b;
                  ss += (a[0] * a[0] + a[1] * a[1]) + (a[2] * a[2] + a[3] * a[3]) + (b[0] * b[0] + b[1] * b[1]) + (b[2] * b[2] + b[3] * b[3]); }
              ss += __shfl_xor(ss, 16); ss += __shfl_xor(ss, 32);
              if (fq == 0) __hip_atomic_store(SSQ2 + (unsigned)row * 16u + (unsigned)(u.pn * 4 + wc), ss, __ATOMIC_RELAXED, __HIP_MEMORY_SCOPE_AGENT);
          EPI_ROWS_END }
        asm volatile("s_waitcnt vmcnt(0)" ::: "memory");
        unsigned* c = cnt + 64 * u.pm;
        if ((threadIdx.x & 63) == 0) __hip_atomic_fetch_add(c, 1u, __ATOMIC_RELAXED, __HIP_MEMORY_SCOPE_AGENT);
        f32x4 gv[2][2];
#pragma unroll
        for (int bj = 0; bj < 2; ++bj)
#pragma unroll
            for (int n = 0; n < 2; ++n) gv[bj][n] = *(const f32x4*)(gfin + col0 + bj * HALF + 4 * n);
        { unsigned sp = 0;
          while ((unsigned)__builtin_amdgcn_readfirstlane(__hip_atomic_load(c, __ATOMIC_RELAXED, __HIP_MEMORY_SCOPE_AGENT)) < 32u) { __builtin_amdgcn_s_sleep(2); if (++sp > (1u << 20)) break; } }
        __builtin_amdgcn_fence(__ATOMIC_ACQUIRE, "agent");
        unsigned long long w0[2][4], w1[2][4];
        EPI_ROWS_BEGIN
            const unsigned long long* sl = (const unsigned long long*)(SSQ2 + (unsigned)row * 16u + (unsigned)(4 * fq));
            w0[ai][m] = __hip_atomic_load(sl, __ATOMIC_RELAXED, __HIP_MEMORY_SCOPE_AGENT); w1[ai][m] = __hip_atomic_load(sl + 1, __ATOMIC_RELAXED, __HIP_MEMORY_SCOPE_AGENT);
        EPI_ROWS_END
        EPI_ROWS_BEGIN
            const unsigned off = (unsigned)row * 1024u + (unsigned)col0;
            float sq = (__uint_as_float((unsigned)w0[ai][m]) + __uint_as_float((unsigned)(w0[ai][m] >> 32))) + (__uint_as_float((unsigned)w1[ai][m]) + __uint_as_float((unsigned)(w1[ai][m] >> 32)));
            sq += __shfl_xor(sq, 16); sq += __shfl_xor(sq, 32);
            const float rs = 1.0f / sqrtf(sq * (1.0f / 1024.0f) + 1e-6f);
#pragma unroll
            for (int bj = 0; bj < 2; ++bj) { *(f32x4*)(OUT + off + bj * HALF) = acc[ai][bj][m][0] * rs * gv[bj][0]; *(f32x4*)(OUT + off + bj * HALF + 4) = acc[ai][bj][m][1] * rs * gv[bj][1]; }
        EPI_ROWS_END
    }
};

template <class Epi, bool ALIGN_EPI, int MID_T = -1>
__device__ __forceinline__ void gemm_phase(PG8_LAS unsigned char* lds, const Gemm g, const StaticOrder& S, const Epi& E) {
    const int tid = threadIdx.x, wid = __builtin_amdgcn_readfirstlane(tid >> 6), lane = tid & 63, wr = wid >> 2, wc = wid & 3, fr = lane & 15, fq = lane >> 4;
    int nt = g.K / BK; asm volatile("" : "+s"(nt));
    unsigned voffA[2], voffB[2];
#pragma unroll
    for (int i = 0; i < 2; ++i) { int R, C; stage_rc(tid * 16 + i * 8192, R, C); const int Rb = (R & ~31) + perm32(R & 31);
        voffA[i] = (unsigned)(R * g.lda + C) * 2u; voffB[i] = (unsigned)(Rb * g.ldb + C) * 2u; }
    const size_t kstep = (size_t)(BK * 2);
    const size_t hstepA = (size_t)HALF * g.lda * 2, hstepB = (size_t)HALF * g.ldb * 2;
    const size_t tstepA = 2 * hstepA, tstepB = 2 * hstepB;
    const unsigned ldsw = (unsigned)wid * 1024u;
    const int aoff = lds_byte(wr * 64 + fr, fq * 8), boff = lds_byte(wc * 32 + fr, fq * 8);
#define PG8_SA(b, h) (((b) * 2 + (h)) * HTB)
#define PG8_SB(b, h) ((4 + (b) * 2 + (h)) * HTB)
#define PG8_STAGE(bufoff, gbase, voff) do { _Pragma("unroll") for (int _i = 0; _i < 2; ++_i) \
        __builtin_amdgcn_global_load_lds((const unsigned*)((const char*)(gbase) + (voff)[_i]), (PG8_LAS unsigned*)(lds + (bufoff) + ldsw + _i * 8192), 16, 0, 0); } while (0)
#define PG8_LDA(dst, b, h) do { _Pragma("unroll") for (int m = 0; m < 4; ++m) _Pragma("unroll") for (int k = 0; k < 2; ++k) dst[m][k] = *(const PG8_LAS bf16x8*)(lds + PG8_SA(b, h) + aoff + m * 2048 + k * 1024); } while (0)
#define PG8_LDB(dst, b, h) do { _Pragma("unroll") for (int n = 0; n < 2; ++n) _Pragma("unroll") for (int k = 0; k < 2; ++k) dst[n][k] = *(const PG8_LAS bf16x8*)(lds + PG8_SB(b, h) + boff + n * 2048 + k * 1024); } while (0)
#define PG8_MMA(ai, bj, At, Bt) do { __builtin_amdgcn_s_setprio(1); _Pragma("unroll") for (int m = 0; m < 4; ++m) _Pragma("unroll") for (int n = 0; n < 2; ++n) _Pragma("unroll") for (int k = 0; k < 2; ++k) \
        acc[ai][bj][m][n] = __builtin_amdgcn_mfma_f32_16x16x32_bf16(Bt[n][k], At[m][k], acc[ai][bj][m][n], 0, 0, 0); __builtin_amdgcn_s_setprio(0); } while (0)
#define PG8_WAIT_V(n) asm volatile("s_waitcnt vmcnt(" #n ")" ::: "memory")
#define PG8_WAIT_L(n) asm volatile("s_waitcnt lgkmcnt(" #n ")" ::: "memory")
#define PG8_BAR __builtin_amdgcn_s_barrier()
#define PG8_SCHED __builtin_amdgcn_sched_barrier(0)
    Unit cur, nxt; int ui = 0;
    if (!S.next(0, cur)) return;
    f32x4 acc[2][2][4][2];
#pragma unroll
    for (int a = 0; a < 2; ++a)
#pragma unroll
        for (int b = 0; b < 2; ++b)
#pragma unroll
            for (int m = 0; m < 4; ++m)
#pragma unroll
                for (int n = 0; n < 2; ++n) acc[a][b][m][n] = (f32x4){0.f, 0.f, 0.f, 0.f};
    bf16x8 At[4][2], B0[2][2], B1[2][2];
    const char* cA = (const char*)g.A + (size_t)cur.pm * tstepA + (size_t)((cur.pn >> g.ash) * g.amul) * 2; const char* cB = (const char*)g.Bt + (size_t)cur.pn * tstepB;
    PG8_STAGE(PG8_SB(0, 0), cB, voffB); PG8_STAGE(PG8_SB(0, 1), cB + hstepB, voffB); PG8_STAGE(PG8_SA(0, 0), cA, voffA); PG8_STAGE(PG8_SA(0, 1), cA + hstepA, voffA);
    if (wr == 1) PG8_BAR;
    PG8_WAIT_V(2); PG8_BAR;
    PG8_STAGE(PG8_SB(1, 0), cB + kstep, voffB); PG8_STAGE(PG8_SA(1, 0), cA + kstep, voffA); PG8_STAGE(PG8_SB(1, 1), cB + hstepB + kstep, voffB);
    PG8_WAIT_V(6); PG8_BAR;
    for (;;) {
        const bool has_next = S.next(ui + 1, nxt);
        const char* nA = has_next ? (const char*)g.A + (size_t)nxt.pm * tstepA + (size_t)((nxt.pn >> g.ash) * g.amul) * 2 : cA; const char* nB = has_next ? (const char*)g.Bt + (size_t)nxt.pn * tstepB : cB;
        for (int t = 0; t < nt; t += 2) {
            const bool last = (t == nt - 2);
            if constexpr (MID_T >= 0) { if (t == MID_T) E.mid(acc, cur, wr, wc, fr, fq); }
            const char* a1 = cA + (size_t)(t + 1) * kstep;
            const char* a2 = last ? nA : cA + (size_t)(t + 2) * kstep; const char* b2 = last ? nB : cB + (size_t)(t + 2) * kstep;
            const char* a3 = a2 + kstep; const char* b3 = b2 + kstep;
            PG8_LDB(B0, 0, 0); PG8_LDB(B1, 0, 1); PG8_SCHED; PG8_LDA(At, 0, 0); PG8_STAGE(PG8_SA(1, 1), a1 + hstepA, voffA);
            PG8_WAIT_V(8); PG8_WAIT_L(0); PG8_BAR; PG8_MMA(0, 0, At, B0); PG8_MMA(0, 1, At, B1); PG8_BAR; PG8_SCHED;
            PG8_LDA(At, 0, 1); PG8_STAGE(PG8_SB(0, 0), b2, voffB); PG8_STAGE(PG8_SB(0, 1), b2 + hstepB, voffB); PG8_STAGE(PG8_SA(0, 0), a2, voffA);
            PG8_WAIT_V(8); PG8_WAIT_L(0); PG8_BAR; PG8_MMA(1, 0, At, B0); PG8_MMA(1, 1, At, B1); PG8_BAR; PG8_SCHED;
            PG8_LDB(B0, 1, 0); PG8_LDB(B1, 1, 1); PG8_SCHED; PG8_LDA(At, 1, 0); PG8_STAGE(PG8_SA(0, 1), a2 + hstepA, voffA);
            PG8_WAIT_V(8); PG8_WAIT_L(0); PG8_BAR; PG8_MMA(0, 0, At, B0); PG8_MMA(0, 1, At, B1); PG8_BAR; PG8_SCHED;
            PG8_LDA(At, 1, 1); PG8_STAGE(PG8_SB(1, 0), b3, voffB); PG8_STAGE(PG8_SB(1, 1), b3 + hstepB, voffB); PG8_STAGE(PG8_SA(1, 0), a3, voffA);
            PG8_WAIT_V(8); PG8_WAIT_L(0); PG8_BAR; PG8_MMA(1, 0, At, B0); PG8_MMA(1, 1, At, B1); PG8_BAR; PG8_SCHED;
        }
        if constexpr (ALIGN_EPI) { if (wr == 0) PG8_BAR; }
        E.template run<2>(acc, cur, wr, wc, fr, fq);
        if (!has_next) break;
#pragma unroll
        for (int a = 0; a < 2; ++a)
#pragma unroll
            for (int b = 0; b < 2; ++b)
#pragma unroll
                for (int m = 0; m < 4; ++m)
#pragma unroll
                    for (int n = 0; n < 2; ++n) acc[a][b][m][n] = (f32x4){0.f, 0.f, 0.f, 0.f};
        cur = nxt; cA = nA; cB = nB; ++ui;
        if constexpr (ALIGN_EPI) { if (wr == 1) PG8_BAR; }
    }
    PG8_WAIT_V(0);
    if constexpr (!ALIGN_EPI) { if (wr == 0) PG8_BAR; }
    PG8_BAR;
#undef PG8_SA
#undef PG8_SB
#undef PG8_STAGE
#undef PG8_LDA
#undef PG8_LDB
#undef PG8_MMA
#undef PG8_WAIT_V
#undef PG8_WAIT_L
#undef PG8_BAR
#undef PG8_SCHED
}

template <class Epi>
__device__ __forceinline__ void gemm_half(PG8_LAS unsigned char* lds, const Gemm g, const Unit u, const Epi& E) {
    const int tid = threadIdx.x, wid = __builtin_amdgcn_readfirstlane(tid >> 6), lane = tid & 63, wr = wid >> 2, wc = wid & 3, fr = lane & 15, fq = lane >> 4;
    int nt = g.K / BK; asm volatile("" : "+s"(nt));
    unsigned voffA[2], voffB[2];
#pragma unroll
    for (int i = 0; i < 2; ++i) { int R, C; stage_rc(tid * 16 + i * 8192, R, C); const int Rb = (R & ~31) + perm32(R & 31);
        voffA[i] = (unsigned)(R * g.lda + C) * 2u; voffB[i] = (unsigned)(Rb * g.ldb + C) * 2u; }
    const size_t kstep = (size_t)(BK * 2);
    const size_t hstepA = (size_t)HALF * g.lda * 2, hstepB = (size_t)HALF * g.ldb * 2;
    const unsigned ldsw = (unsigned)wid * 1024u;
    const int aoff = lds_byte(wr * 64 + fr, fq * 8), boff = lds_byte(wc * 32 + fr, fq * 8);
#define PG8_SA(b, h) (((b) * 2 + (h)) * HTB)
#define PG8_SB(b, h) ((4 + (b) * 2 + (h)) * HTB)
#define PG8_STAGE(bufoff, gbase, voff) do { _Pragma("unroll") for (int _i = 0; _i < 2; ++_i) \
        __builtin_amdgcn_global_load_lds((const unsigned*)((const char*)(gbase) + (voff)[_i]), (PG8_LAS unsigned*)(lds + (bufoff) + ldsw + _i * 8192), 16, 0, 0); } while (0)
#define PG8_LDA(dst, b, h) do { _Pragma("unroll") for (int m = 0; m < 4; ++m) _Pragma("unroll") for (int k = 0; k < 2; ++k) dst[m][k] = *(const PG8_LAS bf16x8*)(lds + PG8_SA(b, h) + aoff + m * 2048 + k * 1024); } while (0)
#define PG8_LDB(dst, b, h) do { _Pragma("unroll") for (int n = 0; n < 2; ++n) _Pragma("unroll") for (int k = 0; k < 2; ++k) dst[n][k] = *(const PG8_LAS bf16x8*)(lds + PG8_SB(b, h) + boff + n * 2048 + k * 1024); } while (0)
#define PG8_MMA(ai, bj, At, Bt) do { __builtin_amdgcn_s_setprio(1); _Pragma("unroll") for (int m = 0; m < 4; ++m) _Pragma("unroll") for (int n = 0; n < 2; ++n) _Pragma("unroll") for (int k = 0; k < 2; ++k) \
        acc[ai][bj][m][n] = __builtin_amdgcn_mfma_f32_16x16x32_bf16(Bt[n][k], At[m][k], acc[ai][bj][m][n], 0, 0, 0); __builtin_amdgcn_s_setprio(0); } while (0)
#define PG8_WAIT_V(n) asm volatile("s_waitcnt vmcnt(" #n ")" ::: "memory")
#define PG8_WAIT_L(n) asm volatile("s_waitcnt lgkmcnt(" #n ")" ::: "memory")
#define PG8_BAR __builtin_amdgcn_s_barrier()
#define PG8_SCHED __builtin_amdgcn_sched_barrier(0)
    f32x4 acc[2][2][4][2];
#pragma unroll
    for (int a = 0; a < 2; ++a)
#pragma unroll
        for (int b = 0; b < 2; ++b)
#pragma unroll
            for (int m = 0; m < 4; ++m)
#pragma unroll
                for (int n = 0; n < 2; ++n) acc[a][b][m][n] = (f32x4){0.f, 0.f, 0.f, 0.f};
    bf16x8 At[4][2], B0[2][2], B1[2][2];
    const char* cA = (const char*)g.A + ((size_t)u.pm * BM + u.rh) * g.lda * 2 + (size_t)((u.pn >> g.ash) * g.amul) * 2; const char* cB = (const char*)g.Bt + (size_t)u.pn * 2 * hstepB;
    PG8_STAGE(PG8_SB(0, 0), cB, voffB); PG8_STAGE(PG8_SB(0, 1), cB + hstepB, voffB); PG8_STAGE(PG8_SA(0, 0), cA, voffA);
    PG8_STAGE(PG8_SB(1, 0), cB + kstep, voffB); PG8_STAGE(PG8_SB(1, 1), cB + hstepB + kstep, voffB); PG8_STAGE(PG8_SA(1, 0), cA + kstep, voffA);
    PG8_WAIT_V(6); PG8_BAR;
#define PG8_HALF_STEP(b, tt) do { \
        PG8_LDB(B0, b, 0); PG8_LDB(B1, b, 1); PG8_LDA(At, b, 0); PG8_WAIT_L(0); PG8_BAR; PG8_SCHED; \
        const bool more_ = (tt) + 2 < nt; \
        if (more_) { const char* b2 = cB + (size_t)((tt) + 2) * kstep; const char* a2 = cA + (size_t)((tt) + 2) * kstep; \
            PG8_STAGE(PG8_SB(b, 0), b2, voffB); PG8_STAGE(PG8_SB(b, 1), b2 + hstepB, voffB); PG8_STAGE(PG8_SA(b, 0), a2, voffA); } \
        PG8_MMA(0, 0, At, B0); PG8_MMA(0, 1, At, B1); \
        if (more_) PG8_WAIT_V(6); else PG8_WAIT_V(0); \
        PG8_BAR; PG8_SCHED; } while (0)
    for (int t = 0; t < nt; t += 2) { PG8_HALF_STEP(0, t); PG8_HALF_STEP(1, t + 1); }
    E.template run<1>(acc, u, wr, wc, fr, fq);
    PG8_BAR;
#undef PG8_HALF_STEP
#undef PG8_SA
#undef PG8_SB
#undef PG8_STAGE
#undef PG8_LDA
#undef PG8_LDB
#undef PG8_MMA
#undef PG8_WAIT_V
#undef PG8_WAIT_L
#undef PG8_BAR
#undef PG8_SCHED
}
template <class Epi>
__device__ __forceinline__ void gate_unit_fused(PG8_LAS unsigned char* lds, const bf16_t* UR, const float* convw, const float* convb, const bf16_t* WG, const Epi& E, int pm, int h, bf16_t* Vg) {
    const int tid = threadIdx.x, wid = __builtin_amdgcn_readfirstlane(tid >> 6), lane = tid & 63, wr = wid >> 2, wc = wid & 3, fr = lane & 15, fq = lane >> 4;
    { const char* cB = (const char*)WG + (size_t)h * 256 * 128 * 2;
#pragma unroll
      for (int i = 0; i < 2; ++i) { int R, C; stage_rc(tid * 16 + i * 8192, R, C); const int Rb = (R & ~31) + perm32(R & 31); const unsigned vo = (unsigned)(Rb * 128 + C) * 2u;
#pragma unroll
          for (int kt = 0; kt < 2; ++kt)
#pragma unroll
              for (int hb = 0; hb < 2; ++hb)
                  __builtin_amdgcn_global_load_lds((const unsigned*)(cB + (size_t)hb * 128 * 128 * 2 + kt * 128 + vo), (PG8_LAS unsigned*)(lds + (4 + kt * 2 + hb) * HTB + wid * 1024 + i * 8192), 16, 0, 0); } }
    { const int to = tid >> 4, co = tid & 15, t0 = pm * 256 + to * 8, tl = t0 & 4095, cog = h * 16 + co;
      const bf16_t* src = UR + (size_t)t0 * 1024 + cog * 8; const float* cw = convw + cog * 8; const float* cb = convb + cog * 8;
      u32x4 rw[11];
#pragma unroll
      for (int k = 0; k < 11; ++k) rw[k] = (k >= 3 || tl != 0) ? *(const u32x4*)(src + (ptrdiff_t)(k - 3) * 1024) : (u32x4){0u, 0u, 0u, 0u};
      f32x4 w0[2], w1[2], w2[2], w3[2], bb[2];
#pragma unroll
      for (int n = 0; n < 2; ++n) { w0[n] = *(const f32x4*)(cw + 4 * n); w1[n] = *(const f32x4*)(cw + 1024 + 4 * n); w2[n] = *(const f32x4*)(cw + 2048 + 4 * n); w3[n] = *(const f32x4*)(cw + 3072 + 4 * n); bb[n] = *(const f32x4*)(cb + 4 * n); }
#pragma unroll
      for (int i = 0; i < 8; ++i) { f32x4 a[2], b[2], c[2], d[2]; unpack8(rw[i], a[0], a[1]); unpack8(rw[i + 1], b[0], b[1]); unpack8(rw[i + 2], c[0], c[1]); unpack8(rw[i + 3], d[0], d[1]);
          const int tr = to * 8 + i;
          const u32x4 cv = pack8(bb[0] + w0[0] * a[0] + w1[0] * b[0] + w2[0] * c[0] + w3[0] * d[0], bb[1] + w0[1] * a[1] + w1[1] * b[1] + w2[1] * c[1] + w3[1] * d[1]);
          *(PG8_LAS u32x4*)(lds + ((co >> 3) * 2 + (tr >> 7)) * HTB + lds_byte(tr & 127, (co & 7) * 8)) = cv;
          if (Vg) *(u32x4*)(Vg + (size_t)(t0 + i) * 1536 + cog * 8) = cv; } }
    asm volatile("s_waitcnt vmcnt(0) lgkmcnt(0)" ::: "memory"); __syncthreads(); __builtin_amdgcn_sched_barrier(0);
    f32x4 acc[2][2][4][2];
#pragma unroll
    for (int a = 0; a < 2; ++a)
#pragma unroll
        for (int b = 0; b < 2; ++b)
#pragma unroll
            for (int m = 0; m < 4; ++m)
#pragma unroll
                for (int n = 0; n < 2; ++n) acc[a][b][m][n] = (f32x4){0.f, 0.f, 0.f, 0.f};
    const int aoff = lds_byte(wr * 64 + fr, fq * 8), boff = lds_byte(wc * 32 + fr, fq * 8);
#pragma unroll
    for (int kt = 0; kt < 2; ++kt) {
#pragma unroll
        for (int ai = 0; ai < 2; ++ai) { bf16x8 At[4][2];
#pragma unroll
            for (int m = 0; m < 4; ++m)
#pragma unroll
                for (int k = 0; k < 2; ++k) At[m][k] = *(const PG8_LAS bf16x8*)(lds + (kt * 2 + ai) * HTB + aoff + m * 2048 + k * 1024);
#pragma unroll
            for (int bj = 0; bj < 2; ++bj) { bf16x8 Bf[2][2];
#pragma unroll
                for (int n = 0; n < 2; ++n)
#pragma unroll
                    for (int k = 0; k < 2; ++k) Bf[n][k] = *(const PG8_LAS bf16x8*)(lds + (4 + kt * 2 + bj) * HTB + boff + n * 2048 + k * 1024);
#pragma unroll
                for (int m = 0; m < 4; ++m)
#pragma unroll
                    for (int n = 0; n < 2; ++n)
#pragma unroll
                        for (int k = 0; k < 2; ++k) acc[ai][bj][m][n] = __builtin_amdgcn_mfma_f32_16x16x32_bf16(Bf[n][k], At[m][k], acc[ai][bj][m][n], 0, 0, 0);
                __builtin_amdgcn_sched_barrier(0); } } }
    Unit u; u.pm = pm; u.pn = h; u.rh = 0; u.idx = 0;
    E.template run<2>(acc, u, wr, wc, fr, fq);
    __syncthreads();
}
}

constexpr int NWAVES = 8, NTHR = 512;
constexpr int M = 16384, SEQ = 4096, NB = 4, D = 1024, DPOOL = 512, DRNN = 1024, DIN = 4608, DFF = 2816;
constexpr float EPS = 1e-6f;
constexpr int NPH = 11;
constexpr int SCAN_T = 128, SCAN_NC = SEQ / SCAN_T;

constexpr size_t MiB = 1u << 20;
constexpr size_t WS_SP8 = 512 * 1024;
constexpr size_t WS_RSI = 576 * 1024;
constexpr size_t WS_SSQ = 1 * MiB;
constexpr size_t WS_SSQ2 = 2 * MiB;
constexpr size_t WS_CS = 2 * MiB, WS_CH = 3 * MiB;
constexpr size_t WS_WIN = 4 * MiB;
constexpr size_t WS_WFI = 13 * MiB;
constexpr size_t WS_WFO = 24 * MiB;
constexpr size_t WS_WCAT = WS_WFO + 5632 * 1024;
constexpr size_t WS_WO = WS_WCAT + 3 * MiB;
constexpr size_t WS_WGRP = WS_WO + 2 * MiB;
constexpr size_t WS_WGATE = WS_WGRP + MiB / 4;
constexpr size_t WS_R1 = 36 * MiB;
constexpr size_t WS_R2 = 68 * MiB;
constexpr size_t WS_R3 = 84 * MiB;
constexpr size_t WS_R4 = 116 * MiB;
constexpr size_t WS_R7 = 148 * MiB;
constexpr size_t WS_R8 = 164 * MiB;
constexpr size_t WS_CAT = 196 * MiB;
constexpr size_t WS_MIXB = 148 * MiB;
constexpr size_t WS_ACT = 68 * MiB;
constexpr size_t WS_END = 244 * MiB;

constexpr int LDS_BYTES = 147456;

#define LAS __attribute__((address_space(3)))
typedef unsigned short bf16;
typedef unsigned v4u __attribute__((ext_vector_type(4)));
typedef unsigned v2u __attribute__((ext_vector_type(2)));
typedef float f32x4 __attribute__((ext_vector_type(4)));
typedef float f32x2 __attribute__((ext_vector_type(2)));
#define LDS_WAIT() asm volatile("s_waitcnt lgkmcnt(0)" ::: "memory")
using pg8::cvt_pk_bf16; using pg8::bf_lo; using pg8::bf_hi;

struct Args { const float* in[19]; float* out; unsigned char* ws; int ph_lo, ph_hi; };
enum { I_X = 0, I_NORM_MIX, I_W_IN, I_W_GRP, I_POOL_SCALE, I_W_POOL_OUT, I_CONV_W, I_CONV_B, I_W_RG_A, I_B_RG_A, I_W_RG_X, I_B_RG_X, I_LAMBDA, I_W_RNN_OUT, I_W_O, I_NORM_FFN, I_W_FFN_IN, I_W_FFN_OUT, I_NORM_FINAL };

__device__ __forceinline__ float wave_sum(float v) {
#pragma unroll
    for (int o = 1; o < 64; o <<= 1) v += __shfl_xor(v, o);
    return v;
}

__device__ __forceinline__ void transpose_item(const float* W, int Nsrc, int Kdst, bf16* WT, int k0, int n_src0, int n_dst0, const float* kscale, LAS float* scr, int lane) {
    f32x4 v[8]; const int n4 = (lane & 7) * 4;
#pragma unroll
    for (int i = 0; i < 8; ++i) { const int kk = 8 * i + (lane >> 3); v[i] = __builtin_nontemporal_load((const f32x4*)(W + (size_t)(k0 + kk) * Nsrc + n_src0 + n4)); }
    if (kscale) {
#pragma unroll
        for (int i = 0; i < 8; ++i) v[i] = v[i] * kscale[k0 + 8 * i + (lane >> 3)]; }
#pragma unroll
    for (int i = 0; i < 8; ++i) { const int kk = 8 * i + (lane >> 3);
#pragma unroll
        for (int j = 0; j < 4; ++j) scr[kk * 33 + n4 + j] = v[i][j]; }
    LDS_WAIT(); asm volatile("" ::: "memory");
    const int c = lane & 7;
#pragma unroll
    for (int j = 0; j < 4; ++j) { const int n = (lane >> 3) + 8 * j; const LAS float* s = scr + (8 * c) * 33 + n;
        v4u o; o.x = cvt_pk_bf16(s[0 * 33], s[1 * 33]); o.y = cvt_pk_bf16(s[2 * 33], s[3 * 33]); o.z = cvt_pk_bf16(s[4 * 33], s[5 * 33]); o.w = cvt_pk_bf16(s[6 * 33], s[7 * 33]);
        *(v4u*)(WT + (size_t)(n_dst0 + n) * Kdst + k0 + 8 * c) = o; }
    LDS_WAIT(); asm volatile("" ::: "memory");
}

#define XB_TMO      128
#define XB_XCNT(j)  (256  + 64 * (j))
#define XB_XSUB(j)  (1280 + 64 * (j))
#define XB_XGEN(j)  (2304 + 64 * (j))
#define XB_TOP      3328
#define XB_TOPGEN   3392
#define XCD_BAR_WORDS 3456
#define XB_SPIN_CAP (1u << 18)
__device__ __forceinline__ unsigned xb_ld(unsigned* p)              { return __hip_atomic_load(p, __ATOMIC_RELAXED, __HIP_MEMORY_SCOPE_AGENT); }
__device__ __forceinline__ unsigned xb_add(unsigned* p, unsigned v) { return __hip_atomic_fetch_add(p, v, __ATOMIC_RELAXED, __HIP_MEMORY_SCOPE_AGENT); }
__device__ __forceinline__ unsigned xb_xcc_id() { return (unsigned)__builtin_amdgcn_s_getreg((3 << 11) | 20) & 0xFu; }
#define XB_SPIN(cond, bar) do { unsigned _sp = 0; while (cond) { __builtin_amdgcn_s_sleep(1); \
    if ((++_sp & 255u) == 0u) { if (xb_ld(&(bar)[XB_TMO])) break; if (_sp > XB_SPIN_CAP) { atomicAdd(&(bar)[XB_TMO], 1u); break; } } } } while (0)
struct XcdBarrier { unsigned* bar; unsigned x; volatile LAS unsigned* st; };
__device__ __forceinline__ XcdBarrier xcd_barrier_post(unsigned* bar, volatile LAS unsigned* st) {
    XcdBarrier b; b.bar = bar; b.x = xb_xcc_id(); b.st = st;
    if (threadIdx.x == 0) (void)xb_add(&bar[XB_XCNT(b.x)], 1u);
    return b;
}
__device__ __forceinline__ void xcd_barrier_complete(unsigned* bar, unsigned x, unsigned& nloc, unsigned& nx) {
    const unsigned G = gridDim.x * gridDim.y * gridDim.z;
    unsigned sum, cnt, mine, sp = 0u;
    for (;;) {
        sum = 0u; cnt = 0u; mine = 0u;
#pragma unroll
        for (unsigned j = 0; j < 16; ++j) { const unsigned c = xb_ld(&bar[XB_XCNT(j)]); sum += c; cnt += (c > 0u) ? 1u : 0u; mine = (j == x) ? c : mine; }
        if (sum == G) break;
        __builtin_amdgcn_s_sleep(1);
        if ((++sp & 255u) == 0u) { if (xb_ld(&bar[XB_TMO])) break; if (sp > XB_SPIN_CAP) { atomicAdd(&bar[XB_TMO], 1u); break; } }
    }
    nloc = mine > 0u ? mine : 1u; nx = cnt > 0u ? cnt : 1u;
}
__device__ __forceinline__ void xcd_barrier(const XcdBarrier& b) {
    asm volatile("s_waitcnt vmcnt(0)" ::: "memory");
    __syncthreads();
    if (threadIdx.x == 0) {
        unsigned* bar = b.bar;
        __builtin_amdgcn_s_waitcnt(0);
        unsigned nloc = b.st[0], nx = b.st[1];
        if (nloc == 0u) { xcd_barrier_complete(bar, b.x, nloc, nx); b.st[0] = nloc; b.st[1] = nx; }
        const unsigned old = xb_add(&bar[XB_XSUB(b.x)], 1u);
        const unsigned gen = old / nloc;
        if (old + 1u == (gen + 1u) * nloc) {
            __builtin_amdgcn_fence(__ATOMIC_RELEASE, "agent");
            asm volatile("s_waitcnt vmcnt(0)" ::: "memory");
            const unsigned og = xb_add(&bar[XB_TOP], 1u);
            const unsigned tg = og / nx;
            if (og + 1u == (tg + 1u) * nx) xb_add(&bar[XB_TOPGEN], 1u);
            else XB_SPIN(xb_ld(&bar[XB_TOPGEN]) == tg, bar);
            __builtin_amdgcn_fence(__ATOMIC_ACQUIRE, "agent");
            xb_add(&bar[XB_XGEN(b.x)], 1u);
            asm volatile("s_waitcnt vmcnt(0)" ::: "memory");
        } else {
            XB_SPIN(xb_ld(&bar[XB_XGEN(b.x)]) == gen, bar);
            __builtin_amdgcn_fence(__ATOMIC_ACQUIRE, "agent");
            asm volatile("s_waitcnt vmcnt(0)" ::: "memory");
        }
    }
    __syncthreads();
}

template <int W>
__device__ __forceinline__ void pool_item(const bf16* src, bf16* dst, int tl) {
    v4u rw[W + 7];
#pragma unroll
    for (int k = 0; k < W + 7; ++k) rw[k] = (tl + k - (W - 1) >= 0) ? *(const v4u*)(src + (ptrdiff_t)(k - (W - 1)) * DPOOL) : (v4u){0u, 0u, 0u, 0u};
    f32x4 s0 = {0.f, 0.f, 0.f, 0.f}, s1 = s0;
#pragma unroll
    for (int k = 0; k < W - 1; ++k) { f32x4 a, c; pg8::unpack8(rw[k], a, c); s0 += a; s1 += c; }
#pragma unroll
    for (int i = 0; i < 8; ++i) { f32x4 a, c; pg8::unpack8(rw[W - 1 + i], a, c); s0 += a; s1 += c;
        const int t = tl + i; const int cnt = (t + 1 < W) ? t + 1 : W; const float inv = 1.0f / (float)cnt;
        *(v4u*)(dst + (size_t)i * DPOOL) = pg8::pack8(s0 * inv - a, s1 * inv - c);
        f32x4 a2, c2; pg8::unpack8(rw[i], a2, c2); s0 -= a2; s1 -= c2; }
}
__device__ __forceinline__ void scan_local16(const bf16* lap, const bf16* bbp, f32x4 (&S)[2], f32x4 (&H)[2]) {
    S[0] = S[1] = H[0] = H[1] = (f32x4){0.f, 0.f, 0.f, 0.f};
#pragma unroll
    for (int i0 = 0; i0 < 16; i0 += 8) { v4u lw[8], bw[8];
#pragma unroll
        for (int i = 0; i < 8; ++i) { lw[i] = *(const v4u*)(lap + (size_t)(i0 + i) * DRNN); bw[i] = *(const v4u*)(bbp + (size_t)(i0 + i) * DRNN); }
#pragma unroll
        for (int i = 0; i < 8; ++i) { f32x4 l[2], bq[2]; pg8::unpack8(lw[i], l[0], l[1]); pg8::unpack8(bw[i], bq[0], bq[1]);
#pragma unroll
            for (int n = 0; n < 2; ++n)
#pragma unroll
                for (int j = 0; j < 4; ++j) { H[n][j] = __expf(l[n][j]) * H[n][j] + bq[n][j]; S[n][j] += l[n][j]; } } }
}

__device__ __forceinline__ void conv_item(const bf16* UR, bf16* V, const float* convw, const float* convb, int t0, int co) {
    const int tl = t0 & (SEQ - 1);
    const bf16* src = UR + (size_t)t0 * DRNN + co * 8; bf16* dst = V + (size_t)t0 * 1536 + co * 8;
    const float* cw = convw + co * 8; const float* cb = convb + co * 8;
    v4u rw[11];
#pragma unroll
    for (int k = 0; k < 11; ++k) rw[k] = (k >= 3 || tl != 0) ? *(const v4u*)(src + (ptrdiff_t)(k - 3) * DRNN) : (v4u){0u, 0u, 0u, 0u};
    f32x4 w0[2], w1[2], w2[2], w3[2], bb[2];
#pragma unroll
    for (int n = 0; n < 2; ++n) { w0[n] = *(const f32x4*)(cw + 4 * n); w1[n] = *(const f32x4*)(cw + 1024 + 4 * n); w2[n] = *(const f32x4*)(cw + 2048 + 4 * n); w3[n] = *(const f32x4*)(cw + 3072 + 4 * n); bb[n] = *(const f32x4*)(cb + 4 * n); }
#pragma unroll
    for (int i = 0; i < 8; ++i) { f32x4 a[2], b[2], c[2], d[2]; pg8::unpack8(rw[i], a[0], a[1]); pg8::unpack8(rw[i + 1], b[0], b[1]); pg8::unpack8(rw[i + 2], c[0], c[1]); pg8::unpack8(rw[i + 3], d[0], d[1]);
        *(v4u*)(dst + (size_t)i * 1536) = pg8::pack8(bb[0] + w0[0] * a[0] + w1[0] * b[0] + w2[0] * c[0] + w3[0] * d[0], bb[1] + w0[1] * a[1] + w1[1] * b[1] + w2[1] * c[1] + w3[1] * d[1]); }
}
__device__ __forceinline__ void pool_witem(const bf16* UP, bf16* POOLED, int g, int tblk, int lane) {
    const int t0 = tblk + (lane >> 4) * 8, co = g * 16 + (lane & 15);
    const bf16* src = UP + (size_t)t0 * DPOOL + co * 8; bf16* dst = POOLED + (size_t)t0 * DPOOL + co * 8; const int tl = t0 & (SEQ - 1);
    if (g == 0) pool_item<2>(src, dst, tl); else if (g == 1) pool_item<4>(src, dst, tl); else if (g == 2) pool_item<8>(src, dst, tl); else pool_item<16>(src, dst, tl);
}

__global__ void __launch_bounds__(NTHR, 2) fwd_kernel(Args args) {
    extern __shared__ __attribute__((aligned(16))) unsigned char lds_raw[];
    LAS unsigned char* lds = (LAS unsigned char*)lds_raw;
    const int tid = threadIdx.x, lane = tid & 63, wave = __builtin_amdgcn_readfirstlane(tid >> 6);
    const int G = gridDim.x, bx = blockIdx.x;
    unsigned char* ws = args.ws;
    const int lo = args.ph_lo, hi = args.ph_hi;
#ifndef PHASE_MASK
#define PHASE_MASK 0x7ff
#endif
#define IN(k) (((PHASE_MASK >> (k)) & 1) && lo <= (k) && (k) < hi)
#ifndef REPEAT_MASK
#define REPEAT_MASK 0
#endif
#define REPS(k) (((REPEAT_MASK >> (k)) & 1) ? 2 : 1)
#ifndef PROBE_PHASE
#define PROBE_PHASE -1
#endif
#define PROBE_MULT 4
    unsigned long long tp0 = 0, tp1 = 0;
#define TSTART(k) do { if ((k) == PROBE_PHASE) tp0 = __builtin_amdgcn_s_memrealtime(); } while (0)
#define TEND(k) do { if ((k) == PROBE_PHASE) tp1 = __builtin_amdgcn_s_memrealtime(); } while (0)
#define GSYNC() xcd_barrier(bar)
#define SEAM(k) do { if (IN(k) && IN((k) + 1)) { GSYNC(); } } while (0)

    const float* x = args.in[I_X];
    bf16* WIN = (bf16*)(ws + WS_WIN); bf16* WFI = (bf16*)(ws + WS_WFI); bf16* WFO = (bf16*)(ws + WS_WFO); bf16* WCAT = (bf16*)(ws + WS_WCAT);
    bf16* WO = (bf16*)(ws + WS_WO); bf16* WGRP = (bf16*)(ws + WS_WGRP); bf16* WGATE = (bf16*)(ws + WS_WGATE);
    bf16* XN = (bf16*)(ws + WS_R1); bf16* X1B = XN;
    bf16* CAT = (bf16*)(ws + WS_CAT); bf16* V = CAT + 512; bf16* LA = V;
    bf16* UP = (bf16*)(ws + WS_R2);
    bf16* UR = (bf16*)(ws + WS_R3);
    bf16* UG = (bf16*)(ws + WS_R4);
    bf16* POOLED = (bf16*)(ws + WS_R7); bf16* BB = (bf16*)(ws + WS_R8);
    bf16* MIXB = (bf16*)(ws + WS_MIXB); bf16* ACT = (bf16*)(ws + WS_ACT);
    float* SSQ = (float*)(ws + WS_SSQ); float* CS = (float*)(ws + WS_CS); float* CH = (float*)(ws + WS_CH);
    bf16* G0 = (bf16*)args.out; bf16* G1 = G0 + (size_t)M * 1024;
    float* X1 = args.out;

#ifndef EXTRA_SYNCS
#define EXTRA_SYNCS 0
#endif
    if (PROBE_PHASE == 99) tp0 = __builtin_amdgcn_s_memrealtime();
    volatile LAS unsigned* MISC = (volatile LAS unsigned*)(lds + 131072 + 1024);
    if (tid < 32) MISC[tid] = 0u;
    __syncthreads();
    XcdBarrier bar = xcd_barrier_post((unsigned*)ws, MISC + 8);
    if (lo < 0) cg::this_grid().sync();
    for (int i = 0; i < EXTRA_SYNCS; ++i) GSYNC();
    TSTART(0);
    if (IN(0)) for (int rep = 0; rep < REPS(0); ++rep) { if (rep) GSYNC();
        LAS float* scr = (LAS float*)(lds + wave * 16384);
        const int gw = bx * NWAVES + wave, NGW = G * NWAVES;
        constexpr int I_IN = 16 * (DIN / 32), I_FI = 16 * (2 * DFF / 32), I_FO = (DFF / 64) * (D / 32), I_RO = 16 * 32, I_WO = 16 * 32, I_PO = 8 * 32;
        constexpr int NITEMS = I_IN + I_FI + I_FO + I_RO + I_WO + I_PO;
        for (int it = gw; it < NITEMS; it += NGW) {
            int r = it;
            if (r < I_IN) { const int nblk = DIN / 32, kb = r / nblk, nb = r % nblk, nd = 32 * nb; int ns = nd;
                if (nd >= 2560) { const int q = nd - 2560, pq = q >> 8, j0 = q & 255; ns = 2560 + (j0 < 128 ? 128 * pq + j0 : 1024 + 128 * pq + (j0 - 128)); }
                transpose_item(args.in[I_W_IN], DIN, D, WIN, 64 * kb, ns, nd, args.in[I_NORM_MIX], scr, lane); continue; } r -= I_IN;
            if (r < I_FI) { const int nblk = 2 * DFF / 32, kb = r / nblk, nb = r % nblk, nd = 32 * nb, pn = nd >> 8, j0 = nd & 255;
                const int ns = j0 < 128 ? 128 * pn + j0 : DFF + 128 * pn + (j0 - 128);
                transpose_item(args.in[I_W_FFN_IN], 2 * DFF, D, WFI, 64 * kb, ns, nd, args.in[I_NORM_FFN], scr, lane); continue; } r -= I_FI;
            if (r < I_FO) { if (G != 256) { const int nblk = D / 32, kb = r / nblk, nb = r % nblk; transpose_item(args.in[I_W_FFN_OUT], D, DFF, WFO, 64 * kb, 32 * nb, 32 * nb, nullptr, scr, lane); } continue; } r -= I_FO;
            if (G == 256 && r < I_RO + I_WO + I_PO) continue;
            if (r < I_RO) { const int nblk = D / 32, kb = r / nblk, nb = r % nblk; transpose_item(args.in[I_W_RNN_OUT], D, 1536, WCAT + 512, 64 * kb, 32 * nb, 32 * nb, nullptr, scr, lane); continue; } r -= I_RO;
            if (r < I_WO) { const int nblk = D / 32, kb = r / nblk, nb = r % nblk; transpose_item(args.in[I_W_O], D, D, WO, 64 * kb, 32 * nb, 32 * nb, nullptr, scr, lane); continue; } r -= I_WO;
            { const int nblk = D / 32, kb = r / nblk, nb = r % nblk; transpose_item(args.in[I_W_POOL_OUT], D, 1536, WCAT, 64 * kb, 32 * nb, 32 * nb, nullptr, scr, lane); }
        }
        {
            const int gt = bx * NTHR + tid, NT = G * NTHR;
            const float* wg = args.in[I_W_GRP];
            for (int e = gt; e < 512 * 32; e += NT) { const int n = e >> 5, kc = (e & 31) * 8, g = n >> 7, nn = n & 127; float v[8];
#pragma unroll
                for (int j = 0; j < 8; ++j) { const int kk = kc + j - (g & 1) * 128; v[j] = (kk >= 0 && kk < 128) ? wg[((size_t)g * 128 + kk) * 128 + nn] : 0.f; }
                v4u o; o.x = cvt_pk_bf16(v[0], v[1]); o.y = cvt_pk_bf16(v[2], v[3]); o.z = cvt_pk_bf16(v[4], v[5]); o.w = cvt_pk_bf16(v[6], v[7]);
                *(v4u*)(WGRP + (size_t)n * 256 + kc) = o; }
            const float* wa = args.in[I_W_RG_A]; const float* wx = args.in[I_W_RG_X];
            for (int e = gt; e < 2048 * 16; e += NT) { const int n = e >> 4, kc = (e & 15) * 8, h = n >> 8, j = n & 255; const float* src = j < 128 ? wa : wx; const int jj = j & 127; float v[8];
#pragma unroll
                for (int q = 0; q < 8; ++q) v[q] = src[((size_t)h * 128 + kc + q) * 128 + jj];
                v4u o; o.x = cvt_pk_bf16(v[0], v[1]); o.y = cvt_pk_bf16(v[2], v[3]); o.z = cvt_pk_bf16(v[4], v[5]); o.w = cvt_pk_bf16(v[6], v[7]);
                *(v4u*)(WGATE + (size_t)n * 128 + kc) = o; }
        }
        { const int gt = bx * NTHR + tid; if (gt < DRNN) { const float z = -args.in[I_LAMBDA][gt]; ((float*)(ws + WS_SP8))[gt] = -8.0f * (fmaxf(z, 0.f) + log1pf(expf(-fabsf(z)))); } }
        float* RSI = (float*)(ws + WS_RSI);
        for (int m = gw; m < M; m += 2 * NGW) {
            const int m1 = (m + NGW < M) ? m + NGW : m;
            const f32x4* xr0 = (const f32x4*)(x + (size_t)m * D) + lane; const f32x4* xr1 = (const f32x4*)(x + (size_t)m1 * D) + lane; f32x4 v0[4], v1[4]; float s0 = 0.f, s1 = 0.f;
#pragma unroll
            for (int j = 0; j < 4; ++j) { v0[j] = __builtin_nontemporal_load(xr0 + 64 * j); v1[j] = __builtin_nontemporal_load(xr1 + 64 * j); }
#pragma unroll
            for (int j = 0; j < 4; ++j) { s0 += (v0[j].x * v0[j].x + v0[j].y * v0[j].y) + (v0[j].z * v0[j].z + v0[j].w * v0[j].w); s1 += (v1[j].x * v1[j].x + v1[j].y * v1[j].y) + (v1[j].z * v1[j].z + v1[j].w * v1[j].w); }
            const float q0 = sqrtf(wave_sum(s0) * (1.f / D) + EPS), q1 = sqrtf(wave_sum(s1) * (1.f / D) + EPS), rs0 = 1.0f / q0, rs1 = 1.0f / q1;
            if (lane == 0) { RSI[m] = q0; RSI[m1] = q1; }
            v2u* o0 = (v2u*)(XN + (size_t)m * D) + lane; v2u* o1 = (v2u*)(XN + (size_t)m1 * D) + lane;
#pragma unroll
            for (int j = 0; j < 4; ++j) { const f32x4 y0 = v0[j] * rs0, y1 = v1[j] * rs1; v2u w0, w1; w0.x = cvt_pk_bf16(y0.x, y0.y); w0.y = cvt_pk_bf16(y0.z, y0.w); w1.x = cvt_pk_bf16(y1.x, y1.y); w1.y = cvt_pk_bf16(y1.z, y1.w); o0[64 * j] = w0; o1[64 * j] = w1; }
        }
        __syncthreads();
    }
    SEAM(0);
    TEND(0);

    TSTART(1);
    if (IN(1)) for (int rep = 0; rep < REPS(1); ++rep) { if (rep) GSYNC();
        pg8::Gemm g{XN, WIN, M, 4096, D, D, D, 0, 0}; pg8::StaticOrder S; S.init(M, 4096, G, bx);
        pg8::EpiProj E{UP, UR, UG, G0, G1, 0};
        pg8::gemm_phase<pg8::EpiProj, true>(lds, g, S, E);
    }
    SEAM(1);
    TEND(1);

    TSTART(2);
    if (IN(2) && G != 256) for (int rep = 0; rep < REPS(2); ++rep) { if (rep) GSYNC();
        { const int gw = bx * NWAVES + wave, NGW = G * NWAVES;
          for (int wi = gw; wi < (M / 32) * 4; wi += NGW) pool_witem(UP, POOLED, wi & 3, (wi >> 2) * 32, lane); }
        { const int gt = bx * NTHR + tid, NT = G * NTHR;
          for (int it = gt; it < (M / 8) * 128; it += NT) conv_item(UR, V, args.in[I_CONV_W], args.in[I_CONV_B], (it >> 7) * 8, it & 127); }
    }
    if (G != 256)     SEAM(2);
    TEND(2);

    TSTART(3);
    if (IN(3)) for (int rep = 0; rep < REPS(3); ++rep) { if (rep) GSYNC();
        const bool fusedp2 = (G == 256);
        if (fusedp2) {
            { pg8::StaticOrder Sg; Sg.init(M, 512, G, (bx + G / 2) % G); pg8::Unit u;
              if (Sg.next(0, u)) { for (int wi = wave; wi < 16; wi += NWAVES) pool_witem(UP, POOLED, 2 * u.pn + (wi & 1), u.pm * 256 + (wi >> 1) * 32, lane); } }
            asm volatile("s_waitcnt vmcnt(0)" ::: "memory"); __syncthreads();
        }
        {
          pg8::Gemm g{XN, WIN + (size_t)4096 * D, M, 512, D, D, D, 0, 0}; pg8::StaticOrder S; S.init(M, 512, G, bx);
          pg8::EpiProj E{UP, UR, UG, G0, G1, 16};
          pg8::gemm_phase<pg8::EpiProj, true>(lds, g, S, E); }
        { pg8::Gemm g{POOLED, WGRP, M, 512, 256, 512, 256, 0, 256}; pg8::StaticOrder S; S.init(M, 512, G, (bx + G / 2) % G);
          pg8::EpiGrp E{CAT, 1536, args.in[I_POOL_SCALE]};
          pg8::gemm_phase<pg8::EpiGrp, true>(lds, g, S, E); }
        { pg8::Gemm g{V, WGATE, M, 2048, 128, 1536, 128, 0, 128}; pg8::StaticOrder S; S.init(M, 2048, G, bx);
          if (fusedp2) { S.lin_base = bx * 2; S.lin_cnt = 2; }
          pg8::EpiGate E{V, LA, BB, args.in[I_B_RG_A], args.in[I_B_RG_X], (const float*)(ws + WS_SP8)};
          if (fusedp2) { E.vlds = lds; E.use_lds = true;
              for (int i = 0; i < 2; ++i) { pg8::Unit u; if (S.next(i, u)) pg8::gate_unit_fused<pg8::EpiGate>(lds, UR, args.in[I_CONV_W], args.in[I_CONV_B], WGATE, E, u.pm, u.pn, nullptr); } }
          else pg8::gemm_phase<pg8::EpiGate, true>(lds, g, S, E); }
        if (fusedp2 && bx >= 128) {
            LAS float* scr = (LAS float*)(lds + wave * 16384); constexpr int J_RO = 16 * 32, J_WO = 16 * 32, J_PO = 8 * 32;
            for (int it = (bx - 128) * NWAVES + wave; it < J_RO + J_WO + J_PO; it += 128 * NWAVES) { int r = it; const int nblk = D / 32;
                if (r < J_RO) { const int kb = r / nblk, nb = r % nblk; transpose_item(args.in[I_W_RNN_OUT], D, 1536, WCAT + 512, 64 * kb, 32 * nb, 32 * nb, nullptr, scr, lane); continue; } r -= J_RO;
                if (r < J_WO) { const int kb = r / nblk, nb = r % nblk; transpose_item(args.in[I_W_O], D, D, WO, 64 * kb, 32 * nb, 32 * nb, nullptr, scr, lane); continue; } r -= J_WO;
                { const int kb = r / nblk, nb = r % nblk; transpose_item(args.in[I_W_POOL_OUT], D, 1536, WCAT, 64 * kb, 32 * nb, 32 * nb, nullptr, scr, lane); } }
        }
    }
    SEAM(3);
    TEND(3);

    TSTART(4);
    TEND(4);

    TSTART(5);
    if (IN(5)) for (int rep = 0; rep < REPS(5); ++rep) { if (rep) GSYNC();
        LAS float* PAS = (LAS float*)lds; LAS float* PAH = PAS + 8 * 512; LAS float* PBS = PAH + 8 * 512; LAS float* PBH = PBS + 8 * 512;
        unsigned* flags = (unsigned*)ws + 8192;
        for (int bi = bx; bi < NB * SCAN_NC * 2; bi += G) { const int hh = bi & 1, c = (bi >> 1) % SCAN_NC, b = bi / (2 * SCAN_NC);
            const size_t off = ((size_t)b * SEQ + (size_t)c * SCAN_T + wave * 16) * DRNN + hh * 512 + lane * 8;
            v4u lwk[16], bwk[16];
            const size_t offL = ((size_t)b * SEQ + (size_t)c * SCAN_T + wave * 16) * 1536 + hh * 512 + lane * 8;
#pragma unroll
            for (int i = 0; i < 16; ++i) { lwk[i] = *(const v4u*)(LA + offL + (size_t)i * 1536); bwk[i] = *(const v4u*)(BB + off + (size_t)i * DRNN); }
            { f32x4 S[2] = {{0.f, 0.f, 0.f, 0.f}, {0.f, 0.f, 0.f, 0.f}}, H[2] = {{0.f, 0.f, 0.f, 0.f}, {0.f, 0.f, 0.f, 0.f}};
#pragma unroll
              for (int i = 0; i < 16; ++i) { f32x4 l[2], bq[2]; pg8::unpack8(lwk[i], l[0], l[1]); pg8::unpack8(bwk[i], bq[0], bq[1]);
#pragma unroll
                  for (int n = 0; n < 2; ++n)
#pragma unroll
                      for (int j = 0; j < 4; ++j) { H[n][j] = __expf(l[n][j]) * H[n][j] + bq[n][j]; S[n][j] += l[n][j]; } }
              *(LAS f32x4*)(PBS + wave * 512 + lane * 8) = S[0]; *(LAS f32x4*)(PBS + wave * 512 + lane * 8 + 4) = S[1];
              *(LAS f32x4*)(PBH + wave * 512 + lane * 8) = H[0]; *(LAS f32x4*)(PBH + wave * 512 + lane * 8 + 4) = H[1]; }
#pragma unroll
            for (int i = 0; i < 16; ++i) asm volatile("" : "+v"(lwk[i]), "+v"(bwk[i]));
            __syncthreads();
            { float h = 0.f, st = 0.f;
#pragma unroll
              for (int sb = 0; sb < 8; ++sb) { const float sv = PBS[sb * 512 + tid]; h = __expf(sv) * h + PBH[sb * 512 + tid]; st += sv; }
              const size_t co = ((size_t)b * SCAN_NC + c) * DRNN + hh * 512 + tid;
              __hip_atomic_store(CS + co, st, __ATOMIC_RELAXED, __HIP_MEMORY_SCOPE_AGENT); __hip_atomic_store(CH + co, h, __ATOMIC_RELAXED, __HIP_MEMORY_SCOPE_AGENT); }
            asm volatile("s_waitcnt vmcnt(0)" ::: "memory");
            __syncthreads();
            if (tid == 0) __hip_atomic_store(flags + ((b * 2 + hh) * SCAN_NC + c) * 16, 1u, __ATOMIC_RELAXED, __HIP_MEMORY_SCOPE_AGENT);
            { f32x4 S[2] = {{0.f, 0.f, 0.f, 0.f}, {0.f, 0.f, 0.f, 0.f}}, H[2] = {{0.f, 0.f, 0.f, 0.f}, {0.f, 0.f, 0.f, 0.f}};
              if (wave * 4 < c) {
                  for (int q = 0; q < 4; ++q) { const int cc = wave * 4 + q; if (cc < c) { unsigned* f = flags + ((b * 2 + hh) * SCAN_NC + cc) * 16; unsigned sp = 0;
                      while ((unsigned)__builtin_amdgcn_readfirstlane(__hip_atomic_load(f, __ATOMIC_RELAXED, __HIP_MEMORY_SCOPE_AGENT)) == 0u) { __builtin_amdgcn_s_sleep(1); if (++sp > (1u << 20)) break; } } }
                  __builtin_amdgcn_fence(__ATOMIC_ACQUIRE, "agent");
#pragma unroll
                  for (int q0 = 0; q0 < 4; q0 += 2) { f32x4 cs[2][2], ch[2][2];
#pragma unroll
                      for (int q = 0; q < 2; ++q) { const int cc = wave * 4 + q0 + q; const size_t co = ((size_t)b * SCAN_NC + (cc < c ? cc : 0)) * DRNN + hh * 512 + lane * 8;
                          cs[q][0] = *(const f32x4*)(CS + co); cs[q][1] = *(const f32x4*)(CS + co + 4); ch[q][0] = *(const f32x4*)(CH + co); ch[q][1] = *(const f32x4*)(CH + co + 4); }
#pragma unroll
                      for (int q = 0; q < 2; ++q) { if (wave * 4 + q0 + q < c) {
#pragma unroll
                          for (int n = 0; n < 2; ++n)
#pragma unroll
                              for (int j = 0; j < 4; ++j) { H[n][j] = __expf(cs[q][n][j]) * H[n][j] + ch[q][n][j]; S[n][j] += cs[q][n][j]; } } }
                      asm volatile("" ::: "memory"); }
              }
              *(LAS f32x4*)(PAS + wave * 512 + lane * 8) = S[0]; *(LAS f32x4*)(PAS + wave * 512 + lane * 8 + 4) = S[1];
              *(LAS f32x4*)(PAH + wave * 512 + lane * 8) = H[0]; *(LAS f32x4*)(PAH + wave * 512 + lane * 8 + 4) = H[1]; }
            __syncthreads();
            f32x4 h[2] = {{0.f, 0.f, 0.f, 0.f}, {0.f, 0.f, 0.f, 0.f}};
#pragma unroll
            for (int sb = 0; sb < 8; ++sb) {
#pragma unroll
                for (int n = 0; n < 2; ++n) { const f32x4 sv = *(const LAS f32x4*)(PAS + sb * 512 + lane * 8 + 4 * n), hv = *(const LAS f32x4*)(PAH + sb * 512 + lane * 8 + 4 * n);
#pragma unroll
                    for (int j = 0; j < 4; ++j) h[n][j] = __expf(sv[j]) * h[n][j] + hv[j]; } }
            for (int sb = 0; sb < wave; ++sb) {
#pragma unroll
                for (int n = 0; n < 2; ++n) { const f32x4 sv = *(const LAS f32x4*)(PBS + sb * 512 + lane * 8 + 4 * n), hv = *(const LAS f32x4*)(PBH + sb * 512 + lane * 8 + 4 * n);
#pragma unroll
                    for (int j = 0; j < 4; ++j) h[n][j] = __expf(sv[j]) * h[n][j] + hv[j]; } }
            const bf16* ugp = UG + off;
            bf16* hgp = CAT + ((size_t)b * SEQ + (size_t)c * SCAN_T + wave * 16) * 1536 + 512 + hh * 512 + lane * 8;
            v4u gwk[16];
#pragma unroll
            for (int i = 0; i < 16; ++i) gwk[i] = *(const v4u*)(ugp + (size_t)i * DRNN);
#pragma unroll
            for (int i0 = 0; i0 < 16; i0 += 8) { const v4u* gw8 = gwk + i0;
#pragma unroll
                for (int i = 0; i < 8; ++i) { f32x4 l[2], bq[2], gq[2], o[2]; pg8::unpack8(lwk[i0 + i], l[0], l[1]); pg8::unpack8(bwk[i0 + i], bq[0], bq[1]); pg8::unpack8(gw8[i], gq[0], gq[1]);
#pragma unroll
                    for (int n = 0; n < 2; ++n)
#pragma unroll
                        for (int j = 0; j < 4; ++j) { h[n][j] = __expf(l[n][j]) * h[n][j] + bq[n][j]; o[n][j] = h[n][j] * pg8::gelu_tanh_(gq[n][j]); }
                    *(v4u*)(hgp + (size_t)(i0 + i) * 1536) = pg8::pack8(o[0], o[1]); } }
            __syncthreads();
        }
    }
    SEAM(5);
    TEND(5);

    TSTART(6);
    if (IN(6)) for (int rep = 0; rep < REPS(6); ++rep) { if (rep) GSYNC();
        pg8::Gemm g{CAT, WCAT, M, D, 1536, 1536, 1536, 0, 0}; pg8::StaticOrder S; S.init(M, D, G, bx);
        pg8::EpiMix E{G0, G1, MIXB};
        pg8::gemm_phase<pg8::EpiMix, true, 8>(lds, g, S, E);
    }
    SEAM(6);
    TEND(6);

    TSTART(7);
    if (IN(7)) for (int rep = 0; rep < REPS(7); ++rep) { if (rep) GSYNC();
        pg8::Gemm g{MIXB, WO, M, D, D, D, D, 0, 0}; pg8::StaticOrder S; S.init(M, D, G, bx);
        pg8::EpiRes1 E{XN, (const float*)(ws + WS_RSI), X1B, SSQ};
        pg8::gemm_phase<pg8::EpiRes1, true>(lds, g, S, E);
    }
    SEAM(7);
    TEND(7);

    TSTART(8);
    if (IN(8)) for (int rep = 0; rep < REPS(8); ++rep) { if (rep) GSYNC();
        pg8::Gemm g{X1B, WFI, M, 2 * DFF, D, D, D, 0, 0}; pg8::StaticOrder S; S.init(M, 2 * DFF, G, bx);
        LAS float* RSL = (LAS float*)(lds + 133120);
        { const int r = tid & 255;
          for (int i = tid >> 8; i < 8; i += 2) { pg8::Unit u; if (!S.next(i, u)) break;
              const f32x4* sp = (const f32x4*)(SSQ + (size_t)(u.pm * 256 + r) * 16); const f32x4 st = (sp[0] + sp[1]) + (sp[2] + sp[3]);
              RSL[i * 256 + r] = __builtin_amdgcn_rsqf(((st[0] + st[1]) + (st[2] + st[3])) * (1.0f / 1024.0f) + 1e-6f); }
          __syncthreads(); }
        pg8::EpiSwiglu E{RSL, ACT};
        pg8::gemm_phase<pg8::EpiSwiglu, true>(lds, g, S, E);
        if (G == 256 && bx >= 128) {
            LAS float* scr = (LAS float*)(lds + wave * 16384); constexpr int I_FO = (DFF / 64) * (D / 32);
            for (int r = (bx - 128) * NWAVES + wave; r < I_FO; r += 128 * NWAVES) { const int nblk = D / 32, kb = r / nblk, nb = r % nblk;
                transpose_item(args.in[I_W_FFN_OUT], D, DFF, WFO, 64 * kb, 32 * nb, 32 * nb, nullptr, scr, lane); }
        }
    }
    SEAM(8);
    TEND(8);

    TSTART(9);
    if (IN(9)) for (int rep = 0; rep < REPS(9); ++rep) { if (rep) GSYNC();
        pg8::Gemm g{ACT, WFO, M, D, DFF, DFF, DFF, 0, 0}; pg8::StaticOrder S; S.init(M, D, G, bx);
        if (G == 256) { pg8::EpiFinal E{X1B, X1, (float*)(ws + WS_SSQ2), (unsigned*)ws + 4096, args.in[I_NORM_FINAL]};
            pg8::gemm_phase<pg8::EpiFinal, true>(lds, g, S, E); }
        else { pg8::EpiRes2 E{X1B, X1};
            pg8::gemm_phase<pg8::EpiRes2, true>(lds, g, S, E); }
    }
    if (G != 256) SEAM(9);
    TEND(9);

    TSTART(10);
    if (IN(10) && G != 256) for (int rep = 0; rep < REPS(10); ++rep) { if (rep) GSYNC();
        const int gw = bx * NWAVES + wave, NGW = G * NWAVES;
        const float* gf = args.in[I_NORM_FINAL]; f32x4 gv[4];
#pragma unroll
        for (int j = 0; j < 4; ++j) gv[j] = ((const f32x4*)gf)[lane + 64 * j];
        for (int m = gw; m < M; m += NGW) {
            f32x4* xr = (f32x4*)(X1 + (size_t)m * D) + lane; f32x4 v[4]; float s = 0.f;
#pragma unroll
            for (int j = 0; j < 4; ++j) { v[j] = xr[64 * j]; s += (v[j].x * v[j].x + v[j].y * v[j].y) + (v[j].z * v[j].z + v[j].w * v[j].w); }
            const float rs = 1.0f / sqrtf(wave_sum(s) * (1.f / D) + EPS);
#pragma unroll
            for (int j = 0; j < 4; ++j) xr[64 * j] = v[j] * rs * gv[j];
        }
    }
    if (PROBE_PHASE == 10 || PROBE_PHASE == 99) tp1 = __builtin_amdgcn_s_memrealtime();
    if (PROBE_PHASE >= 0 && bx == 0 && tid == 0) { const unsigned long long dt = (tp1 - tp0) * PROBE_MULT, te = __builtin_amdgcn_s_memrealtime(); while (__builtin_amdgcn_s_memrealtime() - te < dt) __builtin_amdgcn_s_sleep(8); }
#undef IN
#undef SEAM
}

extern "C" void kernel_launch(void* const* d_in, const int* in_sizes, int n_in, void* d_out, int out_size, void* d_ws, size_t ws_size, hipStream_t stream) {
    static int grid = 0;
    if (grid == 0) {
        if (n_in != 19 || out_size != M * D || ws_size < WS_END) { fprintf(stderr, "kernel_launch: unexpected shapes (n_in %d out %d ws %zu)\n", n_in, out_size, ws_size); grid = -1; return; }
        int dev = 0, cus = 0, per_cu = 0;
        hipGetDevice(&dev);
        hipDeviceGetAttribute(&cus, hipDeviceAttributeMultiprocessorCount, dev);
        if (hipFuncSetAttribute((const void*)fwd_kernel, hipFuncAttributeMaxDynamicSharedMemorySize, LDS_BYTES) != hipSuccess) { fprintf(stderr, "kernel_launch: hipFuncSetAttribute failed\n"); grid = -1; return; }
        if (hipOccupancyMaxActiveBlocksPerMultiprocessor(&per_cu, (const void*)fwd_kernel, NTHR, LDS_BYTES) != hipSuccess || per_cu < 1) { fprintf(stderr, "kernel_launch: occupancy query says %d\n", per_cu); per_cu = 1; }
        (void)hipGetLastError();
        grid = cus * 1;
        fprintf(stderr, "kernel_launch: grid %d (cus %d, per_cu %d)\n", grid, cus, per_cu);
    }
    if (grid < 0) return;
    if (hipMemsetAsync(d_ws, 0, 49152, stream) != hipSuccess) { fprintf(stderr, "kernel_launch: memset failed\n"); return; }
    Args a{};
    for (int i = 0; i < 19; ++i) a.in[i] = (const float*)d_in[i];
    a.out = (float*)d_out; a.ws = (unsigned char*)d_ws;
#if MK_PER_PHASE
    for (int p = 0; p < NPH; ++p) { a.ph_lo = p; a.ph_hi = p + 1; hipLaunchKernelGGL(fwd_kernel, dim3(grid), dim3(NTHR), LDS_BYTES, stream, a); }
#else
    a.ph_lo = 0; a.ph_hi = NPH;
    void* kargs[] = {&a};
    hipError_t e = hipLaunchCooperativeKernel((const void*)fwd_kernel, dim3(grid), dim3(NTHR), kargs, LDS_BYTES, stream);
    if (e != hipSuccess) fprintf(stderr, "cooperative launch failed: %s (grid %d)\n", hipGetErrorString(e), grid);
#endif
}
```

```cpp
#include <hip/hip_runtime.h>
#include <hip/hip_cooperative_groups.h>
#include <cstdio>
#include <cstdint>
namespace cg = cooperative_groups;

#ifndef FG_VLDS
#define FG_VLDS 1
#endif
#ifndef MK_PER_PHASE
#define MK_PER_PHASE 0
#endif

namespace pg8 {
#define PG8_LAS __attribute__((address_space(3)))
typedef unsigned short bf16_t;
typedef short bf16x8 __attribute__((ext_vector_type(8)));
typedef float f32x4 __attribute__((ext_vector_type(4)));
typedef float f32x2 __attribute__((ext_vector_type(2)));
typedef unsigned u32x4 __attribute__((ext_vector_type(4)));
typedef unsigned u32x2 __attribute__((ext_vector_type(2)));
constexpr int BM = 256, BK = 64, HALF = 128, HTB = HALF * BK * 2, STAGE_BYTES = 8 * HTB, NXCD = 8, WGM = 8;

__host__ __device__ __forceinline__ int lds_byte(int r, int c) { const int st = (r >> 4) * 2 + (c >> 5), rr = r & 15, cc = c & 31, ob = rr * 64 + cc * 2; return st * 1024 + (ob ^ (((ob >> 9) & 1) << 5)); }
__host__ __device__ __forceinline__ void stage_rc(int b, int& R, int& C) { const int st = b / 1024, sb = b % 1024, swz = sb ^ (((sb >> 9) & 1) << 5); R = (st >> 1) * 16 + swz / 64; C = (st & 1) * 32 + (swz % 64) / 2; }
__host__ __device__ __forceinline__ int perm32(int rho) { const int n = rho >> 4, i = rho & 15; return 8 * (i >> 2) + 4 * n + (i & 3); }

struct Unit { int pm, pn, rh, idx; };
struct Gemm { const bf16_t* A; const bf16_t* Bt; int M, N, K, lda, ldb, ash, amul; };

struct StaticOrder {
    int nM, nN, nwg, G, c, limit, lin_base, lin_cnt;
    __host__ __device__ __forceinline__ void init(int M, int N, int G_, int c_) { nM = M / BM; nN = N / BM; nwg = nM * nN; G = G_; c = c_; limit = nwg; lin_base = 0; lin_cnt = -1; }
    __host__ __device__ __forceinline__ void map(int L, Unit& u) const {
        int wgid = L; { const int q = nwg / NXCD, r = nwg % NXCD, xcd = wgid % NXCD, off = wgid / NXCD; wgid = (xcd < r ? xcd * (q + 1) : r * (q + 1) + (xcd - r) * q) + off; }
        const int nig = WGM * nN, gid = wgid / nig, fm = gid * WGM, gsz = (nM - fm) < WGM ? (nM - fm) : WGM;
        u.pm = fm + ((wgid % nig) % gsz); u.pn = (wgid % nig) / gsz; u.rh = 0;
    }
    __host__ __device__ __forceinline__ bool next(int i, Unit& u) const {
        u.idx = i;
        if (lin_cnt >= 0) { if (i >= lin_cnt) return false; map(lin_base + i, u); return true; }
        const long L = (long)i * G + c; if (L >= limit) return false;
        map((int)L, u); return true;
    }
};

__device__ __forceinline__ unsigned cvt_pk_bf16(float lo, float hi) { unsigned r; asm volatile("v_cvt_pk_bf16_f32 %0, %1, %2" : "=v"(r) : "v"(lo), "v"(hi)); return r; }
__device__ __forceinline__ float bf_lo(unsigned w) { return __uint_as_float(w << 16); }
__device__ __forceinline__ float bf_hi(unsigned w) { return __uint_as_float(w & 0xffff0000u); }
__device__ __forceinline__ float sigmoidf_(float x) { return __builtin_amdgcn_rcpf(1.0f + __expf(-x)); }
__device__ __forceinline__ float gelu_tanh_(float x) { const float z = 1.5957691216057308f * (x + 0.044715f * x * x * x); return x * sigmoidf_(z); }
__device__ __forceinline__ u32x4 pack8(const f32x4 a, const f32x4 b) { u32x4 w; w.x = cvt_pk_bf16(a[0], a[1]); w.y = cvt_pk_bf16(a[2], a[3]); w.z = cvt_pk_bf16(b[0], b[1]); w.w = cvt_pk_bf16(b[2], b[3]); return w; }
__device__ __forceinline__ void unpack8(const u32x4 w, f32x4& a, f32x4& b) { a = (f32x4){bf_lo(w.x), bf_hi(w.x), bf_lo(w.y), bf_hi(w.y)}; b = (f32x4){bf_lo(w.z), bf_hi(w.z), bf_lo(w.w), bf_hi(w.w)}; }

#define EPI_ROWS_BEGIN _Pragma("unroll") for (int ai = 0; ai < NAI; ++ai) _Pragma("unroll") for (int m = 0; m < 4; ++m) { const int row = u.pm * BM + u.rh + ai * HALF + wr * 64 + m * 16 + fr;
#define EPI_ROWS_END }

struct EpiProj {
    bf16_t *UP, *UR, *UG, *RB, *G1; int pn_off;
    template <int NAI> __device__ __forceinline__ void run(const f32x4 (&acc)[2][2][4][2], const Unit& u, int wr, int wc, int fr, int fq) const {
        const int pn = u.pn + pn_off;
        if (pn < 10) {
            bf16_t* base; int ldc, colt;
            if (pn < 2) { base = UP; ldc = 512; colt = pn * 256; }
            else if (pn < 6) { base = UR; ldc = 1024; colt = (pn - 2) * 256; }
            else { base = UG; ldc = 1024; colt = (pn - 6) * 256; }
            const int col0 = colt + wc * 32 + 8 * fq;
            EPI_ROWS_BEGIN
                bf16_t* rowp = base + (unsigned)((unsigned)row * (unsigned)ldc + (unsigned)col0);
#pragma unroll
                for (int bj = 0; bj < 2; ++bj) *(u32x4*)(rowp + bj * HALF) = pack8(acc[ai][bj][m][0], acc[ai][bj][m][1]);
            EPI_ROWS_END
        } else {
            const int ch0 = (pn - 10) * 128 + wc * 32 + 8 * fq;
            EPI_ROWS_BEGIN
                const unsigned off = (unsigned)row * 1024u + (unsigned)ch0; f32x4 rr[2], gg[2];
#pragma unroll
                for (int n = 0; n < 2; ++n)
#pragma unroll
                    for (int j = 0; j < 4; ++j) { const float d0 = 1.0f + fminf(__expf(-acc[ai][0][m][n][j]), 1e18f), d1 = 1.0f + fminf(__expf(-acc[ai][1][m][n][j]), 1e18f);
                        const float q = __builtin_amdgcn_rcpf(d0 * d1); gg[n][j] = d0 * q; rr[n][j] = d1 * d1 * q; }
                *(u32x4*)(RB + off) = pack8(rr[0], rr[1]); *(u32x4*)(G1 + off) = pack8(gg[0], gg[1]);
            EPI_ROWS_END
        }
    }
};
struct EpiGrp {
    bf16_t* O; int ldc; const float* scale;
    template <int NAI> __device__ __forceinline__ void run(const f32x4 (&acc)[2][2][4][2], const Unit& u, int wr, int wc, int fr, int fq) const {
        const int col0 = u.pn * BM + wc * 32 + 8 * fq;
        f32x4 sc[2][2];
#pragma unroll
        for (int bj = 0; bj < 2; ++bj)
#pragma unroll
            for (int n = 0; n < 2; ++n) sc[bj][n] = *(const f32x4*)(scale + col0 + bj * HALF + 4 * n);
        EPI_ROWS_BEGIN
            bf16_t* rowp = O + (unsigned)((unsigned)row * (unsigned)ldc + (unsigned)col0);
#pragma unroll
            for (int bj = 0; bj < 2; ++bj) *(u32x4*)(rowp + bj * HALF) = pack8(acc[ai][bj][m][0] * sc[bj][0], acc[ai][bj][m][1] * sc[bj][1]);
        EPI_ROWS_END
    }
};
struct EpiGate {
    const bf16_t* V; bf16_t *LA, *BB; const float *b_a, *b_x, *sp8;
    const PG8_LAS unsigned char* vlds = nullptr; bool use_lds = false;
    template <int NAI, bool EXACT> __device__ __forceinline__ void rows(const f32x4 (&acc)[2][2][4][2], const Unit& u, int wr, int fr, int ch0, const f32x4 (&ba)[2], const f32x4 (&bx)[2], const f32x4 (&sp)[2]) const {
        u32x4 vwk[2][4];
        EPI_ROWS_BEGIN
            if (use_lds) vwk[ai][m] = *(const PG8_LAS u32x4*)(vlds + (((ch0 >> 6) & 1) * 2 + ai) * HTB + lds_byte((row & 127), (ch0 & 63)));
            else vwk[ai][m] = *(const u32x4*)(V + ((unsigned)row * 1536u + (unsigned)ch0));
        EPI_ROWS_END
        EPI_ROWS_BEGIN
            const unsigned off = (unsigned)row * 1024u + (unsigned)ch0;
            f32x4 vv[2]; unpack8(vwk[ai][m], vv[0], vv[1]);
            f32x4 la[2], bb[2];
#pragma unroll
            for (int n = 0; n < 2; ++n)
#pragma unroll
                for (int j = 0; j < 4; ++j) {
                    const float r = sigmoidf_(acc[ai][0][m][n][j] + ba[n][j]), ig = sigmoidf_(acc[ai][1][m][n][j] + bx[n][j]);
                    const float l = sp[n][j] * r, x2 = 2.0f * l;
                    const float poly = x2 * (1.0f + 0.5f * x2 * (1.0f + 0.33333334f * x2 * (1.0f + 0.25f * x2 * (1.0f + 0.2f * x2 * (1.0f + 0.16666667f * x2)))));
                    const float em1 = EXACT ? ((x2 > -0.25f) ? poly : (__expf(x2) - 1.0f)) : poly;
                    la[n][j] = l; bb[n][j] = __builtin_amdgcn_sqrtf(fmaxf(-em1, 0.f)) * ig * vv[n][j]; }
            *(u32x4*)(LA + ((unsigned)row * 1536u + (unsigned)ch0)) = pack8(la[0], la[1]); *(u32x4*)(BB + off) = pack8(bb[0], bb[1]);
        EPI_ROWS_END
    }
    template <int NAI> __device__ __forceinline__ void run(const f32x4 (&acc)[2][2][4][2], const Unit& u, int wr, int wc, int fr, int fq) const {
        const int ch0 = u.pn * 128 + wc * 32 + 8 * fq;
        f32x4 ba[2], bx[2], sp[2]; bool big = false;
#pragma unroll
        for (int n = 0; n < 2; ++n) { ba[n] = *(const f32x4*)(b_a + ch0 + 4 * n); bx[n] = *(const f32x4*)(b_x + ch0 + 4 * n); sp[n] = *(const f32x4*)(sp8 + ch0 + 4 * n);
#pragma unroll
            for (int j = 0; j < 4; ++j) big = big || !(sp[n][j] >= -0.125f); }
        if (__builtin_amdgcn_ballot_w64(big) != 0ull) rows<NAI, true>(acc, u, wr, fr, ch0, ba, bx, sp);
        else rows<NAI, false>(acc, u, wr, fr, ch0, ba, bx, sp);
    }
};
struct EpiMix {
    const bf16_t *RB, *G1; bf16_t* MIXB;
    __device__ __forceinline__ void mid(f32x4 (&acc)[2][2][4][2], const Unit& u0, int wr, int wc, int fr, int fq) const {
        constexpr int NAI = 2; Unit u = u0; asm volatile("" : "+s"(u.pm), "+s"(u.pn));
        const int col0 = u.pn * BM + wc * 32 + 8 * fq;
        u32x4 rw[2][4][2];
        EPI_ROWS_BEGIN
            const unsigned off = (unsigned)row * 1024u + (unsigned)col0;
#pragma unroll
            for (int bj = 0; bj < 2; ++bj) rw[ai][m][bj] = __builtin_nontemporal_load((const u32x4*)(RB + off + bj * HALF));
        EPI_ROWS_END
        EPI_ROWS_BEGIN
#pragma unroll
            for (int bj = 0; bj < 2; ++bj) { f32x4 r[2]; unpack8(rw[ai][m][bj], r[0], r[1]); acc[ai][bj][m][0] *= r[0]; acc[ai][bj][m][1] *= r[1]; }
            (void)row;
        EPI_ROWS_END
    }
    template <int NAI> __device__ __forceinline__ void run(const f32x4 (&acc)[2][2][4][2], const Unit& u, int wr, int wc, int fr, int fq) const {
        const int col0 = u.pn * BM + wc * 32 + 8 * fq;
        u32x4 gw[2][4][2];
        EPI_ROWS_BEGIN
            const unsigned off = (unsigned)row * 1024u + (unsigned)col0;
#pragma unroll
            for (int bj = 0; bj < 2; ++bj) gw[ai][m][bj] = __builtin_nontemporal_load((const u32x4*)(G1 + off + bj * HALF));
        EPI_ROWS_END
        EPI_ROWS_BEGIN
            const unsigned off = (unsigned)row * 1024u + (unsigned)col0;
#pragma unroll
            for (int bj = 0; bj < 2; ++bj) { f32x4 g[2]; unpack8(gw[ai][m][bj], g[0], g[1]);
                *(u32x4*)(MIXB + off + bj * HALF) = pack8(g[0] * acc[ai][bj][m][0], g[1] * acc[ai][bj][m][1]); }
        EPI_ROWS_END
    }
};
struct EpiRes1 {
    const bf16_t* XNB; const float* RSI; bf16_t* X1B; float* SSQ;
    template <int NAI> __device__ __forceinline__ void run(const f32x4 (&acc)[2][2][4][2], const Unit& u, int wr, int wc, int fr, int fq) const {
        const int col0 = u.pn * BM + wc * 32 + 8 * fq;
#pragma unroll
        for (int ai = 0; ai < NAI; ++ai) {
            u32x4 xw[4][2]; float qi[4];
#pragma unroll
            for (int m = 0; m < 4; ++m) { const int row = u.pm * BM + u.rh + ai * HALF + wr * 64 + m * 16 + fr; const unsigned off = (unsigned)row * 1024u + (unsigned)col0; qi[m] = RSI[row];
#pragma unroll
                for (int bj = 0; bj < 2; ++bj) xw[m][bj] = __builtin_nontemporal_load((const u32x4*)(XNB + off + bj * HALF)); }
            asm volatile("s_waitcnt vmcnt(0)" ::: "memory");
#pragma unroll
            for (int m = 0; m < 4; ++m) { const int row = u.pm * BM + u.rh + ai * HALF + wr * 64 + m * 16 + fr; const unsigned off = (unsigned)row * 1024u + (unsigned)col0; float ss = 0.f;
#pragma unroll
                for (int bj = 0; bj < 2; ++bj) { f32x4 xa, xb; unpack8(xw[m][bj], xa, xb);
                    const f32x4 a = xa * qi[m] + acc[ai][bj][m][0], b = xb * qi[m] + acc[ai][bj][m][1];
                    *(u32x4*)(X1B + off + bj * HALF) = pack8(a, b);
                    ss += (a[0] * a[0] + a[1] * a[1]) + (a[2] * a[2] + a[3] * a[3]) + (b[0] * b[0] + b[1] * b[1]) + (b[2] * b[2] + b[3] * b[3]); }
                ss += __shfl_xor(ss, 16); ss += __shfl_xor(ss, 32);
                if (fq == 0) SSQ[(unsigned)row * 16u + (unsigned)(u.pn * 4 + wc)] = ss; }
        }
    }
};
struct EpiSwiglu {
    const PG8_LAS float* RSL; bf16_t* ACT;
    template <int NAI> __device__ __forceinline__ void run(const f32x4 (&acc)[2][2][4][2], const Unit& u, int wr, int wc, int fr, int fq) const {
        const int col0 = u.pn * 128 + wc * 32 + 8 * fq;
        const PG8_LAS float* rt = RSL + u.idx * 256 + wr * 64 + fr;
        EPI_ROWS_BEGIN
            const float rs = rt[ai * HALF + m * 16];
            f32x4 o[2];
#pragma unroll
            for (int n = 0; n < 2; ++n)
#pragma unroll
                for (int j = 0; j < 4; ++j) { const float g = acc[ai][0][m][n][j] * rs, up = acc[ai][1][m][n][j] * rs; o[n][j] = g * sigmoidf_(g) * up; }
            __builtin_nontemporal_store(pack8(o[0], o[1]), (u32x4*)(ACT + (unsigned)((unsigned)row * 2816u + (unsigned)col0)));
        EPI_ROWS_END
    }
};
struct EpiRes2 {
    const bf16_t* X1B; float* OUT;
    template <int NAI> __device__ __forceinline__ void run(const f32x4 (&acc)[2][2][4][2], const Unit& u, int wr, int wc, int fr, int fq) const {
        const int col0 = u.pn * BM + wc * 32 + 8 * fq;
        EPI_ROWS_BEGIN
            const unsigned off = (unsigned)row * 1024u + (unsigned)col0;
#pragma unroll
            for (int bj = 0; bj < 2; ++bj) { f32x4 xa, xb; unpack8(*(const u32x4*)(X1B + off + bj * HALF), xa, xb);
                *(f32x4*)(OUT + off + bj * HALF) = xa + acc[ai][bj][m][0]; *(f32x4*)(OUT + off + bj * HALF + 4) = xb + acc[ai][bj][m][1]; }
        EPI_ROWS_END
    }
};

struct EpiFinal {
    const bf16_t* X1B; float* OUT; float* SSQ2; unsigned* cnt; const float* gfin;
    template <int NAI> __device__ __forceinline__ void run(f32x4 (&acc)[2][2][4][2], const Unit& u, int wr, int wc, int fr, int fq) const {
        const int col0 = u.pn * BM + wc * 32 + 8 * fq;
        { u32x4 xw[2][4][2];
          EPI_ROWS_BEGIN
              const unsigned off = (unsigned)row * 1024u + (unsigned)col0;
#pragma unroll
              for (int bj = 0; bj < 2; ++bj) xw[ai][m][bj] = __builtin_nontemporal_load((const u32x4*)(X1B + off + bj * HALF));
          EPI_ROWS_END
          EPI_ROWS_BEGIN
              float ss = 0.f;
#pragma unroll
              for (int bj = 0; bj < 2; ++bj) { f32x4 xa, xb; unpack8(xw[ai][m][bj], xa, xb);
                  const f32x4 a = xa + acc[ai][bj][m][0], b = xb + acc[ai][bj][m][1]; acc[ai][bj][m][0] = a; acc[ai][bj][m][1] = b;
                  ss += (a[0] * a[0] + a[1] * a[1]) + (a[2] * a[2] + a[3] * a[3]) + (b[0] * b[0] + b[1] * b[1]) + (b[2] * b[2] + b[3] * b[3]); }
              ss += __shfl_xor(ss, 16); ss += __shfl_xor(ss, 32);
              if (fq == 0) __hip_atomic_store(SSQ2 + (unsigned)row * 16u + (unsigned)(u.pn * 4 + wc), ss, __ATOMIC_RELAXED, __HIP_MEMORY_SCOPE_AGENT);
          EPI_ROWS_END }
        asm volatile("s_waitcnt vmcnt(0)" ::: "memory");
        unsigned* c = cnt + 64 * u.pm;
        if ((threadIdx.x & 63) == 0) __hip_atomic_fetch_add(c, 1u, __ATOMIC_RELAXED, __HIP_MEMORY_SCOPE_AGENT);
        f32x4 gv[2][2];
#pragma unroll
        for (int bj = 0; bj < 2; ++bj)
#pragma unroll
            for (int n = 0; n < 2; ++n) gv[bj][n] = *(const f32x4*)(gfin + col0 + bj * HALF + 4 * n);
        { unsigned sp = 0;
          while ((unsigned)__builtin_amdgcn_readfirstlane(__hip_atomic_load(c, __ATOMIC_RELAXED, __HIP_MEMORY_SCOPE_AGENT)) < 32u) { __builtin_amdgcn_s_sleep(2); if (++sp > (1u << 20)) break; } }
        __builtin_amdgcn_fence(__ATOMIC_ACQUIRE, "agent");
        unsigned long long w0[2][4], w1[2][4];
        EPI_ROWS_BEGIN
            const unsigned long long* sl = (const unsigned long long*)(SSQ2 + (unsigned)row * 16u + (unsigned)(4 * fq));
            w0[ai][m] = __hip_atomic_load(sl, __ATOMIC_RELAXED, __HIP_MEMORY_SCOPE_AGENT); w1[ai][m] = __hip_atomic_load(sl + 1, __ATOMIC_RELAXED, __HIP_MEMORY_SCOPE_AGENT);
        EPI_ROWS_END
        EPI_ROWS_BEGIN
            const unsigned off = (unsigned)row * 1024u + (unsigned)col0;
            float sq = (__uint_as_float((unsigned)w0[ai][m]) + __uint_as_float((unsigned)(w0[ai][m] >> 32))) + (__uint_as_float((unsigned)w1[ai][m]) + __uint_as_float((unsigned)(w1[ai][m] >> 32)));
            sq += __shfl_xor(sq, 16); sq += __shfl_xor(sq, 32);
            const float rs = 1.0f / sqrtf(sq * (1.0f / 1024.0f) + 1e-6f);
#pragma unroll
            for (int bj = 0; bj < 2; ++bj) { *(f32x4*)(OUT + off + bj * HALF) = acc[ai][bj][m][0] * rs * gv[bj][0]; *(f32x4*)(OUT + off + bj * HALF + 4) = acc[ai][bj][m][1] * rs * gv[bj][1]; }
        EPI_ROWS_END
    }
};

template <class Epi, bool ALIGN_EPI, int MID_T = -1>
__device__ __forceinline__ void gemm_phase(PG8_LAS unsigned char* lds, const Gemm g, const StaticOrder& S, const Epi& E) {
    const int tid = threadIdx.x, wid = __builtin_amdgcn_readfirstlane(tid >> 6), lane = tid & 63, wr = wid >> 2, wc = wid & 3, fr = lane & 15, fq = lane >> 4;
    int nt = g.K / BK; asm volatile("" : "+s"(nt));
    unsigned voffA[2], voffB[2];
#pragma unroll
    for (int i = 0; i < 2; ++i) { int R, C; stage_rc(tid * 16 + i * 8192, R, C); const int Rb = (R & ~31) + perm32(R & 31);
        voffA[i] = (unsigned)(R * g.lda + C) * 2u; voffB[i] = (unsigned)(Rb * g.ldb + C) * 2u; }
    const size_t kstep = (size_t)(BK * 2);
    const size_t hstepA = (size_t)HALF * g.lda * 2, hstepB = (size_t)HALF * g.ldb * 2;
    const size_t tstepA = 2 * hstepA, tstepB = 2 * hstepB;
    const unsigned ldsw = (unsigned)wid * 1024u;
    const int aoff = lds_byte(wr * 64 + fr, fq * 8), boff = lds_byte(wc * 32 + fr, fq * 8);
#define PG8_SA(b, h) (((b) * 2 + (h)) * HTB)
#define PG8_SB(b, h) ((4 + (b) * 2 + (h)) * HTB)
#define PG8_STAGE(bufoff, gbase, voff) do { _Pragma("unroll") for (int _i = 0; _i < 2; ++_i) \
        __builtin_amdgcn_global_load_lds((const unsigned*)((const char*)(gbase) + (voff)[_i]), (PG8_LAS unsigned*)(lds + (bufoff) + ldsw + _i * 8192), 16, 0, 0); } while (0)
#define PG8_LDA(dst, b, h) do { _Pragma("unroll") for (int m = 0; m < 4; ++m) _Pragma("unroll") for (int k = 0; k < 2; ++k) dst[m][k] = *(const PG8_LAS bf16x8*)(lds + PG8_SA(b, h) + aoff + m * 2048 + k * 1024); } while (0)
#define PG8_LDB(dst, b, h) do { _Pragma("unroll") for (int n = 0; n < 2; ++n) _Pragma("unroll") for (int k = 0; k < 2; ++k) dst[n][k] = *(const PG8_LAS bf16x8*)(lds + PG8_SB(b, h) + boff + n * 2048 + k * 1024); } while (0)
#define PG8_MMA(ai, bj, At, Bt) do { __builtin_amdgcn_s_setprio(1); _Pragma("unroll") for (int m = 0; m < 4; ++m) _Pragma("unroll") for (int n = 0; n < 2; ++n) _Pragma("unroll") for (int k = 0; k < 2; ++k) \
        acc[ai][bj][m][n] = __builtin_amdgcn_mfma_f32_16x16x32_bf16(Bt[n][k], At[m][k], acc[ai][bj][m][n], 0, 0, 0); __builtin_amdgcn_s_setprio(0); } while (0)
#define PG8_WAIT_V(n) asm volatile("s_waitcnt vmcnt(" #n ")" ::: "memory")
#define PG8_WAIT_L(n) asm volatile("s_waitcnt lgkmcnt(" #n ")" ::: "memory")
#define PG8_BAR __builtin_amdgcn_s_barrier()
#define PG8_SCHED __builtin_amdgcn_sched_barrier(0)
    Unit cur, nxt; int ui = 0;
    if (!S.next(0, cur)) return;
    f32x4 acc[2][2][4][2];
#pragma unroll
    for (int a = 0; a < 2; ++a)
#pragma unroll
        for (int b = 0; b < 2; ++b)
#pragma unroll
            for (int m = 0; m < 4; ++m)
#pragma unroll
                for (int n = 0; n < 2; ++n) acc[a][b][m][n] = (f32x4){0.f, 0.f, 0.f, 0.f};
    bf16x8 At[4][2], B0[2][2], B1[2][2];
    const char* cA = (const char*)g.A + (size_t)cur.pm * tstepA + (size_t)((cur.pn >> g.ash) * g.amul) * 2; const char* cB = (const char*)g.Bt + (size_t)cur.pn * tstepB;
    PG8_STAGE(PG8_SB(0, 0), cB, voffB); PG8_STAGE(PG8_SB(0, 1), cB + hstepB, voffB); PG8_STAGE(PG8_SA(0, 0), cA, voffA); PG8_STAGE(PG8_SA(0, 1), cA + hstepA, voffA);
    if (wr == 1) PG8_BAR;
    PG8_WAIT_V(2); PG8_BAR;
    PG8_STAGE(PG8_SB(1, 0), cB + kstep, voffB); PG8_STAGE(PG8_SA(1, 0), cA + kstep, voffA); PG8_STAGE(PG8_SB(1, 1), cB + hstepB + kstep, voffB);
    PG8_WAIT_V(6); PG8_BAR;
    for (;;) {
        const bool has_next = S.next(ui + 1, nxt);
        const char* nA = has_next ? (const char*)g.A + (size_t)nxt.pm * tstepA + (size_t)((nxt.pn >> g.ash) * g.amul) * 2 : cA; const char* nB = has_next ? (const char*)g.Bt + (size_t)nxt.pn * tstepB : cB;
        for (int t = 0; t < nt; t += 2) {
            const bool last = (t == nt - 2);
            if constexpr (MID_T >= 0) { if (t == MID_T) E.mid(acc, cur, wr, wc, fr, fq); }
            const char* a1 = cA + (size_t)(t + 1) * kstep;
            const char* a2 = last ? nA : cA + (size_t)(t + 2) * kstep; const char* b2 = last ? nB : cB + (size_t)(t + 2) * kstep;
            const char* a3 = a2 + kstep; const char* b3 = b2 + kstep;
            PG8_LDB(B0, 0, 0); PG8_LDB(B1, 0, 1); PG8_SCHED; PG8_LDA(At, 0, 0); PG8_STAGE(PG8_SA(1, 1), a1 + hstepA, voffA);
            PG8_WAIT_V(8); PG8_WAIT_L(0); PG8_BAR; PG8_MMA(0, 0, At, B0); PG8_MMA(0, 1, At, B1); PG8_BAR; PG8_SCHED;
            PG8_LDA(At, 0, 1); PG8_STAGE(PG8_SB(0, 0), b2, voffB); PG8_STAGE(PG8_SB(0, 1), b2 + hstepB, voffB); PG8_STAGE(PG8_SA(0, 0), a2, voffA);
            PG8_WAIT_V(8); PG8_WAIT_L(0); PG8_BAR; PG8_MMA(1, 0, At, B0); PG8_MMA(1, 1, At, B1); PG8_BAR; PG8_SCHED;
            PG8_LDB(B0, 1, 0); PG8_LDB(B1, 1, 1); PG8_SCHED; PG8_LDA(At, 1, 0); PG8_STAGE(PG8_SA(0, 1), a2 + hstepA, voffA);
            PG8_WAIT_V(8); PG8_WAIT_L(0); PG8_BAR; PG8_MMA(0, 0, At, B0); PG8_MMA(0, 1, At, B1); PG8_BAR; PG8_SCHED;
            PG8_LDA(At, 1, 1); PG8_STAGE(PG8_SB(1, 0), b3, voffB); PG8_STAGE(PG8_SB(1, 1), b3 + hstepB, voffB); PG8_STAGE(PG8_SA(1, 0), a3, voffA);
            PG8_WAIT_V(8); PG8_WAIT_L(0); PG8_BAR; PG8_MMA(1, 0, At, B0); PG8_MMA(1, 1, At, B1); PG8_BAR; PG8_SCHED;
        }
        if constexpr (ALIGN_EPI) { if (wr == 0) PG8_BAR; }
        E.template run<2>(acc, cur, wr, wc, fr, fq);
        if (!has_next) break;
#pragma unroll
        for (int a = 0; a < 2; ++a)
#pragma unroll
            for (int b = 0; b < 2; ++b)
#pragma unroll
                for (int m = 0; m < 4; ++m)
#pragma unroll
                    for (int n = 0; n < 2; ++n) acc[a][b][m][n] = (f32x4){0.f, 0.f, 0.f, 0.f};
        cur = nxt; cA = nA; cB = nB; ++ui;
        if constexpr (ALIGN_EPI) { if (wr == 1) PG8_BAR; }
    }
    PG8_WAIT_V(0);
    if constexpr (!ALIGN_EPI) { if (wr == 0) PG8_BAR; }
    PG8_BAR;
#undef PG8_SA
#undef PG8_SB
#undef PG8_STAGE
#undef PG8_LDA
#undef PG8_LDB
#undef PG8_MMA
#undef PG8_WAIT_V
#undef PG8_WAIT_L
#undef PG8_BAR
#undef PG8_SCHED
}

template <class Epi>
__device__ __forceinline__ void gemm_half(PG8_LAS unsigned char* lds, const Gemm g, const Unit u, const Epi& E) {
    const int tid = threadIdx.x, wid = __builtin_amdgcn_readfirstlane(tid >> 6), lane = tid & 63, wr = wid >> 2, wc = wid & 3, fr = lane & 15, fq = lane >> 4;
    int nt = g.K / BK; asm volatile("" : "+s"(nt));
    unsigned voffA[2], voffB[2];
#pragma unroll
    for (int i = 0; i < 2; ++i) { int R, C; stage_rc(tid * 16 + i * 8192, R, C); const int Rb = (R & ~31) + perm32(R & 31);
        voffA[i] = (unsigned)(R * g.lda + C) * 2u; voffB[i] = (unsigned)(Rb * g.ldb + C) * 2u; }
    const size_t kstep = (size_t)(BK * 2);
    const size_t hstepA = (size_t)HALF * g.lda * 2, hstepB = (size_t)HALF * g.ldb * 2;
    const unsigned ldsw = (unsigned)wid * 1024u;
    const int aoff = lds_byte(wr * 64 + fr, fq * 8), boff = lds_byte(wc * 32 + fr, fq * 8);
#define PG8_SA(b, h) (((b) * 2 + (h)) * HTB)
#define PG8_SB(b, h) ((4 + (b) * 2 + (h)) * HTB)
#define PG8_STAGE(bufoff, gbase, voff) do { _Pragma("unroll") for (int _i = 0; _i < 2; ++_i) \
        __builtin_amdgcn_global_load_lds((const unsigned*)((const char*)(gbase) + (voff)[_i]), (PG8_LAS unsigned*)(lds + (bufoff) + ldsw + _i * 8192), 16, 0, 0); } while (0)
#define PG8_LDA(dst, b, h) do { _Pragma("unroll") for (int m = 0; m < 4; ++m) _Pragma("unroll") for (int k = 0; k < 2; ++k) dst[m][k] = *(const PG8_LAS bf16x8*)(lds + PG8_SA(b, h) + aoff + m * 2048 + k * 1024); } while (0)
#define PG8_LDB(dst, b, h) do { _Pragma("unroll") for (int n = 0; n < 2; ++n) _Pragma("unroll") for (int k = 0; k < 2; ++k) dst[n][k] = *(const PG8_LAS bf16x8*)(lds + PG8_SB(b, h) + boff + n * 2048 + k * 1024); } while (0)
#define PG8_MMA(ai, bj, At, Bt) do { __builtin_amdgcn_s_setprio(1); _Pragma("unroll") for (int m = 0; m < 4; ++m) _Pragma("unroll") for (int n = 0; n < 2; ++n) _Pragma("unroll") for (int k = 0; k < 2; ++k) \
        acc[ai][bj][m][n] = __builtin_amdgcn_mfma_f32_16x16x32_bf16(Bt[n][k], At[m][k], acc[ai][bj][m][n], 0, 0, 0); __builtin_amdgcn_s_setprio(0); } while (0)
#define PG8_WAIT_V(n) asm volatile("s_waitcnt vmcnt(" #n ")" ::: "memory")
#define PG8_WAIT_L(n) asm volatile("s_waitcnt lgkmcnt(" #n ")" ::: "memory")
#define PG8_BAR __builtin_amdgcn_s_barrier()
#define PG8_SCHED __builtin_amdgcn_sched_barrier(0)
    f32x4 acc[2][2][4][2];
#pragma unroll
    for (int a = 0; a < 2; ++a)
#pragma unroll
        for (int b = 0; b < 2; ++b)
#pragma unroll
            for (int m = 0; m < 4; ++m)
#pragma unroll
                for (int n = 0; n < 2; ++n) acc[a][b][m][n] = (f32x4){0.f, 0.f, 0.f, 0.f};
    bf16x8 At[4][2], B0[2][2], B1[2][2];
    const char* cA = (const char*)g.A + ((size_t)u.pm * BM + u.rh) * g.lda * 2 + (size_t)((u.pn >> g.ash) * g.amul) * 2; const char* cB = (const char*)g.Bt + (size_t)u.pn * 2 * hstepB;
    PG8_STAGE(PG8_SB(0, 0), cB, voffB); PG8_STAGE(PG8_SB(0, 1), cB + hstepB, voffB); PG8_STAGE(PG8_SA(0, 0), cA, voffA);
    PG8_STAGE(PG8_SB(1, 0), cB + kstep, voffB); PG8_STAGE(PG8_SB(1, 1), cB + hstepB + kstep, voffB); PG8_STAGE(PG8_SA(1, 0), cA + kstep, voffA);
    PG8_WAIT_V(6); PG8_BAR;
#define PG8_HALF_STEP(b, tt) do { \
        PG8_LDB(B0, b, 0); PG8_LDB(B1, b, 1); PG8_LDA(At, b, 0); PG8_WAIT_L(0); PG8_BAR; PG8_SCHED; \
        const bool more_ = (tt) + 2 < nt; \
        if (more_) { const char* b2 = cB + (size_t)((tt) + 2) * kstep; const char* a2 = cA + (size_t)((tt) + 2) * kstep; \
            PG8_STAGE(PG8_SB(b, 0), b2, voffB); PG8_STAGE(PG8_SB(b, 1), b2 + hstepB, voffB); PG8_STAGE(PG8_SA(b, 0), a2, voffA); } \
        PG8_MMA(0, 0, At, B0); PG8_MMA(0, 1, At, B1); \
        if (more_) PG8_WAIT_V(6); else PG8_WAIT_V(0); \
        PG8_BAR; PG8_SCHED; } while (0)
    for (int t = 0; t < nt; t += 2) { PG8_HALF_STEP(0, t); PG8_HALF_STEP(1, t + 1); }
    E.template run<1>(acc, u, wr, wc, fr, fq);
    PG8_BAR;
#undef PG8_HALF_STEP
#undef PG8_SA
#undef PG8_SB
#undef PG8_STAGE
#undef PG8_LDA
#undef PG8_LDB
#undef PG8_MMA
#undef PG8_WAIT_V
#undef PG8_WAIT_L
#undef PG8_BAR
#undef PG8_SCHED
}
template <class Epi>
__device__ __forceinline__ void gate_unit_fused(PG8_LAS unsigned char* lds, const bf16_t* UR, const float* convw, const float* convb, const bf16_t* WG, const Epi& E, int pm, int h, bf16_t* Vg) {
    const int tid = threadIdx.x, wid = __builtin_amdgcn_readfirstlane(tid >> 6), lane = tid & 63, wr = wid >> 2, wc = wid & 3, fr = lane & 15, fq = lane >> 4;
    { const char* cB = (const char*)WG + (size_t)h * 256 * 128 * 2;
#pragma unroll
      for (int i = 0; i < 2; ++i) { int R, C; stage_rc(tid * 16 + i * 8192, R, C); const int Rb = (R & ~31) + perm32(R & 31); const unsigned vo = (unsigned)(Rb * 128 + C) * 2u;
#pragma unroll
          for (int kt = 0; kt < 2; ++kt)
#pragma unroll
              for (int hb = 0; hb < 2; ++hb)
                  __builtin_amdgcn_global_load_lds((const unsigned*)(cB + (size_t)hb * 128 * 128 * 2 + kt * 128 + vo), (PG8_LAS unsigned*)(lds + (4 + kt * 2 + hb) * HTB + wid * 1024 + i * 8192), 16, 0, 0); } }
    { const int to = tid >> 4, co = tid & 15, t0 = pm * 256 + to * 8, tl = t0 & 4095, cog = h * 16 + co;
      const bf16_t* src = UR + (size_t)t0 * 1024 + cog * 8; const float* cw = convw + cog * 8; const float* cb = convb + cog * 8;
      u32x4 rw[11];
#pragma unroll
      for (int k = 0; k < 11; ++k) rw[k] = (k >= 3 || tl != 0) ? __builtin_nontemporal_load((const u32x4*)(src + (ptrdiff_t)(k - 3) * 1024)) : (u32x4){0u, 0u, 0u, 0u};
      f32x4 w0[2], w1[2], w2[2], w3[2], bb[2];
#pragma unroll
      for (int n = 0; n < 2; ++n) { w0[n] = *(const f32x4*)(cw + 4 * n); w1[n] = *(const f32x4*)(cw + 1024 + 4 * n); w2[n] = *(const f32x4*)(cw + 2048 + 4 * n); w3[n] = *(const f32x4*)(cw + 3072 + 4 * n); bb[n] = *(const f32x4*)(cb + 4 * n); }
#pragma unroll
      for (int i = 0; i < 8; ++i) { f32x4 a[2], b[2], c[2], d[2]; unpack8(rw[i], a[0], a[1]); unpack8(rw[i + 1], b[0], b[1]); unpack8(rw[i + 2], c[0], c[1]); unpack8(rw[i + 3], d[0], d[1]);
          const int tr = to * 8 + i;
          const u32x4 cv = pack8(bb[0] + w0[0] * a[0] + w1[0] * b[0] + w2[0] * c[0] + w3[0] * d[0], bb[1] + w0[1] * a[1] + w1[1] * b[1] + w2[1] * c[1] + w3[1] * d[1]);
          *(PG8_LAS u32x4*)(lds + ((co >> 3) * 2 + (tr >> 7)) * HTB + lds_byte(tr & 127, (co & 7) * 8)) = cv;
          if (Vg) *(u32x4*)(Vg + (size_t)(t0 + i) * 1536 + cog * 8) = cv; } }
    asm volatile("s_waitcnt vmcnt(0) lgkmcnt(0)" ::: "memory"); __syncthreads(); __builtin_amdgcn_sched_barrier(0);
    f32x4 acc[2][2][4][2];
#pragma unroll
    for (int a = 0; a < 2; ++a)
#pragma unroll
        for (int b = 0; b < 2; ++b)
#pragma unroll
            for (int m = 0; m < 4; ++m)
#pragma unroll
                for (int n = 0; n < 2; ++n) acc[a][b][m][n] = (f32x4){0.f, 0.f, 0.f, 0.f};
    const int aoff = lds_byte(wr * 64 + fr, fq * 8), boff = lds_byte(wc * 32 + fr, fq * 8);
#pragma unroll
    for (int kt = 0; kt < 2; ++kt) {
#pragma unroll
        for (int ai = 0; ai < 2; ++ai) { bf16x8 At[4][2];
#pragma unroll
            for (int m = 0; m < 4; ++m)
#pragma unroll
                for (int k = 0; k < 2; ++k) At[m][k] = *(const PG8_LAS bf16x8*)(lds + (kt * 2 + ai) * HTB + aoff + m * 2048 + k * 1024);
#pragma unroll
            for (int bj = 0; bj < 2; ++bj) { bf16x8 Bf[2][2];
#pragma unroll
                for (int n = 0; n < 2; ++n)
#pragma unroll
                    for (int k = 0; k < 2; ++k) Bf[n][k] = *(const PG8_LAS bf16x8*)(lds + (4 + kt * 2 + bj) * HTB + boff + n * 2048 + k * 1024);
#pragma unroll
                for (int m = 0; m < 4; ++m)
#pragma unroll
                    for (int n = 0; n < 2; ++n)
#pragma unroll
                        for (int k = 0; k < 2; ++k) acc[ai][bj][m][n] = __builtin_amdgcn_mfma_f32_16x16x32_bf16(Bf[n][k], At[m][k], acc[ai][bj][m][n], 0, 0, 0);
                __builtin_amdgcn_sched_barrier(0); } } }
    Unit u; u.pm = pm; u.pn = h; u.rh = 0; u.idx = 0;
    E.template run<2>(acc, u, wr, wc, fr, fq);
    __syncthreads();
}
}

constexpr int NWAVES = 8, NTHR = 512;
constexpr int M = 16384, SEQ = 4096, NB = 4, D = 1024, DPOOL = 512, DRNN = 1024, DIN = 4608, DFF = 2816;
constexpr float EPS = 1e-6f;
constexpr int NPH = 11;
constexpr int SCAN_T = 128, SCAN_NC = SEQ / SCAN_T;

constexpr size_t MiB = 1u << 20;
constexpr size_t WS_SP8 = 512 * 1024;
constexpr size_t WS_RSI = 576 * 1024;
constexpr size_t WS_SSQ = 1 * MiB;
constexpr size_t WS_SSQ2 = 2 * MiB;
constexpr size_t WS_CS = 2 * MiB, WS_CH = 3 * MiB;
constexpr size_t WS_WIN = 4 * MiB;
constexpr size_t WS_WFI = 13 * MiB;
constexpr size_t WS_WFO = 24 * MiB;
constexpr size_t WS_WCAT = WS_WFO + 5632 * 1024;
constexpr size_t WS_WO = WS_WCAT + 3 * MiB;
constexpr size_t WS_WGRP = WS_WO + 2 * MiB;
constexpr size_t WS_WGATE = WS_WGRP + MiB / 4;
constexpr size_t WS_R1 = 36 * MiB;
constexpr size_t WS_R2 = 68 * MiB;
constexpr size_t WS_R3 = 84 * MiB;
constexpr size_t WS_R4 = 116 * MiB;
constexpr size_t WS_R7 = 148 * MiB;
constexpr size_t WS_R8 = 164 * MiB;
constexpr size_t WS_CAT = 196 * MiB;
constexpr size_t WS_MIXB = 148 * MiB;
constexpr size_t WS_ACT = 68 * MiB;
constexpr size_t WS_END = 244 * MiB;

constexpr int LDS_BYTES = 147456;

#define LAS __attribute__((address_space(3)))
typedef unsigned short bf16;
typedef unsigned v4u __attribute__((ext_vector_type(4)));
typedef unsigned v2u __attribute__((ext_vector_type(2)));
typedef float f32x4 __attribute__((ext_vector_type(4)));
typedef float f32x2 __attribute__((ext_vector_type(2)));
#define LDS_WAIT() asm volatile("s_waitcnt lgkmcnt(0)" ::: "memory")
using pg8::cvt_pk_bf16; using pg8::bf_lo; using pg8::bf_hi;

struct Args { const float* in[19]; float* out; unsigned char* ws; int ph_lo, ph_hi; };
enum { I_X = 0, I_NORM_MIX, I_W_IN, I_W_GRP, I_POOL_SCALE, I_W_POOL_OUT, I_CONV_W, I_CONV_B, I_W_RG_A, I_B_RG_A, I_W_RG_X, I_B_RG_X, I_LAMBDA, I_W_RNN_OUT, I_W_O, I_NORM_FFN, I_W_FFN_IN, I_W_FFN_OUT, I_NORM_FINAL };

__device__ __forceinline__ float wave_sum(float v) {
#pragma unroll
    for (int o = 1; o < 64; o <<= 1) v += __shfl_xor(v, o);
    return v;
}

__device__ __forceinline__ void transpose_item(const float* W, int Nsrc, int Kdst, bf16* WT, int k0, int n_src0, int n_dst0, const float* kscale, LAS float* scr, int lane) {
    f32x4 v[8]; const int n4 = (lane & 7) * 4;
#pragma unroll
    for (int i = 0; i < 8; ++i) { const int kk = 8 * i + (lane >> 3); v[i] = __builtin_nontemporal_load((const f32x4*)(W + (size_t)(k0 + kk) * Nsrc + n_src0 + n4)); }
    if (kscale) {
#pragma unroll
        for (int i = 0; i < 8; ++i) v[i] = v[i] * kscale[k0 + 8 * i + (lane >> 3)]; }
#pragma unroll
    for (int i = 0; i < 8; ++i) { const int kk = 8 * i + (lane >> 3);
#pragma unroll
        for (int j = 0; j < 4; ++j) scr[kk * 33 + n4 + j] = v[i][j]; }
    LDS_WAIT(); asm volatile("" ::: "memory");
    const int c = lane & 7;
#pragma unroll
    for (int j = 0; j < 4; ++j) { const int n = (lane >> 3) + 8 * j; const LAS float* s = scr + (8 * c) * 33 + n;
        v4u o; o.x = cvt_pk_bf16(s[0 * 33], s[1 * 33]); o.y = cvt_pk_bf16(s[2 * 33], s[3 * 33]); o.z = cvt_pk_bf16(s[4 * 33], s[5 * 33]); o.w = cvt_pk_bf16(s[6 * 33], s[7 * 33]);
        *(v4u*)(WT + (size_t)(n_dst0 + n) * Kdst + k0 + 8 * c) = o; }
    LDS_WAIT(); asm volatile("" ::: "memory");
}

#define XB_TMO      128
#define XB_XCNT(j)  (256  + 64 * (j))
#define XB_XSUB(j)  (1280 + 64 * (j))
#define XB_XGEN(j)  (2304 + 64 * (j))
#define XB_TOP      3328
#define XB_TOPGEN   3392
#define XCD_BAR_WORDS 3456
#define XB_SPIN_CAP (1u << 18)
__device__ __forceinline__ unsigned xb_ld(unsigned* p)              { return __hip_atomic_load(p, __ATOMIC_RELAXED, __HIP_MEMORY_SCOPE_AGENT); }
__device__ __forceinline__ unsigned xb_add(unsigned* p, unsigned v) { return __hip_atomic_fetch_add(p, v, __ATOMIC_RELAXED, __HIP_MEMORY_SCOPE_AGENT); }
__device__ __forceinline__ unsigned xb_xcc_id() { return (unsigned)__builtin_amdgcn_s_getreg((3 << 11) | 20) & 0xFu; }
#define XB_SPIN(cond, bar) do { unsigned _sp = 0; while (cond) { __builtin_amdgcn_s_sleep(1); \
    if ((++_sp & 255u) == 0u) { if (xb_ld(&(bar)[XB_TMO])) break; if (_sp > XB_SPIN_CAP) { atomicAdd(&(bar)[XB_TMO], 1u); break; } } } } while (0)
struct XcdBarrier { unsigned* bar; unsigned x; volatile LAS unsigned* st; };
__device__ __forceinline__ XcdBarrier xcd_barrier_post(unsigned* bar, volatile LAS unsigned* st) {
    XcdBarrier b; b.bar = bar; b.x = xb_xcc_id(); b.st = st;
    if (threadIdx.x == 0) (void)xb_add(&bar[XB_XCNT(b.x)], 1u);
    return b;
}
__device__ __forceinline__ void xcd_barrier_complete(unsigned* bar, unsigned x, unsigned& nloc, unsigned& nx) {
    const unsigned G = gridDim.x * gridDim.y * gridDim.z;
    unsigned sum, cnt, mine, sp = 0u;
    for (;;) {
        sum = 0u; cnt = 0u; mine = 0u;
#pragma unroll
        for (unsigned j = 0; j < 16; ++j) { const unsigned c = xb_ld(&bar[XB_XCNT(j)]); sum += c; cnt += (c > 0u) ? 1u : 0u; mine = (j == x) ? c : mine; }
        if (sum == G) break;
        __builtin_amdgcn_s_sleep(1);
        if ((++sp & 255u) == 0u) { if (xb_ld(&bar[XB_TMO])) break; if (sp > XB_SPIN_CAP) { atomicAdd(&bar[XB_TMO], 1u); break; } }
    }
    nloc = mine > 0u ? mine : 1u; nx = cnt > 0u ? cnt : 1u;
}
__device__ __forceinline__ void xcd_barrier(const XcdBarrier& b) {
    asm volatile("s_waitcnt vmcnt(0)" ::: "memory");
    __syncthreads();
    if (threadIdx.x == 0) {
        unsigned* bar = b.bar;
        __builtin_amdgcn_s_waitcnt(0);
        unsigned nloc = b.st[0], nx = b.st[1];
        if (nloc == 0u) { xcd_barrier_complete(bar, b.x, nloc, nx); b.st[0] = nloc; b.st[1] = nx; }
        const unsigned old = xb_add(&bar[XB_XSUB(b.x)], 1u);
        const unsigned gen = old / nloc;
        if (old + 1u == (gen + 1u) * nloc) {
            __builtin_amdgcn_fence(__ATOMIC_RELEASE, "agent");
            asm volatile("s_waitcnt vmcnt(0)" ::: "memory");
            const unsigned og = xb_add(&bar[XB_TOP], 1u);
            const unsigned tg = og / nx;
            if (og + 1u == (tg + 1u) * nx) xb_add(&bar[XB_TOPGEN], 1u);
            else XB_SPIN(xb_ld(&bar[XB_TOPGEN]) == tg, bar);
            __builtin_amdgcn_fence(__ATOMIC_ACQUIRE, "agent");
            xb_add(&bar[XB_XGEN(b.x)], 1u);
            asm volatile("s_waitcnt vmcnt(0)" ::: "memory");
        } else {
            XB_SPIN(xb_ld(&bar[XB_XGEN(b.x)]) == gen, bar);
            __builtin_amdgcn_fence(__ATOMIC_ACQUIRE, "agent");
            asm volatile("s_waitcnt vmcnt(0)" ::: "memory");
        }
    }
    __syncthreads();
}

template <int W>
__device__ __forceinline__ void pool_item(const bf16* src, bf16* dst, int tl) {
    v4u rw[W + 7];
#pragma unroll
    for (int k = 0; k < W + 7; ++k) rw[k] = (tl + k - (W - 1) >= 0) ? __builtin_nontemporal_load((const v4u*)(src + (ptrdiff_t)(k - (W - 1)) * DPOOL)) : (v4u){0u, 0u, 0u, 0u};
    f32x4 s0 = {0.f, 0.f, 0.f, 0.f}, s1 = s0;
#pragma unroll
    for (int k = 0; k < W - 1; ++k) { f32x4 a, c; pg8::unpack8(rw[k], a, c); s0 += a; s1 += c; }
#pragma unroll
    for (int i = 0; i < 8; ++i) { f32x4 a, c; pg8::unpack8(rw[W - 1 + i], a, c); s0 += a; s1 += c;
        const int t = tl + i; const int cnt = (t + 1 < W) ? t + 1 : W; const float inv = 1.0f / (float)cnt;
        *(v4u*)(dst + (size_t)i * DPOOL) = pg8::pack8(s0 * inv - a, s1 * inv - c);
        f32x4 a2, c2; pg8::unpack8(rw[i], a2, c2); s0 -= a2; s1 -= c2; }
}
__device__ __forceinline__ void scan_local16(const bf16* lap, const bf16* bbp, f32x4 (&S)[2], f32x4 (&H)[2]) {
    S[0] = S[1] = H[0] = H[1] = (f32x4){0.f, 0.f, 0.f, 0.f};
#pragma unroll
    for (int i0 = 0; i0 < 16; i0 += 8) { v4u lw[8], bw[8];
#pragma unroll
        for (int i = 0; i < 8; ++i) { lw[i] = *(const v4u*)(lap + (size_t)(i0 + i) * DRNN); bw[i] = *(const v4u*)(bbp + (size_t)(i0 + i) * DRNN); }
#pragma unroll
        for (int i = 0; i < 8; ++i) { f32x4 l[2], bq[2]; pg8::unpack8(lw[i], l[0], l[1]); pg8::unpack8(bw[i], bq[0], bq[1]);
#pragma unroll
            for (int n = 0; n < 2; ++n)
#pragma unroll
                for (int j = 0; j < 4; ++j) { H[n][j] = __expf(l[n][j]) * H[n][j] + bq[n][j]; S[n][j] += l[n][j]; } } }
}

__device__ __forceinline__ void conv_item(const bf16* UR, bf16* V, const float* convw, const float* convb, int t0, int co) {
    const int tl = t0 & (SEQ - 1);
    const bf16* src = UR + (size_t)t0 * DRNN + co * 8; bf16* dst = V + (size_t)t0 * 1536 + co * 8;
    const float* cw = convw + co * 8; const float* cb = convb + co * 8;
    v4u rw[11];
#pragma unroll
    for (int k = 0; k < 11; ++k) rw[k] = (k >= 3 || tl != 0) ? *(const v4u*)(src + (ptrdiff_t)(k - 3) * DRNN) : (v4u){0u, 0u, 0u, 0u};
    f32x4 w0[2], w1[2], w2[2], w3[2], bb[2];
#pragma unroll
    for (int n = 0; n < 2; ++n) { w0[n] = *(const f32x4*)(cw + 4 * n); w1[n] = *(const f32x4*)(cw + 1024 + 4 * n); w2[n] = *(const f32x4*)(cw + 2048 + 4 * n); w3[n] = *(const f32x4*)(cw + 3072 + 4 * n); bb[n] = *(const f32x4*)(cb + 4 * n); }
#pragma unroll
    for (int i = 0; i < 8; ++i) { f32x4 a[2], b[2], c[2], d[2]; pg8::unpack8(rw[i], a[0], a[1]); pg8::unpack8(rw[i + 1], b[0], b[1]); pg8::unpack8(rw[i + 2], c[0], c[1]); pg8::unpack8(rw[i + 3], d[0], d[1]);
        *(v4u*)(dst + (size_t)i * 1536) = pg8::pack8(bb[0] + w0[0] * a[0] + w1[0] * b[0] + w2[0] * c[0] + w3[0] * d[0], bb[1] + w0[1] * a[1] + w1[1] * b[1] + w2[1] * c[1] + w3[1] * d[1]); }
}
__device__ __forceinline__ void pool_witem(const bf16* UP, bf16* POOLED, int g, int tblk, int lane) {
    const int t0 = tblk + (lane >> 4) * 8, co = g * 16 + (lane & 15);
    const bf16* src = UP + (size_t)t0 * DPOOL + co * 8; bf16* dst = POOLED + (size_t)t0 * DPOOL + co * 8; const int tl = t0 & (SEQ - 1);
    if (g == 0) pool_item<2>(src, dst, tl); else if (g == 1) pool_item<4>(src, dst, tl); else if (g == 2) pool_item<8>(src, dst, tl); else pool_item<16>(src, dst, tl);
}

__global__ void __launch_bounds__(NTHR, 2) fwd_kernel(Args args) {
    extern __shared__ __attribute__((aligned(16))) unsigned char lds_raw[];
    LAS unsigned char* lds = (LAS unsigned char*)lds_raw;
    const int tid = threadIdx.x, lane = tid & 63, wave = __builtin_amdgcn_readfirstlane(tid >> 6);
    const int G = gridDim.x, bx = blockIdx.x;
    unsigned char* ws = args.ws;
    const int lo = args.ph_lo, hi = args.ph_hi;
#ifndef PHASE_MASK
#define PHASE_MASK 0x7ff
#endif
#define IN(k) (((PHASE_MASK >> (k)) & 1) && lo <= (k) && (k) < hi)
#ifndef REPEAT_MASK
#define REPEAT_MASK 0
#endif
#define REPS(k) (((REPEAT_MASK >> (k)) & 1) ? 2 : 1)
#ifndef PROBE_PHASE
#define PROBE_PHASE -1
#endif
#define PROBE_MULT 4
    unsigned long long tp0 = 0, tp1 = 0;
#define TSTART(k) do { if ((k) == PROBE_PHASE) tp0 = __builtin_amdgcn_s_memrealtime(); } while (0)
#define TEND(k) do { if ((k) == PROBE_PHASE) tp1 = __builtin_amdgcn_s_memrealtime(); } while (0)
#define GSYNC() xcd_barrier(bar)
#define SEAM(k) do { if (IN(k) && IN((k) + 1)) { GSYNC(); } } while (0)

    const float* x = args.in[I_X];
    bf16* WIN = (bf16*)(ws + WS_WIN); bf16* WFI = (bf16*)(ws + WS_WFI); bf16* WFO = (bf16*)(ws + WS_WFO); bf16* WCAT = (bf16*)(ws + WS_WCAT);
    bf16* WO = (bf16*)(ws + WS_WO); bf16* WGRP = (bf16*)(ws + WS_WGRP); bf16* WGATE = (bf16*)(ws + WS_WGATE);
    bf16* XN = (bf16*)(ws + WS_R1); bf16* X1B = XN;
    bf16* CAT = (bf16*)(ws + WS_CAT); bf16* V = CAT + 512; bf16* LA = V;
    bf16* UP = (bf16*)(ws + WS_R2);
    bf16* UR = (bf16*)(ws + WS_R3);
    bf16* UG = (bf16*)(ws + WS_R4);
    bf16* POOLED = (bf16*)(ws + WS_R7); bf16* BB = (bf16*)(ws + WS_R8);
    bf16* MIXB = (bf16*)(ws + WS_MIXB); bf16* ACT = (bf16*)(ws + WS_ACT);
    float* SSQ = (float*)(ws + WS_SSQ); float* CS = (float*)(ws + WS_CS); float* CH = (float*)(ws + WS_CH);
    bf16* G0 = (bf16*)args.out; bf16* G1 = G0 + (size_t)M * 1024;
    float* X1 = args.out;

#ifndef EXTRA_SYNCS
#define EXTRA_SYNCS 0
#endif
    if (PROBE_PHASE == 99) tp0 = __builtin_amdgcn_s_memrealtime();
    volatile LAS unsigned* MISC = (volatile LAS unsigned*)(lds + 131072 + 1024);
    if (tid < 32) MISC[tid] = 0u;
    __syncthreads();
    XcdBarrier bar = xcd_barrier_post((unsigned*)ws, MISC + 8);
    if (lo < 0) cg::this_grid().sync();
    for (int i = 0; i < EXTRA_SYNCS; ++i) GSYNC();
    TSTART(0);
    if (IN(0)) for (int rep = 0; rep < REPS(0); ++rep) { if (rep) GSYNC();
        LAS float* scr = (LAS float*)(lds + wave * 16384);
        const int gw = bx * NWAVES + wave, NGW = G * NWAVES;
        constexpr int I_IN = 16 * (DIN / 32), I_FI = 16 * (2 * DFF / 32), I_FO = (DFF / 64) * (D / 32), I_RO = 16 * 32, I_WO = 16 * 32, I_PO = 8 * 32;
        constexpr int NITEMS = I_IN + I_FI + I_FO + I_RO + I_WO + I_PO;
        for (int it = gw; it < NITEMS; it += NGW) {
            int r = it;
            if (r < I_IN) { const int nblk = DIN / 32, kb = r / nblk, nb = r % nblk, nd = 32 * nb; int ns = nd;
                if (nd >= 2560) { const int q = nd - 2560, pq = q >> 8, j0 = q & 255; ns = 2560 + (j0 < 128 ? 128 * pq + j0 : 1024 + 128 * pq + (j0 - 128)); }
                transpose_item(args.in[I_W_IN], DIN, D, WIN, 64 * kb, ns, nd, args.in[I_NORM_MIX], scr, lane); continue; } r -= I_IN;
            if (r < I_FI) { const int nblk = 2 * DFF / 32, kb = r / nblk, nb = r % nblk, nd = 32 * nb, pn = nd >> 8, j0 = nd & 255;
                const int ns = j0 < 128 ? 128 * pn + j0 : DFF + 128 * pn + (j0 - 128);
                transpose_item(args.in[I_W_FFN_IN], 2 * DFF, D, WFI, 64 * kb, ns, nd, args.in[I_NORM_FFN], scr, lane); continue; } r -= I_FI;
            if (r < I_FO) { if (G != 256) { const int nblk = D / 32, kb = r / nblk, nb = r % nblk; transpose_item(args.in[I_W_FFN_OUT], D, DFF, WFO, 64 * kb, 32 * nb, 32 * nb, nullptr, scr, lane); } continue; } r -= I_FO;
            if (G == 256 && r < I_RO + I_WO + I_PO) continue;
            if (r < I_RO) { const int nblk = D / 32, kb = r / nblk, nb = r % nblk; transpose_item(args.in[I_W_RNN_OUT], D, 1536, WCAT + 512, 64 * kb, 32 * nb, 32 * nb, nullptr, scr, lane); continue; } r -= I_RO;
            if (r < I_WO) { const int nblk = D / 32, kb = r / nblk, nb = r % nblk; transpose_item(args.in[I_W_O], D, D, WO, 64 * kb, 32 * nb, 32 * nb, nullptr, scr, lane); continue; } r -= I_WO;
            { const int nblk = D / 32, kb = r / nblk, nb = r % nblk; transpose_item(args.in[I_W_POOL_OUT], D, 1536, WCAT, 64 * kb, 32 * nb, 32 * nb, nullptr, scr, lane); }
        }
        {
            const int gt = bx * NTHR + tid, NT = G * NTHR;
            const float* wg = args.in[I_W_GRP];
            for (int e = gt; e < 512 * 32; e += NT) { const int n = e >> 5, kc = (e & 31) * 8, g = n >> 7, nn = n & 127; float v[8];
#pragma unroll
                for (int j = 0; j < 8; ++j) { const int kk = kc + j - (g & 1) * 128; v[j] = (kk >= 0 && kk < 128) ? wg[((size_t)g * 128 + kk) * 128 + nn] : 0.f; }
                v4u o; o.x = cvt_pk_bf16(v[0], v[1]); o.y = cvt_pk_bf16(v[2], v[3]); o.z = cvt_pk_bf16(v[4], v[5]); o.w = cvt_pk_bf16(v[6], v[7]);
                *(v4u*)(WGRP + (size_t)n * 256 + kc) = o; }
            const float* wa = args.in[I_W_RG_A]; const float* wx = args.in[I_W_RG_X];
            for (int e = gt; e < 2048 * 16; e += NT) { const int n = e >> 4, kc = (e & 15) * 8, h = n >> 8, j = n & 255; const float* src = j < 128 ? wa : wx; const int jj = j & 127; float v[8];
#pragma unroll
                for (int q = 0; q < 8; ++q) v[q] = src[((size_t)h * 128 + kc + q) * 128 + jj];
                v4u o; o.x = cvt_pk_bf16(v[0], v[1]); o.y = cvt_pk_bf16(v[2], v[3]); o.z = cvt_pk_bf16(v[4], v[5]); o.w = cvt_pk_bf16(v[6], v[7]);
                *(v4u*)(WGATE + (size_t)n * 128 + kc) = o; }
        }
        { const int gt = bx * NTHR + tid; if (gt < DRNN) { const float z = -args.in[I_LAMBDA][gt]; ((float*)(ws + WS_SP8))[gt] = -8.0f * (fmaxf(z, 0.f) + log1pf(expf(-fabsf(z)))); } }
        float* RSI = (float*)(ws + WS_RSI);
        for (int m = gw; m < M; m += 2 * NGW) {
            const int m1 = (m + NGW < M) ? m + NGW : m;
            const f32x4* xr0 = (const f32x4*)(x + (size_t)m * D) + lane; const f32x4* xr1 = (const f32x4*)(x + (size_t)m1 * D) + lane; f32x4 v0[4], v1[4]; float s0 = 0.f, s1 = 0.f;
#pragma unroll
            for (int j = 0; j < 4; ++j) { v0[j] = __builtin_nontemporal_load(xr0 + 64 * j); v1[j] = __builtin_nontemporal_load(xr1 + 64 * j); }
#pragma unroll
            for (int j = 0; j < 4; ++j) { s0 += (v0[j].x * v0[j].x + v0[j].y * v0[j].y) + (v0[j].z * v0[j].z + v0[j].w * v0[j].w); s1 += (v1[j].x * v1[j].x + v1[j].y * v1[j].y) + (v1[j].z * v1[j].z + v1[j].w * v1[j].w); }
            const float q0 = sqrtf(wave_sum(s0) * (1.f / D) + EPS), q1 = sqrtf(wave_sum(s1) * (1.f / D) + EPS), rs0 = 1.0f / q0, rs1 = 1.0f / q1;
            if (lane == 0) { RSI[m] = q0; RSI[m1] = q1; }
            v2u* o0 = (v2u*)(XN + (size_t)m * D) + lane; v2u* o1 = (v2u*)(XN + (size_t)m1 * D) + lane;
#pragma unroll
            for (int j = 0; j < 4; ++j) { const f32x4 y0 = v0[j] * rs0, y1 = v1[j] * rs1; v2u w0, w1; w0.x = cvt_pk_bf16(y0.x, y0.y); w0.y = cvt_pk_bf16(y0.z, y0.w); w1.x = cvt_pk_bf16(y1.x, y1.y); w1.y = cvt_pk_bf16(y1.z, y1.w); o0[64 * j] = w0; o1[64 * j] = w1; }
        }
        __syncthreads();
    }
    SEAM(0);
    TEND(0);

    TSTART(1);
    if (IN(1)) for (int rep = 0; rep < REPS(1); ++rep) { if (rep) GSYNC();
        pg8::Gemm g{XN, WIN, M, 4096, D, D, D, 0, 0}; pg8::StaticOrder S; S.init(M, 4096, G, bx);
        pg8::EpiProj E{UP, UR, UG, G0, G1, 0};
        pg8::gemm_phase<pg8::EpiProj, true>(lds, g, S, E);
    }
    SEAM(1);
    TEND(1);

    TSTART(2);
    if (IN(2) && G != 256) for (int rep = 0; rep < REPS(2); ++rep) { if (rep) GSYNC();
        { const int gw = bx * NWAVES + wave, NGW = G * NWAVES;
          for (int wi = gw; wi < (M / 32) * 4; wi += NGW) pool_witem(UP, POOLED, wi & 3, (wi >> 2) * 32, lane); }
        { const int gt = bx * NTHR + tid, NT = G * NTHR;
          for (int it = gt; it < (M / 8) * 128; it += NT) conv_item(UR, V, args.in[I_CONV_W], args.in[I_CONV_B], (it >> 7) * 8, it & 127); }
    }
    if (G != 256)     SEAM(2);
    TEND(2);

    TSTART(3);
    if (IN(3)) for (int rep = 0; rep < REPS(3); ++rep) { if (rep) GSYNC();
        const bool fusedp2 = (G == 256);
        if (fusedp2) {
            { pg8::StaticOrder Sg; Sg.init(M, 512, G, (bx + G / 2) % G); pg8::Unit u;
              if (Sg.next(0, u)) { for (int wi = wave; wi < 16; wi += NWAVES) pool_witem(UP, POOLED, 2 * u.pn + (wi & 1), u.pm * 256 + (wi >> 1) * 32, lane); } }
            asm volatile("s_waitcnt vmcnt(0)" ::: "memory"); __syncthreads();
        }
        {
          pg8::Gemm g{XN, WIN + (size_t)4096 * D, M, 512, D, D, D, 0, 0}; pg8::StaticOrder S; S.init(M, 512, G, bx);
          pg8::EpiProj E{UP, UR, UG, G0, G1, 16};
          pg8::gemm_phase<pg8::EpiProj, true>(lds, g, S, E); }
        { pg8::Gemm g{POOLED, WGRP, M, 512, 256, 512, 256, 0, 256}; pg8::StaticOrder S; S.init(M, 512, G, (bx + G / 2) % G);
          pg8::EpiGrp E{CAT, 1536, args.in[I_POOL_SCALE]};
          pg8::gemm_phase<pg8::EpiGrp, true>(lds, g, S, E); }
        { pg8::Gemm g{V, WGATE, M, 2048, 128, 1536, 128, 0, 128}; pg8::StaticOrder S; S.init(M, 2048, G, bx);
          if (fusedp2) { S.lin_base = bx * 2; S.lin_cnt = 2; }
          pg8::EpiGate E{V, LA, BB, args.in[I_B_RG_A], args.in[I_B_RG_X], (const float*)(ws + WS_SP8)};
          if (fusedp2) { E.vlds = lds; E.use_lds = true;
              for (int i = 0; i < 2; ++i) { pg8::Unit u; if (S.next(i, u)) pg8::gate_unit_fused<pg8::EpiGate>(lds, UR, args.in[I_CONV_W], args.in[I_CONV_B], WGATE, E, u.pm, u.pn, nullptr); } }
          else pg8::gemm_phase<pg8::EpiGate, true>(lds, g, S, E); }
        if (fusedp2 && bx >= 128) {
            LAS float* scr = (LAS float*)(lds + wave * 16384); constexpr int J_RO = 16 * 32, J_WO = 16 * 32, J_PO = 8 * 32;
            for (int it = (bx - 128) * NWAVES + wave; it < J_RO + J_WO + J_PO; it += 128 * NWAVES) { int r = it; const int nblk = D / 32;
                if (r < J_RO) { const int kb = r / nblk, nb = r % nblk; transpose_item(args.in[I_W_RNN_OUT], D, 1536, WCAT + 512, 64 * kb, 32 * nb, 32 * nb, nullptr, scr, lane); continue; } r -= J_RO;
                if (r < J_WO) { const int kb = r / nblk, nb = r % nblk; transpose_item(args.in[I_W_O], D, D, WO, 64 * kb, 32 * nb, 32 * nb, nullptr, scr, lane); continue; } r -= J_WO;
                { const int kb = r / nblk, nb = r % nblk; transpose_item(args.in[I_W_POOL_OUT], D, 1536, WCAT, 64 * kb, 32 * nb, 32 * nb, nullptr, scr, lane); } }
        }
    }
    SEAM(3);
    TEND(3);

    TSTART(4);
    TEND(4);

    TSTART(5);
    if (IN(5)) for (int rep = 0; rep < REPS(5); ++rep) { if (rep) GSYNC();
        LAS float* PAS = (LAS float*)lds; LAS float* PAH = PAS + 8 * 512; LAS float* PBS = PAH + 8 * 512; LAS float* PBH = PBS + 8 * 512;
        unsigned* flags = (unsigned*)ws + 8192;
        for (int bi = bx; bi < NB * SCAN_NC * 2; bi += G) { const int hh = bi & 1, c = (bi >> 1) % SCAN_NC, b = bi / (2 * SCAN_NC);
            const size_t off = ((size_t)b * SEQ + (size_t)c * SCAN_T + wave * 16) * DRNN + hh * 512 + lane * 8;
            v4u lwk[16], bwk[16];
            const size_t offL = ((size_t)b * SEQ + (size_t)c * SCAN_T + wave * 16) * 1536 + hh * 512 + lane * 8;
#pragma unroll
            for (int i = 0; i < 16; ++i) { lwk[i] = __builtin_nontemporal_load((const v4u*)(LA + offL + (size_t)i * 1536)); bwk[i] = __builtin_nontemporal_load((const v4u*)(BB + off + (size_t)i * DRNN)); }
            { f32x4 S[2] = {{0.f, 0.f, 0.f, 0.f}, {0.f, 0.f, 0.f, 0.f}}, H[2] = {{0.f, 0.f, 0.f, 0.f}, {0.f, 0.f, 0.f, 0.f}};
#pragma unroll
              for (int i = 0; i < 16; ++i) { f32x4 l[2], bq[2]; pg8::unpack8(lwk[i], l[0], l[1]); pg8::unpack8(bwk[i], bq[0], bq[1]);
#pragma unroll
                  for (int n = 0; n < 2; ++n)
#pragma unroll
                      for (int j = 0; j < 4; ++j) { H[n][j] = __expf(l[n][j]) * H[n][j] + bq[n][j]; S[n][j] += l[n][j]; } }
              *(LAS f32x4*)(PBS + wave * 512 + lane * 8) = S[0]; *(LAS f32x4*)(PBS + wave * 512 + lane * 8 + 4) = S[1];
              *(LAS f32x4*)(PBH + wave * 512 + lane * 8) = H[0]; *(LAS f32x4*)(PBH + wave * 512 + lane * 8 + 4) = H[1]; }
#pragma unroll
            for (int i = 0; i < 16; ++i) asm volatile("" : "+v"(lwk[i]), "+v"(bwk[i]));
            __syncthreads();
            { float h = 0.f, st = 0.f;
#pragma unroll
              for (int sb = 0; sb < 8; ++sb) { const float sv = PBS[sb * 512 + tid]; h = __expf(sv) * h + PBH[sb * 512 + tid]; st += sv; }
              const size_t co = ((size_t)b * SCAN_NC + c) * DRNN + hh * 512 + tid;
              __hip_atomic_store(CS + co, st, __ATOMIC_RELAXED, __HIP_MEMORY_SCOPE_AGENT); __hip_atomic_store(CH + co, h, __ATOMIC_RELAXED, __HIP_MEMORY_SCOPE_AGENT); }
            asm volatile("s_waitcnt vmcnt(0)" ::: "memory");
            __syncthreads();
            if (tid == 0) __hip_atomic_store(flags + ((b * 2 + hh) * SCAN_NC + c) * 16, 1u, __ATOMIC_RELAXED, __HIP_MEMORY_SCOPE_AGENT);
            { f32x4 S[2] = {{0.f, 0.f, 0.f, 0.f}, {0.f, 0.f, 0.f, 0.f}}, H[2] = {{0.f, 0.f, 0.f, 0.f}, {0.f, 0.f, 0.f, 0.f}};
              if (wave * 4 < c) {
                  for (int q = 0; q < 4; ++q) { const int cc = wave * 4 + q; if (cc < c) { unsigned* f = flags + ((b * 2 + hh) * SCAN_NC + cc) * 16; unsigned sp = 0;
                      while ((unsigned)__builtin_amdgcn_readfirstlane(__hip_atomic_load(f, __ATOMIC_RELAXED, __HIP_MEMORY_SCOPE_AGENT)) == 0u) { __builtin_amdgcn_s_sleep(1); if (++sp > (1u << 20)) break; } } }
                  __builtin_amdgcn_fence(__ATOMIC_ACQUIRE, "agent");
#pragma unroll
                  for (int q0 = 0; q0 < 4; q0 += 2) { f32x4 cs[2][2], ch[2][2];
#pragma unroll
                      for (int q = 0; q < 2; ++q) { const int cc = wave * 4 + q0 + q; const size_t co = ((size_t)b * SCAN_NC + (cc < c ? cc : 0)) * DRNN + hh * 512 + lane * 8;
                          cs[q][0] = *(const f32x4*)(CS + co); cs[q][1] = *(const f32x4*)(CS + co + 4); ch[q][0] = *(const f32x4*)(CH + co); ch[q][1] = *(const f32x4*)(CH + co + 4); }
#pragma unroll
                      for (int q = 0; q < 2; ++q) { if (wave * 4 + q0 + q < c) {
#pragma unroll
                          for (int n = 0; n < 2; ++n)
#pragma unroll
                              for (int j = 0; j < 4; ++j) { H[n][j] = __expf(cs[q][n][j]) * H[n][j] + ch[q][n][j]; S[n][j] += cs[q][n][j]; } } }
                      asm volatile("" ::: "memory"); }
              }
              *(LAS f32x4*)(PAS + wave * 512 + lane * 8) = S[0]; *(LAS f32x4*)(PAS + wave * 512 + lane * 8 + 4) = S[1];
              *(LAS f32x4*)(PAH + wave * 512 + lane * 8) = H[0]; *(LAS f32x4*)(PAH + wave * 512 + lane * 8 + 4) = H[1]; }
            __syncthreads();
            f32x4 h[2] = {{0.f, 0.f, 0.f, 0.f}, {0.f, 0.f, 0.f, 0.f}};
#pragma unroll
            for (int sb = 0; sb < 8; ++sb) {
#pragma unroll
                for (int n = 0; n < 2; ++n) { const f32x4 sv = *(const LAS f32x4*)(PAS + sb * 512 + lane * 8 + 4 * n), hv = *(const LAS f32x4*)(PAH + sb * 512 + lane * 8 + 4 * n);
#pragma unroll
                    for (int j = 0; j < 4; ++j) h[n][j] = __expf(sv[j]) * h[n][j] + hv[j]; } }
            for (int sb = 0; sb < wave; ++sb) {
#pragma unroll
                for (int n = 0; n < 2; ++n) { const f32x4 sv = *(const LAS f32x4*)(PBS + sb * 512 + lane * 8 + 4 * n), hv = *(const LAS f32x4*)(PBH + sb * 512 + lane * 8 + 4 * n);
#pragma unroll
                    for (int j = 0; j < 4; ++j) h[n][j] = __expf(sv[j]) * h[n][j] + hv[j]; } }
            const bf16* ugp = UG + off;
            bf16* hgp = CAT + ((size_t)b * SEQ + (size_t)c * SCAN_T + wave * 16) * 1536 + 512 + hh * 512 + lane * 8;
            v4u gwk[16];
#pragma unroll
            for (int i = 0; i < 16; ++i) gwk[i] = __builtin_nontemporal_load((const v4u*)(ugp + (size_t)i * DRNN));
#pragma unroll
            for (int i0 = 0; i0 < 16; i0 += 8) { const v4u* gw8 = gwk + i0;
#pragma unroll
                for (int i = 0; i < 8; ++i) { f32x4 l[2], bq[2], gq[2], o[2]; pg8::unpack8(lwk[i0 + i], l[0], l[1]); pg8::unpack8(bwk[i0 + i], bq[0], bq[1]); pg8::unpack8(gw8[i], gq[0], gq[1]);
#pragma unroll
                    for (int n = 0; n < 2; ++n)
#pragma unroll
                        for (int j = 0; j < 4; ++j) { h[n][j] = __expf(l[n][j]) * h[n][j] + bq[n][j]; o[n][j] = h[n][j] * pg8::gelu_tanh_(gq[n][j]); }
                    *(v4u*)(hgp + (size_t)(i0 + i) * 1536) = pg8::pack8(o[0], o[1]); } }
            __syncthreads();
        }
    }
    SEAM(5);
    TEND(5);

    TSTART(6);
    if (IN(6)) for (int rep = 0; rep < REPS(6); ++rep) { if (rep) GSYNC();
        pg8::Gemm g{CAT, WCAT, M, D, 1536, 1536, 1536, 0, 0}; pg8::StaticOrder S; S.init(M, D, G, bx);
        pg8::EpiMix E{G0, G1, MIXB};
        pg8::gemm_phase<pg8::EpiMix, true, 8>(lds, g, S, E);
    }
    SEAM(6);
    TEND(6);

    TSTART(7);
    if (IN(7)) for (int rep = 0; rep < REPS(7); ++rep) { if (rep) GSYNC();
        pg8::Gemm g{MIXB, WO, M, D, D, D, D, 0, 0}; pg8::StaticOrder S; S.init(M, D, G, bx);
        pg8::EpiRes1 E{XN, (const float*)(ws + WS_RSI), X1B, SSQ};
        pg8::gemm_phase<pg8::EpiRes1, true>(lds, g, S, E);
    }
    SEAM(7);
    TEND(7);

    TSTART(8);
    if (IN(8)) for (int rep = 0; rep < REPS(8); ++rep) { if (rep) GSYNC();
        pg8::Gemm g{X1B, WFI, M, 2 * DFF, D, D, D, 0, 0}; pg8::StaticOrder S; S.init(M, 2 * DFF, G, bx);
        LAS float* RSL = (LAS float*)(lds + 133120);
        { const int r = tid & 255;
          for (int i = tid >> 8; i < 8; i += 2) { pg8::Unit u; if (!S.next(i, u)) break;
              const f32x4* sp = (const f32x4*)(SSQ + (size_t)(u.pm * 256 + r) * 16); const f32x4 st = (sp[0] + sp[1]) + (sp[2] + sp[3]);
              RSL[i * 256 + r] = __builtin_amdgcn_rsqf(((st[0] + st[1]) + (st[2] + st[3])) * (1.0f / 1024.0f) + 1e-6f); }
          __syncthreads(); }
        pg8::EpiSwiglu E{RSL, ACT};
        pg8::gemm_phase<pg8::EpiSwiglu, true>(lds, g, S, E);
        if (G == 256 && bx >= 128) {
            LAS float* scr = (LAS float*)(lds + wave * 16384); constexpr int I_FO = (DFF / 64) * (D / 32);
            for (int r = (bx - 128) * NWAVES + wave; r < I_FO; r += 128 * NWAVES) { const int nblk = D / 32, kb = r / nblk, nb = r % nblk;
                transpose_item(args.in[I_W_FFN_OUT], D, DFF, WFO, 64 * kb, 32 * nb, 32 * nb, nullptr, scr, lane); }
        }
    }
    SEAM(8);
    TEND(8);

    TSTART(9);
    if (IN(9)) for (int rep = 0; rep < REPS(9); ++rep) { if (rep) GSYNC();
        pg8::Gemm g{ACT, WFO, M, D, DFF, DFF, DFF, 0, 0}; pg8::StaticOrder S; S.init(M, D, G, bx);
        if (G == 256) { pg8::EpiFinal E{X1B, X1, (float*)(ws + WS_SSQ2), (unsigned*)ws + 4096, args.in[I_NORM_FINAL]};
            pg8::gemm_phase<pg8::EpiFinal, true>(lds, g, S, E); }
        else { pg8::EpiRes2 E{X1B, X1};
            pg8::gemm_phase<pg8::EpiRes2, true>(lds, g, S, E); }
    }
    if (G != 256) SEAM(9);
    TEND(9);

    TSTART(10);
    if (IN(10) && G != 256) for (int rep = 0; rep < REPS(10); ++rep) { if (rep) GSYNC();
        const int gw = bx * NWAVES + wave, NGW = G * NWAVES;
        const float* gf = args.in[I_NORM_FINAL]; f32x4 gv[4];
#pragma unroll
        for (int j = 0; j < 4; ++j) gv[j] = ((const f32x4*)gf)[lane + 64 * j];
        for (int m = gw; m < M; m += NGW) {
            f32x4* xr = (f32x4*)(X1 + (size_t)m * D) + lane; f32x4 v[4]; float s = 0.f;
#pragma unroll
            for (int j = 0; j < 4; ++j) { v[j] = xr[64 * j]; s += (v[j].x * v[j].x + v[j].y * v[j].y) + (v[j].z * v[j].z + v[j].w * v[j].w); }
            const float rs = 1.0f / sqrtf(wave_sum(s) * (1.f / D) + EPS);
#pragma unroll
            for (int j = 0; j < 4; ++j) xr[64 * j] = v[j] * rs * gv[j];
        }
    }
    if (PROBE_PHASE == 10 || PROBE_PHASE == 99) tp1 = __builtin_amdgcn_s_memrealtime();
    if (PROBE_PHASE >= 0 && bx == 0 && tid == 0) { const unsigned long long dt = (tp1 - tp0) * PROBE_MULT, te = __builtin_amdgcn_s_memrealtime(); while (__builtin_amdgcn_s_memrealtime() - te < dt) __builtin_amdgcn_s_sleep(8); }
#undef IN
#undef SEAM
}

extern "C" void kernel_launch(void* const* d_in, const int* in_sizes, int n_in, void* d_out, int out_size, void* d_ws, size_t ws_size, hipStream_t stream) {
    static int grid = 0;
    if (grid == 0) {
        if (n_in != 19 || out_size != M * D || ws_size < WS_END) { fprintf(stderr, "kernel_launch: unexpected shapes (n_in %d out %d ws %zu)\n", n_in, out_size, ws_size); grid = -1; return; }
        int dev = 0, cus = 0, per_cu = 0;
        hipGetDevice(&dev);
        hipDeviceGetAttribute(&cus, hipDeviceAttributeMultiprocessorCount, dev);
        if (hipFuncSetAttribute((const void*)fwd_kernel, hipFuncAttributeMaxDynamicSharedMemorySize, LDS_BYTES) != hipSuccess) { fprintf(stderr, "kernel_launch: hipFuncSetAttribute failed\n"); grid = -1; return; }
        if (hipOccupancyMaxActiveBlocksPerMultiprocessor(&per_cu, (const void*)fwd_kernel, NTHR, LDS_BYTES) != hipSuccess || per_cu < 1) { fprintf(stderr, "kernel_launch: occupancy query says %d\n", per_cu); per_cu = 1; }
        (void)hipGetLastError();
        grid = cus * 1;
        fprintf(stderr, "kernel_launch: grid %d (cus %d, per_cu %d)\n", grid, cus, per_cu);
    }
    if (grid < 0) return;
    if (hipMemsetAsync(d_ws, 0, 49152, stream) != hipSuccess) { fprintf(stderr, "kernel_launch: memset failed\n"); return; }
    Args a{};
    for (int i = 0; i < 19; ++i) a.in[i] = (const float*)d_in[i];
    a.out = (float*)d_out; a.ws = (unsigned char*)d_ws;
#if MK_PER_PHASE
    for (int p = 0; p < NPH; ++p) { a.ph_lo = p; a.ph_hi = p + 1; hipLaunchKernelGGL(fwd_kernel, dim3(grid), dim3(NTHR), LDS_BYTES, stream, a); }
#else
    a.ph_lo = 0; a.ph_hi = NPH;
    void* kargs[] = {&a};
    hipError_t e = hipLaunchCooperativeKernel((const void*)fwd_kernel, dim3(grid), dim3(NTHR), kargs, LDS_BYTES, stream);
    if (e != hipSuccess) fprintf(stderr, "cooperative launch failed: %s (grid %d)\n", hipGetErrorString(e), grid);
#endif
}
```
